# Optimizing an MI355X kernel written in HIP

```python
import math
import jax
import jax.numpy as jnp
from jax import lax
import numpy as np

D_MODEL = 1024
BATCH = 8
SEQ = 4096
DEPTH = 2

GLA_HEADS = 4
GLA_DK = D_MODEL // 16
GLA_DV = D_MODEL // 8
GLA_RANK = 16
GLA_GATE_NORM = 16.0
ML_HEADS = 4
ML_DK = D_MODEL // 16
ML_DV = D_MODEL // 8
ML_CONV = 4
S5_GROUP = 16
S5_WIDTH = D_MODEL // 2
S5_GROUPS = S5_WIDTH // S5_GROUP
S5_STATE = 64
S5_DT_MIN = 0.001
S5_DT_MAX = 0.1
CHUNK = 64
FFN_HIDDEN = ((8 * D_MODEL + 767) // 768) * 256
N_BRANCH = 3
RMS_EPS = 1e-6

IN_SIZES = (
    GLA_HEADS * GLA_DK,
    GLA_HEADS * GLA_DK,
    GLA_HEADS * GLA_DV,
    GLA_RANK,
    GLA_HEADS * GLA_DV,
    ML_HEADS * ML_DK,
    ML_HEADS * ML_DK,
    ML_HEADS * ML_DV,
    ML_HEADS,
    ML_HEADS,
    ML_HEADS * ML_DV,
    S5_WIDTH,
    N_BRANCH * D_MODEL,
)
IN_DIM = sum(IN_SIZES)

kernel_name = 'hybrid_gla_mlstm_s5_block'


def rms_norm(x, w):
    xf = x.astype(jnp.float32)
    y = xf * lax.rsqrt(jnp.mean(xf * xf, axis=-1, keepdims=True) + RMS_EPS)
    return (y * w.astype(jnp.float32)).astype(x.dtype)


def _split(z, sizes):
    out, start = [], 0
    for s in sizes:
        out.append(z[..., start:start + s])
        start += s
    return out


def _heads(a, n):
    return a.reshape(a.shape[0], a.shape[1], n, -1)


def _to_chunks(a):
    b, t, h, d = a.shape
    return a.reshape(b, t // CHUNK, CHUNK, h, d).transpose(1, 0, 3, 2, 4)


def _from_chunks(a):
    n, b, h, l, d = a.shape
    return a.transpose(1, 0, 3, 2, 4).reshape(b, n * l, h, d)


def gla_attention(q, k, v, g):
    out_dtype = v.dtype
    f32 = jnp.float32
    bsz, _, heads, dk = q.shape
    dv = v.shape[-1]
    qc, kc, vc, gc = (_to_chunks(a.astype(f32)) for a in (q * dk ** -0.5, k, v, g))
    causal = jnp.tril(jnp.ones((CHUNK, CHUNK), dtype=bool))

    def step(state, inp):
        qi, ki, vi, gi = inp
        cum = jnp.cumsum(gi, axis=2)
        o_inter = jnp.einsum('bhld,bhdv->bhlv', qi * jnp.exp(cum), state)
        rel = cum[:, :, :, None, :] - cum[:, :, None, :, :]
        decay = jnp.exp(jnp.where(causal[:, :, None], rel, -jnp.inf))
        scores = jnp.einsum('bhid,bhjd,bhijd->bhij', qi, ki, decay)
        o = o_inter + jnp.einsum('bhij,bhjv->bhiv', scores, vi)
        last = cum[:, :, -1:, :]
        state = (jnp.exp(last[:, :, 0, :])[..., None] * state
                 + jnp.einsum('bhjd,bhjv->bhdv', ki * jnp.exp(last - cum), vi))
        return state, o

    s0 = jnp.zeros((bsz, heads, dk, dv), f32)
    _, o = lax.scan(step, s0, (qc, kc, vc, gc))
    return _from_chunks(o).astype(out_dtype)


def mlstm_memory(q, k, v, i_pre, f_pre):
    out_dtype = v.dtype
    f32 = jnp.float32
    bsz, _, heads, dk = q.shape
    dv = v.shape[-1]
    log_f = jax.nn.log_sigmoid(f_pre.astype(f32))
    qc, kc, vc = (_to_chunks(a.astype(f32)) for a in (q, k * dk ** -0.5, v))
    ic, fc = (_to_chunks(a.astype(f32)[..., None])[..., 0] for a in (i_pre, log_f))
    causal = jnp.tril(jnp.ones((CHUNK, CHUNK), dtype=bool))

    def step(carry, inp):
        mem, norm, m_prev = carry
        qi, ki, vi, ii, lfi = inp
        b = jnp.cumsum(lfi, axis=-1)
        a_inter = b + m_prev[..., None]
        d_intra = jnp.where(causal, b[..., :, None] - b[..., None, :] + ii[..., None, :], -jnp.inf)
        m_t = jnp.maximum(a_inter, jnp.max(d_intra, axis=-1))
        w_inter = jnp.exp(a_inter - m_t)
        scores = jnp.einsum('bhtd,bhsd->bhts', qi, ki) * jnp.exp(d_intra - m_t[..., None])
        num = (w_inter[..., None] * jnp.einsum('bhtd,bhdv->bhtv', qi, mem)
               + jnp.einsum('bhts,bhsv->bhtv', scores, vi))
        den = w_inter * jnp.einsum('bhtd,bhd->bht', qi, norm) + jnp.sum(scores, axis=-1)
        h = num / jnp.maximum(jnp.abs(den), jnp.exp(-m_t))[..., None]
        m_new = m_t[..., -1]
        carry_decay = jnp.exp(b[..., -1] + m_prev - m_new)
        w_key = jnp.exp(b[..., -1:] - b + ii - m_new[..., None])
        mem = carry_decay[..., None, None] * mem + jnp.einsum('bhs,bhsd,bhsv->bhdv', w_key, ki, vi)
        norm = carry_decay[..., None] * norm + jnp.einsum('bhs,bhsd->bhd', w_key, ki)
        return (mem, norm, m_new), h

    carry0 = (jnp.zeros((bsz, heads, dk, dv), f32),
              jnp.zeros((bsz, heads, dk), f32),
              jnp.zeros((bsz, heads), f32))
    _, h = lax.scan(step, carry0, (qc, kc, vc, ic, fc))
    return _from_chunks(h).astype(out_dtype)


def _complex_linear_combine(earlier, later):
    a1r, a1i, b1r, b1i = earlier
    a2r, a2i, b2r, b2i = later
    return (a2r * a1r - a2i * a1i,
            a2r * a1i + a2i * a1r,
            a2r * b1r - a2i * b1i + b2r,
            a2r * b1i + a2i * b1r + b2i)


def s5_ssm(u, lam_re, lam_im, log_step, b_re, b_im, c_re, c_im, d_skip):
    out_dtype = u.dtype
    f32 = jnp.float32
    bsz, t, _ = u.shape
    uf = u.astype(f32).reshape(bsz, t, S5_GROUPS, S5_GROUP)
    lam_re = jnp.minimum(lam_re.astype(f32), -1e-4)
    lam_im = lam_im.astype(f32)
    dt = jnp.exp(log_step.astype(f32))[:, None]
    mag = jnp.exp(lam_re * dt)
    abar_re = mag * jnp.cos(lam_im * dt)
    abar_im = mag * jnp.sin(lam_im * dt)
    inv = 1.0 / (lam_re * lam_re + lam_im * lam_im)
    z_re = ((abar_re - 1.0) * lam_re + abar_im * lam_im) * inv
    z_im = (abar_im * lam_re - (abar_re - 1.0) * lam_im) * inv
    b_re = b_re.astype(f32)
    b_im = b_im.astype(f32)
    bbar_re = z_re[..., None] * b_re - z_im[..., None] * b_im
    bbar_im = z_re[..., None] * b_im + z_im[..., None] * b_re
    bu_re = jnp.einsum('gpc,btgc->btgp', bbar_re, uf)
    bu_im = jnp.einsum('gpc,btgc->btgp', bbar_im, uf)
    a_re = jnp.broadcast_to(abar_re, (1, t) + abar_re.shape)
    a_im = jnp.broadcast_to(abar_im, (1, t) + abar_im.shape)
    _, _, x_re, x_im = lax.associative_scan(_complex_linear_combine, (a_re, a_im, bu_re, bu_im), axis=1)
    y = (jnp.einsum('gcp,btgp->btgc', c_re.astype(f32), x_re)
         - jnp.einsum('gcp,btgp->btgc', c_im.astype(f32), x_im))
    y = y.reshape(bsz, t, S5_WIDTH) + d_skip.astype(f32) * u.astype(f32)
    return y.astype(out_dtype)


def causal_dwconv(u, w, b):
    k = w.shape[0]
    y = lax.conv_general_dilated(u, w[:, None, :], window_strides=(1,), padding=[(k - 1, 0)],
                                 dimension_numbers=('NWC', 'WIO', 'NWC'),
                                 feature_group_count=u.shape[-1])
    return y + b


def hybrid_mixer(h, w_in, gla_a2, gla_a_b, gla_norm_w, ml_conv_w, ml_conv_b, ml_i_b, ml_f_b,
                 s5_lam_re, s5_lam_im, s5_log_step, s5_b_re, s5_b_im, s5_c_re, s5_c_im, s5_d,
                 s5_glu_w, s5_glu_b, proj_gla, proj_ml, proj_s5, branch_gate_b, w_out):
    bsz, t, _ = h.shape
    z = h @ w_in
    gq, gk, gv, ga, gr, mq, mk, mv, mi, mf, mo, su, zg = _split(z, IN_SIZES)

    g_log = jax.nn.log_sigmoid((ga @ gla_a2 + gla_a_b).astype(jnp.float32)) / GLA_GATE_NORM
    o_gla = gla_attention(_heads(gq, GLA_HEADS), _heads(gk, GLA_HEADS), _heads(gv, GLA_HEADS),
                          _heads(g_log, GLA_HEADS))
    o_gla = rms_norm(o_gla, gla_norm_w.reshape(GLA_HEADS, GLA_DV)).reshape(bsz, t, -1)
    y_gla = o_gla * jax.nn.silu(gr)

    qk = jax.nn.silu(causal_dwconv(jnp.concatenate([mq, mk], axis=-1), ml_conv_w, ml_conv_b))
    mq = qk[..., :ML_HEADS * ML_DK]
    mk = qk[..., ML_HEADS * ML_DK:]
    h_ml = mlstm_memory(_heads(mq, ML_HEADS), _heads(mk, ML_HEADS), _heads(mv, ML_HEADS),
                        mi + ml_i_b, mf + ml_f_b)
    y_ml = jax.nn.sigmoid(mo) * h_ml.reshape(bsz, t, -1)

    y_s5 = jax.nn.gelu(s5_ssm(su, s5_lam_re, s5_lam_im, s5_log_step, s5_b_re, s5_b_im,
                              s5_c_re, s5_c_im, s5_d))
    y_s5 = y_s5 * jax.nn.sigmoid(y_s5 @ s5_glu_w + s5_glu_b)

    gates = jax.nn.sigmoid(zg + branch_gate_b).reshape(bsz, t, N_BRANCH, D_MODEL)
    merged = (gates[:, :, 0] * (y_gla @ proj_gla)
              + gates[:, :, 1] * (y_ml @ proj_ml)
              + gates[:, :, 2] * (y_s5 @ proj_s5))
    return merged @ w_out


def swiglu_ffn(h, w_in, w_out):
    gate, up = jnp.split(h @ w_in, 2, axis=-1)
    return (jax.nn.silu(gate) * up) @ w_out


def setup_inputs(seed: int = 0) -> dict:
    key = jax.random.key(seed)
    keys = list(jax.random.split(key, 48))

    def normal(shape, scale):
        return scale * jax.random.normal(keys.pop(), shape, jnp.float32)

    def uniform(shape):
        return jax.random.uniform(keys.pop(), shape, jnp.float32)

    def gain(shape):
        return 1.0 + normal(shape, 0.05)

    L, D = DEPTH, D_MODEL
    glw = GLA_HEADS * GLA_DV
    mlw = ML_HEADS * ML_DV
    n_idx = jnp.arange(S5_STATE, dtype=jnp.float32)
    log_lo, log_hi = math.log(S5_DT_MIN), math.log(S5_DT_MAX)
    return {
        'x': normal((BATCH, SEQ, D), 1.0),
        'c': normal((BATCH, D), 1.0),
        'ada_w': normal((L, D, 6 * D), 0.1 * D ** -0.5),
        'ada_b': normal((L, 6 * D), 0.01),
        'pre1_w': gain((L, D)),
        'post1_w': gain((L, D)),
        'pre2_w': gain((L, D)),
        'post2_w': gain((L, D)),
        'w_in': normal((L, D, IN_DIM), D ** -0.5),
        'gla_a2': normal((L, GLA_RANK, GLA_HEADS * GLA_DK), GLA_RANK ** -0.5),
        'gla_a_b': normal((L, GLA_HEADS * GLA_DK), 0.1),
        'gla_norm_w': gain((L, glw)),
        'ml_conv_w': normal((L, ML_CONV, 2 * ML_HEADS * ML_DK), ML_CONV ** -0.5),
        'ml_conv_b': normal((L, 2 * ML_HEADS * ML_DK), 0.01),
        'ml_i_b': normal((L, ML_HEADS), 0.1),
        'ml_f_b': 3.0 + 3.0 * uniform((L, ML_HEADS)),
        's5_lam_re': -0.5 + normal((L, S5_GROUPS, S5_STATE), 0.01),
        's5_lam_im': math.pi * n_idx + normal((L, S5_GROUPS, S5_STATE), 0.01),
        's5_log_step': log_lo + (log_hi - log_lo) * uniform((L, S5_GROUPS)),
        's5_b_re': normal((L, S5_GROUPS, S5_STATE, S5_GROUP), (2 * S5_GROUP) ** -0.5),
        's5_b_im': normal((L, S5_GROUPS, S5_STATE, S5_GROUP), (2 * S5_GROUP) ** -0.5),
        's5_c_re': normal((L, S5_GROUPS, S5_GROUP, S5_STATE), S5_STATE ** -0.5),
        's5_c_im': normal((L, S5_GROUPS, S5_GROUP, S5_STATE), S5_STATE ** -0.5),
        's5_d': normal((L, S5_WIDTH), 1.0),
        's5_glu_w': normal((L, S5_WIDTH, S5_WIDTH), S5_WIDTH ** -0.5),
        's5_glu_b': normal((L, S5_WIDTH), 0.01),
        'proj_gla': normal((L, glw, D), glw ** -0.5),
        'proj_ml': normal((L, mlw, D), mlw ** -0.5),
        'proj_s5': normal((L, S5_WIDTH, D), S5_WIDTH ** -0.5),
        'branch_gate_b': normal((L, N_BRANCH * D), 0.01),
        'w_out': normal((L, D, D), D ** -0.5),
        'ffn_w_in': normal((L, D, 2 * FFN_HIDDEN), D ** -0.5),
        'ffn_w_out': normal((L, FFN_HIDDEN, D), FFN_HIDDEN ** -0.5),
    }


def reference(x, c, ada_w, ada_b, pre1_w, post1_w, pre2_w, post2_w, w_in, gla_a2, gla_a_b,
              gla_norm_w, ml_conv_w, ml_conv_b, ml_i_b, ml_f_b, s5_lam_re, s5_lam_im, s5_log_step,
              s5_b_re, s5_b_im, s5_c_re, s5_c_im, s5_d, s5_glu_w, s5_glu_b, proj_gla, proj_ml,
              proj_s5, branch_gate_b, w_out, ffn_w_in, ffn_w_out):
    c_act = jax.nn.silu(c)
    for l in range(DEPTH):
        mod = c_act @ ada_w[l] + ada_b[l]
        sh1, sc1, gt1, sh2, sc2, gt2 = [m[:, None, :] for m in jnp.split(mod, 6, axis=-1)]

        h = rms_norm(x, pre1_w[l]) * (1.0 + sc1) + sh1
        y = hybrid_mixer(h, w_in[l], gla_a2[l], gla_a_b[l], gla_norm_w[l], ml_conv_w[l], ml_conv_b[l],
                         ml_i_b[l], ml_f_b[l], s5_lam_re[l], s5_lam_im[l], s5_log_step[l],
                         s5_b_re[l], s5_b_im[l], s5_c_re[l], s5_c_im[l], s5_d[l], s5_glu_w[l],
                         s5_glu_b[l], proj_gla[l], proj_ml[l], proj_s5[l], branch_gate_b[l], w_out[l])
        x = x + (1.0 + gt1) * rms_norm(y, post1_w[l])

        h = rms_norm(x, pre2_w[l]) * (1.0 + sc2) + sh2
        y = swiglu_ffn(h, ffn_w_in[l], ffn_w_out[l])
        x = x + (1.0 + gt2) * rms_norm(y, post2_w[l])
    return x
```

```cpp
#include <hip/hip_runtime.h>
#include <cstdint>
#include <cstdio>

typedef unsigned short bf16_t;

constexpr int NB = 8, T = 4096, D = 1024, M = NB * T, DEPTH = 2;
constexpr int INDIM = 6680, ZLD = 6656, FF = 2816;
constexpr int GQ = 0, GK = 256, GV = 512, GR = 1024, MQ = 1536, MK = 1792, MV = 2048, MO = 2560, SU = 3072, ZG = 3584;
constexpr int YS2 = 0;
constexpr int MRG = 512;
constexpr int YO = 1536;
constexpr size_t MiB = 1u << 20;
constexpr size_t WS_MOD = 512 * 1024;
constexpr size_t WS_ZS = 1 * MiB;
constexpr size_t WS_H = 32 * MiB;
constexpr size_t WS_Z = 96 * MiB;
constexpr size_t WS_END = 512 * MiB;

__device__ __forceinline__ float bf2f(bf16_t v) { return __uint_as_float(((unsigned)v) << 16); }
__device__ __forceinline__ bf16_t f2bf(float f) { unsigned u = __float_as_uint(f); return (bf16_t)((u + 0x7fffu + ((u >> 16) & 1u)) >> 16); }
__device__ __forceinline__ float wave_sum(float v) {
#pragma unroll
    for (int o = 1; o < 64; o <<= 1) v += __shfl_xor(v, o);
    return v;
}
__device__ __forceinline__ float sigmoidf_(float x) { return 1.f / (1.f + expf(-x)); }
__device__ __forceinline__ float siluf_(float x) { return x / (1.f + expf(-x)); }
__device__ __forceinline__ float logsigmoidf_(float x) { return fminf(x, 0.f) - log1pf(expf(-fabsf(x))); }
__device__ __forceinline__ float gelu_tanh(float y) { return 0.5f * y * (1.f + tanhf(0.7978845608028654f * (y + 0.044715f * y * y * y))); }

__global__ void __launch_bounds__(256) k_ada(const float* c, const float* ada_w, const float* ada_b, float* mod) {
    const int n = blockIdx.x * 256 + threadIdx.x, b = blockIdx.y, l = blockIdx.z;
    __shared__ float cs[1024];
    for (int i = threadIdx.x; i < 1024; i += 256) { const float v = c[b * 1024 + i]; cs[i] = siluf_(v); }
    __syncthreads();
    const float* W = ada_w + (size_t)l * 1024 * 6144;
    float acc = ada_b[l * 6144 + n];
    for (int k = 0; k < 1024; ++k) acc += cs[k] * W[(size_t)k * 6144 + n];
    mod[(size_t)(l * 8 + b) * 6144 + n] = acc;
}

__global__ void __launch_bounds__(256) k_prenorm(const float* x, const float* w, const float* modl, int sh_off, int sc_off, bf16_t* H) {
    const int wave = threadIdx.x >> 6, lane = threadIdx.x & 63;
    const int row = blockIdx.x * 4 + wave, b = row / T;
    const float4* xr = (const float4*)(x + (size_t)row * D);
    float4 v[4]; float ss = 0.f;
#pragma unroll
    for (int j = 0; j < 4; ++j) { v[j] = xr[lane + 64 * j]; ss += v[j].x * v[j].x + v[j].y * v[j].y + v[j].z * v[j].z + v[j].w * v[j].w; }
    ss = wave_sum(ss);
    const float r = rsqrtf(ss * (1.f / D) + 1e-6f);
    const float* sh = modl + (size_t)b * 6144 + sh_off; const float* sc = modl + (size_t)b * 6144 + sc_off;
#pragma unroll
    for (int j = 0; j < 4; ++j) {
        const int col = (lane + 64 * j) * 4;
        const float xv[4] = {v[j].x, v[j].y, v[j].z, v[j].w};
#pragma unroll
        for (int e = 0; e < 4; ++e) H[(size_t)row * D + col + e] = f2bf(xv[e] * r * w[col + e] * (1.f + sc[col + e]) + sh[col + e]);
    }
}
__global__ void __launch_bounds__(256) k_post(const bf16_t* Y, int ldy, const float* xold, const float* w, const float* modl, int gt_off, float* xnew) {
    const int wave = threadIdx.x >> 6, lane = threadIdx.x & 63;
    const int row = blockIdx.x * 4 + wave, b = row / T;
    float yv[16]; float ss = 0.f;
#pragma unroll
    for (int j = 0; j < 4; ++j)
#pragma unroll
        for (int e = 0; e < 4; ++e) { const int col = (lane + 64 * j) * 4 + e; const float y = bf2f(Y[(size_t)row * ldy + col]); yv[j * 4 + e] = y; ss += y * y; }
    ss = wave_sum(ss);
    const float r = rsqrtf(ss * (1.f / D) + 1e-6f);
    const float* gt = modl + (size_t)b * 6144 + gt_off;
#pragma unroll
    for (int j = 0; j < 4; ++j)
#pragma unroll
        for (int e = 0; e < 4; ++e) { const int col = (lane + 64 * j) * 4 + e; const size_t o = (size_t)row * D + col; xnew[o] = xold[o] + (1.f + gt[col]) * (yv[j * 4 + e] * r * w[col]); }
}

__device__ __forceinline__ void tile_mm(float (&acc)[4][4], const bf16_t* A, int lda, const float* Bm, int ldb, int K, int m0, int n0, int Nmax, float (*As)[68], float (*Bs)[68]) {
    const int tid = threadIdx.x, tx = tid & 15, ty = tid >> 4;
    const int ar = tid >> 2, ac = (tid & 3) * 4, bk = tid >> 4, bc = (tid & 15) * 4;
    for (int k0 = 0; k0 < K; k0 += 16) {
        const ushort4 raw = *(const ushort4*)(A + (size_t)(m0 + ar) * lda + k0 + ac);
        As[ac + 0][ar] = bf2f(raw.x); As[ac + 1][ar] = bf2f(raw.y); As[ac + 2][ar] = bf2f(raw.z); As[ac + 3][ar] = bf2f(raw.w);
#pragma unroll
        for (int i = 0; i < 4; ++i) { const int n = n0 + bc + i; Bs[bk][bc + i] = (n < Nmax) ? Bm[(size_t)(k0 + bk) * ldb + n] : 0.f; }
        __syncthreads();
#pragma unroll
        for (int kk = 0; kk < 16; ++kk) {
            float a[4], b[4];
#pragma unroll
            for (int i = 0; i < 4; ++i) { a[i] = As[kk][ty * 4 + i]; b[i] = Bs[kk][tx * 4 + i]; }
#pragma unroll
            for (int i = 0; i < 4; ++i)
#pragma unroll
                for (int j = 0; j < 4; ++j) acc[i][j] += a[i] * b[j];
        }
        __syncthreads();
    }
}
#define TILE_DECL __shared__ float As[16][68]; __shared__ float Bs[16][68]; const int m0 = blockIdx.y * 64, n0 = blockIdx.x * 64, tx = threadIdx.x & 15, ty = threadIdx.x >> 4;

template <int MODE>
__global__ void __launch_bounds__(256) k_gemm(const bf16_t* A, int lda, const float* Bm, int ldb, int K, int N, void* C, int ldc, const float* bias) {
    TILE_DECL
    float acc[4][4] = {};
    tile_mm(acc, A, lda, Bm, ldb, K, m0, n0, N, As, Bs);
#pragma unroll
    for (int i = 0; i < 4; ++i)
#pragma unroll
        for (int j = 0; j < 4; ++j) {
            const int m = m0 + ty * 4 + i, n = n0 + tx * 4 + j;
            if (n < N) {
                if (MODE == 0) ((bf16_t*)C)[(size_t)m * ldc + n] = f2bf(acc[i][j]);
                else if (MODE == 1) ((float*)C)[(size_t)m * ldc + n] = acc[i][j];
                else { const float a = bf2f(A[(size_t)m * lda + n]); ((bf16_t*)C)[(size_t)m * ldc + n] = f2bf(a * sigmoidf_(acc[i][j] + bias[n])); }
            }
        }
}
__global__ void __launch_bounds__(256) k_merge(const bf16_t* A0, int lda0, const bf16_t* A1, int lda1, const bf16_t* A2, int lda2,
                                               const float* P0, const float* P1, const float* P2, const bf16_t* Zg, int ldz, const float* bgb, bf16_t* C, int ldc) {
    TILE_DECL
    float tot[4][4] = {};
#pragma unroll 1
    for (int br = 0; br < 3; ++br) {
        float acc[4][4] = {};
        const bf16_t* A = br == 0 ? A0 : (br == 1 ? A1 : A2); const int lda = br == 0 ? lda0 : (br == 1 ? lda1 : lda2);
        const float* P = br == 0 ? P0 : (br == 1 ? P1 : P2);
        tile_mm(acc, A, lda, P, 1024, 512, m0, n0, 1024, As, Bs);
#pragma unroll
        for (int i = 0; i < 4; ++i)
#pragma unroll
            for (int j = 0; j < 4; ++j) {
                const int m = m0 + ty * 4 + i, n = n0 + tx * 4 + j;
                const float g = sigmoidf_(bf2f(Zg[(size_t)m * ldz + br * 1024 + n]) + bgb[br * 1024 + n]);
                tot[i][j] += g * acc[i][j];
            }
    }
#pragma unroll
    for (int i = 0; i < 4; ++i)
#pragma unroll
        for (int j = 0; j < 4; ++j) C[(size_t)(m0 + ty * 4 + i) * ldc + n0 + tx * 4 + j] = f2bf(tot[i][j]);
}
__global__ void __launch_bounds__(256) k_ffn1(const bf16_t* A, const float* W, bf16_t* C) {
    TILE_DECL
    float ag[4][4] = {}, au[4][4] = {};
    tile_mm(ag, A, D, W, 2 * FF, D, m0, n0, FF, As, Bs);
    tile_mm(au, A, D, W + FF, 2 * FF, D, m0, n0, FF, As, Bs);
#pragma unroll
    for (int i = 0; i < 4; ++i)
#pragma unroll
        for (int j = 0; j < 4; ++j) C[(size_t)(m0 + ty * 4 + i) * FF + n0 + tx * 4 + j] = f2bf(siluf_(ag[i][j]) * au[i][j]);
}

__global__ void __launch_bounds__(256) k_gla(const bf16_t* Z, const float* ZS, const float* a2, const float* ab, const float* nw, bf16_t* YA) {
    const int b = blockIdx.x >> 2, h = blockIdx.x & 3, tid = threadIdx.x, j = tid & 127, half = tid >> 7;
    __shared__ float q[64], k[64], eg[64], v[128], part[2][128], red[2];
    float S[32];
#pragma unroll
    for (int i = 0; i < 32; ++i) S[i] = 0.f;
    float a2c[16]; float abd = 0.f;
#pragma unroll
    for (int r = 0; r < 16; ++r) a2c[r] = (tid < 64) ? a2[r * 256 + h * 64 + tid] : 0.f;
    if (tid < 64) abd = ab[h * 64 + tid];
    const float nwj = nw[h * 128 + j];
    for (int t = 0; t < T; ++t) {
        const size_t m = (size_t)b * T + t;
        const bf16_t* zr = Z + m * ZLD;
        if (tid < 64) {
            const float* zs = ZS + m * 32;
            float xg = abd;
#pragma unroll
            for (int r = 0; r < 16; ++r) xg += zs[r] * a2c[r];
            eg[tid] = expf(logsigmoidf_(xg) * (1.f / 16.f));
            q[tid] = bf2f(zr[GQ + h * 64 + tid]) * 0.125f;
            k[tid] = bf2f(zr[GK + h * 64 + tid]);
        } else if (tid >= 128) {
            v[j] = bf2f(zr[GV + h * 128 + j]);
        }
        __syncthreads();
        const float vj = v[j]; float op = 0.f;
#pragma unroll
        for (int dd = 0; dd < 32; ++dd) { const int d = half * 32 + dd; S[dd] = eg[d] * S[dd] + k[d] * vj; op += q[d] * S[dd]; }
        part[half][j] = op;
        __syncthreads();
        if (tid < 128) {
            const float o = part[0][j] + part[1][j];
            const float ss = wave_sum(o * o);
            if ((tid & 63) == 0) red[tid >> 6] = ss;
        }
        __syncthreads();
        if (tid < 128) {
            const float o = part[0][j] + part[1][j];
            const float r = rsqrtf((red[0] + red[1]) * (1.f / 128.f) + 1e-6f);
            const float gr = bf2f(zr[GR + h * 128 + j]);
            YA[m * 1024 + h * 128 + j] = f2bf(o * r * nwj * siluf_(gr));
        }
        __syncthreads();
    }
}

__global__ void __launch_bounds__(256) k_mlstm(const bf16_t* Z, const float* ZS, const float* cw, const float* cb, const float* ib, const float* fb, bf16_t* YA) {
    const int b = blockIdx.x >> 2, h = blockIdx.x & 3, tid = threadIdx.x, j = tid & 127, half = tid >> 7;
    __shared__ float q[64], k[64], v[128], part[2][128], dens;
    float C[32];
#pragma unroll
    for (int i = 0; i < 32; ++i) C[i] = 0.f;
    float nreg = 0.f, mrun = 0.f;
    float w4[4] = {0.f, 0.f, 0.f, 0.f}, wb = 0.f; int zcol = 0;
    if (tid < 128) {
        const int c = (tid < 64) ? (h * 64 + tid) : (256 + h * 64 + (tid - 64));
        for (int jj = 0; jj < 4; ++jj) w4[jj] = cw[jj * 512 + c];
        wb = cb[c];
        zcol = (tid < 64) ? (MQ + h * 64 + tid) : (MK + h * 64 + (tid - 64));
    }
    const float ibh = ib[h], fbh = fb[h];
    for (int t = 0; t < T; ++t) {
        const size_t m = (size_t)b * T + t;
        const bf16_t* zr = Z + m * ZLD;
        if (tid < 128) {
            float acc = wb;
#pragma unroll
            for (int jj = 0; jj < 4; ++jj) { const int tt = t - 3 + jj; if (tt >= 0) acc += w4[jj] * bf2f(Z[((size_t)b * T + tt) * ZLD + zcol]); }
            const float s = siluf_(acc);
            if (tid < 64) q[tid] = s; else k[tid - 64] = s * 0.125f;
        } else {
            v[j] = bf2f(zr[MV + h * 128 + j]);
        }
        const float ip = ZS[m * 32 + 16 + h] + ibh, fp = ZS[m * 32 + 20 + h] + fbh;
        const float lf = logsigmoidf_(fp);
        const float mnew = fmaxf(lf + mrun, ip);
        const float fdec = expf(lf + mrun - mnew), iw = expf(ip - mnew);
        __syncthreads();
        const float vj = v[j]; float np = 0.f;
#pragma unroll
        for (int dd = 0; dd < 32; ++dd) { const int d = half * 32 + dd; C[dd] = fdec * C[dd] + iw * k[d] * vj; np += q[d] * C[dd]; }
        part[half][j] = np;
        if (tid < 64) { nreg = fdec * nreg + iw * k[tid]; const float dp = wave_sum(q[tid] * nreg); if (tid == 0) dens = dp; }
        __syncthreads();
        if (tid < 128) {
            const float num = part[0][j] + part[1][j];
            const float hh = num / fmaxf(fabsf(dens), expf(-mnew));
            const float mo = bf2f(zr[MO + h * 128 + j]);
            YA[m * 1024 + 512 + h * 128 + j] = f2bf(sigmoidf_(mo) * hh);
        }
        mrun = mnew;
        __syncthreads();
    }
}

__global__ void __launch_bounds__(64) k_s5(bf16_t* Z, const float* lam_re, const float* lam_im, const float* log_step, const float* b_re, const float* b_im,
                                            const float* c_re, const float* c_im, const float* dsk) {
    const int b = blockIdx.x >> 5, g = blockIdx.x & 31, p = threadIdx.x;
    __shared__ float us[64][17], xr[64][65], xi[64][65], cr[16][64], ci[16][64];
    const float lre = fminf(lam_re[g * 64 + p], -1e-4f), lim = lam_im[g * 64 + p], dt = expf(log_step[g]);
    const float mag = expf(lre * dt), ar = mag * cosf(lim * dt), ai = mag * sinf(lim * dt);
    const float inv = 1.f / (lre * lre + lim * lim);
    const float zr_ = ((ar - 1.f) * lre + ai * lim) * inv, zi_ = (ai * lre - (ar - 1.f) * lim) * inv;
    float bbr[16], bbi[16], dk[16];
#pragma unroll
    for (int c = 0; c < 16; ++c) {
        const float br = b_re[(size_t)(g * 64 + p) * 16 + c], bi = b_im[(size_t)(g * 64 + p) * 16 + c];
        bbr[c] = zr_ * br - zi_ * bi; bbi[c] = zr_ * bi + zi_ * br;
        cr[c][p] = c_re[(size_t)(g * 16 + c) * 64 + p]; ci[c][p] = c_im[(size_t)(g * 16 + c) * 64 + p];
        dk[c] = dsk[g * 16 + c];
    }
    float xre = 0.f, xim = 0.f;
    for (int ch = 0; ch < T / 64; ++ch) {
        const size_t m0 = (size_t)b * T + ch * 64;
        bf16_t* zp = Z + (m0 + p) * ZLD + SU + g * 16;
#pragma unroll
        for (int c = 0; c < 16; ++c) us[p][c] = bf2f(zp[c]);
        __syncthreads();
        for (int t = 0; t < 64; ++t) {
            float bur = 0.f, bui = 0.f;
#pragma unroll
            for (int c = 0; c < 16; ++c) { const float u = us[t][c]; bur += bbr[c] * u; bui += bbi[c] * u; }
            const float nr = ar * xre - ai * xim + bur, ni = ar * xim + ai * xre + bui;
            xre = nr; xim = ni; xr[t][p] = nr; xi[t][p] = ni;
        }
        __syncthreads();
#pragma unroll 1
        for (int c = 0; c < 16; ++c) {
            float y = 0.f;
            for (int pp = 0; pp < 64; ++pp) y += cr[c][pp] * xr[p][pp] - ci[c][pp] * xi[p][pp];
            y += dk[c] * us[p][c];
            zp[c] = f2bf(gelu_tanh(y));
        }
        __syncthreads();
    }
}

extern "C" void kernel_launch(void* const* d_in, const int* in_sizes, int n_in, void* d_out, int out_size, void* d_ws, size_t ws_size, hipStream_t stream) {
    if (n_in != 33 || ws_size < WS_END || out_size != M * D) { fprintf(stderr, "kernel_launch: unexpected n_in %d / ws %zu / out %d\n", n_in, ws_size, out_size); return; }
    const float* x_in = (const float*)d_in[0];
    auto F = [&](int i) { return (const float*)d_in[i]; };
    unsigned char* ws = (unsigned char*)d_ws;
    float* mod = (float*)(ws + WS_MOD);
    float* ZS = (float*)(ws + WS_ZS);
    bf16_t* H = (bf16_t*)(ws + WS_H);
    bf16_t* Z = (bf16_t*)(ws + WS_Z);
    float* out = (float*)d_out;

    k_ada<<<dim3(6144 / 256, 8, 2), 256, 0, stream>>>(F(1), F(2), F(3), mod);
    for (int l = 0; l < DEPTH; ++l) {
        const float* modl = mod + (size_t)l * 8 * 6144;
        const float* xsrc = (l == 0) ? x_in : out;
        const float* w_in = F(8) + (size_t)l * D * INDIM;
        k_prenorm<<<M / 4, 256, 0, stream>>>(xsrc, F(4) + l * D, modl, 0, 1024, H);
        const int seg[4][3] = {{0, 0, 1024}, {1024, 1040, 512}, {1536, 1552, 1024}, {2560, 2584, 4096}};
        for (int s = 0; s < 4; ++s)
            k_gemm<0><<<dim3(seg[s][2] / 64, M / 64), 256, 0, stream>>>(H, D, w_in + seg[s][1], INDIM, D, seg[s][2], Z + seg[s][0], ZLD, nullptr);
        k_gemm<1><<<dim3(1, M / 64), 256, 0, stream>>>(H, D, w_in + 1024, INDIM, D, 16, ZS, 32, nullptr);
        k_gemm<1><<<dim3(1, M / 64), 256, 0, stream>>>(H, D, w_in + 2576, INDIM, D, 8, ZS + 16, 32, nullptr);
        bf16_t* YA = H;
        k_gla<<<32, 256, 0, stream>>>(Z, ZS, F(9) + l * 16 * 256, F(10) + l * 256, F(11) + l * 512, YA);
        k_mlstm<<<32, 256, 0, stream>>>(Z, ZS, F(12) + l * 4 * 512, F(13) + l * 512, F(14) + l * 4, F(15) + l * 4, YA);
        k_s5<<<256, 64, 0, stream>>>(Z, F(16) + l * 2048, F(17) + l * 2048, F(18) + l * 32, F(19) + (size_t)l * 32768, F(20) + (size_t)l * 32768,
                                     F(21) + (size_t)l * 32768, F(22) + (size_t)l * 32768, F(23) + l * 512);
        k_gemm<2><<<dim3(512 / 64, M / 64), 256, 0, stream>>>(Z + SU, ZLD, F(24) + (size_t)l * 512 * 512, 512, 512, 512, Z + YS2, ZLD, F(25) + l * 512);
        k_merge<<<dim3(1024 / 64, M / 64), 256, 0, stream>>>(YA, 1024, YA + 512, 1024, Z + YS2, ZLD, F(26) + (size_t)l * 512 * 1024, F(27) + (size_t)l * 512 * 1024,
                                                              F(28) + (size_t)l * 512 * 1024, Z + ZG, ZLD, F(29) + l * 3072, Z + MRG, ZLD);
        k_gemm<0><<<dim3(1024 / 64, M / 64), 256, 0, stream>>>(Z + MRG, ZLD, F(30) + (size_t)l * D * D, D, D, D, Z + YO, ZLD, nullptr);
        k_post<<<M / 4, 256, 0, stream>>>(Z + YO, ZLD, xsrc, F(5) + l * D, modl, 2048, out);
        k_prenorm<<<M / 4, 256, 0, stream>>>(out, F(6) + l * D, modl, 3072, 4096, H);
        bf16_t* HID = Z;
        k_ffn1<<<dim3(FF / 64, M / 64), 256, 0, stream>>>(H, F(31) + (size_t)l * D * 2 * FF, HID);
        bf16_t* Y2 = H;
        k_gemm<0><<<dim3(1024 / 64, M / 64), 256, 0, stream>>>(HID, FF, F(32) + (size_t)l * FF * D, D, FF, D, Y2, D, nullptr);
        k_post<<<M / 4, 256, 0, stream>>>(Y2, D, out, F(7) + l * D, modl, 5120, out);
    }
}
```

```cpp
#include <hip/hip_runtime.h>
#include <cstdint>
#include <cstdio>

#define LAS __attribute__((address_space(3)))
#define GAS __attribute__((address_space(1)))
typedef unsigned short bf16_t;
typedef short bf16x8 __attribute__((ext_vector_type(8)));
typedef float f32x4 __attribute__((ext_vector_type(4)));
typedef float f32x2 __attribute__((ext_vector_type(2)));
typedef unsigned u32x4 __attribute__((ext_vector_type(4)));
typedef unsigned u32x2 __attribute__((ext_vector_type(2)));

constexpr int NB = 8, T = 4096, D = 1024, M = NB * T, DEPTH = 2;
constexpr int INDIM = 6680, ZLD = 6656, FF = 2816;
constexpr int GQ = 0, GK = 256, GV = 512, GR = 1024, MQ = 1536, MK = 1792, MV = 2048, MO = 2560, SU = 3072, ZG = 3584;
constexpr int YGLA = GR;
constexpr int YML = MO;
constexpr int YS2 = 0;
constexpr int MRG = 1536;
constexpr size_t MiB = 1u << 20;
constexpr size_t WS_CTL = 0, CTL_ZERO_BYTES = 64 * 1024;
constexpr size_t WS_MOD = 512 * 1024;
constexpr size_t WS_ZS = 1 * MiB;
constexpr size_t WS_WIN = 5 * MiB;
constexpr size_t WS_WGLU = 18 * MiB;
constexpr size_t WS_WPROJ = 18 * MiB + 512 * 1024;
constexpr size_t WS_WOUT = 21 * MiB + 512 * 1024;
constexpr size_t WS_WFO = 23 * MiB + 512 * 1024;
constexpr size_t WS_H = 32 * MiB;
constexpr size_t WS_Z = 96 * MiB;
constexpr size_t WS_END = 512 * MiB;
constexpr int CW_BAR = 4096;

constexpr int RING_BYTES = 131072, LDSCTL_OFF = RING_BYTES, MISC_OFF = LDSCTL_OFF + 320, LDS_BYTES = 147456;
constexpr int NWAVES = 8;

__device__ __forceinline__ float bf2f(bf16_t v) { return __uint_as_float(((unsigned)v) << 16); }
__device__ __forceinline__ unsigned f2bf(float f) { unsigned u = __float_as_uint(f); return (u + 0x7fffu + ((u >> 16) & 1u)) >> 16; }
__device__ __forceinline__ unsigned pk2(float lo, float hi) { return f2bf(lo) | (f2bf(hi) << 16); }
__device__ __forceinline__ float bflo(unsigned u) { return __uint_as_float(u << 16); }
__device__ __forceinline__ float bfhi(unsigned u) { return __uint_as_float(u & 0xffff0000u); }
__device__ __forceinline__ float wave_sum(float v) {
#pragma unroll
    for (int o = 1; o < 64; o <<= 1) v += __shfl_xor(v, o);
    return v;
}
__device__ __forceinline__ float sigmoidf_(float x) { return 1.f / (1.f + expf(-x)); }
__device__ __forceinline__ float siluf_(float x) { return x / (1.f + expf(-x)); }
__device__ __forceinline__ float logsigmoidf_(float x) { return fminf(x, 0.f) - log1pf(expf(-fabsf(x))); }
__device__ __forceinline__ float gelu_tanh(float y) { return 0.5f * y * (1.f + tanhf(0.7978845608028654f * (y + 0.044715f * y * y * y))); }
__device__ __forceinline__ float fexp_neg(float x) { return __builtin_amdgcn_exp2f(-1.4426950408889634f * x); }
__device__ __forceinline__ float fsigmoid(float x) { return __builtin_amdgcn_rcpf(1.f + fexp_neg(x)); }
#define LDS_WAIT() asm volatile("s_waitcnt lgkmcnt(0)" ::: "memory")
#define VM_WAIT() asm volatile("s_waitcnt vmcnt(0)" ::: "memory")

namespace pg8 {
constexpr int BM = 256, BK = 64, HALF = 128, HTB = HALF * BK * 2, STAGE_BYTES = 8 * HTB, NXCD = 8, WGM = 8;
__host__ __device__ __forceinline__ int lds_byte(int r, int c) { const int st = (r >> 4) * 2 + (c >> 5), rr = r & 15, cc = c & 31, ob = rr * 64 + cc * 2; return st * 1024 + (ob ^ (((ob >> 9) & 1) << 5)); }
__host__ __device__ __forceinline__ void stage_rc(int b, int& R, int& C) { const int st = b / 1024, sb = b % 1024, swz = sb ^ (((sb >> 9) & 1) << 5); R = (st >> 1) * 16 + swz / 64; C = (st & 1) * 32 + (swz % 64) / 2; }
__host__ __device__ __forceinline__ int perm32(int rho) { const int n = rho >> 4, i = rho & 15; return 8 * (i >> 2) + 4 * n + (i & 3); }

struct Unit { int pm, pn, br; };
struct TileOrder {
    int nM, nN, nwg, G, c;
    __device__ void init(int M_, int N_, int G_, int c_) { nM = M_ / BM; nN = N_ / BM; nwg = nM * nN; G = G_; c = c_; }
    __device__ bool tile(int i, int& pm, int& pn) const {
        const long L = (long)i * G + c; if (L >= nwg) return false;
        int wgid = (int)L; { const int q = nwg / NXCD, r = nwg % NXCD, xcd = wgid % NXCD, off = wgid / NXCD; wgid = (xcd < r ? xcd * (q + 1) : r * (q + 1) + (xcd - r) * q) + off; }
        const int nig = WGM * nN, gid = wgid / nig, fm = gid * WGM, gsz = (nM - fm) < WGM ? (nM - fm) : WGM;
        pm = fm + ((wgid % nig) % gsz); pn = (wgid % nig) / gsz; return true;
    }
};
struct PlainSched {
    TileOrder o; const bf16_t* A; int lda; const bf16_t* Bt; int K;
    __device__ bool next(int i, Unit& u) const { u.br = 0; return o.tile(i, u.pm, u.pn); }
    __device__ const char* Ap(const Unit& u) const { return (const char*)(A + (size_t)u.pm * BM * lda); }
    __device__ const char* Bp(const Unit& u) const { return (const char*)(Bt + (size_t)u.pn * BM * K); }
};
struct MergeSched {
    TileOrder o; const bf16_t* Zb; const bf16_t* Wp;
    __device__ bool next(int i, Unit& u) const { u.br = i % 3; return o.tile(i / 3, u.pm, u.pn); }
    __device__ const char* Ap(const Unit& u) const { const int col = u.br == 0 ? YGLA : (u.br == 1 ? YML : YS2); return (const char*)(Zb + (size_t)u.pm * BM * ZLD + col); }
    __device__ const char* Bp(const Unit& u) const { return (const char*)(Wp + (size_t)u.br * 1024 * 512 + (size_t)u.pn * BM * 512); }
};

__device__ __forceinline__ unsigned cvt_pk_bf16(float lo, float hi) { unsigned r; asm volatile("v_cvt_pk_bf16_f32 %0, %1, %2" : "=v"(r) : "v"(lo), "v"(hi)); return r; }

struct EpiStore {
    static constexpr bool PERM = true;
    bf16_t* O; int ldc;
    __device__ __forceinline__ bool keep(const Unit&) const { return false; }
    __device__ __forceinline__ void operator()(f32x4 (&acc)[2][2][4][2], const Unit& u, int wr, int wc, int fr, int fq) const {
        const int row0 = u.pm * BM + wr * 64 + fr, col0 = u.pn * BM + wc * 32 + 8 * fq;
#pragma unroll
        for (int ai = 0; ai < 2; ++ai)
#pragma unroll
            for (int m = 0; m < 4; ++m) { bf16_t* rowp = O + (size_t)(row0 + ai * HALF + m * 16) * ldc + col0;
#pragma unroll
                for (int bj = 0; bj < 2; ++bj) { const f32x4 v0 = acc[ai][bj][m][0], v1 = acc[ai][bj][m][1];
                    u32x4 w; w.x = cvt_pk_bf16(v0[0], v0[1]); w.y = cvt_pk_bf16(v0[2], v0[3]); w.z = cvt_pk_bf16(v1[0], v1[1]); w.w = cvt_pk_bf16(v1[2], v1[3]);
                    *(u32x4*)(rowp + bj * HALF) = w; } }
    }
};
struct EpiGlu {
    static constexpr bool PERM = true;
    bf16_t* O; int ldc; const bf16_t* Asrc; int lda; const float* bias;
    __device__ __forceinline__ bool keep(const Unit&) const { return false; }
    __device__ __forceinline__ void operator()(f32x4 (&acc)[2][2][4][2], const Unit& u, int wr, int wc, int fr, int fq) const {
        const int row0 = u.pm * BM + wr * 64 + fr, col0 = u.pn * BM + wc * 32 + 8 * fq;
        f32x4 bv[2][2];
#pragma unroll
        for (int bj = 0; bj < 2; ++bj)
#pragma unroll
            for (int n = 0; n < 2; ++n) bv[bj][n] = *(const f32x4*)(bias + col0 + bj * HALF + 4 * n);
#pragma unroll
        for (int ai = 0; ai < 2; ++ai)
#pragma unroll
            for (int m = 0; m < 4; ++m) { const size_t r = (size_t)(row0 + ai * HALF + m * 16);
#pragma unroll
                for (int bj = 0; bj < 2; ++bj) {
                    const u32x4 a = *(const u32x4*)(Asrc + r * lda + col0 + bj * HALF);
                    const f32x4 v0 = acc[ai][bj][m][0] + bv[bj][0], v1 = acc[ai][bj][m][1] + bv[bj][1];
                    u32x4 w;
                    w.x = cvt_pk_bf16(bflo(a.x) * fsigmoid(v0[0]), bfhi(a.x) * fsigmoid(v0[1])); w.y = cvt_pk_bf16(bflo(a.y) * fsigmoid(v0[2]), bfhi(a.y) * fsigmoid(v0[3]));
                    w.z = cvt_pk_bf16(bflo(a.z) * fsigmoid(v1[0]), bfhi(a.z) * fsigmoid(v1[1])); w.w = cvt_pk_bf16(bflo(a.w) * fsigmoid(v1[2]), bfhi(a.w) * fsigmoid(v1[3]));
                    *(u32x4*)(O + r * ldc + col0 + bj * HALF) = w; } }
    }
};
struct EpiSwiGlu {
    static constexpr bool PERM = true;
    bf16_t* O; int ldc;
    __device__ __forceinline__ bool keep(const Unit&) const { return false; }
    __device__ __forceinline__ void operator()(f32x4 (&acc)[2][2][4][2], const Unit& u, int wr, int wc, int fr, int fq) const {
        const int row0 = u.pm * BM + wr * 64 + fr, col0 = u.pn * HALF + wc * 32 + 8 * fq;
#pragma unroll
        for (int ai = 0; ai < 2; ++ai)
#pragma unroll
            for (int m = 0; m < 4; ++m) {
                float o[8];
#pragma unroll
                for (int n = 0; n < 2; ++n)
#pragma unroll
                    for (int e = 0; e < 4; ++e) { const float g = acc[ai][0][m][n][e], up = acc[ai][1][m][n][e]; o[n * 4 + e] = g * fsigmoid(g) * up; }
                u32x4 w; w.x = cvt_pk_bf16(o[0], o[1]); w.y = cvt_pk_bf16(o[2], o[3]); w.z = cvt_pk_bf16(o[4], o[5]); w.w = cvt_pk_bf16(o[6], o[7]);
                *(u32x4*)(O + (size_t)(row0 + ai * HALF + m * 16) * ldc + col0) = w; }
    }
};
struct EpiMerge {
    static constexpr bool PERM = true;
    bf16_t* O; int ldc; const bf16_t* Zg; int ldz; const float* bgb;
    __device__ __forceinline__ bool keep(const Unit& u) const { return u.br < 2; }
    __device__ __forceinline__ float e_of(float x) const { return fminf(fexp_neg(x), 1e30f); }
    __device__ __forceinline__ void operator()(f32x4 (&acc)[2][2][4][2], const Unit& u, int wr, int wc, int fr, int fq) const {
        const int row0 = u.pm * BM + wr * 64 + fr, col0 = u.pn * BM + wc * 32 + 8 * fq;
        const int br = u.br, brn = br < 2 ? br + 1 : 2;
#pragma unroll
        for (int bj = 0; bj < 2; ++bj) {
            float ba[8], bb[8];
#pragma unroll
            for (int e = 0; e < 8; ++e) { ba[e] = bgb[br * 1024 + col0 + bj * HALF + e]; bb[e] = bgb[brn * 1024 + col0 + bj * HALF + e]; }
#pragma unroll
            for (int ai = 0; ai < 2; ++ai)
#pragma unroll
                for (int m = 0; m < 4; ++m) { const size_t r = (size_t)(row0 + ai * HALF + m * 16);
                    const u32x4 za = *(const u32x4*)(Zg + r * ldz + br * 1024 + col0 + bj * HALF);
                    const u32x4 zb = *(const u32x4*)(Zg + r * ldz + brn * 1024 + col0 + bj * HALF);
                    const float xa[8] = {bflo(za.x), bfhi(za.x), bflo(za.y), bfhi(za.y), bflo(za.z), bfhi(za.z), bflo(za.w), bfhi(za.w)};
                    const float xb[8] = {bflo(zb.x), bfhi(zb.x), bflo(zb.y), bfhi(zb.y), bflo(zb.z), bfhi(zb.z), bflo(zb.w), bfhi(zb.w)};
                    float f[8];
#pragma unroll
                    for (int e = 0; e < 8; ++e) { const float ga = __builtin_amdgcn_rcpf(1.f + e_of(xa[e] + ba[e]));
                        f[e] = br < 2 ? ga * (1.f + e_of(xb[e] + bb[e])) : ga; }
                    f32x4 v0 = acc[ai][bj][m][0], v1 = acc[ai][bj][m][1];
                    v0[0] *= f[0]; v0[1] *= f[1]; v0[2] *= f[2]; v0[3] *= f[3]; v1[0] *= f[4]; v1[1] *= f[5]; v1[2] *= f[6]; v1[3] *= f[7];
                    if (br < 2) { acc[ai][bj][m][0] = v0; acc[ai][bj][m][1] = v1; }
                    else { u32x4 w; w.x = cvt_pk_bf16(v0[0], v0[1]); w.y = cvt_pk_bf16(v0[2], v0[3]); w.z = cvt_pk_bf16(v1[0], v1[1]); w.w = cvt_pk_bf16(v1[2], v1[3]);
                        *(u32x4*)(O + r * ldc + col0 + bj * HALF) = w; } }
        }
    }
};

template <class Epi, class Sched, bool ALIGN_EPI, bool SP2>
__device__ __forceinline__ void gemm_phase(LAS unsigned char* lds, const int lda, const int K, const Sched& S, const Epi& E) {
    int tid_ = threadIdx.x; asm volatile("" : "+v"(tid_));
    const int tid = tid_, wid = __builtin_amdgcn_readfirstlane(tid >> 6), lane = tid & 63, wr = wid >> 2, wc = wid & 3, fr = lane & 15, fq = lane >> 4;
    const int nt = K / BK;
    unsigned voffA[2], voffB[2];
#pragma unroll
    for (int i = 0; i < 2; ++i) { int R, C; stage_rc(tid * 16 + i * 8192, R, C); const int Rb = Epi::PERM ? ((R & ~31) + perm32(R & 31)) : R;
        voffA[i] = (unsigned)(R * lda + C) * 2u; voffB[i] = (unsigned)(Rb * K + C) * 2u; }
    const size_t kstep = (size_t)(BK * 2);
    const size_t hA = (size_t)HALF * lda * 2, hB = (size_t)HALF * K * 2;
    const unsigned ldsw = (unsigned)wid * 1024u;
    const int aoff = lds_byte(wr * 64 + fr, fq * 8), boff = lds_byte(wc * 32 + fr, fq * 8);
#define PG8_SA(b, h) (((b) * 2 + (h)) * HTB)
#define PG8_SB(b, h) ((4 + (b) * 2 + (h)) * HTB)
#define PG8_STAGE(bufoff, gbase, voff) do { _Pragma("unroll") for (int _i = 0; _i < 2; ++_i) \
        __builtin_amdgcn_global_load_lds((const unsigned*)((const char*)(gbase) + (voff)[_i]), (LAS unsigned*)(lds + (bufoff) + ldsw + _i * 8192), 16, 0, 0); } while (0)
#define PG8_LDA(dst, b, h) do { _Pragma("unroll") for (int m = 0; m < 4; ++m) _Pragma("unroll") for (int k = 0; k < 2; ++k) dst[m][k] = *(const LAS bf16x8*)(lds + PG8_SA(b, h) + aoff + m * 2048 + k * 1024); } while (0)
#define PG8_LDB(dst, b, h) do { _Pragma("unroll") for (int n = 0; n < 2; ++n) _Pragma("unroll") for (int k = 0; k < 2; ++k) dst[n][k] = *(const LAS bf16x8*)(lds + PG8_SB(b, h) + boff + n * 2048 + k * 1024); } while (0)
#define PG8_MMA(ai, bj, At, Bt) do { __builtin_amdgcn_s_setprio(1); _Pragma("unroll") for (int m = 0; m < 4; ++m) _Pragma("unroll") for (int n = 0; n < 2; ++n) _Pragma("unroll") for (int k = 0; k < 2; ++k) \
        acc[ai][bj][m][n] = __builtin_amdgcn_mfma_f32_16x16x32_bf16(Bt[n][k], At[m][k], acc[ai][bj][m][n], 0, 0, 0); __builtin_amdgcn_s_setprio(0); } while (0)
#define PG8_WAIT_V(n) asm volatile("s_waitcnt vmcnt(" #n ")" ::: "memory")
#define PG8_WAIT_L(n) asm volatile("s_waitcnt lgkmcnt(" #n ")" ::: "memory")
#define PG8_BAR __builtin_amdgcn_s_barrier()
#define PG8_SCHED __builtin_amdgcn_sched_barrier(0)
    Unit cur, nxt; int ui = 0;
    if (!S.next(0, cur)) return;
    f32x4 acc[2][2][4][2];
#pragma unroll
    for (int a = 0; a < 2; ++a)
#pragma unroll
        for (int b = 0; b < 2; ++b)
#pragma unroll
            for (int m = 0; m < 4; ++m)
#pragma unroll
                for (int n = 0; n < 2; ++n) acc[a][b][m][n] = (f32x4){0.f, 0.f, 0.f, 0.f};
    bf16x8 At[4][2], B0[2][2], B1[2][2];
    const char* cA = S.Ap(cur); const char* cB = S.Bp(cur);
    if constexpr (SP2) {
        PG8_STAGE(PG8_SB(0, 0), cB, voffB); PG8_STAGE(PG8_SB(0, 1), cB + hB, voffB); PG8_STAGE(PG8_SA(0, 0), cA, voffA); PG8_STAGE(PG8_SA(0, 1), cA + hA, voffA);
        if (wr == 1) PG8_BAR;
        PG8_WAIT_V(2); PG8_BAR;
        PG8_STAGE(PG8_SB(1, 0), cB + kstep, voffB); PG8_STAGE(PG8_SA(1, 0), cA + kstep, voffA); PG8_STAGE(PG8_SB(1, 1), cB + hB + kstep, voffB);
        PG8_WAIT_V(6); PG8_BAR;
    } else {
        PG8_STAGE(PG8_SB(0, 0), cB, voffB); PG8_STAGE(PG8_SA(0, 0), cA, voffA); PG8_STAGE(PG8_SB(0, 1), cB + hB, voffB); PG8_STAGE(PG8_SA(0, 1), cA + hA, voffA);
        if (wr == 1) PG8_BAR;
        PG8_WAIT_V(4); PG8_BAR;
        PG8_STAGE(PG8_SB(1, 0), cB + kstep, voffB); PG8_STAGE(PG8_SA(1, 0), cA + kstep, voffA); PG8_STAGE(PG8_SB(1, 1), cB + hB + kstep, voffB);
        PG8_WAIT_V(6); PG8_BAR;
    }
    for (;;) {
        const bool has_next = S.next(ui + 1, nxt);
        const char* nA = has_next ? S.Ap(nxt) : cA; const char* nB = has_next ? S.Bp(nxt) : cB;
        for (int t = 0; t < nt; t += 2) {
            const bool last = (t == nt - 2);
            const char* a1 = cA + (size_t)(t + 1) * kstep;
            const char* a2 = last ? nA : cA + (size_t)(t + 2) * kstep; const char* b2 = last ? nB : cB + (size_t)(t + 2) * kstep;
            const char* a3 = a2 + kstep; const char* b3 = b2 + kstep;
            if constexpr (SP2) {
            PG8_LDB(B0, 0, 0); PG8_LDB(B1, 0, 1); PG8_SCHED; PG8_LDA(At, 0, 0); PG8_STAGE(PG8_SA(1, 1), a1 + hA, voffA);
            PG8_WAIT_V(8); PG8_WAIT_L(0); PG8_BAR; PG8_MMA(0, 0, At, B0); PG8_MMA(0, 1, At, B1); PG8_BAR; PG8_SCHED;
            PG8_LDA(At, 0, 1); PG8_STAGE(PG8_SB(0, 0), b2, voffB); PG8_STAGE(PG8_SB(0, 1), b2 + hB, voffB); PG8_STAGE(PG8_SA(0, 0), a2, voffA);
            PG8_WAIT_V(8); PG8_WAIT_L(0); PG8_BAR; PG8_MMA(1, 0, At, B0); PG8_MMA(1, 1, At, B1); PG8_BAR; PG8_SCHED;
            PG8_LDB(B0, 1, 0); PG8_LDB(B1, 1, 1); PG8_SCHED; PG8_LDA(At, 1, 0); PG8_STAGE(PG8_SA(0, 1), a2 + hA, voffA);
            PG8_WAIT_V(8); PG8_WAIT_L(0); PG8_BAR; PG8_MMA(0, 0, At, B0); PG8_MMA(0, 1, At, B1); PG8_BAR; PG8_SCHED;
            PG8_LDA(At, 1, 1); PG8_STAGE(PG8_SB(1, 0), b3, voffB); PG8_STAGE(PG8_SB(1, 1), b3 + hB, voffB); PG8_STAGE(PG8_SA(1, 0), a3, voffA);
            PG8_WAIT_V(8); PG8_WAIT_L(0); PG8_BAR; PG8_MMA(1, 0, At, B0); PG8_MMA(1, 1, At, B1); PG8_BAR; PG8_SCHED;
            } else {
            PG8_LDB(B0, 0, 0); PG8_SCHED; PG8_LDA(At, 0, 0); PG8_STAGE(PG8_SA(1, 1), a1 + hA, voffA);
            PG8_WAIT_L(8); PG8_BAR; PG8_WAIT_L(0); PG8_MMA(0, 0, At, B0); PG8_BAR; PG8_SCHED;
            PG8_LDB(B1, 0, 1); PG8_STAGE(PG8_SB(0, 0), b2, voffB);
            PG8_BAR; PG8_WAIT_L(0); PG8_MMA(0, 1, At, B1); PG8_BAR;
            PG8_LDA(At, 0, 1); PG8_STAGE(PG8_SA(0, 0), a2, voffA);
            PG8_BAR; PG8_WAIT_L(0); PG8_MMA(1, 0, At, B0); PG8_BAR; PG8_SCHED;
            PG8_STAGE(PG8_SB(0, 1), b2 + hB, voffB);
            PG8_WAIT_V(6); PG8_BAR; PG8_MMA(1, 1, At, B1); PG8_BAR;
            PG8_LDB(B0, 1, 0); PG8_SCHED; PG8_LDA(At, 1, 0); PG8_STAGE(PG8_SA(0, 1), a2 + hA, voffA);
            PG8_WAIT_L(8); PG8_BAR; PG8_WAIT_L(0); PG8_MMA(0, 0, At, B0); PG8_BAR; PG8_SCHED;
            PG8_LDB(B1, 1, 1); PG8_STAGE(PG8_SB(1, 0), b3, voffB);
            PG8_BAR; PG8_WAIT_L(0); PG8_MMA(0, 1, At, B1); PG8_BAR;
            PG8_LDA(At, 1, 1); PG8_STAGE(PG8_SA(1, 0), a3, voffA);
            PG8_BAR; PG8_WAIT_L(0); PG8_MMA(1, 0, At, B0); PG8_BAR; PG8_SCHED;
            PG8_STAGE(PG8_SB(1, 1), b3 + hB, voffB);
            PG8_WAIT_V(6); PG8_BAR; PG8_MMA(1, 1, At, B1); PG8_BAR;
            }
        }
        if constexpr (ALIGN_EPI) { if (wr == 0) PG8_BAR; }
        E(acc, cur, wr, wc, fr, fq);
        if (!has_next) break;
        if (!E.keep(cur)) {
#pragma unroll
        for (int a = 0; a < 2; ++a)
#pragma unroll
            for (int b = 0; b < 2; ++b)
#pragma unroll
                for (int m = 0; m < 4; ++m)
#pragma unroll
                    for (int n = 0; n < 2; ++n) acc[a][b][m][n] = (f32x4){0.f, 0.f, 0.f, 0.f};
        }
        cur = nxt; cA = nA; cB = nB; ++ui;
        if constexpr (ALIGN_EPI) { if (wr == 1) PG8_BAR; }
    }
    PG8_WAIT_V(0);
    if constexpr (!ALIGN_EPI) { if (wr == 0) PG8_BAR; }
    PG8_BAR;
#undef PG8_SA
#undef PG8_SB
#undef PG8_STAGE
#undef PG8_LDA
#undef PG8_LDB
#undef PG8_MMA
#undef PG8_WAIT_V
#undef PG8_WAIT_L
#undef PG8_BAR
#undef PG8_SCHED
}
}

#define XB_TMO      128
#define XB_XCNT(j)  (256  + 64 * (j))
#define XB_XSUB(j)  (1280 + 64 * (j))
#define XB_XGEN(j)  (2304 + 64 * (j))
#define XB_TOP      3328
#define XB_TOPGEN   3392
#define XCD_BAR_WORDS 3456
#define XB_SPIN_CAP (1u << 18)
__device__ __forceinline__ unsigned xb_ld(unsigned* p)              { return __hip_atomic_load(p, __ATOMIC_RELAXED, __HIP_MEMORY_SCOPE_AGENT); }
__device__ __forceinline__ unsigned xb_add(unsigned* p, unsigned v) { return __hip_atomic_fetch_add(p, v, __ATOMIC_RELAXED, __HIP_MEMORY_SCOPE_AGENT); }
__device__ __forceinline__ unsigned xb_xcc_id() { return (unsigned)__builtin_amdgcn_s_getreg((3 << 11) | 20) & 0xFu; }
#define XB_SPIN(cond, bar) do { unsigned _sp = 0; while (cond) { __builtin_amdgcn_s_sleep(1); \
    if ((++_sp & 255u) == 0u) { if (xb_ld(&(bar)[XB_TMO])) break; if (_sp > XB_SPIN_CAP) { atomicAdd(&(bar)[XB_TMO], 1u); break; } } } } while (0)
struct XcdBarrier { unsigned* bar; unsigned x; volatile LAS unsigned* st; };
__device__ __forceinline__ XcdBarrier xcd_barrier_post(unsigned* bar, volatile LAS unsigned* st) {
    XcdBarrier b; b.bar = bar; b.x = xb_xcc_id(); b.st = st;
    if (threadIdx.x == 0) (void)xb_add(&bar[XB_XCNT(b.x)], 1u);
    return b;
}
__device__ __forceinline__ void xcd_barrier_complete(unsigned* bar, unsigned x, unsigned& nloc, unsigned& nx) {
    const unsigned G = gridDim.x * gridDim.y * gridDim.z;
    unsigned sum, cnt, mine, sp = 0u;
    for (;;) {
        sum = 0u; cnt = 0u; mine = 0u;
#pragma unroll
        for (unsigned j = 0; j < 16; ++j) { const unsigned c = xb_ld(&bar[XB_XCNT(j)]); sum += c; cnt += (c > 0u) ? 1u : 0u; mine = (j == x) ? c : mine; }
        if (sum == G) break;
        __builtin_amdgcn_s_sleep(1);
        if ((++sp & 255u) == 0u) { if (xb_ld(&bar[XB_TMO])) break; if (sp > XB_SPIN_CAP) { atomicAdd(&bar[XB_TMO], 1u); break; } }
    }
    nloc = mine > 0u ? mine : 1u; nx = cnt > 0u ? cnt : 1u;
}
__device__ __forceinline__ void xcd_barrier(const XcdBarrier& b) {
    asm volatile("s_waitcnt vmcnt(0)" ::: "memory");
    __syncthreads();
    if (threadIdx.x == 0) {
        unsigned* bar = b.bar;
        __builtin_amdgcn_s_waitcnt(0);
        unsigned nloc = b.st[0], nx = b.st[1];
        if (nloc == 0u) { xcd_barrier_complete(bar, b.x, nloc, nx); b.st[0] = nloc; b.st[1] = nx; }
        const unsigned old = xb_add(&bar[XB_XSUB(b.x)], 1u);
        const unsigned gen = old / nloc;
        if (old + 1u == (gen + 1u) * nloc) {
            __builtin_amdgcn_fence(__ATOMIC_RELEASE, "agent");
            asm volatile("s_waitcnt vmcnt(0)" ::: "memory");
            const unsigned og = xb_add(&bar[XB_TOP], 1u);
            const unsigned tg = og / nx;
            if (og + 1u == (tg + 1u) * nx) xb_add(&bar[XB_TOPGEN], 1u);
            else XB_SPIN(xb_ld(&bar[XB_TOPGEN]) == tg, bar);
            __builtin_amdgcn_fence(__ATOMIC_ACQUIRE, "agent");
            xb_add(&bar[XB_XGEN(b.x)], 1u);
            asm volatile("s_waitcnt vmcnt(0)" ::: "memory");
        } else {
            XB_SPIN(xb_ld(&bar[XB_XGEN(b.x)]) == gen, bar);
            __builtin_amdgcn_fence(__ATOMIC_ACQUIRE, "agent");
            asm volatile("s_waitcnt vmcnt(0)" ::: "memory");
        }
    }
    __syncthreads();
}

struct Args { const float* in[33]; float* out; unsigned char* ws; };
__device__ __forceinline__ const float* inp(int i) {
    unsigned off = (unsigned)i * 8u; asm volatile("" : "+s"(off));
    typedef const float* cfp;
    return *(const __attribute__((address_space(4))) cfp*)((const __attribute__((address_space(4))) char*)__builtin_amdgcn_kernarg_segment_ptr() + off);
}

#define WSP(off) (inp_ws() + (off))
__device__ __forceinline__ unsigned char* inp_ws() { return (unsigned char*)inp(34); }
__device__ __forceinline__ float* inp_out() { return (float*)inp(33); }

__device__ __forceinline__ void transpose_item(const float* W, int ldw, int K, bf16_t* WT, int src_n0, int dst_n0, int k0, LAS float* scr, int lane) {
#pragma unroll 8
    for (int i = 0; i < 32; ++i) { const int kk = 2 * i + (lane >> 5); scr[kk * 33 + (lane & 31)] = W[(size_t)(k0 + kk) * ldw + src_n0 + (lane & 31)]; }
    LDS_WAIT(); asm volatile("" ::: "memory");
    const int c = lane & 7;
#pragma unroll
    for (int j = 0; j < 4; ++j) { const int n = (lane >> 3) + 8 * j; const LAS float* s = scr + (8 * c) * 33 + n;
        u32x4 o; o.x = pk2(s[0 * 33], s[1 * 33]); o.y = pk2(s[2 * 33], s[3 * 33]); o.z = pk2(s[4 * 33], s[5 * 33]); o.w = pk2(s[6 * 33], s[7 * 33]);
        *(u32x4*)(WT + (size_t)(dst_n0 + n) * K + k0 + 8 * c) = o; }
    LDS_WAIT(); asm volatile("" ::: "memory");
}
template <int MAP>
__device__ __forceinline__ void convert_matrix(const float* W, int ldw, int K, int Ndst, bf16_t* WT, LAS float* scr, int lane, int gw, int NGW, int& base) {
    const int nblk = Ndst / 32, nitems = (K / 64) * nblk;
    int first = (gw - base % NGW + NGW) % NGW;
    for (int it = first; it < nitems; it += NGW) {
        const int kb = it / nblk, nb = it % nblk, d0 = nb * 32;
        int s0 = d0;
        if (MAP == 1) s0 = d0 + (d0 < 1024 ? 0 : (d0 < 2560 ? 16 : 24));
        if (MAP == 2) { const int pn = d0 >> 8, hh = (d0 & 255) >> 7, r = d0 & 127; s0 = hh * FF + pn * 128 + r; }
        transpose_item(W, ldw, K, WT, s0, d0, kb * 64, scr, lane);
    }
    base += nitems;
}

__device__ __forceinline__ void ada_phase(LAS unsigned char* lds, int blk, int wave, int lane) {
    if (blk >= 192) return;
    const int l = blk / 96, n0 = (blk % 96) * 64;
    const float* c = inp(1); const float* W = inp(2) + (size_t)l * 1024 * 6144; const float* bias = inp(3) + l * 6144;
    LAS float* part = (LAS float*)lds;
    float acc[8] = {0.f, 0.f, 0.f, 0.f, 0.f, 0.f, 0.f, 0.f};
    for (int k = wave * 128; k < wave * 128 + 128; ++k) {
        const float wv = W[(size_t)k * 6144 + n0 + lane];
#pragma unroll
        for (int b = 0; b < 8; ++b) { const float cv = c[b * 1024 + k]; acc[b] += siluf_(cv) * wv; }
    }
#pragma unroll
    for (int b = 0; b < 8; ++b) part[(wave * 8 + b) * 64 + lane] = acc[b];
    __syncthreads();
    {
        const int b = wave; float s = bias[n0 + lane];
#pragma unroll
        for (int w = 0; w < 8; ++w) s += part[(w * 8 + b) * 64 + lane];
        ((float*)WSP(WS_MOD))[(size_t)(l * 8 + b) * 6144 + n0 + lane] = s;
    }
    __syncthreads();
}

template <bool WITH_ZS>
__device__ __forceinline__ void prenorm_rows(const float* x, const float* w, const float* modl, int sh_off, int sc_off, bf16_t* H, float* ZS, const LAS float* wsm, int gw, int NGW, int lane) {
    for (int row = gw; row < M; row += NGW) {
        const int b = row / T;
        const f32x4* xr = (const f32x4*)(x + (size_t)row * D);
        f32x4 v[4]; float ss = 0.f;
#pragma unroll
        for (int j = 0; j < 4; ++j) { v[j] = xr[lane + 64 * j]; ss += v[j][0] * v[j][0] + v[j][1] * v[j][1] + v[j][2] * v[j][2] + v[j][3] * v[j][3]; }
        ss = wave_sum(ss);
        const float r = rsqrtf(ss * (1.f / D) + 1e-6f);
        const float* sh = modl + (size_t)b * 6144 + sh_off; const float* sc = modl + (size_t)b * 6144 + sc_off;
#pragma unroll
        for (int j = 0; j < 4; ++j) {
            const int col = (lane + 64 * j) * 4;
            const f32x4 wv = *(const f32x4*)(w + col), scv = *(const f32x4*)(sc + col), shv = *(const f32x4*)(sh + col);
#pragma unroll
            for (int e = 0; e < 4; ++e) v[j][e] = v[j][e] * r * wv[e] * (1.f + scv[e]) + shv[e];
            u32x2 o; o.x = pk2(v[j][0], v[j][1]); o.y = pk2(v[j][2], v[j][3]);
            *(u32x2*)(H + (size_t)row * D + col) = o;
        }
        if (WITH_ZS) {
            float res = 0.f;
#pragma unroll 4
            for (int c = 0; c < 24; ++c) {
                float p = 0.f;
#pragma unroll
                for (int j = 0; j < 4; ++j) { const f32x4 wv = *(const LAS f32x4*)(wsm + c * 1024 + (lane + 64 * j) * 4); p += v[j][0] * wv[0] + v[j][1] * wv[1] + v[j][2] * wv[2] + v[j][3] * wv[3]; }
                p = wave_sum(p);
                res = (lane == c) ? p : res;
            }
            if (lane < 24) ZS[(size_t)row * 32 + lane] = res;
        }
    }
}
template <bool WITH_PRE, bool WITH_ZS>
__device__ __forceinline__ void postpre_rows(const bf16_t* Y, int ldy, const float* xold, const float* pw, const float* modl_post, int gt_off, float* xout,
                                             const float* w2, const float* modl_pre, int sh_off, int sc_off, bf16_t* H, float* ZS, const LAS float* wsm, int gw, int NGW, int lane) {
    for (int row = gw; row < M; row += NGW) {
        const int b = row / T;
        f32x4 v[4]; float ss = 0.f;
#pragma unroll
        for (int j = 0; j < 4; ++j) { const u32x2 y = *(const u32x2*)(Y + (size_t)row * ldy + (lane + 64 * j) * 4);
            v[j] = (f32x4){bflo(y.x), bfhi(y.x), bflo(y.y), bfhi(y.y)}; ss += v[j][0] * v[j][0] + v[j][1] * v[j][1] + v[j][2] * v[j][2] + v[j][3] * v[j][3]; }
        ss = wave_sum(ss);
        const float r = rsqrtf(ss * (1.f / D) + 1e-6f);
        const float* gt = modl_post + (size_t)b * 6144 + gt_off;
        float ss2 = 0.f;
#pragma unroll
        for (int j = 0; j < 4; ++j) {
            const int col = (lane + 64 * j) * 4;
            const f32x4 xo = *(const f32x4*)(xold + (size_t)row * D + col), pwv = *(const f32x4*)(pw + col), gtv = *(const f32x4*)(gt + col);
#pragma unroll
            for (int e = 0; e < 4; ++e) { v[j][e] = xo[e] + (1.f + gtv[e]) * (v[j][e] * r * pwv[e]); ss2 += v[j][e] * v[j][e]; }
            *(f32x4*)(xout + (size_t)row * D + col) = v[j];
        }
        if (WITH_PRE) {
            ss2 = wave_sum(ss2);
            const float r2 = rsqrtf(ss2 * (1.f / D) + 1e-6f);
            const float* sh = modl_pre + (size_t)b * 6144 + sh_off; const float* sc = modl_pre + (size_t)b * 6144 + sc_off;
#pragma unroll
            for (int j = 0; j < 4; ++j) {
                const int col = (lane + 64 * j) * 4;
                const f32x4 wv = *(const f32x4*)(w2 + col), scv = *(const f32x4*)(sc + col), shv = *(const f32x4*)(sh + col);
#pragma unroll
                for (int e = 0; e < 4; ++e) v[j][e] = v[j][e] * r2 * wv[e] * (1.f + scv[e]) + shv[e];
                u32x2 o; o.x = pk2(v[j][0], v[j][1]); o.y = pk2(v[j][2], v[j][3]);
                *(u32x2*)(H + (size_t)row * D + col) = o;
            }
            if (WITH_ZS) {
                float res = 0.f;
#pragma unroll 4
                for (int c = 0; c < 24; ++c) {
                    float p = 0.f;
#pragma unroll
                    for (int j = 0; j < 4; ++j) { const f32x4 wv = *(const LAS f32x4*)(wsm + c * 1024 + (lane + 64 * j) * 4); p += v[j][0] * wv[0] + v[j][1] * wv[1] + v[j][2] * wv[2] + v[j][3] * wv[3]; }
                    p = wave_sum(p);
                    res = (lane == c) ? p : res;
                }
                if (lane < 24) ZS[(size_t)row * 32 + lane] = res;
            }
        }
    }
}
__device__ __forceinline__ void stage_wsmall(const float* w_in, LAS float* wsm, int tid) {
    for (int k = tid; k < 1024; k += NWAVES * 64) {
        const float* src = w_in + (size_t)k * INDIM;
#pragma unroll
        for (int c = 0; c < 16; ++c) wsm[c * 1024 + k] = src[1024 + c];
#pragma unroll
        for (int c = 0; c < 8; ++c) wsm[(16 + c) * 1024 + k] = src[2576 + c];
    }
    __syncthreads();
}

__device__ __forceinline__ void seq_gla_mlstm(int l, LAS unsigned char* lds, int bh) {
    int tid0 = threadIdx.x; asm volatile("" : "+v"(tid0));
    const int b = bh >> 2, h = bh & 3, role = tid0 >> 8, tid = tid0 & 255, j = tid & 127, half = tid >> 7;
    bf16_t* Z = (bf16_t*)WSP(WS_Z); const float* ZS = (const float*)WSP(WS_ZS);
    LAS float* sm = (LAS float*)lds + role * 1024;
    LAS float* q = sm; LAS float* k = sm + 64; LAS float* eg = sm + 128; LAS float* v = sm + 192; LAS float* part = sm + 320; LAS float* red = sm + 576;
    float St[32];
#pragma unroll
    for (int i = 0; i < 32; ++i) St[i] = 0.f;
    float a2c[16]; float abd = 0.f, nwj = 0.f;
#pragma unroll
    for (int r = 0; r < 16; ++r) a2c[r] = 0.f;
    float w4[4] = {0.f, 0.f, 0.f, 0.f}, wb = 0.f, ibh = 0.f, fbh = 0.f, nreg = 0.f, mrun = 0.f; int zcol = 0;
    if (role == 0) {
        const float* a2 = inp(9) + l * 16 * 256; const float* ab = inp(10) + l * 256;
        if (tid < 64) { for (int r = 0; r < 16; ++r) a2c[r] = a2[r * 256 + h * 64 + tid]; abd = ab[h * 64 + tid]; }
        nwj = (inp(11) + l * 512)[h * 128 + j];
    } else {
        const float* cw = inp(12) + l * 4 * 512; const float* cb = inp(13) + l * 512;
        if (tid < 128) {
            const int c = (tid < 64) ? (h * 64 + tid) : (256 + h * 64 + (tid - 64));
            for (int jj = 0; jj < 4; ++jj) w4[jj] = cw[jj * 512 + c];
            wb = cb[c];
            zcol = (tid < 64) ? (MQ + h * 64 + tid) : (MK + h * 64 + (tid - 64));
        }
        ibh = (inp(14) + l * 4)[h]; fbh = (inp(15) + l * 4)[h];
    }
    for (int t = 0; t < T; ++t) {
        const size_t m = (size_t)b * T + t;
        bf16_t* zr = Z + m * ZLD;
        float mnew = 0.f, fdec = 0.f, iw = 0.f;
        if (role == 0) {
            if (tid < 64) {
                const float* zs = ZS + m * 32;
                float xg = abd;
#pragma unroll
                for (int r = 0; r < 16; ++r) xg += zs[r] * a2c[r];
                eg[tid] = expf(logsigmoidf_(xg) * (1.f / 16.f));
                q[tid] = bf2f(zr[GQ + h * 64 + tid]) * 0.125f;
                k[tid] = bf2f(zr[GK + h * 64 + tid]);
            } else if (tid >= 128) v[j] = bf2f(zr[GV + h * 128 + j]);
        } else {
            if (tid < 128) {
                float acc = wb;
#pragma unroll
                for (int jj = 0; jj < 4; ++jj) { const int tt = t - 3 + jj; if (tt >= 0) acc += w4[jj] * bf2f(Z[((size_t)b * T + tt) * ZLD + zcol]); }
                const float s = siluf_(acc);
                if (tid < 64) q[tid] = s; else k[tid - 64] = s * 0.125f;
            } else v[j] = bf2f(zr[MV + h * 128 + j]);
            const float ip = ZS[m * 32 + 16 + h] + ibh, fp = ZS[m * 32 + 20 + h] + fbh;
            const float lf = logsigmoidf_(fp);
            mnew = fmaxf(lf + mrun, ip); fdec = expf(lf + mrun - mnew); iw = expf(ip - mnew);
        }
        __syncthreads();
        {
            const float vj = v[j]; float op = 0.f;
            if (role == 0) {
#pragma unroll
                for (int dd = 0; dd < 32; ++dd) { const int d = half * 32 + dd; St[dd] = eg[d] * St[dd] + k[d] * vj; op += q[d] * St[dd]; }
            } else {
#pragma unroll
                for (int dd = 0; dd < 32; ++dd) { const int d = half * 32 + dd; St[dd] = fdec * St[dd] + iw * k[d] * vj; op += q[d] * St[dd]; }
                if (tid < 64) { nreg = fdec * nreg + iw * k[tid]; const float dp = wave_sum(q[tid] * nreg); if (tid == 0) red[2] = dp; }
            }
            part[half * 128 + j] = op;
        }
        __syncthreads();
        if (role == 0 && tid < 128) {
            const float o = part[j] + part[128 + j];
            const float ss = wave_sum(o * o);
            if ((tid & 63) == 0) red[tid >> 6] = ss;
        }
        __syncthreads();
        if (tid < 128) {
            const float o = part[j] + part[128 + j];
            if (role == 0) {
                const float r = rsqrtf((red[0] + red[1]) * (1.f / 128.f) + 1e-6f);
                const float gr = bf2f(zr[GR + h * 128 + j]);
                zr[YGLA + h * 128 + j] = (bf16_t)f2bf(o * r * nwj * siluf_(gr));
            } else {
                const float hh = o / fmaxf(fabsf(red[2]), expf(-mnew));
                const float mo = bf2f(zr[MO + h * 128 + j]);
                zr[YML + h * 128 + j] = (bf16_t)f2bf(sigmoidf_(mo) * hh);
            }
        }
        mrun = mnew;
        __syncthreads();
    }
}
__device__ __forceinline__ void seq_s5(int l, LAS unsigned char* ldsw, int bg, int p) {
    const int b = bg >> 5, g = bg & 31;
    bf16_t* Z = (bf16_t*)WSP(WS_Z);
    LAS float* us = (LAS float*)ldsw;
    LAS float* xr = us + 64 * 17;
    LAS float* xi = xr + 64 * 65;
    LAS float* cr = xi + 64 * 65;
    LAS float* ci = cr + 16 * 64;
    const float* lam_re = inp(16) + l * 2048; const float* lam_im = inp(17) + l * 2048; const float* log_step = inp(18) + l * 32;
    const float* b_re = inp(19) + (size_t)l * 32768; const float* b_im = inp(20) + (size_t)l * 32768;
    const float* c_re = inp(21) + (size_t)l * 32768; const float* c_im = inp(22) + (size_t)l * 32768; const float* dsk = inp(23) + l * 512;
    const float lre = fminf(lam_re[g * 64 + p], -1e-4f), lim = lam_im[g * 64 + p], dt = expf(log_step[g]);
    const float mag = expf(lre * dt), ar = mag * cosf(lim * dt), ai = mag * sinf(lim * dt);
    const float inv = 1.f / (lre * lre + lim * lim);
    const float zr_ = ((ar - 1.f) * lre + ai * lim) * inv, zi_ = (ai * lre - (ar - 1.f) * lim) * inv;
    float bbr[16], bbi[16], dk[16];
#pragma unroll
    for (int c = 0; c < 16; ++c) {
        const float br = b_re[(size_t)(g * 64 + p) * 16 + c], bi = b_im[(size_t)(g * 64 + p) * 16 + c];
        bbr[c] = zr_ * br - zi_ * bi; bbi[c] = zr_ * bi + zi_ * br;
        cr[c * 64 + p] = c_re[(size_t)(g * 16 + c) * 64 + p]; ci[c * 64 + p] = c_im[(size_t)(g * 16 + c) * 64 + p];
        dk[c] = dsk[g * 16 + c];
    }
    float xre = 0.f, xim = 0.f;
    for (int ch = 0; ch < T / 64; ++ch) {
        const size_t m0 = (size_t)b * T + ch * 64;
        bf16_t* zp = Z + (m0 + p) * ZLD + SU + g * 16;
#pragma unroll
        for (int c = 0; c < 16; ++c) us[p * 17 + c] = bf2f(zp[c]);
        LDS_WAIT(); asm volatile("" ::: "memory");
        for (int t = 0; t < 64; ++t) {
            float bur = 0.f, bui = 0.f;
#pragma unroll
            for (int c = 0; c < 16; ++c) { const float u = us[t * 17 + c]; bur += bbr[c] * u; bui += bbi[c] * u; }
            const float nr = ar * xre - ai * xim + bur, ni = ar * xim + ai * xre + bui;
            xre = nr; xim = ni; xr[t * 65 + p] = nr; xi[t * 65 + p] = ni;
        }
        LDS_WAIT(); asm volatile("" ::: "memory");
#pragma unroll 1
        for (int c = 0; c < 16; ++c) {
            float y = 0.f;
            for (int pp = 0; pp < 64; ++pp) y += cr[c * 64 + pp] * xr[p * 65 + pp] - ci[c * 64 + pp] * xi[p * 65 + pp];
            y += dk[c] * us[p * 17 + c];
            zp[c] = (bf16_t)f2bf(gelu_tanh(y));
        }
        LDS_WAIT(); asm volatile("" ::: "memory");
    }
}

#ifndef PHASE_MASK
#define PHASE_MASK 0xFFFF
#endif
#define PH(k) if constexpr ((PHASE_MASK >> (k)) & 1)
#define PHASE_ENV int tid = threadIdx.x; asm volatile("" : "+v"(tid)); const int lane = tid & 63, wave = __builtin_amdgcn_readfirstlane(tid >> 6); const int gw = vcu * NWAVES + wave; (void)lane; (void)gw;
__global__ void __launch_bounds__(NWAVES * 64, 2) mega_fwd(Args args) {
    extern __shared__ __attribute__((aligned(16))) unsigned char lds_raw[];
    LAS unsigned char* lds = (LAS unsigned char*)lds_raw;
    const int G = gridDim.x, blk = blockIdx.x;
    const int vcu = (G % 8 == 0) ? (blk % 8) * (G / 8) + blk / 8 : blk;
    const int NGW = G * NWAVES;
    for (int u = threadIdx.x; u < (LDS_BYTES - LDSCTL_OFF) / 4; u += NWAVES * 64) ((LAS unsigned*)(lds + LDSCTL_OFF))[u] = 0u;
    __syncthreads();
    XcdBarrier bar = xcd_barrier_post((unsigned*)(args.ws + WS_CTL) + CW_BAR, (volatile LAS unsigned*)(lds + MISC_OFF) + 8);
#define GRID_BAR() xcd_barrier(bar)

    PH(0) { PHASE_ENV
        ada_phase(lds, blk, wave, lane);
        LAS float* scr = (LAS float*)(lds + wave * 16384);
        int base = 0;
        convert_matrix<1>(inp(8), INDIM, 1024, ZLD, (bf16_t*)WSP(WS_WIN), scr, lane, gw, NGW, base);
        convert_matrix<0>(inp(24), 512, 512, 512, (bf16_t*)WSP(WS_WGLU), scr, lane, gw, NGW, base);
        convert_matrix<0>(inp(26), 1024, 512, 1024, (bf16_t*)WSP(WS_WPROJ), scr, lane, gw, NGW, base);
        convert_matrix<0>(inp(27), 1024, 512, 1024, (bf16_t*)WSP(WS_WPROJ) + 1024 * 512, scr, lane, gw, NGW, base);
        convert_matrix<0>(inp(28), 1024, 512, 1024, (bf16_t*)WSP(WS_WPROJ) + 2 * 1024 * 512, scr, lane, gw, NGW, base);
        convert_matrix<0>(inp(30), 1024, 1024, 1024, (bf16_t*)WSP(WS_WOUT), scr, lane, gw, NGW, base);
        convert_matrix<0>(inp(32), 1024, FF, 1024, (bf16_t*)WSP(WS_WFO), scr, lane, gw, NGW, base);
    }
    GRID_BAR();

#pragma unroll 1
    for (int l = 0; l < DEPTH; ++l) {
        PH(1) if (l == 0) { PHASE_ENV
            __syncthreads();
            stage_wsmall(inp(8), (LAS float*)lds, tid);
            prenorm_rows<true>(inp(0), inp(4), (const float*)WSP(WS_MOD), 0, 1024, (bf16_t*)WSP(WS_H), (float*)WSP(WS_ZS), (const LAS float*)lds, gw, NGW, lane);
            GRID_BAR();
        }
        PH(2) {
            pg8::PlainSched S; S.o.init(M, ZLD, G, blk); S.A = (const bf16_t*)WSP(WS_H); S.lda = D; S.Bt = (const bf16_t*)WSP(WS_WIN); S.K = D;
            pg8::EpiStore E{(bf16_t*)WSP(WS_Z), ZLD};
            pg8::gemm_phase<pg8::EpiStore, pg8::PlainSched, true, true>(lds, D, D, S, E);
        }
        GRID_BAR();
        PH(3) { PHASE_ENV
            if (blk < 32) seq_gla_mlstm(l, lds, blk);
            else if (blk < 160) { if (wave < 2) seq_s5(l, lds + wave * 49152, (blk - 32) * 2 + wave, lane); }
            else {
                int base = 0; const int gw2 = (blk - 160) * NWAVES + wave, NGW2 = (G - 160) * NWAVES;
                if (G > 160) convert_matrix<2>(inp(31) + (size_t)l * D * 2 * FF, 2 * FF, 1024, 2 * FF, (bf16_t*)WSP(WS_WIN), (LAS float*)(lds + wave * 16384), lane, gw2, NGW2, base);
            }
        }
        GRID_BAR();
        PH(4) {
            bf16_t* Z = (bf16_t*)WSP(WS_Z);
            pg8::PlainSched S; S.o.init(M, 512, G, blk); S.A = Z + SU; S.lda = ZLD; S.Bt = (const bf16_t*)WSP(WS_WGLU); S.K = 512;
            pg8::EpiGlu E{Z + YS2, ZLD, Z + SU, ZLD, inp(25) + l * 512};
            pg8::gemm_phase<pg8::EpiGlu, pg8::PlainSched, true, true>(lds, ZLD, 512, S, E);
        }
        GRID_BAR();
        PH(5) {
            bf16_t* Z = (bf16_t*)WSP(WS_Z);
            pg8::MergeSched S; S.o.init(M, 1024, G, blk); S.Zb = Z; S.Wp = (const bf16_t*)WSP(WS_WPROJ);
            pg8::EpiMerge E{Z + MRG, ZLD, Z + ZG, ZLD, inp(29) + l * 3072};
            pg8::gemm_phase<pg8::EpiMerge, pg8::MergeSched, true, true>(lds, ZLD, 512, S, E);
        }
        GRID_BAR();
        PH(6) {
            pg8::PlainSched S; S.o.init(M, 1024, G, blk); S.A = (const bf16_t*)WSP(WS_Z) + MRG; S.lda = ZLD; S.Bt = (const bf16_t*)WSP(WS_WOUT); S.K = 1024;
            pg8::EpiStore E{(bf16_t*)WSP(WS_H), D};
            pg8::gemm_phase<pg8::EpiStore, pg8::PlainSched, true, true>(lds, ZLD, 1024, S, E);
        }
        GRID_BAR();
        PH(7) { PHASE_ENV
            const float* modl = (const float*)WSP(WS_MOD) + (size_t)l * 8 * 6144;
            postpre_rows<true, false>((const bf16_t*)WSP(WS_H), D, (l == 0) ? inp(0) : (const float*)inp_out(), inp(5) + l * D, modl, 2048, inp_out(), inp(6) + l * D, modl, 3072, 4096,
                                      (bf16_t*)WSP(WS_H), nullptr, nullptr, gw, NGW, lane);
        }
        GRID_BAR();
        PH(8) {
            pg8::PlainSched S; S.o.init(M, 2 * FF, G, blk); S.A = (const bf16_t*)WSP(WS_H); S.lda = D; S.Bt = (const bf16_t*)WSP(WS_WIN); S.K = D;
            pg8::EpiSwiGlu E{(bf16_t*)WSP(WS_Z), FF};
            pg8::gemm_phase<pg8::EpiSwiGlu, pg8::PlainSched, true, true>(lds, D, D, S, E);
        }
        GRID_BAR();
        PH(9) {
            pg8::PlainSched S; S.o.init(M, 1024, G, blk); S.A = (const bf16_t*)WSP(WS_Z); S.lda = FF; S.Bt = (const bf16_t*)WSP(WS_WFO); S.K = FF;
            pg8::EpiStore E{(bf16_t*)WSP(WS_H), D};
            pg8::gemm_phase<pg8::EpiStore, pg8::PlainSched, true, true>(lds, FF, FF, S, E);
        }
        GRID_BAR();
        PH(10) { PHASE_ENV
            const float* modl = (const float*)WSP(WS_MOD) + (size_t)l * 8 * 6144;
            if (l + 1 < DEPTH) {
                const int l1 = l + 1;
                LAS float* scr = (LAS float*)(lds + wave * 16384);
                int base = 0;
                convert_matrix<1>(inp(8) + (size_t)l1 * D * INDIM, INDIM, 1024, ZLD, (bf16_t*)WSP(WS_WIN), scr, lane, gw, NGW, base);
                convert_matrix<0>(inp(24) + (size_t)l1 * 512 * 512, 512, 512, 512, (bf16_t*)WSP(WS_WGLU), scr, lane, gw, NGW, base);
                convert_matrix<0>(inp(26) + (size_t)l1 * 512 * 1024, 1024, 512, 1024, (bf16_t*)WSP(WS_WPROJ), scr, lane, gw, NGW, base);
                convert_matrix<0>(inp(27) + (size_t)l1 * 512 * 1024, 1024, 512, 1024, (bf16_t*)WSP(WS_WPROJ) + 1024 * 512, scr, lane, gw, NGW, base);
                convert_matrix<0>(inp(28) + (size_t)l1 * 512 * 1024, 1024, 512, 1024, (bf16_t*)WSP(WS_WPROJ) + 2 * 1024 * 512, scr, lane, gw, NGW, base);
                convert_matrix<0>(inp(30) + (size_t)l1 * D * D, 1024, 1024, 1024, (bf16_t*)WSP(WS_WOUT), scr, lane, gw, NGW, base);
                convert_matrix<0>(inp(32) + (size_t)l1 * FF * D, 1024, FF, 1024, (bf16_t*)WSP(WS_WFO), scr, lane, gw, NGW, base);
                __syncthreads();
                stage_wsmall(inp(8) + (size_t)l1 * D * INDIM, (LAS float*)lds, tid);
                postpre_rows<true, true>((const bf16_t*)WSP(WS_H), D, (const float*)inp_out(), inp(7) + l * D, modl, 5120, inp_out(), inp(4) + l1 * D, modl + 8 * 6144, 0, 1024,
                                         (bf16_t*)WSP(WS_H), (float*)WSP(WS_ZS), (const LAS float*)lds, gw, NGW, lane);
                GRID_BAR();
            } else {
                postpre_rows<false, false>((const bf16_t*)WSP(WS_H), D, (const float*)inp_out(), inp(7) + l * D, modl, 5120, inp_out(), nullptr, nullptr, 0, 0, nullptr, nullptr, nullptr, gw, NGW, lane);
            }
        }
    }
}

extern "C" void kernel_launch(void* const* d_in, const int* in_sizes, int n_in, void* d_out, int out_size, void* d_ws, size_t ws_size, hipStream_t stream) {
    static int grid = 0;
    if (grid == 0) {
        if (n_in != 33 || ws_size < WS_END || out_size != M * D) { fprintf(stderr, "kernel_launch: unexpected n_in %d / ws %zu / out %d\n", n_in, ws_size, out_size); grid = -1; return; }
        int dev = 0, cus = 0, per_cu = 0;
        if (hipGetDevice(&dev) != hipSuccess || hipDeviceGetAttribute(&cus, hipDeviceAttributeMultiprocessorCount, dev) != hipSuccess) { grid = -1; return; }
        if (hipFuncSetAttribute((const void*)mega_fwd, hipFuncAttributeMaxDynamicSharedMemorySize, LDS_BYTES) != hipSuccess) { fprintf(stderr, "kernel_launch: hipFuncSetAttribute failed\n"); grid = -1; return; }
        if (hipOccupancyMaxActiveBlocksPerMultiprocessor(&per_cu, (const void*)mega_fwd, NWAVES * 64, LDS_BYTES) != hipSuccess || per_cu < 1) { fprintf(stderr, "kernel_launch: occupancy query says %d blocks/CU\n", per_cu); grid = -1; return; }
        (void)hipGetLastError();
        grid = cus;
    }
    if (grid < 0) return;
    (void)hipMemsetAsync((char*)d_ws + WS_CTL, 0, CTL_ZERO_BYTES, stream);
    Args a{};
    for (int i = 0; i < 33; ++i) a.in[i] = (const float*)d_in[i];
    a.out = (float*)d_out; a.ws = (unsigned char*)d_ws;
    hipLaunchKernelGGL(mega_fwd, dim3(grid), dim3(NWAVES * 64), LDS_BYTES, stream, a);
}
```

```cpp
#include <hip/hip_runtime.h>
#include <cstdint>
#include <cstdio>

#define LAS __attribute__((address_space(3)))
#define GAS __attribute__((address_space(1)))
typedef unsigned short bf16_t;
typedef short bf16x8 __attribute__((ext_vector_type(8)));
typedef float f32x4 __attribute__((ext_vector_type(4)));
typedef float f32x2 __attribute__((ext_vector_type(2)));
typedef unsigned u32x4 __attribute__((ext_vector_type(4)));
typedef unsigned u32x2 __attribute__((ext_vector_type(2)));

constexpr int NB = 8, T = 4096, D = 1024, M = NB * T, DEPTH = 2;
constexpr int INDIM = 6680, ZLD = 6656, FF = 2816;
constexpr int GQ = 0, GK = 256, GV = 512, GR = 1024, MQ = 1536, MK = 1792, MV = 2048, MO = 2560, SU = 3072, ZG = 3584;
constexpr int YGLA = GR;
constexpr int YML = MO;
constexpr int YS2 = 0;
constexpr int MRG = 1536;
constexpr size_t MiB = 1u << 20;
constexpr size_t WS_CTL = 0, CTL_ZERO_BYTES = 64 * 1024;
constexpr size_t WS_MOD = 512 * 1024;
constexpr size_t WS_ZS = 1 * MiB;
constexpr size_t WS_WIN = 5 * MiB;
constexpr size_t WS_WGLU = 18 * MiB;
constexpr size_t WS_WPROJ = 18 * MiB + 512 * 1024;
constexpr size_t WS_WOUT = 21 * MiB + 512 * 1024;
constexpr size_t WS_WFO = 23 * MiB + 512 * 1024;
constexpr size_t WS_H = 32 * MiB;
constexpr size_t WS_Z = 96 * MiB;
constexpr size_t WS_END = 512 * MiB;
constexpr int CW_BAR = 4096;

constexpr int RING_BYTES = 131072, LDSCTL_OFF = RING_BYTES, MISC_OFF = LDSCTL_OFF + 320, LDS_BYTES = 147456;
constexpr int NWAVES = 8;

__device__ __forceinline__ float bf2f(bf16_t v) { return __uint_as_float(((unsigned)v) << 16); }
__device__ __forceinline__ unsigned f2bf(float f) { unsigned u = __float_as_uint(f); return (u + 0x7fffu + ((u >> 16) & 1u)) >> 16; }
__device__ __forceinline__ unsigned pk2(float lo, float hi) { return f2bf(lo) | (f2bf(hi) << 16); }
__device__ __forceinline__ float bflo(unsigned u) { return __uint_as_float(u << 16); }
__device__ __forceinline__ float bfhi(unsigned u) { return __uint_as_float(u & 0xffff0000u); }
__device__ __forceinline__ float wave_sum(float v) {
#pragma unroll
    for (int o = 1; o < 64; o <<= 1) v += __shfl_xor(v, o);
    return v;
}
__device__ __forceinline__ float sigmoidf_(float x) { return 1.f / (1.f + expf(-x)); }
__device__ __forceinline__ float siluf_(float x) { return x / (1.f + expf(-x)); }
__device__ __forceinline__ float logsigmoidf_(float x) { return fminf(x, 0.f) - log1pf(expf(-fabsf(x))); }
__device__ __forceinline__ float gelu_tanh(float y) { return 0.5f * y * (1.f + tanhf(0.7978845608028654f * (y + 0.044715f * y * y * y))); }
__device__ __forceinline__ float fexp_neg(float x) { return __builtin_amdgcn_exp2f(-1.4426950408889634f * x); }
__device__ __forceinline__ float fsigmoid(float x) { return __builtin_amdgcn_rcpf(1.f + fexp_neg(x)); }
#define LDS_WAIT() asm volatile("s_waitcnt lgkmcnt(0)" ::: "memory")
#define VM_WAIT() asm volatile("s_waitcnt vmcnt(0)" ::: "memory")

namespace pg8 {
constexpr int BM = 256, BK = 64, HALF = 128, HTB = HALF * BK * 2, STAGE_BYTES = 8 * HTB, NXCD = 8, WGM = 8;
__host__ __device__ __forceinline__ int lds_byte(int r, int c) { const int st = (r >> 4) * 2 + (c >> 5), rr = r & 15, cc = c & 31, ob = rr * 64 + cc * 2; return st * 1024 + (ob ^ (((ob >> 9) & 1) << 5)); }
__host__ __device__ __forceinline__ void stage_rc(int b, int& R, int& C) { const int st = b / 1024, sb = b % 1024, swz = sb ^ (((sb >> 9) & 1) << 5); R = (st >> 1) * 16 + swz / 64; C = (st & 1) * 32 + (swz % 64) / 2; }
__host__ __device__ __forceinline__ int perm32(int rho) { const int n = rho >> 4, i = rho & 15; return 8 * (i >> 2) + 4 * n + (i & 3); }

struct Unit { int pm, pn, br; };
struct TileOrder {
    int nM, nN, nwg, G, c;
    __device__ void init(int M_, int N_, int G_, int c_) { nM = M_ / BM; nN = N_ / BM; nwg = nM * nN; G = G_; c = c_; }
    __device__ bool tile(int i, int& pm, int& pn) const {
        const long L = (long)i * G + c; if (L >= nwg) return false;
        int wgid = (int)L; { const int q = nwg / NXCD, r = nwg % NXCD, xcd = wgid % NXCD, off = wgid / NXCD; wgid = (xcd < r ? xcd * (q + 1) : r * (q + 1) + (xcd - r) * q) + off; }
        const int nig = WGM * nN, gid = wgid / nig, fm = gid * WGM, gsz = (nM - fm) < WGM ? (nM - fm) : WGM;
        pm = fm + ((wgid % nig) % gsz); pn = (wgid % nig) / gsz; return true;
    }
};
struct PlainSched {
    TileOrder o; const bf16_t* A; int lda; const bf16_t* Bt; int K;
    __device__ bool next(int i, Unit& u) const { u.br = 0; return o.tile(i, u.pm, u.pn); }
    __device__ const char* Ap(const Unit& u) const { return (const char*)(A + (size_t)u.pm * BM * lda); }
    __device__ const char* Bp(const Unit& u) const { return (const char*)(Bt + (size_t)u.pn * BM * K); }
};
struct MergeSched {
    TileOrder o; const bf16_t* Zb; const bf16_t* Wp;
    __device__ bool next(int i, Unit& u) const { u.br = i % 3; return o.tile(i / 3, u.pm, u.pn); }
    __device__ const char* Ap(const Unit& u) const { const int col = u.br == 0 ? YGLA : (u.br == 1 ? YML : YS2); return (const char*)(Zb + (size_t)u.pm * BM * ZLD + col); }
    __device__ const char* Bp(const Unit& u) const { return (const char*)(Wp + (size_t)u.br * 1024 * 512 + (size_t)u.pn * BM * 512); }
};

__device__ __forceinline__ unsigned cvt_pk_bf16(float lo, float hi) { unsigned r; asm volatile("v_cvt_pk_bf16_f32 %0, %1, %2" : "=v"(r) : "v"(lo), "v"(hi)); return r; }

struct EpiStore {
    static constexpr bool PERM = true;
    bf16_t* O; int ldc;
    __device__ __forceinline__ bool keep(const Unit&) const { return false; }
    __device__ __forceinline__ void operator()(f32x4 (&acc)[2][2][4][2], const Unit& u, int wr, int wc, int fr, int fq) const {
        const int row0 = u.pm * BM + wr * 64 + fr, col0 = u.pn * BM + wc * 32 + 8 * fq;
#pragma unroll
        for (int ai = 0; ai < 2; ++ai)
#pragma unroll
            for (int m = 0; m < 4; ++m) { bf16_t* rowp = O + (size_t)(row0 + ai * HALF + m * 16) * ldc + col0;
#pragma unroll
                for (int bj = 0; bj < 2; ++bj) { const f32x4 v0 = acc[ai][bj][m][0], v1 = acc[ai][bj][m][1];
                    u32x4 w; w.x = cvt_pk_bf16(v0[0], v0[1]); w.y = cvt_pk_bf16(v0[2], v0[3]); w.z = cvt_pk_bf16(v1[0], v1[1]); w.w = cvt_pk_bf16(v1[2], v1[3]);
                    *(u32x4*)(rowp + bj * HALF) = w; } }
    }
};
struct EpiGlu {
    static constexpr bool PERM = true;
    bf16_t* O; int ldc; const bf16_t* Asrc; int lda; const float* bias;
    __device__ __forceinline__ bool keep(const Unit&) const { return false; }
    __device__ __forceinline__ void operator()(f32x4 (&acc)[2][2][4][2], const Unit& u, int wr, int wc, int fr, int fq) const {
        const int row0 = u.pm * BM + wr * 64 + fr, col0 = u.pn * BM + wc * 32 + 8 * fq;
        f32x4 bv[2][2];
#pragma unroll
        for (int bj = 0; bj < 2; ++bj)
#pragma unroll
            for (int n = 0; n < 2; ++n) bv[bj][n] = *(const f32x4*)(bias + col0 + bj * HALF + 4 * n);
#pragma unroll
        for (int ai = 0; ai < 2; ++ai)
#pragma unroll
            for (int m = 0; m < 4; ++m) { const size_t r = (size_t)(row0 + ai * HALF + m * 16);
#pragma unroll
                for (int bj = 0; bj < 2; ++bj) {
                    const u32x4 a = *(const u32x4*)(Asrc + r * lda + col0 + bj * HALF);
                    const f32x4 v0 = acc[ai][bj][m][0] + bv[bj][0], v1 = acc[ai][bj][m][1] + bv[bj][1];
                    u32x4 w;
                    w.x = cvt_pk_bf16(bflo(a.x) * fsigmoid(v0[0]), bfhi(a.x) * fsigmoid(v0[1])); w.y = cvt_pk_bf16(bflo(a.y) * fsigmoid(v0[2]), bfhi(a.y) * fsigmoid(v0[3]));
                    w.z = cvt_pk_bf16(bflo(a.z) * fsigmoid(v1[0]), bfhi(a.z) * fsigmoid(v1[1])); w.w = cvt_pk_bf16(bflo(a.w) * fsigmoid(v1[2]), bfhi(a.w) * fsigmoid(v1[3]));
                    *(u32x4*)(O + r * ldc + col0 + bj * HALF) = w; } }
    }
};
struct EpiSwiGlu {
    static constexpr bool PERM = true;
    bf16_t* O; int ldc;
    __device__ __forceinline__ bool keep(const Unit&) const { return false; }
    __device__ __forceinline__ void operator()(f32x4 (&acc)[2][2][4][2], const Unit& u, int wr, int wc, int fr, int fq) const {
        const int row0 = u.pm * BM + wr * 64 + fr, col0 = u.pn * HALF + wc * 32 + 8 * fq;
#pragma unroll
        for (int ai = 0; ai < 2; ++ai)
#pragma unroll
            for (int m = 0; m < 4; ++m) {
                float o[8];
#pragma unroll
                for (int n = 0; n < 2; ++n)
#pragma unroll
                    for (int e = 0; e < 4; ++e) { const float g = acc[ai][0][m][n][e], up = acc[ai][1][m][n][e]; o[n * 4 + e] = g * fsigmoid(g) * up; }
                u32x4 w; w.x = cvt_pk_bf16(o[0], o[1]); w.y = cvt_pk_bf16(o[2], o[3]); w.z = cvt_pk_bf16(o[4], o[5]); w.w = cvt_pk_bf16(o[6], o[7]);
                *(u32x4*)(O + (size_t)(row0 + ai * HALF + m * 16) * ldc + col0) = w; }
    }
};
struct EpiMerge {
    static constexpr bool PERM = true;
    bf16_t* O; int ldc; const bf16_t* Zg; int ldz; const float* bgb;
    __device__ __forceinline__ bool keep(const Unit& u) const { return u.br < 2; }
    __device__ __forceinline__ float e_of(float x) const { return fminf(fexp_neg(x), 1e30f); }
    __device__ __forceinline__ void operator()(f32x4 (&acc)[2][2][4][2], const Unit& u, int wr, int wc, int fr, int fq) const {
        const int row0 = u.pm * BM + wr * 64 + fr, col0 = u.pn * BM + wc * 32 + 8 * fq;
        const int br = u.br, brn = br < 2 ? br + 1 : 2;
#pragma unroll
        for (int bj = 0; bj < 2; ++bj) {
            float ba[8], bb[8];
#pragma unroll
            for (int e = 0; e < 8; ++e) { ba[e] = bgb[br * 1024 + col0 + bj * HALF + e]; bb[e] = bgb[brn * 1024 + col0 + bj * HALF + e]; }
#pragma unroll
            for (int ai = 0; ai < 2; ++ai)
#pragma unroll
                for (int m = 0; m < 4; ++m) { const size_t r = (size_t)(row0 + ai * HALF + m * 16);
                    const u32x4 za = *(const u32x4*)(Zg + r * ldz + br * 1024 + col0 + bj * HALF);
                    const u32x4 zb = *(const u32x4*)(Zg + r * ldz + brn * 1024 + col0 + bj * HALF);
                    const float xa[8] = {bflo(za.x), bfhi(za.x), bflo(za.y), bfhi(za.y), bflo(za.z), bfhi(za.z), bflo(za.w), bfhi(za.w)};
                    const float xb[8] = {bflo(zb.x), bfhi(zb.x), bflo(zb.y), bfhi(zb.y), bflo(zb.z), bfhi(zb.z), bflo(zb.w), bfhi(zb.w)};
                    float f[8];
#pragma unroll
                    for (int e = 0; e < 8; ++e) { const float ga = __builtin_amdgcn_rcpf(1.f + e_of(xa[e] + ba[e]));
                        f[e] = br < 2 ? ga * (1.f + e_of(xb[e] + bb[e])) : ga; }
                    f32x4 v0 = acc[ai][bj][m][0], v1 = acc[ai][bj][m][1];
                    v0[0] *= f[0]; v0[1] *= f[1]; v0[2] *= f[2]; v0[3] *= f[3]; v1[0] *= f[4]; v1[1] *= f[5]; v1[2] *= f[6]; v1[3] *= f[7];
                    if (br < 2) { acc[ai][bj][m][0] = v0; acc[ai][bj][m][1] = v1; }
                    else { u32x4 w; w.x = cvt_pk_bf16(v0[0], v0[1]); w.y = cvt_pk_bf16(v0[2], v0[3]); w.z = cvt_pk_bf16(v1[0], v1[1]); w.w = cvt_pk_bf16(v1[2], v1[3]);
                        *(u32x4*)(O + r * ldc + col0 + bj * HALF) = w; } }
        }
    }
};

template <class Epi, class Sched, bool ALIGN_EPI, bool SP2>
__device__ __forceinline__ void gemm_phase(LAS unsigned char* lds, const int lda, const int K, const Sched& S, const Epi& E) {
    int tid_ = threadIdx.x; asm volatile("" : "+v"(tid_));
    const int tid = tid_, wid = __builtin_amdgcn_readfirstlane(tid >> 6), lane = tid & 63, wr = wid >> 2, wc = wid & 3, fr = lane & 15, fq = lane >> 4;
    const int nt = K / BK;
    unsigned voffA[2], voffB[2];
#pragma unroll
    for (int i = 0; i < 2; ++i) { int R, C; stage_rc(tid * 16 + i * 8192, R, C); const int Rb = Epi::PERM ? ((R & ~31) + perm32(R & 31)) : R;
        voffA[i] = (unsigned)(R * lda + C) * 2u; voffB[i] = (unsigned)(Rb * K + C) * 2u; }
    const size_t kstep = (size_t)(BK * 2);
    const size_t hA = (size_t)HALF * lda * 2, hB = (size_t)HALF * K * 2;
    const unsigned ldsw = (unsigned)wid * 1024u;
    const int aoff = lds_byte(wr * 64 + fr, fq * 8), boff = lds_byte(wc * 32 + fr, fq * 8);
#define PG8_SA(b, h) (((b) * 2 + (h)) * HTB)
#define PG8_SB(b, h) ((4 + (b) * 2 + (h)) * HTB)
#define PG8_STAGE(bufoff, gbase, voff) do { _Pragma("unroll") for (int _i = 0; _i < 2; ++_i) \
        __builtin_amdgcn_global_load_lds((const unsigned*)((const char*)(gbase) + (voff)[_i]), (LAS unsigned*)(lds + (bufoff) + ldsw + _i * 8192), 16, 0, 0); } while (0)
#define PG8_LDA(dst, b, h) do { _Pragma("unroll") for (int m = 0; m < 4; ++m) _Pragma("unroll") for (int k = 0; k < 2; ++k) dst[m][k] = *(const LAS bf16x8*)(lds + PG8_SA(b, h) + aoff + m * 2048 + k * 1024); } while (0)
#define PG8_LDB(dst, b, h) do { _Pragma("unroll") for (int n = 0; n < 2; ++n) _Pragma("unroll") for (int k = 0; k < 2; ++k) dst[n][k] = *(const LAS bf16x8*)(lds + PG8_SB(b, h) + boff + n * 2048 + k * 1024); } while (0)
#define PG8_MMA(ai, bj, At, Bt) do { __builtin_amdgcn_s_setprio(1); _Pragma("unroll") for (int m = 0; m < 4; ++m) _Pragma("unroll") for (int n = 0; n < 2; ++n) _Pragma("unroll") for (int k = 0; k < 2; ++k) \
        acc[ai][bj][m][n] = __builtin_amdgcn_mfma_f32_16x16x32_bf16(Bt[n][k], At[m][k], acc[ai][bj][m][n], 0, 0, 0); __builtin_amdgcn_s_setprio(0); } while (0)
#define PG8_WAIT_V(n) asm volatile("s_waitcnt vmcnt(" #n ")" ::: "memory")
#define PG8_WAIT_L(n) asm volatile("s_waitcnt lgkmcnt(" #n ")" ::: "memory")
#define PG8_BAR __builtin_amdgcn_s_barrier()
#define PG8_SCHED __builtin_amdgcn_sched_barrier(0)
    Unit cur, nxt; int ui = 0;
    if (!S.next(0, cur)) return;
    f32x4 acc[2][2][4][2];
#pragma unroll
    for (int a = 0; a < 2; ++a)
#pragma unroll
        for (int b = 0; b < 2; ++b)
#pragma unroll
            for (int m = 0; m < 4; ++m)
#pragma unroll
                for (int n = 0; n < 2; ++n) acc[a][b][m][n] = (f32x4){0.f, 0.f, 0.f, 0.f};
    bf16x8 At[4][2], B0[2][2], B1[2][2];
    const char* cA = S.Ap(cur); const char* cB = S.Bp(cur);
    if constexpr (SP2) {
        PG8_STAGE(PG8_SB(0, 0), cB, voffB); PG8_STAGE(PG8_SB(0, 1), cB + hB, voffB); PG8_STAGE(PG8_SA(0, 0), cA, voffA); PG8_STAGE(PG8_SA(0, 1), cA + hA, voffA);
        if (wr == 1) PG8_BAR;
        PG8_WAIT_V(2); PG8_BAR;
        PG8_STAGE(PG8_SB(1, 0), cB + kstep, voffB); PG8_STAGE(PG8_SA(1, 0), cA + kstep, voffA); PG8_STAGE(PG8_SB(1, 1), cB + hB + kstep, voffB);
        PG8_WAIT_V(6); PG8_BAR;
    } else {
        PG8_STAGE(PG8_SB(0, 0), cB, voffB); PG8_STAGE(PG8_SA(0, 0), cA, voffA); PG8_STAGE(PG8_SB(0, 1), cB + hB, voffB); PG8_STAGE(PG8_SA(0, 1), cA + hA, voffA);
        if (wr == 1) PG8_BAR;
        PG8_WAIT_V(4); PG8_BAR;
        PG8_STAGE(PG8_SB(1, 0), cB + kstep, voffB); PG8_STAGE(PG8_SA(1, 0), cA + kstep, voffA); PG8_STAGE(PG8_SB(1, 1), cB + hB + kstep, voffB);
        PG8_WAIT_V(6); PG8_BAR;
    }
    for (;;) {
        const bool has_next = S.next(ui + 1, nxt);
        const char* nA = has_next ? S.Ap(nxt) : cA; const char* nB = has_next ? S.Bp(nxt) : cB;
        for (int t = 0; t < nt; t += 2) {
            const bool last = (t == nt - 2);
            const char* a1 = cA + (size_t)(t + 1) * kstep;
            const char* a2 = last ? nA : cA + (size_t)(t + 2) * kstep; const char* b2 = last ? nB : cB + (size_t)(t + 2) * kstep;
            const char* a3 = a2 + kstep; const char* b3 = b2 + kstep;
            if constexpr (SP2) {
            PG8_LDB(B0, 0, 0); PG8_LDB(B1, 0, 1); PG8_SCHED; PG8_LDA(At, 0, 0); PG8_STAGE(PG8_SA(1, 1), a1 + hA, voffA);
            PG8_WAIT_V(8); PG8_WAIT_L(0); PG8_BAR; PG8_MMA(0, 0, At, B0); PG8_MMA(0, 1, At, B1); PG8_BAR; PG8_SCHED;
            PG8_LDA(At, 0, 1); PG8_STAGE(PG8_SB(0, 0), b2, voffB); PG8_STAGE(PG8_SB(0, 1), b2 + hB, voffB); PG8_STAGE(PG8_SA(0, 0), a2, voffA);
            PG8_WAIT_V(8); PG8_WAIT_L(0); PG8_BAR; PG8_MMA(1, 0, At, B0); PG8_MMA(1, 1, At, B1); PG8_BAR; PG8_SCHED;
            PG8_LDB(B0, 1, 0); PG8_LDB(B1, 1, 1); PG8_SCHED; PG8_LDA(At, 1, 0); PG8_STAGE(PG8_SA(0, 1), a2 + hA, voffA);
            PG8_WAIT_V(8); PG8_WAIT_L(0); PG8_BAR; PG8_MMA(0, 0, At, B0); PG8_MMA(0, 1, At, B1); PG8_BAR; PG8_SCHED;
            PG8_LDA(At, 1, 1); PG8_STAGE(PG8_SB(1, 0), b3, voffB); PG8_STAGE(PG8_SB(1, 1), b3 + hB, voffB); PG8_STAGE(PG8_SA(1, 0), a3, voffA);
            PG8_WAIT_V(8); PG8_WAIT_L(0); PG8_BAR; PG8_MMA(1, 0, At, B0); PG8_MMA(1, 1, At, B1); PG8_BAR; PG8_SCHED;
            } else {
            PG8_LDB(B0, 0, 0); PG8_SCHED; PG8_LDA(At, 0, 0); PG8_STAGE(PG8_SA(1, 1), a1 + hA, voffA);
            PG8_WAIT_L(8); PG8_BAR; PG8_WAIT_L(0); PG8_MMA(0, 0, At, B0); PG8_BAR; PG8_SCHED;
            PG8_LDB(B1, 0, 1); PG8_STAGE(PG8_SB(0, 0), b2, voffB);
            PG8_BAR; PG8_WAIT_L(0); PG8_MMA(0, 1, At, B1); PG8_BAR;
            PG8_LDA(At, 0, 1); PG8_STAGE(PG8_SA(0, 0), a2, voffA);
            PG8_BAR; PG8_WAIT_L(0); PG8_MMA(1, 0, At, B0); PG8_BAR; PG8_SCHED;
            PG8_STAGE(PG8_SB(0, 1), b2 + hB, voffB);
            PG8_WAIT_V(6); PG8_BAR; PG8_MMA(1, 1, At, B1); PG8_BAR;
            PG8_LDB(B0, 1, 0); PG8_SCHED; PG8_LDA(At, 1, 0); PG8_STAGE(PG8_SA(0, 1), a2 + hA, voffA);
            PG8_WAIT_L(8); PG8_BAR; PG8_WAIT_L(0); PG8_MMA(0, 0, At, B0); PG8_BAR; PG8_SCHED;
            PG8_LDB(B1, 1, 1); PG8_STAGE(PG8_SB(1, 0), b3, voffB);
            PG8_BAR; PG8_WAIT_L(0); PG8_MMA(0, 1, At, B1); PG8_BAR;
            PG8_LDA(At, 1, 1); PG8_STAGE(PG8_SA(1, 0), a3, voffA);
            PG8_BAR; PG8_WAIT_L(0); PG8_MMA(1, 0, At, B0); PG8_BAR; PG8_SCHED;
            PG8_STAGE(PG8_SB(1, 1), b3 + hB, voffB);
            PG8_WAIT_V(6); PG8_BAR; PG8_MMA(1, 1, At, B1); PG8_BAR;
            }
        }
        if constexpr (ALIGN_EPI) { if (wr == 0) PG8_BAR; }
        E(acc, cur, wr, wc, fr, fq);
        if (!has_next) break;
        if (!E.keep(cur)) {
#pragma unroll
        for (int a = 0; a < 2; ++a)
#pragma unroll
            for (int b = 0; b < 2; ++b)
#pragma unroll
                for (int m = 0; m < 4; ++m)
#pragma unroll
                    for (int n = 0; n < 2; ++n) acc[a][b][m][n] = (f32x4){0.f, 0.f, 0.f, 0.f};
        }
        cur = nxt; cA = nA; cB = nB; ++ui;
        if constexpr (ALIGN_EPI) { if (wr == 1) PG8_BAR; }
    }
    PG8_WAIT_V(0);
    if constexpr (!ALIGN_EPI) { if (wr == 0) PG8_BAR; }
    PG8_BAR;
#undef PG8_SA
#undef PG8_SB
#undef PG8_STAGE
#undef PG8_LDA
#undef PG8_LDB
#undef PG8_MMA
#undef PG8_WAIT_V
#undef PG8_WAIT_L
#undef PG8_BAR
#undef PG8_SCHED
}
}

#define XB_TMO      128
#define XB_XCNT(j)  (256  + 64 * (j))
#define XB_XSUB(j)  (1280 + 64 * (j))
#define XB_XGEN(j)  (2304 + 64 * (j))
#define XB_TOP      3328
#define XB_TOPGEN   3392
#define XCD_BAR_WORDS 3456
#define XB_SPIN_CAP (1u << 18)
__device__ __forceinline__ unsigned xb_ld(unsigned* p)              { return __hip_atomic_load(p, __ATOMIC_RELAXED, __HIP_MEMORY_SCOPE_AGENT); }
__device__ __forceinline__ unsigned xb_add(unsigned* p, unsigned v) { return __hip_atomic_fetch_add(p, v, __ATOMIC_RELAXED, __HIP_MEMORY_SCOPE_AGENT); }
__device__ __forceinline__ unsigned xb_xcc_id() { return (unsigned)__builtin_amdgcn_s_getreg((3 << 11) | 20) & 0xFu; }
#define XB_SPIN(cond, bar) do { unsigned _sp = 0; while (cond) { __builtin_amdgcn_s_sleep(1); \
    if ((++_sp & 255u) == 0u) { if (xb_ld(&(bar)[XB_TMO])) break; if (_sp > XB_SPIN_CAP) { atomicAdd(&(bar)[XB_TMO], 1u); break; } } } } while (0)
struct XcdBarrier { unsigned* bar; unsigned x; volatile LAS unsigned* st; };
__device__ __forceinline__ XcdBarrier xcd_barrier_post(unsigned* bar, volatile LAS unsigned* st) {
    XcdBarrier b; b.bar = bar; b.x = xb_xcc_id(); b.st = st;
    if (threadIdx.x == 0) (void)xb_add(&bar[XB_XCNT(b.x)], 1u);
    return b;
}
__device__ __forceinline__ void xcd_barrier_complete(unsigned* bar, unsigned x, unsigned& nloc, unsigned& nx) {
    const unsigned G = gridDim.x * gridDim.y * gridDim.z;
    unsigned sum, cnt, mine, sp = 0u;
    for (;;) {
        sum = 0u; cnt = 0u; mine = 0u;
#pragma unroll
        for (unsigned j = 0; j < 16; ++j) { const unsigned c = xb_ld(&bar[XB_XCNT(j)]); sum += c; cnt += (c > 0u) ? 1u : 0u; mine = (j == x) ? c : mine; }
        if (sum == G) break;
        __builtin_amdgcn_s_sleep(1);
        if ((++sp & 255u) == 0u) { if (xb_ld(&bar[XB_TMO])) break; if (sp > XB_SPIN_CAP) { atomicAdd(&bar[XB_TMO], 1u); break; } }
    }
    nloc = mine > 0u ? mine : 1u; nx = cnt > 0u ? cnt : 1u;
}
__device__ __forceinline__ void xcd_barrier(const XcdBarrier& b) {
    asm volatile("s_waitcnt vmcnt(0)" ::: "memory");
    __syncthreads();
    if (threadIdx.x == 0) {
        unsigned* bar = b.bar;
        __builtin_amdgcn_s_waitcnt(0);
        unsigned nloc = b.st[0], nx = b.st[1];
        if (nloc == 0u) { xcd_barrier_complete(bar, b.x, nloc, nx); b.st[0] = nloc; b.st[1] = nx; }
        const unsigned old = xb_add(&bar[XB_XSUB(b.x)], 1u);
        const unsigned gen = old / nloc;
        if (old + 1u == (gen + 1u) * nloc) {
            __builtin_amdgcn_fence(__ATOMIC_RELEASE, "agent");
            asm volatile("s_waitcnt vmcnt(0)" ::: "memory");
            const unsigned og = xb_add(&bar[XB_TOP], 1u);
            const unsigned tg = og / nx;
            if (og + 1u == (tg + 1u) * nx) xb_add(&bar[XB_TOPGEN], 1u);
            else XB_SPIN(xb_ld(&bar[XB_TOPGEN]) == tg, bar);
            __builtin_amdgcn_fence(__ATOMIC_ACQUIRE, "agent");
            xb_add(&bar[XB_XGEN(b.x)], 1u);
            asm volatile("s_waitcnt vmcnt(0)" ::: "memory");
        } else {
            XB_SPIN(xb_ld(&bar[XB_XGEN(b.x)]) == gen, bar);
            __builtin_amdgcn_fence(__ATOMIC_ACQUIRE, "agent");
            asm volatile("s_waitcnt vmcnt(0)" ::: "memory");
        }
    }
    __syncthreads();
}

struct Args { const float* in[33]; float* out; unsigned char* ws; };
__device__ __forceinline__ const float* inp(int i) {
    unsigned off = (unsigned)i * 8u; asm volatile("" : "+s"(off));
    typedef const float* cfp;
    return *(const __attribute__((address_space(4))) cfp*)((const __attribute__((address_space(4))) char*)__builtin_amdgcn_kernarg_segment_ptr() + off);
}

#define WSP(off) (inp_ws() + (off))
__device__ __forceinline__ unsigned char* inp_ws() { return (unsigned char*)inp(34); }
__device__ __forceinline__ float* inp_out() { return (float*)inp(33); }

__device__ __forceinline__ void transpose_item(const float* W, int ldw, int K, bf16_t* WT, int src_n0, int dst_n0, int k0, LAS float* scr, int lane) {
#pragma unroll 8
    for (int i = 0; i < 32; ++i) { const int kk = 2 * i + (lane >> 5); scr[kk * 33 + (lane & 31)] = W[(size_t)(k0 + kk) * ldw + src_n0 + (lane & 31)]; }
    LDS_WAIT(); asm volatile("" ::: "memory");
    const int c = lane & 7;
#pragma unroll
    for (int j = 0; j < 4; ++j) { const int n = (lane >> 3) + 8 * j; const LAS float* s = scr + (8 * c) * 33 + n;
        u32x4 o; o.x = pk2(s[0 * 33], s[1 * 33]); o.y = pk2(s[2 * 33], s[3 * 33]); o.z = pk2(s[4 * 33], s[5 * 33]); o.w = pk2(s[6 * 33], s[7 * 33]);
        *(u32x4*)(WT + (size_t)(dst_n0 + n) * K + k0 + 8 * c) = o; }
    LDS_WAIT(); asm volatile("" ::: "memory");
}
template <int MAP>
__device__ __forceinline__ void convert_matrix(const float* W, int ldw, int K, int Ndst, bf16_t* WT, LAS float* scr, int lane, int gw, int NGW, int& base) {
    const int nblk = Ndst / 32, nitems = (K / 64) * nblk;
    int first = (gw - base % NGW + NGW) % NGW;
    for (int it = first; it < nitems; it += NGW) {
        const int kb = it / nblk, nb = it % nblk, d0 = nb * 32;
        int s0 = d0;
        if (MAP == 1) s0 = d0 + (d0 < 1024 ? 0 : (d0 < 2560 ? 16 : 24));
        if (MAP == 2) { const int pn = d0 >> 8, hh = (d0 & 255) >> 7, r = d0 & 127; s0 = hh * FF + pn * 128 + r; }
        transpose_item(W, ldw, K, WT, s0, d0, kb * 64, scr, lane);
    }
    base += nitems;
}

__device__ __forceinline__ void ada_phase(LAS unsigned char* lds, int blk, int wave, int lane) {
    if (blk >= 192) return;
    const int l = blk / 96, n0 = (blk % 96) * 64;
    const float* c = inp(1); const float* W = inp(2) + (size_t)l * 1024 * 6144; const float* bias = inp(3) + l * 6144;
    LAS float* part = (LAS float*)lds;
    float acc[8] = {0.f, 0.f, 0.f, 0.f, 0.f, 0.f, 0.f, 0.f};
    for (int k = wave * 128; k < wave * 128 + 128; ++k) {
        const float wv = W[(size_t)k * 6144 + n0 + lane];
#pragma unroll
        for (int b = 0; b < 8; ++b) { const float cv = c[b * 1024 + k]; acc[b] += siluf_(cv) * wv; }
    }
#pragma unroll
    for (int b = 0; b < 8; ++b) part[(wave * 8 + b) * 64 + lane] = acc[b];
    __syncthreads();
    {
        const int b = wave; float s = bias[n0 + lane];
#pragma unroll
        for (int w = 0; w < 8; ++w) s += part[(w * 8 + b) * 64 + lane];
        ((float*)WSP(WS_MOD))[(size_t)(l * 8 + b) * 6144 + n0 + lane] = s;
    }
    __syncthreads();
}

template <bool WITH_ZS>
__device__ __forceinline__ void prenorm_rows(const float* x, const float* w, const float* modl, int sh_off, int sc_off, bf16_t* H, float* ZS, const LAS float* wsm, int gw, int NGW, int lane) {
    for (int row = gw; row < M; row += NGW) {
        const int b = row / T;
        const f32x4* xr = (const f32x4*)(x + (size_t)row * D);
        f32x4 v[4]; float ss = 0.f;
#pragma unroll
        for (int j = 0; j < 4; ++j) { v[j] = xr[lane + 64 * j]; ss += v[j][0] * v[j][0] + v[j][1] * v[j][1] + v[j][2] * v[j][2] + v[j][3] * v[j][3]; }
        ss = wave_sum(ss);
        const float r = rsqrtf(ss * (1.f / D) + 1e-6f);
        const float* sh = modl + (size_t)b * 6144 + sh_off; const float* sc = modl + (size_t)b * 6144 + sc_off;
#pragma unroll
        for (int j = 0; j < 4; ++j) {
            const int col = (lane + 64 * j) * 4;
            const f32x4 wv = *(const f32x4*)(w + col), scv = *(const f32x4*)(sc + col), shv = *(const f32x4*)(sh + col);
#pragma unroll
            for (int e = 0; e < 4; ++e) v[j][e] = v[j][e] * r * wv[e] * (1.f + scv[e]) + shv[e];
            u32x2 o; o.x = pk2(v[j][0], v[j][1]); o.y = pk2(v[j][2], v[j][3]);
            *(u32x2*)(H + (size_t)row * D + col) = o;
        }
        if (WITH_ZS) {
            float res = 0.f;
#pragma unroll 4
            for (int c = 0; c < 24; ++c) {
                float p = 0.f;
#pragma unroll
                for (int j = 0; j < 4; ++j) { const f32x4 wv = *(const LAS f32x4*)(wsm + c * 1024 + (lane + 64 * j) * 4); p += v[j][0] * wv[0] + v[j][1] * wv[1] + v[j][2] * wv[2] + v[j][3] * wv[3]; }
                p = wave_sum(p);
                res = (lane == c) ? p : res;
            }
            if (lane < 24) ZS[(size_t)row * 32 + lane] = res;
        }
    }
}
template <bool WITH_PRE, bool WITH_ZS>
__device__ __forceinline__ void postpre_rows(const bf16_t* Y, int ldy, const float* xold, const float* pw, const float* modl_post, int gt_off, float* xout,
                                             const float* w2, const float* modl_pre, int sh_off, int sc_off, bf16_t* H, float* ZS, const LAS float* wsm, int gw, int NGW, int lane) {
    for (int row = gw; row < M; row += NGW) {
        const int b = row / T;
        f32x4 v[4]; float ss = 0.f;
#pragma unroll
        for (int j = 0; j < 4; ++j) { const u32x2 y = *(const u32x2*)(Y + (size_t)row * ldy + (lane + 64 * j) * 4);
            v[j] = (f32x4){bflo(y.x), bfhi(y.x), bflo(y.y), bfhi(y.y)}; ss += v[j][0] * v[j][0] + v[j][1] * v[j][1] + v[j][2] * v[j][2] + v[j][3] * v[j][3]; }
        ss = wave_sum(ss);
        const float r = rsqrtf(ss * (1.f / D) + 1e-6f);
        const float* gt = modl_post + (size_t)b * 6144 + gt_off;
        float ss2 = 0.f;
#pragma unroll
        for (int j = 0; j < 4; ++j) {
            const int col = (lane + 64 * j) * 4;
            const f32x4 xo = *(const f32x4*)(xold + (size_t)row * D + col), pwv = *(const f32x4*)(pw + col), gtv = *(const f32x4*)(gt + col);
#pragma unroll
            for (int e = 0; e < 4; ++e) { v[j][e] = xo[e] + (1.f + gtv[e]) * (v[j][e] * r * pwv[e]); ss2 += v[j][e] * v[j][e]; }
            *(f32x4*)(xout + (size_t)row * D + col) = v[j];
        }
        if (WITH_PRE) {
            ss2 = wave_sum(ss2);
            const float r2 = rsqrtf(ss2 * (1.f / D) + 1e-6f);
            const float* sh = modl_pre + (size_t)b * 6144 + sh_off; const float* sc = modl_pre + (size_t)b * 6144 + sc_off;
#pragma unroll
            for (int j = 0; j < 4; ++j) {
                const int col = (lane + 64 * j) * 4;
                const f32x4 wv = *(const f32x4*)(w2 + col), scv = *(const f32x4*)(sc + col), shv = *(const f32x4*)(sh + col);
#pragma unroll
                for (int e = 0; e < 4; ++e) v[j][e] = v[j][e] * r2 * wv[e] * (1.f + scv[e]) + shv[e];
                u32x2 o; o.x = pk2(v[j][0], v[j][1]); o.y = pk2(v[j][2], v[j][3]);
                *(u32x2*)(H + (size_t)row * D + col) = o;
            }
            if (WITH_ZS) {
                float res = 0.f;
#pragma unroll 4
                for (int c = 0; c < 24; ++c) {
                    float p = 0.f;
#pragma unroll
                    for (int j = 0; j < 4; ++j) { const f32x4 wv = *(const LAS f32x4*)(wsm + c * 1024 + (lane + 64 * j) * 4); p += v[j][0] * wv[0] + v[j][1] * wv[1] + v[j][2] * wv[2] + v[j][3] * wv[3]; }
                    p = wave_sum(p);
                    res = (lane == c) ? p : res;
                }
                if (lane < 24) ZS[(size_t)row * 32 + lane] = res;
            }
        }
    }
}
__device__ __forceinline__ void stage_wsmall(const float* w_in, LAS float* wsm, int tid) {
    for (int k = tid; k < 1024; k += NWAVES * 64) {
        const float* src = w_in + (size_t)k * INDIM;
#pragma unroll
        for (int c = 0; c < 16; ++c) wsm[c * 1024 + k] = src[1024 + c];
#pragma unroll
        for (int c = 0; c < 8; ++c) wsm[(16 + c) * 1024 + k] = src[2576 + c];
    }
    __syncthreads();
}

__device__ __forceinline__ void seq_gla_mlstm(int l, LAS unsigned char* lds, int bh) {
    int tid0 = threadIdx.x; asm volatile("" : "+v"(tid0));
    const int b = bh >> 2, h = bh & 3, role = tid0 >> 8, tid = tid0 & 255, j = tid & 127, half = tid >> 7;
    bf16_t* Z = (bf16_t*)WSP(WS_Z); const float* ZS = (const float*)WSP(WS_ZS);
    LAS float* sm = (LAS float*)lds + role * 1024;
    LAS float* q = sm; LAS float* k = sm + 64; LAS float* eg = sm + 128; LAS float* v = sm + 192; LAS float* part = sm + 320; LAS float* red = sm + 576;
    float St[32];
#pragma unroll
    for (int i = 0; i < 32; ++i) St[i] = 0.f;
    float a2c[16]; float abd = 0.f, nwj = 0.f;
#pragma unroll
    for (int r = 0; r < 16; ++r) a2c[r] = 0.f;
    float w4[4] = {0.f, 0.f, 0.f, 0.f}, wb = 0.f, ibh = 0.f, fbh = 0.f, nreg = 0.f, mrun = 0.f; int zcol = 0;
    if (role == 0) {
        const float* a2 = inp(9) + l * 16 * 256; const float* ab = inp(10) + l * 256;
        if (tid < 64) { for (int r = 0; r < 16; ++r) a2c[r] = a2[r * 256 + h * 64 + tid]; abd = ab[h * 64 + tid]; }
        nwj = (inp(11) + l * 512)[h * 128 + j];
    } else {
        const float* cw = inp(12) + l * 4 * 512; const float* cb = inp(13) + l * 512;
        if (tid < 128) {
            const int c = (tid < 64) ? (h * 64 + tid) : (256 + h * 64 + (tid - 64));
            for (int jj = 0; jj < 4; ++jj) w4[jj] = cw[jj * 512 + c];
            wb = cb[c];
            zcol = (tid < 64) ? (MQ + h * 64 + tid) : (MK + h * 64 + (tid - 64));
        }
        ibh = (inp(14) + l * 4)[h]; fbh = (inp(15) + l * 4)[h];
    }
    for (int t = 0; t < T; ++t) {
        const size_t m = (size_t)b * T + t;
        bf16_t* zr = Z + m * ZLD;
        float mnew = 0.f, fdec = 0.f, iw = 0.f;
        if (role == 0) {
            if (tid < 64) {
                const float* zs = ZS + m * 32;
                float xg = abd;
#pragma unroll
                for (int r = 0; r < 16; ++r) xg += zs[r] * a2c[r];
                eg[tid] = expf(logsigmoidf_(xg) * (1.f / 16.f));
                q[tid] = bf2f(zr[GQ + h * 64 + tid]) * 0.125f;
                k[tid] = bf2f(zr[GK + h * 64 + tid]);
            } else if (tid >= 128) v[j] = bf2f(zr[GV + h * 128 + j]);
        } else {
            if (tid < 128) {
                float acc = wb;
#pragma unroll
                for (int jj = 0; jj < 4; ++jj) { const int tt = t - 3 + jj; if (tt >= 0) acc += w4[jj] * bf2f(Z[((size_t)b * T + tt) * ZLD + zcol]); }
                const float s = siluf_(acc);
                if (tid < 64) q[tid] = s; else k[tid - 64] = s * 0.125f;
            } else v[j] = bf2f(zr[MV + h * 128 + j]);
            const float ip = ZS[m * 32 + 16 + h] + ibh, fp = ZS[m * 32 + 20 + h] + fbh;
            const float lf = logsigmoidf_(fp);
            mnew = fmaxf(lf + mrun, ip); fdec = expf(lf + mrun - mnew); iw = expf(ip - mnew);
        }
        __syncthreads();
        {
            const float vj = v[j]; float op = 0.f;
            if (role == 0) {
#pragma unroll
                for (int dd = 0; dd < 32; ++dd) { const int d = half * 32 + dd; St[dd] = eg[d] * St[dd] + k[d] * vj; op += q[d] * St[dd]; }
            } else {
#pragma unroll
                for (int dd = 0; dd < 32; ++dd) { const int d = half * 32 + dd; St[dd] = fdec * St[dd] + iw * k[d] * vj; op += q[d] * St[dd]; }
                if (tid < 64) { nreg = fdec * nreg + iw * k[tid]; const float dp = wave_sum(q[tid] * nreg); if (tid == 0) red[2] = dp; }
            }
            part[half * 128 + j] = op;
        }
        __syncthreads();
        if (role == 0 && tid < 128) {
            const float o = part[j] + part[128 + j];
            const float ss = wave_sum(o * o);
            if ((tid & 63) == 0) red[tid >> 6] = ss;
        }
        __syncthreads();
        if (tid < 128) {
            const float o = part[j] + part[128 + j];
            if (role == 0) {
                const float r = rsqrtf((red[0] + red[1]) * (1.f / 128.f) + 1e-6f);
                const float gr = bf2f(zr[GR + h * 128 + j]);
                zr[YGLA + h * 128 + j] = (bf16_t)f2bf(o * r * nwj * siluf_(gr));
            } else {
                const float hh = o / fmaxf(fabsf(red[2]), expf(-mnew));
                const float mo = bf2f(zr[MO + h * 128 + j]);
                zr[YML + h * 128 + j] = (bf16_t)f2bf(sigmoidf_(mo) * hh);
            }
        }
        mrun = mnew;
        __syncthreads();
    }
}
__device__ __forceinline__ void seq_s5(int l, LAS unsigned char* ldsw, int bg, int p) {
    const int b = bg >> 5, g = bg & 31;
    bf16_t* Z = (bf16_t*)WSP(WS_Z);
    LAS float* us = (LAS float*)ldsw;
    LAS float* xr = us + 64 * 17;
    LAS float* xi = xr + 64 * 65;
    LAS float* cr = xi + 64 * 65;
    LAS float* ci = cr + 16 * 64;
    const float* lam_re = inp(16) + l * 2048; const float* lam_im = inp(17) + l * 2048; const float* log_step = inp(18) + l * 32;
    const float* b_re = inp(19) + (size_t)l * 32768; const float* b_im = inp(20) + (size_t)l * 32768;
    const float* c_re = inp(21) + (size_t)l * 32768; const float* c_im = inp(22) + (size_t)l * 32768; const float* dsk = inp(23) + l * 512;
    const float lre = fminf(lam_re[g * 64 + p], -1e-4f), lim = lam_im[g * 64 + p], dt = expf(log_step[g]);
    const float mag = expf(lre * dt), ar = mag * cosf(lim * dt), ai = mag * sinf(lim * dt);
    const float inv = 1.f / (lre * lre + lim * lim);
    const float zr_ = ((ar - 1.f) * lre + ai * lim) * inv, zi_ = (ai * lre - (ar - 1.f) * lim) * inv;
    float bbr[16], bbi[16], dk[16];
#pragma unroll
    for (int c = 0; c < 16; ++c) {
        const float br = b_re[(size_t)(g * 64 + p) * 16 + c], bi = b_im[(size_t)(g * 64 + p) * 16 + c];
        bbr[c] = zr_ * br - zi_ * bi; bbi[c] = zr_ * bi + zi_ * br;
        cr[c * 64 + p] = c_re[(size_t)(g * 16 + c) * 64 + p]; ci[c * 64 + p] = c_im[(size_t)(g * 16 + c) * 64 + p];
        dk[c] = dsk[g * 16 + c];
    }
    float xre = 0.f, xim = 0.f;
    for (int ch = 0; ch < T / 64; ++ch) {
        const size_t m0 = (size_t)b * T + ch * 64;
        bf16_t* zp = Z + (m0 + p) * ZLD + SU + g * 16;
#pragma unroll
        for (int c = 0; c < 16; ++c) us[p * 17 + c] = bf2f(zp[c]);
        LDS_WAIT(); asm volatile("" ::: "memory");
        for (int t = 0; t < 64; ++t) {
            float bur = 0.f, bui = 0.f;
#pragma unroll
            for (int c = 0; c < 16; ++c) { const float u = us[t * 17 + c]; bur += bbr[c] * u; bui += bbi[c] * u; }
            const float nr = ar * xre - ai * xim + bur, ni = ar * xim + ai * xre + bui;
            xre = nr; xim = ni; xr[t * 65 + p] = nr; xi[t * 65 + p] = ni;
        }
        LDS_WAIT(); asm volatile("" ::: "memory");
#pragma unroll 1
        for (int c = 0; c < 16; ++c) {
            float y = 0.f;
            for (int pp = 0; pp < 64; ++pp) y += cr[c * 64 + pp] * xr[p * 65 + pp] - ci[c * 64 + pp] * xi[p * 65 + pp];
            y += dk[c] * us[p * 17 + c];
            zp[c] = (bf16_t)f2bf(gelu_tanh(y));
        }
        LDS_WAIT(); asm volatile("" ::: "memory");
    }
}


namespace mx {
typedef float f32x16 __attribute__((ext_vector_type(16)));
constexpr int PB = 72;
constexpr int L_QS = 0, L_KS = 9216, L_KT = 18432, L_VT = 27648, L_PS = 46080, L_ST = 55296, L_OS = 73728, L_VEC = 107520;
constexpr int OSP = 132;
constexpr int V_SEG = 0, V_ELAST = 512, V_GA = 576, V_RT = 1600, V_CS = 1664, V_WI = 1728, V_WK = 1792, V_ENM = 1856, V_DEN = 1920, V_NORM = 1984, V_SC = 2112, V_END = 2128;
static_assert(L_VEC + V_END * 4 <= RING_BYTES, "mixer LDS map");
__device__ __forceinline__ int crow(int reg, int hh) { return (reg & 3) + 8 * (reg >> 2) + 4 * hh; }
__device__ __forceinline__ float fexp(float x) { return __builtin_amdgcn_exp2f(1.4426950408889634f * x); }
__device__ __forceinline__ float flogsig(float x) { const float e = fexp(-fabsf(x)); return fminf(x, 0.f) - 0.6931471805599453f * __builtin_amdgcn_logf(1.f + e); }
#define MX_MFMA(a, b, c) __builtin_amdgcn_mfma_f32_32x32x16_bf16((a), (b), (c), 0, 0, 0)

template <int ROLE>
__device__ __forceinline__ void stream(int l, LAS unsigned char* lds, int bh) {
    int tid = threadIdx.x; asm volatile("" : "+v"(tid));
    const int lane = tid & 63, w = __builtin_amdgcn_readfirstlane(tid >> 6), r32 = lane & 31, hh = lane >> 5;
    const int b = bh >> 2, h = bh & 3;
    bf16_t* Z = (bf16_t*)WSP(WS_Z); const float* ZS = (const float*)WSP(WS_ZS);
    LAS float* vec = (LAS float*)(lds + L_VEC);
    LAS bf16_t* Qs = (LAS bf16_t*)(lds + L_QS); LAS bf16_t* Ks = (LAS bf16_t*)(lds + L_KS); LAS bf16_t* KTs = (LAS bf16_t*)(lds + L_KT);
    LAS bf16_t* VTs = (LAS bf16_t*)(lds + L_VT); LAS bf16_t* Ps = (LAS bf16_t*)(lds + L_PS); LAS bf16_t* STs = (LAS bf16_t*)(lds + L_ST);
    LAS float* Os = (LAS float*)(lds + L_OS);
    const int qcol = (ROLE == 0 ? GQ : MQ) + h * 64, kcol = (ROLE == 0 ? GK : MK) + h * 64, vcol = (ROLE == 0 ? GV : MV) + h * 128, gcol = (ROLE == 0 ? GR : MO) + h * 128;
    const int vc_ = tid & 127, rq = tid >> 7, et = tid >> 3, cg = tid & 7;
    const int wa = w >> 2, wv = w & 3;
    float a2c[16], abd = 0.f, nwv[16];
    float cwq[4], cwk[4], cbq = 0.f, cbk = 0.f, ibh = 0.f, fbh = 0.f, mprev = 0.f;
#pragma unroll
    for (int r = 0; r < 16; ++r) { a2c[r] = 0.f; nwv[r] = 0.f; }
#pragma unroll
    for (int j = 0; j < 4; ++j) { cwq[j] = 0.f; cwk[j] = 0.f; }
    if (ROLE == 0) {
        const float* a2 = inp(9) + l * 16 * 256; const float* ab = inp(10) + l * 256; const float* nw = inp(11) + l * 512;
#pragma unroll
        for (int r = 0; r < 16; ++r) { a2c[r] = a2[r * 256 + h * 64 + lane]; nwv[r] = nw[h * 128 + 16 * cg + r]; }
        abd = ab[h * 64 + lane];
    } else {
        const float* cw = inp(12) + l * 4 * 512; const float* cb = inp(13) + l * 512;
#pragma unroll
        for (int j = 0; j < 4; ++j) { cwq[j] = cw[j * 512 + h * 64 + lane]; cwk[j] = cw[j * 512 + 256 + h * 64 + lane]; }
        cbq = cb[h * 64 + lane]; cbk = cb[256 + h * 64 + lane];
        ibh = (inp(14) + l * 4)[h]; fbh = (inp(15) + l * 4)[h];
    }
    for (int i = tid; i < 128 * PB / 2; i += 512) ((LAS unsigned*)STs)[i] = 0u;
    for (int i = tid; i < 64 * PB / 2; i += 512) ((LAS unsigned*)Ps)[i] = 0u;
    if (tid < 128) vec[V_NORM + tid] = 0.f;
    f32x16 accS;
#pragma unroll
    for (int r = 0; r < 16; ++r) accS[r] = 0.f;
    unsigned short qi[11], ki[11], vi[16]; float zs0 = 0.f, zs1 = 0.f; u32x4 gt0 = {0u, 0u, 0u, 0u}, gt1 = {0u, 0u, 0u, 0u};
#define MX_LOAD(mrow, nn) do { \
        if (ROLE == 0) { \
            _Pragma("unroll") for (int i = 0; i < 8; ++i) { const bf16_t* zr = Z + ((mrow) + 8 * w + i) * ZLD; qi[i] = zr[qcol + lane]; ki[i] = zr[kcol + lane]; } \
            const float* zp = ZS + ((mrow) + et) * 32 + 2 * cg; zs0 = zp[0]; zs1 = zp[1]; \
        } else { \
            _Pragma("unroll") for (int i = 0; i < 11; ++i) { const int trel = 8 * w + i - 3; const bool ok = ((nn) > 0) || (trel >= 0); \
                const bf16_t* zr = Z + ((mrow) + trel) * ZLD; qi[i] = ok ? zr[qcol + lane] : (unsigned short)0; ki[i] = ok ? zr[kcol + lane] : (unsigned short)0; } \
            if (w == 0) { const float* zp = ZS + ((mrow) + lane) * 32; zs0 = zp[16 + h]; zs1 = zp[20 + h]; } \
        } \
        _Pragma("unroll") for (int i = 0; i < 16; ++i) vi[i] = Z[((mrow) + 16 * rq + i) * ZLD + vcol + vc_]; \
    } while (0)
    size_t m0 = (size_t)b * T;
    MX_LOAD(m0, 0);
    if (ROLE == 0) { vec[V_GA + et * 16 + 2 * cg] = zs0; vec[V_GA + et * 16 + 2 * cg + 1] = zs1; }
    __syncthreads();

#pragma unroll 1
    for (int n = 0; n <= 64; ++n) {
        if (n > 0) {
            const size_t mp = m0 - 64;
            const LAS float* orow = Os + et * OSP + 16 * cg;
            float o[16];
#pragma unroll
            for (int q4 = 0; q4 < 4; ++q4) { const f32x4 t4 = *(const LAS f32x4*)(orow + 4 * q4); o[4 * q4] = t4[0]; o[4 * q4 + 1] = t4[1]; o[4 * q4 + 2] = t4[2]; o[4 * q4 + 3] = t4[3]; }
            const unsigned gw_[8] = {gt0.x, gt0.y, gt0.z, gt0.w, gt1.x, gt1.y, gt1.z, gt1.w};
            float y[16];
            if (ROLE == 0) {
                float ss = 0.f;
#pragma unroll
                for (int e = 0; e < 16; ++e) ss += o[e] * o[e];
                ss += __shfl_xor(ss, 1); ss += __shfl_xor(ss, 2); ss += __shfl_xor(ss, 4);
                const float rn = rsqrtf(ss * (1.f / 128.f) + 1e-6f);
#pragma unroll
                for (int e = 0; e < 16; ++e) { const float g = (e & 1) ? bfhi(gw_[e >> 1]) : bflo(gw_[e >> 1]); y[e] = o[e] * rn * nwv[e] * g * fsigmoid(g); }
            } else {
                const float rdiv = vec[V_DEN + et];
#pragma unroll
                for (int e = 0; e < 16; ++e) { const float g = (e & 1) ? bfhi(gw_[e >> 1]) : bflo(gw_[e >> 1]); y[e] = o[e] * rdiv * fsigmoid(g); }
            }
            u32x4 s0, s1;
            s0.x = pk2(y[0], y[1]); s0.y = pk2(y[2], y[3]); s0.z = pk2(y[4], y[5]); s0.w = pk2(y[6], y[7]);
            s1.x = pk2(y[8], y[9]); s1.y = pk2(y[10], y[11]); s1.z = pk2(y[12], y[13]); s1.w = pk2(y[14], y[15]);
            bf16_t* dst = Z + (mp + et) * ZLD + gcol + 16 * cg;
            *(u32x4*)dst = s0; *(u32x4*)(dst + 8) = s1;
        }
        if (n == 64) break;
        float c8[8], qf[8], kf[8];
        if (ROLE == 0) {
            float run = 0.f;
#pragma unroll
            for (int i = 0; i < 8; ++i) {
                const LAS f32x4* gp = (const LAS f32x4*)(vec + V_GA + (8 * w + i) * 16);
                float x = abd;
#pragma unroll
                for (int r4 = 0; r4 < 4; ++r4) { const f32x4 g4 = gp[r4]; x += g4[0] * a2c[4 * r4] + g4[1] * a2c[4 * r4 + 1] + g4[2] * a2c[4 * r4 + 2] + g4[3] * a2c[4 * r4 + 3]; }
                run += flogsig(x) * (1.f / 16.f); c8[i] = run;
                qf[i] = bf2f(qi[i]) * 0.125f; kf[i] = bf2f(ki[i]);
            }
            vec[V_SEG + w * 64 + lane] = run;
        } else {
#pragma unroll
            for (int i = 0; i < 8; ++i) {
                float aq = cbq, ak = cbk;
#pragma unroll
                for (int j = 0; j < 4; ++j) { aq += cwq[j] * bf2f(qi[i + j]); ak += cwk[j] * bf2f(ki[i + j]); }
                qf[i] = aq * fsigmoid(aq); kf[i] = ak * fsigmoid(ak) * 0.125f; c8[i] = 0.f;
            }
            if (w == 0) {
                const float ip = zs0 + ibh, lf = logsigmoidf_(zs1 + fbh);
                float bs = lf;
#pragma unroll
                for (int o = 1; o < 64; o <<= 1) { const float t = __shfl_up(bs, o); if (lane >= o) bs += t; }
                const float cs = ip - bs;
                float pm = cs;
#pragma unroll
                for (int o = 1; o < 64; o <<= 1) { const float t = __shfl_up(pm, o); if (lane >= o) pm = fmaxf(pm, t); }
                const float mt = bs + fmaxf(mprev, pm);
                vec[V_RT + lane] = bs - mt; vec[V_CS + lane] = cs; vec[V_WI + lane] = expf(bs + mprev - mt); vec[V_ENM + lane] = expf(-mt);
                const float mnew = __shfl(mt, 63), b63 = __shfl(bs, 63);
                vec[V_WK + lane] = expf(b63 + cs - mnew);
                if (lane == 0) vec[V_SC] = expf(b63 + mprev - mnew);
                mprev = mnew;
            }
        }
        __syncthreads();
        {
            u32x4 ktp; unsigned ktw[4];
            if (ROLE == 0) {
                float off = 0.f, tot = 0.f;
#pragma unroll
                for (int w2 = 0; w2 < 8; ++w2) { const float s = vec[V_SEG + w2 * 64 + lane]; tot += s; off += (w2 < w) ? s : 0.f; }
                if (w == 0) vec[V_ELAST + lane] = fexp(tot);
                float kt[8];
#pragma unroll
                for (int i = 0; i < 8; ++i) {
                    const float cum = off + c8[i];
                    Qs[(8 * w + i) * PB + lane] = (bf16_t)f2bf(qf[i] * fexp(cum));
                    Ks[(8 * w + i) * PB + lane] = (bf16_t)f2bf(kf[i] * fexp(-cum));
                    kt[i] = kf[i] * fexp(tot - cum);
                }
#pragma unroll
                for (int i = 0; i < 4; ++i) ktw[i] = pk2(kt[2 * i], kt[2 * i + 1]);
            } else {
                float kt[8];
#pragma unroll
                for (int i = 0; i < 8; ++i) {
                    Qs[(8 * w + i) * PB + lane] = (bf16_t)f2bf(qf[i]);
                    Ks[(8 * w + i) * PB + lane] = (bf16_t)f2bf(kf[i]);
                    kt[i] = kf[i] * vec[V_WK + 8 * w + i];
                }
#pragma unroll
                for (int i = 0; i < 4; ++i) ktw[i] = pk2(kt[2 * i], kt[2 * i + 1]);
            }
            ktp.x = ktw[0]; ktp.y = ktw[1]; ktp.z = ktw[2]; ktp.w = ktw[3];
            *(LAS u32x4*)(KTs + lane * PB + 8 * w) = ktp;
            u32x4 v0, v1;
            v0.x = vi[0] | ((unsigned)vi[1] << 16); v0.y = vi[2] | ((unsigned)vi[3] << 16); v0.z = vi[4] | ((unsigned)vi[5] << 16); v0.w = vi[6] | ((unsigned)vi[7] << 16);
            v1.x = vi[8] | ((unsigned)vi[9] << 16); v1.y = vi[10] | ((unsigned)vi[11] << 16); v1.z = vi[12] | ((unsigned)vi[13] << 16); v1.w = vi[14] | ((unsigned)vi[15] << 16);
            *(LAS u32x4*)(VTs + vc_ * PB + 16 * rq) = v0; *(LAS u32x4*)(VTs + vc_ * PB + 16 * rq + 8) = v1;
        }
        __syncthreads();
        { const bf16_t* gp = Z + (m0 + et) * ZLD + gcol + 16 * cg; gt0 = *(const u32x4*)gp; gt1 = *(const u32x4*)(gp + 8); }
        if (n < 63) MX_LOAD(m0 + 64, n + 1);
#define MX_FRAG(base, row, ks) (*(const LAS bf16x8*)(lds + (base) + ((row) * PB + 16 * (ks) + 8 * hh) * 2))
        if (w < 3) {
            const int ti = (w >= 1) ? 1 : 0, sj = (w == 2) ? 1 : 0;
            f32x16 sc;
#pragma unroll
            for (int r = 0; r < 16; ++r) sc[r] = 0.f;
#pragma unroll
            for (int ks = 0; ks < 4; ++ks) sc = MX_MFMA(MX_FRAG(L_QS, 32 * ti + r32, ks), MX_FRAG(L_KS, 32 * sj + r32, ks), sc);
            const float csv = (ROLE == 1) ? vec[V_CS + 32 * sj + r32] : 0.f;
#pragma unroll
            for (int r = 0; r < 16; ++r) {
                const int t = crow(r, hh);
                const bool keep = (ti != sj) || (r32 <= t);
                float val = sc[r];
                if (ROLE == 1) val *= expf(vec[V_RT + 32 * ti + t] + csv);
                Ps[(32 * ti + t) * PB + 32 * sj + r32] = (bf16_t)f2bf(keep ? val : 0.f);
            }
        }
        f32x16 acco;
#pragma unroll
        for (int r = 0; r < 16; ++r) acco[r] = 0.f;
#pragma unroll
        for (int ks = 0; ks < 4; ++ks) acco = MX_MFMA(MX_FRAG(L_QS, 32 * wa + r32, ks), MX_FRAG(L_ST, 32 * wv + r32, ks), acco);
        if (ROLE == 1) {
#pragma unroll
            for (int r = 0; r < 16; ++r) acco[r] *= vec[V_WI + 32 * wa + crow(r, hh)];
        }
        if (ROLE == 0) {
#pragma unroll
            for (int r = 0; r < 16; ++r) accS[r] *= vec[V_ELAST + 32 * wa + crow(r, hh)];
        } else {
            const float carry = vec[V_SC];
#pragma unroll
            for (int r = 0; r < 16; ++r) accS[r] *= carry;
        }
#pragma unroll
        for (int ks = 0; ks < 4; ++ks) accS = MX_MFMA(MX_FRAG(L_KT, 32 * wa + r32, ks), MX_FRAG(L_VT, 32 * wv + r32, ks), accS);
        __syncthreads();
        if (wa == 0) {
#pragma unroll
            for (int ks = 0; ks < 2; ++ks) acco = MX_MFMA(MX_FRAG(L_PS, r32, ks), MX_FRAG(L_VT, 32 * wv + r32, ks), acco);
        } else {
#pragma unroll
            for (int ks = 0; ks < 4; ++ks) acco = MX_MFMA(MX_FRAG(L_PS, 32 + r32, ks), MX_FRAG(L_VT, 32 * wv + r32, ks), acco);
        }
#pragma unroll
        for (int r = 0; r < 16; ++r) Os[(32 * wa + crow(r, hh)) * OSP + 32 * wv + r32] = acco[r];
#pragma unroll
        for (int q4 = 0; q4 < 4; ++q4) { u32x2 p; p.x = pk2(accS[4 * q4], accS[4 * q4 + 1]); p.y = pk2(accS[4 * q4 + 2], accS[4 * q4 + 3]);
            *(LAS u32x2*)(STs + (32 * wv + r32) * PB + 32 * wa + 8 * q4 + 4 * hh) = p; }
        if (ROLE == 0) { if (n < 63) { vec[V_GA + et * 16 + 2 * cg] = zs0; vec[V_GA + et * 16 + 2 * cg + 1] = zs1; } }
        else {
            const LAS float* nprev = vec + V_NORM + (n & 1) * 64;
            if (w == 0) {
                float qn = 0.f, si = 0.f;
#pragma unroll
                for (int c8i = 0; c8i < 8; ++c8i) {
                    const u32x4 qv = *(const LAS u32x4*)(Qs + lane * PB + 8 * c8i), pv = *(const LAS u32x4*)(Ps + lane * PB + 8 * c8i);
                    const f32x4 n0 = *(const LAS f32x4*)(nprev + 8 * c8i), n1 = *(const LAS f32x4*)(nprev + 8 * c8i + 4);
                    qn += bflo(qv.x) * n0[0] + bfhi(qv.x) * n0[1] + bflo(qv.y) * n0[2] + bfhi(qv.y) * n0[3] + bflo(qv.z) * n1[0] + bfhi(qv.z) * n1[1] + bflo(qv.w) * n1[2] + bfhi(qv.w) * n1[3];
                    si += (bflo(pv.x) + bfhi(pv.x)) + (bflo(pv.y) + bfhi(pv.y)) + (bflo(pv.z) + bfhi(pv.z)) + (bflo(pv.w) + bfhi(pv.w));
                }
                const float den = vec[V_WI + lane] * qn + si;
                vec[V_DEN + lane] = 1.f / fmaxf(fabsf(den), vec[V_ENM + lane]);
            } else if (w == 1) {
                float kn = 0.f;
#pragma unroll
                for (int c8i = 0; c8i < 8; ++c8i) { const u32x4 kv = *(const LAS u32x4*)(KTs + lane * PB + 8 * c8i);
                    kn += (bflo(kv.x) + bfhi(kv.x)) + (bflo(kv.y) + bfhi(kv.y)) + (bflo(kv.z) + bfhi(kv.z)) + (bflo(kv.w) + bfhi(kv.w)); }
                vec[V_NORM + ((n + 1) & 1) * 64 + lane] = vec[V_SC] * nprev[lane] + kn;
            }
        }
        __syncthreads();
        m0 += 64;
    }
#undef MX_LOAD
#undef MX_FRAG
}
}

#ifndef PHASE_MASK
#define PHASE_MASK 0xFFFF
#endif
#define PH(k) if constexpr ((PHASE_MASK >> (k)) & 1)
#define PHASE_ENV int tid = threadIdx.x; asm volatile("" : "+v"(tid)); const int lane = tid & 63, wave = __builtin_amdgcn_readfirstlane(tid >> 6); const int gw = vcu * NWAVES + wave; (void)lane; (void)gw;
__global__ void __launch_bounds__(NWAVES * 64, 2) mega_fwd(Args args) {
    extern __shared__ __attribute__((aligned(16))) unsigned char lds_raw[];
    LAS unsigned char* lds = (LAS unsigned char*)lds_raw;
    const int G = gridDim.x, blk = blockIdx.x;
    const int vcu = (G % 8 == 0) ? (blk % 8) * (G / 8) + blk / 8 : blk;
    const int NGW = G * NWAVES;
    for (int u = threadIdx.x; u < (LDS_BYTES - LDSCTL_OFF) / 4; u += NWAVES * 64) ((LAS unsigned*)(lds + LDSCTL_OFF))[u] = 0u;
    __syncthreads();
    XcdBarrier bar = xcd_barrier_post((unsigned*)(args.ws + WS_CTL) + CW_BAR, (volatile LAS unsigned*)(lds + MISC_OFF) + 8);
#define GRID_BAR() xcd_barrier(bar)

    PH(0) { PHASE_ENV
        ada_phase(lds, blk, wave, lane);
        LAS float* scr = (LAS float*)(lds + wave * 16384);
        int base = 0;
        convert_matrix<1>(inp(8), INDIM, 1024, ZLD, (bf16_t*)WSP(WS_WIN), scr, lane, gw, NGW, base);
        convert_matrix<0>(inp(24), 512, 512, 512, (bf16_t*)WSP(WS_WGLU), scr, lane, gw, NGW, base);
        convert_matrix<0>(inp(26), 1024, 512, 1024, (bf16_t*)WSP(WS_WPROJ), scr, lane, gw, NGW, base);
        convert_matrix<0>(inp(27), 1024, 512, 1024, (bf16_t*)WSP(WS_WPROJ) + 1024 * 512, scr, lane, gw, NGW, base);
        convert_matrix<0>(inp(28), 1024, 512, 1024, (bf16_t*)WSP(WS_WPROJ) + 2 * 1024 * 512, scr, lane, gw, NGW, base);
        convert_matrix<0>(inp(30), 1024, 1024, 1024, (bf16_t*)WSP(WS_WOUT), scr, lane, gw, NGW, base);
        convert_matrix<0>(inp(32), 1024, FF, 1024, (bf16_t*)WSP(WS_WFO), scr, lane, gw, NGW, base);
    }
    GRID_BAR();

#pragma unroll 1
    for (int l = 0; l < DEPTH; ++l) {
        PH(1) if (l == 0) { PHASE_ENV
            __syncthreads();
            stage_wsmall(inp(8), (LAS float*)lds, tid);
            prenorm_rows<true>(inp(0), inp(4), (const float*)WSP(WS_MOD), 0, 1024, (bf16_t*)WSP(WS_H), (float*)WSP(WS_ZS), (const LAS float*)lds, gw, NGW, lane);
            GRID_BAR();
        }
        PH(2) {
            pg8::PlainSched S; S.o.init(M, ZLD, G, blk); S.A = (const bf16_t*)WSP(WS_H); S.lda = D; S.Bt = (const bf16_t*)WSP(WS_WIN); S.K = D;
            pg8::EpiStore E{(bf16_t*)WSP(WS_Z), ZLD};
            pg8::gemm_phase<pg8::EpiStore, pg8::PlainSched, true, true>(lds, D, D, S, E);
        }
        GRID_BAR();
        PH(3) { PHASE_ENV
            if (blk < 32) mx::stream<0>(l, lds, blk);
            else if (blk < 64) mx::stream<1>(l, lds, blk - 32);
            else if (blk < 192) { if (wave < 2) seq_s5(l, lds + wave * 49152, (blk - 64) * 2 + wave, lane); }
            else {
                int base = 0; const int gw2 = (blk - 192) * NWAVES + wave, NGW2 = (G - 192) * NWAVES;
                if (G > 192) convert_matrix<2>(inp(31) + (size_t)l * D * 2 * FF, 2 * FF, 1024, 2 * FF, (bf16_t*)WSP(WS_WIN), (LAS float*)(lds + wave * 16384), lane, gw2, NGW2, base);
            }
        }
        GRID_BAR();
        PH(4) {
            bf16_t* Z = (bf16_t*)WSP(WS_Z);
            pg8::PlainSched S; S.o.init(M, 512, G, blk); S.A = Z + SU; S.lda = ZLD; S.Bt = (const bf16_t*)WSP(WS_WGLU); S.K = 512;
            pg8::EpiGlu E{Z + YS2, ZLD, Z + SU, ZLD, inp(25) + l * 512};
            pg8::gemm_phase<pg8::EpiGlu, pg8::PlainSched, true, true>(lds, ZLD, 512, S, E);
        }
        GRID_BAR();
        PH(5) {
            bf16_t* Z = (bf16_t*)WSP(WS_Z);
            pg8::MergeSched S; S.o.init(M, 1024, G, blk); S.Zb = Z; S.Wp = (const bf16_t*)WSP(WS_WPROJ);
            pg8::EpiMerge E{Z + MRG, ZLD, Z + ZG, ZLD, inp(29) + l * 3072};
            pg8::gemm_phase<pg8::EpiMerge, pg8::MergeSched, true, true>(lds, ZLD, 512, S, E);
        }
        GRID_BAR();
        PH(6) {
            pg8::PlainSched S; S.o.init(M, 1024, G, blk); S.A = (const bf16_t*)WSP(WS_Z) + MRG; S.lda = ZLD; S.Bt = (const bf16_t*)WSP(WS_WOUT); S.K = 1024;
            pg8::EpiStore E{(bf16_t*)WSP(WS_H), D};
            pg8::gemm_phase<pg8::EpiStore, pg8::PlainSched, true, true>(lds, ZLD, 1024, S, E);
        }
        GRID_BAR();
        PH(7) { PHASE_ENV
            const float* modl = (const float*)WSP(WS_MOD) + (size_t)l * 8 * 6144;
            postpre_rows<true, false>((const bf16_t*)WSP(WS_H), D, (l == 0) ? inp(0) : (const float*)inp_out(), inp(5) + l * D, modl, 2048, inp_out(), inp(6) + l * D, modl, 3072, 4096,
                                      (bf16_t*)WSP(WS_H), nullptr, nullptr, gw, NGW, lane);
        }
        GRID_BAR();
        PH(8) {
            pg8::PlainSched S; S.o.init(M, 2 * FF, G, blk); S.A = (const bf16_t*)WSP(WS_H); S.lda = D; S.Bt = (const bf16_t*)WSP(WS_WIN); S.K = D;
            pg8::EpiSwiGlu E{(bf16_t*)WSP(WS_Z), FF};
            pg8::gemm_phase<pg8::EpiSwiGlu, pg8::PlainSched, true, true>(lds, D, D, S, E);
        }
        GRID_BAR();
        PH(9) {
            pg8::PlainSched S; S.o.init(M, 1024, G, blk); S.A = (const bf16_t*)WSP(WS_Z); S.lda = FF; S.Bt = (const bf16_t*)WSP(WS_WFO); S.K = FF;
            pg8::EpiStore E{(bf16_t*)WSP(WS_H), D};
            pg8::gemm_phase<pg8::EpiStore, pg8::PlainSched, true, true>(lds, FF, FF, S, E);
        }
        GRID_BAR();
        PH(10) { PHASE_ENV
            const float* modl = (const float*)WSP(WS_MOD) + (size_t)l * 8 * 6144;
            if (l + 1 < DEPTH) {
                const int l1 = l + 1;
                LAS float* scr = (LAS float*)(lds + wave * 16384);
                int base = 0;
                convert_matrix<1>(inp(8) + (size_t)l1 * D * INDIM, INDIM, 1024, ZLD, (bf16_t*)WSP(WS_WIN), scr, lane, gw, NGW, base);
                convert_matrix<0>(inp(24) + (size_t)l1 * 512 * 512, 512, 512, 512, (bf16_t*)WSP(WS_WGLU), scr, lane, gw, NGW, base);
                convert_matrix<0>(inp(26) + (size_t)l1 * 512 * 1024, 1024, 512, 1024, (bf16_t*)WSP(WS_WPROJ), scr, lane, gw, NGW, base);
                convert_matrix<0>(inp(27) + (size_t)l1 * 512 * 1024, 1024, 512, 1024, (bf16_t*)WSP(WS_WPROJ) + 1024 * 512, scr, lane, gw, NGW, base);
                convert_matrix<0>(inp(28) + (size_t)l1 * 512 * 1024, 1024, 512, 1024, (bf16_t*)WSP(WS_WPROJ) + 2 * 1024 * 512, scr, lane, gw, NGW, base);
                convert_matrix<0>(inp(30) + (size_t)l1 * D * D, 1024, 1024, 1024, (bf16_t*)WSP(WS_WOUT), scr, lane, gw, NGW, base);
                convert_matrix<0>(inp(32) + (size_t)l1 * FF * D, 1024, FF, 1024, (bf16_t*)WSP(WS_WFO), scr, lane, gw, NGW, base);
                __syncthreads();
                stage_wsmall(inp(8) + (size_t)l1 * D * INDIM, (LAS float*)lds, tid);
                postpre_rows<true, true>((const bf16_t*)WSP(WS_H), D, (const float*)inp_out(), inp(7) + l * D, modl, 5120, inp_out(), inp(4) + l1 * D, modl + 8 * 6144, 0, 1024,
                                         (bf16_t*)WSP(WS_H), (float*)WSP(WS_ZS), (const LAS float*)lds, gw, NGW, lane);
                GRID_BAR();
            } else {
                postpre_rows<false, false>((const bf16_t*)WSP(WS_H), D, (const float*)inp_out(), inp(7) + l * D, modl, 5120, inp_out(), nullptr, nullptr, 0, 0, nullptr, nullptr, nullptr, gw, NGW, lane);
            }
        }
    }
}

extern "C" void kernel_launch(void* const* d_in, const int* in_sizes, int n_in, void* d_out, int out_size, void* d_ws, size_t ws_size, hipStream_t stream) {
    static int grid = 0;
    if (grid == 0) {
        if (n_in != 33 || ws_size < WS_END || out_size != M * D) { fprintf(stderr, "kernel_launch: unexpected n_in %d / ws %zu / out %d\n", n_in, ws_size, out_size); grid = -1; return; }
        int dev = 0, cus = 0, per_cu = 0;
        if (hipGetDevice(&dev) != hipSuccess || hipDeviceGetAttribute(&cus, hipDeviceAttributeMultiprocessorCount, dev) != hipSuccess) { grid = -1; return; }
        if (hipFuncSetAttribute((const void*)mega_fwd, hipFuncAttributeMaxDynamicSharedMemorySize, LDS_BYTES) != hipSuccess) { fprintf(stderr, "kernel_launch: hipFuncSetAttribute failed\n"); grid = -1; return; }
        if (hipOccupancyMaxActiveBlocksPerMultiprocessor(&per_cu, (const void*)mega_fwd, NWAVES * 64, LDS_BYTES) != hipSuccess || per_cu < 1) { fprintf(stderr, "kernel_launch: occupancy query says %d blocks/CU\n", per_cu); grid = -1; return; }
        (void)hipGetLastError();
        grid = cus;
    }
    if (grid < 0) return;
    (void)hipMemsetAsync((char*)d_ws + WS_CTL, 0, CTL_ZERO_BYTES, stream);
    Args a{};
    for (int i = 0; i < 33; ++i) a.in[i] = (const float*)d_in[i];
    a.out = (float*)d_out; a.ws = (unsigned char*)d_ws;
    hipLaunchKernelGGL(mega_fwd, dim3(grid), dim3(NWAVES * 64), LDS_BYTES, stream, a);
}
```

```cpp
#include <hip/hip_runtime.h>
#include <cstdint>
#include <cstdio>

#define LAS __attribute__((address_space(3)))
#define GAS __attribute__((address_space(1)))
typedef unsigned short bf16_t;
typedef short bf16x8 __attribute__((ext_vector_type(8)));
typedef float f32x4 __attribute__((ext_vector_type(4)));
typedef float f32x2 __attribute__((ext_vector_type(2)));
typedef unsigned u32x4 __attribute__((ext_vector_type(4)));
typedef unsigned u32x2 __attribute__((ext_vector_type(2)));

constexpr int NB = 8, T = 4096, D = 1024, M = NB * T, DEPTH = 2;
constexpr int INDIM = 6680, ZLD = 6656, FF = 2816;
constexpr int GQ = 0, GK = 256, GV = 512, GR = 1024, MQ = 1536, MK = 1792, MV = 2048, MO = 2560, SU = 3072, ZG = 3584;
constexpr int YGLA = GR;
constexpr int YML = MO;
constexpr int YS2 = 0;
constexpr int MRG = 1536;
constexpr size_t MiB = 1u << 20;
constexpr size_t WS_CTL = 0, CTL_ZERO_BYTES = 64 * 1024;
constexpr size_t WS_MOD = 512 * 1024;
constexpr size_t WS_ZS = 1 * MiB;
constexpr size_t WS_WIN = 5 * MiB;
constexpr size_t WS_WGLU = 5 * MiB;
constexpr size_t WS_WPROJ = 5 * MiB + 512 * 1024;
constexpr size_t WS_WOUT = 8 * MiB + 512 * 1024;
constexpr size_t WS_WFO = 10 * MiB + 512 * 1024;
constexpr size_t WS_S5M1 = 18 * MiB;
constexpr size_t WS_S5M3 = 24 * MiB;
constexpr size_t WS_WFI = 18 * MiB;
constexpr size_t WS_EX = 32 * MiB;
constexpr size_t WS_YP = 64 * MiB;
constexpr size_t WS_H = 32 * MiB;
constexpr size_t WS_Z = 96 * MiB;
constexpr size_t WS_END = 512 * MiB;
constexpr int CW_BAR = 4096;

constexpr int RING_BYTES = 131072, LDSCTL_OFF = RING_BYTES, MISC_OFF = LDSCTL_OFF + 320, LDS_BYTES = 147456;
constexpr int NWAVES = 8;

__device__ __forceinline__ float bf2f(bf16_t v) { return __uint_as_float(((unsigned)v) << 16); }
__device__ __forceinline__ unsigned f2bf(float f) { unsigned u = __float_as_uint(f); return (u + 0x7fffu + ((u >> 16) & 1u)) >> 16; }
__device__ __forceinline__ unsigned pk2(float lo, float hi) { return f2bf(lo) | (f2bf(hi) << 16); }
__device__ __forceinline__ float bflo(unsigned u) { return __uint_as_float(u << 16); }
__device__ __forceinline__ float bfhi(unsigned u) { return __uint_as_float(u & 0xffff0000u); }
__device__ __forceinline__ int hw_lane() { int l; asm volatile("v_mbcnt_lo_u32_b32 %0, -1, 0\n\tv_mbcnt_hi_u32_b32 %0, -1, %0" : "=v"(l)); return l; }
__device__ __forceinline__ int hw_tid(int wv) { return wv * 64 + hw_lane(); }
__device__ __forceinline__ float shl(float v, int src) { return __int_as_float(__builtin_amdgcn_ds_bpermute(src << 2, __float_as_int(v))); }
__device__ __forceinline__ float wave_sum(float v, int lane) {
#pragma unroll
    for (int o = 1; o < 64; o <<= 1) v += shl(v, lane ^ o);
    return v;
}
__device__ __forceinline__ float sigmoidf_(float x) { return 1.f / (1.f + expf(-x)); }
__device__ __forceinline__ float siluf_(float x) { return x / (1.f + expf(-x)); }
__device__ __forceinline__ float logsigmoidf_(float x) { return fminf(x, 0.f) - log1pf(expf(-fabsf(x))); }
__device__ __forceinline__ float gelu_tanh(float y) { return 0.5f * y * (1.f + tanhf(0.7978845608028654f * (y + 0.044715f * y * y * y))); }
__device__ __forceinline__ float fexp_neg(float x) { return __builtin_amdgcn_exp2f(-1.4426950408889634f * x); }
__device__ __forceinline__ float fsigmoid(float x) { return __builtin_amdgcn_rcpf(1.f + fexp_neg(x)); }
#define LDS_WAIT() asm volatile("s_waitcnt lgkmcnt(0)" ::: "memory")
#define VM_WAIT() asm volatile("s_waitcnt vmcnt(0)" ::: "memory")

namespace pg8 {
constexpr int BM = 256, BK = 64, HALF = 128, HTB = HALF * BK * 2, STAGE_BYTES = 8 * HTB, NXCD = 8, WGM = 8;
__host__ __device__ __forceinline__ int lds_byte(int r, int c) { const int st = (r >> 4) * 2 + (c >> 5), rr = r & 15, cc = c & 31, ob = rr * 64 + cc * 2; return st * 1024 + (ob ^ (((ob >> 9) & 1) << 5)); }
__host__ __device__ __forceinline__ void stage_rc(int b, int& R, int& C) { const int st = b / 1024, sb = b % 1024, swz = sb ^ (((sb >> 9) & 1) << 5); R = (st >> 1) * 16 + swz / 64; C = (st & 1) * 32 + (swz % 64) / 2; }
__host__ __device__ __forceinline__ int perm32(int rho) { const int n = rho >> 4, i = rho & 15; return 8 * (i >> 2) + 4 * n + (i & 3); }

struct Unit { int pm, pn, br; };
struct TileOrder {
    int nM, nN, nwg, G, c;
    __device__ void init(int M_, int N_, int G_, int c_) { nM = M_ / BM; nN = N_ / BM; nwg = nM * nN; G = G_; c = c_; }
    __device__ bool tile(int i, int& pm, int& pn) const {
        const long L = (long)i * G + c; if (L >= nwg) return false;
        int wgid = (int)L; { const int q = nwg / NXCD, r = nwg % NXCD, xcd = wgid % NXCD, off = wgid / NXCD; wgid = (xcd < r ? xcd * (q + 1) : r * (q + 1) + (xcd - r) * q) + off; }
        const int nig = WGM * nN, gid = wgid / nig, fm = gid * WGM, gsz = (nM - fm) < WGM ? (nM - fm) : WGM;
        pm = fm + ((wgid % nig) % gsz); pn = (wgid % nig) / gsz; return true;
    }
};
struct PlainSched {
    TileOrder o; const bf16_t* A; int lda; const bf16_t* Bt; int K;
    __device__ bool next(int i, Unit& u) const { u.br = 0; return o.tile(i, u.pm, u.pn); }
    __device__ const char* Ap(const Unit& u) const { return (const char*)(A + (size_t)u.pm * BM * lda); }
    __device__ const char* Bp(const Unit& u) const { return (const char*)(Bt + (size_t)u.pn * BM * K); }
};
struct MergeSched {
    TileOrder o; const bf16_t* Zb; const bf16_t* Wp;
    __device__ bool next(int i, Unit& u) const { u.br = i % 3; return o.tile(i / 3, u.pm, u.pn); }
    __device__ const char* Ap(const Unit& u) const { const int col = u.br == 0 ? YGLA : (u.br == 1 ? YML : YS2); return (const char*)(Zb + (size_t)u.pm * BM * ZLD + col); }
    __device__ const char* Bp(const Unit& u) const { return (const char*)(Wp + (size_t)u.br * 1024 * 512 + (size_t)u.pn * BM * 512); }
};

__device__ __forceinline__ unsigned cvt_pk_bf16(float lo, float hi) { unsigned r; asm volatile("v_cvt_pk_bf16_f32 %0, %1, %2" : "=v"(r) : "v"(lo), "v"(hi)); return r; }

struct EpiStore {
    static constexpr bool PERM = true;
    bf16_t* O; int ldc;
    __device__ __forceinline__ bool keep(const Unit&) const { return false; }
    __device__ __forceinline__ void operator()(f32x4 (&acc)[2][2][4][2], const Unit& u, int wr, int wc, int fr, int fq) const {
        const int row0 = u.pm * BM + wr * 64 + fr, col0 = u.pn * BM + wc * 32 + 8 * fq;
#pragma unroll
        for (int ai = 0; ai < 2; ++ai)
#pragma unroll
            for (int m = 0; m < 4; ++m) { bf16_t* rowp = O + (size_t)(row0 + ai * HALF + m * 16) * ldc + col0;
#pragma unroll
                for (int bj = 0; bj < 2; ++bj) { const f32x4 v0 = acc[ai][bj][m][0], v1 = acc[ai][bj][m][1];
                    u32x4 w; w.x = cvt_pk_bf16(v0[0], v0[1]); w.y = cvt_pk_bf16(v0[2], v0[3]); w.z = cvt_pk_bf16(v1[0], v1[1]); w.w = cvt_pk_bf16(v1[2], v1[3]);
                    *(u32x4*)(rowp + bj * HALF) = w; } }
    }
};
struct EpiGlu {
    static constexpr bool PERM = true;
    bf16_t* O; int ldc; const bf16_t* Asrc; int lda; const float* bias;
    __device__ __forceinline__ bool keep(const Unit&) const { return false; }
    __device__ __forceinline__ void operator()(f32x4 (&acc)[2][2][4][2], const Unit& u, int wr, int wc, int fr, int fq) const {
        const int row0 = u.pm * BM + wr * 64 + fr, col0 = u.pn * BM + wc * 32 + 8 * fq;
        f32x4 bv[2][2];
#pragma unroll
        for (int bj = 0; bj < 2; ++bj)
#pragma unroll
            for (int n = 0; n < 2; ++n) bv[bj][n] = *(const f32x4*)(bias + col0 + bj * HALF + 4 * n);
#pragma unroll
        for (int ai = 0; ai < 2; ++ai)
#pragma unroll
            for (int m = 0; m < 4; ++m) { const size_t r = (size_t)(row0 + ai * HALF + m * 16);
#pragma unroll
                for (int bj = 0; bj < 2; ++bj) {
                    const u32x4 a = *(const u32x4*)(Asrc + r * lda + col0 + bj * HALF);
                    const f32x4 v0 = acc[ai][bj][m][0] + bv[bj][0], v1 = acc[ai][bj][m][1] + bv[bj][1];
                    u32x4 w;
                    w.x = cvt_pk_bf16(bflo(a.x) * fsigmoid(v0[0]), bfhi(a.x) * fsigmoid(v0[1])); w.y = cvt_pk_bf16(bflo(a.y) * fsigmoid(v0[2]), bfhi(a.y) * fsigmoid(v0[3]));
                    w.z = cvt_pk_bf16(bflo(a.z) * fsigmoid(v1[0]), bfhi(a.z) * fsigmoid(v1[1])); w.w = cvt_pk_bf16(bflo(a.w) * fsigmoid(v1[2]), bfhi(a.w) * fsigmoid(v1[3]));
                    *(u32x4*)(O + r * ldc + col0 + bj * HALF) = w; } }
    }
};
struct EpiSwiGlu {
    static constexpr bool PERM = true;
    bf16_t* O; int ldc;
    __device__ __forceinline__ bool keep(const Unit&) const { return false; }
    __device__ __forceinline__ void operator()(f32x4 (&acc)[2][2][4][2], const Unit& u, int wr, int wc, int fr, int fq) const {
        const int row0 = u.pm * BM + wr * 64 + fr, col0 = u.pn * HALF + wc * 32 + 8 * fq;
#pragma unroll
        for (int ai = 0; ai < 2; ++ai)
#pragma unroll
            for (int m = 0; m < 4; ++m) {
                float o[8];
#pragma unroll
                for (int n = 0; n < 2; ++n)
#pragma unroll
                    for (int e = 0; e < 4; ++e) { const float g = acc[ai][0][m][n][e], up = acc[ai][1][m][n][e]; o[n * 4 + e] = g * fsigmoid(g) * up; }
                u32x4 w; w.x = cvt_pk_bf16(o[0], o[1]); w.y = cvt_pk_bf16(o[2], o[3]); w.z = cvt_pk_bf16(o[4], o[5]); w.w = cvt_pk_bf16(o[6], o[7]);
                *(u32x4*)(O + (size_t)(row0 + ai * HALF + m * 16) * ldc + col0) = w; }
    }
};
struct EpiMerge {
    static constexpr bool PERM = true;
    bf16_t* O; int ldc; const bf16_t* Zg; int ldz; const float* bgb;
    __device__ __forceinline__ bool keep(const Unit& u) const { return u.br < 2; }
    __device__ __forceinline__ float e_of(float x) const { return fminf(fexp_neg(x), 1e30f); }
    __device__ __forceinline__ void operator()(f32x4 (&acc)[2][2][4][2], const Unit& u, int wr, int wc, int fr, int fq) const {
        const int row0 = u.pm * BM + wr * 64 + fr, col0 = u.pn * BM + wc * 32 + 8 * fq;
        const int br = u.br, brn = br < 2 ? br + 1 : 2;
#pragma unroll
        for (int bj = 0; bj < 2; ++bj) {
            float ba[8], bb[8];
#pragma unroll
            for (int e = 0; e < 8; ++e) { ba[e] = bgb[br * 1024 + col0 + bj * HALF + e]; bb[e] = bgb[brn * 1024 + col0 + bj * HALF + e]; }
#pragma unroll
            for (int ai = 0; ai < 2; ++ai)
#pragma unroll
                for (int m = 0; m < 4; ++m) { const size_t r = (size_t)(row0 + ai * HALF + m * 16);
                    const u32x4 za = *(const u32x4*)(Zg + r * ldz + br * 1024 + col0 + bj * HALF);
                    const u32x4 zb = *(const u32x4*)(Zg + r * ldz + brn * 1024 + col0 + bj * HALF);
                    const float xa[8] = {bflo(za.x), bfhi(za.x), bflo(za.y), bfhi(za.y), bflo(za.z), bfhi(za.z), bflo(za.w), bfhi(za.w)};
                    const float xb[8] = {bflo(zb.x), bfhi(zb.x), bflo(zb.y), bfhi(zb.y), bflo(zb.z), bfhi(zb.z), bflo(zb.w), bfhi(zb.w)};
                    float f[8];
#pragma unroll
                    for (int e = 0; e < 8; ++e) { const float ga = __builtin_amdgcn_rcpf(1.f + e_of(xa[e] + ba[e]));
                        f[e] = br < 2 ? ga * (1.f + e_of(xb[e] + bb[e])) : ga; }
                    f32x4 v0 = acc[ai][bj][m][0], v1 = acc[ai][bj][m][1];
                    v0[0] *= f[0]; v0[1] *= f[1]; v0[2] *= f[2]; v0[3] *= f[3]; v1[0] *= f[4]; v1[1] *= f[5]; v1[2] *= f[6]; v1[3] *= f[7];
                    if (br < 2) { acc[ai][bj][m][0] = v0; acc[ai][bj][m][1] = v1; }
                    else { u32x4 w; w.x = cvt_pk_bf16(v0[0], v0[1]); w.y = cvt_pk_bf16(v0[2], v0[3]); w.z = cvt_pk_bf16(v1[0], v1[1]); w.w = cvt_pk_bf16(v1[2], v1[3]);
                        *(u32x4*)(O + r * ldc + col0 + bj * HALF) = w; } }
        }
    }
};


struct S5aSched {
    int G, c; const bf16_t* Zb; const bf16_t* Bt1;
    __device__ bool next(int i, Unit& u) const { const int L = i * G + c; if (L >= 512) return false; u.br = L >> 4; u.pm = (L & 15) >> 1; u.pn = L & 1; return true; }
    __device__ const char* Ap(const Unit& u) const { return (const char*)(Zb + (size_t)u.pm * T * ZLD + SU + 16 * u.br); }
    __device__ const char* Bp(const Unit& u) const { return (const char*)(Bt1 + ((size_t)u.br * 384 + (size_t)u.pn * 256) * 256); }
};
struct EpiS5a {
    static constexpr bool PERM = true;
    float* EX; bf16_t* YP;
    __device__ __forceinline__ bool keep(const Unit&) const { return false; }
    __device__ __forceinline__ void operator()(f32x4 (&acc)[2][2][4][2], const Unit& u, int wr, int wc, int fr, int fq) const {
        const int rowbase = u.br * 2048 + u.pm * 256 + wr * 64 + fr, colsub = wc * 32 + 8 * fq;
#pragma unroll
        for (int ai = 0; ai < 2; ++ai)
#pragma unroll
            for (int m = 0; m < 4; ++m) { const size_t R = (size_t)(rowbase + ai * HALF + m * 16);
                if (u.pn == 0) {
                    *(f32x4*)(EX + R * 128 + colsub) = acc[ai][0][m][0]; *(f32x4*)(EX + R * 128 + colsub + 4) = acc[ai][0][m][1];
                    const f32x4 v0 = acc[ai][1][m][0], v1 = acc[ai][1][m][1];
                    u32x4 w; w.x = cvt_pk_bf16(v0[0], v0[1]); w.y = cvt_pk_bf16(v0[2], v0[3]); w.z = cvt_pk_bf16(v1[0], v1[1]); w.w = cvt_pk_bf16(v1[2], v1[3]);
                    *(u32x4*)(YP + R * 256 + colsub) = w;
                } else {
                    const f32x4 v0 = acc[ai][0][m][0], v1 = acc[ai][0][m][1];
                    u32x4 w; w.x = cvt_pk_bf16(v0[0], v0[1]); w.y = cvt_pk_bf16(v0[2], v0[3]); w.z = cvt_pk_bf16(v1[0], v1[1]); w.w = cvt_pk_bf16(v1[2], v1[3]);
                    *(u32x4*)(YP + R * 256 + 128 + colsub) = w;
                } }
    }
};
struct S5bSched {
    int G, c; const bf16_t* X; const bf16_t* Bt3;
    __device__ bool next(int i, Unit& u) const { const int L = i * G + c; if (L >= 256) return false; u.br = L >> 3; u.pm = L & 7; u.pn = 0; return true; }
    __device__ const char* Ap(const Unit& u) const { return (const char*)(X + (size_t)(u.br * 2048 + u.pm * 256) * 256); }
    __device__ const char* Bp(const Unit& u) const { return (const char*)(Bt3 + (size_t)u.br * 256 * 256); }
};
struct EpiS5b {
    static constexpr bool PERM = true;
    const bf16_t* YP; bf16_t* Zb; const float* dsk;
    __device__ __forceinline__ bool keep(const Unit&) const { return false; }
    __device__ __forceinline__ void operator()(f32x4 (&acc)[2][2][4][2], const Unit& u, int wr, int wc, int fr, int fq) const {
        const int g = u.br, b = u.pm;
#pragma unroll
        for (int bj = 0; bj < 2; ++bj) {
            const int j0 = bj * HALF + wc * 32 + 8 * fq, s = j0 >> 4, c0 = j0 & 15;
            const f32x4 d0 = *(const f32x4*)(dsk + 16 * g + c0), d1 = *(const f32x4*)(dsk + 16 * g + c0 + 4);
#pragma unroll
            for (int ai = 0; ai < 2; ++ai)
#pragma unroll
                for (int m = 0; m < 4; ++m) {
                    const int n = ai * HALF + wr * 64 + m * 16 + fr;
                    const size_t R = (size_t)(g * 2048 + b * 256 + n);
                    const u32x4 yp = *(const u32x4*)(YP + R * 256 + j0);
                    bf16_t* zp = Zb + ((size_t)b * T + 16 * n + s) * ZLD + SU + 16 * g + c0;
                    const u32x4 uu = *(const u32x4*)zp;
                    const f32x4 a0 = acc[ai][bj][m][0], a1 = acc[ai][bj][m][1];
                    float y[8];
                    y[0] = a0[0] + bflo(yp.x) + d0[0] * bflo(uu.x); y[1] = a0[1] + bfhi(yp.x) + d0[1] * bfhi(uu.x);
                    y[2] = a0[2] + bflo(yp.y) + d0[2] * bflo(uu.y); y[3] = a0[3] + bfhi(yp.y) + d0[3] * bfhi(uu.y);
                    y[4] = a1[0] + bflo(yp.z) + d1[0] * bflo(uu.z); y[5] = a1[1] + bfhi(yp.z) + d1[1] * bfhi(uu.z);
                    y[6] = a1[2] + bflo(yp.w) + d1[2] * bflo(uu.w); y[7] = a1[3] + bfhi(yp.w) + d1[3] * bfhi(uu.w);
#pragma unroll
                    for (int e = 0; e < 8; ++e) { const float v = y[e]; y[e] = v * fsigmoid(1.5957691216057308f * (v + 0.044715f * v * v * v)); }
                    u32x4 w; w.x = cvt_pk_bf16(y[0], y[1]); w.y = cvt_pk_bf16(y[2], y[3]); w.z = cvt_pk_bf16(y[4], y[5]); w.w = cvt_pk_bf16(y[6], y[7]);
                    *(u32x4*)zp = w;
                    if (m & 1) asm volatile("" ::: "memory");
                }
        }
    }
};

template <class Epi, class Sched, bool ALIGN_EPI, bool SP2, int AMODE = 0>
__device__ __forceinline__ void gemm_phase(LAS unsigned char* lds, const int wv, const int lda, const int K, const Sched& S, const Epi& E) {
    int tid_ = hw_tid(wv); asm volatile("" : "+v"(tid_));
    const int tid = tid_, wid = __builtin_amdgcn_readfirstlane(tid >> 6), lane = tid & 63, wr = wid >> 2, wc = wid & 3, fr = lane & 15, fq = lane >> 4;
    const int nt = K / BK;
    unsigned voffA[2], voffB[2];
#pragma unroll
    for (int i = 0; i < 2; ++i) { int R, C; stage_rc(tid * 16 + i * 8192, R, C); const int Rb = Epi::PERM ? ((R & ~31) + perm32(R & 31)) : R;
        voffA[i] = AMODE == 0 ? (unsigned)(R * lda + C) * 2u : (unsigned)((16 * R + (C >> 4)) * ZLD + (C & 15)) * 2u; voffB[i] = (unsigned)(Rb * K + C) * 2u; }
    const size_t kstep = (size_t)(BK * 2);
    const size_t kstepA = AMODE == 0 ? (size_t)(BK * 2) : (size_t)4 * ZLD * 2;
    const size_t hA = AMODE == 0 ? (size_t)HALF * lda * 2 : (size_t)HALF * 16 * ZLD * 2, hB = (size_t)HALF * K * 2;
    const unsigned ldsw = (unsigned)wid * 1024u;
    const int aoff = lds_byte(wr * 64 + fr, fq * 8), boff = lds_byte(wc * 32 + fr, fq * 8);
#define PG8_SA(b, h) (((b) * 2 + (h)) * HTB)
#define PG8_SB(b, h) ((4 + (b) * 2 + (h)) * HTB)
#define PG8_STAGE(bufoff, gbase, voff) do { _Pragma("unroll") for (int _i = 0; _i < 2; ++_i) \
        __builtin_amdgcn_global_load_lds((const unsigned*)((const char*)(gbase) + (voff)[_i]), (LAS unsigned*)(lds + (bufoff) + ldsw + _i * 8192), 16, 0, 0); } while (0)
#define PG8_LDA(dst, b, h) do { _Pragma("unroll") for (int m = 0; m < 4; ++m) _Pragma("unroll") for (int k = 0; k < 2; ++k) dst[m][k] = *(const LAS bf16x8*)(lds + PG8_SA(b, h) + aoff + m * 2048 + k * 1024); } while (0)
#define PG8_LDB(dst, b, h) do { _Pragma("unroll") for (int n = 0; n < 2; ++n) _Pragma("unroll") for (int k = 0; k < 2; ++k) dst[n][k] = *(const LAS bf16x8*)(lds + PG8_SB(b, h) + boff + n * 2048 + k * 1024); } while (0)
#define PG8_MMA(ai, bj, At, Bt) do { __builtin_amdgcn_s_setprio(1); _Pragma("unroll") for (int m = 0; m < 4; ++m) _Pragma("unroll") for (int n = 0; n < 2; ++n) _Pragma("unroll") for (int k = 0; k < 2; ++k) \
        acc[ai][bj][m][n] = __builtin_amdgcn_mfma_f32_16x16x32_bf16(Bt[n][k], At[m][k], acc[ai][bj][m][n], 0, 0, 0); __builtin_amdgcn_s_setprio(0); } while (0)
#define PG8_WAIT_V(n) asm volatile("s_waitcnt vmcnt(" #n ")" ::: "memory")
#define PG8_WAIT_L(n) asm volatile("s_waitcnt lgkmcnt(" #n ")" ::: "memory")
#define PG8_BAR __builtin_amdgcn_s_barrier()
#define PG8_SCHED __builtin_amdgcn_sched_barrier(0)
    Unit cur, nxt; int ui = 0;
    if (!S.next(0, cur)) return;
    f32x4 acc[2][2][4][2];
#pragma unroll
    for (int a = 0; a < 2; ++a)
#pragma unroll
        for (int b = 0; b < 2; ++b)
#pragma unroll
            for (int m = 0; m < 4; ++m)
#pragma unroll
                for (int n = 0; n < 2; ++n) acc[a][b][m][n] = (f32x4){0.f, 0.f, 0.f, 0.f};
    bf16x8 At[4][2], B0[2][2], B1[2][2];
    const char* cA = S.Ap(cur); const char* cB = S.Bp(cur);
    if constexpr (SP2) {
        PG8_STAGE(PG8_SB(0, 0), cB, voffB); PG8_STAGE(PG8_SB(0, 1), cB + hB, voffB); PG8_STAGE(PG8_SA(0, 0), cA, voffA); PG8_STAGE(PG8_SA(0, 1), cA + hA, voffA);
        if (wr == 1) PG8_BAR;
        PG8_WAIT_V(2); PG8_BAR;
        PG8_STAGE(PG8_SB(1, 0), cB + kstep, voffB); PG8_STAGE(PG8_SA(1, 0), cA + kstepA, voffA); PG8_STAGE(PG8_SB(1, 1), cB + hB + kstep, voffB);
        PG8_WAIT_V(6); PG8_BAR;
    } else {
        PG8_STAGE(PG8_SB(0, 0), cB, voffB); PG8_STAGE(PG8_SA(0, 0), cA, voffA); PG8_STAGE(PG8_SB(0, 1), cB + hB, voffB); PG8_STAGE(PG8_SA(0, 1), cA + hA, voffA);
        if (wr == 1) PG8_BAR;
        PG8_WAIT_V(4); PG8_BAR;
        PG8_STAGE(PG8_SB(1, 0), cB + kstep, voffB); PG8_STAGE(PG8_SA(1, 0), cA + kstepA, voffA); PG8_STAGE(PG8_SB(1, 1), cB + hB + kstep, voffB);
        PG8_WAIT_V(6); PG8_BAR;
    }
    for (;;) {
        const bool has_next = S.next(ui + 1, nxt);
        const char* nA = has_next ? S.Ap(nxt) : cA; const char* nB = has_next ? S.Bp(nxt) : cB;
        for (int t = 0; t < nt; t += 2) {
            const bool last = (t == nt - 2);
            const char* a1 = cA + (size_t)(t + 1) * kstepA;
            const char* a2 = last ? nA : cA + (size_t)(t + 2) * kstepA; const char* b2 = last ? nB : cB + (size_t)(t + 2) * kstep;
            const char* a3 = a2 + kstepA; const char* b3 = b2 + kstep;
            if constexpr (SP2) {
            PG8_LDB(B0, 0, 0); PG8_LDB(B1, 0, 1); PG8_SCHED; PG8_LDA(At, 0, 0); PG8_STAGE(PG8_SA(1, 1), a1 + hA, voffA);
            PG8_WAIT_V(8); PG8_WAIT_L(0); PG8_BAR; PG8_MMA(0, 0, At, B0); PG8_MMA(0, 1, At, B1); PG8_BAR; PG8_SCHED;
            PG8_LDA(At, 0, 1); PG8_STAGE(PG8_SB(0, 0), b2, voffB); PG8_STAGE(PG8_SB(0, 1), b2 + hB, voffB); PG8_STAGE(PG8_SA(0, 0), a2, voffA);
            PG8_WAIT_V(8); PG8_WAIT_L(0); PG8_BAR; PG8_MMA(1, 0, At, B0); PG8_MMA(1, 1, At, B1); PG8_BAR; PG8_SCHED;
            PG8_LDB(B0, 1, 0); PG8_LDB(B1, 1, 1); PG8_SCHED; PG8_LDA(At, 1, 0); PG8_STAGE(PG8_SA(0, 1), a2 + hA, voffA);
            PG8_WAIT_V(8); PG8_WAIT_L(0); PG8_BAR; PG8_MMA(0, 0, At, B0); PG8_MMA(0, 1, At, B1); PG8_BAR; PG8_SCHED;
            PG8_LDA(At, 1, 1); PG8_STAGE(PG8_SB(1, 0), b3, voffB); PG8_STAGE(PG8_SB(1, 1), b3 + hB, voffB); PG8_STAGE(PG8_SA(1, 0), a3, voffA);
            PG8_WAIT_V(8); PG8_WAIT_L(0); PG8_BAR; PG8_MMA(1, 0, At, B0); PG8_MMA(1, 1, At, B1); PG8_BAR; PG8_SCHED;
            } else {
            PG8_LDB(B0, 0, 0); PG8_SCHED; PG8_LDA(At, 0, 0); PG8_STAGE(PG8_SA(1, 1), a1 + hA, voffA);
            PG8_WAIT_L(8); PG8_BAR; PG8_WAIT_L(0); PG8_MMA(0, 0, At, B0); PG8_BAR; PG8_SCHED;
            PG8_LDB(B1, 0, 1); PG8_STAGE(PG8_SB(0, 0), b2, voffB);
            PG8_BAR; PG8_WAIT_L(0); PG8_MMA(0, 1, At, B1); PG8_BAR;
            PG8_LDA(At, 0, 1); PG8_STAGE(PG8_SA(0, 0), a2, voffA);
            PG8_BAR; PG8_WAIT_L(0); PG8_MMA(1, 0, At, B0); PG8_BAR; PG8_SCHED;
            PG8_STAGE(PG8_SB(0, 1), b2 + hB, voffB);
            PG8_WAIT_V(6); PG8_BAR; PG8_MMA(1, 1, At, B1); PG8_BAR;
            PG8_LDB(B0, 1, 0); PG8_SCHED; PG8_LDA(At, 1, 0); PG8_STAGE(PG8_SA(0, 1), a2 + hA, voffA);
            PG8_WAIT_L(8); PG8_BAR; PG8_WAIT_L(0); PG8_MMA(0, 0, At, B0); PG8_BAR; PG8_SCHED;
            PG8_LDB(B1, 1, 1); PG8_STAGE(PG8_SB(1, 0), b3, voffB);
            PG8_BAR; PG8_WAIT_L(0); PG8_MMA(0, 1, At, B1); PG8_BAR;
            PG8_LDA(At, 1, 1); PG8_STAGE(PG8_SA(1, 0), a3, voffA);
            PG8_BAR; PG8_WAIT_L(0); PG8_MMA(1, 0, At, B0); PG8_BAR; PG8_SCHED;
            PG8_STAGE(PG8_SB(1, 1), b3 + hB, voffB);
            PG8_WAIT_V(6); PG8_BAR; PG8_MMA(1, 1, At, B1); PG8_BAR;
            }
        }
        if constexpr (ALIGN_EPI) { if (wr == 0) PG8_BAR; }
        { const int lane_e = hw_lane();
          E(acc, cur, wr, wc, lane_e & 15, lane_e >> 4); }
        if (!has_next) break;
        if (!E.keep(cur)) {
#pragma unroll
        for (int a = 0; a < 2; ++a)
#pragma unroll
            for (int b = 0; b < 2; ++b)
#pragma unroll
                for (int m = 0; m < 4; ++m)
#pragma unroll
                    for (int n = 0; n < 2; ++n) acc[a][b][m][n] = (f32x4){0.f, 0.f, 0.f, 0.f};
        }
        cur = nxt; cA = nA; cB = nB; ++ui;
        if constexpr (ALIGN_EPI) { if (wr == 1) PG8_BAR; }
    }
    PG8_WAIT_V(0);
    if constexpr (!ALIGN_EPI) { if (wr == 0) PG8_BAR; }
    PG8_BAR;
#undef PG8_SA
#undef PG8_SB
#undef PG8_STAGE
#undef PG8_LDA
#undef PG8_LDB
#undef PG8_MMA
#undef PG8_WAIT_V
#undef PG8_WAIT_L
#undef PG8_BAR
#undef PG8_SCHED
}
}

#define XB_TMO      128
#define XB_XCNT(j)  (256  + 64 * (j))
#define XB_XSUB(j)  (1280 + 64 * (j))
#define XB_XGEN(j)  (2304 + 64 * (j))
#define XB_TOP      3328
#define XB_TOPGEN   3392
#define XCD_BAR_WORDS 3456
#define XB_SPIN_CAP (1u << 18)
__device__ __forceinline__ unsigned xb_ld(unsigned* p)              { return __hip_atomic_load(p, __ATOMIC_RELAXED, __HIP_MEMORY_SCOPE_AGENT); }
__device__ __forceinline__ unsigned xb_add(unsigned* p, unsigned v) { return __hip_atomic_fetch_add(p, v, __ATOMIC_RELAXED, __HIP_MEMORY_SCOPE_AGENT); }
__device__ __forceinline__ unsigned xb_xcc_id() { return (unsigned)__builtin_amdgcn_s_getreg((3 << 11) | 20) & 0xFu; }
#define XB_SPIN(cond, bar) do { unsigned _sp = 0; while (cond) { __builtin_amdgcn_s_sleep(1); \
    if ((++_sp & 255u) == 0u) { if (xb_ld(&(bar)[XB_TMO])) break; if (_sp > XB_SPIN_CAP) { atomicAdd(&(bar)[XB_TMO], 1u); break; } } } } while (0)
struct XcdBarrier { unsigned* bar; unsigned x; volatile LAS unsigned* st; };
__device__ __forceinline__ XcdBarrier xcd_barrier_post(unsigned* bar, volatile LAS unsigned* st) {
    XcdBarrier b; b.bar = bar; b.x = xb_xcc_id(); b.st = st;
    if (threadIdx.x == 0) (void)xb_add(&bar[XB_XCNT(b.x)], 1u);
    return b;
}
__device__ __forceinline__ void xcd_barrier_complete(unsigned* bar, unsigned x, unsigned& nloc, unsigned& nx) {
    const unsigned G = gridDim.x * gridDim.y * gridDim.z;
    unsigned sum, cnt, mine, sp = 0u;
    for (;;) {
        sum = 0u; cnt = 0u; mine = 0u;
#pragma unroll
        for (unsigned j = 0; j < 16; ++j) { const unsigned c = xb_ld(&bar[XB_XCNT(j)]); sum += c; cnt += (c > 0u) ? 1u : 0u; mine = (j == x) ? c : mine; }
        if (sum == G) break;
        __builtin_amdgcn_s_sleep(1);
        if ((++sp & 255u) == 0u) { if (xb_ld(&bar[XB_TMO])) break; if (sp > XB_SPIN_CAP) { atomicAdd(&bar[XB_TMO], 1u); break; } }
    }
    nloc = mine > 0u ? mine : 1u; nx = cnt > 0u ? cnt : 1u;
}
__device__ __forceinline__ void xcd_barrier(const XcdBarrier& b, const int wv) {
    asm volatile("s_waitcnt vmcnt(0)" ::: "memory");
    __syncthreads();
    if (wv == 0 && hw_lane() == 0) {
        unsigned* bar = b.bar;
        __builtin_amdgcn_s_waitcnt(0);
        unsigned nloc = b.st[0], nx = b.st[1];
        if (nloc == 0u) { xcd_barrier_complete(bar, b.x, nloc, nx); b.st[0] = nloc; b.st[1] = nx; }
        const unsigned old = xb_add(&bar[XB_XSUB(b.x)], 1u);
        const unsigned gen = old / nloc;
        if (old + 1u == (gen + 1u) * nloc) {
            __builtin_amdgcn_fence(__ATOMIC_RELEASE, "agent");
            asm volatile("s_waitcnt vmcnt(0)" ::: "memory");
            const unsigned og = xb_add(&bar[XB_TOP], 1u);
            const unsigned tg = og / nx;
            if (og + 1u == (tg + 1u) * nx) xb_add(&bar[XB_TOPGEN], 1u);
            else XB_SPIN(xb_ld(&bar[XB_TOPGEN]) == tg, bar);
            __builtin_amdgcn_fence(__ATOMIC_ACQUIRE, "agent");
            xb_add(&bar[XB_XGEN(b.x)], 1u);
            asm volatile("s_waitcnt vmcnt(0)" ::: "memory");
        } else {
            XB_SPIN(xb_ld(&bar[XB_XGEN(b.x)]) == gen, bar);
            __builtin_amdgcn_fence(__ATOMIC_ACQUIRE, "agent");
            asm volatile("s_waitcnt vmcnt(0)" ::: "memory");
        }
    }
    __syncthreads();
}

struct Args { const float* in[33]; float* out; unsigned char* ws; };
__device__ __forceinline__ const float* inp(int i) {
    unsigned off = (unsigned)i * 8u; asm volatile("" : "+s"(off));
    typedef const float* cfp;
    return *(const __attribute__((address_space(4))) cfp*)((const __attribute__((address_space(4))) char*)__builtin_amdgcn_kernarg_segment_ptr() + off);
}

#define WSP(off) (inp_ws() + (off))
__device__ __forceinline__ unsigned char* inp_ws() { return (unsigned char*)inp(34); }
__device__ __forceinline__ float* inp_out() { return (float*)inp(33); }

__device__ __forceinline__ void transpose_item(const float* W, int ldw, int K, bf16_t* WT, int src_n0, int dst_n0, int k0, LAS float* scr, int lane) {
#pragma unroll 8
    for (int i = 0; i < 32; ++i) { const int kk = 2 * i + (lane >> 5); scr[kk * 33 + (lane & 31)] = W[(size_t)(k0 + kk) * ldw + src_n0 + (lane & 31)]; }
    LDS_WAIT(); asm volatile("" ::: "memory");
    const int c = lane & 7;
#pragma unroll
    for (int j = 0; j < 4; ++j) { const int n = (lane >> 3) + 8 * j; const LAS float* s = scr + (8 * c) * 33 + n;
        u32x4 o; o.x = pk2(s[0 * 33], s[1 * 33]); o.y = pk2(s[2 * 33], s[3 * 33]); o.z = pk2(s[4 * 33], s[5 * 33]); o.w = pk2(s[6 * 33], s[7 * 33]);
        *(u32x4*)(WT + (size_t)(dst_n0 + n) * K + k0 + 8 * c) = o; }
    LDS_WAIT(); asm volatile("" ::: "memory");
}
template <int MAP>
__device__ __forceinline__ void convert_matrix(const float* W, int ldw, int K, int Ndst, bf16_t* WT, LAS float* scr, int lane, int gw, int NGW, int& base) {
    const int nblk = Ndst / 32, nitems = (K / 64) * nblk;
    int first = (gw - base % NGW + NGW) % NGW;
    for (int it = first; it < nitems; it += NGW) {
        const int kb = it / nblk, nb = it % nblk, d0 = nb * 32;
        int s0 = d0;
        if (MAP == 1) s0 = d0 + (d0 < 1024 ? 0 : (d0 < 2560 ? 16 : 24));
        if (MAP == 2) { const int pn = d0 >> 8, hh = (d0 & 255) >> 7, r = d0 & 127; s0 = hh * FF + pn * 128 + r; }
        transpose_item(W, ldw, K, WT, s0, d0, kb * 64, scr, lane);
    }
    base += nitems;
}

__device__ __forceinline__ void ada_phase(LAS unsigned char* lds, int blk, int wave, int lane) {
    if (blk >= 192) return;
    const int l = blk / 96, n0 = (blk % 96) * 64;
    const float* c = inp(1); const float* W = inp(2) + (size_t)l * 1024 * 6144; const float* bias = inp(3) + l * 6144;
    LAS float* part = (LAS float*)lds;
    float acc[8] = {0.f, 0.f, 0.f, 0.f, 0.f, 0.f, 0.f, 0.f};
    for (int k = wave * 128; k < wave * 128 + 128; ++k) {
        const float wv = W[(size_t)k * 6144 + n0 + lane];
#pragma unroll
        for (int b = 0; b < 8; ++b) { const float cv = c[b * 1024 + k]; acc[b] += siluf_(cv) * wv; }
    }
#pragma unroll
    for (int b = 0; b < 8; ++b) part[(wave * 8 + b) * 64 + lane] = acc[b];
    __syncthreads();
    {
        const int b = wave; float s = bias[n0 + lane];
#pragma unroll
        for (int w = 0; w < 8; ++w) s += part[(w * 8 + b) * 64 + lane];
        ((float*)WSP(WS_MOD))[(size_t)(l * 8 + b) * 6144 + n0 + lane] = s;
    }
    __syncthreads();
}

template <bool WITH_ZS>
__device__ __forceinline__ void prenorm_rows(const float* x, const float* w, const float* modl, int sh_off, int sc_off, bf16_t* H, float* ZS, const LAS float* wsm, int gw, int NGW, int lane) {
    for (int row = gw; row < M; row += NGW) {
        const int b = row / T;
        const f32x4* xr = (const f32x4*)(x + (size_t)row * D);
        f32x4 v[4]; float ss = 0.f;
#pragma unroll
        for (int j = 0; j < 4; ++j) { v[j] = xr[lane + 64 * j]; ss += v[j][0] * v[j][0] + v[j][1] * v[j][1] + v[j][2] * v[j][2] + v[j][3] * v[j][3]; }
        ss = wave_sum(ss, lane);
        const float r = rsqrtf(ss * (1.f / D) + 1e-6f);
        const float* sh = modl + (size_t)b * 6144 + sh_off; const float* sc = modl + (size_t)b * 6144 + sc_off;
#pragma unroll
        for (int j = 0; j < 4; ++j) {
            const int col = (lane + 64 * j) * 4;
            const f32x4 wv = *(const f32x4*)(w + col), scv = *(const f32x4*)(sc + col), shv = *(const f32x4*)(sh + col);
#pragma unroll
            for (int e = 0; e < 4; ++e) v[j][e] = v[j][e] * r * wv[e] * (1.f + scv[e]) + shv[e];
            u32x2 o; o.x = pk2(v[j][0], v[j][1]); o.y = pk2(v[j][2], v[j][3]);
            *(u32x2*)(H + (size_t)row * D + col) = o;
        }
        if (WITH_ZS) {
            float res = 0.f;
#pragma unroll 4
            for (int c = 0; c < 24; ++c) {
                float p = 0.f;
#pragma unroll
                for (int j = 0; j < 4; ++j) { const f32x4 wv = *(const LAS f32x4*)(wsm + c * 1024 + (lane + 64 * j) * 4); p += v[j][0] * wv[0] + v[j][1] * wv[1] + v[j][2] * wv[2] + v[j][3] * wv[3]; }
                p = wave_sum(p, lane);
                res = (lane == c) ? p : res;
            }
            if (lane < 24) ZS[(size_t)row * 32 + lane] = res;
        }
    }
}
template <bool WITH_PRE, bool WITH_ZS>
__device__ __forceinline__ void postpre_rows(const bf16_t* Y, int ldy, const float* xold, const float* pw, const float* modl_post, int gt_off, float* xout,
                                             const float* w2, const float* modl_pre, int sh_off, int sc_off, bf16_t* H, float* ZS, const LAS float* wsm, int gw, int NGW, int lane) {
    for (int row = gw; row < M; row += NGW) {
        const int b = row / T;
        f32x4 v[4]; float ss = 0.f;
#pragma unroll
        for (int j = 0; j < 4; ++j) { const u32x2 y = *(const u32x2*)(Y + (size_t)row * ldy + (lane + 64 * j) * 4);
            v[j] = (f32x4){bflo(y.x), bfhi(y.x), bflo(y.y), bfhi(y.y)}; ss += v[j][0] * v[j][0] + v[j][1] * v[j][1] + v[j][2] * v[j][2] + v[j][3] * v[j][3]; }
        ss = wave_sum(ss, lane);
        const float r = rsqrtf(ss * (1.f / D) + 1e-6f);
        const float* gt = modl_post + (size_t)b * 6144 + gt_off;
        float ss2 = 0.f;
#pragma unroll
        for (int j = 0; j < 4; ++j) {
            const int col = (lane + 64 * j) * 4;
            const f32x4 xo = *(const f32x4*)(xold + (size_t)row * D + col), pwv = *(const f32x4*)(pw + col), gtv = *(const f32x4*)(gt + col);
#pragma unroll
            for (int e = 0; e < 4; ++e) { v[j][e] = xo[e] + (1.f + gtv[e]) * (v[j][e] * r * pwv[e]); ss2 += v[j][e] * v[j][e]; }
            *(f32x4*)(xout + (size_t)row * D + col) = v[j];
        }
        if (WITH_PRE) {
            ss2 = wave_sum(ss2, lane);
            const float r2 = rsqrtf(ss2 * (1.f / D) + 1e-6f);
            const float* sh = modl_pre + (size_t)b * 6144 + sh_off; const float* sc = modl_pre + (size_t)b * 6144 + sc_off;
#pragma unroll
            for (int j = 0; j < 4; ++j) {
                const int col = (lane + 64 * j) * 4;
                const f32x4 wv = *(const f32x4*)(w2 + col), scv = *(const f32x4*)(sc + col), shv = *(const f32x4*)(sh + col);
#pragma unroll
                for (int e = 0; e < 4; ++e) v[j][e] = v[j][e] * r2 * wv[e] * (1.f + scv[e]) + shv[e];
                u32x2 o; o.x = pk2(v[j][0], v[j][1]); o.y = pk2(v[j][2], v[j][3]);
                *(u32x2*)(H + (size_t)row * D + col) = o;
            }
            if (WITH_ZS) {
                float res = 0.f;
#pragma unroll 4
                for (int c = 0; c < 24; ++c) {
                    float p = 0.f;
#pragma unroll
                    for (int j = 0; j < 4; ++j) { const f32x4 wv = *(const LAS f32x4*)(wsm + c * 1024 + (lane + 64 * j) * 4); p += v[j][0] * wv[0] + v[j][1] * wv[1] + v[j][2] * wv[2] + v[j][3] * wv[3]; }
                    p = wave_sum(p, lane);
                    res = (lane == c) ? p : res;
                }
                if (lane < 24) ZS[(size_t)row * 32 + lane] = res;
            }
        }
    }
}
__device__ __forceinline__ void stage_wsmall(const float* w_in, LAS float* wsm, int tid) {
    for (int k = tid; k < 1024; k += NWAVES * 64) {
        const float* src = w_in + (size_t)k * INDIM;
#pragma unroll
        for (int c = 0; c < 16; ++c) wsm[c * 1024 + k] = src[1024 + c];
#pragma unroll
        for (int c = 0; c < 8; ++c) wsm[(16 + c) * 1024 + k] = src[2576 + c];
    }
    __syncthreads();
}

__device__ __forceinline__ void s5_generate(int l, int g, LAS unsigned char* lds, int wv) {
    int tid = hw_tid(wv); asm volatile("" : "+v"(tid));
    LAS float* ar = (LAS float*)lds;
    LAS float* ai = ar + 17 * 64;
    LAS float* bbr = ai + 17 * 64;
    LAS float* bbi = bbr + 1024;
    LAS float* cr = bbi + 1024;
    LAS float* ci = cr + 1024;
    LAS float* Kt = ci + 1024;
    bf16_t* Bt1 = (bf16_t*)WSP(WS_S5M1) + (size_t)g * 384 * 256;
    bf16_t* Bt3 = (bf16_t*)WSP(WS_S5M3) + (size_t)g * 256 * 256;
    __syncthreads();
    if (tid < 64) {
        const int p = tid;
        const float lre = fminf((inp(16) + l * 2048)[g * 64 + p], -1e-4f), lim = (inp(17) + l * 2048)[g * 64 + p], dt = expf((inp(18) + l * 32)[g]);
        for (int k = 0; k <= 16; ++k) { const float mg = expf((float)k * lre * dt), an = (float)k * lim * dt; ar[k * 64 + p] = mg * cosf(an); ai[k * 64 + p] = mg * sinf(an); }
        const float a1r = ar[64 + p], a1i = ai[64 + p];
        const float inv = 1.f / (lre * lre + lim * lim);
        const float zr_ = ((a1r - 1.f) * lre + a1i * lim) * inv, zi_ = (a1i * lre - (a1r - 1.f) * lim) * inv;
        const float* b_re = inp(19) + (size_t)l * 32768 + (size_t)(g * 64 + p) * 16; const float* b_im = inp(20) + (size_t)l * 32768 + (size_t)(g * 64 + p) * 16;
        for (int c = 0; c < 16; ++c) { const float br = b_re[c], bi = b_im[c]; bbr[p * 16 + c] = zr_ * br - zi_ * bi; bbi[p * 16 + c] = zr_ * bi + zi_ * br; }
    }
    for (int i = tid; i < 1024; i += 512) { cr[i] = (inp(21) + (size_t)l * 32768)[g * 1024 + i]; ci[i] = (inp(22) + (size_t)l * 32768)[g * 1024 + i]; }
    __syncthreads();
    {
        const int cp = tid >> 5, c = (tid >> 1) & 15, ph = tid & 1;
        float acc[16];
#pragma unroll
        for (int t = 0; t < 16; ++t) acc[t] = 0.f;
        for (int pp = 0; pp < 32; ++pp) {
            const int p = 32 * ph + pp;
            const float xr = cr[cp * 64 + p], xi = ci[cp * 64 + p], yr = bbr[p * 16 + c], yi = bbi[p * 16 + c];
            const float cbr = xr * yr - xi * yi, cbi = xr * yi + xi * yr;
#pragma unroll
            for (int t = 0; t < 16; ++t) acc[t] += cbr * ar[t * 64 + p] - cbi * ai[t * 64 + p];
        }
#pragma unroll
        for (int t = 0; t < 16; ++t) { const float o = acc[t] + shl(acc[t], (tid & 63) ^ 1); if (ph == 0) Kt[(t * 16 + cp) * 16 + c] = o; }
    }
    __syncthreads();
    for (int pc = tid; pc < 128 * 32; pc += 512) {
        const int row = pc >> 5, k0 = (pc & 31) * 8, sp = k0 >> 4, c0 = k0 & 15, p = row & 63, e15 = 15 - sp;
        const float xr = ar[e15 * 64 + p], xi = ai[e15 * 64 + p];
        float v[8];
#pragma unroll
        for (int e = 0; e < 8; ++e) { const float yr = bbr[p * 16 + c0 + e], yi = bbi[p * 16 + c0 + e]; v[e] = row < 64 ? (xr * yr - xi * yi) : (xr * yi + xi * yr); }
        u32x4 w; w.x = pk2(v[0], v[1]); w.y = pk2(v[2], v[3]); w.z = pk2(v[4], v[5]); w.w = pk2(v[6], v[7]);
        *(u32x4*)(Bt1 + (size_t)row * 256 + k0) = w;
    }
    for (int pc = tid; pc < 256 * 32; pc += 512) {
        const int j = pc >> 5, k0 = (pc & 31) * 8, s = j >> 4, cp = j & 15, sp = k0 >> 4, c0 = k0 & 15;
        float v[8];
#pragma unroll
        for (int e = 0; e < 8; ++e) v[e] = (sp <= s) ? Kt[((s - sp) * 16 + cp) * 16 + c0 + e] : 0.f;
        u32x4 w; w.x = pk2(v[0], v[1]); w.y = pk2(v[2], v[3]); w.z = pk2(v[4], v[5]); w.w = pk2(v[6], v[7]);
        *(u32x4*)(Bt1 + (size_t)(128 + j) * 256 + k0) = w;
    }
    for (int pc = tid; pc < 256 * 32; pc += 512) {
        const int j = pc >> 5, k0 = (pc & 31) * 8, s = j >> 4, cp = j & 15;
        float v[8];
#pragma unroll
        for (int e = 0; e < 8; ++e) {
            const int k = k0 + e, p = k & 63;
            const float xr = cr[cp * 64 + p], xi = ci[cp * 64 + p], yr = ar[(s + 1) * 64 + p], yi = ai[(s + 1) * 64 + p];
            v[e] = k < 64 ? (xr * yr - xi * yi) : (k < 128 ? -(xr * yi + xi * yr) : 0.f);
        }
        u32x4 w; w.x = pk2(v[0], v[1]); w.y = pk2(v[2], v[3]); w.z = pk2(v[4], v[5]); w.w = pk2(v[6], v[7]);
        *(u32x4*)(Bt3 + (size_t)j * 256 + k0) = w;
    }
    __syncthreads();
}
__device__ __forceinline__ void s5_scan(int l, int sid, int lane) {
    const int g = sid >> 3, b = sid & 7, p = lane;
    const float lre = fminf((inp(16) + l * 2048)[g * 64 + p], -1e-4f), lim = (inp(17) + l * 2048)[g * 64 + p], dt = expf((inp(18) + l * 32)[g]);
    const float mg = expf(16.f * lre * dt), an = 16.f * lim * dt, a16r = mg * cosf(an), a16i = mg * sinf(an);
    float* base = (float*)WSP(WS_EX) + (size_t)(g * 2048 + b * 256) * 128;
    float xr = 0.f, xi = 0.f;
    float er[8], ei[8], nr[8], ni[8];
#pragma unroll
    for (int j = 0; j < 8; ++j) { er[j] = base[(size_t)j * 128 + p]; ei[j] = base[(size_t)j * 128 + 64 + p]; }
#pragma unroll 1
    for (int n0 = 0; n0 < 256; n0 += 8) {
        if (n0 + 8 < 256) {
#pragma unroll
            for (int j = 0; j < 8; ++j) { nr[j] = base[(size_t)(n0 + 8 + j) * 128 + p]; ni[j] = base[(size_t)(n0 + 8 + j) * 128 + 64 + p]; }
        }
        asm volatile("s_waitcnt vmcnt(16)" ::: "memory");
#pragma unroll
        for (int j = 0; j < 8; ++j) {
            bf16_t* row = (bf16_t*)(base + (size_t)(n0 + j) * 128);
            row[p] = (bf16_t)f2bf(xr); row[64 + p] = (bf16_t)f2bf(xi); ((unsigned*)row)[64 + p] = 0u;
            const float tr = a16r * xr - a16i * xi + er[j], ti = a16r * xi + a16i * xr + ei[j];
            xr = tr; xi = ti;
        }
#pragma unroll
        for (int j = 0; j < 8; ++j) { er[j] = nr[j]; ei[j] = ni[j]; }
    }
}

namespace mx {
typedef float f32x16 __attribute__((ext_vector_type(16)));
constexpr int PB = 72;
constexpr int L_QS = 0, L_KS = 9216, L_KT = 18432, L_VT = 27648, L_PS = 46080, L_ST = 55296, L_OS = 73728, L_VEC = 107520;
constexpr int OSP = 132;
constexpr int V_SEG = 0, V_ELAST = 512, V_GA = 576, V_RT = 1600, V_CS = 1664, V_WI = 1728, V_WK = 1792, V_ENM = 1856, V_DEN = 1920, V_NORM = 1984, V_SC = 2112, V_END = 2128;
static_assert(L_VEC + V_END * 4 <= RING_BYTES, "mixer LDS map");
__device__ __forceinline__ int crow(int reg, int hh) { return (reg & 3) + 8 * (reg >> 2) + 4 * hh; }
__device__ __forceinline__ float fexp(float x) { return __builtin_amdgcn_exp2f(1.4426950408889634f * x); }
__device__ __forceinline__ float flogsig(float x) { const float e = fexp(-fabsf(x)); return fminf(x, 0.f) - 0.6931471805599453f * __builtin_amdgcn_logf(1.f + e); }
#define MX_MFMA(a, b, c) __builtin_amdgcn_mfma_f32_32x32x16_bf16((a), (b), (c), 0, 0, 0)

template <int ROLE>
__device__ __forceinline__ void stream(int l, LAS unsigned char* lds, int bh, int wvs) {
    int tid = hw_tid(wvs); asm volatile("" : "+v"(tid));
    const int lane = tid & 63, w = __builtin_amdgcn_readfirstlane(tid >> 6), r32 = lane & 31, hh = lane >> 5;
    const int b = bh >> 2, h = bh & 3;
    bf16_t* Z = (bf16_t*)WSP(WS_Z); const float* ZS = (const float*)WSP(WS_ZS);
    LAS float* vec = (LAS float*)(lds + L_VEC);
    LAS bf16_t* Qs = (LAS bf16_t*)(lds + L_QS); LAS bf16_t* Ks = (LAS bf16_t*)(lds + L_KS); LAS bf16_t* KTs = (LAS bf16_t*)(lds + L_KT);
    LAS bf16_t* VTs = (LAS bf16_t*)(lds + L_VT); LAS bf16_t* Ps = (LAS bf16_t*)(lds + L_PS); LAS bf16_t* STs = (LAS bf16_t*)(lds + L_ST);
    LAS float* Os = (LAS float*)(lds + L_OS);
    const int qcol = (ROLE == 0 ? GQ : MQ) + h * 64, kcol = (ROLE == 0 ? GK : MK) + h * 64, vcol = (ROLE == 0 ? GV : MV) + h * 128, gcol = (ROLE == 0 ? GR : MO) + h * 128;
    const int vc_ = tid & 127, rq = tid >> 7, et = tid >> 3, cg = tid & 7;
    const int wa = w >> 2, wv = w & 3;
    float a2c[16], abd = 0.f, nwv[16];
    float cwq[4], cwk[4], cbq = 0.f, cbk = 0.f, ibh = 0.f, fbh = 0.f, mprev = 0.f;
#pragma unroll
    for (int r = 0; r < 16; ++r) { a2c[r] = 0.f; nwv[r] = 0.f; }
#pragma unroll
    for (int j = 0; j < 4; ++j) { cwq[j] = 0.f; cwk[j] = 0.f; }
    if (ROLE == 0) {
        const float* a2 = inp(9) + l * 16 * 256; const float* ab = inp(10) + l * 256; const float* nw = inp(11) + l * 512;
#pragma unroll
        for (int r = 0; r < 16; ++r) { a2c[r] = a2[r * 256 + h * 64 + lane]; nwv[r] = nw[h * 128 + 16 * cg + r]; }
        abd = ab[h * 64 + lane];
    } else {
        const float* cw = inp(12) + l * 4 * 512; const float* cb = inp(13) + l * 512;
#pragma unroll
        for (int j = 0; j < 4; ++j) { cwq[j] = cw[j * 512 + h * 64 + lane]; cwk[j] = cw[j * 512 + 256 + h * 64 + lane]; }
        cbq = cb[h * 64 + lane]; cbk = cb[256 + h * 64 + lane];
        ibh = (inp(14) + l * 4)[h]; fbh = (inp(15) + l * 4)[h];
    }
    for (int i = tid; i < 128 * PB / 2; i += 512) ((LAS unsigned*)STs)[i] = 0u;
    for (int i = tid; i < 64 * PB / 2; i += 512) ((LAS unsigned*)Ps)[i] = 0u;
    if (tid < 128) vec[V_NORM + tid] = 0.f;
    f32x16 accS;
#pragma unroll
    for (int r = 0; r < 16; ++r) accS[r] = 0.f;
    unsigned short qi[11], ki[11], vi[16]; float zs0 = 0.f, zs1 = 0.f; u32x4 gt0 = {0u, 0u, 0u, 0u}, gt1 = {0u, 0u, 0u, 0u};
#define MX_LOAD(mrow, nn) do { \
        if (ROLE == 0) { \
            _Pragma("unroll") for (int i = 0; i < 8; ++i) { const bf16_t* zr = Z + ((mrow) + 8 * w + i) * ZLD; qi[i] = zr[qcol + lane]; ki[i] = zr[kcol + lane]; } \
            const float* zp = ZS + ((mrow) + et) * 32 + 2 * cg; zs0 = zp[0]; zs1 = zp[1]; \
        } else { \
            _Pragma("unroll") for (int i = 0; i < 11; ++i) { const int trel = 8 * w + i - 3; const bool ok = ((nn) > 0) || (trel >= 0); \
                const bf16_t* zr = Z + ((mrow) + trel) * ZLD; qi[i] = ok ? zr[qcol + lane] : (unsigned short)0; ki[i] = ok ? zr[kcol + lane] : (unsigned short)0; } \
            if (w == 0) { const float* zp = ZS + ((mrow) + lane) * 32; zs0 = zp[16 + h]; zs1 = zp[20 + h]; } \
        } \
        _Pragma("unroll") for (int i = 0; i < 16; ++i) vi[i] = Z[((mrow) + 16 * rq + i) * ZLD + vcol + vc_]; \
    } while (0)
    size_t m0 = (size_t)b * T;
    MX_LOAD(m0, 0);
    if (ROLE == 0) { vec[V_GA + et * 16 + 2 * cg] = zs0; vec[V_GA + et * 16 + 2 * cg + 1] = zs1; }
    __syncthreads();

#pragma unroll 1
    for (int n = 0; n <= 64; ++n) {
        if (n > 0) {
            const size_t mp = m0 - 64;
            const LAS float* orow = Os + et * OSP + 16 * cg;
            float o[16];
#pragma unroll
            for (int q4 = 0; q4 < 4; ++q4) { const f32x4 t4 = *(const LAS f32x4*)(orow + 4 * q4); o[4 * q4] = t4[0]; o[4 * q4 + 1] = t4[1]; o[4 * q4 + 2] = t4[2]; o[4 * q4 + 3] = t4[3]; }
            const unsigned gw_[8] = {gt0.x, gt0.y, gt0.z, gt0.w, gt1.x, gt1.y, gt1.z, gt1.w};
            float y[16];
            if (ROLE == 0) {
                float ss = 0.f;
#pragma unroll
                for (int e = 0; e < 16; ++e) ss += o[e] * o[e];
                ss += shl(ss, lane ^ 1); ss += shl(ss, lane ^ 2); ss += shl(ss, lane ^ 4);
                const float rn = rsqrtf(ss * (1.f / 128.f) + 1e-6f);
#pragma unroll
                for (int e = 0; e < 16; ++e) { const float g = (e & 1) ? bfhi(gw_[e >> 1]) : bflo(gw_[e >> 1]); y[e] = o[e] * rn * nwv[e] * g * fsigmoid(g); }
            } else {
                const float rdiv = vec[V_DEN + et];
#pragma unroll
                for (int e = 0; e < 16; ++e) { const float g = (e & 1) ? bfhi(gw_[e >> 1]) : bflo(gw_[e >> 1]); y[e] = o[e] * rdiv * fsigmoid(g); }
            }
            u32x4 s0, s1;
            s0.x = pk2(y[0], y[1]); s0.y = pk2(y[2], y[3]); s0.z = pk2(y[4], y[5]); s0.w = pk2(y[6], y[7]);
            s1.x = pk2(y[8], y[9]); s1.y = pk2(y[10], y[11]); s1.z = pk2(y[12], y[13]); s1.w = pk2(y[14], y[15]);
            bf16_t* dst = Z + (mp + et) * ZLD + gcol + 16 * cg;
            *(u32x4*)dst = s0; *(u32x4*)(dst + 8) = s1;
        }
        if (n == 64) break;
        float c8[8], qf[8], kf[8];
        if (ROLE == 0) {
            float run = 0.f;
#pragma unroll
            for (int i = 0; i < 8; ++i) {
                const LAS f32x4* gp = (const LAS f32x4*)(vec + V_GA + (8 * w + i) * 16);
                float x = abd;
#pragma unroll
                for (int r4 = 0; r4 < 4; ++r4) { const f32x4 g4 = gp[r4]; x += g4[0] * a2c[4 * r4] + g4[1] * a2c[4 * r4 + 1] + g4[2] * a2c[4 * r4 + 2] + g4[3] * a2c[4 * r4 + 3]; }
                run += flogsig(x) * (1.f / 16.f); c8[i] = run;
                qf[i] = bf2f(qi[i]) * 0.125f; kf[i] = bf2f(ki[i]);
            }
            vec[V_SEG + w * 64 + lane] = run;
        } else {
#pragma unroll
            for (int i = 0; i < 8; ++i) {
                float aq = cbq, ak = cbk;
#pragma unroll
                for (int j = 0; j < 4; ++j) { aq += cwq[j] * bf2f(qi[i + j]); ak += cwk[j] * bf2f(ki[i + j]); }
                qf[i] = aq * fsigmoid(aq); kf[i] = ak * fsigmoid(ak) * 0.125f; c8[i] = 0.f;
            }
            if (w == 0) {
                const float ip = zs0 + ibh, lf = logsigmoidf_(zs1 + fbh);
                float bs = lf;
#pragma unroll
                for (int o = 1; o < 64; o <<= 1) { const float t = shl(bs, lane >= o ? lane - o : lane); if (lane >= o) bs += t; }
                const float cs = ip - bs;
                float pm = cs;
#pragma unroll
                for (int o = 1; o < 64; o <<= 1) { const float t = shl(pm, lane >= o ? lane - o : lane); if (lane >= o) pm = fmaxf(pm, t); }
                const float mt = bs + fmaxf(mprev, pm);
                vec[V_RT + lane] = bs - mt; vec[V_CS + lane] = cs; vec[V_WI + lane] = expf(bs + mprev - mt); vec[V_ENM + lane] = expf(-mt);
                const float mnew = shl(mt, 63), b63 = shl(bs, 63);
                vec[V_WK + lane] = expf(b63 + cs - mnew);
                if (lane == 0) vec[V_SC] = expf(b63 + mprev - mnew);
                mprev = mnew;
            }
        }
        __syncthreads();
        {
            u32x4 ktp; unsigned ktw[4];
            if (ROLE == 0) {
                float off = 0.f, tot = 0.f;
#pragma unroll
                for (int w2 = 0; w2 < 8; ++w2) { const float s = vec[V_SEG + w2 * 64 + lane]; tot += s; off += (w2 < w) ? s : 0.f; }
                if (w == 0) vec[V_ELAST + lane] = fexp(tot);
                float kt[8];
#pragma unroll
                for (int i = 0; i < 8; ++i) {
                    const float cum = off + c8[i];
                    Qs[(8 * w + i) * PB + lane] = (bf16_t)f2bf(qf[i] * fexp(cum));
                    Ks[(8 * w + i) * PB + lane] = (bf16_t)f2bf(kf[i] * fexp(-cum));
                    kt[i] = kf[i] * fexp(tot - cum);
                }
#pragma unroll
                for (int i = 0; i < 4; ++i) ktw[i] = pk2(kt[2 * i], kt[2 * i + 1]);
            } else {
                float kt[8];
#pragma unroll
                for (int i = 0; i < 8; ++i) {
                    Qs[(8 * w + i) * PB + lane] = (bf16_t)f2bf(qf[i]);
                    Ks[(8 * w + i) * PB + lane] = (bf16_t)f2bf(kf[i]);
                    kt[i] = kf[i] * vec[V_WK + 8 * w + i];
                }
#pragma unroll
                for (int i = 0; i < 4; ++i) ktw[i] = pk2(kt[2 * i], kt[2 * i + 1]);
            }
            ktp.x = ktw[0]; ktp.y = ktw[1]; ktp.z = ktw[2]; ktp.w = ktw[3];
            *(LAS u32x4*)(KTs + lane * PB + 8 * w) = ktp;
            u32x4 v0, v1;
            v0.x = vi[0] | ((unsigned)vi[1] << 16); v0.y = vi[2] | ((unsigned)vi[3] << 16); v0.z = vi[4] | ((unsigned)vi[5] << 16); v0.w = vi[6] | ((unsigned)vi[7] << 16);
            v1.x = vi[8] | ((unsigned)vi[9] << 16); v1.y = vi[10] | ((unsigned)vi[11] << 16); v1.z = vi[12] | ((unsigned)vi[13] << 16); v1.w = vi[14] | ((unsigned)vi[15] << 16);
            *(LAS u32x4*)(VTs + vc_ * PB + 16 * rq) = v0; *(LAS u32x4*)(VTs + vc_ * PB + 16 * rq + 8) = v1;
        }
        __syncthreads();
        { const bf16_t* gp = Z + (m0 + et) * ZLD + gcol + 16 * cg; gt0 = *(const u32x4*)gp; gt1 = *(const u32x4*)(gp + 8); }
        if (n < 63) MX_LOAD(m0 + 64, n + 1);
#define MX_FRAG(base, row, ks) (*(const LAS bf16x8*)(lds + (base) + ((row) * PB + 16 * (ks) + 8 * hh) * 2))
        if (w < 3) {
            const int ti = (w >= 1) ? 1 : 0, sj = (w == 2) ? 1 : 0;
            f32x16 sc;
#pragma unroll
            for (int r = 0; r < 16; ++r) sc[r] = 0.f;
#pragma unroll
            for (int ks = 0; ks < 4; ++ks) sc = MX_MFMA(MX_FRAG(L_QS, 32 * ti + r32, ks), MX_FRAG(L_KS, 32 * sj + r32, ks), sc);
            const float csv = (ROLE == 1) ? vec[V_CS + 32 * sj + r32] : 0.f;
#pragma unroll
            for (int r = 0; r < 16; ++r) {
                const int t = crow(r, hh);
                const bool keep = (ti != sj) || (r32 <= t);
                float val = sc[r];
                if (ROLE == 1) val *= expf(vec[V_RT + 32 * ti + t] + csv);
                Ps[(32 * ti + t) * PB + 32 * sj + r32] = (bf16_t)f2bf(keep ? val : 0.f);
            }
        }
        f32x16 acco;
#pragma unroll
        for (int r = 0; r < 16; ++r) acco[r] = 0.f;
#pragma unroll
        for (int ks = 0; ks < 4; ++ks) acco = MX_MFMA(MX_FRAG(L_QS, 32 * wa + r32, ks), MX_FRAG(L_ST, 32 * wv + r32, ks), acco);
        if (ROLE == 1) {
#pragma unroll
            for (int r = 0; r < 16; ++r) acco[r] *= vec[V_WI + 32 * wa + crow(r, hh)];
        }
        if (ROLE == 0) {
#pragma unroll
            for (int r = 0; r < 16; ++r) accS[r] *= vec[V_ELAST + 32 * wa + crow(r, hh)];
        } else {
            const float carry = vec[V_SC];
#pragma unroll
            for (int r = 0; r < 16; ++r) accS[r] *= carry;
        }
#pragma unroll
        for (int ks = 0; ks < 4; ++ks) accS = MX_MFMA(MX_FRAG(L_KT, 32 * wa + r32, ks), MX_FRAG(L_VT, 32 * wv + r32, ks), accS);
        __syncthreads();
        if (wa == 0) {
#pragma unroll
            for (int ks = 0; ks < 2; ++ks) acco = MX_MFMA(MX_FRAG(L_PS, r32, ks), MX_FRAG(L_VT, 32 * wv + r32, ks), acco);
        } else {
#pragma unroll
            for (int ks = 0; ks < 4; ++ks) acco = MX_MFMA(MX_FRAG(L_PS, 32 + r32, ks), MX_FRAG(L_VT, 32 * wv + r32, ks), acco);
        }
#pragma unroll
        for (int r = 0; r < 16; ++r) Os[(32 * wa + crow(r, hh)) * OSP + 32 * wv + r32] = acco[r];
#pragma unroll
        for (int q4 = 0; q4 < 4; ++q4) { u32x2 p; p.x = pk2(accS[4 * q4], accS[4 * q4 + 1]); p.y = pk2(accS[4 * q4 + 2], accS[4 * q4 + 3]);
            *(LAS u32x2*)(STs + (32 * wv + r32) * PB + 32 * wa + 8 * q4 + 4 * hh) = p; }
        if (ROLE == 0) { if (n < 63) { vec[V_GA + et * 16 + 2 * cg] = zs0; vec[V_GA + et * 16 + 2 * cg + 1] = zs1; } }
        else {
            const LAS float* nprev = vec + V_NORM + (n & 1) * 64;
            if (w == 0) {
                float qn = 0.f, si = 0.f;
#pragma unroll
                for (int c8i = 0; c8i < 8; ++c8i) {
                    const u32x4 qv = *(const LAS u32x4*)(Qs + lane * PB + 8 * c8i), pv = *(const LAS u32x4*)(Ps + lane * PB + 8 * c8i);
                    const f32x4 n0 = *(const LAS f32x4*)(nprev + 8 * c8i), n1 = *(const LAS f32x4*)(nprev + 8 * c8i + 4);
                    qn += bflo(qv.x) * n0[0] + bfhi(qv.x) * n0[1] + bflo(qv.y) * n0[2] + bfhi(qv.y) * n0[3] + bflo(qv.z) * n1[0] + bfhi(qv.z) * n1[1] + bflo(qv.w) * n1[2] + bfhi(qv.w) * n1[3];
                    si += (bflo(pv.x) + bfhi(pv.x)) + (bflo(pv.y) + bfhi(pv.y)) + (bflo(pv.z) + bfhi(pv.z)) + (bflo(pv.w) + bfhi(pv.w));
                }
                const float den = vec[V_WI + lane] * qn + si;
                vec[V_DEN + lane] = 1.f / fmaxf(fabsf(den), vec[V_ENM + lane]);
            } else if (w == 1) {
                float kn = 0.f;
#pragma unroll
                for (int c8i = 0; c8i < 8; ++c8i) { const u32x4 kv = *(const LAS u32x4*)(KTs + lane * PB + 8 * c8i);
                    kn += (bflo(kv.x) + bfhi(kv.x)) + (bflo(kv.y) + bfhi(kv.y)) + (bflo(kv.z) + bfhi(kv.z)) + (bflo(kv.w) + bfhi(kv.w)); }
                vec[V_NORM + ((n + 1) & 1) * 64 + lane] = vec[V_SC] * nprev[lane] + kn;
            }
        }
        __syncthreads();
        m0 += 64;
    }
#undef MX_LOAD
#undef MX_FRAG
}
}

#ifndef PHASE_MASK
#define PHASE_MASK 0xFFFF
#endif
#define PH(k) if constexpr ((PHASE_MASK >> (k)) & 1)
#define BLK_ENV int blk = blockIdx.x; asm volatile("" : "+s"(blk));
#define PHASE_ENV BLK_ENV int tid = hw_tid(wave_s); asm volatile("" : "+v"(tid)); const int lane = tid & 63, wave = wave_s; int vcu_ = vcu; asm volatile("" : "+s"(vcu_)); const int gw = vcu_ * NWAVES + wave; (void)lane; (void)gw;
__global__ void __launch_bounds__(NWAVES * 64, 2) mega_fwd(Args args) {
    extern __shared__ __attribute__((aligned(16))) unsigned char lds_raw[];
    LAS unsigned char* lds = (LAS unsigned char*)lds_raw;
    const int G = gridDim.x, blk0 = blockIdx.x;
    const int wave_s = __builtin_amdgcn_readfirstlane(threadIdx.x >> 6);
    const int vcu = (G % 8 == 0) ? (blk0 % 8) * (G / 8) + blk0 / 8 : blk0;
    const int NGW = G * NWAVES;
    for (int u = threadIdx.x; u < (LDS_BYTES - LDSCTL_OFF) / 4; u += NWAVES * 64) ((LAS unsigned*)(lds + LDSCTL_OFF))[u] = 0u;
    __syncthreads();
    (void)xcd_barrier_post((unsigned*)(args.ws + WS_CTL) + CW_BAR, (volatile LAS unsigned*)(lds + MISC_OFF) + 8);
#define GRID_BAR() do { XcdBarrier b_; b_.bar = (unsigned*)(inp_ws() + WS_CTL) + CW_BAR; b_.x = xb_xcc_id(); b_.st = (volatile LAS unsigned*)(lds + MISC_OFF) + 8; xcd_barrier(b_, wave_s); } while (0)

    PH(0) { PHASE_ENV
        ada_phase(lds, blk, wave, lane);
        if (blk < 32) s5_generate(0, blk, lds, wave_s);
        LAS float* scr = (LAS float*)(lds + wave * 16384);
        int base = 0;
        convert_matrix<1>(inp(8), INDIM, 1024, ZLD, (bf16_t*)WSP(WS_WIN), scr, lane, gw, NGW, base);
    }
    GRID_BAR();

#pragma unroll 1
    for (int l = 0; l < DEPTH; ++l) {
        PH(1) if (l == 0) { PHASE_ENV
            __syncthreads();
            stage_wsmall(inp(8), (LAS float*)lds, tid);
            prenorm_rows<true>(inp(0), inp(4), (const float*)WSP(WS_MOD), 0, 1024, (bf16_t*)WSP(WS_H), (float*)WSP(WS_ZS), (const LAS float*)lds, gw, NGW, lane);
            GRID_BAR();
        }
        PH(2) { BLK_ENV
            pg8::PlainSched S; S.o.init(M, ZLD, G, blk); S.A = (const bf16_t*)WSP(WS_H); S.lda = D; S.Bt = (const bf16_t*)WSP(WS_WIN); S.K = D;
            pg8::EpiStore E{(bf16_t*)WSP(WS_Z), ZLD};
            pg8::gemm_phase<pg8::EpiStore, pg8::PlainSched, true, true>(lds, wave_s, D, D, S, E);
        }
        GRID_BAR();
        PH(11) { BLK_ENV
            pg8::S5aSched S; S.G = G; S.c = blk; S.Zb = (const bf16_t*)WSP(WS_Z); S.Bt1 = (const bf16_t*)WSP(WS_S5M1);
            pg8::EpiS5a E{(float*)WSP(WS_EX), (bf16_t*)WSP(WS_YP)};
            pg8::gemm_phase<pg8::EpiS5a, pg8::S5aSched, true, true, 1>(lds, wave_s, 0, 256, S, E);
        }
        GRID_BAR();
        PH(3) { PHASE_ENV
            if (blk < 32) mx::stream<0>(l, lds, blk, wave_s);
            else if (blk < 64) mx::stream<1>(l, lds, blk - 32, wave_s);
            else if (blk < 192) { if (wave < 2) s5_scan(l, (blk - 64) * 2 + wave, lane); }
            else if (G > 192) {
                int base = 0; const int gw2 = (blk - 192) * NWAVES + wave, NGW2 = (G - 192) * NWAVES;
                LAS float* scr = (LAS float*)(lds + wave * 16384);
                convert_matrix<0>(inp(24) + (size_t)l * 512 * 512, 512, 512, 512, (bf16_t*)WSP(WS_WGLU), scr, lane, gw2, NGW2, base);
                convert_matrix<0>(inp(26) + (size_t)l * 512 * 1024, 1024, 512, 1024, (bf16_t*)WSP(WS_WPROJ), scr, lane, gw2, NGW2, base);
                convert_matrix<0>(inp(27) + (size_t)l * 512 * 1024, 1024, 512, 1024, (bf16_t*)WSP(WS_WPROJ) + 1024 * 512, scr, lane, gw2, NGW2, base);
                convert_matrix<0>(inp(28) + (size_t)l * 512 * 1024, 1024, 512, 1024, (bf16_t*)WSP(WS_WPROJ) + 2 * 1024 * 512, scr, lane, gw2, NGW2, base);
                convert_matrix<0>(inp(30) + (size_t)l * D * D, 1024, 1024, 1024, (bf16_t*)WSP(WS_WOUT), scr, lane, gw2, NGW2, base);
                convert_matrix<0>(inp(32) + (size_t)l * FF * D, 1024, FF, 1024, (bf16_t*)WSP(WS_WFO), scr, lane, gw2, NGW2, base);
            }
        }
        GRID_BAR();
        PH(12) { BLK_ENV
            pg8::S5bSched S; S.G = G; S.c = blk; S.X = (const bf16_t*)WSP(WS_EX); S.Bt3 = (const bf16_t*)WSP(WS_S5M3);
            pg8::EpiS5b E{(const bf16_t*)WSP(WS_YP), (bf16_t*)WSP(WS_Z), inp(23) + l * 512};
            pg8::gemm_phase<pg8::EpiS5b, pg8::S5bSched, true, true>(lds, wave_s, 256, 256, S, E);
        }
        GRID_BAR();
        PH(4) { BLK_ENV
            bf16_t* Z = (bf16_t*)WSP(WS_Z);
            pg8::PlainSched S; S.o.init(M, 512, G, blk); S.A = Z + SU; S.lda = ZLD; S.Bt = (const bf16_t*)WSP(WS_WGLU); S.K = 512;
            pg8::EpiGlu E{Z + YS2, ZLD, Z + SU, ZLD, inp(25) + l * 512};
            pg8::gemm_phase<pg8::EpiGlu, pg8::PlainSched, true, true>(lds, wave_s, ZLD, 512, S, E);
        }
        GRID_BAR();
        PH(5) { BLK_ENV
            bf16_t* Z = (bf16_t*)WSP(WS_Z);
            pg8::MergeSched S; S.o.init(M, 1024, G, blk); S.Zb = Z; S.Wp = (const bf16_t*)WSP(WS_WPROJ);
            pg8::EpiMerge E{Z + MRG, ZLD, Z + ZG, ZLD, inp(29) + l * 3072};
            pg8::gemm_phase<pg8::EpiMerge, pg8::MergeSched, true, true>(lds, wave_s, ZLD, 512, S, E);
        }
        GRID_BAR();
        PH(6) { BLK_ENV
            pg8::PlainSched S; S.o.init(M, 1024, G, blk); S.A = (const bf16_t*)WSP(WS_Z) + MRG; S.lda = ZLD; S.Bt = (const bf16_t*)WSP(WS_WOUT); S.K = 1024;
            pg8::EpiStore E{(bf16_t*)WSP(WS_H), D};
            pg8::gemm_phase<pg8::EpiStore, pg8::PlainSched, true, true>(lds, wave_s, ZLD, 1024, S, E);
        }
        GRID_BAR();
        PH(7) { PHASE_ENV
            const float* modl = (const float*)WSP(WS_MOD) + (size_t)l * 8 * 6144;
            { int base = 0; convert_matrix<2>(inp(31) + (size_t)l * D * 2 * FF, 2 * FF, 1024, 2 * FF, (bf16_t*)WSP(WS_WFI), (LAS float*)(lds + wave * 16384), lane, gw, NGW, base); }
            postpre_rows<true, false>((const bf16_t*)WSP(WS_H), D, (l == 0) ? inp(0) : (const float*)inp_out(), inp(5) + l * D, modl, 2048, inp_out(), inp(6) + l * D, modl, 3072, 4096,
                                      (bf16_t*)WSP(WS_H), nullptr, nullptr, gw, NGW, lane);
        }
        GRID_BAR();
        PH(8) { BLK_ENV
            pg8::PlainSched S; S.o.init(M, 2 * FF, G, blk); S.A = (const bf16_t*)WSP(WS_H); S.lda = D; S.Bt = (const bf16_t*)WSP(WS_WFI); S.K = D;
            pg8::EpiSwiGlu E{(bf16_t*)WSP(WS_Z), FF};
            pg8::gemm_phase<pg8::EpiSwiGlu, pg8::PlainSched, true, true>(lds, wave_s, D, D, S, E);
        }
        GRID_BAR();
        PH(9) { BLK_ENV
            pg8::PlainSched S; S.o.init(M, 1024, G, blk); S.A = (const bf16_t*)WSP(WS_Z); S.lda = FF; S.Bt = (const bf16_t*)WSP(WS_WFO); S.K = FF;
            pg8::EpiStore E{(bf16_t*)WSP(WS_H), D};
            pg8::gemm_phase<pg8::EpiStore, pg8::PlainSched, true, true>(lds, wave_s, FF, FF, S, E);
        }
        GRID_BAR();
        PH(10) { PHASE_ENV
            const float* modl = (const float*)WSP(WS_MOD) + (size_t)l * 8 * 6144;
            if (l + 1 < DEPTH) {
                const int l1 = l + 1;
                LAS float* scr = (LAS float*)(lds + wave * 16384);
                int base = 0;
                if (blk < 32) s5_generate(l1, blk, lds, wave_s);
                convert_matrix<1>(inp(8) + (size_t)l1 * D * INDIM, INDIM, 1024, ZLD, (bf16_t*)WSP(WS_WIN), scr, lane, gw, NGW, base);
                __syncthreads();
                stage_wsmall(inp(8) + (size_t)l1 * D * INDIM, (LAS float*)lds, tid);
                postpre_rows<true, true>((const bf16_t*)WSP(WS_H), D, (const float*)inp_out(), inp(7) + l * D, modl, 5120, inp_out(), inp(4) + l1 * D, modl + 8 * 6144, 0, 1024,
                                         (bf16_t*)WSP(WS_H), (float*)WSP(WS_ZS), (const LAS float*)lds, gw, NGW, lane);
                GRID_BAR();
            } else {
                postpre_rows<false, false>((const bf16_t*)WSP(WS_H), D, (const float*)inp_out(), inp(7) + l * D, modl, 5120, inp_out(), nullptr, nullptr, 0, 0, nullptr, nullptr, nullptr, gw, NGW, lane);
            }
        }
    }
}

extern "C" void kernel_launch(void* const* d_in, const int* in_sizes, int n_in, void* d_out, int out_size, void* d_ws, size_t ws_size, hipStream_t stream) {
    static int grid = 0;
    if (grid == 0) {
        if (n_in != 33 || ws_size < WS_END || out_size != M * D) { fprintf(stderr, "kernel_launch: unexpected n_in %d / ws %zu / out %d\n", n_in, ws_size, out_size); grid = -1; return; }
        int dev = 0, cus = 0, per_cu = 0;
        if (hipGetDevice(&dev) != hipSuccess || hipDeviceGetAttribute(&cus, hipDeviceAttributeMultiprocessorCount, dev) != hipSuccess) { grid = -1; return; }
        if (hipFuncSetAttribute((const void*)mega_fwd, hipFuncAttributeMaxDynamicSharedMemorySize, LDS_BYTES) != hipSuccess) { fprintf(stderr, "kernel_launch: hipFuncSetAttribute failed\n"); grid = -1; return; }
        if (hipOccupancyMaxActiveBlocksPerMultiprocessor(&per_cu, (const void*)mega_fwd, NWAVES * 64, LDS_BYTES) != hipSuccess || per_cu < 1) { fprintf(stderr, "kernel_launch: occupancy query says %d blocks/CU\n", per_cu); grid = -1; return; }
        (void)hipGetLastError();
        grid = cus;
    }
    if (grid < 0) return;
    (void)hipMemsetAsync((char*)d_ws + WS_CTL, 0, CTL_ZERO_BYTES, stream);
    Args a{};
    for (int i = 0; i < 33; ++i) a.in[i] = (const float*)d_in[i];
    a.out = (float*)d_out; a.ws = (unsigned char*)d_ws;
    hipLaunchKernelGGL(mega_fwd, dim3(grid), dim3(NWAVES * 64), LDS_BYTES, stream, a);
}
```

```cpp
#include <hip/hip_runtime.h>
#include <cstdint>
#include <cstdio>

#define LAS __attribute__((address_space(3)))
#define GAS __attribute__((address_space(1)))
typedef unsigned short bf16_t;
typedef short bf16x8 __attribute__((ext_vector_type(8)));
typedef float f32x4 __attribute__((ext_vector_type(4)));
typedef float f32x2 __attribute__((ext_vector_type(2)));
typedef unsigned u32x4 __attribute__((ext_vector_type(4)));
typedef unsigned u32x2 __attribute__((ext_vector_type(2)));

constexpr int NB = 8, T = 4096, D = 1024, M = NB * T, DEPTH = 2;
constexpr int INDIM = 6680, ZLD = 6656, FF = 2816;
constexpr int GQ = 0, GK = 256, GV = 512, GR = 1024, MQ = 1536, MK = 1792, MV = 2048, MO = 2560, SU = 3072, ZG = 3584;
constexpr int YGLA = GR;
constexpr int YML = MO;
constexpr int YS2 = 0;
constexpr int MRG = 1536;
constexpr size_t MiB = 1u << 20;
constexpr size_t WS_CTL = 0, CTL_ZERO_BYTES = 64 * 1024;
constexpr size_t WS_MOD = 512 * 1024;
constexpr size_t WS_ZS = 1 * MiB;
constexpr size_t WS_WIN = 5 * MiB;
constexpr size_t WS_WGLU = 5 * MiB;
constexpr size_t WS_WPROJ = 5 * MiB + 512 * 1024;
constexpr size_t WS_WOUT = 8 * MiB + 512 * 1024;
constexpr size_t WS_WFO = 10 * MiB + 512 * 1024;
constexpr size_t WS_S5M1 = 18 * MiB;
constexpr size_t WS_S5M3 = 24 * MiB;
constexpr size_t WS_WFI = 18 * MiB;
constexpr size_t WS_EX = 32 * MiB;
constexpr size_t WS_YP = 64 * MiB;
constexpr size_t WS_H = 32 * MiB;
constexpr size_t WS_Z = 96 * MiB;
constexpr size_t WS_END = 512 * MiB;
constexpr int CW_BAR = 4096;

constexpr int RING_BYTES = 131072, LDSCTL_OFF = RING_BYTES, MISC_OFF = LDSCTL_OFF + 320, LDS_BYTES = 147456;
constexpr int NWAVES = 8;

__device__ __forceinline__ float bf2f(bf16_t v) { return __uint_as_float(((unsigned)v) << 16); }
__device__ __forceinline__ unsigned f2bf(float f) { unsigned u = __float_as_uint(f); return (u + 0x7fffu + ((u >> 16) & 1u)) >> 16; }
__device__ __forceinline__ unsigned pk2(float lo, float hi) { return f2bf(lo) | (f2bf(hi) << 16); }
__device__ __forceinline__ float bflo(unsigned u) { return __uint_as_float(u << 16); }
__device__ __forceinline__ float bfhi(unsigned u) { return __uint_as_float(u & 0xffff0000u); }
__device__ __forceinline__ int hw_lane() { int l; asm volatile("v_mbcnt_lo_u32_b32 %0, -1, 0\n\tv_mbcnt_hi_u32_b32 %0, -1, %0" : "=v"(l)); return l; }
__device__ __forceinline__ int hw_tid(int wv) { return wv * 64 + hw_lane(); }
__device__ __forceinline__ float shl(float v, int src) { return __int_as_float(__builtin_amdgcn_ds_bpermute(src << 2, __float_as_int(v))); }
__device__ __forceinline__ float wave_sum(float v, int lane) {
#pragma unroll
    for (int o = 1; o < 64; o <<= 1) v += shl(v, lane ^ o);
    return v;
}
__device__ __forceinline__ float sigmoidf_(float x) { return 1.f / (1.f + expf(-x)); }
__device__ __forceinline__ float siluf_(float x) { return x / (1.f + expf(-x)); }
__device__ __forceinline__ float logsigmoidf_(float x) { return fminf(x, 0.f) - log1pf(expf(-fabsf(x))); }
__device__ __forceinline__ float gelu_tanh(float y) { return 0.5f * y * (1.f + tanhf(0.7978845608028654f * (y + 0.044715f * y * y * y))); }
__device__ __forceinline__ float fexp_neg(float x) { return __builtin_amdgcn_exp2f(-1.4426950408889634f * x); }
__device__ __forceinline__ float fsigmoid(float x) { return __builtin_amdgcn_rcpf(1.f + fexp_neg(x)); }
#define LDS_WAIT() asm volatile("s_waitcnt lgkmcnt(0)" ::: "memory")
#define VM_WAIT() asm volatile("s_waitcnt vmcnt(0)" ::: "memory")

namespace pg8 {
constexpr int BM = 256, BK = 64, HALF = 128, HTB = HALF * BK * 2, STAGE_BYTES = 8 * HTB, NXCD = 8, WGM = 8;
__host__ __device__ __forceinline__ int lds_byte(int r, int c) { const int st = (r >> 4) * 2 + (c >> 5), rr = r & 15, cc = c & 31, ob = rr * 64 + cc * 2; return st * 1024 + (ob ^ (((ob >> 9) & 1) << 5)); }
__host__ __device__ __forceinline__ void stage_rc(int b, int& R, int& C) { const int st = b / 1024, sb = b % 1024, swz = sb ^ (((sb >> 9) & 1) << 5); R = (st >> 1) * 16 + swz / 64; C = (st & 1) * 32 + (swz % 64) / 2; }
__host__ __device__ __forceinline__ int perm32(int rho) { const int n = rho >> 4, i = rho & 15; return 8 * (i >> 2) + 4 * n + (i & 3); }

struct Unit { int pm, pn, br; };
struct TileOrder {
    int nM, nN, nwg, G, c;
    __device__ void init(int M_, int N_, int G_, int c_) { nM = M_ / BM; nN = N_ / BM; nwg = nM * nN; G = G_; c = c_; }
    __device__ bool tile(int i, int& pm, int& pn) const {
        const long L = (long)i * G + c; if (L >= nwg) return false;
        int wgid = (int)L; { const int q = nwg / NXCD, r = nwg % NXCD, xcd = wgid % NXCD, off = wgid / NXCD; wgid = (xcd < r ? xcd * (q + 1) : r * (q + 1) + (xcd - r) * q) + off; }
        const int nig = WGM * nN, gid = wgid / nig, fm = gid * WGM, gsz = (nM - fm) < WGM ? (nM - fm) : WGM;
        pm = fm + ((wgid % nig) % gsz); pn = (wgid % nig) / gsz; return true;
    }
};
struct PlainSched {
    TileOrder o; const bf16_t* A; int lda; const bf16_t* Bt; int K;
    __device__ bool next(int i, Unit& u) const { u.br = 0; return o.tile(i, u.pm, u.pn); }
    __device__ const char* Ap(const Unit& u) const { return (const char*)(A + (size_t)u.pm * BM * lda); }
    __device__ const char* Bp(const Unit& u) const { return (const char*)(Bt + (size_t)u.pn * BM * K); }
};
struct MergeSched {
    TileOrder o; const bf16_t* Zb; const bf16_t* Wp;
    __device__ bool next(int i, Unit& u) const { u.br = i % 3; return o.tile(i / 3, u.pm, u.pn); }
    __device__ const char* Ap(const Unit& u) const { const int col = u.br == 0 ? YGLA : (u.br == 1 ? YML : YS2); return (const char*)(Zb + (size_t)u.pm * BM * ZLD + col); }
    __device__ const char* Bp(const Unit& u) const { return (const char*)(Wp + (size_t)u.br * 1024 * 512 + (size_t)u.pn * BM * 512); }
};

__device__ __forceinline__ unsigned cvt_pk_bf16(float lo, float hi) { unsigned r; asm volatile("v_cvt_pk_bf16_f32 %0, %1, %2" : "=v"(r) : "v"(lo), "v"(hi)); return r; }

struct EpiStore {
    static constexpr bool PERM = true;
    bf16_t* O; int ldc;
    __device__ __forceinline__ bool keep(const Unit&) const { return false; }
    __device__ __forceinline__ void operator()(f32x4 (&acc)[2][2][4][2], const Unit& u, int wr, int wc, int fr, int fq) const {
        const int row0 = u.pm * BM + wr * 64 + fr, col0 = u.pn * BM + wc * 32 + 8 * fq;
#pragma unroll
        for (int ai = 0; ai < 2; ++ai)
#pragma unroll
            for (int m = 0; m < 4; ++m) { bf16_t* rowp = O + (size_t)(row0 + ai * HALF + m * 16) * ldc + col0;
#pragma unroll
                for (int bj = 0; bj < 2; ++bj) { const f32x4 v0 = acc[ai][bj][m][0], v1 = acc[ai][bj][m][1];
                    u32x4 w; w.x = cvt_pk_bf16(v0[0], v0[1]); w.y = cvt_pk_bf16(v0[2], v0[3]); w.z = cvt_pk_bf16(v1[0], v1[1]); w.w = cvt_pk_bf16(v1[2], v1[3]);
                    *(u32x4*)(rowp + bj * HALF) = w; } }
    }
};
struct EpiGlu {
    static constexpr bool PERM = true;
    bf16_t* O; int ldc; const bf16_t* Asrc; int lda; const float* bias;
    __device__ __forceinline__ bool keep(const Unit&) const { return false; }
    __device__ __forceinline__ void operator()(f32x4 (&acc)[2][2][4][2], const Unit& u, int wr, int wc, int fr, int fq) const {
        const int row0 = u.pm * BM + wr * 64 + fr, col0 = u.pn * BM + wc * 32 + 8 * fq;
        f32x4 bv[2][2];
#pragma unroll
        for (int bj = 0; bj < 2; ++bj)
#pragma unroll
            for (int n = 0; n < 2; ++n) bv[bj][n] = *(const f32x4*)(bias + col0 + bj * HALF + 4 * n);
#pragma unroll
        for (int ai = 0; ai < 2; ++ai)
#pragma unroll
            for (int m = 0; m < 4; ++m) { const size_t r = (size_t)(row0 + ai * HALF + m * 16);
#pragma unroll
                for (int bj = 0; bj < 2; ++bj) {
                    const u32x4 a = *(const u32x4*)(Asrc + r * lda + col0 + bj * HALF);
                    const f32x4 v0 = acc[ai][bj][m][0] + bv[bj][0], v1 = acc[ai][bj][m][1] + bv[bj][1];
                    u32x4 w;
                    w.x = cvt_pk_bf16(bflo(a.x) * fsigmoid(v0[0]), bfhi(a.x) * fsigmoid(v0[1])); w.y = cvt_pk_bf16(bflo(a.y) * fsigmoid(v0[2]), bfhi(a.y) * fsigmoid(v0[3]));
                    w.z = cvt_pk_bf16(bflo(a.z) * fsigmoid(v1[0]), bfhi(a.z) * fsigmoid(v1[1])); w.w = cvt_pk_bf16(bflo(a.w) * fsigmoid(v1[2]), bfhi(a.w) * fsigmoid(v1[3]));
                    *(u32x4*)(O + r * ldc + col0 + bj * HALF) = w; } }
    }
};
struct EpiSwiGlu {
    static constexpr bool PERM = true;
    bf16_t* O; int ldc;
    __device__ __forceinline__ bool keep(const Unit&) const { return false; }
    __device__ __forceinline__ void operator()(f32x4 (&acc)[2][2][4][2], const Unit& u, int wr, int wc, int fr, int fq) const {
        const int row0 = u.pm * BM + wr * 64 + fr, col0 = u.pn * HALF + wc * 32 + 8 * fq;
#pragma unroll
        for (int ai = 0; ai < 2; ++ai)
#pragma unroll
            for (int m = 0; m < 4; ++m) {
                float o[8];
#pragma unroll
                for (int n = 0; n < 2; ++n)
#pragma unroll
                    for (int e = 0; e < 4; ++e) { const float g = acc[ai][0][m][n][e], up = acc[ai][1][m][n][e]; o[n * 4 + e] = g * fsigmoid(g) * up; }
                u32x4 w; w.x = cvt_pk_bf16(o[0], o[1]); w.y = cvt_pk_bf16(o[2], o[3]); w.z = cvt_pk_bf16(o[4], o[5]); w.w = cvt_pk_bf16(o[6], o[7]);
                *(u32x4*)(O + (size_t)(row0 + ai * HALF + m * 16) * ldc + col0) = w; }
    }
};
struct EpiMerge {
    static constexpr bool PERM = true;
    bf16_t* O; int ldc; const bf16_t* Zg; int ldz; const float* bgb;
    __device__ __forceinline__ bool keep(const Unit& u) const { return u.br < 2; }
    __device__ __forceinline__ float e_of(float x) const { return fminf(fexp_neg(x), 1e30f); }
    __device__ __forceinline__ void operator()(f32x4 (&acc)[2][2][4][2], const Unit& u, int wr, int wc, int fr, int fq) const {
        const int row0 = u.pm * BM + wr * 64 + fr, col0 = u.pn * BM + wc * 32 + 8 * fq;
        const int br = u.br, brn = br < 2 ? br + 1 : 2;
#pragma unroll
        for (int bj = 0; bj < 2; ++bj) {
            float ba[8], bb[8];
#pragma unroll
            for (int e = 0; e < 8; ++e) { ba[e] = bgb[br * 1024 + col0 + bj * HALF + e]; bb[e] = bgb[brn * 1024 + col0 + bj * HALF + e]; }
#pragma unroll
            for (int ai = 0; ai < 2; ++ai)
#pragma unroll
                for (int m = 0; m < 4; ++m) { const size_t r = (size_t)(row0 + ai * HALF + m * 16);
                    const u32x4 za = *(const u32x4*)(Zg + r * ldz + br * 1024 + col0 + bj * HALF);
                    const u32x4 zb = *(const u32x4*)(Zg + r * ldz + brn * 1024 + col0 + bj * HALF);
                    const float xa[8] = {bflo(za.x), bfhi(za.x), bflo(za.y), bfhi(za.y), bflo(za.z), bfhi(za.z), bflo(za.w), bfhi(za.w)};
                    const float xb[8] = {bflo(zb.x), bfhi(zb.x), bflo(zb.y), bfhi(zb.y), bflo(zb.z), bfhi(zb.z), bflo(zb.w), bfhi(zb.w)};
                    float f[8];
#pragma unroll
                    for (int e = 0; e < 8; ++e) { const float ga = __builtin_amdgcn_rcpf(1.f + e_of(xa[e] + ba[e]));
                        f[e] = br < 2 ? ga * (1.f + e_of(xb[e] + bb[e])) : ga; }
                    f32x4 v0 = acc[ai][bj][m][0], v1 = acc[ai][bj][m][1];
                    v0[0] *= f[0]; v0[1] *= f[1]; v0[2] *= f[2]; v0[3] *= f[3]; v1[0] *= f[4]; v1[1] *= f[5]; v1[2] *= f[6]; v1[3] *= f[7];
                    if (br < 2) { acc[ai][bj][m][0] = v0; acc[ai][bj][m][1] = v1; }
                    else { u32x4 w; w.x = cvt_pk_bf16(v0[0], v0[1]); w.y = cvt_pk_bf16(v0[2], v0[3]); w.z = cvt_pk_bf16(v1[0], v1[1]); w.w = cvt_pk_bf16(v1[2], v1[3]);
                        *(u32x4*)(O + r * ldc + col0 + bj * HALF) = w; } }
        }
    }
};


struct S5aSched {
    int G, c; const bf16_t* Zb; const bf16_t* Bt1;
    __device__ bool next(int i, Unit& u) const { const int L = i * G + c; if (L >= 512) return false; u.br = L >> 4; u.pm = (L & 15) >> 1; u.pn = L & 1; return true; }
    __device__ const char* Ap(const Unit& u) const { return (const char*)(Zb + (size_t)u.pm * T * ZLD + SU + 16 * u.br); }
    __device__ const char* Bp(const Unit& u) const { return (const char*)(Bt1 + ((size_t)u.br * 384 + (size_t)u.pn * 256) * 256); }
};
struct EpiS5a {
    static constexpr bool PERM = true;
    float* EX; bf16_t* YP;
    __device__ __forceinline__ bool keep(const Unit&) const { return false; }
    __device__ __forceinline__ void operator()(f32x4 (&acc)[2][2][4][2], const Unit& u, int wr, int wc, int fr, int fq) const {
        const int rowbase = u.br * 2048 + u.pm * 256 + wr * 64 + fr, colsub = wc * 32 + 8 * fq;
#pragma unroll
        for (int ai = 0; ai < 2; ++ai)
#pragma unroll
            for (int m = 0; m < 4; ++m) { const size_t R = (size_t)(rowbase + ai * HALF + m * 16);
                if (u.pn == 0) {
                    *(f32x4*)(EX + R * 128 + colsub) = acc[ai][0][m][0]; *(f32x4*)(EX + R * 128 + colsub + 4) = acc[ai][0][m][1];
                    const f32x4 v0 = acc[ai][1][m][0], v1 = acc[ai][1][m][1];
                    u32x4 w; w.x = cvt_pk_bf16(v0[0], v0[1]); w.y = cvt_pk_bf16(v0[2], v0[3]); w.z = cvt_pk_bf16(v1[0], v1[1]); w.w = cvt_pk_bf16(v1[2], v1[3]);
                    *(u32x4*)(YP + R * 256 + colsub) = w;
                } else {
                    const f32x4 v0 = acc[ai][0][m][0], v1 = acc[ai][0][m][1];
                    u32x4 w; w.x = cvt_pk_bf16(v0[0], v0[1]); w.y = cvt_pk_bf16(v0[2], v0[3]); w.z = cvt_pk_bf16(v1[0], v1[1]); w.w = cvt_pk_bf16(v1[2], v1[3]);
                    *(u32x4*)(YP + R * 256 + 128 + colsub) = w;
                } }
    }
};
struct S5bSched {
    int G, c; const bf16_t* X; const bf16_t* Bt3;
    __device__ bool next(int i, Unit& u) const { const int L = i * G + c; if (L >= 256) return false; u.br = L >> 3; u.pm = L & 7; u.pn = 0; return true; }
    __device__ const char* Ap(const Unit& u) const { return (const char*)(X + (size_t)(u.br * 2048 + u.pm * 256) * 256); }
    __device__ const char* Bp(const Unit& u) const { return (const char*)(Bt3 + (size_t)u.br * 256 * 256); }
};
struct EpiS5b {
    static constexpr bool PERM = true;
    const bf16_t* YP; bf16_t* Zb; const float* dsk;
    __device__ __forceinline__ bool keep(const Unit&) const { return false; }
    __device__ __forceinline__ void operator()(f32x4 (&acc)[2][2][4][2], const Unit& u, int wr, int wc, int fr, int fq) const {
        const int g = u.br, b = u.pm;
#pragma unroll
        for (int bj = 0; bj < 2; ++bj) {
            const int j0 = bj * HALF + wc * 32 + 8 * fq, s = j0 >> 4, c0 = j0 & 15;
            const f32x4 d0 = *(const f32x4*)(dsk + 16 * g + c0), d1 = *(const f32x4*)(dsk + 16 * g + c0 + 4);
#pragma unroll
            for (int ai = 0; ai < 2; ++ai)
#pragma unroll
                for (int m = 0; m < 4; ++m) {
                    const int n = ai * HALF + wr * 64 + m * 16 + fr;
                    const size_t R = (size_t)(g * 2048 + b * 256 + n);
                    const u32x4 yp = *(const u32x4*)(YP + R * 256 + j0);
                    bf16_t* zp = Zb + ((size_t)b * T + 16 * n + s) * ZLD + SU + 16 * g + c0;
                    const u32x4 uu = *(const u32x4*)zp;
                    const f32x4 a0 = acc[ai][bj][m][0], a1 = acc[ai][bj][m][1];
                    float y[8];
                    y[0] = a0[0] + bflo(yp.x) + d0[0] * bflo(uu.x); y[1] = a0[1] + bfhi(yp.x) + d0[1] * bfhi(uu.x);
                    y[2] = a0[2] + bflo(yp.y) + d0[2] * bflo(uu.y); y[3] = a0[3] + bfhi(yp.y) + d0[3] * bfhi(uu.y);
                    y[4] = a1[0] + bflo(yp.z) + d1[0] * bflo(uu.z); y[5] = a1[1] + bfhi(yp.z) + d1[1] * bfhi(uu.z);
                    y[6] = a1[2] + bflo(yp.w) + d1[2] * bflo(uu.w); y[7] = a1[3] + bfhi(yp.w) + d1[3] * bfhi(uu.w);
#pragma unroll
                    for (int e = 0; e < 8; ++e) { const float v = y[e]; y[e] = v * fsigmoid(1.5957691216057308f * (v + 0.044715f * v * v * v)); }
                    u32x4 w; w.x = cvt_pk_bf16(y[0], y[1]); w.y = cvt_pk_bf16(y[2], y[3]); w.z = cvt_pk_bf16(y[4], y[5]); w.w = cvt_pk_bf16(y[6], y[7]);
                    *(u32x4*)zp = w;
                    if (m & 1) asm volatile("" ::: "memory");
                }
        }
    }
};

template <class Epi, class Sched, bool ALIGN_EPI, bool SP2, int AMODE = 0>
__device__ __forceinline__ void gemm_phase(LAS unsigned char* lds, const int wv, const int lda, const int K, const Sched& S, const Epi& E) {
    int tid_ = hw_tid(wv); asm volatile("" : "+v"(tid_));
    const int tid = tid_, wid = __builtin_amdgcn_readfirstlane(tid >> 6), lane = tid & 63, wr = wid >> 2, wc = wid & 3, fr = lane & 15, fq = lane >> 4;
    const int nt = K / BK;
    unsigned voffA[2], voffB[2];
#pragma unroll
    for (int i = 0; i < 2; ++i) { int R, C; stage_rc(tid * 16 + i * 8192, R, C); const int Rb = Epi::PERM ? ((R & ~31) + perm32(R & 31)) : R;
        voffA[i] = AMODE == 0 ? (unsigned)(R * lda + C) * 2u : (unsigned)((16 * R + (C >> 4)) * ZLD + (C & 15)) * 2u; voffB[i] = (unsigned)(Rb * K + C) * 2u; }
    const size_t kstep = (size_t)(BK * 2);
    const size_t kstepA = AMODE == 0 ? (size_t)(BK * 2) : (size_t)4 * ZLD * 2;
    const size_t hA = AMODE == 0 ? (size_t)HALF * lda * 2 : (size_t)HALF * 16 * ZLD * 2, hB = (size_t)HALF * K * 2;
    const unsigned ldsw = (unsigned)wid * 1024u;
    const int aoff = lds_byte(wr * 64 + fr, fq * 8), boff = lds_byte(wc * 32 + fr, fq * 8);
#define PG8_SA(b, h) (((b) * 2 + (h)) * HTB)
#define PG8_SB(b, h) ((4 + (b) * 2 + (h)) * HTB)
#define PG8_STAGE(bufoff, gbase, voff) do { _Pragma("unroll") for (int _i = 0; _i < 2; ++_i) \
        __builtin_amdgcn_global_load_lds((const unsigned*)((const char*)(gbase) + (voff)[_i]), (LAS unsigned*)(lds + (bufoff) + ldsw + _i * 8192), 16, 0, 0); } while (0)
#define PG8_LDA(dst, b, h) do { _Pragma("unroll") for (int m = 0; m < 4; ++m) _Pragma("unroll") for (int k = 0; k < 2; ++k) dst[m][k] = *(const LAS bf16x8*)(lds + PG8_SA(b, h) + aoff + m * 2048 + k * 1024); } while (0)
#define PG8_LDB(dst, b, h) do { _Pragma("unroll") for (int n = 0; n < 2; ++n) _Pragma("unroll") for (int k = 0; k < 2; ++k) dst[n][k] = *(const LAS bf16x8*)(lds + PG8_SB(b, h) + boff + n * 2048 + k * 1024); } while (0)
#define PG8_MMA(ai, bj, At, Bt) do { __builtin_amdgcn_s_setprio(1); _Pragma("unroll") for (int m = 0; m < 4; ++m) _Pragma("unroll") for (int n = 0; n < 2; ++n) _Pragma("unroll") for (int k = 0; k < 2; ++k) \
        acc[ai][bj][m][n] = __builtin_amdgcn_mfma_f32_16x16x32_bf16(Bt[n][k], At[m][k], acc[ai][bj][m][n], 0, 0, 0); __builtin_amdgcn_s_setprio(0); } while (0)
#define PG8_WAIT_V(n) asm volatile("s_waitcnt vmcnt(" #n ")" ::: "memory")
#define PG8_WAIT_L(n) asm volatile("s_waitcnt lgkmcnt(" #n ")" ::: "memory")
#define PG8_BAR __builtin_amdgcn_s_barrier()
#define PG8_SCHED __builtin_amdgcn_sched_barrier(0)
    Unit cur, nxt; int ui = 0;
    if (!S.next(0, cur)) return;
    f32x4 acc[2][2][4][2];
#pragma unroll
    for (int a = 0; a < 2; ++a)
#pragma unroll
        for (int b = 0; b < 2; ++b)
#pragma unroll
            for (int m = 0; m < 4; ++m)
#pragma unroll
                for (int n = 0; n < 2; ++n) acc[a][b][m][n] = (f32x4){0.f, 0.f, 0.f, 0.f};
    bf16x8 At[4][2], B0[2][2], B1[2][2];
    const char* cA = S.Ap(cur); const char* cB = S.Bp(cur);
    if constexpr (SP2) {
        PG8_STAGE(PG8_SB(0, 0), cB, voffB); PG8_STAGE(PG8_SB(0, 1), cB + hB, voffB); PG8_STAGE(PG8_SA(0, 0), cA, voffA); PG8_STAGE(PG8_SA(0, 1), cA + hA, voffA);
        if (wr == 1) PG8_BAR;
        PG8_WAIT_V(2); PG8_BAR;
        PG8_STAGE(PG8_SB(1, 0), cB + kstep, voffB); PG8_STAGE(PG8_SA(1, 0), cA + kstepA, voffA); PG8_STAGE(PG8_SB(1, 1), cB + hB + kstep, voffB);
        PG8_WAIT_V(6); PG8_BAR;
    } else {
        PG8_STAGE(PG8_SB(0, 0), cB, voffB); PG8_STAGE(PG8_SA(0, 0), cA, voffA); PG8_STAGE(PG8_SB(0, 1), cB + hB, voffB); PG8_STAGE(PG8_SA(0, 1), cA + hA, voffA);
        if (wr == 1) PG8_BAR;
        PG8_WAIT_V(4); PG8_BAR;
        PG8_STAGE(PG8_SB(1, 0), cB + kstep, voffB); PG8_STAGE(PG8_SA(1, 0), cA + kstepA, voffA); PG8_STAGE(PG8_SB(1, 1), cB + hB + kstep, voffB);
        PG8_WAIT_V(6); PG8_BAR;
    }
    for (;;) {
        const bool has_next = S.next(ui + 1, nxt);
        const char* nA = has_next ? S.Ap(nxt) : cA; const char* nB = has_next ? S.Bp(nxt) : cB;
        for (int t = 0; t < nt; t += 2) {
            const bool last = (t == nt - 2);
            const char* a1 = cA + (size_t)(t + 1) * kstepA;
            const char* a2 = last ? nA : cA + (size_t)(t + 2) * kstepA; const char* b2 = last ? nB : cB + (size_t)(t + 2) * kstep;
            const char* a3 = a2 + kstepA; const char* b3 = b2 + kstep;
            if constexpr (SP2) {
            PG8_LDB(B0, 0, 0); PG8_LDB(B1, 0, 1); PG8_SCHED; PG8_LDA(At, 0, 0); PG8_STAGE(PG8_SA(1, 1), a1 + hA, voffA);
            PG8_WAIT_V(8); PG8_WAIT_L(0); PG8_BAR; PG8_MMA(0, 0, At, B0); PG8_MMA(0, 1, At, B1); PG8_BAR; PG8_SCHED;
            PG8_LDA(At, 0, 1); PG8_STAGE(PG8_SB(0, 0), b2, voffB); PG8_STAGE(PG8_SB(0, 1), b2 + hB, voffB); PG8_STAGE(PG8_SA(0, 0), a2, voffA);
            PG8_WAIT_V(8); PG8_WAIT_L(0); PG8_BAR; PG8_MMA(1, 0, At, B0); PG8_MMA(1, 1, At, B1); PG8_BAR; PG8_SCHED;
            PG8_LDB(B0, 1, 0); PG8_LDB(B1, 1, 1); PG8_SCHED; PG8_LDA(At, 1, 0); PG8_STAGE(PG8_SA(0, 1), a2 + hA, voffA);
            PG8_WAIT_V(8); PG8_WAIT_L(0); PG8_BAR; PG8_MMA(0, 0, At, B0); PG8_MMA(0, 1, At, B1); PG8_BAR; PG8_SCHED;
            PG8_LDA(At, 1, 1); PG8_STAGE(PG8_SB(1, 0), b3, voffB); PG8_STAGE(PG8_SB(1, 1), b3 + hB, voffB); PG8_STAGE(PG8_SA(1, 0), a3, voffA);
            PG8_WAIT_V(8); PG8_WAIT_L(0); PG8_BAR; PG8_MMA(1, 0, At, B0); PG8_MMA(1, 1, At, B1); PG8_BAR; PG8_SCHED;
            } else {
            PG8_LDB(B0, 0, 0); PG8_SCHED; PG8_LDA(At, 0, 0); PG8_STAGE(PG8_SA(1, 1), a1 + hA, voffA);
            PG8_WAIT_L(8); PG8_BAR; PG8_WAIT_L(0); PG8_MMA(0, 0, At, B0); PG8_BAR; PG8_SCHED;
            PG8_LDB(B1, 0, 1); PG8_STAGE(PG8_SB(0, 0), b2, voffB);
            PG8_BAR; PG8_WAIT_L(0); PG8_MMA(0, 1, At, B1); PG8_BAR;
            PG8_LDA(At, 0, 1); PG8_STAGE(PG8_SA(0, 0), a2, voffA);
            PG8_BAR; PG8_WAIT_L(0); PG8_MMA(1, 0, At, B0); PG8_BAR; PG8_SCHED;
            PG8_STAGE(PG8_SB(0, 1), b2 + hB, voffB);
            PG8_WAIT_V(6); PG8_BAR; PG8_MMA(1, 1, At, B1); PG8_BAR;
            PG8_LDB(B0, 1, 0); PG8_SCHED; PG8_LDA(At, 1, 0); PG8_STAGE(PG8_SA(0, 1), a2 + hA, voffA);
            PG8_WAIT_L(8); PG8_BAR; PG8_WAIT_L(0); PG8_MMA(0, 0, At, B0); PG8_BAR; PG8_SCHED;
            PG8_LDB(B1, 1, 1); PG8_STAGE(PG8_SB(1, 0), b3, voffB);
            PG8_BAR; PG8_WAIT_L(0); PG8_MMA(0, 1, At, B1); PG8_BAR;
            PG8_LDA(At, 1, 1); PG8_STAGE(PG8_SA(1, 0), a3, voffA);
            PG8_BAR; PG8_WAIT_L(0); PG8_MMA(1, 0, At, B0); PG8_BAR; PG8_SCHED;
            PG8_STAGE(PG8_SB(1, 1), b3 + hB, voffB);
            PG8_WAIT_V(6); PG8_BAR; PG8_MMA(1, 1, At, B1); PG8_BAR;
            }
        }
        if constexpr (ALIGN_EPI) { if (wr == 0) PG8_BAR; }
        { const int lane_e = hw_lane();
          E(acc, cur, wr, wc, lane_e & 15, lane_e >> 4); }
        if (!has_next) break;
        if (!E.keep(cur)) {
#pragma unroll
        for (int a = 0; a < 2; ++a)
#pragma unroll
            for (int b = 0; b < 2; ++b)
#pragma unroll
                for (int m = 0; m < 4; ++m)
#pragma unroll
                    for (int n = 0; n < 2; ++n) acc[a][b][m][n] = (f32x4){0.f, 0.f, 0.f, 0.f};
        }
        cur = nxt; cA = nA; cB = nB; ++ui;
        if constexpr (ALIGN_EPI) { if (wr == 1) PG8_BAR; }
    }
    PG8_WAIT_V(0);
    if constexpr (!ALIGN_EPI) { if (wr == 0) PG8_BAR; }
    PG8_BAR;
#undef PG8_SA
#undef PG8_SB
#undef PG8_STAGE
#undef PG8_LDA
#undef PG8_LDB
#undef PG8_MMA
#undef PG8_WAIT_V
#undef PG8_WAIT_L
#undef PG8_BAR
#undef PG8_SCHED
}
}

#define XB_TMO      128
#define XB_XCNT(j)  (256  + 64 * (j))
#define XB_XSUB(j)  (1280 + 64 * (j))
#define XB_XGEN(j)  (2304 + 64 * (j))
#define XB_TOP      3328
#define XB_TOPGEN   3392
#define XCD_BAR_WORDS 3456
#define XB_SPIN_CAP (1u << 18)
__device__ __forceinline__ unsigned xb_ld(unsigned* p)              { return __hip_atomic_load(p, __ATOMIC_RELAXED, __HIP_MEMORY_SCOPE_AGENT); }
__device__ __forceinline__ unsigned xb_add(unsigned* p, unsigned v) { return __hip_atomic_fetch_add(p, v, __ATOMIC_RELAXED, __HIP_MEMORY_SCOPE_AGENT); }
__device__ __forceinline__ unsigned xb_xcc_id() { return (unsigned)__builtin_amdgcn_s_getreg((3 << 11) | 20) & 0xFu; }
#define XB_SPIN(cond, bar) do { unsigned _sp = 0; while (cond) { __builtin_amdgcn_s_sleep(1); \
    if ((++_sp & 255u) == 0u) { if (xb_ld(&(bar)[XB_TMO])) break; if (_sp > XB_SPIN_CAP) { atomicAdd(&(bar)[XB_TMO], 1u); break; } } } } while (0)
struct XcdBarrier { unsigned* bar; unsigned x; volatile LAS unsigned* st; };
__device__ __forceinline__ XcdBarrier xcd_barrier_post(unsigned* bar, volatile LAS unsigned* st) {
    XcdBarrier b; b.bar = bar; b.x = xb_xcc_id(); b.st = st;
    if (threadIdx.x == 0) (void)xb_add(&bar[XB_XCNT(b.x)], 1u);
    return b;
}
__device__ __forceinline__ void xcd_barrier_complete(unsigned* bar, unsigned x, unsigned& nloc, unsigned& nx) {
    const unsigned G = gridDim.x * gridDim.y * gridDim.z;
    unsigned sum, cnt, mine, sp = 0u;
    for (;;) {
        sum = 0u; cnt = 0u; mine = 0u;
#pragma unroll
        for (unsigned j = 0; j < 16; ++j) { const unsigned c = xb_ld(&bar[XB_XCNT(j)]); sum += c; cnt += (c > 0u) ? 1u : 0u; mine = (j == x) ? c : mine; }
        if (sum == G) break;
        __builtin_amdgcn_s_sleep(1);
        if ((++sp & 255u) == 0u) { if (xb_ld(&bar[XB_TMO])) break; if (sp > XB_SPIN_CAP) { atomicAdd(&bar[XB_TMO], 1u); break; } }
    }
    nloc = mine > 0u ? mine : 1u; nx = cnt > 0u ? cnt : 1u;
}
__device__ __forceinline__ void xcd_barrier(const XcdBarrier& b, const int wv) {
    asm volatile("s_waitcnt vmcnt(0)" ::: "memory");
    __syncthreads();
    if (wv == 0 && hw_lane() == 0) {
        unsigned* bar = b.bar;
        __builtin_amdgcn_s_waitcnt(0);
        unsigned nloc = b.st[0], nx = b.st[1];
        if (nloc == 0u) { xcd_barrier_complete(bar, b.x, nloc, nx); b.st[0] = nloc; b.st[1] = nx; }
        const unsigned old = xb_add(&bar[XB_XSUB(b.x)], 1u);
        const unsigned gen = old / nloc;
        if (old + 1u == (gen + 1u) * nloc) {
            __builtin_amdgcn_fence(__ATOMIC_RELEASE, "agent");
            asm volatile("s_waitcnt vmcnt(0)" ::: "memory");
            const unsigned og = xb_add(&bar[XB_TOP], 1u);
            const unsigned tg = og / nx;
            if (og + 1u == (tg + 1u) * nx) xb_add(&bar[XB_TOPGEN], 1u);
            else XB_SPIN(xb_ld(&bar[XB_TOPGEN]) == tg, bar);
            __builtin_amdgcn_fence(__ATOMIC_ACQUIRE, "agent");
            xb_add(&bar[XB_XGEN(b.x)], 1u);
            asm volatile("s_waitcnt vmcnt(0)" ::: "memory");
        } else {
            XB_SPIN(xb_ld(&bar[XB_XGEN(b.x)]) == gen, bar);
            __builtin_amdgcn_fence(__ATOMIC_ACQUIRE, "agent");
            asm volatile("s_waitcnt vmcnt(0)" ::: "memory");
        }
    }
    __syncthreads();
}

struct Args { const float* in[33]; float* out; unsigned char* ws; };
__device__ __forceinline__ const float* inp(int i) {
    unsigned off = (unsigned)i * 8u; asm volatile("" : "+s"(off));
    typedef const float* cfp;
    return *(const __attribute__((address_space(4))) cfp*)((const __attribute__((address_space(4))) char*)__builtin_amdgcn_kernarg_segment_ptr() + off);
}

#define WSP(off) (inp_ws() + (off))
__device__ __forceinline__ unsigned char* inp_ws() { return (unsigned char*)inp(34); }
__device__ __forceinline__ float* inp_out() { return (float*)inp(33); }

__device__ __forceinline__ void transpose_item(const float* W, int ldw, int K, bf16_t* WT, int src_n0, int dst_n0, int k0, LAS float* scr, int lane) {
#pragma unroll 8
    for (int i = 0; i < 32; ++i) { const int kk = 2 * i + (lane >> 5); scr[kk * 33 + (lane & 31)] = W[(size_t)(k0 + kk) * ldw + src_n0 + (lane & 31)]; }
    LDS_WAIT(); asm volatile("" ::: "memory");
    const int c = lane & 7;
#pragma unroll
    for (int j = 0; j < 4; ++j) { const int n = (lane >> 3) + 8 * j; const LAS float* s = scr + (8 * c) * 33 + n;
        u32x4 o; o.x = pk2(s[0 * 33], s[1 * 33]); o.y = pk2(s[2 * 33], s[3 * 33]); o.z = pk2(s[4 * 33], s[5 * 33]); o.w = pk2(s[6 * 33], s[7 * 33]);
        *(u32x4*)(WT + (size_t)(dst_n0 + n) * K + k0 + 8 * c) = o; }
    LDS_WAIT(); asm volatile("" ::: "memory");
}
template <int MAP>
__device__ __forceinline__ void convert_matrix(const float* W, int ldw, int K, int Ndst, bf16_t* WT, LAS float* scr, int lane, int gw, int NGW, int& base) {
    const int nblk = Ndst / 32, nitems = (K / 64) * nblk;
    int first = (gw - base % NGW + NGW) % NGW;
    for (int it = first; it < nitems; it += NGW) {
        const int kb = it / nblk, nb = it % nblk, d0 = nb * 32;
        int s0 = d0;
        if (MAP == 1) s0 = d0 + (d0 < 1024 ? 0 : (d0 < 2560 ? 16 : 24));
        if (MAP == 2) { const int pn = d0 >> 8, hh = (d0 & 255) >> 7, r = d0 & 127; s0 = hh * FF + pn * 128 + r; }
        transpose_item(W, ldw, K, WT, s0, d0, kb * 64, scr, lane);
    }
    base += nitems;
}

__device__ __forceinline__ void ada_phase(LAS unsigned char* lds, int blk, int wave, int lane) {
    if (blk >= 192) return;
    const int l = blk / 96, n0 = (blk % 96) * 64;
    const float* c = inp(1); const float* W = inp(2) + (size_t)l * 1024 * 6144; const float* bias = inp(3) + l * 6144;
    LAS float* part = (LAS float*)lds;
    float acc[8] = {0.f, 0.f, 0.f, 0.f, 0.f, 0.f, 0.f, 0.f};
    for (int k = wave * 128; k < wave * 128 + 128; ++k) {
        const float wv = W[(size_t)k * 6144 + n0 + lane];
#pragma unroll
        for (int b = 0; b < 8; ++b) { const float cv = c[b * 1024 + k]; acc[b] += siluf_(cv) * wv; }
    }
#pragma unroll
    for (int b = 0; b < 8; ++b) part[(wave * 8 + b) * 64 + lane] = acc[b];
    __syncthreads();
    {
        const int b = wave; float s = bias[n0 + lane];
#pragma unroll
        for (int w = 0; w < 8; ++w) s += part[(w * 8 + b) * 64 + lane];
        ((float*)WSP(WS_MOD))[(size_t)(l * 8 + b) * 6144 + n0 + lane] = s;
    }
    __syncthreads();
}

template <bool WITH_ZS>
__device__ __forceinline__ void prenorm_rows(const float* x, const float* w, const float* modl, int sh_off, int sc_off, bf16_t* H, float* ZS, const LAS float* wsm, int gw, int NGW, int lane) {
    for (int row = gw; row < M; row += NGW) {
        const int b = row / T;
        const f32x4* xr = (const f32x4*)(x + (size_t)row * D);
        f32x4 v[4]; float ss = 0.f;
#pragma unroll
        for (int j = 0; j < 4; ++j) { v[j] = xr[lane + 64 * j]; ss += v[j][0] * v[j][0] + v[j][1] * v[j][1] + v[j][2] * v[j][2] + v[j][3] * v[j][3]; }
        ss = wave_sum(ss, lane);
        const float r = rsqrtf(ss * (1.f / D) + 1e-6f);
        const float* sh = modl + (size_t)b * 6144 + sh_off; const float* sc = modl + (size_t)b * 6144 + sc_off;
#pragma unroll
        for (int j = 0; j < 4; ++j) {
            const int col = (lane + 64 * j) * 4;
            const f32x4 wv = *(const f32x4*)(w + col), scv = *(const f32x4*)(sc + col), shv = *(const f32x4*)(sh + col);
#pragma unroll
            for (int e = 0; e < 4; ++e) v[j][e] = v[j][e] * r * wv[e] * (1.f + scv[e]) + shv[e];
            u32x2 o; o.x = pk2(v[j][0], v[j][1]); o.y = pk2(v[j][2], v[j][3]);
            *(u32x2*)(H + (size_t)row * D + col) = o;
        }
        if (WITH_ZS) {
            float res = 0.f;
#pragma unroll 4
            for (int c = 0; c < 24; ++c) {
                float p = 0.f;
#pragma unroll
                for (int j = 0; j < 4; ++j) { const f32x4 wv = *(const LAS f32x4*)(wsm + c * 1024 + (lane + 64 * j) * 4); p += v[j][0] * wv[0] + v[j][1] * wv[1] + v[j][2] * wv[2] + v[j][3] * wv[3]; }
                p = wave_sum(p, lane);
                res = (lane == c) ? p : res;
            }
            if (lane < 24) ZS[(size_t)row * 32 + lane] = res;
        }
    }
}
template <bool WITH_PRE, bool WITH_ZS>
__device__ __forceinline__ void postpre_rows(const bf16_t* Y, int ldy, const float* xold, const float* pw, const float* modl_post, int gt_off, float* xout,
                                             const float* w2, const float* modl_pre, int sh_off, int sc_off, bf16_t* H, float* ZS, const LAS float* wsm, int gw, int NGW, int lane) {
    for (int row = gw; row < M; row += NGW) {
        const int b = row / T;
        f32x4 v[4]; float ss = 0.f;
#pragma unroll
        for (int j = 0; j < 4; ++j) { const u32x2 y = *(const u32x2*)(Y + (size_t)row * ldy + (lane + 64 * j) * 4);
            v[j] = (f32x4){bflo(y.x), bfhi(y.x), bflo(y.y), bfhi(y.y)}; ss += v[j][0] * v[j][0] + v[j][1] * v[j][1] + v[j][2] * v[j][2] + v[j][3] * v[j][3]; }
        ss = wave_sum(ss, lane);
        const float r = rsqrtf(ss * (1.f / D) + 1e-6f);
        const float* gt = modl_post + (size_t)b * 6144 + gt_off;
        float ss2 = 0.f;
#pragma unroll
        for (int j = 0; j < 4; ++j) {
            const int col = (lane + 64 * j) * 4;
            const f32x4 xo = *(const f32x4*)(xold + (size_t)row * D + col), pwv = *(const f32x4*)(pw + col), gtv = *(const f32x4*)(gt + col);
#pragma unroll
            for (int e = 0; e < 4; ++e) { v[j][e] = xo[e] + (1.f + gtv[e]) * (v[j][e] * r * pwv[e]); ss2 += v[j][e] * v[j][e]; }
            *(f32x4*)(xout + (size_t)row * D + col) = v[j];
        }
        if (WITH_PRE) {
            ss2 = wave_sum(ss2, lane);
            const float r2 = rsqrtf(ss2 * (1.f / D) + 1e-6f);
            const float* sh = modl_pre + (size_t)b * 6144 + sh_off; const float* sc = modl_pre + (size_t)b * 6144 + sc_off;
#pragma unroll
            for (int j = 0; j < 4; ++j) {
                const int col = (lane + 64 * j) * 4;
                const f32x4 wv = *(const f32x4*)(w2 + col), scv = *(const f32x4*)(sc + col), shv = *(const f32x4*)(sh + col);
#pragma unroll
                for (int e = 0; e < 4; ++e) v[j][e] = v[j][e] * r2 * wv[e] * (1.f + scv[e]) + shv[e];
                u32x2 o; o.x = pk2(v[j][0], v[j][1]); o.y = pk2(v[j][2], v[j][3]);
                *(u32x2*)(H + (size_t)row * D + col) = o;
            }
            if (WITH_ZS) {
                float res = 0.f;
#pragma unroll 4
                for (int c = 0; c < 24; ++c) {
                    float p = 0.f;
#pragma unroll
                    for (int j = 0; j < 4; ++j) { const f32x4 wv = *(const LAS f32x4*)(wsm + c * 1024 + (lane + 64 * j) * 4); p += v[j][0] * wv[0] + v[j][1] * wv[1] + v[j][2] * wv[2] + v[j][3] * wv[3]; }
                    p = wave_sum(p, lane);
                    res = (lane == c) ? p : res;
                }
                if (lane < 24) ZS[(size_t)row * 32 + lane] = res;
            }
        }
    }
}
__device__ __forceinline__ void stage_wsmall(const float* w_in, LAS float* wsm, int tid) {
    for (int k = tid; k < 1024; k += NWAVES * 64) {
        const float* src = w_in + (size_t)k * INDIM;
#pragma unroll
        for (int c = 0; c < 16; ++c) wsm[c * 1024 + k] = src[1024 + c];
#pragma unroll
        for (int c = 0; c < 8; ++c) wsm[(16 + c) * 1024 + k] = src[2576 + c];
    }
    __syncthreads();
}

__device__ __forceinline__ void s5_generate(int l, int g, LAS unsigned char* lds, int wv) {
    int tid = hw_tid(wv); asm volatile("" : "+v"(tid));
    LAS float* ar = (LAS float*)lds;
    LAS float* ai = ar + 17 * 64;
    LAS float* bbr = ai + 17 * 64;
    LAS float* bbi = bbr + 1024;
    LAS float* cr = bbi + 1024;
    LAS float* ci = cr + 1024;
    LAS float* Kt = ci + 1024;
    bf16_t* Bt1 = (bf16_t*)WSP(WS_S5M1) + (size_t)g * 384 * 256;
    bf16_t* Bt3 = (bf16_t*)WSP(WS_S5M3) + (size_t)g * 256 * 256;
    __syncthreads();
    if (tid < 64) {
        const int p = tid;
        const float lre = fminf((inp(16) + l * 2048)[g * 64 + p], -1e-4f), lim = (inp(17) + l * 2048)[g * 64 + p], dt = expf((inp(18) + l * 32)[g]);
        for (int k = 0; k <= 16; ++k) { const float mg = expf((float)k * lre * dt), an = (float)k * lim * dt; ar[k * 64 + p] = mg * cosf(an); ai[k * 64 + p] = mg * sinf(an); }
        const float a1r = ar[64 + p], a1i = ai[64 + p];
        const float inv = 1.f / (lre * lre + lim * lim);
        const float zr_ = ((a1r - 1.f) * lre + a1i * lim) * inv, zi_ = (a1i * lre - (a1r - 1.f) * lim) * inv;
        const float* b_re = inp(19) + (size_t)l * 32768 + (size_t)(g * 64 + p) * 16; const float* b_im = inp(20) + (size_t)l * 32768 + (size_t)(g * 64 + p) * 16;
        for (int c = 0; c < 16; ++c) { const float br = b_re[c], bi = b_im[c]; bbr[p * 16 + c] = zr_ * br - zi_ * bi; bbi[p * 16 + c] = zr_ * bi + zi_ * br; }
    }
    for (int i = tid; i < 1024; i += 512) { cr[i] = (inp(21) + (size_t)l * 32768)[g * 1024 + i]; ci[i] = (inp(22) + (size_t)l * 32768)[g * 1024 + i]; }
    __syncthreads();
    {
        const int cp = tid >> 5, c = (tid >> 1) & 15, ph = tid & 1;
        float acc[16];
#pragma unroll
        for (int t = 0; t < 16; ++t) acc[t] = 0.f;
        for (int pp = 0; pp < 32; ++pp) {
            const int p = 32 * ph + pp;
            const float xr = cr[cp * 64 + p], xi = ci[cp * 64 + p], yr = bbr[p * 16 + c], yi = bbi[p * 16 + c];
            const float cbr = xr * yr - xi * yi, cbi = xr * yi + xi * yr;
#pragma unroll
            for (int t = 0; t < 16; ++t) acc[t] += cbr * ar[t * 64 + p] - cbi * ai[t * 64 + p];
        }
#pragma unroll
        for (int t = 0; t < 16; ++t) { const float o = acc[t] + shl(acc[t], (tid & 63) ^ 1); if (ph == 0) Kt[(t * 16 + cp) * 16 + c] = o; }
    }
    __syncthreads();
    for (int pc = tid; pc < 128 * 32; pc += 512) {
        const int row = pc >> 5, k0 = (pc & 31) * 8, sp = k0 >> 4, c0 = k0 & 15, p = row & 63, e15 = 15 - sp;
        const float xr = ar[e15 * 64 + p], xi = ai[e15 * 64 + p];
        float v[8];
#pragma unroll
        for (int e = 0; e < 8; ++e) { const float yr = bbr[p * 16 + c0 + e], yi = bbi[p * 16 + c0 + e]; v[e] = row < 64 ? (xr * yr - xi * yi) : (xr * yi + xi * yr); }
        u32x4 w; w.x = pk2(v[0], v[1]); w.y = pk2(v[2], v[3]); w.z = pk2(v[4], v[5]); w.w = pk2(v[6], v[7]);
        *(u32x4*)(Bt1 + (size_t)row * 256 + k0) = w;
    }
    for (int pc = tid; pc < 256 * 32; pc += 512) {
        const int j = pc >> 5, k0 = (pc & 31) * 8, s = j >> 4, cp = j & 15, sp = k0 >> 4, c0 = k0 & 15;
        float v[8];
#pragma unroll
        for (int e = 0; e < 8; ++e) v[e] = (sp <= s) ? Kt[((s - sp) * 16 + cp) * 16 + c0 + e] : 0.f;
        u32x4 w; w.x = pk2(v[0], v[1]); w.y = pk2(v[2], v[3]); w.z = pk2(v[4], v[5]); w.w = pk2(v[6], v[7]);
        *(u32x4*)(Bt1 + (size_t)(128 + j) * 256 + k0) = w;
    }
    for (int pc = tid; pc < 256 * 32; pc += 512) {
        const int j = pc >> 5, k0 = (pc & 31) * 8, s = j >> 4, cp = j & 15;
        float v[8];
#pragma unroll
        for (int e = 0; e < 8; ++e) {
            const int k = k0 + e, p = k & 63;
            const float xr = cr[cp * 64 + p], xi = ci[cp * 64 + p], yr = ar[(s + 1) * 64 + p], yi = ai[(s + 1) * 64 + p];
            v[e] = k < 64 ? (xr * yr - xi * yi) : (k < 128 ? -(xr * yi + xi * yr) : 0.f);
        }
        u32x4 w; w.x = pk2(v[0], v[1]); w.y = pk2(v[2], v[3]); w.z = pk2(v[4], v[5]); w.w = pk2(v[6], v[7]);
        *(u32x4*)(Bt3 + (size_t)j * 256 + k0) = w;
    }
    __syncthreads();
}
__device__ __forceinline__ void s5_scan(int l, int sid, int lane) {
    const int g = sid >> 3, b = sid & 7, p = lane;
    const float lre = fminf((inp(16) + l * 2048)[g * 64 + p], -1e-4f), lim = (inp(17) + l * 2048)[g * 64 + p], dt = expf((inp(18) + l * 32)[g]);
    const float mg = expf(16.f * lre * dt), an = 16.f * lim * dt, a16r = mg * cosf(an), a16i = mg * sinf(an);
    float* base = (float*)WSP(WS_EX) + (size_t)(g * 2048 + b * 256) * 128;
    float xr = 0.f, xi = 0.f;
    float er[8], ei[8], nr[8], ni[8];
#pragma unroll
    for (int j = 0; j < 8; ++j) { er[j] = base[(size_t)j * 128 + p]; ei[j] = base[(size_t)j * 128 + 64 + p]; }
#pragma unroll 1
    for (int n0 = 0; n0 < 256; n0 += 8) {
        if (n0 + 8 < 256) {
#pragma unroll
            for (int j = 0; j < 8; ++j) { nr[j] = base[(size_t)(n0 + 8 + j) * 128 + p]; ni[j] = base[(size_t)(n0 + 8 + j) * 128 + 64 + p]; }
        }
        asm volatile("s_waitcnt vmcnt(16)" ::: "memory");
#pragma unroll
        for (int j = 0; j < 8; ++j) {
            bf16_t* row = (bf16_t*)(base + (size_t)(n0 + j) * 128);
            row[p] = (bf16_t)f2bf(xr); row[64 + p] = (bf16_t)f2bf(xi); ((unsigned*)row)[64 + p] = 0u;
            const float tr = a16r * xr - a16i * xi + er[j], ti = a16r * xi + a16i * xr + ei[j];
            xr = tr; xi = ti;
        }
#pragma unroll
        for (int j = 0; j < 8; ++j) { er[j] = nr[j]; ei[j] = ni[j]; }
    }
}

namespace mx {
typedef float f32x16 __attribute__((ext_vector_type(16)));
constexpr int PB = 72;
constexpr int L_QS = 0, L_KS = 9216, L_KT = 18432, L_VT = 27648, L_PS = 46080, L_ST = 55296, L_OS = 73728, L_VEC = 107520;
constexpr int OSP = 132;
constexpr int V_SEG = 0, V_ELAST = 512, V_GA = 576, V_RT = 1600, V_CS = 1664, V_WI = 1728, V_WK = 1792, V_ENM = 1856, V_DEN = 1920, V_NORM = 1984, V_SC = 2112, V_END = 2128;
static_assert(L_VEC + V_END * 4 <= RING_BYTES, "mixer LDS map");
__device__ __forceinline__ int crow(int reg, int hh) { return (reg & 3) + 8 * (reg >> 2) + 4 * hh; }
__device__ __forceinline__ float fexp(float x) { return __builtin_amdgcn_exp2f(1.4426950408889634f * x); }
__device__ __forceinline__ float flogsig(float x) { const float e = fexp(-fabsf(x)); return fminf(x, 0.f) - 0.6931471805599453f * __builtin_amdgcn_logf(1.f + e); }
#define MX_MFMA(a, b, c) __builtin_amdgcn_mfma_f32_32x32x16_bf16((a), (b), (c), 0, 0, 0)

template <int ROLE, bool STORE = true>
__device__ __forceinline__ void stream(int l, LAS unsigned char* lds, int bh, int wvs) {
    int tid = hw_tid(wvs); asm volatile("" : "+v"(tid));
    const int lane = tid & 63, w = __builtin_amdgcn_readfirstlane(tid >> 6), r32 = lane & 31, hh = lane >> 5;
    const int b = bh >> 2, h = bh & 3;
    bf16_t* Z = (bf16_t*)WSP(WS_Z); const float* ZS = (const float*)WSP(WS_ZS);
    LAS float* vec = (LAS float*)(lds + L_VEC);
    LAS bf16_t* Qs = (LAS bf16_t*)(lds + L_QS); LAS bf16_t* Ks = (LAS bf16_t*)(lds + L_KS); LAS bf16_t* KTs = (LAS bf16_t*)(lds + L_KT);
    LAS bf16_t* VTs = (LAS bf16_t*)(lds + L_VT); LAS bf16_t* Ps = (LAS bf16_t*)(lds + L_PS); LAS bf16_t* STs = (LAS bf16_t*)(lds + L_ST);
    LAS float* Os = (LAS float*)(lds + L_OS);
    const int qcol = (ROLE == 0 ? GQ : MQ) + h * 64, kcol = (ROLE == 0 ? GK : MK) + h * 64, vcol = (ROLE == 0 ? GV : MV) + h * 128, gcol = (ROLE == 0 ? GR : MO) + h * 128;
    const int vc_ = tid & 127, rq = tid >> 7, et = tid >> 3, cg = tid & 7;
    const int wa = w >> 2, wv = w & 3;
    float a2c[16], abd = 0.f, nwv[16];
    float cwq[4], cwk[4], cbq = 0.f, cbk = 0.f, ibh = 0.f, fbh = 0.f, mprev = 0.f;
#pragma unroll
    for (int r = 0; r < 16; ++r) { a2c[r] = 0.f; nwv[r] = 0.f; }
#pragma unroll
    for (int j = 0; j < 4; ++j) { cwq[j] = 0.f; cwk[j] = 0.f; }
    if (ROLE == 0) {
        const float* a2 = inp(9) + l * 16 * 256; const float* ab = inp(10) + l * 256; const float* nw = inp(11) + l * 512;
#pragma unroll
        for (int r = 0; r < 16; ++r) { a2c[r] = a2[r * 256 + h * 64 + lane]; nwv[r] = nw[h * 128 + 16 * cg + r]; }
        abd = ab[h * 64 + lane];
    } else {
        const float* cw = inp(12) + l * 4 * 512; const float* cb = inp(13) + l * 512;
#pragma unroll
        for (int j = 0; j < 4; ++j) { cwq[j] = cw[j * 512 + h * 64 + lane]; cwk[j] = cw[j * 512 + 256 + h * 64 + lane]; }
        cbq = cb[h * 64 + lane]; cbk = cb[256 + h * 64 + lane];
        ibh = (inp(14) + l * 4)[h]; fbh = (inp(15) + l * 4)[h];
    }
    for (int i = tid; i < 128 * PB / 2; i += 512) ((LAS unsigned*)STs)[i] = 0u;
    for (int i = tid; i < 64 * PB / 2; i += 512) ((LAS unsigned*)Ps)[i] = 0u;
    if (tid < 128) vec[V_NORM + tid] = 0.f;
    f32x16 accS;
#pragma unroll
    for (int r = 0; r < 16; ++r) accS[r] = 0.f;
    unsigned qi[11], ki[11], vi[16]; float zs0 = 0.f, zs1 = 0.f; u32x4 gt0 = {0u, 0u, 0u, 0u}, gt1 = {0u, 0u, 0u, 0u};
#define MX_LOAD(mrow, nn) do { \
        if (ROLE == 0) { \
            _Pragma("unroll") for (int i = 0; i < 8; ++i) { const bf16_t* zr = Z + ((mrow) + 8 * w + i) * ZLD; qi[i] = *(const unsigned*)(zr + qcol + (lane & ~1)); ki[i] = *(const unsigned*)(zr + kcol + (lane & ~1)); } \
            const float* zp = ZS + ((mrow) + et) * 32 + 2 * cg; zs0 = zp[0]; zs1 = zp[1]; \
        } else { \
            _Pragma("unroll") for (int i = 0; i < 11; ++i) { const int trel = 8 * w + i - 3; const int trc = ((nn) > 0 || trel >= 0) ? trel : 0;     \
                const bf16_t* zr = Z + ((mrow) + trc) * ZLD; qi[i] = *(const unsigned*)(zr + qcol + (lane & ~1)); ki[i] = *(const unsigned*)(zr + kcol + (lane & ~1)); } \
            if (w == 0) { const float* zp = ZS + ((mrow) + lane) * 32; zs0 = zp[16 + h]; zs1 = zp[20 + h]; } \
        } \
        _Pragma("unroll") for (int i = 0; i < 16; ++i) vi[i] = *(const unsigned*)(Z + ((mrow) + 16 * rq + i) * ZLD + vcol + (vc_ & ~1)); \
    } while (0)
#define MX_PIN11(a) asm volatile("" : "+v"(a[0]), "+v"(a[1]), "+v"(a[2]), "+v"(a[3]), "+v"(a[4]), "+v"(a[5]), "+v"(a[6]), "+v"(a[7]), "+v"(a[8]), "+v"(a[9]), "+v"(a[10]))
#define MX_PIN8(a, o) asm volatile("" : "+v"(a[o]), "+v"(a[o + 1]), "+v"(a[o + 2]), "+v"(a[o + 3]), "+v"(a[o + 4]), "+v"(a[o + 5]), "+v"(a[o + 6]), "+v"(a[o + 7]))
    size_t m0 = (size_t)b * T;
    MX_LOAD(m0, 0);
    if (ROLE == 0) { vec[V_GA + et * 16 + 2 * cg] = zs0; vec[V_GA + et * 16 + 2 * cg + 1] = zs1; }
    __syncthreads();

#pragma unroll 1
    for (int n = 0; n <= 64; ++n) {
        if (n > 0) {
            const size_t mp = m0 - 64;
            const LAS float* orow = Os + et * OSP + 16 * cg;
            float o[16];
#pragma unroll
            for (int q4 = 0; q4 < 4; ++q4) { const f32x4 t4 = *(const LAS f32x4*)(orow + 4 * q4); o[4 * q4] = t4[0]; o[4 * q4 + 1] = t4[1]; o[4 * q4 + 2] = t4[2]; o[4 * q4 + 3] = t4[3]; }
            asm volatile("" : "+v"(gt0), "+v"(gt1));
            const unsigned gw_[8] = {gt0.x, gt0.y, gt0.z, gt0.w, gt1.x, gt1.y, gt1.z, gt1.w};
            float y[16];
            if (ROLE == 0) {
                float ss = 0.f;
#pragma unroll
                for (int e = 0; e < 16; ++e) ss += o[e] * o[e];
                ss += shl(ss, lane ^ 1); ss += shl(ss, lane ^ 2); ss += shl(ss, lane ^ 4);
                const float rn = rsqrtf(ss * (1.f / 128.f) + 1e-6f);
#pragma unroll
                for (int e = 0; e < 16; ++e) { const float g = (e & 1) ? bfhi(gw_[e >> 1]) : bflo(gw_[e >> 1]); y[e] = o[e] * rn * nwv[e] * g * fsigmoid(g); }
            } else {
                const float rdiv = vec[V_DEN + et];
#pragma unroll
                for (int e = 0; e < 16; ++e) { const float g = (e & 1) ? bfhi(gw_[e >> 1]) : bflo(gw_[e >> 1]); y[e] = o[e] * rdiv * fsigmoid(g); }
            }
            u32x4 s0, s1;
            s0.x = pk2(y[0], y[1]); s0.y = pk2(y[2], y[3]); s0.z = pk2(y[4], y[5]); s0.w = pk2(y[6], y[7]);
            s1.x = pk2(y[8], y[9]); s1.y = pk2(y[10], y[11]); s1.z = pk2(y[12], y[13]); s1.w = pk2(y[14], y[15]);
            bf16_t* dst = Z + (mp + et) * ZLD + gcol + 16 * cg;
            if (STORE) { *(u32x4*)dst = s0; *(u32x4*)(dst + 8) = s1; } else { asm volatile("" :: "v"(s0), "v"(s1), "v"(dst)); }
        }
        if (n == 64) break;
        if (ROLE == 0) { MX_PIN8(qi, 0); MX_PIN8(ki, 0); } else { MX_PIN11(qi); MX_PIN11(ki); if (n == 0 && w == 0) { qi[0] = qi[1] = qi[2] = 0u; ki[0] = ki[1] = ki[2] = 0u; } }
        asm volatile("" : "+v"(zs0), "+v"(zs1));
        float c8[8], qf[8], kf[8];
        if (ROLE == 0) {
            float run = 0.f;
#pragma unroll
            for (int i = 0; i < 8; ++i) {
                const LAS f32x4* gp = (const LAS f32x4*)(vec + V_GA + (8 * w + i) * 16);
                float x = abd;
#pragma unroll
                for (int r4 = 0; r4 < 4; ++r4) { const f32x4 g4 = gp[r4]; x += g4[0] * a2c[4 * r4] + g4[1] * a2c[4 * r4 + 1] + g4[2] * a2c[4 * r4 + 2] + g4[3] * a2c[4 * r4 + 3]; }
                run += flogsig(x) * (1.f / 16.f); c8[i] = run;
                qf[i] = ((lane & 1) ? bfhi(qi[i]) : bflo(qi[i])) * 0.125f; kf[i] = (lane & 1) ? bfhi(ki[i]) : bflo(ki[i]);
            }
            vec[V_SEG + w * 64 + lane] = run;
        } else {
#pragma unroll
            for (int i = 0; i < 8; ++i) {
                float aq = cbq, ak = cbk;
#pragma unroll
                for (int j = 0; j < 4; ++j) { aq += cwq[j] * ((lane & 1) ? bfhi(qi[i + j]) : bflo(qi[i + j])); ak += cwk[j] * ((lane & 1) ? bfhi(ki[i + j]) : bflo(ki[i + j])); }
                qf[i] = aq * fsigmoid(aq); kf[i] = ak * fsigmoid(ak) * 0.125f; c8[i] = 0.f;
            }
            if (w == 0) {
                const float ip = zs0 + ibh, lf = logsigmoidf_(zs1 + fbh);
                float bs = lf;
#pragma unroll
                for (int o = 1; o < 64; o <<= 1) { const float t = shl(bs, lane >= o ? lane - o : lane); if (lane >= o) bs += t; }
                const float cs = ip - bs;
                float pm = cs;
#pragma unroll
                for (int o = 1; o < 64; o <<= 1) { const float t = shl(pm, lane >= o ? lane - o : lane); if (lane >= o) pm = fmaxf(pm, t); }
                const float mt = bs + fmaxf(mprev, pm);
                vec[V_RT + lane] = bs - mt; vec[V_CS + lane] = cs; vec[V_WI + lane] = expf(bs + mprev - mt); vec[V_ENM + lane] = expf(-mt);
                const float mnew = shl(mt, 63), b63 = shl(bs, 63);
                vec[V_WK + lane] = expf(b63 + cs - mnew);
                if (lane == 0) vec[V_SC] = expf(b63 + mprev - mnew);
                mprev = mnew;
            }
        }
        __syncthreads();
        {
            u32x4 ktp; unsigned ktw[4];
            if (ROLE == 0) {
                float off = 0.f, tot = 0.f;
#pragma unroll
                for (int w2 = 0; w2 < 8; ++w2) { const float s = vec[V_SEG + w2 * 64 + lane]; tot += s; off += (w2 < w) ? s : 0.f; }
                if (w == 0) vec[V_ELAST + lane] = fexp(tot);
                float kt[8];
#pragma unroll
                for (int i = 0; i < 8; ++i) {
                    const float cum = off + c8[i];
                    Qs[(8 * w + i) * PB + lane] = (bf16_t)f2bf(qf[i] * fexp(cum));
                    Ks[(8 * w + i) * PB + lane] = (bf16_t)f2bf(kf[i] * fexp(-cum));
                    kt[i] = kf[i] * fexp(tot - cum);
                }
#pragma unroll
                for (int i = 0; i < 4; ++i) ktw[i] = pk2(kt[2 * i], kt[2 * i + 1]);
            } else {
                float kt[8];
#pragma unroll
                for (int i = 0; i < 8; ++i) {
                    Qs[(8 * w + i) * PB + lane] = (bf16_t)f2bf(qf[i]);
                    Ks[(8 * w + i) * PB + lane] = (bf16_t)f2bf(kf[i]);
                    kt[i] = kf[i] * vec[V_WK + 8 * w + i];
                }
#pragma unroll
                for (int i = 0; i < 4; ++i) ktw[i] = pk2(kt[2 * i], kt[2 * i + 1]);
            }
            ktp.x = ktw[0]; ktp.y = ktw[1]; ktp.z = ktw[2]; ktp.w = ktw[3];
            *(LAS u32x4*)(KTs + lane * PB + 8 * w) = ktp;
            MX_PIN8(vi, 0); MX_PIN8(vi, 8);
#pragma unroll
            for (int i = 0; i < 16; ++i) vi[i] = (vc_ & 1) ? (vi[i] >> 16) : (vi[i] & 0xffffu);
            u32x4 v0, v1;
            v0.x = vi[0] | ((unsigned)vi[1] << 16); v0.y = vi[2] | ((unsigned)vi[3] << 16); v0.z = vi[4] | ((unsigned)vi[5] << 16); v0.w = vi[6] | ((unsigned)vi[7] << 16);
            v1.x = vi[8] | ((unsigned)vi[9] << 16); v1.y = vi[10] | ((unsigned)vi[11] << 16); v1.z = vi[12] | ((unsigned)vi[13] << 16); v1.w = vi[14] | ((unsigned)vi[15] << 16);
            *(LAS u32x4*)(VTs + vc_ * PB + 16 * rq) = v0; *(LAS u32x4*)(VTs + vc_ * PB + 16 * rq + 8) = v1;
        }
        __syncthreads();
        { const bf16_t* gp = Z + (m0 + et) * ZLD + gcol + 16 * cg; gt0 = *(const u32x4*)gp; gt1 = *(const u32x4*)(gp + 8); }
        if (n < 63) MX_LOAD(m0 + 64, n + 1);
#define MX_FRAG(base, row, ks) (*(const LAS bf16x8*)(lds + (base) + ((row) * PB + 16 * (ks) + 8 * hh) * 2))
        if (w < 3) {
            const int ti = (w >= 1) ? 1 : 0, sj = (w == 2) ? 1 : 0;
            f32x16 sc;
#pragma unroll
            for (int r = 0; r < 16; ++r) sc[r] = 0.f;
#pragma unroll
            for (int ks = 0; ks < 4; ++ks) sc = MX_MFMA(MX_FRAG(L_QS, 32 * ti + r32, ks), MX_FRAG(L_KS, 32 * sj + r32, ks), sc);
            const float csv = (ROLE == 1) ? vec[V_CS + 32 * sj + r32] : 0.f;
#pragma unroll
            for (int r = 0; r < 16; ++r) {
                const int t = crow(r, hh);
                const bool keep = (ti != sj) || (r32 <= t);
                float val = sc[r];
                if (ROLE == 1) val *= expf(vec[V_RT + 32 * ti + t] + csv);
                Ps[(32 * ti + t) * PB + 32 * sj + r32] = (bf16_t)f2bf(keep ? val : 0.f);
            }
        }
        f32x16 acco;
#pragma unroll
        for (int r = 0; r < 16; ++r) acco[r] = 0.f;
#pragma unroll
        for (int ks = 0; ks < 4; ++ks) acco = MX_MFMA(MX_FRAG(L_QS, 32 * wa + r32, ks), MX_FRAG(L_ST, 32 * wv + r32, ks), acco);
        if (ROLE == 1) {
#pragma unroll
            for (int r = 0; r < 16; ++r) acco[r] *= vec[V_WI + 32 * wa + crow(r, hh)];
        }
        if (ROLE == 0) {
#pragma unroll
            for (int r = 0; r < 16; ++r) accS[r] *= vec[V_ELAST + 32 * wa + crow(r, hh)];
        } else {
            const float carry = vec[V_SC];
#pragma unroll
            for (int r = 0; r < 16; ++r) accS[r] *= carry;
        }
#pragma unroll
        for (int ks = 0; ks < 4; ++ks) accS = MX_MFMA(MX_FRAG(L_KT, 32 * wa + r32, ks), MX_FRAG(L_VT, 32 * wv + r32, ks), accS);
        __syncthreads();
        if (wa == 0) {
#pragma unroll
            for (int ks = 0; ks < 2; ++ks) acco = MX_MFMA(MX_FRAG(L_PS, r32, ks), MX_FRAG(L_VT, 32 * wv + r32, ks), acco);
        } else {
#pragma unroll
            for (int ks = 0; ks < 4; ++ks) acco = MX_MFMA(MX_FRAG(L_PS, 32 + r32, ks), MX_FRAG(L_VT, 32 * wv + r32, ks), acco);
        }
#pragma unroll
        for (int r = 0; r < 16; ++r) Os[(32 * wa + crow(r, hh)) * OSP + 32 * wv + r32] = acco[r];
#pragma unroll
        for (int q4 = 0; q4 < 4; ++q4) { u32x2 p; p.x = pk2(accS[4 * q4], accS[4 * q4 + 1]); p.y = pk2(accS[4 * q4 + 2], accS[4 * q4 + 3]);
            *(LAS u32x2*)(STs + (32 * wv + r32) * PB + 32 * wa + 8 * q4 + 4 * hh) = p; }
        if (ROLE == 0) { if (n < 63) { vec[V_GA + et * 16 + 2 * cg] = zs0; vec[V_GA + et * 16 + 2 * cg + 1] = zs1; } }
        else {
            const LAS float* nprev = vec + V_NORM + (n & 1) * 64;
            if (w == 0) {
                float qn = 0.f, si = 0.f;
#pragma unroll
                for (int c8i = 0; c8i < 8; ++c8i) {
                    const u32x4 qv = *(const LAS u32x4*)(Qs + lane * PB + 8 * c8i), pv = *(const LAS u32x4*)(Ps + lane * PB + 8 * c8i);
                    const f32x4 n0 = *(const LAS f32x4*)(nprev + 8 * c8i), n1 = *(const LAS f32x4*)(nprev + 8 * c8i + 4);
                    qn += bflo(qv.x) * n0[0] + bfhi(qv.x) * n0[1] + bflo(qv.y) * n0[2] + bfhi(qv.y) * n0[3] + bflo(qv.z) * n1[0] + bfhi(qv.z) * n1[1] + bflo(qv.w) * n1[2] + bfhi(qv.w) * n1[3];
                    si += (bflo(pv.x) + bfhi(pv.x)) + (bflo(pv.y) + bfhi(pv.y)) + (bflo(pv.z) + bfhi(pv.z)) + (bflo(pv.w) + bfhi(pv.w));
                }
                const float den = vec[V_WI + lane] * qn + si;
                vec[V_DEN + lane] = 1.f / fmaxf(fabsf(den), vec[V_ENM + lane]);
            } else if (w == 1) {
                float kn = 0.f;
#pragma unroll
                for (int c8i = 0; c8i < 8; ++c8i) { const u32x4 kv = *(const LAS u32x4*)(KTs + lane * PB + 8 * c8i);
                    kn += (bflo(kv.x) + bfhi(kv.x)) + (bflo(kv.y) + bfhi(kv.y)) + (bflo(kv.z) + bfhi(kv.z)) + (bflo(kv.w) + bfhi(kv.w)); }
                vec[V_NORM + ((n + 1) & 1) * 64 + lane] = vec[V_SC] * nprev[lane] + kn;
            }
        }
        __syncthreads();
        m0 += 64;
    }
#undef MX_LOAD
#undef MX_PIN8
#undef MX_PIN11
#undef MX_FRAG
}
}

#ifndef PHASE_MASK
#define PHASE_MASK 0xFFFF
#endif
#define PH(k) if constexpr ((PHASE_MASK >> (k)) & 1)
#ifndef PROBE_GEMM_REPS
#define PROBE_GEMM_REPS 1
#endif
#ifndef PROBE_STREAM_REPS
#define PROBE_STREAM_REPS 1
#endif
#define GREP _Pragma("unroll 1") for (int rep_ = 0; rep_ < PROBE_GEMM_REPS; ++rep_)
#define GREP_BAR if (rep_) GRID_BAR();
#define BLK_ENV int blk = blockIdx.x; asm volatile("" : "+s"(blk));
#define PHASE_ENV BLK_ENV int tid = hw_tid(wave_s); asm volatile("" : "+v"(tid)); const int lane = tid & 63, wave = wave_s; int vcu_ = vcu; asm volatile("" : "+s"(vcu_)); const int gw = vcu_ * NWAVES + wave; (void)lane; (void)gw;
__global__ void __launch_bounds__(NWAVES * 64, 2) mega_fwd(Args args) {
    extern __shared__ __attribute__((aligned(16))) unsigned char lds_raw[];
    LAS unsigned char* lds = (LAS unsigned char*)lds_raw;
    const int G = gridDim.x, blk0 = blockIdx.x;
    const int wave_s = __builtin_amdgcn_readfirstlane(threadIdx.x >> 6);
    const int vcu = (G % 8 == 0) ? (blk0 % 8) * (G / 8) + blk0 / 8 : blk0;
    const int NGW = G * NWAVES;
    for (int u = threadIdx.x; u < (LDS_BYTES - LDSCTL_OFF) / 4; u += NWAVES * 64) ((LAS unsigned*)(lds + LDSCTL_OFF))[u] = 0u;
    __syncthreads();
    (void)xcd_barrier_post((unsigned*)(args.ws + WS_CTL) + CW_BAR, (volatile LAS unsigned*)(lds + MISC_OFF) + 8);
#define GRID_BAR() do { XcdBarrier b_; b_.bar = (unsigned*)(inp_ws() + WS_CTL) + CW_BAR; b_.x = xb_xcc_id(); b_.st = (volatile LAS unsigned*)(lds + MISC_OFF) + 8; xcd_barrier(b_, wave_s); } while (0)

    PH(0) { PHASE_ENV
        ada_phase(lds, blk, wave, lane);
        if (blk < 32) s5_generate(0, blk, lds, wave_s);
        LAS float* scr = (LAS float*)(lds + wave * 16384);
        int base = 0;
        convert_matrix<1>(inp(8), INDIM, 1024, ZLD, (bf16_t*)WSP(WS_WIN), scr, lane, gw, NGW, base);
    }
    GRID_BAR();

#pragma unroll 1
    for (int l = 0; l < DEPTH; ++l) {
        PH(1) if (l == 0) { PHASE_ENV
            __syncthreads();
            stage_wsmall(inp(8), (LAS float*)lds, tid);
            prenorm_rows<true>(inp(0), inp(4), (const float*)WSP(WS_MOD), 0, 1024, (bf16_t*)WSP(WS_H), (float*)WSP(WS_ZS), (const LAS float*)lds, gw, NGW, lane);
            GRID_BAR();
        }
        PH(2) GREP { GREP_BAR BLK_ENV
            pg8::PlainSched S; S.o.init(M, ZLD, G, blk); S.A = (const bf16_t*)WSP(WS_H); S.lda = D; S.Bt = (const bf16_t*)WSP(WS_WIN); S.K = D;
            pg8::EpiStore E{(bf16_t*)WSP(WS_Z), ZLD};
            pg8::gemm_phase<pg8::EpiStore, pg8::PlainSched, true, true>(lds, wave_s, D, D, S, E);
        }
        GRID_BAR();
        PH(11) GREP { GREP_BAR BLK_ENV
            pg8::S5aSched S; S.G = G; S.c = blk; S.Zb = (const bf16_t*)WSP(WS_Z); S.Bt1 = (const bf16_t*)WSP(WS_S5M1);
            pg8::EpiS5a E{(float*)WSP(WS_EX), (bf16_t*)WSP(WS_YP)};
            pg8::gemm_phase<pg8::EpiS5a, pg8::S5aSched, true, true, 1>(lds, wave_s, 0, 256, S, E);
        }
        GRID_BAR();
        PH(3) { PHASE_ENV
#if PROBE_STREAM_REPS > 1
            for (int rep_ = 1; rep_ < PROBE_STREAM_REPS; ++rep_) { if (blk < 32) mx::stream<0, false>(l, lds, blk, wave_s); else if (blk < 64) mx::stream<1, false>(l, lds, blk - 32, wave_s); __syncthreads(); }
#endif
            if (blk < 32) mx::stream<0>(l, lds, blk, wave_s);
            else if (blk < 64) mx::stream<1>(l, lds, blk - 32, wave_s);
            else if (blk < 192) { if (wave < 2) s5_scan(l, (blk - 64) * 2 + wave, lane); }
            else if (G > 192) {
                int base = 0; const int gw2 = (blk - 192) * NWAVES + wave, NGW2 = (G - 192) * NWAVES;
                LAS float* scr = (LAS float*)(lds + wave * 16384);
                convert_matrix<0>(inp(24) + (size_t)l * 512 * 512, 512, 512, 512, (bf16_t*)WSP(WS_WGLU), scr, lane, gw2, NGW2, base);
                convert_matrix<0>(inp(26) + (size_t)l * 512 * 1024, 1024, 512, 1024, (bf16_t*)WSP(WS_WPROJ), scr, lane, gw2, NGW2, base);
                convert_matrix<0>(inp(27) + (size_t)l * 512 * 1024, 1024, 512, 1024, (bf16_t*)WSP(WS_WPROJ) + 1024 * 512, scr, lane, gw2, NGW2, base);
                convert_matrix<0>(inp(28) + (size_t)l * 512 * 1024, 1024, 512, 1024, (bf16_t*)WSP(WS_WPROJ) + 2 * 1024 * 512, scr, lane, gw2, NGW2, base);
                convert_matrix<0>(inp(30) + (size_t)l * D * D, 1024, 1024, 1024, (bf16_t*)WSP(WS_WOUT), scr, lane, gw2, NGW2, base);
                convert_matrix<0>(inp(32) + (size_t)l * FF * D, 1024, FF, 1024, (bf16_t*)WSP(WS_WFO), scr, lane, gw2, NGW2, base);
            }
        }
        GRID_BAR();
        PH(12) { BLK_ENV
            pg8::S5bSched S; S.G = G; S.c = blk; S.X = (const bf16_t*)WSP(WS_EX); S.Bt3 = (const bf16_t*)WSP(WS_S5M3);
            pg8::EpiS5b E{(const bf16_t*)WSP(WS_YP), (bf16_t*)WSP(WS_Z), inp(23) + l * 512};
            pg8::gemm_phase<pg8::EpiS5b, pg8::S5bSched, true, true>(lds, wave_s, 256, 256, S, E);
        }
        GRID_BAR();
        PH(4) GREP { GREP_BAR BLK_ENV
            bf16_t* Z = (bf16_t*)WSP(WS_Z);
            pg8::PlainSched S; S.o.init(M, 512, G, blk); S.A = Z + SU; S.lda = ZLD; S.Bt = (const bf16_t*)WSP(WS_WGLU); S.K = 512;
            pg8::EpiGlu E{Z + YS2, ZLD, Z + SU, ZLD, inp(25) + l * 512};
            pg8::gemm_phase<pg8::EpiGlu, pg8::PlainSched, true, true>(lds, wave_s, ZLD, 512, S, E);
        }
        GRID_BAR();
        PH(5) GREP { GREP_BAR BLK_ENV
            bf16_t* Z = (bf16_t*)WSP(WS_Z);
            pg8::MergeSched S; S.o.init(M, 1024, G, blk); S.Zb = Z; S.Wp = (const bf16_t*)WSP(WS_WPROJ);
            pg8::EpiMerge E{Z + MRG, ZLD, Z + ZG, ZLD, inp(29) + l * 3072};
            pg8::gemm_phase<pg8::EpiMerge, pg8::MergeSched, true, true>(lds, wave_s, ZLD, 512, S, E);
        }
        GRID_BAR();
        PH(6) GREP { GREP_BAR BLK_ENV
            pg8::PlainSched S; S.o.init(M, 1024, G, blk); S.A = (const bf16_t*)WSP(WS_Z) + MRG; S.lda = ZLD; S.Bt = (const bf16_t*)WSP(WS_WOUT); S.K = 1024;
            pg8::EpiStore E{(bf16_t*)WSP(WS_H), D};
            pg8::gemm_phase<pg8::EpiStore, pg8::PlainSched, true, true>(lds, wave_s, ZLD, 1024, S, E);
        }
        GRID_BAR();
        PH(7) { PHASE_ENV
            const float* modl = (const float*)WSP(WS_MOD) + (size_t)l * 8 * 6144;
            { int base = 0; convert_matrix<2>(inp(31) + (size_t)l * D * 2 * FF, 2 * FF, 1024, 2 * FF, (bf16_t*)WSP(WS_WFI), (LAS float*)(lds + wave * 16384), lane, gw, NGW, base); }
            postpre_rows<true, false>((const bf16_t*)WSP(WS_H), D, (l == 0) ? inp(0) : (const float*)inp_out(), inp(5) + l * D, modl, 2048, inp_out(), inp(6) + l * D, modl, 3072, 4096,
                                      (bf16_t*)WSP(WS_H), nullptr, nullptr, gw, NGW, lane);
        }
        GRID_BAR();
        PH(8) GREP { GREP_BAR BLK_ENV
            pg8::PlainSched S; S.o.init(M, 2 * FF, G, blk); S.A = (const bf16_t*)WSP(WS_H); S.lda = D; S.Bt = (const bf16_t*)WSP(WS_WFI); S.K = D;
            pg8::EpiSwiGlu E{(bf16_t*)WSP(WS_Z), FF};
            pg8::gemm_phase<pg8::EpiSwiGlu, pg8::PlainSched, true, true>(lds, wave_s, D, D, S, E);
        }
        GRID_BAR();
        PH(9) GREP { GREP_BAR BLK_ENV
            pg8::PlainSched S; S.o.init(M, 1024, G, blk); S.A = (const bf16_t*)WSP(WS_Z); S.lda = FF; S.Bt = (const bf16_t*)WSP(WS_WFO); S.K = FF;
            pg8::EpiStore E{(bf16_t*)WSP(WS_H), D};
            pg8::gemm_phase<pg8::EpiStore, pg8::PlainSched, true, true>(lds, wave_s, FF, FF, S, E);
        }
        GRID_BAR();
        PH(10) { PHASE_ENV
            const float* modl = (const float*)WSP(WS_MOD) + (size_t)l * 8 * 6144;
            if (l + 1 < DEPTH) {
                const int l1 = l + 1;
                LAS float* scr = (LAS float*)(lds + wave * 16384);
                int base = 0;
                if (blk < 32) s5_generate(l1, blk, lds, wave_s);
                convert_matrix<1>(inp(8) + (size_t)l1 * D * INDIM, INDIM, 1024, ZLD, (bf16_t*)WSP(WS_WIN), scr, lane, gw, NGW, base);
                __syncthreads();
                stage_wsmall(inp(8) + (size_t)l1 * D * INDIM, (LAS float*)lds, tid);
                postpre_rows<true, true>((const bf16_t*)WSP(WS_H), D, (const float*)inp_out(), inp(7) + l * D, modl, 5120, inp_out(), inp(4) + l1 * D, modl + 8 * 6144, 0, 1024,
                                         (bf16_t*)WSP(WS_H), (float*)WSP(WS_ZS), (const LAS float*)lds, gw, NGW, lane);
                GRID_BAR();
            } else {
                postpre_rows<false, false>((const bf16_t*)WSP(WS_H), D, (const float*)inp_out(), inp(7) + l * D, modl, 5120, inp_out(), nullptr, nullptr, 0, 0, nullptr, nullptr, nullptr, gw, NGW, lane);
            }
        }
    }
}

extern "C" void kernel_launch(void* const* d_in, const int* in_sizes, int n_in, void* d_out, int out_size, void* d_ws, size_t ws_size, hipStream_t stream) {
    static int grid = 0;
    if (grid == 0) {
        if (n_in != 33 || ws_size < WS_END || out_size != M * D) { fprintf(stderr, "kernel_launch: unexpected n_in %d / ws %zu / out %d\n", n_in, ws_size, out_size); grid = -1; return; }
        int dev = 0, cus = 0, per_cu = 0;
        if (hipGetDevice(&dev) != hipSuccess || hipDeviceGetAttribute(&cus, hipDeviceAttributeMultiprocessorCount, dev) != hipSuccess) { grid = -1; return; }
        if (hipFuncSetAttribute((const void*)mega_fwd, hipFuncAttributeMaxDynamicSharedMemorySize, LDS_BYTES) != hipSuccess) { fprintf(stderr, "kernel_launch: hipFuncSetAttribute failed\n"); grid = -1; return; }
        if (hipOccupancyMaxActiveBlocksPerMultiprocessor(&per_cu, (const void*)mega_fwd, NWAVES * 64, LDS_BYTES) != hipSuccess || per_cu < 1) { fprintf(stderr, "kernel_launch: occupancy query says %d blocks/CU\n", per_cu); grid = -1; return; }
        (void)hipGetLastError();
        grid = cus;
    }
    if (grid < 0) return;
    (void)hipMemsetAsync((char*)d_ws + WS_CTL, 0, CTL_ZERO_BYTES, stream);
    Args a{};
    for (int i = 0; i < 33; ++i) a.in[i] = (const float*)d_in[i];
    a.out = (float*)d_out; a.ws = (unsigned char*)d_ws;
    hipLaunchKernelGGL(mega_fwd, dim3(grid), dim3(NWAVES * 64), LDS_BYTES, stream, a);
}
```

```cpp
#include <hip/hip_runtime.h>
#include <cstdint>
#include <cstdio>

#define LAS __attribute__((address_space(3)))
#define GAS __attribute__((address_space(1)))
typedef unsigned short bf16_t;
typedef short bf16x8 __attribute__((ext_vector_type(8)));
typedef float f32x4 __attribute__((ext_vector_type(4)));
typedef float f32x2 __attribute__((ext_vector_type(2)));
typedef unsigned u32x4 __attribute__((ext_vector_type(4)));
typedef unsigned u32x2 __attribute__((ext_vector_type(2)));

constexpr int NB = 8, T = 4096, D = 1024, M = NB * T, DEPTH = 2;
constexpr int INDIM = 6680, ZLD = 6656, FF = 2816;
constexpr int GQ = 0, GK = 256, GV = 512, GR = 1024, MQ = 1536, MK = 1792, MV = 2048, MO = 2560, SU = 3072, ZG = 3584;
constexpr int YGLA = GR;
constexpr int YML = MO;
constexpr int YS2 = 0;
constexpr int MRG = 1536;
constexpr size_t MiB = 1u << 20;
constexpr size_t WS_CTL = 0, CTL_ZERO_BYTES = 64 * 1024;
constexpr size_t WS_MOD = 512 * 1024;
constexpr size_t WS_ZS = 1 * MiB;
constexpr size_t WS_WIN = 5 * MiB;
constexpr size_t WS_WGLU = 5 * MiB;
constexpr size_t WS_WPROJ = 5 * MiB + 512 * 1024;
constexpr size_t WS_WOUT = 8 * MiB + 512 * 1024;
constexpr size_t WS_WFO = 10 * MiB + 512 * 1024;
constexpr size_t WS_S5M1 = 18 * MiB;
constexpr size_t WS_S5M3 = 24 * MiB;
constexpr size_t WS_WFI = 18 * MiB;
constexpr size_t WS_EX = 32 * MiB;
constexpr size_t WS_YP = 64 * MiB;
constexpr size_t WS_H = 32 * MiB;
constexpr size_t WS_Z = 96 * MiB;
constexpr size_t WS_END = 512 * MiB;
constexpr int CW_BAR = 4096;

constexpr int RING_BYTES = 131072, LDSCTL_OFF = RING_BYTES, MISC_OFF = LDSCTL_OFF + 320, LDS_BYTES = 147456;
constexpr int NWAVES = 8;

__device__ __forceinline__ float bf2f(bf16_t v) { return __uint_as_float(((unsigned)v) << 16); }
__device__ __forceinline__ unsigned f2bf(float f) { unsigned u = __float_as_uint(f); return (u + 0x7fffu + ((u >> 16) & 1u)) >> 16; }
__device__ __forceinline__ unsigned pk2(float lo, float hi) { return f2bf(lo) | (f2bf(hi) << 16); }
__device__ __forceinline__ float bflo(unsigned u) { return __uint_as_float(u << 16); }
__device__ __forceinline__ float bfhi(unsigned u) { return __uint_as_float(u & 0xffff0000u); }
__device__ __forceinline__ int hw_lane() { int l; asm volatile("v_mbcnt_lo_u32_b32 %0, -1, 0\n\tv_mbcnt_hi_u32_b32 %0, -1, %0" : "=v"(l)); return l; }
__device__ __forceinline__ int hw_tid(int wv) { return wv * 64 + hw_lane(); }
__device__ __forceinline__ float shl(float v, int src) { return __int_as_float(__builtin_amdgcn_ds_bpermute(src << 2, __float_as_int(v))); }
__device__ __forceinline__ float wave_sum(float v, int lane) {
#pragma unroll
    for (int o = 1; o < 64; o <<= 1) v += shl(v, lane ^ o);
    return v;
}
__device__ __forceinline__ float sigmoidf_(float x) { return 1.f / (1.f + expf(-x)); }
__device__ __forceinline__ float siluf_(float x) { return x / (1.f + expf(-x)); }
__device__ __forceinline__ float logsigmoidf_(float x) { return fminf(x, 0.f) - log1pf(expf(-fabsf(x))); }
__device__ __forceinline__ float gelu_tanh(float y) { return 0.5f * y * (1.f + tanhf(0.7978845608028654f * (y + 0.044715f * y * y * y))); }
__device__ __forceinline__ float fexp_neg(float x) { return __builtin_amdgcn_exp2f(-1.4426950408889634f * x); }
__device__ __forceinline__ float fsigmoid(float x) { return __builtin_amdgcn_rcpf(1.f + fexp_neg(x)); }
#define LDS_WAIT() asm volatile("s_waitcnt lgkmcnt(0)" ::: "memory")
#define VM_WAIT() asm volatile("s_waitcnt vmcnt(0)" ::: "memory")

namespace pg8 {
constexpr int BM = 256, BK = 64, HALF = 128, HTB = HALF * BK * 2, STAGE_BYTES = 8 * HTB, NXCD = 8, WGM = 8;
__host__ __device__ __forceinline__ int lds_byte(int r, int c) { const int st = (r >> 4) * 2 + (c >> 5), rr = r & 15, cc = c & 31, ob = rr * 64 + cc * 2; return st * 1024 + (ob ^ (((ob >> 9) & 1) << 5)); }
__host__ __device__ __forceinline__ void stage_rc(int b, int& R, int& C) { const int st = b / 1024, sb = b % 1024, swz = sb ^ (((sb >> 9) & 1) << 5); R = (st >> 1) * 16 + swz / 64; C = (st & 1) * 32 + (swz % 64) / 2; }
__host__ __device__ __forceinline__ int perm32(int rho) { const int n = rho >> 4, i = rho & 15; return 8 * (i >> 2) + 4 * n + (i & 3); }

struct Unit { int pm, pn, br; };
struct TileOrder {
    int nM, nN, nwg, G, c;
    __device__ void init(int M_, int N_, int G_, int c_) { nM = M_ / BM; nN = N_ / BM; nwg = nM * nN; G = G_; c = c_; }
    __device__ bool tile(int i, int& pm, int& pn) const {
        const long L = (long)i * G + c; if (L >= nwg) return false;
        int wgid = (int)L; { const int q = nwg / NXCD, r = nwg % NXCD, xcd = wgid % NXCD, off = wgid / NXCD; wgid = (xcd < r ? xcd * (q + 1) : r * (q + 1) + (xcd - r) * q) + off; }
        const int nig = WGM * nN, gid = wgid / nig, fm = gid * WGM, gsz = (nM - fm) < WGM ? (nM - fm) : WGM;
        pm = fm + ((wgid % nig) % gsz); pn = (wgid % nig) / gsz; return true;
    }
};
struct PlainSched {
    TileOrder o; const bf16_t* A; int lda; const bf16_t* Bt; int K;
    __device__ bool next(int i, Unit& u) const { u.br = 0; return o.tile(i, u.pm, u.pn); }
    __device__ const char* Ap(const Unit& u) const { return (const char*)(A + (size_t)u.pm * BM * lda); }
    __device__ const char* Bp(const Unit& u) const { return (const char*)(Bt + (size_t)u.pn * BM * K); }
};
struct MergeSched {
    TileOrder o; const bf16_t* Zb; const bf16_t* Wp;
    __device__ bool next(int i, Unit& u) const { u.br = i % 3; return o.tile(i / 3, u.pm, u.pn); }
    __device__ const char* Ap(const Unit& u) const { const int col = u.br == 0 ? YGLA : (u.br == 1 ? YML : YS2); return (const char*)(Zb + (size_t)u.pm * BM * ZLD + col); }
    __device__ const char* Bp(const Unit& u) const { return (const char*)(Wp + (size_t)u.br * 1024 * 512 + (size_t)u.pn * BM * 512); }
};

__device__ __forceinline__ unsigned cvt_pk_bf16(float lo, float hi) { unsigned r; asm volatile("v_cvt_pk_bf16_f32 %0, %1, %2" : "=v"(r) : "v"(lo), "v"(hi)); return r; }

struct EpiStore {
    static constexpr bool PERM = true;
    bf16_t* O; int ldc;
    __device__ __forceinline__ bool keep(const Unit&) const { return false; }
    __device__ __forceinline__ void operator()(f32x4 (&acc)[2][2][4][2], const Unit& u, int wr, int wc, int fr, int fq) const {
        const int row0 = u.pm * BM + wr * 64 + fr, col0 = u.pn * BM + wc * 32 + 8 * fq;
#pragma unroll
        for (int ai = 0; ai < 2; ++ai)
#pragma unroll
            for (int m = 0; m < 4; ++m) { bf16_t* rowp = O + (size_t)(row0 + ai * HALF + m * 16) * ldc + col0;
#pragma unroll
                for (int bj = 0; bj < 2; ++bj) { const f32x4 v0 = acc[ai][bj][m][0], v1 = acc[ai][bj][m][1];
                    u32x4 w; w.x = cvt_pk_bf16(v0[0], v0[1]); w.y = cvt_pk_bf16(v0[2], v0[3]); w.z = cvt_pk_bf16(v1[0], v1[1]); w.w = cvt_pk_bf16(v1[2], v1[3]);
                    *(u32x4*)(rowp + bj * HALF) = w; } }
    }
};
struct EpiGlu {
    static constexpr bool PERM = true;
    bf16_t* O; int ldc; const bf16_t* Asrc; int lda; const float* bias;
    __device__ __forceinline__ bool keep(const Unit&) const { return false; }
    __device__ __forceinline__ void operator()(f32x4 (&acc)[2][2][4][2], const Unit& u, int wr, int wc, int fr, int fq) const {
        const int row0 = u.pm * BM + wr * 64 + fr, col0 = u.pn * BM + wc * 32 + 8 * fq;
        f32x4 bv[2][2];
#pragma unroll
        for (int bj = 0; bj < 2; ++bj)
#pragma unroll
            for (int n = 0; n < 2; ++n) bv[bj][n] = *(const f32x4*)(bias + col0 + bj * HALF + 4 * n);
#pragma unroll
        for (int ai = 0; ai < 2; ++ai)
#pragma unroll
            for (int m = 0; m < 4; ++m) { const size_t r = (size_t)(row0 + ai * HALF + m * 16);
#pragma unroll
                for (int bj = 0; bj < 2; ++bj) {
                    const u32x4 a = *(const u32x4*)(Asrc + r * lda + col0 + bj * HALF);
                    const f32x4 v0 = acc[ai][bj][m][0] + bv[bj][0], v1 = acc[ai][bj][m][1] + bv[bj][1];
                    u32x4 w;
                    w.x = cvt_pk_bf16(bflo(a.x) * fsigmoid(v0[0]), bfhi(a.x) * fsigmoid(v0[1])); w.y = cvt_pk_bf16(bflo(a.y) * fsigmoid(v0[2]), bfhi(a.y) * fsigmoid(v0[3]));
                    w.z = cvt_pk_bf16(bflo(a.z) * fsigmoid(v1[0]), bfhi(a.z) * fsigmoid(v1[1])); w.w = cvt_pk_bf16(bflo(a.w) * fsigmoid(v1[2]), bfhi(a.w) * fsigmoid(v1[3]));
                    *(u32x4*)(O + r * ldc + col0 + bj * HALF) = w; } }
    }
};
struct EpiSwiGlu {
    static constexpr bool PERM = true;
    bf16_t* O; int ldc;
    __device__ __forceinline__ bool keep(const Unit&) const { return false; }
    __device__ __forceinline__ void operator()(f32x4 (&acc)[2][2][4][2], const Unit& u, int wr, int wc, int fr, int fq) const {
        const int row0 = u.pm * BM + wr * 64 + fr, col0 = u.pn * HALF + wc * 32 + 8 * fq;
#pragma unroll
        for (int ai = 0; ai < 2; ++ai)
#pragma unroll
            for (int m = 0; m < 4; ++m) {
                float o[8];
#pragma unroll
                for (int n = 0; n < 2; ++n)
#pragma unroll
                    for (int e = 0; e < 4; ++e) { const float g = acc[ai][0][m][n][e], up = acc[ai][1][m][n][e]; o[n * 4 + e] = g * fsigmoid(g) * up; }
                u32x4 w; w.x = cvt_pk_bf16(o[0], o[1]); w.y = cvt_pk_bf16(o[2], o[3]); w.z = cvt_pk_bf16(o[4], o[5]); w.w = cvt_pk_bf16(o[6], o[7]);
                *(u32x4*)(O + (size_t)(row0 + ai * HALF + m * 16) * ldc + col0) = w; }
    }
};
struct EpiMerge {
    static constexpr bool PERM = true;
    bf16_t* O; int ldc; const bf16_t* Zg; int ldz; const float* bgb;
    __device__ __forceinline__ bool keep(const Unit& u) const { return u.br < 2; }
    __device__ __forceinline__ float e_of(float x) const { return fminf(fexp_neg(x), 1e30f); }
    __device__ __forceinline__ void operator()(f32x4 (&acc)[2][2][4][2], const Unit& u, int wr, int wc, int fr, int fq) const {
        const int row0 = u.pm * BM + wr * 64 + fr, col0 = u.pn * BM + wc * 32 + 8 * fq;
        const int br = u.br, brn = br < 2 ? br + 1 : 2;
#pragma unroll
        for (int bj = 0; bj < 2; ++bj) {
            float ba[8], bb[8];
#pragma unroll
            for (int e = 0; e < 8; ++e) { ba[e] = bgb[br * 1024 + col0 + bj * HALF + e]; bb[e] = bgb[brn * 1024 + col0 + bj * HALF + e]; }
#pragma unroll
            for (int ai = 0; ai < 2; ++ai)
#pragma unroll
                for (int m = 0; m < 4; ++m) { const size_t r = (size_t)(row0 + ai * HALF + m * 16);
                    const u32x4 za = *(const u32x4*)(Zg + r * ldz + br * 1024 + col0 + bj * HALF);
                    const u32x4 zb = *(const u32x4*)(Zg + r * ldz + brn * 1024 + col0 + bj * HALF);
                    const float xa[8] = {bflo(za.x), bfhi(za.x), bflo(za.y), bfhi(za.y), bflo(za.z), bfhi(za.z), bflo(za.w), bfhi(za.w)};
                    const float xb[8] = {bflo(zb.x), bfhi(zb.x), bflo(zb.y), bfhi(zb.y), bflo(zb.z), bfhi(zb.z), bflo(zb.w), bfhi(zb.w)};
                    float f[8];
#pragma unroll
                    for (int e = 0; e < 8; ++e) { const float ga = __builtin_amdgcn_rcpf(1.f + e_of(xa[e] + ba[e]));
                        f[e] = br < 2 ? ga * (1.f + e_of(xb[e] + bb[e])) : ga; }
                    f32x4 v0 = acc[ai][bj][m][0], v1 = acc[ai][bj][m][1];
                    v0[0] *= f[0]; v0[1] *= f[1]; v0[2] *= f[2]; v0[3] *= f[3]; v1[0] *= f[4]; v1[1] *= f[5]; v1[2] *= f[6]; v1[3] *= f[7];
                    if (br < 2) { acc[ai][bj][m][0] = v0; acc[ai][bj][m][1] = v1; }
                    else { u32x4 w; w.x = cvt_pk_bf16(v0[0], v0[1]); w.y = cvt_pk_bf16(v0[2], v0[3]); w.z = cvt_pk_bf16(v1[0], v1[1]); w.w = cvt_pk_bf16(v1[2], v1[3]);
                        *(u32x4*)(O + r * ldc + col0 + bj * HALF) = w; } }
        }
    }
};


struct S5aSched {
    int G, c; const bf16_t* Zb; const bf16_t* Bt1;
    __device__ bool next(int i, Unit& u) const { const int L = i * G + c; if (L >= 512) return false; u.br = L >> 4; u.pm = (L & 15) >> 1; u.pn = L & 1; return true; }
    __device__ const char* Ap(const Unit& u) const { return (const char*)(Zb + (size_t)u.pm * T * ZLD + SU + 16 * u.br); }
    __device__ const char* Bp(const Unit& u) const { return (const char*)(Bt1 + ((size_t)u.br * 384 + (size_t)u.pn * 256) * 256); }
};
struct EpiS5a {
    static constexpr bool PERM = true;
    float* EX; bf16_t* YP;
    __device__ __forceinline__ bool keep(const Unit&) const { return false; }
    __device__ __forceinline__ void operator()(f32x4 (&acc)[2][2][4][2], const Unit& u, int wr, int wc, int fr, int fq) const {
        const int rowbase = u.br * 2048 + u.pm * 256 + wr * 64 + fr, colsub = wc * 32 + 8 * fq;
#pragma unroll
        for (int ai = 0; ai < 2; ++ai)
#pragma unroll
            for (int m = 0; m < 4; ++m) { const size_t R = (size_t)(rowbase + ai * HALF + m * 16);
                if (u.pn == 0) {
                    *(f32x4*)(EX + R * 128 + colsub) = acc[ai][0][m][0]; *(f32x4*)(EX + R * 128 + colsub + 4) = acc[ai][0][m][1];
                    const f32x4 v0 = acc[ai][1][m][0], v1 = acc[ai][1][m][1];
                    u32x4 w; w.x = cvt_pk_bf16(v0[0], v0[1]); w.y = cvt_pk_bf16(v0[2], v0[3]); w.z = cvt_pk_bf16(v1[0], v1[1]); w.w = cvt_pk_bf16(v1[2], v1[3]);
                    *(u32x4*)(YP + R * 256 + colsub) = w;
                } else {
                    const f32x4 v0 = acc[ai][0][m][0], v1 = acc[ai][0][m][1];
                    u32x4 w; w.x = cvt_pk_bf16(v0[0], v0[1]); w.y = cvt_pk_bf16(v0[2], v0[3]); w.z = cvt_pk_bf16(v1[0], v1[1]); w.w = cvt_pk_bf16(v1[2], v1[3]);
                    *(u32x4*)(YP + R * 256 + 128 + colsub) = w;
                } }
    }
};
struct S5bSched {
    int G, c; const bf16_t* X; const bf16_t* Bt3;
    __device__ bool next(int i, Unit& u) const { const int L = i * G + c; if (L >= 256) return false; u.br = L >> 3; u.pm = L & 7; u.pn = 0; return true; }
    __device__ const char* Ap(const Unit& u) const { return (const char*)(X + (size_t)(u.br * 2048 + u.pm * 256) * 256); }
    __device__ const char* Bp(const Unit& u) const { return (const char*)(Bt3 + (size_t)u.br * 256 * 256); }
};
struct EpiS5b {
    static constexpr bool PERM = true;
    const bf16_t* YP; bf16_t* Zb; const float* dsk;
    __device__ __forceinline__ bool keep(const Unit&) const { return false; }
    __device__ __forceinline__ void operator()(f32x4 (&acc)[2][2][4][2], const Unit& u, int wr, int wc, int fr, int fq) const {
        const int g = u.br, b = u.pm;
#pragma unroll
        for (int bj = 0; bj < 2; ++bj) {
            const int j0 = bj * HALF + wc * 32 + 8 * fq, s = j0 >> 4, c0 = j0 & 15;
            const f32x4 d0 = *(const f32x4*)(dsk + 16 * g + c0), d1 = *(const f32x4*)(dsk + 16 * g + c0 + 4);
#pragma unroll
            for (int ai = 0; ai < 2; ++ai)
#pragma unroll
                for (int m = 0; m < 4; ++m) {
                    const int n = ai * HALF + wr * 64 + m * 16 + fr;
                    const size_t R = (size_t)(g * 2048 + b * 256 + n);
                    const u32x4 yp = *(const u32x4*)(YP + R * 256 + j0);
                    bf16_t* zp = Zb + ((size_t)b * T + 16 * n + s) * ZLD + SU + 16 * g + c0;
                    const u32x4 uu = *(const u32x4*)zp;
                    const f32x4 a0 = acc[ai][bj][m][0], a1 = acc[ai][bj][m][1];
                    float y[8];
                    y[0] = a0[0] + bflo(yp.x) + d0[0] * bflo(uu.x); y[1] = a0[1] + bfhi(yp.x) + d0[1] * bfhi(uu.x);
                    y[2] = a0[2] + bflo(yp.y) + d0[2] * bflo(uu.y); y[3] = a0[3] + bfhi(yp.y) + d0[3] * bfhi(uu.y);
                    y[4] = a1[0] + bflo(yp.z) + d1[0] * bflo(uu.z); y[5] = a1[1] + bfhi(yp.z) + d1[1] * bfhi(uu.z);
                    y[6] = a1[2] + bflo(yp.w) + d1[2] * bflo(uu.w); y[7] = a1[3] + bfhi(yp.w) + d1[3] * bfhi(uu.w);
#pragma unroll
                    for (int e = 0; e < 8; ++e) { const float v = y[e]; y[e] = v * fsigmoid(1.5957691216057308f * (v + 0.044715f * v * v * v)); }
                    u32x4 w; w.x = cvt_pk_bf16(y[0], y[1]); w.y = cvt_pk_bf16(y[2], y[3]); w.z = cvt_pk_bf16(y[4], y[5]); w.w = cvt_pk_bf16(y[6], y[7]);
                    *(u32x4*)zp = w;
                    if (m & 1) asm volatile("" ::: "memory");
                }
        }
    }
};

template <class Epi, class Sched, bool ALIGN_EPI, bool SP2, int AMODE = 0>
__device__ __forceinline__ void gemm_phase(LAS unsigned char* lds, const int wv, const int lda, const int K, const Sched& S, const Epi& E) {
    int tid_ = hw_tid(wv); asm volatile("" : "+v"(tid_));
    const int tid = tid_, wid = __builtin_amdgcn_readfirstlane(tid >> 6), lane = tid & 63, wr = wid >> 2, wc = wid & 3, fr = lane & 15, fq = lane >> 4;
    const int nt = K / BK;
    unsigned voffA[2], voffB[2];
#pragma unroll
    for (int i = 0; i < 2; ++i) { int R, C; stage_rc(tid * 16 + i * 8192, R, C); const int Rb = Epi::PERM ? ((R & ~31) + perm32(R & 31)) : R;
        voffA[i] = AMODE == 0 ? (unsigned)(R * lda + C) * 2u : (unsigned)((16 * R + (C >> 4)) * ZLD + (C & 15)) * 2u; voffB[i] = (unsigned)(Rb * K + C) * 2u; }
    const size_t kstep = (size_t)(BK * 2);
    const size_t kstepA = AMODE == 0 ? (size_t)(BK * 2) : (size_t)4 * ZLD * 2;
    const size_t hA = AMODE == 0 ? (size_t)HALF * lda * 2 : (size_t)HALF * 16 * ZLD * 2, hB = (size_t)HALF * K * 2;
    const unsigned ldsw = (unsigned)wid * 1024u;
    const int aoff = lds_byte(wr * 64 + fr, fq * 8), boff = lds_byte(wc * 32 + fr, fq * 8);
#define PG8_SA(b, h) (((b) * 2 + (h)) * HTB)
#define PG8_SB(b, h) ((4 + (b) * 2 + (h)) * HTB)
#define PG8_STAGE(bufoff, gbase, voff) do { _Pragma("unroll") for (int _i = 0; _i < 2; ++_i) \
        __builtin_amdgcn_global_load_lds((const unsigned*)((const char*)(gbase) + (voff)[_i]), (LAS unsigned*)(lds + (bufoff) + ldsw + _i * 8192), 16, 0, 0); } while (0)
#define PG8_LDA(dst, b, h) do { _Pragma("unroll") for (int m = 0; m < 4; ++m) _Pragma("unroll") for (int k = 0; k < 2; ++k) dst[m][k] = *(const LAS bf16x8*)(lds + PG8_SA(b, h) + aoff + m * 2048 + k * 1024); } while (0)
#define PG8_LDB(dst, b, h) do { _Pragma("unroll") for (int n = 0; n < 2; ++n) _Pragma("unroll") for (int k = 0; k < 2; ++k) dst[n][k] = *(const LAS bf16x8*)(lds + PG8_SB(b, h) + boff + n * 2048 + k * 1024); } while (0)
#define PG8_MMA(ai, bj, At, Bt) do { __builtin_amdgcn_s_setprio(1); _Pragma("unroll") for (int m = 0; m < 4; ++m) _Pragma("unroll") for (int n = 0; n < 2; ++n) _Pragma("unroll") for (int k = 0; k < 2; ++k) \
        acc[ai][bj][m][n] = __builtin_amdgcn_mfma_f32_16x16x32_bf16(Bt[n][k], At[m][k], acc[ai][bj][m][n], 0, 0, 0); __builtin_amdgcn_s_setprio(0); } while (0)
#define PG8_WAIT_V(n) asm volatile("s_waitcnt vmcnt(" #n ")" ::: "memory")
#define PG8_WAIT_L(n) asm volatile("s_waitcnt lgkmcnt(" #n ")" ::: "memory")
#define PG8_BAR __builtin_amdgcn_s_barrier()
#define PG8_SCHED __builtin_amdgcn_sched_barrier(0)
    Unit cur, nxt; int ui = 0;
    if (!S.next(0, cur)) return;
    f32x4 acc[2][2][4][2];
#pragma unroll
    for (int a = 0; a < 2; ++a)
#pragma unroll
        for (int b = 0; b < 2; ++b)
#pragma unroll
            for (int m = 0; m < 4; ++m)
#pragma unroll
                for (int n = 0; n < 2; ++n) acc[a][b][m][n] = (f32x4){0.f, 0.f, 0.f, 0.f};
    bf16x8 At[4][2], B0[2][2], B1[2][2];
    const char* cA = S.Ap(cur); const char* cB = S.Bp(cur);
    if constexpr (SP2) {
        PG8_STAGE(PG8_SB(0, 0), cB, voffB); PG8_STAGE(PG8_SB(0, 1), cB + hB, voffB); PG8_STAGE(PG8_SA(0, 0), cA, voffA); PG8_STAGE(PG8_SA(0, 1), cA + hA, voffA);
        if (wr == 1) PG8_BAR;
        PG8_WAIT_V(2); PG8_BAR;
        PG8_STAGE(PG8_SB(1, 0), cB + kstep, voffB); PG8_STAGE(PG8_SA(1, 0), cA + kstepA, voffA); PG8_STAGE(PG8_SB(1, 1), cB + hB + kstep, voffB);
        PG8_WAIT_V(6); PG8_BAR;
    } else {
        PG8_STAGE(PG8_SB(0, 0), cB, voffB); PG8_STAGE(PG8_SA(0, 0), cA, voffA); PG8_STAGE(PG8_SB(0, 1), cB + hB, voffB); PG8_STAGE(PG8_SA(0, 1), cA + hA, voffA);
        if (wr == 1) PG8_BAR;
        PG8_WAIT_V(4); PG8_BAR;
        PG8_STAGE(PG8_SB(1, 0), cB + kstep, voffB); PG8_STAGE(PG8_SA(1, 0), cA + kstepA, voffA); PG8_STAGE(PG8_SB(1, 1), cB + hB + kstep, voffB);
        PG8_WAIT_V(6); PG8_BAR;
    }
    for (;;) {
        const bool has_next = S.next(ui + 1, nxt);
        const char* nA = has_next ? S.Ap(nxt) : cA; const char* nB = has_next ? S.Bp(nxt) : cB;
        for (int t = 0; t < nt; t += 2) {
            const bool last = (t == nt - 2);
            const char* a1 = cA + (size_t)(t + 1) * kstepA;
            const char* a2 = last ? nA : cA + (size_t)(t + 2) * kstepA; const char* b2 = last ? nB : cB + (size_t)(t + 2) * kstep;
            const char* a3 = a2 + kstepA; const char* b3 = b2 + kstep;
            if constexpr (SP2) {
            PG8_LDB(B0, 0, 0); PG8_LDB(B1, 0, 1); PG8_SCHED; PG8_LDA(At, 0, 0); PG8_STAGE(PG8_SA(1, 1), a1 + hA, voffA);
            PG8_WAIT_V(8); PG8_WAIT_L(0); PG8_BAR; PG8_MMA(0, 0, At, B0); PG8_MMA(0, 1, At, B1); PG8_BAR; PG8_SCHED;
            PG8_LDA(At, 0, 1); PG8_STAGE(PG8_SB(0, 0), b2, voffB); PG8_STAGE(PG8_SB(0, 1), b2 + hB, voffB); PG8_STAGE(PG8_SA(0, 0), a2, voffA);
            PG8_WAIT_V(8); PG8_WAIT_L(0); PG8_BAR; PG8_MMA(1, 0, At, B0); PG8_MMA(1, 1, At, B1); PG8_BAR; PG8_SCHED;
            PG8_LDB(B0, 1, 0); PG8_LDB(B1, 1, 1); PG8_SCHED; PG8_LDA(At, 1, 0); PG8_STAGE(PG8_SA(0, 1), a2 + hA, voffA);
            PG8_WAIT_V(8); PG8_WAIT_L(0); PG8_BAR; PG8_MMA(0, 0, At, B0); PG8_MMA(0, 1, At, B1); PG8_BAR; PG8_SCHED;
            PG8_LDA(At, 1, 1); PG8_STAGE(PG8_SB(1, 0), b3, voffB); PG8_STAGE(PG8_SB(1, 1), b3 + hB, voffB); PG8_STAGE(PG8_SA(1, 0), a3, voffA);
            PG8_WAIT_V(8); PG8_WAIT_L(0); PG8_BAR; PG8_MMA(1, 0, At, B0); PG8_MMA(1, 1, At, B1); PG8_BAR; PG8_SCHED;
            } else {
            PG8_LDB(B0, 0, 0); PG8_SCHED; PG8_LDA(At, 0, 0); PG8_STAGE(PG8_SA(1, 1), a1 + hA, voffA);
            PG8_WAIT_L(8); PG8_BAR; PG8_WAIT_L(0); PG8_MMA(0, 0, At, B0); PG8_BAR; PG8_SCHED;
            PG8_LDB(B1, 0, 1); PG8_STAGE(PG8_SB(0, 0), b2, voffB);
            PG8_BAR; PG8_WAIT_L(0); PG8_MMA(0, 1, At, B1); PG8_BAR;
            PG8_LDA(At, 0, 1); PG8_STAGE(PG8_SA(0, 0), a2, voffA);
            PG8_BAR; PG8_WAIT_L(0); PG8_MMA(1, 0, At, B0); PG8_BAR; PG8_SCHED;
            PG8_STAGE(PG8_SB(0, 1), b2 + hB, voffB);
            PG8_WAIT_V(6); PG8_BAR; PG8_MMA(1, 1, At, B1); PG8_BAR;
            PG8_LDB(B0, 1, 0); PG8_SCHED; PG8_LDA(At, 1, 0); PG8_STAGE(PG8_SA(0, 1), a2 + hA, voffA);
            PG8_WAIT_L(8); PG8_BAR; PG8_WAIT_L(0); PG8_MMA(0, 0, At, B0); PG8_BAR; PG8_SCHED;
            PG8_LDB(B1, 1, 1); PG8_STAGE(PG8_SB(1, 0), b3, voffB);
            PG8_BAR; PG8_WAIT_L(0); PG8_MMA(0, 1, At, B1); PG8_BAR;
            PG8_LDA(At, 1, 1); PG8_STAGE(PG8_SA(1, 0), a3, voffA);
            PG8_BAR; PG8_WAIT_L(0); PG8_MMA(1, 0, At, B0); PG8_BAR; PG8_SCHED;
            PG8_STAGE(PG8_SB(1, 1), b3 + hB, voffB);
            PG8_WAIT_V(6); PG8_BAR; PG8_MMA(1, 1, At, B1); PG8_BAR;
            }
        }
        if constexpr (ALIGN_EPI) { if (wr == 0) PG8_BAR; }
        { const int lane_e = hw_lane();
          E(acc, cur, wr, wc, lane_e & 15, lane_e >> 4); }
        if (!has_next) break;
        if (!E.keep(cur)) {
#pragma unroll
        for (int a = 0; a < 2; ++a)
#pragma unroll
            for (int b = 0; b < 2; ++b)
#pragma unroll
                for (int m = 0; m < 4; ++m)
#pragma unroll
                    for (int n = 0; n < 2; ++n) acc[a][b][m][n] = (f32x4){0.f, 0.f, 0.f, 0.f};
        }
        cur = nxt; cA = nA; cB = nB; ++ui;
        if constexpr (ALIGN_EPI) { if (wr == 1) PG8_BAR; }
    }
    PG8_WAIT_V(0);
    if constexpr (!ALIGN_EPI) { if (wr == 0) PG8_BAR; }
    PG8_BAR;
#undef PG8_SA
#undef PG8_SB
#undef PG8_STAGE
#undef PG8_LDA
#undef PG8_LDB
#undef PG8_MMA
#undef PG8_WAIT_V
#undef PG8_WAIT_L
#undef PG8_BAR
#undef PG8_SCHED
}
}

#define XB_TMO      128
#define XB_XCNT(j)  (256  + 64 * (j))
#define XB_XSUB(j)  (1280 + 64 * (j))
#define XB_XGEN(j)  (2304 + 64 * (j))
#define XB_TOP      3328
#define XB_TOPGEN   3392
#define XCD_BAR_WORDS 3456
#define XB_SPIN_CAP (1u << 18)
__device__ __forceinline__ unsigned xb_ld(unsigned* p)              { return __hip_atomic_load(p, __ATOMIC_RELAXED, __HIP_MEMORY_SCOPE_AGENT); }
__device__ __forceinline__ unsigned xb_add(unsigned* p, unsigned v) { return __hip_atomic_fetch_add(p, v, __ATOMIC_RELAXED, __HIP_MEMORY_SCOPE_AGENT); }
__device__ __forceinline__ unsigned xb_xcc_id() { return (unsigned)__builtin_amdgcn_s_getreg((3 << 11) | 20) & 0xFu; }
#define XB_SPIN(cond, bar) do { unsigned _sp = 0; while (cond) { __builtin_amdgcn_s_sleep(1); \
    if ((++_sp & 255u) == 0u) { if (xb_ld(&(bar)[XB_TMO])) break; if (_sp > XB_SPIN_CAP) { atomicAdd(&(bar)[XB_TMO], 1u); break; } } } } while (0)
struct XcdBarrier { unsigned* bar; unsigned x; volatile LAS unsigned* st; };
__device__ __forceinline__ XcdBarrier xcd_barrier_post(unsigned* bar, volatile LAS unsigned* st) {
    XcdBarrier b; b.bar = bar; b.x = xb_xcc_id(); b.st = st;
    if (threadIdx.x == 0) (void)xb_add(&bar[XB_XCNT(b.x)], 1u);
    return b;
}
__device__ __forceinline__ void xcd_barrier_complete(unsigned* bar, unsigned x, unsigned& nloc, unsigned& nx) {
    const unsigned G = gridDim.x * gridDim.y * gridDim.z;
    unsigned sum, cnt, mine, sp = 0u;
    for (;;) {
        sum = 0u; cnt = 0u; mine = 0u;
#pragma unroll
        for (unsigned j = 0; j < 16; ++j) { const unsigned c = xb_ld(&bar[XB_XCNT(j)]); sum += c; cnt += (c > 0u) ? 1u : 0u; mine = (j == x) ? c : mine; }
        if (sum == G) break;
        __builtin_amdgcn_s_sleep(1);
        if ((++sp & 255u) == 0u) { if (xb_ld(&bar[XB_TMO])) break; if (sp > XB_SPIN_CAP) { atomicAdd(&bar[XB_TMO], 1u); break; } }
    }
    nloc = mine > 0u ? mine : 1u; nx = cnt > 0u ? cnt : 1u;
}
__device__ __forceinline__ void xcd_barrier(const XcdBarrier& b, const int wv) {
    asm volatile("s_waitcnt vmcnt(0)" ::: "memory");
    __syncthreads();
    if (wv == 0 && hw_lane() == 0) {
        unsigned* bar = b.bar;
        __builtin_amdgcn_s_waitcnt(0);
        unsigned nloc = b.st[0], nx = b.st[1];
        if (nloc == 0u) { xcd_barrier_complete(bar, b.x, nloc, nx); b.st[0] = nloc; b.st[1] = nx; }
        const unsigned old = xb_add(&bar[XB_XSUB(b.x)], 1u);
        const unsigned gen = old / nloc;
        if (old + 1u == (gen + 1u) * nloc) {
            __builtin_amdgcn_fence(__ATOMIC_RELEASE, "agent");
            asm volatile("s_waitcnt vmcnt(0)" ::: "memory");
            const unsigned og = xb_add(&bar[XB_TOP], 1u);
            const unsigned tg = og / nx;
            if (og + 1u == (tg + 1u) * nx) xb_add(&bar[XB_TOPGEN], 1u);
            else XB_SPIN(xb_ld(&bar[XB_TOPGEN]) == tg, bar);
            __builtin_amdgcn_fence(__ATOMIC_ACQUIRE, "agent");
            xb_add(&bar[XB_XGEN(b.x)], 1u);
            asm volatile("s_waitcnt vmcnt(0)" ::: "memory");
        } else {
            XB_SPIN(xb_ld(&bar[XB_XGEN(b.x)]) == gen, bar);
            __builtin_amdgcn_fence(__ATOMIC_ACQUIRE, "agent");
            asm volatile("s_waitcnt vmcnt(0)" ::: "memory");
        }
    }
    __syncthreads();
}

struct Args { const float* in[33]; float* out; unsigned char* ws; };
__device__ __forceinline__ const float* inp(int i) {
    unsigned off = (unsigned)i * 8u; asm volatile("" : "+s"(off));
    typedef const float* cfp;
    return *(const __attribute__((address_space(4))) cfp*)((const __attribute__((address_space(4))) char*)__builtin_amdgcn_kernarg_segment_ptr() + off);
}

#define WSP(off) (inp_ws() + (off))
__device__ __forceinline__ unsigned char* inp_ws() { return (unsigned char*)inp(34); }
__device__ __forceinline__ float* inp_out() { return (float*)inp(33); }

__device__ __forceinline__ void transpose_item(const float* W, int ldw, int K, bf16_t* WT, int src_n0, int dst_n0, int k0, LAS float* scr, int lane) {
#pragma unroll 8
    for (int i = 0; i < 32; ++i) { const int kk = 2 * i + (lane >> 5); scr[kk * 33 + (lane & 31)] = W[(size_t)(k0 + kk) * ldw + src_n0 + (lane & 31)]; }
    LDS_WAIT(); asm volatile("" ::: "memory");
    const int c = lane & 7;
#pragma unroll
    for (int j = 0; j < 4; ++j) { const int n = (lane >> 3) + 8 * j; const LAS float* s = scr + (8 * c) * 33 + n;
        u32x4 o; o.x = pk2(s[0 * 33], s[1 * 33]); o.y = pk2(s[2 * 33], s[3 * 33]); o.z = pk2(s[4 * 33], s[5 * 33]); o.w = pk2(s[6 * 33], s[7 * 33]);
        *(u32x4*)(WT + (size_t)(dst_n0 + n) * K + k0 + 8 * c) = o; }
    LDS_WAIT(); asm volatile("" ::: "memory");
}
template <int MAP>
__device__ __forceinline__ void convert_matrix(const float* W, int ldw, int K, int Ndst, bf16_t* WT, LAS float* scr, int lane, int gw, int NGW, int& base) {
    const int nblk = Ndst / 32, nitems = (K / 64) * nblk;
    int first = (gw - base % NGW + NGW) % NGW;
    for (int it = first; it < nitems; it += NGW) {
        const int kb = it / nblk, nb = it % nblk, d0 = nb * 32;
        int s0 = d0;
        if (MAP == 1) s0 = d0 + (d0 < 1024 ? 0 : (d0 < 2560 ? 16 : 24));
        if (MAP == 2) { const int pn = d0 >> 8, hh = (d0 & 255) >> 7, r = d0 & 127; s0 = hh * FF + pn * 128 + r; }
        transpose_item(W, ldw, K, WT, s0, d0, kb * 64, scr, lane);
    }
    base += nitems;
}

__device__ __forceinline__ void ada_phase(LAS unsigned char* lds, int blk, int wave, int lane) {
    if (blk >= 192) return;
    const int l = blk / 96, n0 = (blk % 96) * 64;
    const float* c = inp(1); const float* W = inp(2) + (size_t)l * 1024 * 6144; const float* bias = inp(3) + l * 6144;
    LAS float* part = (LAS float*)lds;
    float acc[8] = {0.f, 0.f, 0.f, 0.f, 0.f, 0.f, 0.f, 0.f};
    for (int k = wave * 128; k < wave * 128 + 128; ++k) {
        const float wv = W[(size_t)k * 6144 + n0 + lane];
#pragma unroll
        for (int b = 0; b < 8; ++b) { const float cv = c[b * 1024 + k]; acc[b] += siluf_(cv) * wv; }
    }
#pragma unroll
    for (int b = 0; b < 8; ++b) part[(wave * 8 + b) * 64 + lane] = acc[b];
    __syncthreads();
    {
        const int b = wave; float s = bias[n0 + lane];
#pragma unroll
        for (int w = 0; w < 8; ++w) s += part[(w * 8 + b) * 64 + lane];
        ((float*)WSP(WS_MOD))[(size_t)(l * 8 + b) * 6144 + n0 + lane] = s;
    }
    __syncthreads();
}

__device__ __forceinline__ float reduce32(const float (&p)[32], int lane) {
    float q16[16], q8[8], q4[4], q2[2];
    const bool b5 = (lane & 32) != 0, b4 = (lane & 16) != 0, b3 = (lane & 8) != 0, b2 = (lane & 4) != 0, b1 = (lane & 2) != 0;
#pragma unroll
    for (int i = 0; i < 16; ++i) { const float send = b5 ? p[i] : p[i + 16], keep = b5 ? p[i + 16] : p[i]; q16[i] = keep + shl(send, lane ^ 32); }
#pragma unroll
    for (int i = 0; i < 8; ++i) { const float send = b4 ? q16[i] : q16[i + 8], keep = b4 ? q16[i + 8] : q16[i]; q8[i] = keep + shl(send, lane ^ 16); }
#pragma unroll
    for (int i = 0; i < 4; ++i) { const float send = b3 ? q8[i] : q8[i + 4], keep = b3 ? q8[i + 4] : q8[i]; q4[i] = keep + shl(send, lane ^ 8); }
#pragma unroll
    for (int i = 0; i < 2; ++i) { const float send = b2 ? q4[i] : q4[i + 2], keep = b2 ? q4[i + 2] : q4[i]; q2[i] = keep + shl(send, lane ^ 4); }
    const float send = b1 ? q2[0] : q2[1], keep = b1 ? q2[1] : q2[0];
    const float q1 = keep + shl(send, lane ^ 2);
    return q1 + shl(q1, lane ^ 1);
}
template <bool WITH_POST, bool WITH_PRE, bool WITH_ZS>
__device__ __forceinline__ void norm_rows(const bf16_t* Y, int ldy, const float* xin, const float* pw, const float* modl_post, int gt_off, float* xout,
                                          const float* w2, const float* modl_pre, int sh_off, int sc_off, bf16_t* H, float* ZS, const LAS float* wsm, int gw, int NGW, int lane) {
    for (int row0 = gw; row0 < M; row0 += 2 * NGW) {
        f32x4 v[2][4];
        if (WITH_POST) {
            float ss[2] = {0.f, 0.f};
#pragma unroll
            for (int q = 0; q < 2; ++q)
#pragma unroll
                for (int j = 0; j < 4; ++j) { const u32x2 y = *(const u32x2*)(Y + (size_t)(row0 + q * NGW) * ldy + (lane + 64 * j) * 4);
                    v[q][j] = (f32x4){bflo(y.x), bfhi(y.x), bflo(y.y), bfhi(y.y)}; ss[q] += v[q][j][0] * v[q][j][0] + v[q][j][1] * v[q][j][1] + v[q][j][2] * v[q][j][2] + v[q][j][3] * v[q][j][3]; }
#pragma unroll
            for (int o = 1; o < 64; o <<= 1) { const float t0 = shl(ss[0], lane ^ o), t1 = shl(ss[1], lane ^ o); ss[0] += t0; ss[1] += t1; }
#pragma unroll
            for (int q = 0; q < 2; ++q) {
                const int row = row0 + q * NGW, b = row / T;
                const float r = rsqrtf(ss[q] * (1.f / D) + 1e-6f);
                const float* gt = modl_post + (size_t)b * 6144 + gt_off;
#pragma unroll
                for (int j = 0; j < 4; ++j) {
                    const int col = (lane + 64 * j) * 4;
                    const f32x4 xo = *(const f32x4*)(xin + (size_t)row * D + col), pwv = *(const f32x4*)(pw + col), gtv = *(const f32x4*)(gt + col);
#pragma unroll
                    for (int e = 0; e < 4; ++e) v[q][j][e] = xo[e] + (1.f + gtv[e]) * (v[q][j][e] * r * pwv[e]);
                    *(f32x4*)(xout + (size_t)row * D + col) = v[q][j];
                }
            }
        } else {
#pragma unroll
            for (int q = 0; q < 2; ++q)
#pragma unroll
                for (int j = 0; j < 4; ++j) v[q][j] = *(const f32x4*)(xin + (size_t)(row0 + q * NGW) * D + (lane + 64 * j) * 4);
        }
        if (WITH_PRE) {
            float ss[2] = {0.f, 0.f};
#pragma unroll
            for (int q = 0; q < 2; ++q)
#pragma unroll
                for (int j = 0; j < 4; ++j) ss[q] += v[q][j][0] * v[q][j][0] + v[q][j][1] * v[q][j][1] + v[q][j][2] * v[q][j][2] + v[q][j][3] * v[q][j][3];
#pragma unroll
            for (int o = 1; o < 64; o <<= 1) { const float t0 = shl(ss[0], lane ^ o), t1 = shl(ss[1], lane ^ o); ss[0] += t0; ss[1] += t1; }
#pragma unroll
            for (int q = 0; q < 2; ++q) {
                const int row = row0 + q * NGW, b = row / T;
                const float r2 = rsqrtf(ss[q] * (1.f / D) + 1e-6f);
                const float* sh = modl_pre + (size_t)b * 6144 + sh_off; const float* sc = modl_pre + (size_t)b * 6144 + sc_off;
#pragma unroll
                for (int j = 0; j < 4; ++j) {
                    const int col = (lane + 64 * j) * 4;
                    const f32x4 wv = *(const f32x4*)(w2 + col), scv = *(const f32x4*)(sc + col), shv = *(const f32x4*)(sh + col);
#pragma unroll
                    for (int e = 0; e < 4; ++e) v[q][j][e] = v[q][j][e] * r2 * wv[e] * (1.f + scv[e]) + shv[e];
                    u32x2 o; o.x = pk2(v[q][j][0], v[q][j][1]); o.y = pk2(v[q][j][2], v[q][j][3]);
                    *(u32x2*)(H + (size_t)row * D + col) = o;
                }
            }
            if (WITH_ZS) {
                float p0[32], p1[32];
#pragma unroll
                for (int c = 0; c < 32; ++c) { p0[c] = 0.f; p1[c] = 0.f; }
#pragma unroll
                for (int c = 0; c < 24; ++c) {
#pragma unroll
                    for (int j = 0; j < 4; ++j) { const f32x4 wv = *(const LAS f32x4*)(wsm + c * 1024 + (lane + 64 * j) * 4);
                        p0[c] += v[0][j][0] * wv[0] + v[0][j][1] * wv[1] + v[0][j][2] * wv[2] + v[0][j][3] * wv[3];
                        p1[c] += v[1][j][0] * wv[0] + v[1][j][1] * wv[1] + v[1][j][2] * wv[2] + v[1][j][3] * wv[3]; }
                    if ((c & 1) == 1) asm volatile("" ::: "memory");
                }
                const float r0 = reduce32(p0, lane), r1 = reduce32(p1, lane);
                if ((lane & 1) == 0 && lane < 48) { ZS[(size_t)row0 * 32 + (lane >> 1)] = r0; ZS[(size_t)(row0 + NGW) * 32 + (lane >> 1)] = r1; }
            }
        }
    }
}
__device__ __forceinline__ void stage_wsmall(const float* w_in, LAS float* wsm, int tid) {
    for (int k = tid; k < 1024; k += NWAVES * 64) {
        const float* src = w_in + (size_t)k * INDIM;
#pragma unroll
        for (int c = 0; c < 16; ++c) wsm[c * 1024 + k] = src[1024 + c];
#pragma unroll
        for (int c = 0; c < 8; ++c) wsm[(16 + c) * 1024 + k] = src[2576 + c];
    }
    __syncthreads();
}

__device__ __forceinline__ void s5_generate(int l, int g, LAS unsigned char* lds, int wv) {
    int tid = hw_tid(wv); asm volatile("" : "+v"(tid));
    LAS float* ar = (LAS float*)lds;
    LAS float* ai = ar + 17 * 64;
    LAS float* bbr = ai + 17 * 64;
    LAS float* bbi = bbr + 1024;
    LAS float* cr = bbi + 1024;
    LAS float* ci = cr + 1024;
    LAS float* Kt = ci + 1024;
    bf16_t* Bt1 = (bf16_t*)WSP(WS_S5M1) + (size_t)g * 384 * 256;
    bf16_t* Bt3 = (bf16_t*)WSP(WS_S5M3) + (size_t)g * 256 * 256;
    __syncthreads();
    if (tid < 64) {
        const int p = tid;
        const float lre = fminf((inp(16) + l * 2048)[g * 64 + p], -1e-4f), lim = (inp(17) + l * 2048)[g * 64 + p], dt = expf((inp(18) + l * 32)[g]);
        for (int k = 0; k <= 16; ++k) { const float mg = expf((float)k * lre * dt), an = (float)k * lim * dt; ar[k * 64 + p] = mg * cosf(an); ai[k * 64 + p] = mg * sinf(an); }
        const float a1r = ar[64 + p], a1i = ai[64 + p];
        const float inv = 1.f / (lre * lre + lim * lim);
        const float zr_ = ((a1r - 1.f) * lre + a1i * lim) * inv, zi_ = (a1i * lre - (a1r - 1.f) * lim) * inv;
        const float* b_re = inp(19) + (size_t)l * 32768 + (size_t)(g * 64 + p) * 16; const float* b_im = inp(20) + (size_t)l * 32768 + (size_t)(g * 64 + p) * 16;
        for (int c = 0; c < 16; ++c) { const float br = b_re[c], bi = b_im[c]; bbr[p * 16 + c] = zr_ * br - zi_ * bi; bbi[p * 16 + c] = zr_ * bi + zi_ * br; }
    }
    for (int i = tid; i < 1024; i += 512) { cr[i] = (inp(21) + (size_t)l * 32768)[g * 1024 + i]; ci[i] = (inp(22) + (size_t)l * 32768)[g * 1024 + i]; }
    __syncthreads();
    {
        const int cp = tid >> 5, c = (tid >> 1) & 15, ph = tid & 1;
        float acc[16];
#pragma unroll
        for (int t = 0; t < 16; ++t) acc[t] = 0.f;
        for (int pp = 0; pp < 32; ++pp) {
            const int p = 32 * ph + pp;
            const float xr = cr[cp * 64 + p], xi = ci[cp * 64 + p], yr = bbr[p * 16 + c], yi = bbi[p * 16 + c];
            const float cbr = xr * yr - xi * yi, cbi = xr * yi + xi * yr;
#pragma unroll
            for (int t = 0; t < 16; ++t) acc[t] += cbr * ar[t * 64 + p] - cbi * ai[t * 64 + p];
        }
#pragma unroll
        for (int t = 0; t < 16; ++t) { const float o = acc[t] + shl(acc[t], (tid & 63) ^ 1); if (ph == 0) Kt[(t * 16 + cp) * 16 + c] = o; }
    }
    __syncthreads();
    for (int pc = tid; pc < 128 * 32; pc += 512) {
        const int row = pc >> 5, k0 = (pc & 31) * 8, sp = k0 >> 4, c0 = k0 & 15, p = row & 63, e15 = 15 - sp;
        const float xr = ar[e15 * 64 + p], xi = ai[e15 * 64 + p];
        float v[8];
#pragma unroll
        for (int e = 0; e < 8; ++e) { const float yr = bbr[p * 16 + c0 + e], yi = bbi[p * 16 + c0 + e]; v[e] = row < 64 ? (xr * yr - xi * yi) : (xr * yi + xi * yr); }
        u32x4 w; w.x = pk2(v[0], v[1]); w.y = pk2(v[2], v[3]); w.z = pk2(v[4], v[5]); w.w = pk2(v[6], v[7]);
        *(u32x4*)(Bt1 + (size_t)row * 256 + k0) = w;
    }
    for (int pc = tid; pc < 256 * 32; pc += 512) {
        const int j = pc >> 5, k0 = (pc & 31) * 8, s = j >> 4, cp = j & 15, sp = k0 >> 4, c0 = k0 & 15;
        float v[8];
#pragma unroll
        for (int e = 0; e < 8; ++e) v[e] = (sp <= s) ? Kt[((s - sp) * 16 + cp) * 16 + c0 + e] : 0.f;
        u32x4 w; w.x = pk2(v[0], v[1]); w.y = pk2(v[2], v[3]); w.z = pk2(v[4], v[5]); w.w = pk2(v[6], v[7]);
        *(u32x4*)(Bt1 + (size_t)(128 + j) * 256 + k0) = w;
    }
    for (int pc = tid; pc < 256 * 32; pc += 512) {
        const int j = pc >> 5, k0 = (pc & 31) * 8, s = j >> 4, cp = j & 15;
        float v[8];
#pragma unroll
        for (int e = 0; e < 8; ++e) {
            const int k = k0 + e, p = k & 63;
            const float xr = cr[cp * 64 + p], xi = ci[cp * 64 + p], yr = ar[(s + 1) * 64 + p], yi = ai[(s + 1) * 64 + p];
            v[e] = k < 64 ? (xr * yr - xi * yi) : (k < 128 ? -(xr * yi + xi * yr) : 0.f);
        }
        u32x4 w; w.x = pk2(v[0], v[1]); w.y = pk2(v[2], v[3]); w.z = pk2(v[4], v[5]); w.w = pk2(v[6], v[7]);
        *(u32x4*)(Bt3 + (size_t)j * 256 + k0) = w;
    }
    __syncthreads();
}
__device__ __forceinline__ void s5_scan(int l, int sid, int lane) {
    const int g = sid >> 3, b = sid & 7, p = lane;
    const float lre = fminf((inp(16) + l * 2048)[g * 64 + p], -1e-4f), lim = (inp(17) + l * 2048)[g * 64 + p], dt = expf((inp(18) + l * 32)[g]);
    const float mg = expf(16.f * lre * dt), an = 16.f * lim * dt, a16r = mg * cosf(an), a16i = mg * sinf(an);
    float* base = (float*)WSP(WS_EX) + (size_t)(g * 2048 + b * 256) * 128;
    float xr = 0.f, xi = 0.f;
    float er[8], ei[8], nr[8], ni[8];
#pragma unroll
    for (int j = 0; j < 8; ++j) { er[j] = base[(size_t)j * 128 + p]; ei[j] = base[(size_t)j * 128 + 64 + p]; }
#pragma unroll 1
    for (int n0 = 0; n0 < 256; n0 += 8) {
        if (n0 + 8 < 256) {
#pragma unroll
            for (int j = 0; j < 8; ++j) { nr[j] = base[(size_t)(n0 + 8 + j) * 128 + p]; ni[j] = base[(size_t)(n0 + 8 + j) * 128 + 64 + p]; }
        }
        asm volatile("s_waitcnt vmcnt(16)" ::: "memory");
#pragma unroll
        for (int j = 0; j < 8; ++j) {
            bf16_t* row = (bf16_t*)(base + (size_t)(n0 + j) * 128);
            row[p] = (bf16_t)f2bf(xr); row[64 + p] = (bf16_t)f2bf(xi); ((unsigned*)row)[64 + p] = 0u;
            const float tr = a16r * xr - a16i * xi + er[j], ti = a16r * xi + a16i * xr + ei[j];
            xr = tr; xi = ti;
        }
#pragma unroll
        for (int j = 0; j < 8; ++j) { er[j] = nr[j]; ei[j] = ni[j]; }
    }
}

namespace mx {
typedef float f32x16 __attribute__((ext_vector_type(16)));
constexpr int PB = 72;
constexpr int L_QS = 0, L_KS = 9216, L_KT = 18432, L_VT = 27648, L_PS = 46080, L_ST = 55296, L_OS = 73728, L_VEC = 107520;
constexpr int OSP = 132;
constexpr int V_SEG = 0, V_ELAST = 512, V_GA = 576, V_RT = 1600, V_CS = 1664, V_WI = 1728, V_WK = 1792, V_ENM = 1856, V_DEN = 1920, V_NORM = 1984, V_SC = 2112, V_END = 2128;
static_assert(L_VEC + V_END * 4 <= RING_BYTES, "mixer LDS map");
__device__ __forceinline__ int crow(int reg, int hh) { return (reg & 3) + 8 * (reg >> 2) + 4 * hh; }
__device__ __forceinline__ float fexp(float x) { return __builtin_amdgcn_exp2f(1.4426950408889634f * x); }
__device__ __forceinline__ float flogsig(float x) { const float e = fexp(-fabsf(x)); return fminf(x, 0.f) - 0.6931471805599453f * __builtin_amdgcn_logf(1.f + e); }
#define MX_MFMA(a, b, c) __builtin_amdgcn_mfma_f32_32x32x16_bf16((a), (b), (c), 0, 0, 0)

template <int ROLE, bool STORE = true>
__device__ __forceinline__ void stream(int l, LAS unsigned char* lds, int bh, int wvs) {
    int tid = hw_tid(wvs); asm volatile("" : "+v"(tid));
    const int lane = tid & 63, w = __builtin_amdgcn_readfirstlane(tid >> 6), r32 = lane & 31, hh = lane >> 5;
    const int b = bh >> 2, h = bh & 3;
    bf16_t* Z = (bf16_t*)WSP(WS_Z); const float* ZS = (const float*)WSP(WS_ZS);
    LAS float* vec = (LAS float*)(lds + L_VEC);
    LAS bf16_t* Qs = (LAS bf16_t*)(lds + L_QS); LAS bf16_t* Ks = (LAS bf16_t*)(lds + L_KS); LAS bf16_t* KTs = (LAS bf16_t*)(lds + L_KT);
    LAS bf16_t* VTs = (LAS bf16_t*)(lds + L_VT); LAS bf16_t* Ps = (LAS bf16_t*)(lds + L_PS); LAS bf16_t* STs = (LAS bf16_t*)(lds + L_ST);
    LAS float* Os = (LAS float*)(lds + L_OS);
    const int qcol = (ROLE == 0 ? GQ : MQ) + h * 64, kcol = (ROLE == 0 ? GK : MK) + h * 64, vcol = (ROLE == 0 ? GV : MV) + h * 128, gcol = (ROLE == 0 ? GR : MO) + h * 128;
    const int vc_ = tid & 127, rq = tid >> 7, et = tid >> 3, cg = tid & 7;
    const int wa = w >> 2, wv = w & 3;
    float a2c[16], abd = 0.f, nwv[16];
    float cwq[4], cwk[4], cbq = 0.f, cbk = 0.f, ibh = 0.f, fbh = 0.f, mprev = 0.f;
#pragma unroll
    for (int r = 0; r < 16; ++r) { a2c[r] = 0.f; nwv[r] = 0.f; }
#pragma unroll
    for (int j = 0; j < 4; ++j) { cwq[j] = 0.f; cwk[j] = 0.f; }
    if (ROLE == 0) {
        const float* a2 = inp(9) + l * 16 * 256; const float* ab = inp(10) + l * 256; const float* nw = inp(11) + l * 512;
#pragma unroll
        for (int r = 0; r < 16; ++r) { a2c[r] = a2[r * 256 + h * 64 + lane]; nwv[r] = nw[h * 128 + 16 * cg + r]; }
        abd = ab[h * 64 + lane];
    } else {
        const float* cw = inp(12) + l * 4 * 512; const float* cb = inp(13) + l * 512;
#pragma unroll
        for (int j = 0; j < 4; ++j) { cwq[j] = cw[j * 512 + h * 64 + lane]; cwk[j] = cw[j * 512 + 256 + h * 64 + lane]; }
        cbq = cb[h * 64 + lane]; cbk = cb[256 + h * 64 + lane];
        ibh = (inp(14) + l * 4)[h]; fbh = (inp(15) + l * 4)[h];
    }
    for (int i = tid; i < 128 * PB / 2; i += 512) ((LAS unsigned*)STs)[i] = 0u;
    for (int i = tid; i < 64 * PB / 2; i += 512) ((LAS unsigned*)Ps)[i] = 0u;
    if (tid < 128) vec[V_NORM + tid] = 0.f;
    f32x16 accS;
#pragma unroll
    for (int r = 0; r < 16; ++r) accS[r] = 0.f;
    unsigned qi[11], ki[11], vi[16]; float zs0 = 0.f, zs1 = 0.f; u32x4 gt0 = {0u, 0u, 0u, 0u}, gt1 = {0u, 0u, 0u, 0u};
#define MX_LOAD(mrow, nn) do { \
        if (ROLE == 0) { \
            _Pragma("unroll") for (int i = 0; i < 8; ++i) { const bf16_t* zr = Z + ((mrow) + 8 * w + i) * ZLD; qi[i] = *(const unsigned*)(zr + qcol + (lane & ~1)); ki[i] = *(const unsigned*)(zr + kcol + (lane & ~1)); } \
            const float* zp = ZS + ((mrow) + et) * 32 + 2 * cg; zs0 = zp[0]; zs1 = zp[1]; \
        } else { \
            _Pragma("unroll") for (int i = 0; i < 11; ++i) { const int trel = 8 * w + i - 3; const int trc = ((nn) > 0 || trel >= 0) ? trel : 0;     \
                const bf16_t* zr = Z + ((mrow) + trc) * ZLD; qi[i] = *(const unsigned*)(zr + qcol + (lane & ~1)); ki[i] = *(const unsigned*)(zr + kcol + (lane & ~1)); } \
            if (w == 0) { const float* zp = ZS + ((mrow) + lane) * 32; zs0 = zp[16 + h]; zs1 = zp[20 + h]; } \
        } \
        _Pragma("unroll") for (int i = 0; i < 16; ++i) vi[i] = *(const unsigned*)(Z + ((mrow) + 16 * rq + i) * ZLD + vcol + (vc_ & ~1)); \
    } while (0)
#define MX_PIN11(a) asm volatile("" : "+v"(a[0]), "+v"(a[1]), "+v"(a[2]), "+v"(a[3]), "+v"(a[4]), "+v"(a[5]), "+v"(a[6]), "+v"(a[7]), "+v"(a[8]), "+v"(a[9]), "+v"(a[10]))
#define MX_PIN8(a, o) asm volatile("" : "+v"(a[o]), "+v"(a[o + 1]), "+v"(a[o + 2]), "+v"(a[o + 3]), "+v"(a[o + 4]), "+v"(a[o + 5]), "+v"(a[o + 6]), "+v"(a[o + 7]))
    size_t m0 = (size_t)b * T;
    MX_LOAD(m0, 0);
    if (ROLE == 0) { vec[V_GA + et * 16 + 2 * cg] = zs0; vec[V_GA + et * 16 + 2 * cg + 1] = zs1; }
    __syncthreads();

#pragma unroll 1
    for (int n = 0; n <= 64; ++n) {
        if (n > 0) {
            const size_t mp = m0 - 64;
            const LAS float* orow = Os + et * OSP + 16 * cg;
            float o[16];
#pragma unroll
            for (int q4 = 0; q4 < 4; ++q4) { const f32x4 t4 = *(const LAS f32x4*)(orow + 4 * q4); o[4 * q4] = t4[0]; o[4 * q4 + 1] = t4[1]; o[4 * q4 + 2] = t4[2]; o[4 * q4 + 3] = t4[3]; }
            asm volatile("" : "+v"(gt0), "+v"(gt1));
            const unsigned gw_[8] = {gt0.x, gt0.y, gt0.z, gt0.w, gt1.x, gt1.y, gt1.z, gt1.w};
            float y[16];
            if (ROLE == 0) {
                float ss = 0.f;
#pragma unroll
                for (int e = 0; e < 16; ++e) ss += o[e] * o[e];
                ss += shl(ss, lane ^ 1); ss += shl(ss, lane ^ 2); ss += shl(ss, lane ^ 4);
                const float rn = rsqrtf(ss * (1.f / 128.f) + 1e-6f);
#pragma unroll
                for (int e = 0; e < 16; ++e) { const float g = (e & 1) ? bfhi(gw_[e >> 1]) : bflo(gw_[e >> 1]); y[e] = o[e] * rn * nwv[e] * g * fsigmoid(g); }
            } else {
                const float rdiv = vec[V_DEN + et];
#pragma unroll
                for (int e = 0; e < 16; ++e) { const float g = (e & 1) ? bfhi(gw_[e >> 1]) : bflo(gw_[e >> 1]); y[e] = o[e] * rdiv * fsigmoid(g); }
            }
            u32x4 s0, s1;
            s0.x = pk2(y[0], y[1]); s0.y = pk2(y[2], y[3]); s0.z = pk2(y[4], y[5]); s0.w = pk2(y[6], y[7]);
            s1.x = pk2(y[8], y[9]); s1.y = pk2(y[10], y[11]); s1.z = pk2(y[12], y[13]); s1.w = pk2(y[14], y[15]);
            bf16_t* dst = Z + (mp + et) * ZLD + gcol + 16 * cg;
            if (STORE) { *(u32x4*)dst = s0; *(u32x4*)(dst + 8) = s1; } else { asm volatile("" :: "v"(s0), "v"(s1), "v"(dst)); }
        }
        if (n == 64) break;
        if (ROLE == 0) { MX_PIN8(qi, 0); MX_PIN8(ki, 0); } else { MX_PIN11(qi); MX_PIN11(ki); if (n == 0 && w == 0) { qi[0] = qi[1] = qi[2] = 0u; ki[0] = ki[1] = ki[2] = 0u; } }
        asm volatile("" : "+v"(zs0), "+v"(zs1));
        float c8[8], qf[8], kf[8];
        if (ROLE == 0) {
            float run = 0.f;
#pragma unroll
            for (int i = 0; i < 8; ++i) {
                const LAS f32x4* gp = (const LAS f32x4*)(vec + V_GA + (8 * w + i) * 16);
                float x = abd;
#pragma unroll
                for (int r4 = 0; r4 < 4; ++r4) { const f32x4 g4 = gp[r4]; x += g4[0] * a2c[4 * r4] + g4[1] * a2c[4 * r4 + 1] + g4[2] * a2c[4 * r4 + 2] + g4[3] * a2c[4 * r4 + 3]; }
                run += flogsig(x) * (1.f / 16.f); c8[i] = run;
                qf[i] = ((lane & 1) ? bfhi(qi[i]) : bflo(qi[i])) * 0.125f; kf[i] = (lane & 1) ? bfhi(ki[i]) : bflo(ki[i]);
            }
            vec[V_SEG + w * 64 + lane] = run;
        } else {
#pragma unroll
            for (int i = 0; i < 8; ++i) {
                float aq = cbq, ak = cbk;
#pragma unroll
                for (int j = 0; j < 4; ++j) { aq += cwq[j] * ((lane & 1) ? bfhi(qi[i + j]) : bflo(qi[i + j])); ak += cwk[j] * ((lane & 1) ? bfhi(ki[i + j]) : bflo(ki[i + j])); }
                qf[i] = aq * fsigmoid(aq); kf[i] = ak * fsigmoid(ak) * 0.125f; c8[i] = 0.f;
            }
            if (w == 0) {
                const float ip = zs0 + ibh, lf = logsigmoidf_(zs1 + fbh);
                float bs = lf;
#pragma unroll
                for (int o = 1; o < 64; o <<= 1) { const float t = shl(bs, lane >= o ? lane - o : lane); if (lane >= o) bs += t; }
                const float cs = ip - bs;
                float pm = cs;
#pragma unroll
                for (int o = 1; o < 64; o <<= 1) { const float t = shl(pm, lane >= o ? lane - o : lane); if (lane >= o) pm = fmaxf(pm, t); }
                const float mt = bs + fmaxf(mprev, pm);
                vec[V_RT + lane] = bs - mt; vec[V_CS + lane] = cs; vec[V_WI + lane] = expf(bs + mprev - mt); vec[V_ENM + lane] = expf(-mt);
                const float mnew = shl(mt, 63), b63 = shl(bs, 63);
                vec[V_WK + lane] = expf(b63 + cs - mnew);
                if (lane == 0) vec[V_SC] = expf(b63 + mprev - mnew);
                mprev = mnew;
            }
        }
        __syncthreads();
        {
            u32x4 ktp; unsigned ktw[4];
            if (ROLE == 0) {
                float off = 0.f, tot = 0.f;
#pragma unroll
                for (int w2 = 0; w2 < 8; ++w2) { const float s = vec[V_SEG + w2 * 64 + lane]; tot += s; off += (w2 < w) ? s : 0.f; }
                if (w == 0) vec[V_ELAST + lane] = fexp(tot);
                float kt[8];
#pragma unroll
                for (int i = 0; i < 8; ++i) {
                    const float cum = off + c8[i];
                    Qs[(8 * w + i) * PB + lane] = (bf16_t)f2bf(qf[i] * fexp(cum));
                    Ks[(8 * w + i) * PB + lane] = (bf16_t)f2bf(kf[i] * fexp(-cum));
                    kt[i] = kf[i] * fexp(tot - cum);
                }
#pragma unroll
                for (int i = 0; i < 4; ++i) ktw[i] = pk2(kt[2 * i], kt[2 * i + 1]);
            } else {
                float kt[8];
#pragma unroll
                for (int i = 0; i < 8; ++i) {
                    Qs[(8 * w + i) * PB + lane] = (bf16_t)f2bf(qf[i]);
                    Ks[(8 * w + i) * PB + lane] = (bf16_t)f2bf(kf[i]);
                    kt[i] = kf[i] * vec[V_WK + 8 * w + i];
                }
#pragma unroll
                for (int i = 0; i < 4; ++i) ktw[i] = pk2(kt[2 * i], kt[2 * i + 1]);
            }
            ktp.x = ktw[0]; ktp.y = ktw[1]; ktp.z = ktw[2]; ktp.w = ktw[3];
            *(LAS u32x4*)(KTs + lane * PB + 8 * w) = ktp;
            MX_PIN8(vi, 0); MX_PIN8(vi, 8);
#pragma unroll
            for (int i = 0; i < 16; ++i) vi[i] = (vc_ & 1) ? (vi[i] >> 16) : (vi[i] & 0xffffu);
            u32x4 v0, v1;
            v0.x = vi[0] | ((unsigned)vi[1] << 16); v0.y = vi[2] | ((unsigned)vi[3] << 16); v0.z = vi[4] | ((unsigned)vi[5] << 16); v0.w = vi[6] | ((unsigned)vi[7] << 16);
            v1.x = vi[8] | ((unsigned)vi[9] << 16); v1.y = vi[10] | ((unsigned)vi[11] << 16); v1.z = vi[12] | ((unsigned)vi[13] << 16); v1.w = vi[14] | ((unsigned)vi[15] << 16);
            *(LAS u32x4*)(VTs + vc_ * PB + 16 * rq) = v0; *(LAS u32x4*)(VTs + vc_ * PB + 16 * rq + 8) = v1;
        }
        __syncthreads();
        { const bf16_t* gp = Z + (m0 + et) * ZLD + gcol + 16 * cg; gt0 = *(const u32x4*)gp; gt1 = *(const u32x4*)(gp + 8); }
        if (n < 63) MX_LOAD(m0 + 64, n + 1);
#define MX_FRAG(base, row, ks) (*(const LAS bf16x8*)(lds + (base) + ((row) * PB + 16 * (ks) + 8 * hh) * 2))
        if (w < 3) {
            const int ti = (w >= 1) ? 1 : 0, sj = (w == 2) ? 1 : 0;
            f32x16 sc;
#pragma unroll
            for (int r = 0; r < 16; ++r) sc[r] = 0.f;
#pragma unroll
            for (int ks = 0; ks < 4; ++ks) sc = MX_MFMA(MX_FRAG(L_QS, 32 * ti + r32, ks), MX_FRAG(L_KS, 32 * sj + r32, ks), sc);
            const float csv = (ROLE == 1) ? vec[V_CS + 32 * sj + r32] : 0.f;
#pragma unroll
            for (int r = 0; r < 16; ++r) {
                const int t = crow(r, hh);
                const bool keep = (ti != sj) || (r32 <= t);
                float val = sc[r];
                if (ROLE == 1) val *= expf(vec[V_RT + 32 * ti + t] + csv);
                Ps[(32 * ti + t) * PB + 32 * sj + r32] = (bf16_t)f2bf(keep ? val : 0.f);
            }
        }
        f32x16 acco;
#pragma unroll
        for (int r = 0; r < 16; ++r) acco[r] = 0.f;
#pragma unroll
        for (int ks = 0; ks < 4; ++ks) acco = MX_MFMA(MX_FRAG(L_QS, 32 * wa + r32, ks), MX_FRAG(L_ST, 32 * wv + r32, ks), acco);
        if (ROLE == 1) {
#pragma unroll
            for (int r = 0; r < 16; ++r) acco[r] *= vec[V_WI + 32 * wa + crow(r, hh)];
        }
        if (ROLE == 0) {
#pragma unroll
            for (int r = 0; r < 16; ++r) accS[r] *= vec[V_ELAST + 32 * wa + crow(r, hh)];
        } else {
            const float carry = vec[V_SC];
#pragma unroll
            for (int r = 0; r < 16; ++r) accS[r] *= carry;
        }
#pragma unroll
        for (int ks = 0; ks < 4; ++ks) accS = MX_MFMA(MX_FRAG(L_KT, 32 * wa + r32, ks), MX_FRAG(L_VT, 32 * wv + r32, ks), accS);
        __syncthreads();
        if (wa == 0) {
#pragma unroll
            for (int ks = 0; ks < 2; ++ks) acco = MX_MFMA(MX_FRAG(L_PS, r32, ks), MX_FRAG(L_VT, 32 * wv + r32, ks), acco);
        } else {
#pragma unroll
            for (int ks = 0; ks < 4; ++ks) acco = MX_MFMA(MX_FRAG(L_PS, 32 + r32, ks), MX_FRAG(L_VT, 32 * wv + r32, ks), acco);
        }
#pragma unroll
        for (int r = 0; r < 16; ++r) Os[(32 * wa + crow(r, hh)) * OSP + 32 * wv + r32] = acco[r];
#pragma unroll
        for (int q4 = 0; q4 < 4; ++q4) { u32x2 p; p.x = pk2(accS[4 * q4], accS[4 * q4 + 1]); p.y = pk2(accS[4 * q4 + 2], accS[4 * q4 + 3]);
            *(LAS u32x2*)(STs + (32 * wv + r32) * PB + 32 * wa + 8 * q4 + 4 * hh) = p; }
        if (ROLE == 0) { if (n < 63) { vec[V_GA + et * 16 + 2 * cg] = zs0; vec[V_GA + et * 16 + 2 * cg + 1] = zs1; } }
        else {
            const LAS float* nprev = vec + V_NORM + (n & 1) * 64;
            if (w == 0) {
                float qn = 0.f, si = 0.f;
#pragma unroll
                for (int c8i = 0; c8i < 8; ++c8i) {
                    const u32x4 qv = *(const LAS u32x4*)(Qs + lane * PB + 8 * c8i), pv = *(const LAS u32x4*)(Ps + lane * PB + 8 * c8i);
                    const f32x4 n0 = *(const LAS f32x4*)(nprev + 8 * c8i), n1 = *(const LAS f32x4*)(nprev + 8 * c8i + 4);
                    qn += bflo(qv.x) * n0[0] + bfhi(qv.x) * n0[1] + bflo(qv.y) * n0[2] + bfhi(qv.y) * n0[3] + bflo(qv.z) * n1[0] + bfhi(qv.z) * n1[1] + bflo(qv.w) * n1[2] + bfhi(qv.w) * n1[3];
                    si += (bflo(pv.x) + bfhi(pv.x)) + (bflo(pv.y) + bfhi(pv.y)) + (bflo(pv.z) + bfhi(pv.z)) + (bflo(pv.w) + bfhi(pv.w));
                }
                const float den = vec[V_WI + lane] * qn + si;
                vec[V_DEN + lane] = 1.f / fmaxf(fabsf(den), vec[V_ENM + lane]);
            } else if (w == 1) {
                float kn = 0.f;
#pragma unroll
                for (int c8i = 0; c8i < 8; ++c8i) { const u32x4 kv = *(const LAS u32x4*)(KTs + lane * PB + 8 * c8i);
                    kn += (bflo(kv.x) + bfhi(kv.x)) + (bflo(kv.y) + bfhi(kv.y)) + (bflo(kv.z) + bfhi(kv.z)) + (bflo(kv.w) + bfhi(kv.w)); }
                vec[V_NORM + ((n + 1) & 1) * 64 + lane] = vec[V_SC] * nprev[lane] + kn;
            }
        }
        __syncthreads();
        m0 += 64;
    }
#undef MX_LOAD
#undef MX_PIN8
#undef MX_PIN11
#undef MX_FRAG
}
}

#ifndef PHASE_MASK
#define PHASE_MASK 0xFFFF
#endif
#define PH(k) if constexpr ((PHASE_MASK >> (k)) & 1)
#ifndef PROBE_GEMM_REPS
#define PROBE_GEMM_REPS 1
#endif
#ifndef PROBE_STREAM_REPS
#define PROBE_STREAM_REPS 1
#endif
#define GREP _Pragma("unroll 1") for (int rep_ = 0; rep_ < PROBE_GEMM_REPS; ++rep_)
#define GREP_BAR if (rep_) GRID_BAR();
#define BLK_ENV int blk = blockIdx.x; asm volatile("" : "+s"(blk));
#define PHASE_ENV BLK_ENV int tid = hw_tid(wave_s); asm volatile("" : "+v"(tid)); const int lane = tid & 63, wave = wave_s; int vcu_ = vcu; asm volatile("" : "+s"(vcu_)); const int gw = vcu_ * NWAVES + wave; (void)lane; (void)gw;
__global__ void __launch_bounds__(NWAVES * 64, 2) mega_fwd(Args args) {
    extern __shared__ __attribute__((aligned(16))) unsigned char lds_raw[];
    LAS unsigned char* lds = (LAS unsigned char*)lds_raw;
    const int G = gridDim.x, blk0 = blockIdx.x;
    const int wave_s = __builtin_amdgcn_readfirstlane(threadIdx.x >> 6);
    const int vcu = (G % 8 == 0) ? (blk0 % 8) * (G / 8) + blk0 / 8 : blk0;
    const int NGW = G * NWAVES;
    for (int u = threadIdx.x; u < (LDS_BYTES - LDSCTL_OFF) / 4; u += NWAVES * 64) ((LAS unsigned*)(lds + LDSCTL_OFF))[u] = 0u;
    __syncthreads();
    (void)xcd_barrier_post((unsigned*)(args.ws + WS_CTL) + CW_BAR, (volatile LAS unsigned*)(lds + MISC_OFF) + 8);
#define GRID_BAR() do { XcdBarrier b_; b_.bar = (unsigned*)(inp_ws() + WS_CTL) + CW_BAR; b_.x = xb_xcc_id(); b_.st = (volatile LAS unsigned*)(lds + MISC_OFF) + 8; xcd_barrier(b_, wave_s); } while (0)

    PH(0) { PHASE_ENV
        ada_phase(lds, blk, wave, lane);
        if (blk < 32) s5_generate(0, blk, lds, wave_s);
        LAS float* scr = (LAS float*)(lds + wave * 16384);
        int base = 0;
        convert_matrix<1>(inp(8), INDIM, 1024, ZLD, (bf16_t*)WSP(WS_WIN), scr, lane, gw, NGW, base);
    }
    GRID_BAR();

#pragma unroll 1
    for (int l = 0; l < DEPTH; ++l) {
        PH(1) if (l == 0) { PHASE_ENV
            __syncthreads();
            stage_wsmall(inp(8), (LAS float*)lds, tid);
            norm_rows<false, true, true>(nullptr, 0, inp(0), nullptr, nullptr, 0, nullptr, inp(4), (const float*)WSP(WS_MOD), 0, 1024, (bf16_t*)WSP(WS_H), (float*)WSP(WS_ZS), (const LAS float*)lds, gw, NGW, lane);
            GRID_BAR();
        }
        PH(2) GREP { GREP_BAR BLK_ENV
            pg8::PlainSched S; S.o.init(M, ZLD, G, blk); S.A = (const bf16_t*)WSP(WS_H); S.lda = D; S.Bt = (const bf16_t*)WSP(WS_WIN); S.K = D;
            pg8::EpiStore E{(bf16_t*)WSP(WS_Z), ZLD};
            pg8::gemm_phase<pg8::EpiStore, pg8::PlainSched, true, true>(lds, wave_s, D, D, S, E);
        }
        GRID_BAR();
        PH(11) GREP { GREP_BAR BLK_ENV
            pg8::S5aSched S; S.G = G; S.c = blk; S.Zb = (const bf16_t*)WSP(WS_Z); S.Bt1 = (const bf16_t*)WSP(WS_S5M1);
            pg8::EpiS5a E{(float*)WSP(WS_EX), (bf16_t*)WSP(WS_YP)};
            pg8::gemm_phase<pg8::EpiS5a, pg8::S5aSched, true, true, 1>(lds, wave_s, 0, 256, S, E);
        }
        GRID_BAR();
        PH(3) { PHASE_ENV
#if PROBE_STREAM_REPS > 1
            for (int rep_ = 1; rep_ < PROBE_STREAM_REPS; ++rep_) { if (blk < 32) mx::stream<0, false>(l, lds, blk, wave_s); else if (blk < 64) mx::stream<1, false>(l, lds, blk - 32, wave_s); __syncthreads(); }
#endif
            if (blk < 32) mx::stream<0>(l, lds, blk, wave_s);
            else if (blk < 64) mx::stream<1>(l, lds, blk - 32, wave_s);
            else if (blk < 192) { if (wave < 2) s5_scan(l, (blk - 64) * 2 + wave, lane); }
            else if (G > 192) {
                int base = 0; const int gw2 = (blk - 192) * NWAVES + wave, NGW2 = (G - 192) * NWAVES;
                LAS float* scr = (LAS float*)(lds + wave * 16384);
                convert_matrix<0>(inp(24) + (size_t)l * 512 * 512, 512, 512, 512, (bf16_t*)WSP(WS_WGLU), scr, lane, gw2, NGW2, base);
                convert_matrix<0>(inp(26) + (size_t)l * 512 * 1024, 1024, 512, 1024, (bf16_t*)WSP(WS_WPROJ), scr, lane, gw2, NGW2, base);
                convert_matrix<0>(inp(27) + (size_t)l * 512 * 1024, 1024, 512, 1024, (bf16_t*)WSP(WS_WPROJ) + 1024 * 512, scr, lane, gw2, NGW2, base);
                convert_matrix<0>(inp(28) + (size_t)l * 512 * 1024, 1024, 512, 1024, (bf16_t*)WSP(WS_WPROJ) + 2 * 1024 * 512, scr, lane, gw2, NGW2, base);
                convert_matrix<0>(inp(30) + (size_t)l * D * D, 1024, 1024, 1024, (bf16_t*)WSP(WS_WOUT), scr, lane, gw2, NGW2, base);
                convert_matrix<0>(inp(32) + (size_t)l * FF * D, 1024, FF, 1024, (bf16_t*)WSP(WS_WFO), scr, lane, gw2, NGW2, base);
            }
        }
        GRID_BAR();
        PH(12) { BLK_ENV
            pg8::S5bSched S; S.G = G; S.c = blk; S.X = (const bf16_t*)WSP(WS_EX); S.Bt3 = (const bf16_t*)WSP(WS_S5M3);
            pg8::EpiS5b E{(const bf16_t*)WSP(WS_YP), (bf16_t*)WSP(WS_Z), inp(23) + l * 512};
            pg8::gemm_phase<pg8::EpiS5b, pg8::S5bSched, true, true>(lds, wave_s, 256, 256, S, E);
        }
        GRID_BAR();
        PH(4) GREP { GREP_BAR BLK_ENV
            bf16_t* Z = (bf16_t*)WSP(WS_Z);
            pg8::PlainSched S; S.o.init(M, 512, G, blk); S.A = Z + SU; S.lda = ZLD; S.Bt = (const bf16_t*)WSP(WS_WGLU); S.K = 512;
            pg8::EpiGlu E{Z + YS2, ZLD, Z + SU, ZLD, inp(25) + l * 512};
            pg8::gemm_phase<pg8::EpiGlu, pg8::PlainSched, true, true>(lds, wave_s, ZLD, 512, S, E);
        }
        GRID_BAR();
        PH(5) GREP { GREP_BAR BLK_ENV
            bf16_t* Z = (bf16_t*)WSP(WS_Z);
            pg8::MergeSched S; S.o.init(M, 1024, G, blk); S.Zb = Z; S.Wp = (const bf16_t*)WSP(WS_WPROJ);
            pg8::EpiMerge E{Z + MRG, ZLD, Z + ZG, ZLD, inp(29) + l * 3072};
            pg8::gemm_phase<pg8::EpiMerge, pg8::MergeSched, true, true>(lds, wave_s, ZLD, 512, S, E);
        }
        GRID_BAR();
        PH(6) GREP { GREP_BAR BLK_ENV
            pg8::PlainSched S; S.o.init(M, 1024, G, blk); S.A = (const bf16_t*)WSP(WS_Z) + MRG; S.lda = ZLD; S.Bt = (const bf16_t*)WSP(WS_WOUT); S.K = 1024;
            pg8::EpiStore E{(bf16_t*)WSP(WS_H), D};
            pg8::gemm_phase<pg8::EpiStore, pg8::PlainSched, true, true>(lds, wave_s, ZLD, 1024, S, E);
        }
        GRID_BAR();
        PH(7) { PHASE_ENV
            const float* modl = (const float*)WSP(WS_MOD) + (size_t)l * 8 * 6144;
            { int base = 0; convert_matrix<2>(inp(31) + (size_t)l * D * 2 * FF, 2 * FF, 1024, 2 * FF, (bf16_t*)WSP(WS_WFI), (LAS float*)(lds + wave * 16384), lane, gw, NGW, base); }
            norm_rows<true, true, false>((const bf16_t*)WSP(WS_H), D, (l == 0) ? inp(0) : (const float*)inp_out(), inp(5) + l * D, modl, 2048, inp_out(), inp(6) + l * D, modl, 3072, 4096,
                                      (bf16_t*)WSP(WS_H), nullptr, nullptr, gw, NGW, lane);
        }
        GRID_BAR();
        PH(8) GREP { GREP_BAR BLK_ENV
            pg8::PlainSched S; S.o.init(M, 2 * FF, G, blk); S.A = (const bf16_t*)WSP(WS_H); S.lda = D; S.Bt = (const bf16_t*)WSP(WS_WFI); S.K = D;
            pg8::EpiSwiGlu E{(bf16_t*)WSP(WS_Z), FF};
            pg8::gemm_phase<pg8::EpiSwiGlu, pg8::PlainSched, true, true>(lds, wave_s, D, D, S, E);
        }
        GRID_BAR();
        PH(9) GREP { GREP_BAR BLK_ENV
            pg8::PlainSched S; S.o.init(M, 1024, G, blk); S.A = (const bf16_t*)WSP(WS_Z); S.lda = FF; S.Bt = (const bf16_t*)WSP(WS_WFO); S.K = FF;
            pg8::EpiStore E{(bf16_t*)WSP(WS_H), D};
            pg8::gemm_phase<pg8::EpiStore, pg8::PlainSched, true, true>(lds, wave_s, FF, FF, S, E);
        }
        GRID_BAR();
        PH(10) { PHASE_ENV
            const float* modl = (const float*)WSP(WS_MOD) + (size_t)l * 8 * 6144;
            if (l + 1 < DEPTH) {
                const int l1 = l + 1;
                LAS float* scr = (LAS float*)(lds + wave * 16384);
                int base = 0;
                if (blk < 32) s5_generate(l1, blk, lds, wave_s);
                convert_matrix<1>(inp(8) + (size_t)l1 * D * INDIM, INDIM, 1024, ZLD, (bf16_t*)WSP(WS_WIN), scr, lane, gw, NGW, base);
                __syncthreads();
                stage_wsmall(inp(8) + (size_t)l1 * D * INDIM, (LAS float*)lds, tid);
                norm_rows<true, true, true>((const bf16_t*)WSP(WS_H), D, (const float*)inp_out(), inp(7) + l * D, modl, 5120, inp_out(), inp(4) + l1 * D, modl + 8 * 6144, 0, 1024,
                                         (bf16_t*)WSP(WS_H), (float*)WSP(WS_ZS), (const LAS float*)lds, gw, NGW, lane);
                GRID_BAR();
            } else {
                norm_rows<true, false, false>((const bf16_t*)WSP(WS_H), D, (const float*)inp_out(), inp(7) + l * D, modl, 5120, inp_out(), nullptr, nullptr, 0, 0, nullptr, nullptr, nullptr, gw, NGW, lane);
            }
        }
    }
}

extern "C" void kernel_launch(void* const* d_in, const int* in_sizes, int n_in, void* d_out, int out_size, void* d_ws, size_t ws_size, hipStream_t stream) {
    static int grid = 0;
    if (grid == 0) {
        if (n_in != 33 || ws_size < WS_END || out_size != M * D) { fprintf(stderr, "kernel_launch: unexpected n_in %d / ws %zu / out %d\n", n_in, ws_size, out_size); grid = -1; return; }
        int dev = 0, cus = 0, per_cu = 0;
        if (hipGetDevice(&dev) != hipSuccess || hipDeviceGetAttribute(&cus, hipDeviceAttributeMultiprocessorCount, dev) != hipSuccess) { grid = -1; return; }
        if (hipFuncSetAttribute((const void*)mega_fwd, hipFuncAttributeMaxDynamicSharedMemorySize, LDS_BYTES) != hipSuccess) { fprintf(stderr, "kernel_launch: hipFuncSetAttribute failed\n"); grid = -1; return; }
        if (hipOccupancyMaxActiveBlocksPerMultiprocessor(&per_cu, (const void*)mega_fwd, NWAVES * 64, LDS_BYTES) != hipSuccess || per_cu < 1) { fprintf(stderr, "kernel_launch: occupancy query says %d blocks/CU\n", per_cu); grid = -1; return; }
        (void)hipGetLastError();
        grid = cus;
    }
    if (grid < 0) return;
    (void)hipMemsetAsync((char*)d_ws + WS_CTL, 0, CTL_ZERO_BYTES, stream);
    Args a{};
    for (int i = 0; i < 33; ++i) a.in[i] = (const float*)d_in[i];
    a.out = (float*)d_out; a.ws = (unsigned char*)d_ws;
    hipLaunchKernelGGL(mega_fwd, dim3(grid), dim3(NWAVES * 64), LDS_BYTES, stream, a);
}
```

```cpp
#include <hip/hip_runtime.h>
#include <cstdint>
#include <cstdio>

#define LAS __attribute__((address_space(3)))
#define GAS __attribute__((address_space(1)))
typedef unsigned short bf16_t;
typedef short bf16x8 __attribute__((ext_vector_type(8)));
typedef float f32x4 __attribute__((ext_vector_type(4)));
typedef float f32x2 __attribute__((ext_vector_type(2)));
typedef unsigned u32x4 __attribute__((ext_vector_type(4)));
typedef unsigned u32x2 __attribute__((ext_vector_type(2)));

constexpr int NB = 8, T = 4096, D = 1024, M = NB * T, DEPTH = 2;
constexpr int INDIM = 6680, ZLD = 6656, FF = 2816;
constexpr int GQ = 0, GK = 256, GV = 512, GR = 1024, MQ = 1536, MK = 1792, MV = 2048, MO = 2560, SU = 3072, ZG = 3584;
constexpr int YGLA = GR;
constexpr int YML = MO;
constexpr int YS2 = 0;
constexpr int MRG = 1536;
constexpr size_t MiB = 1u << 20;
constexpr size_t WS_CTL = 0, CTL_ZERO_BYTES = 64 * 1024;
constexpr size_t WS_MOD = 512 * 1024;
constexpr size_t WS_ZS = 1 * MiB;
constexpr size_t WS_WIN = 5 * MiB;
constexpr size_t WS_WGLU = 5 * MiB;
constexpr size_t WS_WPROJ = 5 * MiB + 512 * 1024;
constexpr size_t WS_WOUT = 8 * MiB + 512 * 1024;
constexpr size_t WS_WFO = 10 * MiB + 512 * 1024;
constexpr size_t WS_S5M1 = 18 * MiB;
constexpr size_t WS_S5M3 = 24 * MiB;
constexpr size_t WS_WSM = 29 * MiB;
constexpr size_t WS_WFI = 18 * MiB;
constexpr size_t WS_EX = 32 * MiB;
constexpr size_t WS_YP = 64 * MiB;
constexpr size_t WS_H = 32 * MiB;
constexpr size_t WS_Z = 96 * MiB;
constexpr size_t WS_END = 512 * MiB;
constexpr int CW_BAR = 4096;

constexpr int RING_BYTES = 131072, LDSCTL_OFF = RING_BYTES, MISC_OFF = LDSCTL_OFF + 320, LDS_BYTES = 147456;
constexpr int NWAVES = 8;

__device__ __forceinline__ float bf2f(bf16_t v) { return __uint_as_float(((unsigned)v) << 16); }
__device__ __forceinline__ unsigned f2bf(float f) { unsigned u = __float_as_uint(f); return (u + 0x7fffu + ((u >> 16) & 1u)) >> 16; }
__device__ __forceinline__ unsigned pk2(float lo, float hi) { return f2bf(lo) | (f2bf(hi) << 16); }
__device__ __forceinline__ float bflo(unsigned u) { return __uint_as_float(u << 16); }
__device__ __forceinline__ float bfhi(unsigned u) { return __uint_as_float(u & 0xffff0000u); }
__device__ __forceinline__ int hw_lane() { int l; asm volatile("v_mbcnt_lo_u32_b32 %0, -1, 0\n\tv_mbcnt_hi_u32_b32 %0, -1, %0" : "=v"(l)); return l; }
__device__ __forceinline__ int hw_tid(int wv) { return wv * 64 + hw_lane(); }
__device__ __forceinline__ float shl(float v, int src) { return __int_as_float(__builtin_amdgcn_ds_bpermute(src << 2, __float_as_int(v))); }
__device__ __forceinline__ float wave_sum(float v, int lane) {
#pragma unroll
    for (int o = 1; o < 64; o <<= 1) v += shl(v, lane ^ o);
    return v;
}
__device__ __forceinline__ float sigmoidf_(float x) { return 1.f / (1.f + expf(-x)); }
__device__ __forceinline__ float siluf_(float x) { return x / (1.f + expf(-x)); }
__device__ __forceinline__ float logsigmoidf_(float x) { return fminf(x, 0.f) - log1pf(expf(-fabsf(x))); }
__device__ __forceinline__ float gelu_tanh(float y) { return 0.5f * y * (1.f + tanhf(0.7978845608028654f * (y + 0.044715f * y * y * y))); }
__device__ __forceinline__ float fexp_neg(float x) { return __builtin_amdgcn_exp2f(-1.4426950408889634f * x); }
__device__ __forceinline__ float fsigmoid(float x) { return __builtin_amdgcn_rcpf(1.f + fexp_neg(x)); }
#define LDS_WAIT() asm volatile("s_waitcnt lgkmcnt(0)" ::: "memory")
#define VM_WAIT() asm volatile("s_waitcnt vmcnt(0)" ::: "memory")

namespace pg8 {
constexpr int BM = 256, BK = 64, HALF = 128, HTB = HALF * BK * 2, STAGE_BYTES = 8 * HTB, NXCD = 8, WGM = 8;
__host__ __device__ __forceinline__ int lds_byte(int r, int c) { const int st = (r >> 4) * 2 + (c >> 5), rr = r & 15, cc = c & 31, ob = rr * 64 + cc * 2; return st * 1024 + (ob ^ (((ob >> 9) & 1) << 5)); }
__host__ __device__ __forceinline__ void stage_rc(int b, int& R, int& C) { const int st = b / 1024, sb = b % 1024, swz = sb ^ (((sb >> 9) & 1) << 5); R = (st >> 1) * 16 + swz / 64; C = (st & 1) * 32 + (swz % 64) / 2; }
__host__ __device__ __forceinline__ int perm32(int rho) { const int n = rho >> 4, i = rho & 15; return 8 * (i >> 2) + 4 * n + (i & 3); }

struct Unit { int pm, pn, br; };
struct TileOrder {
    int nM, nN, nwg, G, c;
    __device__ void init(int M_, int N_, int G_, int c_) { nM = M_ / BM; nN = N_ / BM; nwg = nM * nN; G = G_; c = c_; }
    __device__ bool tile(int i, int& pm, int& pn) const {
        const long L = (long)i * G + c; if (L >= nwg) return false;
        int wgid = (int)L; { const int q = nwg / NXCD, r = nwg % NXCD, xcd = wgid % NXCD, off = wgid / NXCD; wgid = (xcd < r ? xcd * (q + 1) : r * (q + 1) + (xcd - r) * q) + off; }
        const int nig = WGM * nN, gid = wgid / nig, fm = gid * WGM, gsz = (nM - fm) < WGM ? (nM - fm) : WGM;
        pm = fm + ((wgid % nig) % gsz); pn = (wgid % nig) / gsz; return true;
    }
};
struct PlainSched {
    TileOrder o; const bf16_t* A; int lda; const bf16_t* Bt; int K;
    __device__ bool next(int i, Unit& u) const { u.br = 0; return o.tile(i, u.pm, u.pn); }
    __device__ const char* Ap(const Unit& u) const { return (const char*)(A + (size_t)u.pm * BM * lda); }
    __device__ const char* Bp(const Unit& u) const { return (const char*)(Bt + (size_t)u.pn * BM * K); }
};
struct MergeSched {
    TileOrder o; const bf16_t* Zb; const bf16_t* Wp;
    __device__ bool next(int i, Unit& u) const { u.br = i % 3; return o.tile(i / 3, u.pm, u.pn); }
    __device__ const char* Ap(const Unit& u) const { const int col = u.br == 0 ? YGLA : (u.br == 1 ? YML : YS2); return (const char*)(Zb + (size_t)u.pm * BM * ZLD + col); }
    __device__ const char* Bp(const Unit& u) const { return (const char*)(Wp + (size_t)u.br * 1024 * 512 + (size_t)u.pn * BM * 512); }
};

__device__ __forceinline__ unsigned cvt_pk_bf16(float lo, float hi) { unsigned r; asm volatile("v_cvt_pk_bf16_f32 %0, %1, %2" : "=v"(r) : "v"(lo), "v"(hi)); return r; }

struct EpiStore {
    static constexpr bool PERM = true;
    bf16_t* O; int ldc;
    __device__ __forceinline__ bool keep(const Unit&) const { return false; }
    __device__ __forceinline__ void operator()(f32x4 (&acc)[2][2][4][2], const Unit& u, int wr, int wc, int fr, int fq) const {
        const int row0 = u.pm * BM + wr * 64 + fr, col0 = u.pn * BM + wc * 32 + 8 * fq;
#pragma unroll
        for (int ai = 0; ai < 2; ++ai)
#pragma unroll
            for (int m = 0; m < 4; ++m) { bf16_t* rowp = O + (size_t)(row0 + ai * HALF + m * 16) * ldc + col0;
#pragma unroll
                for (int bj = 0; bj < 2; ++bj) { const f32x4 v0 = acc[ai][bj][m][0], v1 = acc[ai][bj][m][1];
                    u32x4 w; w.x = cvt_pk_bf16(v0[0], v0[1]); w.y = cvt_pk_bf16(v0[2], v0[3]); w.z = cvt_pk_bf16(v1[0], v1[1]); w.w = cvt_pk_bf16(v1[2], v1[3]);
                    *(u32x4*)(rowp + bj * HALF) = w; } }
    }
};
struct EpiGlu {
    static constexpr bool PERM = true;
    bf16_t* O; int ldc; const bf16_t* Asrc; int lda; const float* bias;
    __device__ __forceinline__ bool keep(const Unit&) const { return false; }
    __device__ __forceinline__ void operator()(f32x4 (&acc)[2][2][4][2], const Unit& u, int wr, int wc, int fr, int fq) const {
        const int row0 = u.pm * BM + wr * 64 + fr, col0 = u.pn * BM + wc * 32 + 8 * fq;
        f32x4 bv[2][2];
#pragma unroll
        for (int bj = 0; bj < 2; ++bj)
#pragma unroll
            for (int n = 0; n < 2; ++n) bv[bj][n] = *(const f32x4*)(bias + col0 + bj * HALF + 4 * n);
#pragma unroll
        for (int ai = 0; ai < 2; ++ai)
#pragma unroll
            for (int m = 0; m < 4; ++m) { const size_t r = (size_t)(row0 + ai * HALF + m * 16);
#pragma unroll
                for (int bj = 0; bj < 2; ++bj) {
                    const u32x4 a = *(const u32x4*)(Asrc + r * lda + col0 + bj * HALF);
                    const f32x4 v0 = acc[ai][bj][m][0] + bv[bj][0], v1 = acc[ai][bj][m][1] + bv[bj][1];
                    u32x4 w;
                    w.x = cvt_pk_bf16(bflo(a.x) * fsigmoid(v0[0]), bfhi(a.x) * fsigmoid(v0[1])); w.y = cvt_pk_bf16(bflo(a.y) * fsigmoid(v0[2]), bfhi(a.y) * fsigmoid(v0[3]));
                    w.z = cvt_pk_bf16(bflo(a.z) * fsigmoid(v1[0]), bfhi(a.z) * fsigmoid(v1[1])); w.w = cvt_pk_bf16(bflo(a.w) * fsigmoid(v1[2]), bfhi(a.w) * fsigmoid(v1[3]));
                    *(u32x4*)(O + r * ldc + col0 + bj * HALF) = w; } }
    }
};
struct EpiSwiGlu {
    static constexpr bool PERM = true;
    bf16_t* O; int ldc;
    __device__ __forceinline__ bool keep(const Unit&) const { return false; }
    __device__ __forceinline__ void operator()(f32x4 (&acc)[2][2][4][2], const Unit& u, int wr, int wc, int fr, int fq) const {
        const int row0 = u.pm * BM + wr * 64 + fr, col0 = u.pn * HALF + wc * 32 + 8 * fq;
#pragma unroll
        for (int ai = 0; ai < 2; ++ai)
#pragma unroll
            for (int m = 0; m < 4; ++m) {
                float o[8];
#pragma unroll
                for (int n = 0; n < 2; ++n)
#pragma unroll
                    for (int e = 0; e < 4; ++e) { const float g = acc[ai][0][m][n][e], up = acc[ai][1][m][n][e]; o[n * 4 + e] = g * fsigmoid(g) * up; }
                u32x4 w; w.x = cvt_pk_bf16(o[0], o[1]); w.y = cvt_pk_bf16(o[2], o[3]); w.z = cvt_pk_bf16(o[4], o[5]); w.w = cvt_pk_bf16(o[6], o[7]);
                *(u32x4*)(O + (size_t)(row0 + ai * HALF + m * 16) * ldc + col0) = w; }
    }
};
struct EpiMerge {
    static constexpr bool PERM = true;
    bf16_t* O; int ldc; const bf16_t* Zg; int ldz; const float* bgb;
    __device__ __forceinline__ bool keep(const Unit& u) const { return u.br < 2; }
    __device__ __forceinline__ float e_of(float x) const { return fminf(fexp_neg(x), 1e30f); }
    __device__ __forceinline__ void operator()(f32x4 (&acc)[2][2][4][2], const Unit& u, int wr, int wc, int fr, int fq) const {
        const int row0 = u.pm * BM + wr * 64 + fr, col0 = u.pn * BM + wc * 32 + 8 * fq;
        const int br = u.br, brn = br < 2 ? br + 1 : 2;
#pragma unroll
        for (int bj = 0; bj < 2; ++bj) {
            float ba[8], bb[8];
#pragma unroll
            for (int e = 0; e < 8; ++e) { ba[e] = bgb[br * 1024 + col0 + bj * HALF + e]; bb[e] = bgb[brn * 1024 + col0 + bj * HALF + e]; }
#pragma unroll
            for (int ai = 0; ai < 2; ++ai)
#pragma unroll
                for (int m = 0; m < 4; ++m) { const size_t r = (size_t)(row0 + ai * HALF + m * 16);
                    const u32x4 za = *(const u32x4*)(Zg + r * ldz + br * 1024 + col0 + bj * HALF);
                    const u32x4 zb = *(const u32x4*)(Zg + r * ldz + brn * 1024 + col0 + bj * HALF);
                    const float xa[8] = {bflo(za.x), bfhi(za.x), bflo(za.y), bfhi(za.y), bflo(za.z), bfhi(za.z), bflo(za.w), bfhi(za.w)};
                    const float xb[8] = {bflo(zb.x), bfhi(zb.x), bflo(zb.y), bfhi(zb.y), bflo(zb.z), bfhi(zb.z), bflo(zb.w), bfhi(zb.w)};
                    float f[8];
#pragma unroll
                    for (int e = 0; e < 8; ++e) { const float ga = __builtin_amdgcn_rcpf(1.f + e_of(xa[e] + ba[e]));
                        f[e] = br < 2 ? ga * (1.f + e_of(xb[e] + bb[e])) : ga; }
                    f32x4 v0 = acc[ai][bj][m][0], v1 = acc[ai][bj][m][1];
                    v0[0] *= f[0]; v0[1] *= f[1]; v0[2] *= f[2]; v0[3] *= f[3]; v1[0] *= f[4]; v1[1] *= f[5]; v1[2] *= f[6]; v1[3] *= f[7];
                    if (br < 2) { acc[ai][bj][m][0] = v0; acc[ai][bj][m][1] = v1; }
                    else { u32x4 w; w.x = cvt_pk_bf16(v0[0], v0[1]); w.y = cvt_pk_bf16(v0[2], v0[3]); w.z = cvt_pk_bf16(v1[0], v1[1]); w.w = cvt_pk_bf16(v1[2], v1[3]);
                        *(u32x4*)(O + r * ldc + col0 + bj * HALF) = w; } }
        }
    }
};


struct S5aSched {
    int G, c; const bf16_t* Zb; const bf16_t* Bt1;
    __device__ bool next(int i, Unit& u) const { const int L = i * G + c; if (L >= 512) return false; u.br = L >> 4; u.pm = (L & 15) >> 1; u.pn = L & 1; return true; }
    __device__ const char* Ap(const Unit& u) const { return (const char*)(Zb + (size_t)u.pm * T * ZLD + SU + 16 * u.br); }
    __device__ const char* Bp(const Unit& u) const { return (const char*)(Bt1 + ((size_t)u.br * 384 + (size_t)u.pn * 256) * 256); }
};
struct EpiS5a {
    static constexpr bool PERM = true;
    float* EX; bf16_t* YP;
    __device__ __forceinline__ bool keep(const Unit&) const { return false; }
    __device__ __forceinline__ void operator()(f32x4 (&acc)[2][2][4][2], const Unit& u, int wr, int wc, int fr, int fq) const {
        const int rowbase = u.br * 2048 + u.pm * 256 + wr * 64 + fr, colsub = wc * 32 + 8 * fq;
#pragma unroll
        for (int ai = 0; ai < 2; ++ai)
#pragma unroll
            for (int m = 0; m < 4; ++m) { const size_t R = (size_t)(rowbase + ai * HALF + m * 16);
                if (u.pn == 0) {
                    *(f32x4*)(EX + R * 128 + colsub) = acc[ai][0][m][0]; *(f32x4*)(EX + R * 128 + colsub + 4) = acc[ai][0][m][1];
                    const f32x4 v0 = acc[ai][1][m][0], v1 = acc[ai][1][m][1];
                    u32x4 w; w.x = cvt_pk_bf16(v0[0], v0[1]); w.y = cvt_pk_bf16(v0[2], v0[3]); w.z = cvt_pk_bf16(v1[0], v1[1]); w.w = cvt_pk_bf16(v1[2], v1[3]);
                    *(u32x4*)(YP + R * 256 + colsub) = w;
                } else {
                    const f32x4 v0 = acc[ai][0][m][0], v1 = acc[ai][0][m][1];
                    u32x4 w; w.x = cvt_pk_bf16(v0[0], v0[1]); w.y = cvt_pk_bf16(v0[2], v0[3]); w.z = cvt_pk_bf16(v1[0], v1[1]); w.w = cvt_pk_bf16(v1[2], v1[3]);
                    *(u32x4*)(YP + R * 256 + 128 + colsub) = w;
                } }
    }
};
struct S5bSched {
    int G, c; const bf16_t* X; const bf16_t* Bt3;
    __device__ bool next(int i, Unit& u) const { const int L = i * G + c; if (L >= 256) return false; u.br = L >> 3; u.pm = L & 7; u.pn = 0; return true; }
    __device__ const char* Ap(const Unit& u) const { return (const char*)(X + (size_t)(u.br * 2048 + u.pm * 256) * 256); }
    __device__ const char* Bp(const Unit& u) const { return (const char*)(Bt3 + (size_t)u.br * 256 * 256); }
};
struct EpiS5b {
    static constexpr bool PERM = true;
    const bf16_t* YP; bf16_t* Zb; const float* dsk;
    __device__ __forceinline__ bool keep(const Unit&) const { return false; }
    __device__ __forceinline__ void operator()(f32x4 (&acc)[2][2][4][2], const Unit& u, int wr, int wc, int fr, int fq) const {
        const int g = u.br, b = u.pm;
#pragma unroll
        for (int bj = 0; bj < 2; ++bj) {
            const int j0 = bj * HALF + wc * 32 + 8 * fq, s = j0 >> 4, c0 = j0 & 15;
            const f32x4 d0 = *(const f32x4*)(dsk + 16 * g + c0), d1 = *(const f32x4*)(dsk + 16 * g + c0 + 4);
#pragma unroll
            for (int ai = 0; ai < 2; ++ai)
#pragma unroll
                for (int m = 0; m < 4; ++m) {
                    const int n = ai * HALF + wr * 64 + m * 16 + fr;
                    const size_t R = (size_t)(g * 2048 + b * 256 + n);
                    const u32x4 yp = *(const u32x4*)(YP + R * 256 + j0);
                    bf16_t* zp = Zb + ((size_t)b * T + 16 * n + s) * ZLD + SU + 16 * g + c0;
                    const u32x4 uu = *(const u32x4*)zp;
                    const f32x4 a0 = acc[ai][bj][m][0], a1 = acc[ai][bj][m][1];
                    float y[8];
                    y[0] = a0[0] + bflo(yp.x) + d0[0] * bflo(uu.x); y[1] = a0[1] + bfhi(yp.x) + d0[1] * bfhi(uu.x);
                    y[2] = a0[2] + bflo(yp.y) + d0[2] * bflo(uu.y); y[3] = a0[3] + bfhi(yp.y) + d0[3] * bfhi(uu.y);
                    y[4] = a1[0] + bflo(yp.z) + d1[0] * bflo(uu.z); y[5] = a1[1] + bfhi(yp.z) + d1[1] * bfhi(uu.z);
                    y[6] = a1[2] + bflo(yp.w) + d1[2] * bflo(uu.w); y[7] = a1[3] + bfhi(yp.w) + d1[3] * bfhi(uu.w);
#pragma unroll
                    for (int e = 0; e < 8; ++e) { const float v = y[e]; y[e] = v * fsigmoid(1.5957691216057308f * (v + 0.044715f * v * v * v)); }
                    u32x4 w; w.x = cvt_pk_bf16(y[0], y[1]); w.y = cvt_pk_bf16(y[2], y[3]); w.z = cvt_pk_bf16(y[4], y[5]); w.w = cvt_pk_bf16(y[6], y[7]);
                    *(u32x4*)zp = w;
                    if (m & 1) asm volatile("" ::: "memory");
                }
        }
    }
};

template <class Epi, class Sched, bool ALIGN_EPI, bool SP2, int AMODE = 0>
__device__ __forceinline__ void gemm_phase(LAS unsigned char* lds, const int wv, const int lda, const int K, const Sched& S, const Epi& E) {
    int tid_ = hw_tid(wv); asm volatile("" : "+v"(tid_));
    const int tid = tid_, wid = __builtin_amdgcn_readfirstlane(tid >> 6), lane = tid & 63, wr = wid >> 2, wc = wid & 3, fr = lane & 15, fq = lane >> 4;
    const int nt = K / BK;
    unsigned voffA[2], voffB[2];
#pragma unroll
    for (int i = 0; i < 2; ++i) { int R, C; stage_rc(tid * 16 + i * 8192, R, C); const int Rb = Epi::PERM ? ((R & ~31) + perm32(R & 31)) : R;
        voffA[i] = AMODE == 0 ? (unsigned)(R * lda + C) * 2u : (unsigned)((16 * R + (C >> 4)) * ZLD + (C & 15)) * 2u; voffB[i] = (unsigned)(Rb * K + C) * 2u; }
    const size_t kstep = (size_t)(BK * 2);
    const size_t kstepA = AMODE == 0 ? (size_t)(BK * 2) : (size_t)4 * ZLD * 2;
    const size_t hA = AMODE == 0 ? (size_t)HALF * lda * 2 : (size_t)HALF * 16 * ZLD * 2, hB = (size_t)HALF * K * 2;
    const unsigned ldsw = (unsigned)wid * 1024u;
    const int aoff = lds_byte(wr * 64 + fr, fq * 8), boff = lds_byte(wc * 32 + fr, fq * 8);
#define PG8_SA(b, h) (((b) * 2 + (h)) * HTB)
#define PG8_SB(b, h) ((4 + (b) * 2 + (h)) * HTB)
#define PG8_STAGE(bufoff, gbase, voff) do { _Pragma("unroll") for (int _i = 0; _i < 2; ++_i) \
        __builtin_amdgcn_global_load_lds((const unsigned*)((const char*)(gbase) + (voff)[_i]), (LAS unsigned*)(lds + (bufoff) + ldsw + _i * 8192), 16, 0, 0); } while (0)
#define PG8_LDA(dst, b, h) do { _Pragma("unroll") for (int m = 0; m < 4; ++m) _Pragma("unroll") for (int k = 0; k < 2; ++k) dst[m][k] = *(const LAS bf16x8*)(lds + PG8_SA(b, h) + aoff + m * 2048 + k * 1024); } while (0)
#define PG8_LDB(dst, b, h) do { _Pragma("unroll") for (int n = 0; n < 2; ++n) _Pragma("unroll") for (int k = 0; k < 2; ++k) dst[n][k] = *(const LAS bf16x8*)(lds + PG8_SB(b, h) + boff + n * 2048 + k * 1024); } while (0)
#define PG8_MMA(ai, bj, At, Bt) do { __builtin_amdgcn_s_setprio(1); _Pragma("unroll") for (int m = 0; m < 4; ++m) _Pragma("unroll") for (int n = 0; n < 2; ++n) _Pragma("unroll") for (int k = 0; k < 2; ++k) \
        acc[ai][bj][m][n] = __builtin_amdgcn_mfma_f32_16x16x32_bf16(Bt[n][k], At[m][k], acc[ai][bj][m][n], 0, 0, 0); __builtin_amdgcn_s_setprio(0); } while (0)
#define PG8_WAIT_V(n) asm volatile("s_waitcnt vmcnt(" #n ")" ::: "memory")
#define PG8_WAIT_L(n) asm volatile("s_waitcnt lgkmcnt(" #n ")" ::: "memory")
#define PG8_BAR __builtin_amdgcn_s_barrier()
#define PG8_SCHED __builtin_amdgcn_sched_barrier(0)
    Unit cur, nxt; int ui = 0;
    if (!S.next(0, cur)) return;
    f32x4 acc[2][2][4][2];
#pragma unroll
    for (int a = 0; a < 2; ++a)
#pragma unroll
        for (int b = 0; b < 2; ++b)
#pragma unroll
            for (int m = 0; m < 4; ++m)
#pragma unroll
                for (int n = 0; n < 2; ++n) acc[a][b][m][n] = (f32x4){0.f, 0.f, 0.f, 0.f};
    bf16x8 At[4][2], B0[2][2], B1[2][2];
    const char* cA = S.Ap(cur); const char* cB = S.Bp(cur);
    if constexpr (SP2) {
        PG8_STAGE(PG8_SB(0, 0), cB, voffB); PG8_STAGE(PG8_SB(0, 1), cB + hB, voffB); PG8_STAGE(PG8_SA(0, 0), cA, voffA); PG8_STAGE(PG8_SA(0, 1), cA + hA, voffA);
        if (wr == 1) PG8_BAR;
        PG8_WAIT_V(2); PG8_BAR;
        PG8_STAGE(PG8_SB(1, 0), cB + kstep, voffB); PG8_STAGE(PG8_SA(1, 0), cA + kstepA, voffA); PG8_STAGE(PG8_SB(1, 1), cB + hB + kstep, voffB);
        PG8_WAIT_V(6); PG8_BAR;
    } else {
        PG8_STAGE(PG8_SB(0, 0), cB, voffB); PG8_STAGE(PG8_SA(0, 0), cA, voffA); PG8_STAGE(PG8_SB(0, 1), cB + hB, voffB); PG8_STAGE(PG8_SA(0, 1), cA + hA, voffA);
        if (wr == 1) PG8_BAR;
        PG8_WAIT_V(4); PG8_BAR;
        PG8_STAGE(PG8_SB(1, 0), cB + kstep, voffB); PG8_STAGE(PG8_SA(1, 0), cA + kstepA, voffA); PG8_STAGE(PG8_SB(1, 1), cB + hB + kstep, voffB);
        PG8_WAIT_V(6); PG8_BAR;
    }
    for (;;) {
        const bool has_next = S.next(ui + 1, nxt);
        const char* nA = has_next ? S.Ap(nxt) : cA; const char* nB = has_next ? S.Bp(nxt) : cB;
        for (int t = 0; t < nt; t += 2) {
            const bool last = (t == nt - 2);
            const char* a1 = cA + (size_t)(t + 1) * kstepA;
            const char* a2 = last ? nA : cA + (size_t)(t + 2) * kstepA; const char* b2 = last ? nB : cB + (size_t)(t + 2) * kstep;
            const char* a3 = a2 + kstepA; const char* b3 = b2 + kstep;
            if constexpr (SP2) {
            PG8_LDB(B0, 0, 0); PG8_LDB(B1, 0, 1); PG8_SCHED; PG8_LDA(At, 0, 0); PG8_STAGE(PG8_SA(1, 1), a1 + hA, voffA);
            PG8_WAIT_V(8); PG8_WAIT_L(0); PG8_BAR; PG8_MMA(0, 0, At, B0); PG8_MMA(0, 1, At, B1); PG8_BAR; PG8_SCHED;
            PG8_LDA(At, 0, 1); PG8_STAGE(PG8_SB(0, 0), b2, voffB); PG8_STAGE(PG8_SB(0, 1), b2 + hB, voffB); PG8_STAGE(PG8_SA(0, 0), a2, voffA);
            PG8_WAIT_V(8); PG8_WAIT_L(0); PG8_BAR; PG8_MMA(1, 0, At, B0); PG8_MMA(1, 1, At, B1); PG8_BAR; PG8_SCHED;
            PG8_LDB(B0, 1, 0); PG8_LDB(B1, 1, 1); PG8_SCHED; PG8_LDA(At, 1, 0); PG8_STAGE(PG8_SA(0, 1), a2 + hA, voffA);
            PG8_WAIT_V(8); PG8_WAIT_L(0); PG8_BAR; PG8_MMA(0, 0, At, B0); PG8_MMA(0, 1, At, B1); PG8_BAR; PG8_SCHED;
            PG8_LDA(At, 1, 1); PG8_STAGE(PG8_SB(1, 0), b3, voffB); PG8_STAGE(PG8_SB(1, 1), b3 + hB, voffB); PG8_STAGE(PG8_SA(1, 0), a3, voffA);
            PG8_WAIT_V(8); PG8_WAIT_L(0); PG8_BAR; PG8_MMA(1, 0, At, B0); PG8_MMA(1, 1, At, B1); PG8_BAR; PG8_SCHED;
            } else {
            PG8_LDB(B0, 0, 0); PG8_SCHED; PG8_LDA(At, 0, 0); PG8_STAGE(PG8_SA(1, 1), a1 + hA, voffA);
            PG8_WAIT_L(8); PG8_BAR; PG8_WAIT_L(0); PG8_MMA(0, 0, At, B0); PG8_BAR; PG8_SCHED;
            PG8_LDB(B1, 0, 1); PG8_STAGE(PG8_SB(0, 0), b2, voffB);
            PG8_BAR; PG8_WAIT_L(0); PG8_MMA(0, 1, At, B1); PG8_BAR;
            PG8_LDA(At, 0, 1); PG8_STAGE(PG8_SA(0, 0), a2, voffA);
            PG8_BAR; PG8_WAIT_L(0); PG8_MMA(1, 0, At, B0); PG8_BAR; PG8_SCHED;
            PG8_STAGE(PG8_SB(0, 1), b2 + hB, voffB);
            PG8_WAIT_V(6); PG8_BAR; PG8_MMA(1, 1, At, B1); PG8_BAR;
            PG8_LDB(B0, 1, 0); PG8_SCHED; PG8_LDA(At, 1, 0); PG8_STAGE(PG8_SA(0, 1), a2 + hA, voffA);
            PG8_WAIT_L(8); PG8_BAR; PG8_WAIT_L(0); PG8_MMA(0, 0, At, B0); PG8_BAR; PG8_SCHED;
            PG8_LDB(B1, 1, 1); PG8_STAGE(PG8_SB(1, 0), b3, voffB);
            PG8_BAR; PG8_WAIT_L(0); PG8_MMA(0, 1, At, B1); PG8_BAR;
            PG8_LDA(At, 1, 1); PG8_STAGE(PG8_SA(1, 0), a3, voffA);
            PG8_BAR; PG8_WAIT_L(0); PG8_MMA(1, 0, At, B0); PG8_BAR; PG8_SCHED;
            PG8_STAGE(PG8_SB(1, 1), b3 + hB, voffB);
            PG8_WAIT_V(6); PG8_BAR; PG8_MMA(1, 1, At, B1); PG8_BAR;
            }
        }
        if constexpr (ALIGN_EPI) { if (wr == 0) PG8_BAR; }
        { const int lane_e = hw_lane();
          E(acc, cur, wr, wc, lane_e & 15, lane_e >> 4); }
        if (!has_next) break;
        if (!E.keep(cur)) {
#pragma unroll
        for (int a = 0; a < 2; ++a)
#pragma unroll
            for (int b = 0; b < 2; ++b)
#pragma unroll
                for (int m = 0; m < 4; ++m)
#pragma unroll
                    for (int n = 0; n < 2; ++n) acc[a][b][m][n] = (f32x4){0.f, 0.f, 0.f, 0.f};
        }
        cur = nxt; cA = nA; cB = nB; ++ui;
        if constexpr (ALIGN_EPI) { if (wr == 1) PG8_BAR; }
    }
    PG8_WAIT_V(0);
    if constexpr (!ALIGN_EPI) { if (wr == 0) PG8_BAR; }
    PG8_BAR;
#undef PG8_SA
#undef PG8_SB
#undef PG8_STAGE
#undef PG8_LDA
#undef PG8_LDB
#undef PG8_MMA
#undef PG8_WAIT_V
#undef PG8_WAIT_L
#undef PG8_BAR
#undef PG8_SCHED
}
}

#define XB_TMO      128
#define XB_XCNT(j)  (256  + 64 * (j))
#define XB_XSUB(j)  (1280 + 64 * (j))
#define XB_XGEN(j)  (2304 + 64 * (j))
#define XB_TOP      3328
#define XB_TOPGEN   3392
#define XCD_BAR_WORDS 3456
#define XB_SPIN_CAP (1u << 18)
__device__ __forceinline__ unsigned xb_ld(unsigned* p)              { return __hip_atomic_load(p, __ATOMIC_RELAXED, __HIP_MEMORY_SCOPE_AGENT); }
__device__ __forceinline__ unsigned xb_add(unsigned* p, unsigned v) { return __hip_atomic_fetch_add(p, v, __ATOMIC_RELAXED, __HIP_MEMORY_SCOPE_AGENT); }
__device__ __forceinline__ unsigned xb_xcc_id() { return (unsigned)__builtin_amdgcn_s_getreg((3 << 11) | 20) & 0xFu; }
#define XB_SPIN(cond, bar) do { unsigned _sp = 0; while (cond) { __builtin_amdgcn_s_sleep(1); \
    if ((++_sp & 255u) == 0u) { if (xb_ld(&(bar)[XB_TMO])) break; if (_sp > XB_SPIN_CAP) { atomicAdd(&(bar)[XB_TMO], 1u); break; } } } } while (0)
struct XcdBarrier { unsigned* bar; unsigned x; volatile LAS unsigned* st; };
__device__ __forceinline__ XcdBarrier xcd_barrier_post(unsigned* bar, volatile LAS unsigned* st) {
    XcdBarrier b; b.bar = bar; b.x = xb_xcc_id(); b.st = st;
    if (threadIdx.x == 0) (void)xb_add(&bar[XB_XCNT(b.x)], 1u);
    return b;
}
__device__ __forceinline__ void xcd_barrier_complete(unsigned* bar, unsigned x, unsigned& nloc, unsigned& nx) {
    const unsigned G = gridDim.x * gridDim.y * gridDim.z;
    unsigned sum, cnt, mine, sp = 0u;
    for (;;) {
        sum = 0u; cnt = 0u; mine = 0u;
#pragma unroll
        for (unsigned j = 0; j < 16; ++j) { const unsigned c = xb_ld(&bar[XB_XCNT(j)]); sum += c; cnt += (c > 0u) ? 1u : 0u; mine = (j == x) ? c : mine; }
        if (sum == G) break;
        __builtin_amdgcn_s_sleep(1);
        if ((++sp & 255u) == 0u) { if (xb_ld(&bar[XB_TMO])) break; if (sp > XB_SPIN_CAP) { atomicAdd(&bar[XB_TMO], 1u); break; } }
    }
    nloc = mine > 0u ? mine : 1u; nx = cnt > 0u ? cnt : 1u;
}
__device__ __forceinline__ void xcd_barrier(const XcdBarrier& b, const int wv) {
    asm volatile("s_waitcnt vmcnt(0)" ::: "memory");
    __syncthreads();
    if (wv == 0 && hw_lane() == 0) {
        unsigned* bar = b.bar;
        __builtin_amdgcn_s_waitcnt(0);
        unsigned nloc = b.st[0], nx = b.st[1];
        if (nloc == 0u) { xcd_barrier_complete(bar, b.x, nloc, nx); b.st[0] = nloc; b.st[1] = nx; }
        const unsigned old = xb_add(&bar[XB_XSUB(b.x)], 1u);
        const unsigned gen = old / nloc;
        if (old + 1u == (gen + 1u) * nloc) {
            __builtin_amdgcn_fence(__ATOMIC_RELEASE, "agent");
            asm volatile("s_waitcnt vmcnt(0)" ::: "memory");
            const unsigned og = xb_add(&bar[XB_TOP], 1u);
            const unsigned tg = og / nx;
            if (og + 1u == (tg + 1u) * nx) xb_add(&bar[XB_TOPGEN], 1u);
            else XB_SPIN(xb_ld(&bar[XB_TOPGEN]) == tg, bar);
            __builtin_amdgcn_fence(__ATOMIC_ACQUIRE, "agent");
            xb_add(&bar[XB_XGEN(b.x)], 1u);
            asm volatile("s_waitcnt vmcnt(0)" ::: "memory");
        } else {
            XB_SPIN(xb_ld(&bar[XB_XGEN(b.x)]) == gen, bar);
            __builtin_amdgcn_fence(__ATOMIC_ACQUIRE, "agent");
            asm volatile("s_waitcnt vmcnt(0)" ::: "memory");
        }
    }
    __syncthreads();
}

struct Args { const float* in[33]; float* out; unsigned char* ws; };
__device__ __forceinline__ const float* inp(int i) {
    unsigned off = (unsigned)i * 8u; asm volatile("" : "+s"(off));
    typedef const float* cfp;
    return *(const __attribute__((address_space(4))) cfp*)((const __attribute__((address_space(4))) char*)__builtin_amdgcn_kernarg_segment_ptr() + off);
}

#define WSP(off) (inp_ws() + (off))
__device__ __forceinline__ unsigned char* inp_ws() { return (unsigned char*)inp(34); }
__device__ __forceinline__ float* inp_out() { return (float*)inp(33); }

__device__ __forceinline__ void transpose_item(const float* W, int ldw, int K, bf16_t* WT, int src_n0, int dst_n0, int k0, LAS float* scr, int lane) {
#pragma unroll 8
    for (int i = 0; i < 32; ++i) { const int kk = 2 * i + (lane >> 5); scr[kk * 33 + (lane & 31)] = W[(size_t)(k0 + kk) * ldw + src_n0 + (lane & 31)]; }
    LDS_WAIT(); asm volatile("" ::: "memory");
    const int c = lane & 7;
#pragma unroll
    for (int j = 0; j < 4; ++j) { const int n = (lane >> 3) + 8 * j; const LAS float* s = scr + (8 * c) * 33 + n;
        u32x4 o; o.x = pk2(s[0 * 33], s[1 * 33]); o.y = pk2(s[2 * 33], s[3 * 33]); o.z = pk2(s[4 * 33], s[5 * 33]); o.w = pk2(s[6 * 33], s[7 * 33]);
        *(u32x4*)(WT + (size_t)(dst_n0 + n) * K + k0 + 8 * c) = o; }
    LDS_WAIT(); asm volatile("" ::: "memory");
}
template <int MAP>
__device__ __forceinline__ void convert_matrix(const float* W, int ldw, int K, int Ndst, bf16_t* WT, LAS float* scr, int lane, int gw, int NGW, int& base) {
    const int nblk = Ndst / 32, nitems = (K / 64) * nblk;
    int first = (gw - base % NGW + NGW) % NGW;
    for (int it = first; it < nitems; it += NGW) {
        const int kb = it / nblk, nb = it % nblk, d0 = nb * 32;
        int s0 = d0;
        if (MAP == 1) s0 = d0 + (d0 < 1024 ? 0 : (d0 < 2560 ? 16 : 24));
        if (MAP == 2) { const int pn = d0 >> 8, hh = (d0 & 255) >> 7, r = d0 & 127; s0 = hh * FF + pn * 128 + r; }
        transpose_item(W, ldw, K, WT, s0, d0, kb * 64, scr, lane);
    }
    base += nitems;
}

__device__ __forceinline__ void ada_phase(LAS unsigned char* lds, int blk, int wave, int lane) {
    if (blk >= 192) return;
    const int l = blk / 96, n0 = (blk % 96) * 64;
    const float* c = inp(1); const float* W = inp(2) + (size_t)l * 1024 * 6144; const float* bias = inp(3) + l * 6144;
    LAS float* part = (LAS float*)lds;
    float acc[8] = {0.f, 0.f, 0.f, 0.f, 0.f, 0.f, 0.f, 0.f};
    for (int k = wave * 128; k < wave * 128 + 128; ++k) {
        const float wv = W[(size_t)k * 6144 + n0 + lane];
#pragma unroll
        for (int b = 0; b < 8; ++b) { const float cv = c[b * 1024 + k]; acc[b] += siluf_(cv) * wv; }
    }
#pragma unroll
    for (int b = 0; b < 8; ++b) part[(wave * 8 + b) * 64 + lane] = acc[b];
    __syncthreads();
    {
        const int b = wave; float s = bias[n0 + lane];
#pragma unroll
        for (int w = 0; w < 8; ++w) s += part[(w * 8 + b) * 64 + lane];
        ((float*)WSP(WS_MOD))[(size_t)(l * 8 + b) * 6144 + n0 + lane] = s;
    }
    __syncthreads();
}

template <bool WITH_POST, bool WITH_PRE>
__device__ __forceinline__ void norm_rows(const bf16_t* Y, int ldy, const float* xin, const float* pw, const float* modl_post, int gt_off, float* xout,
                                          const float* w2, const float* modl_pre, int sh_off, int sc_off, bf16_t* H, int gw, int NGW, int lane) {
    f32x4 xc[2][4], xn[2][4]; u32x2 yc[2][4], yn[2][4];
#pragma unroll
    for (int q = 0; q < 2; ++q)
#pragma unroll
        for (int j = 0; j < 4; ++j) { xc[q][j] = *(const f32x4*)(xin + (size_t)(gw + q * NGW) * D + (lane + 64 * j) * 4);
            if (WITH_POST) yc[q][j] = *(const u32x2*)(Y + (size_t)(gw + q * NGW) * ldy + (lane + 64 * j) * 4); else yc[q][j] = (u32x2){0u, 0u}; xn[q][j] = xc[q][j]; yn[q][j] = yc[q][j]; }
    for (int row0 = gw; row0 < M; row0 += 2 * NGW) {
        const int rown = row0 + 2 * NGW;
        if (rown < M) {
#pragma unroll
            for (int q = 0; q < 2; ++q)
#pragma unroll
                for (int j = 0; j < 4; ++j) { xn[q][j] = *(const f32x4*)(xin + (size_t)(rown + q * NGW) * D + (lane + 64 * j) * 4);
                    if (WITH_POST) yn[q][j] = *(const u32x2*)(Y + (size_t)(rown + q * NGW) * ldy + (lane + 64 * j) * 4); }
        }
        f32x4 v[2][4];
        if (WITH_POST) {
            float ss[2] = {0.f, 0.f};
#pragma unroll
            for (int q = 0; q < 2; ++q)
#pragma unroll
                for (int j = 0; j < 4; ++j) { const u32x2 y = yc[q][j];
                    v[q][j] = (f32x4){bflo(y.x), bfhi(y.x), bflo(y.y), bfhi(y.y)}; ss[q] += v[q][j][0] * v[q][j][0] + v[q][j][1] * v[q][j][1] + v[q][j][2] * v[q][j][2] + v[q][j][3] * v[q][j][3]; }
#pragma unroll
            for (int o = 1; o < 64; o <<= 1) { const float t0 = shl(ss[0], lane ^ o), t1 = shl(ss[1], lane ^ o); ss[0] += t0; ss[1] += t1; }
#pragma unroll
            for (int q = 0; q < 2; ++q) {
                const int row = row0 + q * NGW, b = row / T;
                const float r = rsqrtf(ss[q] * (1.f / D) + 1e-6f);
                const float* gt = modl_post + (size_t)b * 6144 + gt_off;
#pragma unroll
                for (int j = 0; j < 4; ++j) {
                    const int col = (lane + 64 * j) * 4;
                    const f32x4 xo = xc[q][j], pwv = *(const f32x4*)(pw + col), gtv = *(const f32x4*)(gt + col);
#pragma unroll
                    for (int e = 0; e < 4; ++e) v[q][j][e] = xo[e] + (1.f + gtv[e]) * (v[q][j][e] * r * pwv[e]);
                    *(f32x4*)(xout + (size_t)row * D + col) = v[q][j];
                }
            }
        } else {
#pragma unroll
            for (int q = 0; q < 2; ++q)
#pragma unroll
                for (int j = 0; j < 4; ++j) v[q][j] = xc[q][j];
        }
        if (WITH_PRE) {
            float ss[2] = {0.f, 0.f};
#pragma unroll
            for (int q = 0; q < 2; ++q)
#pragma unroll
                for (int j = 0; j < 4; ++j) ss[q] += v[q][j][0] * v[q][j][0] + v[q][j][1] * v[q][j][1] + v[q][j][2] * v[q][j][2] + v[q][j][3] * v[q][j][3];
#pragma unroll
            for (int o = 1; o < 64; o <<= 1) { const float t0 = shl(ss[0], lane ^ o), t1 = shl(ss[1], lane ^ o); ss[0] += t0; ss[1] += t1; }
#pragma unroll
            for (int q = 0; q < 2; ++q) {
                const int row = row0 + q * NGW, b = row / T;
                const float r2 = rsqrtf(ss[q] * (1.f / D) + 1e-6f);
                const float* sh = modl_pre + (size_t)b * 6144 + sh_off; const float* sc = modl_pre + (size_t)b * 6144 + sc_off;
#pragma unroll
                for (int j = 0; j < 4; ++j) {
                    const int col = (lane + 64 * j) * 4;
                    const f32x4 wv = *(const f32x4*)(w2 + col), scv = *(const f32x4*)(sc + col), shv = *(const f32x4*)(sh + col);
#pragma unroll
                    for (int e = 0; e < 4; ++e) v[q][j][e] = v[q][j][e] * r2 * wv[e] * (1.f + scv[e]) + shv[e];
                    u32x2 o; o.x = pk2(v[q][j][0], v[q][j][1]); o.y = pk2(v[q][j][2], v[q][j][3]);
                    *(u32x2*)(H + (size_t)row * D + col) = o;
                }
            }
        }
#pragma unroll
        for (int q = 0; q < 2; ++q)
#pragma unroll
            for (int j = 0; j < 4; ++j) { xc[q][j] = xn[q][j]; yc[q][j] = yn[q][j]; }
    }
}
__device__ __forceinline__ void zs_mfma(const bf16_t* H, const bf16_t* Wsm, float* ZS, int task, int lane) {
    typedef float f32x16_ __attribute__((ext_vector_type(16)));
    const int r32 = lane & 31, hh = lane >> 5;
    const bf16_t* ap = H + (size_t)(32 * task + r32) * D + 8 * hh;
    const bf16_t* bp = Wsm + (size_t)r32 * D + 8 * hh;
    f32x16_ acc;
#pragma unroll
    for (int r = 0; r < 16; ++r) acc[r] = 0.f;
#pragma unroll 8
    for (int ks = 0; ks < D / 16; ++ks) acc = __builtin_amdgcn_mfma_f32_32x32x16_bf16(*(const bf16x8*)(ap + 16 * ks), *(const bf16x8*)(bp + 16 * ks), acc, 0, 0, 0);
    if (r32 < 24) {
#pragma unroll
        for (int r = 0; r < 16; ++r) ZS[(size_t)(32 * task + (r & 3) + 8 * (r >> 2) + 4 * hh) * 32 + r32] = acc[r];
    }
}
__device__ __forceinline__ void convert_small(const float* w_in, bf16_t* Wsm, int part, int tid) {
    for (int i = tid; i < 4 * 1024; i += NWAVES * 64) {
        const int c = 4 * part + (i >> 10), k = i & 1023;
        float v = 0.f;
        if (c < 16) v = w_in[(size_t)k * INDIM + 1024 + c]; else if (c < 24) v = w_in[(size_t)k * INDIM + 2576 + (c - 16)];
        Wsm[c * 1024 + k] = (bf16_t)f2bf(v);
    }
}

__device__ __forceinline__ void s5_generate(int l, int g, LAS unsigned char* lds, int wv) {
    int tid = hw_tid(wv); asm volatile("" : "+v"(tid));
    LAS float* ar = (LAS float*)lds;
    LAS float* ai = ar + 17 * 64;
    LAS float* bbr = ai + 17 * 64;
    LAS float* bbi = bbr + 1024;
    LAS float* cr = bbi + 1024;
    LAS float* ci = cr + 1024;
    LAS float* Kt = ci + 1024;
    bf16_t* Bt1 = (bf16_t*)WSP(WS_S5M1) + (size_t)g * 384 * 256;
    bf16_t* Bt3 = (bf16_t*)WSP(WS_S5M3) + (size_t)g * 256 * 256;
    __syncthreads();
    if (tid < 64) {
        const int p = tid;
        const float lre = fminf((inp(16) + l * 2048)[g * 64 + p], -1e-4f), lim = (inp(17) + l * 2048)[g * 64 + p], dt = expf((inp(18) + l * 32)[g]);
        for (int k = 0; k <= 16; ++k) { const float mg = expf((float)k * lre * dt), an = (float)k * lim * dt; ar[k * 64 + p] = mg * cosf(an); ai[k * 64 + p] = mg * sinf(an); }
        const float a1r = ar[64 + p], a1i = ai[64 + p];
        const float inv = 1.f / (lre * lre + lim * lim);
        const float zr_ = ((a1r - 1.f) * lre + a1i * lim) * inv, zi_ = (a1i * lre - (a1r - 1.f) * lim) * inv;
        const float* b_re = inp(19) + (size_t)l * 32768 + (size_t)(g * 64 + p) * 16; const float* b_im = inp(20) + (size_t)l * 32768 + (size_t)(g * 64 + p) * 16;
        for (int c = 0; c < 16; ++c) { const float br = b_re[c], bi = b_im[c]; bbr[p * 16 + c] = zr_ * br - zi_ * bi; bbi[p * 16 + c] = zr_ * bi + zi_ * br; }
    }
    for (int i = tid; i < 1024; i += 512) { cr[i] = (inp(21) + (size_t)l * 32768)[g * 1024 + i]; ci[i] = (inp(22) + (size_t)l * 32768)[g * 1024 + i]; }
    __syncthreads();
    {
        const int cp = tid >> 5, c = (tid >> 1) & 15, ph = tid & 1;
        float acc[16];
#pragma unroll
        for (int t = 0; t < 16; ++t) acc[t] = 0.f;
        for (int pp = 0; pp < 32; ++pp) {
            const int p = 32 * ph + pp;
            const float xr = cr[cp * 64 + p], xi = ci[cp * 64 + p], yr = bbr[p * 16 + c], yi = bbi[p * 16 + c];
            const float cbr = xr * yr - xi * yi, cbi = xr * yi + xi * yr;
#pragma unroll
            for (int t = 0; t < 16; ++t) acc[t] += cbr * ar[t * 64 + p] - cbi * ai[t * 64 + p];
        }
#pragma unroll
        for (int t = 0; t < 16; ++t) { const float o = acc[t] + shl(acc[t], (tid & 63) ^ 1); if (ph == 0) Kt[(t * 16 + cp) * 16 + c] = o; }
    }
    __syncthreads();
    for (int pc = tid; pc < 128 * 32; pc += 512) {
        const int row = pc >> 5, k0 = (pc & 31) * 8, sp = k0 >> 4, c0 = k0 & 15, p = row & 63, e15 = 15 - sp;
        const float xr = ar[e15 * 64 + p], xi = ai[e15 * 64 + p];
        float v[8];
#pragma unroll
        for (int e = 0; e < 8; ++e) { const float yr = bbr[p * 16 + c0 + e], yi = bbi[p * 16 + c0 + e]; v[e] = row < 64 ? (xr * yr - xi * yi) : (xr * yi + xi * yr); }
        u32x4 w; w.x = pk2(v[0], v[1]); w.y = pk2(v[2], v[3]); w.z = pk2(v[4], v[5]); w.w = pk2(v[6], v[7]);
        *(u32x4*)(Bt1 + (size_t)row * 256 + k0) = w;
    }
    for (int pc = tid; pc < 256 * 32; pc += 512) {
        const int j = pc >> 5, k0 = (pc & 31) * 8, s = j >> 4, cp = j & 15, sp = k0 >> 4, c0 = k0 & 15;
        float v[8];
#pragma unroll
        for (int e = 0; e < 8; ++e) v[e] = (sp <= s) ? Kt[((s - sp) * 16 + cp) * 16 + c0 + e] : 0.f;
        u32x4 w; w.x = pk2(v[0], v[1]); w.y = pk2(v[2], v[3]); w.z = pk2(v[4], v[5]); w.w = pk2(v[6], v[7]);
        *(u32x4*)(Bt1 + (size_t)(128 + j) * 256 + k0) = w;
    }
    for (int pc = tid; pc < 256 * 32; pc += 512) {
        const int j = pc >> 5, k0 = (pc & 31) * 8, s = j >> 4, cp = j & 15;
        float v[8];
#pragma unroll
        for (int e = 0; e < 8; ++e) {
            const int k = k0 + e, p = k & 63;
            const float xr = cr[cp * 64 + p], xi = ci[cp * 64 + p], yr = ar[(s + 1) * 64 + p], yi = ai[(s + 1) * 64 + p];
            v[e] = k < 64 ? (xr * yr - xi * yi) : (k < 128 ? -(xr * yi + xi * yr) : 0.f);
        }
        u32x4 w; w.x = pk2(v[0], v[1]); w.y = pk2(v[2], v[3]); w.z = pk2(v[4], v[5]); w.w = pk2(v[6], v[7]);
        *(u32x4*)(Bt3 + (size_t)j * 256 + k0) = w;
    }
    __syncthreads();
}
__device__ __forceinline__ void s5_scan(int l, int sid, int lane) {
    const int g = sid >> 3, b = sid & 7, p = lane;
    const float lre = fminf((inp(16) + l * 2048)[g * 64 + p], -1e-4f), lim = (inp(17) + l * 2048)[g * 64 + p], dt = expf((inp(18) + l * 32)[g]);
    const float mg = expf(16.f * lre * dt), an = 16.f * lim * dt, a16r = mg * cosf(an), a16i = mg * sinf(an);
    float* base = (float*)WSP(WS_EX) + (size_t)(g * 2048 + b * 256) * 128;
    float xr = 0.f, xi = 0.f;
    float er[8], ei[8], nr[8], ni[8];
#pragma unroll
    for (int j = 0; j < 8; ++j) { er[j] = base[(size_t)j * 128 + p]; ei[j] = base[(size_t)j * 128 + 64 + p]; }
#pragma unroll 1
    for (int n0 = 0; n0 < 256; n0 += 8) {
        if (n0 + 8 < 256) {
#pragma unroll
            for (int j = 0; j < 8; ++j) { nr[j] = base[(size_t)(n0 + 8 + j) * 128 + p]; ni[j] = base[(size_t)(n0 + 8 + j) * 128 + 64 + p]; }
        }
        asm volatile("s_waitcnt vmcnt(16)" ::: "memory");
#pragma unroll
        for (int j = 0; j < 8; ++j) {
            bf16_t* row = (bf16_t*)(base + (size_t)(n0 + j) * 128);
            row[p] = (bf16_t)f2bf(xr); row[64 + p] = (bf16_t)f2bf(xi); ((unsigned*)row)[64 + p] = 0u;
            const float tr = a16r * xr - a16i * xi + er[j], ti = a16r * xi + a16i * xr + ei[j];
            xr = tr; xi = ti;
        }
#pragma unroll
        for (int j = 0; j < 8; ++j) { er[j] = nr[j]; ei[j] = ni[j]; }
    }
}

namespace mx {
typedef float f32x16 __attribute__((ext_vector_type(16)));
constexpr int PB = 72;
constexpr int L_QS = 0, L_KS = 9216, L_KT = 18432, L_VT = 27648, L_PS = 46080, L_ST = 55296, L_OS = 73728, L_VEC = 107520;
constexpr int OSP = 132;
constexpr int V_SEG = 0, V_ELAST = 512, V_GA = 576, V_RT = 1600, V_CS = 1664, V_WI = 1728, V_WK = 1792, V_ENM = 1856, V_DEN = 1920, V_NORM = 1984, V_SC = 2112, V_END = 2128;
static_assert(L_VEC + V_END * 4 <= RING_BYTES, "mixer LDS map");
__device__ __forceinline__ int crow(int reg, int hh) { return (reg & 3) + 8 * (reg >> 2) + 4 * hh; }
__device__ __forceinline__ float fexp(float x) { return __builtin_amdgcn_exp2f(1.4426950408889634f * x); }
__device__ __forceinline__ float flogsig(float x) { const float e = fexp(-fabsf(x)); return fminf(x, 0.f) - 0.6931471805599453f * __builtin_amdgcn_logf(1.f + e); }
#define MX_MFMA(a, b, c) __builtin_amdgcn_mfma_f32_32x32x16_bf16((a), (b), (c), 0, 0, 0)

template <int ROLE, bool STORE = true>
__device__ __forceinline__ void stream(int l, LAS unsigned char* lds, int bh, int wvs) {
    int tid = hw_tid(wvs); asm volatile("" : "+v"(tid));
    const int lane = tid & 63, w = __builtin_amdgcn_readfirstlane(tid >> 6), r32 = lane & 31, hh = lane >> 5;
    const int b = bh >> 2, h = bh & 3;
    bf16_t* Z = (bf16_t*)WSP(WS_Z); const float* ZS = (const float*)WSP(WS_ZS);
    LAS float* vec = (LAS float*)(lds + L_VEC);
    LAS bf16_t* Qs = (LAS bf16_t*)(lds + L_QS); LAS bf16_t* Ks = (LAS bf16_t*)(lds + L_KS); LAS bf16_t* KTs = (LAS bf16_t*)(lds + L_KT);
    LAS bf16_t* VTs = (LAS bf16_t*)(lds + L_VT); LAS bf16_t* Ps = (LAS bf16_t*)(lds + L_PS); LAS bf16_t* STs = (LAS bf16_t*)(lds + L_ST);
    LAS float* Os = (LAS float*)(lds + L_OS);
    const int qcol = (ROLE == 0 ? GQ : MQ) + h * 64, kcol = (ROLE == 0 ? GK : MK) + h * 64, vcol = (ROLE == 0 ? GV : MV) + h * 128, gcol = (ROLE == 0 ? GR : MO) + h * 128;
    const int vc_ = tid & 127, rq = tid >> 7, et = tid >> 3, cg = tid & 7;
    const int wa = w >> 2, wv = w & 3;
    float a2c[16], abd = 0.f, nwv[16];
    float cwq[4], cwk[4], cbq = 0.f, cbk = 0.f, ibh = 0.f, fbh = 0.f, mprev = 0.f;
#pragma unroll
    for (int r = 0; r < 16; ++r) { a2c[r] = 0.f; nwv[r] = 0.f; }
#pragma unroll
    for (int j = 0; j < 4; ++j) { cwq[j] = 0.f; cwk[j] = 0.f; }
    if (ROLE == 0) {
        const float* a2 = inp(9) + l * 16 * 256; const float* ab = inp(10) + l * 256; const float* nw = inp(11) + l * 512;
#pragma unroll
        for (int r = 0; r < 16; ++r) { a2c[r] = a2[r * 256 + h * 64 + lane]; nwv[r] = nw[h * 128 + 16 * cg + r]; }
        abd = ab[h * 64 + lane];
    } else {
        const float* cw = inp(12) + l * 4 * 512; const float* cb = inp(13) + l * 512;
#pragma unroll
        for (int j = 0; j < 4; ++j) { cwq[j] = cw[j * 512 + h * 64 + lane]; cwk[j] = cw[j * 512 + 256 + h * 64 + lane]; }
        cbq = cb[h * 64 + lane]; cbk = cb[256 + h * 64 + lane];
        ibh = (inp(14) + l * 4)[h]; fbh = (inp(15) + l * 4)[h];
    }
    for (int i = tid; i < 128 * PB / 2; i += 512) ((LAS unsigned*)STs)[i] = 0u;
    for (int i = tid; i < 64 * PB / 2; i += 512) ((LAS unsigned*)Ps)[i] = 0u;
    if (tid < 128) vec[V_NORM + tid] = 0.f;
    f32x16 accS;
#pragma unroll
    for (int r = 0; r < 16; ++r) accS[r] = 0.f;
    unsigned qi[11], ki[11], vi[16]; float zs0 = 0.f, zs1 = 0.f; u32x4 gt0 = {0u, 0u, 0u, 0u}, gt1 = {0u, 0u, 0u, 0u};
#define MX_LOAD(mrow, nn) do { \
        if (ROLE == 0) { \
            _Pragma("unroll") for (int i = 0; i < 8; ++i) { const bf16_t* zr = Z + ((mrow) + 8 * w + i) * ZLD; qi[i] = *(const unsigned*)(zr + qcol + (lane & ~1)); ki[i] = *(const unsigned*)(zr + kcol + (lane & ~1)); } \
            const float* zp = ZS + ((mrow) + et) * 32 + 2 * cg; zs0 = zp[0]; zs1 = zp[1]; \
        } else { \
            _Pragma("unroll") for (int i = 0; i < 11; ++i) { const int trel = 8 * w + i - 3; const int trc = ((nn) > 0 || trel >= 0) ? trel : 0;     \
                const bf16_t* zr = Z + ((mrow) + trc) * ZLD; qi[i] = *(const unsigned*)(zr + qcol + (lane & ~1)); ki[i] = *(const unsigned*)(zr + kcol + (lane & ~1)); } \
            if (w == 0) { const float* zp = ZS + ((mrow) + lane) * 32; zs0 = zp[16 + h]; zs1 = zp[20 + h]; } \
        } \
        _Pragma("unroll") for (int i = 0; i < 16; ++i) vi[i] = *(const unsigned*)(Z + ((mrow) + 16 * rq + i) * ZLD + vcol + (vc_ & ~1)); \
    } while (0)
#define MX_PIN11(a) asm volatile("" : "+v"(a[0]), "+v"(a[1]), "+v"(a[2]), "+v"(a[3]), "+v"(a[4]), "+v"(a[5]), "+v"(a[6]), "+v"(a[7]), "+v"(a[8]), "+v"(a[9]), "+v"(a[10]))
#define MX_PIN8(a, o) asm volatile("" : "+v"(a[o]), "+v"(a[o + 1]), "+v"(a[o + 2]), "+v"(a[o + 3]), "+v"(a[o + 4]), "+v"(a[o + 5]), "+v"(a[o + 6]), "+v"(a[o + 7]))
    size_t m0 = (size_t)b * T;
    MX_LOAD(m0, 0);
    if (ROLE == 0) { vec[V_GA + et * 16 + 2 * cg] = zs0; vec[V_GA + et * 16 + 2 * cg + 1] = zs1; }
    __syncthreads();

#pragma unroll 1
    for (int n = 0; n <= 64; ++n) {
        if (n > 0) {
            const size_t mp = m0 - 64;
            const LAS float* orow = Os + et * OSP + 16 * cg;
            float o[16];
#pragma unroll
            for (int q4 = 0; q4 < 4; ++q4) { const f32x4 t4 = *(const LAS f32x4*)(orow + 4 * q4); o[4 * q4] = t4[0]; o[4 * q4 + 1] = t4[1]; o[4 * q4 + 2] = t4[2]; o[4 * q4 + 3] = t4[3]; }
            asm volatile("" : "+v"(gt0), "+v"(gt1));
            const unsigned gw_[8] = {gt0.x, gt0.y, gt0.z, gt0.w, gt1.x, gt1.y, gt1.z, gt1.w};
            float y[16];
            if (ROLE == 0) {
                float ss = 0.f;
#pragma unroll
                for (int e = 0; e < 16; ++e) ss += o[e] * o[e];
                ss += shl(ss, lane ^ 1); ss += shl(ss, lane ^ 2); ss += shl(ss, lane ^ 4);
                const float rn = rsqrtf(ss * (1.f / 128.f) + 1e-6f);
#pragma unroll
                for (int e = 0; e < 16; ++e) { const float g = (e & 1) ? bfhi(gw_[e >> 1]) : bflo(gw_[e >> 1]); y[e] = o[e] * rn * nwv[e] * g * fsigmoid(g); }
            } else {
                const float rdiv = vec[V_DEN + et];
#pragma unroll
                for (int e = 0; e < 16; ++e) { const float g = (e & 1) ? bfhi(gw_[e >> 1]) : bflo(gw_[e >> 1]); y[e] = o[e] * rdiv * fsigmoid(g); }
            }
            u32x4 s0, s1;
            s0.x = pk2(y[0], y[1]); s0.y = pk2(y[2], y[3]); s0.z = pk2(y[4], y[5]); s0.w = pk2(y[6], y[7]);
            s1.x = pk2(y[8], y[9]); s1.y = pk2(y[10], y[11]); s1.z = pk2(y[12], y[13]); s1.w = pk2(y[14], y[15]);
            bf16_t* dst = Z + (mp + et) * ZLD + gcol + 16 * cg;
            if (STORE) { *(u32x4*)dst = s0; *(u32x4*)(dst + 8) = s1; } else { asm volatile("" :: "v"(s0), "v"(s1), "v"(dst)); }
        }
        if (n == 64) break;
        if (ROLE == 0) { MX_PIN8(qi, 0); MX_PIN8(ki, 0); } else { MX_PIN11(qi); MX_PIN11(ki); if (n == 0 && w == 0) { qi[0] = qi[1] = qi[2] = 0u; ki[0] = ki[1] = ki[2] = 0u; } }
        asm volatile("" : "+v"(zs0), "+v"(zs1));
        float c8[8], qf[8], kf[8];
        if (ROLE == 0) {
            float run = 0.f;
#pragma unroll
            for (int i = 0; i < 8; ++i) {
                const LAS f32x4* gp = (const LAS f32x4*)(vec + V_GA + (8 * w + i) * 16);
                float x = abd;
#pragma unroll
                for (int r4 = 0; r4 < 4; ++r4) { const f32x4 g4 = gp[r4]; x += g4[0] * a2c[4 * r4] + g4[1] * a2c[4 * r4 + 1] + g4[2] * a2c[4 * r4 + 2] + g4[3] * a2c[4 * r4 + 3]; }
                run += flogsig(x) * (1.f / 16.f); c8[i] = run;
                qf[i] = ((lane & 1) ? bfhi(qi[i]) : bflo(qi[i])) * 0.125f; kf[i] = (lane & 1) ? bfhi(ki[i]) : bflo(ki[i]);
            }
            vec[V_SEG + w * 64 + lane] = run;
        } else {
#pragma unroll
            for (int i = 0; i < 8; ++i) {
                float aq = cbq, ak = cbk;
#pragma unroll
                for (int j = 0; j < 4; ++j) { aq += cwq[j] * ((lane & 1) ? bfhi(qi[i + j]) : bflo(qi[i + j])); ak += cwk[j] * ((lane & 1) ? bfhi(ki[i + j]) : bflo(ki[i + j])); }
                qf[i] = aq * fsigmoid(aq); kf[i] = ak * fsigmoid(ak) * 0.125f; c8[i] = 0.f;
            }
            if (w == 0) {
                const float ip = zs0 + ibh, lf = logsigmoidf_(zs1 + fbh);
                float bs = lf;
#pragma unroll
                for (int o = 1; o < 64; o <<= 1) { const float t = shl(bs, lane >= o ? lane - o : lane); if (lane >= o) bs += t; }
                const float cs = ip - bs;
                float pm = cs;
#pragma unroll
                for (int o = 1; o < 64; o <<= 1) { const float t = shl(pm, lane >= o ? lane - o : lane); if (lane >= o) pm = fmaxf(pm, t); }
                const float mt = bs + fmaxf(mprev, pm);
                vec[V_RT + lane] = bs - mt; vec[V_CS + lane] = cs; vec[V_WI + lane] = expf(bs + mprev - mt); vec[V_ENM + lane] = expf(-mt);
                const float mnew = shl(mt, 63), b63 = shl(bs, 63);
                vec[V_WK + lane] = expf(b63 + cs - mnew);
                if (lane == 0) vec[V_SC] = expf(b63 + mprev - mnew);
                mprev = mnew;
            }
        }
        __syncthreads();
        {
            u32x4 ktp; unsigned ktw[4];
            if (ROLE == 0) {
                float off = 0.f, tot = 0.f;
#pragma unroll
                for (int w2 = 0; w2 < 8; ++w2) { const float s = vec[V_SEG + w2 * 64 + lane]; tot += s; off += (w2 < w) ? s : 0.f; }
                if (w == 0) vec[V_ELAST + lane] = fexp(tot);
                float kt[8];
#pragma unroll
                for (int i = 0; i < 8; ++i) {
                    const float cum = off + c8[i];
                    Qs[(8 * w + i) * PB + lane] = (bf16_t)f2bf(qf[i] * fexp(cum));
                    Ks[(8 * w + i) * PB + lane] = (bf16_t)f2bf(kf[i] * fexp(-cum));
                    kt[i] = kf[i] * fexp(tot - cum);
                }
#pragma unroll
                for (int i = 0; i < 4; ++i) ktw[i] = pk2(kt[2 * i], kt[2 * i + 1]);
            } else {
                float kt[8];
#pragma unroll
                for (int i = 0; i < 8; ++i) {
                    Qs[(8 * w + i) * PB + lane] = (bf16_t)f2bf(qf[i]);
                    Ks[(8 * w + i) * PB + lane] = (bf16_t)f2bf(kf[i]);
                    kt[i] = kf[i] * vec[V_WK + 8 * w + i];
                }
#pragma unroll
                for (int i = 0; i < 4; ++i) ktw[i] = pk2(kt[2 * i], kt[2 * i + 1]);
            }
            ktp.x = ktw[0]; ktp.y = ktw[1]; ktp.z = ktw[2]; ktp.w = ktw[3];
            *(LAS u32x4*)(KTs + lane * PB + 8 * w) = ktp;
            MX_PIN8(vi, 0); MX_PIN8(vi, 8);
#pragma unroll
            for (int i = 0; i < 16; ++i) vi[i] = (vc_ & 1) ? (vi[i] >> 16) : (vi[i] & 0xffffu);
            u32x4 v0, v1;
            v0.x = vi[0] | ((unsigned)vi[1] << 16); v0.y = vi[2] | ((unsigned)vi[3] << 16); v0.z = vi[4] | ((unsigned)vi[5] << 16); v0.w = vi[6] | ((unsigned)vi[7] << 16);
            v1.x = vi[8] | ((unsigned)vi[9] << 16); v1.y = vi[10] | ((unsigned)vi[11] << 16); v1.z = vi[12] | ((unsigned)vi[13] << 16); v1.w = vi[14] | ((unsigned)vi[15] << 16);
            *(LAS u32x4*)(VTs + vc_ * PB + 16 * rq) = v0; *(LAS u32x4*)(VTs + vc_ * PB + 16 * rq + 8) = v1;
        }
        __syncthreads();
        { const bf16_t* gp = Z + (m0 + et) * ZLD + gcol + 16 * cg; gt0 = *(const u32x4*)gp; gt1 = *(const u32x4*)(gp + 8); }
        if (n < 63) MX_LOAD(m0 + 64, n + 1);
#define MX_FRAG(base, row, ks) (*(const LAS bf16x8*)(lds + (base) + ((row) * PB + 16 * (ks) + 8 * hh) * 2))
        if (w < 3) {
            const int ti = (w >= 1) ? 1 : 0, sj = (w == 2) ? 1 : 0;
            f32x16 sc;
#pragma unroll
            for (int r = 0; r < 16; ++r) sc[r] = 0.f;
#pragma unroll
            for (int ks = 0; ks < 4; ++ks) sc = MX_MFMA(MX_FRAG(L_QS, 32 * ti + r32, ks), MX_FRAG(L_KS, 32 * sj + r32, ks), sc);
            const float csv = (ROLE == 1) ? vec[V_CS + 32 * sj + r32] : 0.f;
#pragma unroll
            for (int r = 0; r < 16; ++r) {
                const int t = crow(r, hh);
                const bool keep = (ti != sj) || (r32 <= t);
                float val = sc[r];
                if (ROLE == 1) val *= expf(vec[V_RT + 32 * ti + t] + csv);
                Ps[(32 * ti + t) * PB + 32 * sj + r32] = (bf16_t)f2bf(keep ? val : 0.f);
            }
        }
        f32x16 acco;
#pragma unroll
        for (int r = 0; r < 16; ++r) acco[r] = 0.f;
#pragma unroll
        for (int ks = 0; ks < 4; ++ks) acco = MX_MFMA(MX_FRAG(L_QS, 32 * wa + r32, ks), MX_FRAG(L_ST, 32 * wv + r32, ks), acco);
        if (ROLE == 1) {
#pragma unroll
            for (int r = 0; r < 16; ++r) acco[r] *= vec[V_WI + 32 * wa + crow(r, hh)];
        }
        if (ROLE == 0) {
#pragma unroll
            for (int r = 0; r < 16; ++r) accS[r] *= vec[V_ELAST + 32 * wa + crow(r, hh)];
        } else {
            const float carry = vec[V_SC];
#pragma unroll
            for (int r = 0; r < 16; ++r) accS[r] *= carry;
        }
#pragma unroll
        for (int ks = 0; ks < 4; ++ks) accS = MX_MFMA(MX_FRAG(L_KT, 32 * wa + r32, ks), MX_FRAG(L_VT, 32 * wv + r32, ks), accS);
        __syncthreads();
        if (wa == 0) {
#pragma unroll
            for (int ks = 0; ks < 2; ++ks) acco = MX_MFMA(MX_FRAG(L_PS, r32, ks), MX_FRAG(L_VT, 32 * wv + r32, ks), acco);
        } else {
#pragma unroll
            for (int ks = 0; ks < 4; ++ks) acco = MX_MFMA(MX_FRAG(L_PS, 32 + r32, ks), MX_FRAG(L_VT, 32 * wv + r32, ks), acco);
        }
#pragma unroll
        for (int r = 0; r < 16; ++r) Os[(32 * wa + crow(r, hh)) * OSP + 32 * wv + r32] = acco[r];
#pragma unroll
        for (int q4 = 0; q4 < 4; ++q4) { u32x2 p; p.x = pk2(accS[4 * q4], accS[4 * q4 + 1]); p.y = pk2(accS[4 * q4 + 2], accS[4 * q4 + 3]);
            *(LAS u32x2*)(STs + (32 * wv + r32) * PB + 32 * wa + 8 * q4 + 4 * hh) = p; }
        if (ROLE == 0) { if (n < 63) { vec[V_GA + et * 16 + 2 * cg] = zs0; vec[V_GA + et * 16 + 2 * cg + 1] = zs1; } }
        else {
            const LAS float* nprev = vec + V_NORM + (n & 1) * 64;
            if (w == 0) {
                float qn = 0.f, si = 0.f;
#pragma unroll
                for (int c8i = 0; c8i < 8; ++c8i) {
                    const u32x4 qv = *(const LAS u32x4*)(Qs + lane * PB + 8 * c8i), pv = *(const LAS u32x4*)(Ps + lane * PB + 8 * c8i);
                    const f32x4 n0 = *(const LAS f32x4*)(nprev + 8 * c8i), n1 = *(const LAS f32x4*)(nprev + 8 * c8i + 4);
                    qn += bflo(qv.x) * n0[0] + bfhi(qv.x) * n0[1] + bflo(qv.y) * n0[2] + bfhi(qv.y) * n0[3] + bflo(qv.z) * n1[0] + bfhi(qv.z) * n1[1] + bflo(qv.w) * n1[2] + bfhi(qv.w) * n1[3];
                    si += (bflo(pv.x) + bfhi(pv.x)) + (bflo(pv.y) + bfhi(pv.y)) + (bflo(pv.z) + bfhi(pv.z)) + (bflo(pv.w) + bfhi(pv.w));
                }
                const float den = vec[V_WI + lane] * qn + si;
                vec[V_DEN + lane] = 1.f / fmaxf(fabsf(den), vec[V_ENM + lane]);
            } else if (w == 1) {
                float kn = 0.f;
#pragma unroll
                for (int c8i = 0; c8i < 8; ++c8i) { const u32x4 kv = *(const LAS u32x4*)(KTs + lane * PB + 8 * c8i);
                    kn += (bflo(kv.x) + bfhi(kv.x)) + (bflo(kv.y) + bfhi(kv.y)) + (bflo(kv.z) + bfhi(kv.z)) + (bflo(kv.w) + bfhi(kv.w)); }
                vec[V_NORM + ((n + 1) & 1) * 64 + lane] = vec[V_SC] * nprev[lane] + kn;
            }
        }
        __syncthreads();
        m0 += 64;
    }
#undef MX_LOAD
#undef MX_PIN8
#undef MX_PIN11
#undef MX_FRAG
}
}

#ifndef PHASE_MASK
#define PHASE_MASK 0xFFFF
#endif
#define PH(k) if constexpr ((PHASE_MASK >> (k)) & 1)
#ifndef PROBE_GEMM_REPS
#define PROBE_GEMM_REPS 1
#endif
#ifndef PROBE_STREAM_REPS
#define PROBE_STREAM_REPS 1
#endif
#define GREP _Pragma("unroll 1") for (int rep_ = 0; rep_ < PROBE_GEMM_REPS; ++rep_)
#define GREP_BAR if (rep_) GRID_BAR();
#define BLK_ENV int blk = blockIdx.x; asm volatile("" : "+s"(blk));
#define PHASE_ENV BLK_ENV int tid = hw_tid(wave_s); asm volatile("" : "+v"(tid)); const int lane = tid & 63, wave = wave_s; int vcu_ = vcu; asm volatile("" : "+s"(vcu_)); const int gw = vcu_ * NWAVES + wave; (void)lane; (void)gw;
__global__ void __launch_bounds__(NWAVES * 64, 2) mega_fwd(Args args) {
    extern __shared__ __attribute__((aligned(16))) unsigned char lds_raw[];
    LAS unsigned char* lds = (LAS unsigned char*)lds_raw;
    const int G = gridDim.x, blk0 = blockIdx.x;
    const int wave_s = __builtin_amdgcn_readfirstlane(threadIdx.x >> 6);
    const int vcu = (G % 8 == 0) ? (blk0 % 8) * (G / 8) + blk0 / 8 : blk0;
    const int NGW = G * NWAVES;
    for (int u = threadIdx.x; u < (LDS_BYTES - LDSCTL_OFF) / 4; u += NWAVES * 64) ((LAS unsigned*)(lds + LDSCTL_OFF))[u] = 0u;
    __syncthreads();
    (void)xcd_barrier_post((unsigned*)(args.ws + WS_CTL) + CW_BAR, (volatile LAS unsigned*)(lds + MISC_OFF) + 8);
#define GRID_BAR() do { XcdBarrier b_; b_.bar = (unsigned*)(inp_ws() + WS_CTL) + CW_BAR; b_.x = xb_xcc_id(); b_.st = (volatile LAS unsigned*)(lds + MISC_OFF) + 8; xcd_barrier(b_, wave_s); } while (0)

    PH(0) { PHASE_ENV
        ada_phase(lds, blk, wave, lane);
        if (blk < 32) s5_generate(0, blk, lds, wave_s);
        else if (blk < 40) convert_small(inp(8), (bf16_t*)WSP(WS_WSM), blk - 32, tid);
        LAS float* scr = (LAS float*)(lds + wave * 16384);
        int base = 0;
        convert_matrix<1>(inp(8), INDIM, 1024, ZLD, (bf16_t*)WSP(WS_WIN), scr, lane, gw, NGW, base);
    }
    GRID_BAR();

#pragma unroll 1
    for (int l = 0; l < DEPTH; ++l) {
        PH(1) if (l == 0) { PHASE_ENV
            norm_rows<false, true>(nullptr, 0, inp(0), nullptr, nullptr, 0, nullptr, inp(4), (const float*)WSP(WS_MOD), 0, 1024, (bf16_t*)WSP(WS_H), gw, NGW, lane);
            GRID_BAR();
        }
        PH(2) GREP { GREP_BAR BLK_ENV
            pg8::PlainSched S; S.o.init(M, ZLD, G, blk); S.A = (const bf16_t*)WSP(WS_H); S.lda = D; S.Bt = (const bf16_t*)WSP(WS_WIN); S.K = D;
            pg8::EpiStore E{(bf16_t*)WSP(WS_Z), ZLD};
            pg8::gemm_phase<pg8::EpiStore, pg8::PlainSched, true, true>(lds, wave_s, D, D, S, E);
            { const int task = (int)(((G % 8 == 0) ? (blk % 8) * (G / 8) + blk / 8 : blk) * NWAVES + wave_s);
              for (int t = task; t < M / 32; t += G * NWAVES) zs_mfma((const bf16_t*)WSP(WS_H), (const bf16_t*)WSP(WS_WSM), (float*)WSP(WS_ZS), t, hw_lane()); }
        }
        GRID_BAR();
        PH(11) GREP { GREP_BAR BLK_ENV
            pg8::S5aSched S; S.G = G; S.c = blk; S.Zb = (const bf16_t*)WSP(WS_Z); S.Bt1 = (const bf16_t*)WSP(WS_S5M1);
            pg8::EpiS5a E{(float*)WSP(WS_EX), (bf16_t*)WSP(WS_YP)};
            pg8::gemm_phase<pg8::EpiS5a, pg8::S5aSched, true, true, 1>(lds, wave_s, 0, 256, S, E);
        }
        GRID_BAR();
        PH(3) { PHASE_ENV
#if PROBE_STREAM_REPS > 1
            for (int rep_ = 1; rep_ < PROBE_STREAM_REPS; ++rep_) { if (blk < 32) mx::stream<0, false>(l, lds, blk, wave_s); else if (blk < 64) mx::stream<1, false>(l, lds, blk - 32, wave_s); __syncthreads(); }
#endif
            if (blk < 32) mx::stream<0>(l, lds, blk, wave_s);
            else if (blk < 64) mx::stream<1>(l, lds, blk - 32, wave_s);
            else if (blk < 192) { if (wave < 2) s5_scan(l, (blk - 64) * 2 + wave, lane); }
            else if (G > 192) {
                int base = 0; const int gw2 = (blk - 192) * NWAVES + wave, NGW2 = (G - 192) * NWAVES;
                LAS float* scr = (LAS float*)(lds + wave * 16384);
                convert_matrix<0>(inp(24) + (size_t)l * 512 * 512, 512, 512, 512, (bf16_t*)WSP(WS_WGLU), scr, lane, gw2, NGW2, base);
                convert_matrix<0>(inp(26) + (size_t)l * 512 * 1024, 1024, 512, 1024, (bf16_t*)WSP(WS_WPROJ), scr, lane, gw2, NGW2, base);
                convert_matrix<0>(inp(27) + (size_t)l * 512 * 1024, 1024, 512, 1024, (bf16_t*)WSP(WS_WPROJ) + 1024 * 512, scr, lane, gw2, NGW2, base);
                convert_matrix<0>(inp(28) + (size_t)l * 512 * 1024, 1024, 512, 1024, (bf16_t*)WSP(WS_WPROJ) + 2 * 1024 * 512, scr, lane, gw2, NGW2, base);
                convert_matrix<0>(inp(30) + (size_t)l * D * D, 1024, 1024, 1024, (bf16_t*)WSP(WS_WOUT), scr, lane, gw2, NGW2, base);
                convert_matrix<0>(inp(32) + (size_t)l * FF * D, 1024, FF, 1024, (bf16_t*)WSP(WS_WFO), scr, lane, gw2, NGW2, base);
            }
        }
        GRID_BAR();
        PH(12) { BLK_ENV
            pg8::S5bSched S; S.G = G; S.c = blk; S.X = (const bf16_t*)WSP(WS_EX); S.Bt3 = (const bf16_t*)WSP(WS_S5M3);
            pg8::EpiS5b E{(const bf16_t*)WSP(WS_YP), (bf16_t*)WSP(WS_Z), inp(23) + l * 512};
            pg8::gemm_phase<pg8::EpiS5b, pg8::S5bSched, true, true>(lds, wave_s, 256, 256, S, E);
        }
        GRID_BAR();
        PH(4) GREP { GREP_BAR BLK_ENV
            bf16_t* Z = (bf16_t*)WSP(WS_Z);
            pg8::PlainSched S; S.o.init(M, 512, G, blk); S.A = Z + SU; S.lda = ZLD; S.Bt = (const bf16_t*)WSP(WS_WGLU); S.K = 512;
            pg8::EpiGlu E{Z + YS2, ZLD, Z + SU, ZLD, inp(25) + l * 512};
            pg8::gemm_phase<pg8::EpiGlu, pg8::PlainSched, true, true>(lds, wave_s, ZLD, 512, S, E);
        }
        GRID_BAR();
        PH(5) GREP { GREP_BAR BLK_ENV
            bf16_t* Z = (bf16_t*)WSP(WS_Z);
            pg8::MergeSched S; S.o.init(M, 1024, G, blk); S.Zb = Z; S.Wp = (const bf16_t*)WSP(WS_WPROJ);
            pg8::EpiMerge E{Z + MRG, ZLD, Z + ZG, ZLD, inp(29) + l * 3072};
            pg8::gemm_phase<pg8::EpiMerge, pg8::MergeSched, true, true>(lds, wave_s, ZLD, 512, S, E);
        }
        GRID_BAR();
        PH(6) GREP { GREP_BAR BLK_ENV
            pg8::PlainSched S; S.o.init(M, 1024, G, blk); S.A = (const bf16_t*)WSP(WS_Z) + MRG; S.lda = ZLD; S.Bt = (const bf16_t*)WSP(WS_WOUT); S.K = 1024;
            pg8::EpiStore E{(bf16_t*)WSP(WS_H), D};
            pg8::gemm_phase<pg8::EpiStore, pg8::PlainSched, true, true>(lds, wave_s, ZLD, 1024, S, E);
        }
        GRID_BAR();
        PH(7) { PHASE_ENV
            const float* modl = (const float*)WSP(WS_MOD) + (size_t)l * 8 * 6144;
            { int base = 0; convert_matrix<2>(inp(31) + (size_t)l * D * 2 * FF, 2 * FF, 1024, 2 * FF, (bf16_t*)WSP(WS_WFI), (LAS float*)(lds + wave * 16384), lane, gw, NGW, base); }
            norm_rows<true, true>((const bf16_t*)WSP(WS_H), D, (l == 0) ? inp(0) : (const float*)inp_out(), inp(5) + l * D, modl, 2048, inp_out(), inp(6) + l * D, modl, 3072, 4096,
                                      (bf16_t*)WSP(WS_H), gw, NGW, lane);
        }
        GRID_BAR();
        PH(8) GREP { GREP_BAR BLK_ENV
            pg8::PlainSched S; S.o.init(M, 2 * FF, G, blk); S.A = (const bf16_t*)WSP(WS_H); S.lda = D; S.Bt = (const bf16_t*)WSP(WS_WFI); S.K = D;
            pg8::EpiSwiGlu E{(bf16_t*)WSP(WS_Z), FF};
            pg8::gemm_phase<pg8::EpiSwiGlu, pg8::PlainSched, true, true>(lds, wave_s, D, D, S, E);
        }
        GRID_BAR();
        PH(9) GREP { GREP_BAR BLK_ENV
            pg8::PlainSched S; S.o.init(M, 1024, G, blk); S.A = (const bf16_t*)WSP(WS_Z); S.lda = FF; S.Bt = (const bf16_t*)WSP(WS_WFO); S.K = FF;
            pg8::EpiStore E{(bf16_t*)WSP(WS_H), D};
            pg8::gemm_phase<pg8::EpiStore, pg8::PlainSched, true, true>(lds, wave_s, FF, FF, S, E);
        }
        GRID_BAR();
        PH(10) { PHASE_ENV
            const float* modl = (const float*)WSP(WS_MOD) + (size_t)l * 8 * 6144;
            if (l + 1 < DEPTH) {
                const int l1 = l + 1;
                LAS float* scr = (LAS float*)(lds + wave * 16384);
                int base = 0;
                if (blk < 32) s5_generate(l1, blk, lds, wave_s);
                convert_matrix<1>(inp(8) + (size_t)l1 * D * INDIM, INDIM, 1024, ZLD, (bf16_t*)WSP(WS_WIN), scr, lane, gw, NGW, base);
                if (blk >= 32 && blk < 40) convert_small(inp(8) + (size_t)l1 * D * INDIM, (bf16_t*)WSP(WS_WSM), blk - 32, tid);
                norm_rows<true, true>((const bf16_t*)WSP(WS_H), D, (const float*)inp_out(), inp(7) + l * D, modl, 5120, inp_out(), inp(4) + l1 * D, modl + 8 * 6144, 0, 1024,
                                      (bf16_t*)WSP(WS_H), gw, NGW, lane);
                GRID_BAR();
            } else {
                norm_rows<true, false>((const bf16_t*)WSP(WS_H), D, (const float*)inp_out(), inp(7) + l * D, modl, 5120, inp_out(), nullptr, nullptr, 0, 0, nullptr, gw, NGW, lane);
            }
        }
    }
}

extern "C" void kernel_launch(void* const* d_in, const int* in_sizes, int n_in, void* d_out, int out_size, void* d_ws, size_t ws_size, hipStream_t stream) {
    static int grid = 0;
    if (grid == 0) {
        if (n_in != 33 || ws_size < WS_END || out_size != M * D) { fprintf(stderr, "kernel_launch: unexpected n_in %d / ws %zu / out %d\n", n_in, ws_size, out_size); grid = -1; return; }
        int dev = 0, cus = 0, per_cu = 0;
        if (hipGetDevice(&dev) != hipSuccess || hipDeviceGetAttribute(&cus, hipDeviceAttributeMultiprocessorCount, dev) != hipSuccess) { grid = -1; return; }
        if (hipFuncSetAttribute((const void*)mega_fwd, hipFuncAttributeMaxDynamicSharedMemorySize, LDS_BYTES) != hipSuccess) { fprintf(stderr, "kernel_launch: hipFuncSetAttribute failed\n"); grid = -1; return; }
        if (hipOccupancyMaxActiveBlocksPerMultiprocessor(&per_cu, (const void*)mega_fwd, NWAVES * 64, LDS_BYTES) != hipSuccess || per_cu < 1) { fprintf(stderr, "kernel_launch: occupancy query says %d blocks/CU\n", per_cu); grid = -1; return; }
        (void)hipGetLastError();
        grid = cus;
    }
    if (grid < 0) return;
    (void)hipMemsetAsync((char*)d_ws + WS_CTL, 0, CTL_ZERO_BYTES, stream);
    Args a{};
    for (int i = 0; i < 33; ++i) a.in[i] = (const float*)d_in[i];
    a.out = (float*)d_out; a.ws = (unsigned char*)d_ws;
    hipLaunchKernelGGL(mega_fwd, dim3(grid), dim3(NWAVES * 64), LDS_BYTES, stream, a);
}
```

```cpp
#include <hip/hip_runtime.h>
#include <cstdint>
#include <cstdio>

#define LAS __attribute__((address_space(3)))
#define GAS __attribute__((address_space(1)))
typedef unsigned short bf16_t;
typedef short bf16x8 __attribute__((ext_vector_type(8)));
typedef float f32x4 __attribute__((ext_vector_type(4)));
typedef float f32x2 __attribute__((ext_vector_type(2)));
typedef unsigned u32x4 __attribute__((ext_vector_type(4)));
typedef unsigned u32x2 __attribute__((ext_vector_type(2)));

constexpr int NB = 8, T = 4096, D = 1024, M = NB * T, DEPTH = 2;
constexpr int INDIM = 6680, ZLD = 6656, FF = 2816;
constexpr int GQ = 0, GK = 256, GV = 512, GR = 1024, MQ = 1536, MK = 1792, MV = 2048, MO = 2560, SU = 3072, ZG = 3584;
constexpr int YGLA = GR;
constexpr int YML = MO;
constexpr int YS2 = 0;
constexpr int MRG = 1536;
constexpr size_t MiB = 1u << 20;
constexpr size_t WS_CTL = 0, CTL_ZERO_BYTES = 64 * 1024;
constexpr size_t WS_MOD = 512 * 1024;
constexpr size_t WS_ZS = 1 * MiB;
constexpr size_t WS_WIN = 5 * MiB;
constexpr size_t WS_WGLU = 5 * MiB;
constexpr size_t WS_WPROJ = 5 * MiB + 512 * 1024;
constexpr size_t WS_WOUT = 8 * MiB + 512 * 1024;
constexpr size_t WS_WFO = 10 * MiB + 512 * 1024;
constexpr size_t WS_S5M1 = 18 * MiB;
constexpr size_t WS_S5M3 = 24 * MiB;
constexpr size_t WS_WSM = 29 * MiB;
constexpr size_t WS_WFI = 18 * MiB;
constexpr size_t WS_EX = 32 * MiB;
constexpr size_t WS_YP = 64 * MiB;
constexpr size_t WS_H = 32 * MiB;
constexpr size_t WS_Z = 96 * MiB;
constexpr size_t WS_END = 512 * MiB;
constexpr int CW_BAR = 4096;

constexpr int RING_BYTES = 131072, LDSCTL_OFF = RING_BYTES, MISC_OFF = LDSCTL_OFF + 320, LDS_BYTES = 147456;
constexpr int NWAVES = 8;

__device__ __forceinline__ float bf2f(bf16_t v) { return __uint_as_float(((unsigned)v) << 16); }
__device__ __forceinline__ unsigned f2bf(float f) { unsigned u = __float_as_uint(f); return (u + 0x7fffu + ((u >> 16) & 1u)) >> 16; }
__device__ __forceinline__ unsigned pk2(float lo, float hi) { return f2bf(lo) | (f2bf(hi) << 16); }
__device__ __forceinline__ float bflo(unsigned u) { return __uint_as_float(u << 16); }
__device__ __forceinline__ float bfhi(unsigned u) { return __uint_as_float(u & 0xffff0000u); }
__device__ __forceinline__ int hw_lane() { int l; asm volatile("v_mbcnt_lo_u32_b32 %0, -1, 0\n\tv_mbcnt_hi_u32_b32 %0, -1, %0" : "=v"(l)); return l; }
__device__ __forceinline__ int hw_tid(int wv) { return wv * 64 + hw_lane(); }
__device__ __forceinline__ float shl(float v, int src) { return __int_as_float(__builtin_amdgcn_ds_bpermute(src << 2, __float_as_int(v))); }
__device__ __forceinline__ float wave_sum(float v, int lane) {
#pragma unroll
    for (int o = 1; o < 64; o <<= 1) v += shl(v, lane ^ o);
    return v;
}
__device__ __forceinline__ float sigmoidf_(float x) { return 1.f / (1.f + expf(-x)); }
__device__ __forceinline__ float siluf_(float x) { return x / (1.f + expf(-x)); }
__device__ __forceinline__ float logsigmoidf_(float x) { return fminf(x, 0.f) - log1pf(expf(-fabsf(x))); }
__device__ __forceinline__ float gelu_tanh(float y) { return 0.5f * y * (1.f + tanhf(0.7978845608028654f * (y + 0.044715f * y * y * y))); }
__device__ __forceinline__ float fexp_neg(float x) { return __builtin_amdgcn_exp2f(-1.4426950408889634f * x); }
__device__ __forceinline__ float fsigmoid(float x) { return __builtin_amdgcn_rcpf(1.f + fexp_neg(x)); }
#define LDS_WAIT() asm volatile("s_waitcnt lgkmcnt(0)" ::: "memory")
#define VM_WAIT() asm volatile("s_waitcnt vmcnt(0)" ::: "memory")

namespace pg8 {
constexpr int BM = 256, BK = 64, HALF = 128, HTB = HALF * BK * 2, STAGE_BYTES = 8 * HTB, NXCD = 8, WGM = 8;
__host__ __device__ __forceinline__ int lds_byte(int r, int c) { const int st = (r >> 4) * 2 + (c >> 5), rr = r & 15, cc = c & 31, ob = rr * 64 + cc * 2; return st * 1024 + (ob ^ (((ob >> 9) & 1) << 5)); }
__host__ __device__ __forceinline__ void stage_rc(int b, int& R, int& C) { const int st = b / 1024, sb = b % 1024, swz = sb ^ (((sb >> 9) & 1) << 5); R = (st >> 1) * 16 + swz / 64; C = (st & 1) * 32 + (swz % 64) / 2; }
__host__ __device__ __forceinline__ int perm32(int rho) { const int n = rho >> 4, i = rho & 15; return 8 * (i >> 2) + 4 * n + (i & 3); }

struct Unit { int pm, pn, br; };
struct TileOrder {
    int nM, nN, nwg, G, c;
    __device__ void init(int M_, int N_, int G_, int c_) { nM = M_ / BM; nN = N_ / BM; nwg = nM * nN; G = G_; c = c_; }
    __device__ bool tile(int i, int& pm, int& pn) const {
        const long L = (long)i * G + c; if (L >= nwg) return false;
        int wgid = (int)L; { const int q = nwg / NXCD, r = nwg % NXCD, xcd = wgid % NXCD, off = wgid / NXCD; wgid = (xcd < r ? xcd * (q + 1) : r * (q + 1) + (xcd - r) * q) + off; }
        const int nig = WGM * nN, gid = wgid / nig, fm = gid * WGM, gsz = (nM - fm) < WGM ? (nM - fm) : WGM;
        pm = fm + ((wgid % nig) % gsz); pn = (wgid % nig) / gsz; return true;
    }
};
struct PlainSched {
    TileOrder o; const bf16_t* A; int lda; const bf16_t* Bt; int K;
    __device__ bool next(int i, Unit& u) const { u.br = 0; return o.tile(i, u.pm, u.pn); }
    __device__ const char* Ap(const Unit& u) const { return (const char*)(A + (size_t)u.pm * BM * lda); }
    __device__ const char* Bp(const Unit& u) const { return (const char*)(Bt + (size_t)u.pn * BM * K); }
};
struct MergeSched {
    TileOrder o; const bf16_t* Zb; const bf16_t* Wp;
    __device__ bool next(int i, Unit& u) const { u.br = i % 3; return o.tile(i / 3, u.pm, u.pn); }
    __device__ const char* Ap(const Unit& u) const { const int col = u.br == 0 ? YGLA : (u.br == 1 ? YML : YS2); return (const char*)(Zb + (size_t)u.pm * BM * ZLD + col); }
    __device__ const char* Bp(const Unit& u) const { return (const char*)(Wp + (size_t)u.br * 1024 * 512 + (size_t)u.pn * BM * 512); }
};

__device__ __forceinline__ unsigned cvt_pk_bf16(float lo, float hi) { unsigned r; asm volatile("v_cvt_pk_bf16_f32 %0, %1, %2" : "=v"(r) : "v"(lo), "v"(hi)); return r; }

struct EpiStore {
    static constexpr bool PERM = true;
    bf16_t* O; int ldc;
    __device__ __forceinline__ bool keep(const Unit&) const { return false; }
    __device__ __forceinline__ void operator()(f32x4 (&acc)[2][2][4][2], const Unit& u, int wr, int wc, int fr, int fq) const {
        const int row0 = u.pm * BM + wr * 64 + fr, col0 = u.pn * BM + wc * 32 + 8 * fq;
#pragma unroll
        for (int ai = 0; ai < 2; ++ai)
#pragma unroll
            for (int m = 0; m < 4; ++m) { bf16_t* rowp = O + (size_t)(row0 + ai * HALF + m * 16) * ldc + col0;
#pragma unroll
                for (int bj = 0; bj < 2; ++bj) { const f32x4 v0 = acc[ai][bj][m][0], v1 = acc[ai][bj][m][1];
                    u32x4 w; w.x = cvt_pk_bf16(v0[0], v0[1]); w.y = cvt_pk_bf16(v0[2], v0[3]); w.z = cvt_pk_bf16(v1[0], v1[1]); w.w = cvt_pk_bf16(v1[2], v1[3]);
                    *(u32x4*)(rowp + bj * HALF) = w; } }
    }
};
struct EpiGlu {
    static constexpr bool PERM = true;
    bf16_t* O; int ldc; const bf16_t* Asrc; int lda; const float* bias;
    __device__ __forceinline__ bool keep(const Unit&) const { return false; }
    __device__ __forceinline__ void operator()(f32x4 (&acc)[2][2][4][2], const Unit& u, int wr, int wc, int fr, int fq) const {
        const int row0 = u.pm * BM + wr * 64 + fr, col0 = u.pn * BM + wc * 32 + 8 * fq;
        f32x4 bv[2][2];
#pragma unroll
        for (int bj = 0; bj < 2; ++bj)
#pragma unroll
            for (int n = 0; n < 2; ++n) bv[bj][n] = *(const f32x4*)(bias + col0 + bj * HALF + 4 * n);
#pragma unroll
        for (int ai = 0; ai < 2; ++ai)
#pragma unroll
            for (int m = 0; m < 4; ++m) { const size_t r = (size_t)(row0 + ai * HALF + m * 16);
#pragma unroll
                for (int bj = 0; bj < 2; ++bj) {
                    const u32x4 a = *(const u32x4*)(Asrc + r * lda + col0 + bj * HALF);
                    const f32x4 v0 = acc[ai][bj][m][0] + bv[bj][0], v1 = acc[ai][bj][m][1] + bv[bj][1];
                    u32x4 w;
                    w.x = cvt_pk_bf16(bflo(a.x) * fsigmoid(v0[0]), bfhi(a.x) * fsigmoid(v0[1])); w.y = cvt_pk_bf16(bflo(a.y) * fsigmoid(v0[2]), bfhi(a.y) * fsigmoid(v0[3]));
                    w.z = cvt_pk_bf16(bflo(a.z) * fsigmoid(v1[0]), bfhi(a.z) * fsigmoid(v1[1])); w.w = cvt_pk_bf16(bflo(a.w) * fsigmoid(v1[2]), bfhi(a.w) * fsigmoid(v1[3]));
                    *(u32x4*)(O + r * ldc + col0 + bj * HALF) = w; } }
    }
};
struct EpiSwiGlu {
    static constexpr bool PERM = true;
    bf16_t* O; int ldc;
    __device__ __forceinline__ bool keep(const Unit&) const { return false; }
    __device__ __forceinline__ void operator()(f32x4 (&acc)[2][2][4][2], const Unit& u, int wr, int wc, int fr, int fq) const {
        const int row0 = u.pm * BM + wr * 64 + fr, col0 = u.pn * HALF + wc * 32 + 8 * fq;
#pragma unroll
        for (int ai = 0; ai < 2; ++ai)
#pragma unroll
            for (int m = 0; m < 4; ++m) {
                float o[8];
#pragma unroll
                for (int n = 0; n < 2; ++n)
#pragma unroll
                    for (int e = 0; e < 4; ++e) { const float g = acc[ai][0][m][n][e], up = acc[ai][1][m][n][e]; o[n * 4 + e] = g * fsigmoid(g) * up; }
                u32x4 w; w.x = cvt_pk_bf16(o[0], o[1]); w.y = cvt_pk_bf16(o[2], o[3]); w.z = cvt_pk_bf16(o[4], o[5]); w.w = cvt_pk_bf16(o[6], o[7]);
                *(u32x4*)(O + (size_t)(row0 + ai * HALF + m * 16) * ldc + col0) = w; }
    }
};
struct EpiMerge {
    static constexpr bool PERM = true;
    bf16_t* O; int ldc; const bf16_t* Zg; int ldz; const float* bgb;
    __device__ __forceinline__ bool keep(const Unit& u) const { return u.br < 2; }
    __device__ __forceinline__ float e_of(float x) const { return fminf(fexp_neg(x), 1e30f); }
    __device__ __forceinline__ void operator()(f32x4 (&acc)[2][2][4][2], const Unit& u, int wr, int wc, int fr, int fq) const {
        const int row0 = u.pm * BM + wr * 64 + fr, col0 = u.pn * BM + wc * 32 + 8 * fq;
        const int br = u.br, brn = br < 2 ? br + 1 : 2;
#pragma unroll
        for (int bj = 0; bj < 2; ++bj) {
            float ba[8], bb[8];
#pragma unroll
            for (int e = 0; e < 8; ++e) { ba[e] = bgb[br * 1024 + col0 + bj * HALF + e]; bb[e] = bgb[brn * 1024 + col0 + bj * HALF + e]; }
#pragma unroll
            for (int ai = 0; ai < 2; ++ai)
#pragma unroll
                for (int m = 0; m < 4; ++m) { const size_t r = (size_t)(row0 + ai * HALF + m * 16);
                    const u32x4 za = *(const u32x4*)(Zg + r * ldz + br * 1024 + col0 + bj * HALF);
                    const u32x4 zb = *(const u32x4*)(Zg + r * ldz + brn * 1024 + col0 + bj * HALF);
                    const float xa[8] = {bflo(za.x), bfhi(za.x), bflo(za.y), bfhi(za.y), bflo(za.z), bfhi(za.z), bflo(za.w), bfhi(za.w)};
                    const float xb[8] = {bflo(zb.x), bfhi(zb.x), bflo(zb.y), bfhi(zb.y), bflo(zb.z), bfhi(zb.z), bflo(zb.w), bfhi(zb.w)};
                    float f[8];
#pragma unroll
                    for (int e = 0; e < 8; ++e) { const float ga = __builtin_amdgcn_rcpf(1.f + e_of(xa[e] + ba[e]));
                        f[e] = br < 2 ? ga * (1.f + e_of(xb[e] + bb[e])) : ga; }
                    f32x4 v0 = acc[ai][bj][m][0], v1 = acc[ai][bj][m][1];
                    v0[0] *= f[0]; v0[1] *= f[1]; v0[2] *= f[2]; v0[3] *= f[3]; v1[0] *= f[4]; v1[1] *= f[5]; v1[2] *= f[6]; v1[3] *= f[7];
                    if (br < 2) { acc[ai][bj][m][0] = v0; acc[ai][bj][m][1] = v1; }
                    else { u32x4 w; w.x = cvt_pk_bf16(v0[0], v0[1]); w.y = cvt_pk_bf16(v0[2], v0[3]); w.z = cvt_pk_bf16(v1[0], v1[1]); w.w = cvt_pk_bf16(v1[2], v1[3]);
                        *(u32x4*)(O + r * ldc + col0 + bj * HALF) = w; } }
        }
    }
};


struct S5aSched {
    int G, c; const bf16_t* Zb; const bf16_t* Bt1;
    __device__ bool next(int i, Unit& u) const { const int L = i * G + c; if (L >= 512) return false; u.br = L >> 4; u.pm = (L & 15) >> 1; u.pn = L & 1; return true; }
    __device__ const char* Ap(const Unit& u) const { return (const char*)(Zb + (size_t)u.pm * T * ZLD + SU + 16 * u.br); }
    __device__ const char* Bp(const Unit& u) const { return (const char*)(Bt1 + ((size_t)u.br * 384 + (size_t)u.pn * 256) * 256); }
};
struct EpiS5a {
    static constexpr bool PERM = true;
    float* EX; bf16_t* YP;
    __device__ __forceinline__ bool keep(const Unit&) const { return false; }
    __device__ __forceinline__ void operator()(f32x4 (&acc)[2][2][4][2], const Unit& u, int wr, int wc, int fr, int fq) const {
        const int rowbase = u.br * 2048 + u.pm * 256 + wr * 64 + fr, colsub = wc * 32 + 8 * fq;
#pragma unroll
        for (int ai = 0; ai < 2; ++ai)
#pragma unroll
            for (int m = 0; m < 4; ++m) { const size_t R = (size_t)(rowbase + ai * HALF + m * 16);
                if (u.pn == 0) {
                    *(f32x4*)(EX + R * 128 + colsub) = acc[ai][0][m][0]; *(f32x4*)(EX + R * 128 + colsub + 4) = acc[ai][0][m][1];
                    const f32x4 v0 = acc[ai][1][m][0], v1 = acc[ai][1][m][1];
                    u32x4 w; w.x = cvt_pk_bf16(v0[0], v0[1]); w.y = cvt_pk_bf16(v0[2], v0[3]); w.z = cvt_pk_bf16(v1[0], v1[1]); w.w = cvt_pk_bf16(v1[2], v1[3]);
                    *(u32x4*)(YP + R * 256 + colsub) = w;
                } else {
                    const f32x4 v0 = acc[ai][0][m][0], v1 = acc[ai][0][m][1];
                    u32x4 w; w.x = cvt_pk_bf16(v0[0], v0[1]); w.y = cvt_pk_bf16(v0[2], v0[3]); w.z = cvt_pk_bf16(v1[0], v1[1]); w.w = cvt_pk_bf16(v1[2], v1[3]);
                    *(u32x4*)(YP + R * 256 + 128 + colsub) = w;
                } }
    }
};
struct S5bSched {
    int G, c; const bf16_t* X; const bf16_t* Bt3;
    __device__ bool next(int i, Unit& u) const { const int L = i * G + c; if (L >= 256) return false; u.br = L >> 3; u.pm = L & 7; u.pn = 0; return true; }
    __device__ const char* Ap(const Unit& u) const { return (const char*)(X + (size_t)(u.br * 2048 + u.pm * 256) * 256); }
    __device__ const char* Bp(const Unit& u) const { return (const char*)(Bt3 + (size_t)u.br * 256 * 256); }
};
struct EpiS5b {
    static constexpr bool PERM = true;
    const bf16_t* YP; bf16_t* Zb; const float* dsk;
    __device__ __forceinline__ bool keep(const Unit&) const { return false; }
    __device__ __forceinline__ void operator()(f32x4 (&acc)[2][2][4][2], const Unit& u, int wr, int wc, int fr, int fq) const {
        const int g = u.br, b = u.pm;
#pragma unroll
        for (int bj = 0; bj < 2; ++bj) {
            const int j0 = bj * HALF + wc * 32 + 8 * fq, s = j0 >> 4, c0 = j0 & 15;
            const f32x4 d0 = *(const f32x4*)(dsk + 16 * g + c0), d1 = *(const f32x4*)(dsk + 16 * g + c0 + 4);
#pragma unroll
            for (int ai = 0; ai < 2; ++ai)
#pragma unroll
                for (int m = 0; m < 4; ++m) {
                    const int n = ai * HALF + wr * 64 + m * 16 + fr;
                    const size_t R = (size_t)(g * 2048 + b * 256 + n);
                    const u32x4 yp = *(const u32x4*)(YP + R * 256 + j0);
                    bf16_t* zp = Zb + ((size_t)b * T + 16 * n + s) * ZLD + SU + 16 * g + c0;
                    const u32x4 uu = *(const u32x4*)zp;
                    const f32x4 a0 = acc[ai][bj][m][0], a1 = acc[ai][bj][m][1];
                    float y[8];
                    y[0] = a0[0] + bflo(yp.x) + d0[0] * bflo(uu.x); y[1] = a0[1] + bfhi(yp.x) + d0[1] * bfhi(uu.x);
                    y[2] = a0[2] + bflo(yp.y) + d0[2] * bflo(uu.y); y[3] = a0[3] + bfhi(yp.y) + d0[3] * bfhi(uu.y);
                    y[4] = a1[0] + bflo(yp.z) + d1[0] * bflo(uu.z); y[5] = a1[1] + bfhi(yp.z) + d1[1] * bfhi(uu.z);
                    y[6] = a1[2] + bflo(yp.w) + d1[2] * bflo(uu.w); y[7] = a1[3] + bfhi(yp.w) + d1[3] * bfhi(uu.w);
#pragma unroll
                    for (int e = 0; e < 8; ++e) { const float v = y[e]; y[e] = v * fsigmoid(1.5957691216057308f * (v + 0.044715f * v * v * v)); }
                    u32x4 w; w.x = cvt_pk_bf16(y[0], y[1]); w.y = cvt_pk_bf16(y[2], y[3]); w.z = cvt_pk_bf16(y[4], y[5]); w.w = cvt_pk_bf16(y[6], y[7]);
                    *(u32x4*)zp = w;
                    if (m & 1) asm volatile("" ::: "memory");
                }
        }
    }
};

template <class Epi, class Sched, bool ALIGN_EPI, bool SP2, int AMODE = 0>
__device__ __forceinline__ void gemm_phase(LAS unsigned char* lds, const int wv, const int lda, const int K, const Sched& S, const Epi& E) {
    int tid_ = hw_tid(wv); asm volatile("" : "+v"(tid_));
    const int tid = tid_, wid = __builtin_amdgcn_readfirstlane(tid >> 6), lane = tid & 63, wr = wid >> 2, wc = wid & 3, fr = lane & 15, fq = lane >> 4;
    const int nt = K / BK;
    unsigned voffA[2], voffB[2];
#pragma unroll
    for (int i = 0; i < 2; ++i) { int R, C; stage_rc(tid * 16 + i * 8192, R, C); const int Rb = Epi::PERM ? ((R & ~31) + perm32(R & 31)) : R;
        voffA[i] = AMODE == 0 ? (unsigned)(R * lda + C) * 2u : (unsigned)((16 * R + (C >> 4)) * ZLD + (C & 15)) * 2u; voffB[i] = (unsigned)(Rb * K + C) * 2u; }
    const size_t kstep = (size_t)(BK * 2);
    const size_t kstepA = AMODE == 0 ? (size_t)(BK * 2) : (size_t)4 * ZLD * 2;
    const size_t hA = AMODE == 0 ? (size_t)HALF * lda * 2 : (size_t)HALF * 16 * ZLD * 2, hB = (size_t)HALF * K * 2;
    const unsigned ldsw = (unsigned)wid * 1024u;
    const int aoff = lds_byte(wr * 64 + fr, fq * 8), boff = lds_byte(wc * 32 + fr, fq * 8);
#define PG8_SA(b, h) (((b) * 2 + (h)) * HTB)
#define PG8_SB(b, h) ((4 + (b) * 2 + (h)) * HTB)
#define PG8_STAGE(bufoff, gbase, voff) do { _Pragma("unroll") for (int _i = 0; _i < 2; ++_i) \
        __builtin_amdgcn_global_load_lds((const unsigned*)((const char*)(gbase) + (voff)[_i]), (LAS unsigned*)(lds + (bufoff) + ldsw + _i * 8192), 16, 0, 0); } while (0)
#define PG8_LDA(dst, b, h) do { _Pragma("unroll") for (int m = 0; m < 4; ++m) _Pragma("unroll") for (int k = 0; k < 2; ++k) dst[m][k] = *(const LAS bf16x8*)(lds + PG8_SA(b, h) + aoff + m * 2048 + k * 1024); } while (0)
#define PG8_LDB(dst, b, h) do { _Pragma("unroll") for (int n = 0; n < 2; ++n) _Pragma("unroll") for (int k = 0; k < 2; ++k) dst[n][k] = *(const LAS bf16x8*)(lds + PG8_SB(b, h) + boff + n * 2048 + k * 1024); } while (0)
#define PG8_MMA(ai, bj, At, Bt) do { __builtin_amdgcn_s_setprio(1); _Pragma("unroll") for (int m = 0; m < 4; ++m) _Pragma("unroll") for (int n = 0; n < 2; ++n) _Pragma("unroll") for (int k = 0; k < 2; ++k) \
        acc[ai][bj][m][n] = __builtin_amdgcn_mfma_f32_16x16x32_bf16(Bt[n][k], At[m][k], acc[ai][bj][m][n], 0, 0, 0); __builtin_amdgcn_s_setprio(0); } while (0)
#define PG8_WAIT_V(n) asm volatile("s_waitcnt vmcnt(" #n ")" ::: "memory")
#define PG8_WAIT_L(n) asm volatile("s_waitcnt lgkmcnt(" #n ")" ::: "memory")
#define PG8_BAR __builtin_amdgcn_s_barrier()
#define PG8_SCHED __builtin_amdgcn_sched_barrier(0)
    Unit cur, nxt; int ui = 0;
    if (!S.next(0, cur)) return;
    f32x4 acc[2][2][4][2];
#pragma unroll
    for (int a = 0; a < 2; ++a)
#pragma unroll
        for (int b = 0; b < 2; ++b)
#pragma unroll
            for (int m = 0; m < 4; ++m)
#pragma unroll
                for (int n = 0; n < 2; ++n) acc[a][b][m][n] = (f32x4){0.f, 0.f, 0.f, 0.f};
    bf16x8 At[4][2], B0[2][2], B1[2][2];
    const char* cA = S.Ap(cur); const char* cB = S.Bp(cur);
    if constexpr (SP2) {
        PG8_STAGE(PG8_SB(0, 0), cB, voffB); PG8_STAGE(PG8_SB(0, 1), cB + hB, voffB); PG8_STAGE(PG8_SA(0, 0), cA, voffA); PG8_STAGE(PG8_SA(0, 1), cA + hA, voffA);
        if (wr == 1) PG8_BAR;
        PG8_WAIT_V(2); PG8_BAR;
        PG8_STAGE(PG8_SB(1, 0), cB + kstep, voffB); PG8_STAGE(PG8_SA(1, 0), cA + kstepA, voffA); PG8_STAGE(PG8_SB(1, 1), cB + hB + kstep, voffB);
        PG8_WAIT_V(6); PG8_BAR;
    } else {
        PG8_STAGE(PG8_SB(0, 0), cB, voffB); PG8_STAGE(PG8_SA(0, 0), cA, voffA); PG8_STAGE(PG8_SB(0, 1), cB + hB, voffB); PG8_STAGE(PG8_SA(0, 1), cA + hA, voffA);
        if (wr == 1) PG8_BAR;
        PG8_WAIT_V(4); PG8_BAR;
        PG8_STAGE(PG8_SB(1, 0), cB + kstep, voffB); PG8_STAGE(PG8_SA(1, 0), cA + kstepA, voffA); PG8_STAGE(PG8_SB(1, 1), cB + hB + kstep, voffB);
        PG8_WAIT_V(6); PG8_BAR;
    }
    for (;;) {
        const bool has_next = S.next(ui + 1, nxt);
        const char* nA = has_next ? S.Ap(nxt) : cA; const char* nB = has_next ? S.Bp(nxt) : cB;
        for (int t = 0; t < nt; t += 2) {
            const bool last = (t == nt - 2);
            const char* a1 = cA + (size_t)(t + 1) * kstepA;
            const char* a2 = last ? nA : cA + (size_t)(t + 2) * kstepA; const char* b2 = last ? nB : cB + (size_t)(t + 2) * kstep;
            const char* a3 = a2 + kstepA; const char* b3 = b2 + kstep;
            if constexpr (SP2) {
            PG8_LDB(B0, 0, 0); PG8_LDB(B1, 0, 1); PG8_SCHED; PG8_LDA(At, 0, 0); PG8_STAGE(PG8_SA(1, 1), a1 + hA, voffA);
            PG8_WAIT_V(8); PG8_WAIT_L(0); PG8_BAR; PG8_MMA(0, 0, At, B0); PG8_MMA(0, 1, At, B1); PG8_BAR; PG8_SCHED;
            PG8_LDA(At, 0, 1); PG8_STAGE(PG8_SB(0, 0), b2, voffB); PG8_STAGE(PG8_SB(0, 1), b2 + hB, voffB); PG8_STAGE(PG8_SA(0, 0), a2, voffA);
            PG8_WAIT_V(8); PG8_WAIT_L(0); PG8_BAR; PG8_MMA(1, 0, At, B0); PG8_MMA(1, 1, At, B1); PG8_BAR; PG8_SCHED;
            PG8_LDB(B0, 1, 0); PG8_LDB(B1, 1, 1); PG8_SCHED; PG8_LDA(At, 1, 0); PG8_STAGE(PG8_SA(0, 1), a2 + hA, voffA);
            PG8_WAIT_V(8); PG8_WAIT_L(0); PG8_BAR; PG8_MMA(0, 0, At, B0); PG8_MMA(0, 1, At, B1); PG8_BAR; PG8_SCHED;
            PG8_LDA(At, 1, 1); PG8_STAGE(PG8_SB(1, 0), b3, voffB); PG8_STAGE(PG8_SB(1, 1), b3 + hB, voffB); PG8_STAGE(PG8_SA(1, 0), a3, voffA);
            PG8_WAIT_V(8); PG8_WAIT_L(0); PG8_BAR; PG8_MMA(1, 0, At, B0); PG8_MMA(1, 1, At, B1); PG8_BAR; PG8_SCHED;
            } else {
            PG8_LDB(B0, 0, 0); PG8_SCHED; PG8_LDA(At, 0, 0); PG8_STAGE(PG8_SA(1, 1), a1 + hA, voffA);
            PG8_WAIT_L(8); PG8_BAR; PG8_WAIT_L(0); PG8_MMA(0, 0, At, B0); PG8_BAR; PG8_SCHED;
            PG8_LDB(B1, 0, 1); PG8_STAGE(PG8_SB(0, 0), b2, voffB);
            PG8_BAR; PG8_WAIT_L(0); PG8_MMA(0, 1, At, B1); PG8_BAR;
            PG8_LDA(At, 0, 1); PG8_STAGE(PG8_SA(0, 0), a2, voffA);
            PG8_BAR; PG8_WAIT_L(0); PG8_MMA(1, 0, At, B0); PG8_BAR; PG8_SCHED;
            PG8_STAGE(PG8_SB(0, 1), b2 + hB, voffB);
            PG8_WAIT_V(6); PG8_BAR; PG8_MMA(1, 1, At, B1); PG8_BAR;
            PG8_LDB(B0, 1, 0); PG8_SCHED; PG8_LDA(At, 1, 0); PG8_STAGE(PG8_SA(0, 1), a2 + hA, voffA);
            PG8_WAIT_L(8); PG8_BAR; PG8_WAIT_L(0); PG8_MMA(0, 0, At, B0); PG8_BAR; PG8_SCHED;
            PG8_LDB(B1, 1, 1); PG8_STAGE(PG8_SB(1, 0), b3, voffB);
            PG8_BAR; PG8_WAIT_L(0); PG8_MMA(0, 1, At, B1); PG8_BAR;
            PG8_LDA(At, 1, 1); PG8_STAGE(PG8_SA(1, 0), a3, voffA);
            PG8_BAR; PG8_WAIT_L(0); PG8_MMA(1, 0, At, B0); PG8_BAR; PG8_SCHED;
            PG8_STAGE(PG8_SB(1, 1), b3 + hB, voffB);
            PG8_WAIT_V(6); PG8_BAR; PG8_MMA(1, 1, At, B1); PG8_BAR;
            }
        }
        if constexpr (ALIGN_EPI) { if (wr == 0) PG8_BAR; }
        { const int lane_e = hw_lane();
          E(acc, cur, wr, wc, lane_e & 15, lane_e >> 4); }
        if (!has_next) break;
        if (!E.keep(cur)) {
#pragma unroll
        for (int a = 0; a < 2; ++a)
#pragma unroll
            for (int b = 0; b < 2; ++b)
#pragma unroll
                for (int m = 0; m < 4; ++m)
#pragma unroll
                    for (int n = 0; n < 2; ++n) acc[a][b][m][n] = (f32x4){0.f, 0.f, 0.f, 0.f};
        }
        cur = nxt; cA = nA; cB = nB; ++ui;
        if constexpr (ALIGN_EPI) { if (wr == 1) PG8_BAR; }
    }
    PG8_WAIT_V(0);
    if constexpr (!ALIGN_EPI) { if (wr == 0) PG8_BAR; }
    PG8_BAR;
#undef PG8_SA
#undef PG8_SB
#undef PG8_STAGE
#undef PG8_LDA
#undef PG8_LDB
#undef PG8_MMA
#undef PG8_WAIT_V
#undef PG8_WAIT_L
#undef PG8_BAR
#undef PG8_SCHED
}
}

#define XB_TMO      128
#define XB_XCNT(j)  (256  + 64 * (j))
#define XB_XSUB(j)  (1280 + 64 * (j))
#define XB_XGEN(j)  (2304 + 64 * (j))
#define XB_TOP      3328
#define XB_TOPGEN   3392
#define XCD_BAR_WORDS 3456
#define XB_SPIN_CAP (1u << 18)
__device__ __forceinline__ unsigned xb_ld(unsigned* p)              { return __hip_atomic_load(p, __ATOMIC_RELAXED, __HIP_MEMORY_SCOPE_AGENT); }
__device__ __forceinline__ unsigned xb_add(unsigned* p, unsigned v) { return __hip_atomic_fetch_add(p, v, __ATOMIC_RELAXED, __HIP_MEMORY_SCOPE_AGENT); }
__device__ __forceinline__ unsigned xb_xcc_id() { return (unsigned)__builtin_amdgcn_s_getreg((3 << 11) | 20) & 0xFu; }
#define XB_SPIN(cond, bar) do { unsigned _sp = 0; while (cond) { __builtin_amdgcn_s_sleep(1); \
    if ((++_sp & 255u) == 0u) { if (xb_ld(&(bar)[XB_TMO])) break; if (_sp > XB_SPIN_CAP) { atomicAdd(&(bar)[XB_TMO], 1u); break; } } } } while (0)
struct XcdBarrier { unsigned* bar; unsigned x; volatile LAS unsigned* st; };
__device__ __forceinline__ XcdBarrier xcd_barrier_post(unsigned* bar, volatile LAS unsigned* st) {
    XcdBarrier b; b.bar = bar; b.x = xb_xcc_id(); b.st = st;
    if (threadIdx.x == 0) (void)xb_add(&bar[XB_XCNT(b.x)], 1u);
    return b;
}
__device__ __forceinline__ void xcd_barrier_complete(unsigned* bar, unsigned x, unsigned& nloc, unsigned& nx) {
    const unsigned G = gridDim.x * gridDim.y * gridDim.z;
    unsigned sum, cnt, mine, sp = 0u;
    for (;;) {
        sum = 0u; cnt = 0u; mine = 0u;
#pragma unroll
        for (unsigned j = 0; j < 16; ++j) { const unsigned c = xb_ld(&bar[XB_XCNT(j)]); sum += c; cnt += (c > 0u) ? 1u : 0u; mine = (j == x) ? c : mine; }
        if (sum == G) break;
        __builtin_amdgcn_s_sleep(1);
        if ((++sp & 255u) == 0u) { if (xb_ld(&bar[XB_TMO])) break; if (sp > XB_SPIN_CAP) { atomicAdd(&bar[XB_TMO], 1u); break; } }
    }
    nloc = mine > 0u ? mine : 1u; nx = cnt > 0u ? cnt : 1u;
}
__device__ __forceinline__ void xcd_barrier(const XcdBarrier& b, const int wv) {
    asm volatile("s_waitcnt vmcnt(0)" ::: "memory");
    __syncthreads();
    if (wv == 0 && hw_lane() == 0) {
        unsigned* bar = b.bar;
        __builtin_amdgcn_s_waitcnt(0);
        unsigned nloc = b.st[0], nx = b.st[1];
        if (nloc == 0u) { xcd_barrier_complete(bar, b.x, nloc, nx); b.st[0] = nloc; b.st[1] = nx; }
        const unsigned old = xb_add(&bar[XB_XSUB(b.x)], 1u);
        const unsigned gen = old / nloc;
        if (old + 1u == (gen + 1u) * nloc) {
            __builtin_amdgcn_fence(__ATOMIC_RELEASE, "agent");
            asm volatile("s_waitcnt vmcnt(0)" ::: "memory");
            const unsigned og = xb_add(&bar[XB_TOP], 1u);
            const unsigned tg = og / nx;
            if (og + 1u == (tg + 1u) * nx) xb_add(&bar[XB_TOPGEN], 1u);
            else XB_SPIN(xb_ld(&bar[XB_TOPGEN]) == tg, bar);
            __builtin_amdgcn_fence(__ATOMIC_ACQUIRE, "agent");
            xb_add(&bar[XB_XGEN(b.x)], 1u);
            asm volatile("s_waitcnt vmcnt(0)" ::: "memory");
        } else {
            XB_SPIN(xb_ld(&bar[XB_XGEN(b.x)]) == gen, bar);
            __builtin_amdgcn_fence(__ATOMIC_ACQUIRE, "agent");
            asm volatile("s_waitcnt vmcnt(0)" ::: "memory");
        }
    }
    __syncthreads();
}

struct Args { const float* in[33]; float* out; unsigned char* ws; };
__device__ __forceinline__ const float* inp(int i) {
    unsigned off = (unsigned)i * 8u; asm volatile("" : "+s"(off));
    typedef const float* cfp;
    return *(const __attribute__((address_space(4))) cfp*)((const __attribute__((address_space(4))) char*)__builtin_amdgcn_kernarg_segment_ptr() + off);
}

#define WSP(off) (inp_ws() + (off))
__device__ __forceinline__ unsigned char* inp_ws() { return (unsigned char*)inp(34); }
__device__ __forceinline__ float* inp_out() { return (float*)inp(33); }

__device__ __forceinline__ void transpose_item(const float* W, int ldw, int K, bf16_t* WT, int src_n0, int dst_n0, int k0, LAS float* scr, int lane) {
#pragma unroll 8
    for (int i = 0; i < 32; ++i) { const int kk = 2 * i + (lane >> 5); scr[kk * 33 + (lane & 31)] = W[(size_t)(k0 + kk) * ldw + src_n0 + (lane & 31)]; }
    LDS_WAIT(); asm volatile("" ::: "memory");
    const int c = lane & 7;
#pragma unroll
    for (int j = 0; j < 4; ++j) { const int n = (lane >> 3) + 8 * j; const LAS float* s = scr + (8 * c) * 33 + n;
        u32x4 o; o.x = pk2(s[0 * 33], s[1 * 33]); o.y = pk2(s[2 * 33], s[3 * 33]); o.z = pk2(s[4 * 33], s[5 * 33]); o.w = pk2(s[6 * 33], s[7 * 33]);
        *(u32x4*)(WT + (size_t)(dst_n0 + n) * K + k0 + 8 * c) = o; }
    LDS_WAIT(); asm volatile("" ::: "memory");
}
template <int MAP>
__device__ __forceinline__ void convert_matrix(const float* W, int ldw, int K, int Ndst, bf16_t* WT, LAS float* scr, int lane, int gw, int NGW, int& base) {
    const int nblk = Ndst / 32, nitems = (K / 64) * nblk;
    int first = (gw - base % NGW + NGW) % NGW;
    for (int it = first; it < nitems; it += NGW) {
        const int kb = it / nblk, nb = it % nblk, d0 = nb * 32;
        int s0 = d0;
        if (MAP == 1) s0 = d0 + (d0 < 1024 ? 0 : (d0 < 2560 ? 16 : 24));
        if (MAP == 2) { const int pn = d0 >> 8, hh = (d0 & 255) >> 7, r = d0 & 127; s0 = hh * FF + pn * 128 + r; }
        transpose_item(W, ldw, K, WT, s0, d0, kb * 64, scr, lane);
    }
    base += nitems;
}

__device__ __forceinline__ void ada_phase(LAS unsigned char* lds, int blk, int wave, int lane) {
    if (blk >= 192) return;
    const int l = blk / 96, n0 = (blk % 96) * 64;
    const float* c = inp(1); const float* W = inp(2) + (size_t)l * 1024 * 6144; const float* bias = inp(3) + l * 6144;
    LAS float* part = (LAS float*)lds;
    float acc[8] = {0.f, 0.f, 0.f, 0.f, 0.f, 0.f, 0.f, 0.f};
    for (int k = wave * 128; k < wave * 128 + 128; ++k) {
        const float wv = W[(size_t)k * 6144 + n0 + lane];
#pragma unroll
        for (int b = 0; b < 8; ++b) { const float cv = c[b * 1024 + k]; acc[b] += siluf_(cv) * wv; }
    }
#pragma unroll
    for (int b = 0; b < 8; ++b) part[(wave * 8 + b) * 64 + lane] = acc[b];
    __syncthreads();
    {
        const int b = wave; float s = bias[n0 + lane];
#pragma unroll
        for (int w = 0; w < 8; ++w) s += part[(w * 8 + b) * 64 + lane];
        ((float*)WSP(WS_MOD))[(size_t)(l * 8 + b) * 6144 + n0 + lane] = s;
    }
    __syncthreads();
}

template <bool WITH_POST, bool WITH_PRE>
__device__ __forceinline__ void norm_rows(const bf16_t* Y, int ldy, const float* xin, const float* pw, const float* modl_post, int gt_off, float* xout,
                                          const float* w2, const float* modl_pre, int sh_off, int sc_off, bf16_t* H, int gw, int NGW, int lane) {
    f32x4 xc[2][4], xn[2][4]; u32x2 yc[2][4], yn[2][4];
#pragma unroll
    for (int q = 0; q < 2; ++q)
#pragma unroll
        for (int j = 0; j < 4; ++j) { xc[q][j] = *(const f32x4*)(xin + (size_t)(gw + q * NGW) * D + (lane + 64 * j) * 4);
            if (WITH_POST) yc[q][j] = *(const u32x2*)(Y + (size_t)(gw + q * NGW) * ldy + (lane + 64 * j) * 4); else yc[q][j] = (u32x2){0u, 0u}; xn[q][j] = xc[q][j]; yn[q][j] = yc[q][j]; }
    for (int row0 = gw; row0 < M; row0 += 2 * NGW) {
        const int rown = row0 + 2 * NGW;
        if (rown < M) {
#pragma unroll
            for (int q = 0; q < 2; ++q)
#pragma unroll
                for (int j = 0; j < 4; ++j) { xn[q][j] = *(const f32x4*)(xin + (size_t)(rown + q * NGW) * D + (lane + 64 * j) * 4);
                    if (WITH_POST) yn[q][j] = *(const u32x2*)(Y + (size_t)(rown + q * NGW) * ldy + (lane + 64 * j) * 4); }
        }
        f32x4 v[2][4];
        if (WITH_POST) {
            float ss[2] = {0.f, 0.f};
#pragma unroll
            for (int q = 0; q < 2; ++q)
#pragma unroll
                for (int j = 0; j < 4; ++j) { const u32x2 y = yc[q][j];
                    v[q][j] = (f32x4){bflo(y.x), bfhi(y.x), bflo(y.y), bfhi(y.y)}; ss[q] += v[q][j][0] * v[q][j][0] + v[q][j][1] * v[q][j][1] + v[q][j][2] * v[q][j][2] + v[q][j][3] * v[q][j][3]; }
#pragma unroll
            for (int o = 1; o < 64; o <<= 1) { const float t0 = shl(ss[0], lane ^ o), t1 = shl(ss[1], lane ^ o); ss[0] += t0; ss[1] += t1; }
#pragma unroll
            for (int q = 0; q < 2; ++q) {
                const int row = row0 + q * NGW, b = row / T;
                const float r = rsqrtf(ss[q] * (1.f / D) + 1e-6f);
                const float* gt = modl_post + (size_t)b * 6144 + gt_off;
#pragma unroll
                for (int j = 0; j < 4; ++j) {
                    const int col = (lane + 64 * j) * 4;
                    const f32x4 xo = xc[q][j], pwv = *(const f32x4*)(pw + col), gtv = *(const f32x4*)(gt + col);
#pragma unroll
                    for (int e = 0; e < 4; ++e) v[q][j][e] = xo[e] + (1.f + gtv[e]) * (v[q][j][e] * r * pwv[e]);
                    *(f32x4*)(xout + (size_t)row * D + col) = v[q][j];
                }
            }
        } else {
#pragma unroll
            for (int q = 0; q < 2; ++q)
#pragma unroll
                for (int j = 0; j < 4; ++j) v[q][j] = xc[q][j];
        }
        if (WITH_PRE) {
            float ss[2] = {0.f, 0.f};
#pragma unroll
            for (int q = 0; q < 2; ++q)
#pragma unroll
                for (int j = 0; j < 4; ++j) ss[q] += v[q][j][0] * v[q][j][0] + v[q][j][1] * v[q][j][1] + v[q][j][2] * v[q][j][2] + v[q][j][3] * v[q][j][3];
#pragma unroll
            for (int o = 1; o < 64; o <<= 1) { const float t0 = shl(ss[0], lane ^ o), t1 = shl(ss[1], lane ^ o); ss[0] += t0; ss[1] += t1; }
#pragma unroll
            for (int q = 0; q < 2; ++q) {
                const int row = row0 + q * NGW, b = row / T;
                const float r2 = rsqrtf(ss[q] * (1.f / D) + 1e-6f);
                const float* sh = modl_pre + (size_t)b * 6144 + sh_off; const float* sc = modl_pre + (size_t)b * 6144 + sc_off;
#pragma unroll
                for (int j = 0; j < 4; ++j) {
                    const int col = (lane + 64 * j) * 4;
                    const f32x4 wv = *(const f32x4*)(w2 + col), scv = *(const f32x4*)(sc + col), shv = *(const f32x4*)(sh + col);
#pragma unroll
                    for (int e = 0; e < 4; ++e) v[q][j][e] = v[q][j][e] * r2 * wv[e] * (1.f + scv[e]) + shv[e];
                    u32x2 o; o.x = pk2(v[q][j][0], v[q][j][1]); o.y = pk2(v[q][j][2], v[q][j][3]);
                    *(u32x2*)(H + (size_t)row * D + col) = o;
                }
            }
        }
#pragma unroll
        for (int q = 0; q < 2; ++q)
#pragma unroll
            for (int j = 0; j < 4; ++j) { xc[q][j] = xn[q][j]; yc[q][j] = yn[q][j]; }
    }
}
__device__ __forceinline__ void zs_mfma(const bf16_t* H, const bf16_t* Wsm, float* ZS, int task, int lane) {
    typedef float f32x16_ __attribute__((ext_vector_type(16)));
    const int r32 = lane & 31, hh = lane >> 5;
    const bf16_t* ap = H + (size_t)(32 * task + r32) * D + 8 * hh;
    const bf16_t* bp = Wsm + (size_t)r32 * D + 8 * hh;
    f32x16_ acc;
#pragma unroll
    for (int r = 0; r < 16; ++r) acc[r] = 0.f;
#pragma unroll 8
    for (int ks = 0; ks < D / 16; ++ks) acc = __builtin_amdgcn_mfma_f32_32x32x16_bf16(*(const bf16x8*)(ap + 16 * ks), *(const bf16x8*)(bp + 16 * ks), acc, 0, 0, 0);
    if (r32 < 24) {
#pragma unroll
        for (int r = 0; r < 16; ++r) ZS[(size_t)(32 * task + (r & 3) + 8 * (r >> 2) + 4 * hh) * 32 + r32] = acc[r];
    }
}
__device__ __forceinline__ void convert_small(const float* w_in, bf16_t* Wsm, int part, int tid) {
    for (int i = tid; i < 4 * 1024; i += NWAVES * 64) {
        const int c = 4 * part + (i >> 10), k = i & 1023;
        float v = 0.f;
        if (c < 16) v = w_in[(size_t)k * INDIM + 1024 + c]; else if (c < 24) v = w_in[(size_t)k * INDIM + 2576 + (c - 16)];
        Wsm[c * 1024 + k] = (bf16_t)f2bf(v);
    }
}

__device__ __forceinline__ void s5_generate(int l, int g, LAS unsigned char* lds, int wv) {
    int tid = hw_tid(wv); asm volatile("" : "+v"(tid));
    LAS float* ar = (LAS float*)lds;
    LAS float* ai = ar + 17 * 64;
    LAS float* bbr = ai + 17 * 64;
    LAS float* bbi = bbr + 1024;
    LAS float* cr = bbi + 1024;
    LAS float* ci = cr + 1024;
    LAS float* Kt = ci + 1024;
    bf16_t* Bt1 = (bf16_t*)WSP(WS_S5M1) + (size_t)g * 384 * 256;
    bf16_t* Bt3 = (bf16_t*)WSP(WS_S5M3) + (size_t)g * 256 * 256;
    __syncthreads();
    if (tid < 64) {
        const int p = tid;
        const float lre = fminf((inp(16) + l * 2048)[g * 64 + p], -1e-4f), lim = (inp(17) + l * 2048)[g * 64 + p], dt = expf((inp(18) + l * 32)[g]);
        for (int k = 0; k <= 16; ++k) { const float mg = expf((float)k * lre * dt), an = (float)k * lim * dt; ar[k * 64 + p] = mg * cosf(an); ai[k * 64 + p] = mg * sinf(an); }
        const float a1r = ar[64 + p], a1i = ai[64 + p];
        const float inv = 1.f / (lre * lre + lim * lim);
        const float zr_ = ((a1r - 1.f) * lre + a1i * lim) * inv, zi_ = (a1i * lre - (a1r - 1.f) * lim) * inv;
        const float* b_re = inp(19) + (size_t)l * 32768 + (size_t)(g * 64 + p) * 16; const float* b_im = inp(20) + (size_t)l * 32768 + (size_t)(g * 64 + p) * 16;
        for (int c = 0; c < 16; ++c) { const float br = b_re[c], bi = b_im[c]; bbr[p * 16 + c] = zr_ * br - zi_ * bi; bbi[p * 16 + c] = zr_ * bi + zi_ * br; }
    }
    for (int i = tid; i < 1024; i += 512) { cr[i] = (inp(21) + (size_t)l * 32768)[g * 1024 + i]; ci[i] = (inp(22) + (size_t)l * 32768)[g * 1024 + i]; }
    __syncthreads();
    {
        const int cp = tid >> 5, c = (tid >> 1) & 15, ph = tid & 1;
        float acc[16];
#pragma unroll
        for (int t = 0; t < 16; ++t) acc[t] = 0.f;
        for (int pp = 0; pp < 32; ++pp) {
            const int p = 32 * ph + pp;
            const float xr = cr[cp * 64 + p], xi = ci[cp * 64 + p], yr = bbr[p * 16 + c], yi = bbi[p * 16 + c];
            const float cbr = xr * yr - xi * yi, cbi = xr * yi + xi * yr;
#pragma unroll
            for (int t = 0; t < 16; ++t) acc[t] += cbr * ar[t * 64 + p] - cbi * ai[t * 64 + p];
        }
#pragma unroll
        for (int t = 0; t < 16; ++t) { const float o = acc[t] + shl(acc[t], (tid & 63) ^ 1); if (ph == 0) Kt[(t * 16 + cp) * 16 + c] = o; }
    }
    __syncthreads();
    for (int pc = tid; pc < 128 * 32; pc += 512) {
        const int row = pc >> 5, k0 = (pc & 31) * 8, sp = k0 >> 4, c0 = k0 & 15, p = row & 63, e15 = 15 - sp;
        const float xr = ar[e15 * 64 + p], xi = ai[e15 * 64 + p];
        float v[8];
#pragma unroll
        for (int e = 0; e < 8; ++e) { const float yr = bbr[p * 16 + c0 + e], yi = bbi[p * 16 + c0 + e]; v[e] = row < 64 ? (xr * yr - xi * yi) : (xr * yi + xi * yr); }
        u32x4 w; w.x = pk2(v[0], v[1]); w.y = pk2(v[2], v[3]); w.z = pk2(v[4], v[5]); w.w = pk2(v[6], v[7]);
        *(u32x4*)(Bt1 + (size_t)row * 256 + k0) = w;
    }
    for (int pc = tid; pc < 256 * 32; pc += 512) {
        const int j = pc >> 5, k0 = (pc & 31) * 8, s = j >> 4, cp = j & 15, sp = k0 >> 4, c0 = k0 & 15;
        float v[8];
#pragma unroll
        for (int e = 0; e < 8; ++e) v[e] = (sp <= s) ? Kt[((s - sp) * 16 + cp) * 16 + c0 + e] : 0.f;
        u32x4 w; w.x = pk2(v[0], v[1]); w.y = pk2(v[2], v[3]); w.z = pk2(v[4], v[5]); w.w = pk2(v[6], v[7]);
        *(u32x4*)(Bt1 + (size_t)(128 + j) * 256 + k0) = w;
    }
    for (int pc = tid; pc < 256 * 32; pc += 512) {
        const int j = pc >> 5, k0 = (pc & 31) * 8, s = j >> 4, cp = j & 15;
        float v[8];
#pragma unroll
        for (int e = 0; e < 8; ++e) {
            const int k = k0 + e, p = k & 63;
            const float xr = cr[cp * 64 + p], xi = ci[cp * 64 + p], yr = ar[(s + 1) * 64 + p], yi = ai[(s + 1) * 64 + p];
            v[e] = k < 64 ? (xr * yr - xi * yi) : (k < 128 ? -(xr * yi + xi * yr) : 0.f);
        }
        u32x4 w; w.x = pk2(v[0], v[1]); w.y = pk2(v[2], v[3]); w.z = pk2(v[4], v[5]); w.w = pk2(v[6], v[7]);
        *(u32x4*)(Bt3 + (size_t)j * 256 + k0) = w;
    }
    __syncthreads();
}
__device__ __forceinline__ void s5_scan(int l, int sid, int lane) {
    const int g = sid >> 3, b = sid & 7, p = lane;
    const float lre = fminf((inp(16) + l * 2048)[g * 64 + p], -1e-4f), lim = (inp(17) + l * 2048)[g * 64 + p], dt = expf((inp(18) + l * 32)[g]);
    const float mg = expf(16.f * lre * dt), an = 16.f * lim * dt, a16r = mg * cosf(an), a16i = mg * sinf(an);
    float* base = (float*)WSP(WS_EX) + (size_t)(g * 2048 + b * 256) * 128;
    float xr = 0.f, xi = 0.f;
    float er[8], ei[8], nr[8], ni[8];
#pragma unroll
    for (int j = 0; j < 8; ++j) { er[j] = base[(size_t)j * 128 + p]; ei[j] = base[(size_t)j * 128 + 64 + p]; }
#pragma unroll 1
    for (int n0 = 0; n0 < 256; n0 += 8) {
        if (n0 + 8 < 256) {
#pragma unroll
            for (int j = 0; j < 8; ++j) { nr[j] = base[(size_t)(n0 + 8 + j) * 128 + p]; ni[j] = base[(size_t)(n0 + 8 + j) * 128 + 64 + p]; }
        }
        asm volatile("s_waitcnt vmcnt(16)" ::: "memory");
#pragma unroll
        for (int j = 0; j < 8; ++j) {
            bf16_t* row = (bf16_t*)(base + (size_t)(n0 + j) * 128);
            row[p] = (bf16_t)f2bf(xr); row[64 + p] = (bf16_t)f2bf(xi); ((unsigned*)row)[64 + p] = 0u;
            const float tr = a16r * xr - a16i * xi + er[j], ti = a16r * xi + a16i * xr + ei[j];
            xr = tr; xi = ti;
        }
#pragma unroll
        for (int j = 0; j < 8; ++j) { er[j] = nr[j]; ei[j] = ni[j]; }
    }
}

namespace mx {
typedef float f32x16 __attribute__((ext_vector_type(16)));
__device__ __forceinline__ unsigned cpk(float lo, float hi) { return pg8::cvt_pk_bf16(lo, hi); }
__device__ __forceinline__ unsigned cpk1(float x) { return pg8::cvt_pk_bf16(x, x); }
constexpr int PB = 72;
constexpr int L_QS = 0, L_KS = 9216, L_KT = 18432, L_VT = 27648, L_PS = 46080, L_ST = 55296, L_OS = 73728, L_VEC = 107520;
constexpr int OSP = 132;
constexpr int V_SEG = 0, V_ELAST = 512, V_GA = 576, V_SETS = 1600, SETSZ = 384, V_RT = 0, V_CS = 64, V_WI = 128, V_WK = 192, V_ENM = 256, V_SC = 320, V_DEN = 2368, V_NORM = 2432, V_END = 2560;
static_assert(L_VEC + V_END * 4 <= RING_BYTES, "mixer LDS map");
__device__ __forceinline__ int crow(int reg, int hh) { return (reg & 3) + 8 * (reg >> 2) + 4 * hh; }
__device__ __forceinline__ float fexp(float x) { return __builtin_amdgcn_exp2f(1.4426950408889634f * x); }
__device__ __forceinline__ float flogsig(float x) { const float e = fexp(-fabsf(x)); return fminf(x, 0.f) - 0.6931471805599453f * __builtin_amdgcn_logf(1.f + e); }
#define MX_MFMA(a, b, c) __builtin_amdgcn_mfma_f32_32x32x16_bf16((a), (b), (c), 0, 0, 0)

template <int ROLE, bool STORE = true>
__device__ __forceinline__ void stream(int l, LAS unsigned char* lds, int bh, int wvs) {
    int tid = hw_tid(wvs); asm volatile("" : "+v"(tid));
    const int lane = tid & 63, w = __builtin_amdgcn_readfirstlane(tid >> 6), r32 = lane & 31, hh = lane >> 5;
    const int b = bh >> 2, h = bh & 3;
    bf16_t* Z = (bf16_t*)WSP(WS_Z); const float* ZS = (const float*)WSP(WS_ZS);
    LAS float* vec = (LAS float*)(lds + L_VEC);
    LAS bf16_t* Qs = (LAS bf16_t*)(lds + L_QS); LAS bf16_t* Ks = (LAS bf16_t*)(lds + L_KS); LAS bf16_t* KTs = (LAS bf16_t*)(lds + L_KT);
    LAS bf16_t* VTs = (LAS bf16_t*)(lds + L_VT); LAS bf16_t* Ps = (LAS bf16_t*)(lds + L_PS); LAS bf16_t* STs = (LAS bf16_t*)(lds + L_ST);
    LAS float* Os = (LAS float*)(lds + L_OS);
    const int qcol = (ROLE == 0 ? GQ : MQ) + h * 64, kcol = (ROLE == 0 ? GK : MK) + h * 64, vcol = (ROLE == 0 ? GV : MV) + h * 128, gcol = (ROLE == 0 ? GR : MO) + h * 128;
    const int vc_ = tid & 127, rq = tid >> 7, et = tid >> 3, cg = tid & 7;
    const int wa = w >> 2, wv = w & 3;
    float a2c[16], abd = 0.f, nwv[16];
    float cwq[4], cwk[4], cbq = 0.f, cbk = 0.f, ibh = 0.f, fbh = 0.f, mprev = 0.f;
#pragma unroll
    for (int r = 0; r < 16; ++r) { a2c[r] = 0.f; nwv[r] = 0.f; }
#pragma unroll
    for (int j = 0; j < 4; ++j) { cwq[j] = 0.f; cwk[j] = 0.f; }
    if (ROLE == 0) {
        const float* a2 = inp(9) + l * 16 * 256; const float* ab = inp(10) + l * 256; const float* nw = inp(11) + l * 512;
#pragma unroll
        for (int r = 0; r < 16; ++r) { a2c[r] = a2[r * 256 + h * 64 + lane]; nwv[r] = nw[h * 128 + 16 * cg + r]; }
        abd = ab[h * 64 + lane];
    } else {
        const float* cw = inp(12) + l * 4 * 512; const float* cb = inp(13) + l * 512;
#pragma unroll
        for (int j = 0; j < 4; ++j) { cwq[j] = cw[j * 512 + h * 64 + lane]; cwk[j] = cw[j * 512 + 256 + h * 64 + lane]; }
        cbq = cb[h * 64 + lane]; cbk = cb[256 + h * 64 + lane];
        ibh = (inp(14) + l * 4)[h]; fbh = (inp(15) + l * 4)[h];
    }
    for (int i = tid; i < 128 * PB / 2; i += 512) ((LAS unsigned*)STs)[i] = 0u;
    for (int i = tid; i < 64 * PB / 2; i += 512) ((LAS unsigned*)Ps)[i] = 0u;
    if (tid < 128) vec[V_NORM + tid] = 0.f;
    f32x16 accS;
#pragma unroll
    for (int r = 0; r < 16; ++r) accS[r] = 0.f;
    unsigned qi[11], ki[11], vi[16]; float zs0 = 0.f, zs1 = 0.f; u32x4 gt0 = {0u, 0u, 0u, 0u}, gt1 = {0u, 0u, 0u, 0u};
#define MX_LOAD(mrow, nn) do { \
        if (ROLE == 0) { \
            _Pragma("unroll") for (int i = 0; i < 8; ++i) { const bf16_t* zr = Z + ((mrow) + 8 * w + i) * ZLD; qi[i] = *(const unsigned*)(zr + qcol + (lane & ~1)); ki[i] = *(const unsigned*)(zr + kcol + (lane & ~1)); } \
            const float* zp = ZS + ((mrow) + et) * 32 + 2 * cg; zs0 = zp[0]; zs1 = zp[1]; \
        } else { \
            _Pragma("unroll") for (int i = 0; i < 11; ++i) { const int trel = 8 * w + i - 3; const int trc = ((nn) > 0 || trel >= 0) ? trel : 0;     \
                const bf16_t* zr = Z + ((mrow) + trc) * ZLD; qi[i] = *(const unsigned*)(zr + qcol + (lane & ~1)); ki[i] = *(const unsigned*)(zr + kcol + (lane & ~1)); } \
            if (w == 7) { const float* zp = ZS + ((mrow) + lane) * 32; zs0 = zp[16 + h]; zs1 = zp[20 + h]; } \
        } \
        _Pragma("unroll") for (int i = 0; i < 16; ++i) vi[i] = *(const unsigned*)(Z + ((mrow) + 16 * rq + i) * ZLD + vcol + (vc_ & ~1)); \
    } while (0)
#define MX_SCALARS(sv) do { \
        asm volatile("" : "+v"(zs0), "+v"(zs1)); \
        const float ip = zs0 + ibh, lf = flogsig(zs1 + fbh); \
        float bs = lf; \
        _Pragma("unroll") for (int o = 1; o < 64; o <<= 1) { const float t = shl(bs, lane >= o ? lane - o : lane); if (lane >= o) bs += t; } \
        const float cs = ip - bs; \
        float pm = cs; \
        _Pragma("unroll") for (int o = 1; o < 64; o <<= 1) { const float t = shl(pm, lane >= o ? lane - o : lane); if (lane >= o) pm = fmaxf(pm, t); } \
        const float mt = bs + fmaxf(mprev, pm); \
        (sv)[V_RT + lane] = bs - mt; (sv)[V_CS + lane] = cs; (sv)[V_WI + lane] = fexp(bs + mprev - mt); (sv)[V_ENM + lane] = fexp(-mt); \
        const float mnew = shl(mt, 63), b63 = shl(bs, 63); \
        (sv)[V_WK + lane] = fexp(b63 + cs - mnew); \
        if (lane == 0) (sv)[V_SC] = fexp(b63 + mprev - mnew); \
        mprev = mnew; \
    } while (0)
#define MX_PIN11(a) asm volatile("" : "+v"(a[0]), "+v"(a[1]), "+v"(a[2]), "+v"(a[3]), "+v"(a[4]), "+v"(a[5]), "+v"(a[6]), "+v"(a[7]), "+v"(a[8]), "+v"(a[9]), "+v"(a[10]))
#define MX_PIN8(a, o) asm volatile("" : "+v"(a[o]), "+v"(a[o + 1]), "+v"(a[o + 2]), "+v"(a[o + 3]), "+v"(a[o + 4]), "+v"(a[o + 5]), "+v"(a[o + 6]), "+v"(a[o + 7]))
    size_t m0 = (size_t)b * T;
    MX_LOAD(m0, 0);
    if (ROLE == 0) { vec[V_GA + et * 16 + 2 * cg] = zs0; vec[V_GA + et * 16 + 2 * cg + 1] = zs1; }
    else if (w == 7) MX_SCALARS(vec + V_SETS);
    __syncthreads();

#pragma unroll 1
    for (int n = 0; n <= 64; ++n) {
        if (n > 0) {
            const size_t mp = m0 - 64;
            const LAS float* orow = Os + et * OSP + 16 * cg;
            float o[16];
#pragma unroll
            for (int q4 = 0; q4 < 4; ++q4) { const f32x4 t4 = *(const LAS f32x4*)(orow + 4 * q4); o[4 * q4] = t4[0]; o[4 * q4 + 1] = t4[1]; o[4 * q4 + 2] = t4[2]; o[4 * q4 + 3] = t4[3]; }
            asm volatile("" : "+v"(gt0), "+v"(gt1));
            const unsigned gw_[8] = {gt0.x, gt0.y, gt0.z, gt0.w, gt1.x, gt1.y, gt1.z, gt1.w};
            float y[16];
            if (ROLE == 0) {
                float ss = 0.f;
#pragma unroll
                for (int e = 0; e < 16; ++e) ss += o[e] * o[e];
                ss += shl(ss, lane ^ 1); ss += shl(ss, lane ^ 2); ss += shl(ss, lane ^ 4);
                const float rn = rsqrtf(ss * (1.f / 128.f) + 1e-6f);
#pragma unroll
                for (int e = 0; e < 16; ++e) { const float g = (e & 1) ? bfhi(gw_[e >> 1]) : bflo(gw_[e >> 1]); y[e] = o[e] * rn * nwv[e] * g * fsigmoid(g); }
            } else {
                const float rdiv = vec[V_DEN + et];
#pragma unroll
                for (int e = 0; e < 16; ++e) { const float g = (e & 1) ? bfhi(gw_[e >> 1]) : bflo(gw_[e >> 1]); y[e] = o[e] * rdiv * fsigmoid(g); }
            }
            u32x4 s0, s1;
            s0.x = cpk(y[0], y[1]); s0.y = cpk(y[2], y[3]); s0.z = cpk(y[4], y[5]); s0.w = cpk(y[6], y[7]);
            s1.x = cpk(y[8], y[9]); s1.y = cpk(y[10], y[11]); s1.z = cpk(y[12], y[13]); s1.w = cpk(y[14], y[15]);
            bf16_t* dst = Z + (mp + et) * ZLD + gcol + 16 * cg;
            if (STORE) { *(u32x4*)dst = s0; *(u32x4*)(dst + 8) = s1; } else { asm volatile("" :: "v"(s0), "v"(s1), "v"(dst)); }
        }
        if (n == 64) break;
        if (ROLE == 0) { MX_PIN8(qi, 0); MX_PIN8(ki, 0); } else { MX_PIN11(qi); MX_PIN11(ki); if (n == 0 && w == 0) { qi[0] = qi[1] = qi[2] = 0u; ki[0] = ki[1] = ki[2] = 0u; } }
        float c8[8], qf[8], kf[8];
        const LAS float* sv = vec + V_SETS + (n & 1) * SETSZ;
        if (ROLE == 0) {
            float run = 0.f;
#pragma unroll
            for (int i = 0; i < 8; ++i) {
                const LAS f32x4* gp = (const LAS f32x4*)(vec + V_GA + (8 * w + i) * 16);
                float x = abd;
#pragma unroll
                for (int r4 = 0; r4 < 4; ++r4) { const f32x4 g4 = gp[r4]; x += g4[0] * a2c[4 * r4] + g4[1] * a2c[4 * r4 + 1] + g4[2] * a2c[4 * r4 + 2] + g4[3] * a2c[4 * r4 + 3]; }
                run += flogsig(x) * (1.f / 16.f); c8[i] = run;
                qf[i] = ((lane & 1) ? bfhi(qi[i]) : bflo(qi[i])) * 0.125f; kf[i] = (lane & 1) ? bfhi(ki[i]) : bflo(ki[i]);
            }
            vec[V_SEG + w * 64 + lane] = run;
        } else {
#pragma unroll
            for (int i = 0; i < 8; ++i) {
                float aq = cbq, ak = cbk;
#pragma unroll
                for (int j = 0; j < 4; ++j) { aq += cwq[j] * ((lane & 1) ? bfhi(qi[i + j]) : bflo(qi[i + j])); ak += cwk[j] * ((lane & 1) ? bfhi(ki[i + j]) : bflo(ki[i + j])); }
                qf[i] = aq * fsigmoid(aq); kf[i] = ak * fsigmoid(ak) * 0.125f; c8[i] = 0.f;
            }
        }
        if (ROLE == 0) __syncthreads();
        {
            u32x4 ktp; unsigned ktw[4];
            if (ROLE == 0) {
                float off = 0.f, tot = 0.f;
#pragma unroll
                for (int w2 = 0; w2 < 8; ++w2) { const float s = vec[V_SEG + w2 * 64 + lane]; tot += s; off += (w2 < w) ? s : 0.f; }
                if (w == 0) vec[V_ELAST + lane] = fexp(tot);
                float kt[8];
#pragma unroll
                for (int i = 0; i < 8; ++i) {
                    const float cum = off + c8[i];
                    Qs[(8 * w + i) * PB + lane] = (bf16_t)cpk1(qf[i] * fexp(cum));
                    Ks[(8 * w + i) * PB + lane] = (bf16_t)cpk1(kf[i] * fexp(-cum));
                    kt[i] = kf[i] * fexp(tot - cum);
                }
#pragma unroll
                for (int i = 0; i < 4; ++i) ktw[i] = cpk(kt[2 * i], kt[2 * i + 1]);
            } else {
                float kt[8];
#pragma unroll
                for (int i = 0; i < 8; ++i) {
                    Qs[(8 * w + i) * PB + lane] = (bf16_t)cpk1(qf[i]);
                    Ks[(8 * w + i) * PB + lane] = (bf16_t)cpk1(kf[i]);
                    kt[i] = kf[i] * sv[V_WK + 8 * w + i];
                }
#pragma unroll
                for (int i = 0; i < 4; ++i) ktw[i] = cpk(kt[2 * i], kt[2 * i + 1]);
            }
            ktp.x = ktw[0]; ktp.y = ktw[1]; ktp.z = ktw[2]; ktp.w = ktw[3];
            *(LAS u32x4*)(KTs + lane * PB + 8 * w) = ktp;
            MX_PIN8(vi, 0); MX_PIN8(vi, 8);
#pragma unroll
            for (int i = 0; i < 16; ++i) vi[i] = (vc_ & 1) ? (vi[i] >> 16) : (vi[i] & 0xffffu);
            u32x4 v0, v1;
            v0.x = vi[0] | ((unsigned)vi[1] << 16); v0.y = vi[2] | ((unsigned)vi[3] << 16); v0.z = vi[4] | ((unsigned)vi[5] << 16); v0.w = vi[6] | ((unsigned)vi[7] << 16);
            v1.x = vi[8] | ((unsigned)vi[9] << 16); v1.y = vi[10] | ((unsigned)vi[11] << 16); v1.z = vi[12] | ((unsigned)vi[13] << 16); v1.w = vi[14] | ((unsigned)vi[15] << 16);
            *(LAS u32x4*)(VTs + vc_ * PB + 16 * rq) = v0; *(LAS u32x4*)(VTs + vc_ * PB + 16 * rq + 8) = v1;
        }
        __syncthreads();
        { const bf16_t* gp = Z + (m0 + et) * ZLD + gcol + 16 * cg; gt0 = *(const u32x4*)gp; gt1 = *(const u32x4*)(gp + 8); }
        if (n < 63) MX_LOAD(m0 + 64, n + 1);
#define MX_FRAG(base, row, ks) (*(const LAS bf16x8*)(lds + (base) + ((row) * PB + 16 * (ks) + 8 * hh) * 2))
        if (w < 3) {
            const int ti = (w >= 1) ? 1 : 0, sj = (w == 2) ? 1 : 0;
            f32x16 sc;
#pragma unroll
            for (int r = 0; r < 16; ++r) sc[r] = 0.f;
#pragma unroll
            for (int ks = 0; ks < 4; ++ks) sc = MX_MFMA(MX_FRAG(L_QS, 32 * ti + r32, ks), MX_FRAG(L_KS, 32 * sj + r32, ks), sc);
            const float csv = (ROLE == 1) ? sv[V_CS + 32 * sj + r32] : 0.f;
#pragma unroll
            for (int r = 0; r < 16; ++r) {
                const int t = crow(r, hh);
                const bool keep = (ti != sj) || (r32 <= t);
                float val = sc[r];
                if (ROLE == 1) val *= fexp(sv[V_RT + 32 * ti + t] + csv);
                Ps[(32 * ti + t) * PB + 32 * sj + r32] = (bf16_t)cpk1(keep ? val : 0.f);
            }
        }
        f32x16 acco;
#pragma unroll
        for (int r = 0; r < 16; ++r) acco[r] = 0.f;
#pragma unroll
        for (int ks = 0; ks < 4; ++ks) acco = MX_MFMA(MX_FRAG(L_QS, 32 * wa + r32, ks), MX_FRAG(L_ST, 32 * wv + r32, ks), acco);
        if (ROLE == 1) {
#pragma unroll
            for (int r = 0; r < 16; ++r) acco[r] *= sv[V_WI + 32 * wa + crow(r, hh)];
        }
        if (ROLE == 0) {
#pragma unroll
            for (int r = 0; r < 16; ++r) accS[r] *= vec[V_ELAST + 32 * wa + crow(r, hh)];
        } else {
            const float carry = sv[V_SC];
#pragma unroll
            for (int r = 0; r < 16; ++r) accS[r] *= carry;
        }
#pragma unroll
        for (int ks = 0; ks < 4; ++ks) accS = MX_MFMA(MX_FRAG(L_KT, 32 * wa + r32, ks), MX_FRAG(L_VT, 32 * wv + r32, ks), accS);
        __syncthreads();
        if (wa == 0) {
#pragma unroll
            for (int ks = 0; ks < 2; ++ks) acco = MX_MFMA(MX_FRAG(L_PS, r32, ks), MX_FRAG(L_VT, 32 * wv + r32, ks), acco);
        } else {
#pragma unroll
            for (int ks = 0; ks < 4; ++ks) acco = MX_MFMA(MX_FRAG(L_PS, 32 + r32, ks), MX_FRAG(L_VT, 32 * wv + r32, ks), acco);
        }
#pragma unroll
        for (int r = 0; r < 16; ++r) Os[(32 * wa + crow(r, hh)) * OSP + 32 * wv + r32] = acco[r];
#pragma unroll
        for (int q4 = 0; q4 < 4; ++q4) { u32x2 p; p.x = cpk(accS[4 * q4], accS[4 * q4 + 1]); p.y = cpk(accS[4 * q4 + 2], accS[4 * q4 + 3]);
            *(LAS u32x2*)(STs + (32 * wv + r32) * PB + 32 * wa + 8 * q4 + 4 * hh) = p; }
        if (ROLE == 0) { if (n < 63) { vec[V_GA + et * 16 + 2 * cg] = zs0; vec[V_GA + et * 16 + 2 * cg + 1] = zs1; } }
        else {
            const LAS float* nprev = vec + V_NORM + (n & 1) * 64;
            if (w == 0) {
                float qn = 0.f, si = 0.f;
#pragma unroll
                for (int c8i = 0; c8i < 8; ++c8i) {
                    const u32x4 qv = *(const LAS u32x4*)(Qs + lane * PB + 8 * c8i), pv = *(const LAS u32x4*)(Ps + lane * PB + 8 * c8i);
                    const f32x4 n0 = *(const LAS f32x4*)(nprev + 8 * c8i), n1 = *(const LAS f32x4*)(nprev + 8 * c8i + 4);
                    qn += bflo(qv.x) * n0[0] + bfhi(qv.x) * n0[1] + bflo(qv.y) * n0[2] + bfhi(qv.y) * n0[3] + bflo(qv.z) * n1[0] + bfhi(qv.z) * n1[1] + bflo(qv.w) * n1[2] + bfhi(qv.w) * n1[3];
                    si += (bflo(pv.x) + bfhi(pv.x)) + (bflo(pv.y) + bfhi(pv.y)) + (bflo(pv.z) + bfhi(pv.z)) + (bflo(pv.w) + bfhi(pv.w));
                }
                const float den = sv[V_WI + lane] * qn + si;
                vec[V_DEN + lane] = 1.f / fmaxf(fabsf(den), sv[V_ENM + lane]);
            } else if (w == 7) {
                if (n < 63) MX_SCALARS(vec + V_SETS + ((n + 1) & 1) * SETSZ);
            } else if (w == 1) {
                float kn = 0.f;
#pragma unroll
                for (int c8i = 0; c8i < 8; ++c8i) { const u32x4 kv = *(const LAS u32x4*)(KTs + lane * PB + 8 * c8i);
                    kn += (bflo(kv.x) + bfhi(kv.x)) + (bflo(kv.y) + bfhi(kv.y)) + (bflo(kv.z) + bfhi(kv.z)) + (bflo(kv.w) + bfhi(kv.w)); }
                vec[V_NORM + ((n + 1) & 1) * 64 + lane] = sv[V_SC] * nprev[lane] + kn;
            }
        }
        __syncthreads();
        m0 += 64;
    }
#undef MX_LOAD
#undef MX_PIN8
#undef MX_SCALARS
#undef MX_PIN11
#undef MX_FRAG
}
}

#ifndef PHASE_MASK
#define PHASE_MASK 0xFFFF
#endif
#define PH(k) if constexpr ((PHASE_MASK >> (k)) & 1)
#ifndef PROBE_GEMM_REPS
#define PROBE_GEMM_REPS 1
#endif
#ifndef PROBE_STREAM_REPS
#define PROBE_STREAM_REPS 1
#endif
#define GREP _Pragma("unroll 1") for (int rep_ = 0; rep_ < PROBE_GEMM_REPS; ++rep_)
#define GREP_BAR if (rep_) GRID_BAR();
#define BLK_ENV int blk = blockIdx.x; asm volatile("" : "+s"(blk));
#define PHASE_ENV BLK_ENV int tid = hw_tid(wave_s); asm volatile("" : "+v"(tid)); const int lane = tid & 63, wave = wave_s; int vcu_ = vcu; asm volatile("" : "+s"(vcu_)); const int gw = vcu_ * NWAVES + wave; (void)lane; (void)gw;
__global__ void __launch_bounds__(NWAVES * 64, 2) mega_fwd(Args args) {
    extern __shared__ __attribute__((aligned(16))) unsigned char lds_raw[];
    LAS unsigned char* lds = (LAS unsigned char*)lds_raw;
    const int G = gridDim.x, blk0 = blockIdx.x;
    const int wave_s = __builtin_amdgcn_readfirstlane(threadIdx.x >> 6);
    const int vcu = (G % 8 == 0) ? (blk0 % 8) * (G / 8) + blk0 / 8 : blk0;
    const int NGW = G * NWAVES;
    for (int u = threadIdx.x; u < (LDS_BYTES - LDSCTL_OFF) / 4; u += NWAVES * 64) ((LAS unsigned*)(lds + LDSCTL_OFF))[u] = 0u;
    __syncthreads();
    (void)xcd_barrier_post((unsigned*)(args.ws + WS_CTL) + CW_BAR, (volatile LAS unsigned*)(lds + MISC_OFF) + 8);
#define GRID_BAR() do { XcdBarrier b_; b_.bar = (unsigned*)(inp_ws() + WS_CTL) + CW_BAR; b_.x = xb_xcc_id(); b_.st = (volatile LAS unsigned*)(lds + MISC_OFF) + 8; xcd_barrier(b_, wave_s); } while (0)

    PH(0) { PHASE_ENV
        ada_phase(lds, blk, wave, lane);
        if (blk < 32) s5_generate(0, blk, lds, wave_s);
        else if (blk < 40) convert_small(inp(8), (bf16_t*)WSP(WS_WSM), blk - 32, tid);
        LAS float* scr = (LAS float*)(lds + wave * 16384);
        int base = 0;
        convert_matrix<1>(inp(8), INDIM, 1024, ZLD, (bf16_t*)WSP(WS_WIN), scr, lane, gw, NGW, base);
    }
    GRID_BAR();

#pragma unroll 1
    for (int l = 0; l < DEPTH; ++l) {
        PH(1) if (l == 0) { PHASE_ENV
            norm_rows<false, true>(nullptr, 0, inp(0), nullptr, nullptr, 0, nullptr, inp(4), (const float*)WSP(WS_MOD), 0, 1024, (bf16_t*)WSP(WS_H), gw, NGW, lane);
            GRID_BAR();
        }
        PH(2) GREP { GREP_BAR BLK_ENV
            pg8::PlainSched S; S.o.init(M, ZLD, G, blk); S.A = (const bf16_t*)WSP(WS_H); S.lda = D; S.Bt = (const bf16_t*)WSP(WS_WIN); S.K = D;
            pg8::EpiStore E{(bf16_t*)WSP(WS_Z), ZLD};
            pg8::gemm_phase<pg8::EpiStore, pg8::PlainSched, true, true>(lds, wave_s, D, D, S, E);
            { const int task = (int)(((G % 8 == 0) ? (blk % 8) * (G / 8) + blk / 8 : blk) * NWAVES + wave_s);
              for (int t = task; t < M / 32; t += G * NWAVES) zs_mfma((const bf16_t*)WSP(WS_H), (const bf16_t*)WSP(WS_WSM), (float*)WSP(WS_ZS), t, hw_lane()); }
        }
        GRID_BAR();
        PH(11) GREP { GREP_BAR BLK_ENV
            pg8::S5aSched S; S.G = G; S.c = blk; S.Zb = (const bf16_t*)WSP(WS_Z); S.Bt1 = (const bf16_t*)WSP(WS_S5M1);
            pg8::EpiS5a E{(float*)WSP(WS_EX), (bf16_t*)WSP(WS_YP)};
            pg8::gemm_phase<pg8::EpiS5a, pg8::S5aSched, true, true, 1>(lds, wave_s, 0, 256, S, E);
        }
        GRID_BAR();
        PH(3) { PHASE_ENV
#if PROBE_STREAM_REPS > 1
            for (int rep_ = 1; rep_ < PROBE_STREAM_REPS; ++rep_) { if (blk < 32) mx::stream<0, false>(l, lds, blk, wave_s); else if (blk < 64) mx::stream<1, false>(l, lds, blk - 32, wave_s); __syncthreads(); }
#endif
            if (blk < 32) mx::stream<0>(l, lds, blk, wave_s);
            else if (blk < 64) mx::stream<1>(l, lds, blk - 32, wave_s);
            else if (blk < 192) { if (wave < 2) s5_scan(l, (blk - 64) * 2 + wave, lane); }
            else if (G > 192) {
                int base = 0; const int gw2 = (blk - 192) * NWAVES + wave, NGW2 = (G - 192) * NWAVES;
                LAS float* scr = (LAS float*)(lds + wave * 16384);
                convert_matrix<0>(inp(24) + (size_t)l * 512 * 512, 512, 512, 512, (bf16_t*)WSP(WS_WGLU), scr, lane, gw2, NGW2, base);
                convert_matrix<0>(inp(26) + (size_t)l * 512 * 1024, 1024, 512, 1024, (bf16_t*)WSP(WS_WPROJ), scr, lane, gw2, NGW2, base);
                convert_matrix<0>(inp(27) + (size_t)l * 512 * 1024, 1024, 512, 1024, (bf16_t*)WSP(WS_WPROJ) + 1024 * 512, scr, lane, gw2, NGW2, base);
                convert_matrix<0>(inp(28) + (size_t)l * 512 * 1024, 1024, 512, 1024, (bf16_t*)WSP(WS_WPROJ) + 2 * 1024 * 512, scr, lane, gw2, NGW2, base);
                convert_matrix<0>(inp(30) + (size_t)l * D * D, 1024, 1024, 1024, (bf16_t*)WSP(WS_WOUT), scr, lane, gw2, NGW2, base);
                convert_matrix<0>(inp(32) + (size_t)l * FF * D, 1024, FF, 1024, (bf16_t*)WSP(WS_WFO), scr, lane, gw2, NGW2, base);
            }
        }
        GRID_BAR();
        PH(12) { BLK_ENV
            pg8::S5bSched S; S.G = G; S.c = blk; S.X = (const bf16_t*)WSP(WS_EX); S.Bt3 = (const bf16_t*)WSP(WS_S5M3);
            pg8::EpiS5b E{(const bf16_t*)WSP(WS_YP), (bf16_t*)WSP(WS_Z), inp(23) + l * 512};
            pg8::gemm_phase<pg8::EpiS5b, pg8::S5bSched, true, true>(lds, wave_s, 256, 256, S, E);
        }
        GRID_BAR();
        PH(4) GREP { GREP_BAR BLK_ENV
            bf16_t* Z = (bf16_t*)WSP(WS_Z);
            pg8::PlainSched S; S.o.init(M, 512, G, blk); S.A = Z + SU; S.lda = ZLD; S.Bt = (const bf16_t*)WSP(WS_WGLU); S.K = 512;
            pg8::EpiGlu E{Z + YS2, ZLD, Z + SU, ZLD, inp(25) + l * 512};
            pg8::gemm_phase<pg8::EpiGlu, pg8::PlainSched, true, true>(lds, wave_s, ZLD, 512, S, E);
        }
        GRID_BAR();
        PH(5) GREP { GREP_BAR BLK_ENV
            bf16_t* Z = (bf16_t*)WSP(WS_Z);
            pg8::MergeSched S; S.o.init(M, 1024, G, blk); S.Zb = Z; S.Wp = (const bf16_t*)WSP(WS_WPROJ);
            pg8::EpiMerge E{Z + MRG, ZLD, Z + ZG, ZLD, inp(29) + l * 3072};
            pg8::gemm_phase<pg8::EpiMerge, pg8::MergeSched, true, true>(lds, wave_s, ZLD, 512, S, E);
        }
        GRID_BAR();
        PH(6) GREP { GREP_BAR BLK_ENV
            pg8::PlainSched S; S.o.init(M, 1024, G, blk); S.A = (const bf16_t*)WSP(WS_Z) + MRG; S.lda = ZLD; S.Bt = (const bf16_t*)WSP(WS_WOUT); S.K = 1024;
            pg8::EpiStore E{(bf16_t*)WSP(WS_H), D};
            pg8::gemm_phase<pg8::EpiStore, pg8::PlainSched, true, true>(lds, wave_s, ZLD, 1024, S, E);
        }
        GRID_BAR();
        PH(7) { PHASE_ENV
            const float* modl = (const float*)WSP(WS_MOD) + (size_t)l * 8 * 6144;
            { int base = 0; convert_matrix<2>(inp(31) + (size_t)l * D * 2 * FF, 2 * FF, 1024, 2 * FF, (bf16_t*)WSP(WS_WFI), (LAS float*)(lds + wave * 16384), lane, gw, NGW, base); }
            norm_rows<true, true>((const bf16_t*)WSP(WS_H), D, (l == 0) ? inp(0) : (const float*)inp_out(), inp(5) + l * D, modl, 2048, inp_out(), inp(6) + l * D, modl, 3072, 4096,
                                      (bf16_t*)WSP(WS_H), gw, NGW, lane);
        }
        GRID_BAR();
        PH(8) GREP { GREP_BAR BLK_ENV
            pg8::PlainSched S; S.o.init(M, 2 * FF, G, blk); S.A = (const bf16_t*)WSP(WS_H); S.lda = D; S.Bt = (const bf16_t*)WSP(WS_WFI); S.K = D;
            pg8::EpiSwiGlu E{(bf16_t*)WSP(WS_Z), FF};
            pg8::gemm_phase<pg8::EpiSwiGlu, pg8::PlainSched, true, true>(lds, wave_s, D, D, S, E);
        }
        GRID_BAR();
        PH(9) GREP { GREP_BAR BLK_ENV
            pg8::PlainSched S; S.o.init(M, 1024, G, blk); S.A = (const bf16_t*)WSP(WS_Z); S.lda = FF; S.Bt = (const bf16_t*)WSP(WS_WFO); S.K = FF;
            pg8::EpiStore E{(bf16_t*)WSP(WS_H), D};
            pg8::gemm_phase<pg8::EpiStore, pg8::PlainSched, true, true>(lds, wave_s, FF, FF, S, E);
        }
        GRID_BAR();
        PH(10) { PHASE_ENV
            const float* modl = (const float*)WSP(WS_MOD) + (size_t)l * 8 * 6144;
            if (l + 1 < DEPTH) {
                const int l1 = l + 1;
                LAS float* scr = (LAS float*)(lds + wave * 16384);
                int base = 0;
                if (blk < 32) s5_generate(l1, blk, lds, wave_s);
                convert_matrix<1>(inp(8) + (size_t)l1 * D * INDIM, INDIM, 1024, ZLD, (bf16_t*)WSP(WS_WIN), scr, lane, gw, NGW, base);
                if (blk >= 32 && blk < 40) convert_small(inp(8) + (size_t)l1 * D * INDIM, (bf16_t*)WSP(WS_WSM), blk - 32, tid);
                norm_rows<true, true>((const bf16_t*)WSP(WS_H), D, (const float*)inp_out(), inp(7) + l * D, modl, 5120, inp_out(), inp(4) + l1 * D, modl + 8 * 6144, 0, 1024,
                                      (bf16_t*)WSP(WS_H), gw, NGW, lane);
                GRID_BAR();
            } else {
                norm_rows<true, false>((const bf16_t*)WSP(WS_H), D, (const float*)inp_out(), inp(7) + l * D, modl, 5120, inp_out(), nullptr, nullptr, 0, 0, nullptr, gw, NGW, lane);
            }
        }
    }
}

extern "C" void kernel_launch(void* const* d_in, const int* in_sizes, int n_in, void* d_out, int out_size, void* d_ws, size_t ws_size, hipStream_t stream) {
    static int grid = 0;
    if (grid == 0) {
        if (n_in != 33 || ws_size < WS_END || out_size != M * D) { fprintf(stderr, "kernel_launch: unexpected n_in %d / ws %zu / out %d\n", n_in, ws_size, out_size); grid = -1; return; }
        int dev = 0, cus = 0, per_cu = 0;
        if (hipGetDevice(&dev) != hipSuccess || hipDeviceGetAttribute(&cus, hipDeviceAttributeMultiprocessorCount, dev) != hipSuccess) { grid = -1; return; }
        if (hipFuncSetAttribute((const void*)mega_fwd, hipFuncAttributeMaxDynamicSharedMemorySize, LDS_BYTES) != hipSuccess) { fprintf(stderr, "kernel_launch: hipFuncSetAttribute failed\n"); grid = -1; return; }
        if (hipOccupancyMaxActiveBlocksPerMultiprocessor(&per_cu, (const void*)mega_fwd, NWAVES * 64, LDS_BYTES) != hipSuccess || per_cu < 1) { fprintf(stderr, "kernel_launch: occupancy query says %d blocks/CU\n", per_cu); grid = -1; return; }
        (void)hipGetLastError();
        grid = cus;
    }
    if (grid < 0) return;
    (void)hipMemsetAsync((char*)d_ws + WS_CTL, 0, CTL_ZERO_BYTES, stream);
    Args a{};
    for (int i = 0; i < 33; ++i) a.in[i] = (const float*)d_in[i];
    a.out = (float*)d_out; a.ws = (unsigned char*)d_ws;
    hipLaunchKernelGGL(mega_fwd, dim3(grid), dim3(NWAVES * 64), LDS_BYTES, stream, a);
}
```

```cpp
#include <hip/hip_runtime.h>
#include <cstdint>
#include <cstdio>

#define LAS __attribute__((address_space(3)))
#define GAS __attribute__((address_space(1)))
typedef unsigned short bf16_t;
typedef short bf16x8 __attribute__((ext_vector_type(8)));
typedef float f32x4 __attribute__((ext_vector_type(4)));
typedef float f32x2 __attribute__((ext_vector_type(2)));
typedef unsigned u32x4 __attribute__((ext_vector_type(4)));
typedef unsigned u32x2 __attribute__((ext_vector_type(2)));

constexpr int NB = 8, T = 4096, D = 1024, M = NB * T, DEPTH = 2;
constexpr int INDIM = 6680, ZLD = 6656, FF = 2816;
constexpr int GQ = 0, GK = 256, GV = 512, GR = 1024, MQ = 1536, MK = 1792, MV = 2048, MO = 2560, SU = 3072, ZG = 3584;
constexpr int YGLA = GR;
constexpr int YML = MO;
constexpr int YS2 = 0;
constexpr int MRG = 1536;
constexpr int EXC = ZG;
constexpr int YPC = ZG + 512;
constexpr int NMIX = 3584;
constexpr size_t MiB = 1u << 20;
constexpr size_t WS_CTL = 0, CTL_ZERO_BYTES = 64 * 1024;
constexpr size_t WS_MOD = 512 * 1024;
constexpr size_t WS_ZS = 1 * MiB;
constexpr size_t WS_WIN = 5 * MiB;
constexpr size_t WS_WFI = 5 * MiB;
constexpr size_t WS_S5M1 = 18 * MiB;
constexpr size_t WS_S5M3 = 24 * MiB;
constexpr size_t WS_WGLU = 18 * MiB;
constexpr size_t WS_WPROJ = 18 * MiB + 512 * 1024;
constexpr size_t WS_WOUT = 21 * MiB + 512 * 1024;
constexpr size_t WS_WFO = 23 * MiB + 512 * 1024;
constexpr size_t WS_WSM = 29 * MiB;
constexpr size_t WS_H = 32 * MiB;
constexpr size_t WS_Z = 96 * MiB;
constexpr size_t WS_END = 512 * MiB;
constexpr int CW_BAR = 4096;

constexpr int RING_BYTES = 131072, LDSCTL_OFF = RING_BYTES, MISC_OFF = LDSCTL_OFF + 320, LDS_BYTES = 147456;
constexpr int NWAVES = 8;

__device__ __forceinline__ float bf2f(bf16_t v) { return __uint_as_float(((unsigned)v) << 16); }
__device__ __forceinline__ unsigned f2bf(float f) { unsigned u = __float_as_uint(f); return (u + 0x7fffu + ((u >> 16) & 1u)) >> 16; }
__device__ __forceinline__ unsigned pk2(float lo, float hi) { return f2bf(lo) | (f2bf(hi) << 16); }
__device__ __forceinline__ float bflo(unsigned u) { return __uint_as_float(u << 16); }
__device__ __forceinline__ float bfhi(unsigned u) { return __uint_as_float(u & 0xffff0000u); }
__device__ __forceinline__ int hw_lane() { int l; asm volatile("v_mbcnt_lo_u32_b32 %0, -1, 0\n\tv_mbcnt_hi_u32_b32 %0, -1, %0" : "=v"(l)); return l; }
__device__ __forceinline__ int hw_tid(int wv) { return wv * 64 + hw_lane(); }
__device__ __forceinline__ float shl(float v, int src) { return __int_as_float(__builtin_amdgcn_ds_bpermute(src << 2, __float_as_int(v))); }
__device__ __forceinline__ float wave_sum(float v, int lane) {
#pragma unroll
    for (int o = 1; o < 64; o <<= 1) v += shl(v, lane ^ o);
    return v;
}
__device__ __forceinline__ float sigmoidf_(float x) { return 1.f / (1.f + expf(-x)); }
__device__ __forceinline__ float siluf_(float x) { return x / (1.f + expf(-x)); }
__device__ __forceinline__ float logsigmoidf_(float x) { return fminf(x, 0.f) - log1pf(expf(-fabsf(x))); }
__device__ __forceinline__ float gelu_tanh(float y) { return 0.5f * y * (1.f + tanhf(0.7978845608028654f * (y + 0.044715f * y * y * y))); }
__device__ __forceinline__ float fexp_neg(float x) { return __builtin_amdgcn_exp2f(-1.4426950408889634f * x); }
__device__ __forceinline__ float fsigmoid(float x) { return __builtin_amdgcn_rcpf(1.f + fexp_neg(x)); }
#define LDS_WAIT() asm volatile("s_waitcnt lgkmcnt(0)" ::: "memory")
#define VM_WAIT() asm volatile("s_waitcnt vmcnt(0)" ::: "memory")

namespace pg8 {
constexpr int BM = 256, BK = 64, HALF = 128, HTB = HALF * BK * 2, STAGE_BYTES = 8 * HTB, NXCD = 8, WGM = 8;
__host__ __device__ __forceinline__ int lds_byte(int r, int c) { const int st = (r >> 4) * 2 + (c >> 5), rr = r & 15, cc = c & 31, ob = rr * 64 + cc * 2; return st * 1024 + (ob ^ (((ob >> 9) & 1) << 5)); }
__host__ __device__ __forceinline__ void stage_rc(int b, int& R, int& C) { const int st = b / 1024, sb = b % 1024, swz = sb ^ (((sb >> 9) & 1) << 5); R = (st >> 1) * 16 + swz / 64; C = (st & 1) * 32 + (swz % 64) / 2; }
__host__ __device__ __forceinline__ int perm32(int rho) { const int n = rho >> 4, i = rho & 15; return 8 * (i >> 2) + 4 * n + (i & 3); }

struct Unit { int pm, pn, br; };
struct TileOrder {
    int nM, nN, nwg, G, c;
    __device__ void init(int M_, int N_, int G_, int c_) { nM = M_ / BM; nN = N_ / BM; nwg = nM * nN; G = G_; c = c_; }
    __device__ bool tile(int i, int& pm, int& pn) const {
        const long L = (long)i * G + c; if (L >= nwg) return false;
        int wgid = (int)L; { const int q = nwg / NXCD, r = nwg % NXCD, xcd = wgid % NXCD, off = wgid / NXCD; wgid = (xcd < r ? xcd * (q + 1) : r * (q + 1) + (xcd - r) * q) + off; }
        const int nig = WGM * nN, gid = wgid / nig, fm = gid * WGM, gsz = (nM - fm) < WGM ? (nM - fm) : WGM;
        pm = fm + ((wgid % nig) % gsz); pn = (wgid % nig) / gsz; return true;
    }
};
struct PlainSched {
    TileOrder o; const bf16_t* A; int lda; const bf16_t* Bt; int K;
    __device__ bool next(int i, Unit& u) const { u.br = 0; return o.tile(i, u.pm, u.pn); }
    __device__ const char* Ap(const Unit& u) const { return (const char*)(A + (size_t)u.pm * BM * lda); }
    __device__ const char* Bp(const Unit& u) const { return (const char*)(Bt + (size_t)u.pn * BM * K); }
};
struct MergeSched {
    TileOrder o; const bf16_t* Zb; const bf16_t* Wp;
    __device__ bool next(int i, Unit& u) const { u.br = i % 3; return o.tile(i / 3, u.pm, u.pn); }
    __device__ const char* Ap(const Unit& u) const { const int col = u.br == 0 ? YGLA : (u.br == 1 ? YML : YS2); return (const char*)(Zb + (size_t)u.pm * BM * ZLD + col); }
    __device__ const char* Bp(const Unit& u) const { return (const char*)(Wp + (size_t)u.br * 1024 * 512 + (size_t)u.pn * BM * 512); }
};

__device__ __forceinline__ unsigned cvt_pk_bf16(float lo, float hi) { unsigned r; asm volatile("v_cvt_pk_bf16_f32 %0, %1, %2" : "=v"(r) : "v"(lo), "v"(hi)); return r; }

struct EpiStore {
    static constexpr bool PERM = true;
    bf16_t* O; int ldc;
    __device__ __forceinline__ bool keep(const Unit&) const { return false; }
    __device__ __forceinline__ void operator()(f32x4 (&acc)[2][2][4][2], const Unit& u, int wr, int wc, int fr, int fq) const {
        const int row0 = u.pm * BM + wr * 64 + fr, col0 = u.pn * BM + wc * 32 + 8 * fq;
#pragma unroll
        for (int ai = 0; ai < 2; ++ai)
#pragma unroll
            for (int m = 0; m < 4; ++m) { bf16_t* rowp = O + (size_t)(row0 + ai * HALF + m * 16) * ldc + col0;
#pragma unroll
                for (int bj = 0; bj < 2; ++bj) { const f32x4 v0 = acc[ai][bj][m][0], v1 = acc[ai][bj][m][1];
                    u32x4 w; w.x = cvt_pk_bf16(v0[0], v0[1]); w.y = cvt_pk_bf16(v0[2], v0[3]); w.z = cvt_pk_bf16(v1[0], v1[1]); w.w = cvt_pk_bf16(v1[2], v1[3]);
                    *(u32x4*)(rowp + bj * HALF) = w; } }
    }
};
struct EpiGlu {
    static constexpr bool PERM = true;
    bf16_t* O; int ldc; const bf16_t* Asrc; int lda; const float* bias;
    __device__ __forceinline__ bool keep(const Unit&) const { return false; }
    __device__ __forceinline__ void operator()(f32x4 (&acc)[2][2][4][2], const Unit& u, int wr, int wc, int fr, int fq) const {
        const int row0 = u.pm * BM + wr * 64 + fr, col0 = u.pn * BM + wc * 32 + 8 * fq;
        f32x4 bv[2][2];
#pragma unroll
        for (int bj = 0; bj < 2; ++bj)
#pragma unroll
            for (int n = 0; n < 2; ++n) bv[bj][n] = *(const f32x4*)(bias + col0 + bj * HALF + 4 * n);
#pragma unroll
        for (int ai = 0; ai < 2; ++ai)
#pragma unroll
            for (int m = 0; m < 4; ++m) { const size_t r = (size_t)(row0 + ai * HALF + m * 16);
#pragma unroll
                for (int bj = 0; bj < 2; ++bj) {
                    const u32x4 a = *(const u32x4*)(Asrc + r * lda + col0 + bj * HALF);
                    const f32x4 v0 = acc[ai][bj][m][0] + bv[bj][0], v1 = acc[ai][bj][m][1] + bv[bj][1];
                    u32x4 w;
                    w.x = cvt_pk_bf16(bflo(a.x) * fsigmoid(v0[0]), bfhi(a.x) * fsigmoid(v0[1])); w.y = cvt_pk_bf16(bflo(a.y) * fsigmoid(v0[2]), bfhi(a.y) * fsigmoid(v0[3]));
                    w.z = cvt_pk_bf16(bflo(a.z) * fsigmoid(v1[0]), bfhi(a.z) * fsigmoid(v1[1])); w.w = cvt_pk_bf16(bflo(a.w) * fsigmoid(v1[2]), bfhi(a.w) * fsigmoid(v1[3]));
                    *(u32x4*)(O + r * ldc + col0 + bj * HALF) = w; } }
    }
};
struct EpiSwiGlu {
    static constexpr bool PERM = true;
    bf16_t* O; int ldc;
    __device__ __forceinline__ bool keep(const Unit&) const { return false; }
    __device__ __forceinline__ void operator()(f32x4 (&acc)[2][2][4][2], const Unit& u, int wr, int wc, int fr, int fq) const {
        const int row0 = u.pm * BM + wr * 64 + fr, col0 = u.pn * HALF + wc * 32 + 8 * fq;
#pragma unroll
        for (int ai = 0; ai < 2; ++ai)
#pragma unroll
            for (int m = 0; m < 4; ++m) {
                float o[8];
#pragma unroll
                for (int n = 0; n < 2; ++n)
#pragma unroll
                    for (int e = 0; e < 4; ++e) { const float g = acc[ai][0][m][n][e], up = acc[ai][1][m][n][e]; o[n * 4 + e] = g * fsigmoid(g) * up; }
                u32x4 w; w.x = cvt_pk_bf16(o[0], o[1]); w.y = cvt_pk_bf16(o[2], o[3]); w.z = cvt_pk_bf16(o[4], o[5]); w.w = cvt_pk_bf16(o[6], o[7]);
                *(u32x4*)(O + (size_t)(row0 + ai * HALF + m * 16) * ldc + col0) = w; }
    }
};
struct EpiMerge {
    static constexpr bool PERM = true;
    bf16_t* O; int ldc; const bf16_t* Zg; int ldz; const float* bgb;
    __device__ __forceinline__ bool keep(const Unit& u) const { return u.br < 2; }
    __device__ __forceinline__ float e_of(float x) const { return fminf(fexp_neg(x), 1e30f); }
    __device__ __forceinline__ void operator()(f32x4 (&acc)[2][2][4][2], const Unit& u, int wr, int wc, int fr, int fq) const {
        const int row0 = u.pm * BM + wr * 64 + fr, col0 = u.pn * BM + wc * 32 + 8 * fq;
        const int br = u.br, brn = br < 2 ? br + 1 : 2;
#pragma unroll
        for (int bj = 0; bj < 2; ++bj) {
            float ba[8], bb[8];
#pragma unroll
            for (int e = 0; e < 8; ++e) { ba[e] = bgb[br * 1024 + col0 + bj * HALF + e]; bb[e] = bgb[brn * 1024 + col0 + bj * HALF + e]; }
#pragma unroll
            for (int ai = 0; ai < 2; ++ai)
#pragma unroll
                for (int m = 0; m < 4; ++m) { const size_t r = (size_t)(row0 + ai * HALF + m * 16);
                    const u32x4 za = *(const u32x4*)(Zg + r * ldz + br * 1024 + col0 + bj * HALF);
                    const u32x4 zb = *(const u32x4*)(Zg + r * ldz + brn * 1024 + col0 + bj * HALF);
                    const float xa[8] = {bflo(za.x), bfhi(za.x), bflo(za.y), bfhi(za.y), bflo(za.z), bfhi(za.z), bflo(za.w), bfhi(za.w)};
                    const float xb[8] = {bflo(zb.x), bfhi(zb.x), bflo(zb.y), bfhi(zb.y), bflo(zb.z), bfhi(zb.z), bflo(zb.w), bfhi(zb.w)};
                    float f[8];
#pragma unroll
                    for (int e = 0; e < 8; ++e) { const float ga = __builtin_amdgcn_rcpf(1.f + e_of(xa[e] + ba[e]));
                        f[e] = br < 2 ? ga * (1.f + e_of(xb[e] + bb[e])) : ga; }
                    f32x4 v0 = acc[ai][bj][m][0], v1 = acc[ai][bj][m][1];
                    v0[0] *= f[0]; v0[1] *= f[1]; v0[2] *= f[2]; v0[3] *= f[3]; v1[0] *= f[4]; v1[1] *= f[5]; v1[2] *= f[6]; v1[3] *= f[7];
                    if (br < 2) { acc[ai][bj][m][0] = v0; acc[ai][bj][m][1] = v1; }
                    else { u32x4 w; w.x = cvt_pk_bf16(v0[0], v0[1]); w.y = cvt_pk_bf16(v0[2], v0[3]); w.z = cvt_pk_bf16(v1[0], v1[1]); w.w = cvt_pk_bf16(v1[2], v1[3]);
                        *(u32x4*)(O + r * ldc + col0 + bj * HALF) = w; } }
        }
    }
};


struct S5aSched {
    int G, c; const bf16_t* Zb; const bf16_t* Bt1;
    __device__ bool next(int i, Unit& u) const { const int L = i * G + c; if (L >= 512) return false; u.br = L >> 4; u.pm = (L & 15) >> 1; u.pn = L & 1; return true; }
    __device__ const char* Ap(const Unit& u) const { return (const char*)(Zb + (size_t)u.pm * T * ZLD + SU + 16 * u.br); }
    __device__ const char* Bp(const Unit& u) const { return (const char*)(Bt1 + ((size_t)u.br * 384 + (size_t)u.pn * 256) * 256); }
};
struct EpiS5a {
    static constexpr bool PERM = true;
    bf16_t* Zb;
    __device__ __forceinline__ bool keep(const Unit&) const { return false; }
    __device__ __forceinline__ void operator()(f32x4 (&acc)[2][2][4][2], const Unit& u, int wr, int wc, int fr, int fq) const {
        const int rowbase = (u.br & 15) * 2048 + u.pm * 256 + wr * 64 + fr, colsub = wc * 32 + 8 * fq, hoff = (u.br >> 4) * 256;
#pragma unroll
        for (int ai = 0; ai < 2; ++ai)
#pragma unroll
            for (int m = 0; m < 4; ++m) { bf16_t* zrow = Zb + (size_t)(rowbase + ai * HALF + m * 16) * ZLD + hoff;
                if (u.pn == 0) {
                    float* ex = (float*)(zrow + EXC);
                    *(f32x4*)(ex + colsub) = acc[ai][0][m][0]; *(f32x4*)(ex + colsub + 4) = acc[ai][0][m][1];
                    const f32x4 v0 = acc[ai][1][m][0], v1 = acc[ai][1][m][1];
                    u32x4 w; w.x = cvt_pk_bf16(v0[0], v0[1]); w.y = cvt_pk_bf16(v0[2], v0[3]); w.z = cvt_pk_bf16(v1[0], v1[1]); w.w = cvt_pk_bf16(v1[2], v1[3]);
                    *(u32x4*)(zrow + YPC + colsub) = w;
                } else {
                    const f32x4 v0 = acc[ai][0][m][0], v1 = acc[ai][0][m][1];
                    u32x4 w; w.x = cvt_pk_bf16(v0[0], v0[1]); w.y = cvt_pk_bf16(v0[2], v0[3]); w.z = cvt_pk_bf16(v1[0], v1[1]); w.w = cvt_pk_bf16(v1[2], v1[3]);
                    *(u32x4*)(zrow + YPC + 128 + colsub) = w;
                } }
    }
};
struct S5bSched {
    int G, c; const bf16_t* X; const bf16_t* Bt3;
    __device__ bool next(int i, Unit& u) const { const int L = i * G + c; if (L >= 256) return false; u.br = L >> 3; u.pm = L & 7; u.pn = 0; return true; }
    __device__ const char* Ap(const Unit& u) const { return (const char*)(X + (size_t)((u.br & 15) * 2048 + u.pm * 256) * ZLD + EXC + (u.br >> 4) * 256); }
    __device__ const char* Bp(const Unit& u) const { return (const char*)(Bt3 + (size_t)u.br * 256 * 256); }
};
struct EpiS5b {
    static constexpr bool PERM = true;
    bf16_t* Zb; const float* dsk;
    __device__ __forceinline__ bool keep(const Unit&) const { return false; }
    __device__ __forceinline__ void operator()(f32x4 (&acc)[2][2][4][2], const Unit& u, int wr, int wc, int fr, int fq) const {
        const int g = u.br, b = u.pm;
#pragma unroll
        for (int bj = 0; bj < 2; ++bj) {
            const int j0 = bj * HALF + wc * 32 + 8 * fq, s = j0 >> 4, c0 = j0 & 15;
            const f32x4 d0 = *(const f32x4*)(dsk + 16 * g + c0), d1 = *(const f32x4*)(dsk + 16 * g + c0 + 4);
#pragma unroll
            for (int ai = 0; ai < 2; ++ai)
#pragma unroll
                for (int m = 0; m < 4; ++m) {
                    const int n = ai * HALF + wr * 64 + m * 16 + fr;
                    const u32x4 yp = *(const u32x4*)(Zb + (size_t)((g & 15) * 2048 + b * 256 + n) * ZLD + YPC + (g >> 4) * 256 + j0);
                    bf16_t* zp = Zb + ((size_t)b * T + 16 * n + s) * ZLD + SU + 16 * g + c0;
                    const u32x4 uu = *(const u32x4*)zp;
                    const f32x4 a0 = acc[ai][bj][m][0], a1 = acc[ai][bj][m][1];
                    float y[8];
                    y[0] = a0[0] + bflo(yp.x) + d0[0] * bflo(uu.x); y[1] = a0[1] + bfhi(yp.x) + d0[1] * bfhi(uu.x);
                    y[2] = a0[2] + bflo(yp.y) + d0[2] * bflo(uu.y); y[3] = a0[3] + bfhi(yp.y) + d0[3] * bfhi(uu.y);
                    y[4] = a1[0] + bflo(yp.z) + d1[0] * bflo(uu.z); y[5] = a1[1] + bfhi(yp.z) + d1[1] * bfhi(uu.z);
                    y[6] = a1[2] + bflo(yp.w) + d1[2] * bflo(uu.w); y[7] = a1[3] + bfhi(yp.w) + d1[3] * bfhi(uu.w);
#pragma unroll
                    for (int e = 0; e < 8; ++e) { const float v = y[e]; y[e] = v * fsigmoid(1.5957691216057308f * (v + 0.044715f * v * v * v)); }
                    u32x4 w; w.x = cvt_pk_bf16(y[0], y[1]); w.y = cvt_pk_bf16(y[2], y[3]); w.z = cvt_pk_bf16(y[4], y[5]); w.w = cvt_pk_bf16(y[6], y[7]);
                    *(u32x4*)zp = w;
                    if (m & 1) asm volatile("" ::: "memory");
                }
        }
    }
};

template <class Epi, class Sched, bool ALIGN_EPI, bool SP2, int AMODE = 0>
__device__ __forceinline__ void gemm_phase(LAS unsigned char* lds, const int wv, const int lda, const int K, const Sched& S, const Epi& E) {
    int tid_ = hw_tid(wv); asm volatile("" : "+v"(tid_));
    const int tid = tid_, wid = __builtin_amdgcn_readfirstlane(tid >> 6), lane = tid & 63, wr = wid >> 2, wc = wid & 3, fr = lane & 15, fq = lane >> 4;
    const int nt = K / BK;
    unsigned voffA[2], voffB[2];
#pragma unroll
    for (int i = 0; i < 2; ++i) { int R, C; stage_rc(tid * 16 + i * 8192, R, C); const int Rb = Epi::PERM ? ((R & ~31) + perm32(R & 31)) : R;
        voffA[i] = AMODE == 0 ? (unsigned)(R * lda + C) * 2u : (unsigned)((16 * R + (C >> 4)) * ZLD + (C & 15)) * 2u; voffB[i] = (unsigned)(Rb * K + C) * 2u; }
    const size_t kstep = (size_t)(BK * 2);
    const size_t kstepA = AMODE == 0 ? (size_t)(BK * 2) : (size_t)4 * ZLD * 2;
    const size_t hA = AMODE == 0 ? (size_t)HALF * lda * 2 : (size_t)HALF * 16 * ZLD * 2, hB = (size_t)HALF * K * 2;
    const unsigned ldsw = (unsigned)wid * 1024u;
    const int aoff = lds_byte(wr * 64 + fr, fq * 8), boff = lds_byte(wc * 32 + fr, fq * 8);
#define PG8_SA(b, h) (((b) * 2 + (h)) * HTB)
#define PG8_SB(b, h) ((4 + (b) * 2 + (h)) * HTB)
#define PG8_STAGE(bufoff, gbase, voff) do { _Pragma("unroll") for (int _i = 0; _i < 2; ++_i) \
        __builtin_amdgcn_global_load_lds((const unsigned*)((const char*)(gbase) + (voff)[_i]), (LAS unsigned*)(lds + (bufoff) + ldsw + _i * 8192), 16, 0, 0); } while (0)
#define PG8_LDA(dst, b, h) do { _Pragma("unroll") for (int m = 0; m < 4; ++m) _Pragma("unroll") for (int k = 0; k < 2; ++k) dst[m][k] = *(const LAS bf16x8*)(lds + PG8_SA(b, h) + aoff + m * 2048 + k * 1024); } while (0)
#define PG8_LDB(dst, b, h) do { _Pragma("unroll") for (int n = 0; n < 2; ++n) _Pragma("unroll") for (int k = 0; k < 2; ++k) dst[n][k] = *(const LAS bf16x8*)(lds + PG8_SB(b, h) + boff + n * 2048 + k * 1024); } while (0)
#define PG8_MMA(ai, bj, At, Bt) do { __builtin_amdgcn_s_setprio(1); _Pragma("unroll") for (int m = 0; m < 4; ++m) _Pragma("unroll") for (int n = 0; n < 2; ++n) _Pragma("unroll") for (int k = 0; k < 2; ++k) \
        acc[ai][bj][m][n] = __builtin_amdgcn_mfma_f32_16x16x32_bf16(Bt[n][k], At[m][k], acc[ai][bj][m][n], 0, 0, 0); __builtin_amdgcn_s_setprio(0); } while (0)
#define PG8_WAIT_V(n) asm volatile("s_waitcnt vmcnt(" #n ")" ::: "memory")
#define PG8_WAIT_L(n) asm volatile("s_waitcnt lgkmcnt(" #n ")" ::: "memory")
#define PG8_BAR __builtin_amdgcn_s_barrier()
#define PG8_SCHED __builtin_amdgcn_sched_barrier(0)
    Unit cur, nxt; int ui = 0;
    if (!S.next(0, cur)) return;
    f32x4 acc[2][2][4][2];
#pragma unroll
    for (int a = 0; a < 2; ++a)
#pragma unroll
        for (int b = 0; b < 2; ++b)
#pragma unroll
            for (int m = 0; m < 4; ++m)
#pragma unroll
                for (int n = 0; n < 2; ++n) acc[a][b][m][n] = (f32x4){0.f, 0.f, 0.f, 0.f};
    bf16x8 At[4][2], B0[2][2], B1[2][2];
    const char* cA = S.Ap(cur); const char* cB = S.Bp(cur);
    if constexpr (SP2) {
        PG8_STAGE(PG8_SB(0, 0), cB, voffB); PG8_STAGE(PG8_SB(0, 1), cB + hB, voffB); PG8_STAGE(PG8_SA(0, 0), cA, voffA); PG8_STAGE(PG8_SA(0, 1), cA + hA, voffA);
        if (wr == 1) PG8_BAR;
        PG8_WAIT_V(2); PG8_BAR;
        PG8_STAGE(PG8_SB(1, 0), cB + kstep, voffB); PG8_STAGE(PG8_SA(1, 0), cA + kstepA, voffA); PG8_STAGE(PG8_SB(1, 1), cB + hB + kstep, voffB);
        PG8_WAIT_V(6); PG8_BAR;
    } else {
        PG8_STAGE(PG8_SB(0, 0), cB, voffB); PG8_STAGE(PG8_SA(0, 0), cA, voffA); PG8_STAGE(PG8_SB(0, 1), cB + hB, voffB); PG8_STAGE(PG8_SA(0, 1), cA + hA, voffA);
        if (wr == 1) PG8_BAR;
        PG8_WAIT_V(4); PG8_BAR;
        PG8_STAGE(PG8_SB(1, 0), cB + kstep, voffB); PG8_STAGE(PG8_SA(1, 0), cA + kstepA, voffA); PG8_STAGE(PG8_SB(1, 1), cB + hB + kstep, voffB);
        PG8_WAIT_V(6); PG8_BAR;
    }
    for (;;) {
        const bool has_next = S.next(ui + 1, nxt);
        const char* nA = has_next ? S.Ap(nxt) : cA; const char* nB = has_next ? S.Bp(nxt) : cB;
        for (int t = 0; t < nt; t += 2) {
            const bool last = (t == nt - 2);
            const char* a1 = cA + (size_t)(t + 1) * kstepA;
            const char* a2 = last ? nA : cA + (size_t)(t + 2) * kstepA; const char* b2 = last ? nB : cB + (size_t)(t + 2) * kstep;
            const char* a3 = a2 + kstepA; const char* b3 = b2 + kstep;
            if constexpr (SP2) {
            PG8_LDB(B0, 0, 0); PG8_LDB(B1, 0, 1); PG8_SCHED; PG8_LDA(At, 0, 0); PG8_STAGE(PG8_SA(1, 1), a1 + hA, voffA);
            PG8_WAIT_V(8); PG8_WAIT_L(0); PG8_BAR; PG8_MMA(0, 0, At, B0); PG8_MMA(0, 1, At, B1); PG8_BAR; PG8_SCHED;
            PG8_LDA(At, 0, 1); PG8_STAGE(PG8_SB(0, 0), b2, voffB); PG8_STAGE(PG8_SB(0, 1), b2 + hB, voffB); PG8_STAGE(PG8_SA(0, 0), a2, voffA);
            PG8_WAIT_V(8); PG8_WAIT_L(0); PG8_BAR; PG8_MMA(1, 0, At, B0); PG8_MMA(1, 1, At, B1); PG8_BAR; PG8_SCHED;
            PG8_LDB(B0, 1, 0); PG8_LDB(B1, 1, 1); PG8_SCHED; PG8_LDA(At, 1, 0); PG8_STAGE(PG8_SA(0, 1), a2 + hA, voffA);
            PG8_WAIT_V(8); PG8_WAIT_L(0); PG8_BAR; PG8_MMA(0, 0, At, B0); PG8_MMA(0, 1, At, B1); PG8_BAR; PG8_SCHED;
            PG8_LDA(At, 1, 1); PG8_STAGE(PG8_SB(1, 0), b3, voffB); PG8_STAGE(PG8_SB(1, 1), b3 + hB, voffB); PG8_STAGE(PG8_SA(1, 0), a3, voffA);
            PG8_WAIT_V(8); PG8_WAIT_L(0); PG8_BAR; PG8_MMA(1, 0, At, B0); PG8_MMA(1, 1, At, B1); PG8_BAR; PG8_SCHED;
            } else {
            PG8_LDB(B0, 0, 0); PG8_SCHED; PG8_LDA(At, 0, 0); PG8_STAGE(PG8_SA(1, 1), a1 + hA, voffA);
            PG8_WAIT_L(8); PG8_BAR; PG8_WAIT_L(0); PG8_MMA(0, 0, At, B0); PG8_BAR; PG8_SCHED;
            PG8_LDB(B1, 0, 1); PG8_STAGE(PG8_SB(0, 0), b2, voffB);
            PG8_BAR; PG8_WAIT_L(0); PG8_MMA(0, 1, At, B1); PG8_BAR;
            PG8_LDA(At, 0, 1); PG8_STAGE(PG8_SA(0, 0), a2, voffA);
            PG8_BAR; PG8_WAIT_L(0); PG8_MMA(1, 0, At, B0); PG8_BAR; PG8_SCHED;
            PG8_STAGE(PG8_SB(0, 1), b2 + hB, voffB);
            PG8_WAIT_V(6); PG8_BAR; PG8_MMA(1, 1, At, B1); PG8_BAR;
            PG8_LDB(B0, 1, 0); PG8_SCHED; PG8_LDA(At, 1, 0); PG8_STAGE(PG8_SA(0, 1), a2 + hA, voffA);
            PG8_WAIT_L(8); PG8_BAR; PG8_WAIT_L(0); PG8_MMA(0, 0, At, B0); PG8_BAR; PG8_SCHED;
            PG8_LDB(B1, 1, 1); PG8_STAGE(PG8_SB(1, 0), b3, voffB);
            PG8_BAR; PG8_WAIT_L(0); PG8_MMA(0, 1, At, B1); PG8_BAR;
            PG8_LDA(At, 1, 1); PG8_STAGE(PG8_SA(1, 0), a3, voffA);
            PG8_BAR; PG8_WAIT_L(0); PG8_MMA(1, 0, At, B0); PG8_BAR; PG8_SCHED;
            PG8_STAGE(PG8_SB(1, 1), b3 + hB, voffB);
            PG8_WAIT_V(6); PG8_BAR; PG8_MMA(1, 1, At, B1); PG8_BAR;
            }
        }
        if constexpr (ALIGN_EPI) { if (wr == 0) PG8_BAR; }
        { const int lane_e = hw_lane();
          E(acc, cur, wr, wc, lane_e & 15, lane_e >> 4); }
        if (!has_next) break;
        if (!E.keep(cur)) {
#pragma unroll
        for (int a = 0; a < 2; ++a)
#pragma unroll
            for (int b = 0; b < 2; ++b)
#pragma unroll
                for (int m = 0; m < 4; ++m)
#pragma unroll
                    for (int n = 0; n < 2; ++n) acc[a][b][m][n] = (f32x4){0.f, 0.f, 0.f, 0.f};
        }
        cur = nxt; cA = nA; cB = nB; ++ui;
        if constexpr (ALIGN_EPI) { if (wr == 1) PG8_BAR; }
    }
    PG8_WAIT_V(0);
    if constexpr (!ALIGN_EPI) { if (wr == 0) PG8_BAR; }
    PG8_BAR;
#undef PG8_SA
#undef PG8_SB
#undef PG8_STAGE
#undef PG8_LDA
#undef PG8_LDB
#undef PG8_MMA
#undef PG8_WAIT_V
#undef PG8_WAIT_L
#undef PG8_BAR
#undef PG8_SCHED
}
}

#define XB_TMO      128
#define XB_XCNT(j)  (256  + 64 * (j))
#define XB_XSUB(j)  (1280 + 64 * (j))
#define XB_XGEN(j)  (2304 + 64 * (j))
#define XB_TOP      3328
#define XB_TOPGEN   3392
#define XCD_BAR_WORDS 3456
#define XB_SPIN_CAP (1u << 18)
__device__ __forceinline__ unsigned xb_ld(unsigned* p)              { return __hip_atomic_load(p, __ATOMIC_RELAXED, __HIP_MEMORY_SCOPE_AGENT); }
__device__ __forceinline__ unsigned xb_add(unsigned* p, unsigned v) { return __hip_atomic_fetch_add(p, v, __ATOMIC_RELAXED, __HIP_MEMORY_SCOPE_AGENT); }
__device__ __forceinline__ unsigned xb_xcc_id() { return (unsigned)__builtin_amdgcn_s_getreg((3 << 11) | 20) & 0xFu; }
#define XB_SPIN(cond, bar) do { unsigned _sp = 0; while (cond) { __builtin_amdgcn_s_sleep(1); \
    if ((++_sp & 255u) == 0u) { if (xb_ld(&(bar)[XB_TMO])) break; if (_sp > XB_SPIN_CAP) { atomicAdd(&(bar)[XB_TMO], 1u); break; } } } } while (0)
struct XcdBarrier { unsigned* bar; unsigned x; volatile LAS unsigned* st; };
__device__ __forceinline__ XcdBarrier xcd_barrier_post(unsigned* bar, volatile LAS unsigned* st) {
    XcdBarrier b; b.bar = bar; b.x = xb_xcc_id(); b.st = st;
    if (threadIdx.x == 0) (void)xb_add(&bar[XB_XCNT(b.x)], 1u);
    return b;
}
__device__ __forceinline__ void xcd_barrier_complete(unsigned* bar, unsigned x, unsigned& nloc, unsigned& nx) {
    const unsigned G = gridDim.x * gridDim.y * gridDim.z;
    unsigned sum, cnt, mine, sp = 0u;
    for (;;) {
        sum = 0u; cnt = 0u; mine = 0u;
#pragma unroll
        for (unsigned j = 0; j < 16; ++j) { const unsigned c = xb_ld(&bar[XB_XCNT(j)]); sum += c; cnt += (c > 0u) ? 1u : 0u; mine = (j == x) ? c : mine; }
        if (sum == G) break;
        __builtin_amdgcn_s_sleep(1);
        if ((++sp & 255u) == 0u) { if (xb_ld(&bar[XB_TMO])) break; if (sp > XB_SPIN_CAP) { atomicAdd(&bar[XB_TMO], 1u); break; } }
    }
    nloc = mine > 0u ? mine : 1u; nx = cnt > 0u ? cnt : 1u;
}
__device__ __forceinline__ void xcd_barrier(const XcdBarrier& b, const int wv) {
    asm volatile("s_waitcnt vmcnt(0)" ::: "memory");
    __syncthreads();
    if (wv == 0 && hw_lane() == 0) {
        unsigned* bar = b.bar;
        __builtin_amdgcn_s_waitcnt(0);
        unsigned nloc = b.st[0], nx = b.st[1];
        if (nloc == 0u) { xcd_barrier_complete(bar, b.x, nloc, nx); b.st[0] = nloc; b.st[1] = nx; }
        const unsigned old = xb_add(&bar[XB_XSUB(b.x)], 1u);
        const unsigned gen = old / nloc;
        if (old + 1u == (gen + 1u) * nloc) {
            __builtin_amdgcn_fence(__ATOMIC_RELEASE, "agent");
            asm volatile("s_waitcnt vmcnt(0)" ::: "memory");
            const unsigned og = xb_add(&bar[XB_TOP], 1u);
            const unsigned tg = og / nx;
            if (og + 1u == (tg + 1u) * nx) xb_add(&bar[XB_TOPGEN], 1u);
            else XB_SPIN(xb_ld(&bar[XB_TOPGEN]) == tg, bar);
            __builtin_amdgcn_fence(__ATOMIC_ACQUIRE, "agent");
            xb_add(&bar[XB_XGEN(b.x)], 1u);
            asm volatile("s_waitcnt vmcnt(0)" ::: "memory");
        } else {
            XB_SPIN(xb_ld(&bar[XB_XGEN(b.x)]) == gen, bar);
            __builtin_amdgcn_fence(__ATOMIC_ACQUIRE, "agent");
            asm volatile("s_waitcnt vmcnt(0)" ::: "memory");
        }
    }
    __syncthreads();
}

struct Args { const float* in[33]; float* out; unsigned char* ws; };
__device__ __forceinline__ const float* inp(int i) {
    unsigned off = (unsigned)i * 8u; asm volatile("" : "+s"(off));
    typedef const float* cfp;
    return *(const __attribute__((address_space(4))) cfp*)((const __attribute__((address_space(4))) char*)__builtin_amdgcn_kernarg_segment_ptr() + off);
}

#define WSP(off) (inp_ws() + (off))
__device__ __forceinline__ unsigned char* inp_ws() { return (unsigned char*)inp(34); }
__device__ __forceinline__ float* inp_out() { return (float*)inp(33); }

__device__ __forceinline__ void transpose_item(const float* W, int ldw, int K, bf16_t* WT, int src_n0, int dst_n0, int k0, LAS float* scr, int lane) {
#pragma unroll 8
    for (int i = 0; i < 32; ++i) { const int kk = 2 * i + (lane >> 5); scr[kk * 33 + (lane & 31)] = W[(size_t)(k0 + kk) * ldw + src_n0 + (lane & 31)]; }
    LDS_WAIT(); asm volatile("" ::: "memory");
    const int c = lane & 7;
#pragma unroll
    for (int j = 0; j < 4; ++j) { const int n = (lane >> 3) + 8 * j; const LAS float* s = scr + (8 * c) * 33 + n;
        u32x4 o; o.x = pk2(s[0 * 33], s[1 * 33]); o.y = pk2(s[2 * 33], s[3 * 33]); o.z = pk2(s[4 * 33], s[5 * 33]); o.w = pk2(s[6 * 33], s[7 * 33]);
        *(u32x4*)(WT + (size_t)(dst_n0 + n) * K + k0 + 8 * c) = o; }
    LDS_WAIT(); asm volatile("" ::: "memory");
}
template <int MAP>
__device__ __forceinline__ void convert_matrix(const float* W, int ldw, int K, int Ndst, bf16_t* WT, LAS float* scr, int lane, int gw, int NGW, int& base) {
    const int nblk = Ndst / 32, nitems = (K / 64) * nblk;
    int first = (gw - base % NGW + NGW) % NGW;
    for (int it = first; it < nitems; it += NGW) {
        const int kb = it / nblk, nb = it % nblk, d0 = nb * 32;
        int s0 = d0;
        if (MAP == 1) s0 = d0 + (d0 < 1024 ? 0 : (d0 < 2560 ? 16 : 24));
        if (MAP == 2) { const int pn = d0 >> 8, hh = (d0 & 255) >> 7, r = d0 & 127; s0 = hh * FF + pn * 128 + r; }
        transpose_item(W, ldw, K, WT, s0, d0, kb * 64, scr, lane);
    }
    base += nitems;
}

__device__ __forceinline__ void ada_phase(LAS unsigned char* lds, int blk, int wave, int lane) {
    if (blk >= 192) return;
    const int l = blk / 96, n0 = (blk % 96) * 64;
    const float* c = inp(1); const float* W = inp(2) + (size_t)l * 1024 * 6144; const float* bias = inp(3) + l * 6144;
    LAS float* part = (LAS float*)lds;
    float acc[8] = {0.f, 0.f, 0.f, 0.f, 0.f, 0.f, 0.f, 0.f};
    for (int k = wave * 128; k < wave * 128 + 128; ++k) {
        const float wv = W[(size_t)k * 6144 + n0 + lane];
#pragma unroll
        for (int b = 0; b < 8; ++b) { const float cv = c[b * 1024 + k]; acc[b] += siluf_(cv) * wv; }
    }
#pragma unroll
    for (int b = 0; b < 8; ++b) part[(wave * 8 + b) * 64 + lane] = acc[b];
    __syncthreads();
    {
        const int b = wave; float s = bias[n0 + lane];
#pragma unroll
        for (int w = 0; w < 8; ++w) s += part[(w * 8 + b) * 64 + lane];
        ((float*)WSP(WS_MOD))[(size_t)(l * 8 + b) * 6144 + n0 + lane] = s;
    }
    __syncthreads();
}

template <bool WITH_POST, bool WITH_PRE>
__device__ __forceinline__ void norm_rows(const bf16_t* Y, int ldy, const float* xin, const float* pw, const float* modl_post, int gt_off, float* xout,
                                          const float* w2, const float* modl_pre, int sh_off, int sc_off, bf16_t* H, int gw, int NGW, int lane) {
    f32x4 xc[2][4], xn[2][4]; u32x2 yc[2][4], yn[2][4];
#pragma unroll
    for (int q = 0; q < 2; ++q)
#pragma unroll
        for (int j = 0; j < 4; ++j) { xc[q][j] = *(const f32x4*)(xin + (size_t)(gw + q * NGW) * D + (lane + 64 * j) * 4);
            if (WITH_POST) yc[q][j] = *(const u32x2*)(Y + (size_t)(gw + q * NGW) * ldy + (lane + 64 * j) * 4); else yc[q][j] = (u32x2){0u, 0u}; xn[q][j] = xc[q][j]; yn[q][j] = yc[q][j]; }
    for (int row0 = gw; row0 < M; row0 += 2 * NGW) {
        const int rown = row0 + 2 * NGW;
        if (rown < M) {
#pragma unroll
            for (int q = 0; q < 2; ++q)
#pragma unroll
                for (int j = 0; j < 4; ++j) { xn[q][j] = *(const f32x4*)(xin + (size_t)(rown + q * NGW) * D + (lane + 64 * j) * 4);
                    if (WITH_POST) yn[q][j] = *(const u32x2*)(Y + (size_t)(rown + q * NGW) * ldy + (lane + 64 * j) * 4); }
        }
        f32x4 v[2][4];
        if (WITH_POST) {
            float ss[2] = {0.f, 0.f};
#pragma unroll
            for (int q = 0; q < 2; ++q)
#pragma unroll
                for (int j = 0; j < 4; ++j) { const u32x2 y = yc[q][j];
                    v[q][j] = (f32x4){bflo(y.x), bfhi(y.x), bflo(y.y), bfhi(y.y)}; ss[q] += v[q][j][0] * v[q][j][0] + v[q][j][1] * v[q][j][1] + v[q][j][2] * v[q][j][2] + v[q][j][3] * v[q][j][3]; }
#pragma unroll
            for (int o = 1; o < 64; o <<= 1) { const float t0 = shl(ss[0], lane ^ o), t1 = shl(ss[1], lane ^ o); ss[0] += t0; ss[1] += t1; }
#pragma unroll
            for (int q = 0; q < 2; ++q) {
                const int row = row0 + q * NGW, b = row / T;
                const float r = rsqrtf(ss[q] * (1.f / D) + 1e-6f);
                const float* gt = modl_post + (size_t)b * 6144 + gt_off;
#pragma unroll
                for (int j = 0; j < 4; ++j) {
                    const int col = (lane + 64 * j) * 4;
                    const f32x4 xo = xc[q][j], pwv = *(const f32x4*)(pw + col), gtv = *(const f32x4*)(gt + col);
#pragma unroll
                    for (int e = 0; e < 4; ++e) v[q][j][e] = xo[e] + (1.f + gtv[e]) * (v[q][j][e] * r * pwv[e]);
                    *(f32x4*)(xout + (size_t)row * D + col) = v[q][j];
                }
            }
        } else {
#pragma unroll
            for (int q = 0; q < 2; ++q)
#pragma unroll
                for (int j = 0; j < 4; ++j) v[q][j] = xc[q][j];
        }
        if (WITH_PRE) {
            float ss[2] = {0.f, 0.f};
#pragma unroll
            for (int q = 0; q < 2; ++q)
#pragma unroll
                for (int j = 0; j < 4; ++j) ss[q] += v[q][j][0] * v[q][j][0] + v[q][j][1] * v[q][j][1] + v[q][j][2] * v[q][j][2] + v[q][j][3] * v[q][j][3];
#pragma unroll
            for (int o = 1; o < 64; o <<= 1) { const float t0 = shl(ss[0], lane ^ o), t1 = shl(ss[1], lane ^ o); ss[0] += t0; ss[1] += t1; }
#pragma unroll
            for (int q = 0; q < 2; ++q) {
                const int row = row0 + q * NGW, b = row / T;
                const float r2 = rsqrtf(ss[q] * (1.f / D) + 1e-6f);
                const float* sh = modl_pre + (size_t)b * 6144 + sh_off; const float* sc = modl_pre + (size_t)b * 6144 + sc_off;
#pragma unroll
                for (int j = 0; j < 4; ++j) {
                    const int col = (lane + 64 * j) * 4;
                    const f32x4 wv = *(const f32x4*)(w2 + col), scv = *(const f32x4*)(sc + col), shv = *(const f32x4*)(sh + col);
#pragma unroll
                    for (int e = 0; e < 4; ++e) v[q][j][e] = v[q][j][e] * r2 * wv[e] * (1.f + scv[e]) + shv[e];
                    u32x2 o; o.x = pk2(v[q][j][0], v[q][j][1]); o.y = pk2(v[q][j][2], v[q][j][3]);
                    *(u32x2*)(H + (size_t)row * D + col) = o;
                }
            }
        }
#pragma unroll
        for (int q = 0; q < 2; ++q)
#pragma unroll
            for (int j = 0; j < 4; ++j) { xc[q][j] = xn[q][j]; yc[q][j] = yn[q][j]; }
    }
}
__device__ __forceinline__ void zs_mfma(const bf16_t* H, const bf16_t* Wsm, float* ZS, int task, int lane) {
    typedef float f32x16_ __attribute__((ext_vector_type(16)));
    const int r32 = lane & 31, hh = lane >> 5;
    const bf16_t* ap = H + (size_t)(32 * task + r32) * D + 8 * hh;
    const bf16_t* bp = Wsm + (size_t)r32 * D + 8 * hh;
    f32x16_ acc;
#pragma unroll
    for (int r = 0; r < 16; ++r) acc[r] = 0.f;
#pragma unroll 8
    for (int ks = 0; ks < D / 16; ++ks) acc = __builtin_amdgcn_mfma_f32_32x32x16_bf16(*(const bf16x8*)(ap + 16 * ks), *(const bf16x8*)(bp + 16 * ks), acc, 0, 0, 0);
    if (r32 < 24) {
#pragma unroll
        for (int r = 0; r < 16; ++r) ZS[(size_t)(32 * task + (r & 3) + 8 * (r >> 2) + 4 * hh) * 32 + r32] = acc[r];
    }
}
__device__ __forceinline__ void convert_small(const float* w_in, bf16_t* Wsm, int part, int tid) {
    for (int i = tid; i < 4 * 1024; i += NWAVES * 64) {
        const int c = 4 * part + (i >> 10), k = i & 1023;
        float v = 0.f;
        if (c < 16) v = w_in[(size_t)k * INDIM + 1024 + c]; else if (c < 24) v = w_in[(size_t)k * INDIM + 2576 + (c - 16)];
        Wsm[c * 1024 + k] = (bf16_t)f2bf(v);
    }
}

__device__ __forceinline__ void s5_generate(int l, int g, LAS unsigned char* lds, int wv) {
    int tid = hw_tid(wv); asm volatile("" : "+v"(tid));
    LAS float* ar = (LAS float*)lds;
    LAS float* ai = ar + 17 * 64;
    LAS float* bbr = ai + 17 * 64;
    LAS float* bbi = bbr + 1024;
    LAS float* cr = bbi + 1024;
    LAS float* ci = cr + 1024;
    LAS float* Kt = ci + 1024;
    bf16_t* Bt1 = (bf16_t*)WSP(WS_S5M1) + (size_t)g * 384 * 256;
    bf16_t* Bt3 = (bf16_t*)WSP(WS_S5M3) + (size_t)g * 256 * 256;
    __syncthreads();
    if (tid < 64) {
        const int p = tid;
        const float lre = fminf((inp(16) + l * 2048)[g * 64 + p], -1e-4f), lim = (inp(17) + l * 2048)[g * 64 + p], dt = expf((inp(18) + l * 32)[g]);
        for (int k = 0; k <= 16; ++k) { const float mg = expf((float)k * lre * dt), an = (float)k * lim * dt; ar[k * 64 + p] = mg * cosf(an); ai[k * 64 + p] = mg * sinf(an); }
        const float a1r = ar[64 + p], a1i = ai[64 + p];
        const float inv = 1.f / (lre * lre + lim * lim);
        const float zr_ = ((a1r - 1.f) * lre + a1i * lim) * inv, zi_ = (a1i * lre - (a1r - 1.f) * lim) * inv;
        const float* b_re = inp(19) + (size_t)l * 32768 + (size_t)(g * 64 + p) * 16; const float* b_im = inp(20) + (size_t)l * 32768 + (size_t)(g * 64 + p) * 16;
        for (int c = 0; c < 16; ++c) { const float br = b_re[c], bi = b_im[c]; bbr[p * 16 + c] = zr_ * br - zi_ * bi; bbi[p * 16 + c] = zr_ * bi + zi_ * br; }
    }
    for (int i = tid; i < 1024; i += 512) { cr[i] = (inp(21) + (size_t)l * 32768)[g * 1024 + i]; ci[i] = (inp(22) + (size_t)l * 32768)[g * 1024 + i]; }
    __syncthreads();
    {
        const int cp = tid >> 5, c = (tid >> 1) & 15, ph = tid & 1;
        float acc[16];
#pragma unroll
        for (int t = 0; t < 16; ++t) acc[t] = 0.f;
        for (int pp = 0; pp < 32; ++pp) {
            const int p = 32 * ph + pp;
            const float xr = cr[cp * 64 + p], xi = ci[cp * 64 + p], yr = bbr[p * 16 + c], yi = bbi[p * 16 + c];
            const float cbr = xr * yr - xi * yi, cbi = xr * yi + xi * yr;
#pragma unroll
            for (int t = 0; t < 16; ++t) acc[t] += cbr * ar[t * 64 + p] - cbi * ai[t * 64 + p];
        }
#pragma unroll
        for (int t = 0; t < 16; ++t) { const float o = acc[t] + shl(acc[t], (tid & 63) ^ 1); if (ph == 0) Kt[(t * 16 + cp) * 16 + c] = o; }
    }
    __syncthreads();
    for (int pc = tid; pc < 128 * 32; pc += 512) {
        const int row = pc >> 5, k0 = (pc & 31) * 8, sp = k0 >> 4, c0 = k0 & 15, p = row >> 1, e15 = 15 - sp;
        const float xr = ar[e15 * 64 + p], xi = ai[e15 * 64 + p];
        float v[8];
#pragma unroll
        for (int e = 0; e < 8; ++e) { const float yr = bbr[p * 16 + c0 + e], yi = bbi[p * 16 + c0 + e]; v[e] = (row & 1) == 0 ? (xr * yr - xi * yi) : (xr * yi + xi * yr); }
        u32x4 w; w.x = pk2(v[0], v[1]); w.y = pk2(v[2], v[3]); w.z = pk2(v[4], v[5]); w.w = pk2(v[6], v[7]);
        *(u32x4*)(Bt1 + (size_t)row * 256 + k0) = w;
    }
    for (int pc = tid; pc < 256 * 32; pc += 512) {
        const int j = pc >> 5, k0 = (pc & 31) * 8, s = j >> 4, cp = j & 15, sp = k0 >> 4, c0 = k0 & 15;
        float v[8];
#pragma unroll
        for (int e = 0; e < 8; ++e) v[e] = (sp <= s) ? Kt[((s - sp) * 16 + cp) * 16 + c0 + e] : 0.f;
        u32x4 w; w.x = pk2(v[0], v[1]); w.y = pk2(v[2], v[3]); w.z = pk2(v[4], v[5]); w.w = pk2(v[6], v[7]);
        *(u32x4*)(Bt1 + (size_t)(128 + j) * 256 + k0) = w;
    }
    for (int pc = tid; pc < 256 * 32; pc += 512) {
        const int j = pc >> 5, k0 = (pc & 31) * 8, s = j >> 4, cp = j & 15;
        float v[8];
#pragma unroll
        for (int e = 0; e < 8; ++e) {
            const int k = k0 + e, p = (k >> 1) & 63;
            const float xr = cr[cp * 64 + p], xi = ci[cp * 64 + p], yr = ar[(s + 1) * 64 + p], yi = ai[(s + 1) * 64 + p];
            v[e] = k >= 128 ? 0.f : ((k & 1) == 0 ? (xr * yr - xi * yi) : -(xr * yi + xi * yr));
        }
        u32x4 w; w.x = pk2(v[0], v[1]); w.y = pk2(v[2], v[3]); w.z = pk2(v[4], v[5]); w.w = pk2(v[6], v[7]);
        *(u32x4*)(Bt3 + (size_t)j * 256 + k0) = w;
    }
    __syncthreads();
}
__device__ __forceinline__ void s5_scan(int l, int sid, int lane) {
    const int g = sid >> 3, b = sid & 7, p = lane;
    const float lre = fminf((inp(16) + l * 2048)[g * 64 + p], -1e-4f), lim = (inp(17) + l * 2048)[g * 64 + p], dt = expf((inp(18) + l * 32)[g]);
    const float mg = expf(16.f * lre * dt), an = 16.f * lim * dt, a16r = mg * cosf(an), a16i = mg * sinf(an);
    char* base = (char*)((bf16_t*)WSP(WS_Z) + (size_t)((g & 15) * 2048 + b * 256) * ZLD + EXC + (g >> 4) * 256);
    constexpr size_t RP = (size_t)ZLD * 2;
    float xr = 0.f, xi = 0.f;
    f32x2 ec[16], en[16];
#pragma unroll
    for (int j = 0; j < 16; ++j) { ec[j] = *(const f32x2*)(base + (size_t)j * RP + 8 * p); en[j] = ec[j]; }
#pragma unroll 1
    for (int n0 = 0; n0 < 256; n0 += 16) {
        if (n0 + 16 < 256) {
#pragma unroll
            for (int j = 0; j < 16; ++j) en[j] = *(const f32x2*)(base + (size_t)(n0 + 16 + j) * RP + 8 * p);
        }
        asm volatile("s_waitcnt vmcnt(16)" ::: "memory");
#pragma unroll
        for (int j = 0; j < 16; ++j) {
            unsigned* row = (unsigned*)(base + (size_t)(n0 + j) * RP);
            row[p] = pk2(xr, xi); row[64 + p] = 0u;
            const float tr = a16r * xr - a16i * xi + ec[j][0], ti = a16r * xi + a16i * xr + ec[j][1];
            xr = tr; xi = ti;
        }
#pragma unroll
        for (int j = 0; j < 16; ++j) ec[j] = en[j];
    }
}

namespace mx {
typedef float f32x16 __attribute__((ext_vector_type(16)));
__device__ __forceinline__ unsigned cpk(float lo, float hi) { return pg8::cvt_pk_bf16(lo, hi); }
__device__ __forceinline__ unsigned cpk1(float x) { return pg8::cvt_pk_bf16(x, x); }
constexpr int PB = 72;
constexpr int L_QS = 0, L_KS = 9216, L_KT = 18432, L_VT = 27648, L_PS = 46080, L_ST = 55296, L_OS = 73728, L_VEC = 107520;
constexpr int OSP = 132;
constexpr int V_SEG = 0, V_ELAST = 512, V_GA = 576, V_SETS = 1600, SETSZ = 384, V_RT = 0, V_CS = 64, V_WI = 128, V_WK = 192, V_ENM = 256, V_SC = 320, V_DEN = 2368, V_NORM = 2432, V_END = 2560;
static_assert(L_VEC + V_END * 4 <= RING_BYTES, "mixer LDS map");
__device__ __forceinline__ int crow(int reg, int hh) { return (reg & 3) + 8 * (reg >> 2) + 4 * hh; }
__device__ __forceinline__ float fexp(float x) { return __builtin_amdgcn_exp2f(1.4426950408889634f * x); }
__device__ __forceinline__ float flogsig(float x) { const float e = fexp(-fabsf(x)); return fminf(x, 0.f) - 0.6931471805599453f * __builtin_amdgcn_logf(1.f + e); }
#define MX_MFMA(a, b, c) __builtin_amdgcn_mfma_f32_32x32x16_bf16((a), (b), (c), 0, 0, 0)

template <int ROLE, bool STORE = true>
__device__ __forceinline__ void stream(int l, LAS unsigned char* lds, int bh, int wvs) {
    int tid = hw_tid(wvs); asm volatile("" : "+v"(tid));
    const int lane = tid & 63, w = __builtin_amdgcn_readfirstlane(tid >> 6), r32 = lane & 31, hh = lane >> 5;
    const int b = bh >> 2, h = bh & 3;
    bf16_t* Z = (bf16_t*)WSP(WS_Z); const float* ZS = (const float*)WSP(WS_ZS);
    LAS float* vec = (LAS float*)(lds + L_VEC);
    LAS bf16_t* Qs = (LAS bf16_t*)(lds + L_QS); LAS bf16_t* Ks = (LAS bf16_t*)(lds + L_KS); LAS bf16_t* KTs = (LAS bf16_t*)(lds + L_KT);
    LAS bf16_t* VTs = (LAS bf16_t*)(lds + L_VT); LAS bf16_t* Ps = (LAS bf16_t*)(lds + L_PS); LAS bf16_t* STs = (LAS bf16_t*)(lds + L_ST);
    LAS float* Os = (LAS float*)(lds + L_OS);
    const int qcol = (ROLE == 0 ? GQ : MQ) + h * 64, kcol = (ROLE == 0 ? GK : MK) + h * 64, vcol = (ROLE == 0 ? GV : MV) + h * 128, gcol = (ROLE == 0 ? GR : MO) + h * 128;
    const int vc_ = tid & 127, rq = tid >> 7, et = tid >> 3, cg = tid & 7;
    const int wa = w >> 2, wv = w & 3;
    float a2c[16], abd = 0.f, nwv[16];
    float cwq[4], cwk[4], cbq = 0.f, cbk = 0.f, ibh = 0.f, fbh = 0.f, mprev = 0.f;
#pragma unroll
    for (int r = 0; r < 16; ++r) { a2c[r] = 0.f; nwv[r] = 0.f; }
#pragma unroll
    for (int j = 0; j < 4; ++j) { cwq[j] = 0.f; cwk[j] = 0.f; }
    if (ROLE == 0) {
        const float* a2 = inp(9) + l * 16 * 256; const float* ab = inp(10) + l * 256; const float* nw = inp(11) + l * 512;
#pragma unroll
        for (int r = 0; r < 16; ++r) { a2c[r] = a2[r * 256 + h * 64 + lane]; nwv[r] = nw[h * 128 + 16 * cg + r]; }
        abd = ab[h * 64 + lane];
    } else {
        const float* cw = inp(12) + l * 4 * 512; const float* cb = inp(13) + l * 512;
#pragma unroll
        for (int j = 0; j < 4; ++j) { cwq[j] = cw[j * 512 + h * 64 + lane]; cwk[j] = cw[j * 512 + 256 + h * 64 + lane]; }
        cbq = cb[h * 64 + lane]; cbk = cb[256 + h * 64 + lane];
        ibh = (inp(14) + l * 4)[h]; fbh = (inp(15) + l * 4)[h];
    }
    for (int i = tid; i < 128 * PB / 2; i += 512) ((LAS unsigned*)STs)[i] = 0u;
    for (int i = tid; i < 64 * PB / 2; i += 512) ((LAS unsigned*)Ps)[i] = 0u;
    if (tid < 128) vec[V_NORM + tid] = 0.f;
    f32x16 accS;
#pragma unroll
    for (int r = 0; r < 16; ++r) accS[r] = 0.f;
    unsigned qi[11], ki[11], vi[16]; float zs0 = 0.f, zs1 = 0.f; u32x4 gt0 = {0u, 0u, 0u, 0u}, gt1 = {0u, 0u, 0u, 0u};
#define MX_LOAD(mrow, nn) do { \
        if (ROLE == 0) { \
            _Pragma("unroll") for (int i = 0; i < 8; ++i) { const bf16_t* zr = Z + ((mrow) + 8 * w + i) * ZLD; qi[i] = *(const unsigned*)(zr + qcol + (lane & ~1)); ki[i] = *(const unsigned*)(zr + kcol + (lane & ~1)); } \
            const float* zp = ZS + ((mrow) + et) * 32 + 2 * cg; zs0 = zp[0]; zs1 = zp[1]; \
        } else { \
            _Pragma("unroll") for (int i = 0; i < 11; ++i) { const int trel = 8 * w + i - 3; const int trc = ((nn) > 0 || trel >= 0) ? trel : 0;     \
                const bf16_t* zr = Z + ((mrow) + trc) * ZLD; qi[i] = *(const unsigned*)(zr + qcol + (lane & ~1)); ki[i] = *(const unsigned*)(zr + kcol + (lane & ~1)); } \
            if (w == 7) { const float* zp = ZS + ((mrow) + lane) * 32; zs0 = zp[16 + h]; zs1 = zp[20 + h]; } \
        } \
        _Pragma("unroll") for (int i = 0; i < 16; ++i) vi[i] = *(const unsigned*)(Z + ((mrow) + 16 * rq + i) * ZLD + vcol + (vc_ & ~1)); \
    } while (0)
#define MX_SCALARS(sv) do { \
        asm volatile("" : "+v"(zs0), "+v"(zs1)); \
        const float ip = zs0 + ibh, lf = flogsig(zs1 + fbh); \
        float bs = lf; \
        _Pragma("unroll") for (int o = 1; o < 64; o <<= 1) { const float t = shl(bs, lane >= o ? lane - o : lane); if (lane >= o) bs += t; } \
        const float cs = ip - bs; \
        float pm = cs; \
        _Pragma("unroll") for (int o = 1; o < 64; o <<= 1) { const float t = shl(pm, lane >= o ? lane - o : lane); if (lane >= o) pm = fmaxf(pm, t); } \
        const float mt = bs + fmaxf(mprev, pm); \
        (sv)[V_RT + lane] = bs - mt; (sv)[V_CS + lane] = cs; (sv)[V_WI + lane] = fexp(bs + mprev - mt); (sv)[V_ENM + lane] = fexp(-mt); \
        const float mnew = shl(mt, 63), b63 = shl(bs, 63); \
        (sv)[V_WK + lane] = fexp(b63 + cs - mnew); \
        if (lane == 0) (sv)[V_SC] = fexp(b63 + mprev - mnew); \
        mprev = mnew; \
    } while (0)
#define MX_PIN11(a) asm volatile("" : "+v"(a[0]), "+v"(a[1]), "+v"(a[2]), "+v"(a[3]), "+v"(a[4]), "+v"(a[5]), "+v"(a[6]), "+v"(a[7]), "+v"(a[8]), "+v"(a[9]), "+v"(a[10]))
#define MX_PIN8(a, o) asm volatile("" : "+v"(a[o]), "+v"(a[o + 1]), "+v"(a[o + 2]), "+v"(a[o + 3]), "+v"(a[o + 4]), "+v"(a[o + 5]), "+v"(a[o + 6]), "+v"(a[o + 7]))
    size_t m0 = (size_t)b * T;
    MX_LOAD(m0, 0);
    if (ROLE == 0) { vec[V_GA + et * 16 + 2 * cg] = zs0; vec[V_GA + et * 16 + 2 * cg + 1] = zs1; }
    else if (w == 7) MX_SCALARS(vec + V_SETS);
    __syncthreads();

#pragma unroll 1
    for (int n = 0; n <= 64; ++n) {
        if (n > 0) {
            const size_t mp = m0 - 64;
            const LAS float* orow = Os + et * OSP + 16 * cg;
            float o[16];
#pragma unroll
            for (int q4 = 0; q4 < 4; ++q4) { const f32x4 t4 = *(const LAS f32x4*)(orow + 4 * q4); o[4 * q4] = t4[0]; o[4 * q4 + 1] = t4[1]; o[4 * q4 + 2] = t4[2]; o[4 * q4 + 3] = t4[3]; }
            asm volatile("" : "+v"(gt0), "+v"(gt1));
            const unsigned gw_[8] = {gt0.x, gt0.y, gt0.z, gt0.w, gt1.x, gt1.y, gt1.z, gt1.w};
            float y[16];
            if (ROLE == 0) {
                float ss = 0.f;
#pragma unroll
                for (int e = 0; e < 16; ++e) ss += o[e] * o[e];
                ss += shl(ss, lane ^ 1); ss += shl(ss, lane ^ 2); ss += shl(ss, lane ^ 4);
                const float rn = rsqrtf(ss * (1.f / 128.f) + 1e-6f);
#pragma unroll
                for (int e = 0; e < 16; ++e) { const float g = (e & 1) ? bfhi(gw_[e >> 1]) : bflo(gw_[e >> 1]); y[e] = o[e] * rn * nwv[e] * g * fsigmoid(g); }
            } else {
                const float rdiv = vec[V_DEN + et];
#pragma unroll
                for (int e = 0; e < 16; ++e) { const float g = (e & 1) ? bfhi(gw_[e >> 1]) : bflo(gw_[e >> 1]); y[e] = o[e] * rdiv * fsigmoid(g); }
            }
            u32x4 s0, s1;
            s0.x = cpk(y[0], y[1]); s0.y = cpk(y[2], y[3]); s0.z = cpk(y[4], y[5]); s0.w = cpk(y[6], y[7]);
            s1.x = cpk(y[8], y[9]); s1.y = cpk(y[10], y[11]); s1.z = cpk(y[12], y[13]); s1.w = cpk(y[14], y[15]);
            bf16_t* dst = Z + (mp + et) * ZLD + gcol + 16 * cg;
            if (STORE) { *(u32x4*)dst = s0; *(u32x4*)(dst + 8) = s1; } else { asm volatile("" :: "v"(s0), "v"(s1), "v"(dst)); }
        }
        if (n == 64) break;
        if (ROLE == 0) { MX_PIN8(qi, 0); MX_PIN8(ki, 0); } else { MX_PIN11(qi); MX_PIN11(ki); if (n == 0 && w == 0) { qi[0] = qi[1] = qi[2] = 0u; ki[0] = ki[1] = ki[2] = 0u; } }
        float c8[8], qf[8], kf[8];
        const LAS float* sv = vec + V_SETS + (n & 1) * SETSZ;
        if (ROLE == 0) {
            float run = 0.f;
#pragma unroll
            for (int i = 0; i < 8; ++i) {
                const LAS f32x4* gp = (const LAS f32x4*)(vec + V_GA + (8 * w + i) * 16);
                float x = abd;
#pragma unroll
                for (int r4 = 0; r4 < 4; ++r4) { const f32x4 g4 = gp[r4]; x += g4[0] * a2c[4 * r4] + g4[1] * a2c[4 * r4 + 1] + g4[2] * a2c[4 * r4 + 2] + g4[3] * a2c[4 * r4 + 3]; }
                run += flogsig(x) * (1.f / 16.f); c8[i] = run;
                qf[i] = ((lane & 1) ? bfhi(qi[i]) : bflo(qi[i])) * 0.125f; kf[i] = (lane & 1) ? bfhi(ki[i]) : bflo(ki[i]);
            }
            vec[V_SEG + w * 64 + lane] = run;
        } else {
#pragma unroll
            for (int i = 0; i < 8; ++i) {
                float aq = cbq, ak = cbk;
#pragma unroll
                for (int j = 0; j < 4; ++j) { aq += cwq[j] * ((lane & 1) ? bfhi(qi[i + j]) : bflo(qi[i + j])); ak += cwk[j] * ((lane & 1) ? bfhi(ki[i + j]) : bflo(ki[i + j])); }
                qf[i] = aq * fsigmoid(aq); kf[i] = ak * fsigmoid(ak) * 0.125f; c8[i] = 0.f;
            }
        }
        if (ROLE == 0) __syncthreads();
        {
            u32x4 ktp; unsigned ktw[4];
            if (ROLE == 0) {
                float off = 0.f, tot = 0.f;
#pragma unroll
                for (int w2 = 0; w2 < 8; ++w2) { const float s = vec[V_SEG + w2 * 64 + lane]; tot += s; off += (w2 < w) ? s : 0.f; }
                if (w == 0) vec[V_ELAST + lane] = fexp(tot);
                float kt[8];
#pragma unroll
                for (int i = 0; i < 8; ++i) {
                    const float cum = off + c8[i];
                    Qs[(8 * w + i) * PB + lane] = (bf16_t)cpk1(qf[i] * fexp(cum));
                    Ks[(8 * w + i) * PB + lane] = (bf16_t)cpk1(kf[i] * fexp(-cum));
                    kt[i] = kf[i] * fexp(tot - cum);
                }
#pragma unroll
                for (int i = 0; i < 4; ++i) ktw[i] = cpk(kt[2 * i], kt[2 * i + 1]);
            } else {
                float kt[8];
#pragma unroll
                for (int i = 0; i < 8; ++i) {
                    Qs[(8 * w + i) * PB + lane] = (bf16_t)cpk1(qf[i]);
                    Ks[(8 * w + i) * PB + lane] = (bf16_t)cpk1(kf[i]);
                    kt[i] = kf[i] * sv[V_WK + 8 * w + i];
                }
#pragma unroll
                for (int i = 0; i < 4; ++i) ktw[i] = cpk(kt[2 * i], kt[2 * i + 1]);
            }
            ktp.x = ktw[0]; ktp.y = ktw[1]; ktp.z = ktw[2]; ktp.w = ktw[3];
            *(LAS u32x4*)(KTs + lane * PB + 8 * w) = ktp;
            MX_PIN8(vi, 0); MX_PIN8(vi, 8);
#pragma unroll
            for (int i = 0; i < 16; ++i) vi[i] = (vc_ & 1) ? (vi[i] >> 16) : (vi[i] & 0xffffu);
            u32x4 v0, v1;
            v0.x = vi[0] | ((unsigned)vi[1] << 16); v0.y = vi[2] | ((unsigned)vi[3] << 16); v0.z = vi[4] | ((unsigned)vi[5] << 16); v0.w = vi[6] | ((unsigned)vi[7] << 16);
            v1.x = vi[8] | ((unsigned)vi[9] << 16); v1.y = vi[10] | ((unsigned)vi[11] << 16); v1.z = vi[12] | ((unsigned)vi[13] << 16); v1.w = vi[14] | ((unsigned)vi[15] << 16);
            *(LAS u32x4*)(VTs + vc_ * PB + 16 * rq) = v0; *(LAS u32x4*)(VTs + vc_ * PB + 16 * rq + 8) = v1;
        }
        __syncthreads();
        { const bf16_t* gp = Z + (m0 + et) * ZLD + gcol + 16 * cg; gt0 = *(const u32x4*)gp; gt1 = *(const u32x4*)(gp + 8); }
        if (n < 63) MX_LOAD(m0 + 64, n + 1);
#define MX_FRAG(base, row, ks) (*(const LAS bf16x8*)(lds + (base) + ((row) * PB + 16 * (ks) + 8 * hh) * 2))
        if (w < 3) {
            const int ti = (w >= 1) ? 1 : 0, sj = (w == 2) ? 1 : 0;
            f32x16 sc;
#pragma unroll
            for (int r = 0; r < 16; ++r) sc[r] = 0.f;
#pragma unroll
            for (int ks = 0; ks < 4; ++ks) sc = MX_MFMA(MX_FRAG(L_QS, 32 * ti + r32, ks), MX_FRAG(L_KS, 32 * sj + r32, ks), sc);
            const float csv = (ROLE == 1) ? sv[V_CS + 32 * sj + r32] : 0.f;
#pragma unroll
            for (int r = 0; r < 16; ++r) {
                const int t = crow(r, hh);
                const bool keep = (ti != sj) || (r32 <= t);
                float val = sc[r];
                if (ROLE == 1) val *= fexp(sv[V_RT + 32 * ti + t] + csv);
                Ps[(32 * ti + t) * PB + 32 * sj + r32] = (bf16_t)cpk1(keep ? val : 0.f);
            }
        }
        f32x16 acco;
#pragma unroll
        for (int r = 0; r < 16; ++r) acco[r] = 0.f;
#pragma unroll
        for (int ks = 0; ks < 4; ++ks) acco = MX_MFMA(MX_FRAG(L_QS, 32 * wa + r32, ks), MX_FRAG(L_ST, 32 * wv + r32, ks), acco);
        if (ROLE == 1) {
#pragma unroll
            for (int r = 0; r < 16; ++r) acco[r] *= sv[V_WI + 32 * wa + crow(r, hh)];
        }
        if (ROLE == 0) {
#pragma unroll
            for (int r = 0; r < 16; ++r) accS[r] *= vec[V_ELAST + 32 * wa + crow(r, hh)];
        } else {
            const float carry = sv[V_SC];
#pragma unroll
            for (int r = 0; r < 16; ++r) accS[r] *= carry;
        }
#pragma unroll
        for (int ks = 0; ks < 4; ++ks) accS = MX_MFMA(MX_FRAG(L_KT, 32 * wa + r32, ks), MX_FRAG(L_VT, 32 * wv + r32, ks), accS);
        __syncthreads();
        if (wa == 0) {
#pragma unroll
            for (int ks = 0; ks < 2; ++ks) acco = MX_MFMA(MX_FRAG(L_PS, r32, ks), MX_FRAG(L_VT, 32 * wv + r32, ks), acco);
        } else {
#pragma unroll
            for (int ks = 0; ks < 4; ++ks) acco = MX_MFMA(MX_FRAG(L_PS, 32 + r32, ks), MX_FRAG(L_VT, 32 * wv + r32, ks), acco);
        }
#pragma unroll
        for (int r = 0; r < 16; ++r) Os[(32 * wa + crow(r, hh)) * OSP + 32 * wv + r32] = acco[r];
#pragma unroll
        for (int q4 = 0; q4 < 4; ++q4) { u32x2 p; p.x = cpk(accS[4 * q4], accS[4 * q4 + 1]); p.y = cpk(accS[4 * q4 + 2], accS[4 * q4 + 3]);
            *(LAS u32x2*)(STs + (32 * wv + r32) * PB + 32 * wa + 8 * q4 + 4 * hh) = p; }
        if (ROLE == 0) { if (n < 63) { vec[V_GA + et * 16 + 2 * cg] = zs0; vec[V_GA + et * 16 + 2 * cg + 1] = zs1; } }
        else {
            const LAS float* nprev = vec + V_NORM + (n & 1) * 64;
            if (w == 0) {
                float qn = 0.f, si = 0.f;
#pragma unroll
                for (int c8i = 0; c8i < 8; ++c8i) {
                    const u32x4 qv = *(const LAS u32x4*)(Qs + lane * PB + 8 * c8i), pv = *(const LAS u32x4*)(Ps + lane * PB + 8 * c8i);
                    const f32x4 n0 = *(const LAS f32x4*)(nprev + 8 * c8i), n1 = *(const LAS f32x4*)(nprev + 8 * c8i + 4);
                    qn += bflo(qv.x) * n0[0] + bfhi(qv.x) * n0[1] + bflo(qv.y) * n0[2] + bfhi(qv.y) * n0[3] + bflo(qv.z) * n1[0] + bfhi(qv.z) * n1[1] + bflo(qv.w) * n1[2] + bfhi(qv.w) * n1[3];
                    si += (bflo(pv.x) + bfhi(pv.x)) + (bflo(pv.y) + bfhi(pv.y)) + (bflo(pv.z) + bfhi(pv.z)) + (bflo(pv.w) + bfhi(pv.w));
                }
                const float den = sv[V_WI + lane] * qn + si;
                vec[V_DEN + lane] = 1.f / fmaxf(fabsf(den), sv[V_ENM + lane]);
            } else if (w == 7) {
                if (n < 63) MX_SCALARS(vec + V_SETS + ((n + 1) & 1) * SETSZ);
            } else if (w == 1) {
                float kn = 0.f;
#pragma unroll
                for (int c8i = 0; c8i < 8; ++c8i) { const u32x4 kv = *(const LAS u32x4*)(KTs + lane * PB + 8 * c8i);
                    kn += (bflo(kv.x) + bfhi(kv.x)) + (bflo(kv.y) + bfhi(kv.y)) + (bflo(kv.z) + bfhi(kv.z)) + (bflo(kv.w) + bfhi(kv.w)); }
                vec[V_NORM + ((n + 1) & 1) * 64 + lane] = sv[V_SC] * nprev[lane] + kn;
            }
        }
        __syncthreads();
        m0 += 64;
    }
#undef MX_LOAD
#undef MX_PIN8
#undef MX_SCALARS
#undef MX_PIN11
#undef MX_FRAG
}
}

#ifndef PHASE_MASK
#define PHASE_MASK 0xFFFF
#endif
#define PH(k) if constexpr ((PHASE_MASK >> (k)) & 1)
#ifndef PROBE_GEMM_REPS
#define PROBE_GEMM_REPS 1
#endif
#ifndef PROBE_STREAM_REPS
#define PROBE_STREAM_REPS 1
#endif
#define GREP _Pragma("unroll 1") for (int rep_ = 0; rep_ < PROBE_GEMM_REPS; ++rep_)
#define GREP_BAR if (rep_) GRID_BAR();
#define BLK_ENV int blk = blockIdx.x; asm volatile("" : "+s"(blk));
#define PHASE_ENV BLK_ENV int tid = hw_tid(wave_s); asm volatile("" : "+v"(tid)); const int lane = tid & 63, wave = wave_s; int vcu_ = vcu; asm volatile("" : "+s"(vcu_)); const int gw = vcu_ * NWAVES + wave; (void)lane; (void)gw;
__global__ void __launch_bounds__(NWAVES * 64, 2) mega_fwd(Args args) {
    extern __shared__ __attribute__((aligned(16))) unsigned char lds_raw[];
    LAS unsigned char* lds = (LAS unsigned char*)lds_raw;
    const int G = gridDim.x, blk0 = blockIdx.x;
    const int wave_s = __builtin_amdgcn_readfirstlane(threadIdx.x >> 6);
    const int vcu = (G % 8 == 0) ? (blk0 % 8) * (G / 8) + blk0 / 8 : blk0;
    const int NGW = G * NWAVES;
    for (int u = threadIdx.x; u < (LDS_BYTES - LDSCTL_OFF) / 4; u += NWAVES * 64) ((LAS unsigned*)(lds + LDSCTL_OFF))[u] = 0u;
    __syncthreads();
    (void)xcd_barrier_post((unsigned*)(args.ws + WS_CTL) + CW_BAR, (volatile LAS unsigned*)(lds + MISC_OFF) + 8);
#define GRID_BAR() do { XcdBarrier b_; b_.bar = (unsigned*)(inp_ws() + WS_CTL) + CW_BAR; b_.x = xb_xcc_id(); b_.st = (volatile LAS unsigned*)(lds + MISC_OFF) + 8; xcd_barrier(b_, wave_s); } while (0)

    PH(0) { PHASE_ENV
        ada_phase(lds, blk, wave, lane);
        if (blk < 32) s5_generate(0, blk, lds, wave_s);
        else if (blk < 40) convert_small(inp(8), (bf16_t*)WSP(WS_WSM), blk - 32, tid);
        LAS float* scr = (LAS float*)(lds + wave * 16384);
        int base = 0;
        convert_matrix<1>(inp(8), INDIM, 1024, ZLD, (bf16_t*)WSP(WS_WIN), scr, lane, gw, NGW, base);
    }
    GRID_BAR();

#pragma unroll 1
    for (int l = 0; l < DEPTH; ++l) {
        PH(1) if (l == 0) { PHASE_ENV
            norm_rows<false, true>(nullptr, 0, inp(0), nullptr, nullptr, 0, nullptr, inp(4), (const float*)WSP(WS_MOD), 0, 1024, (bf16_t*)WSP(WS_H), gw, NGW, lane);
            GRID_BAR();
        }
        PH(2) GREP { GREP_BAR BLK_ENV
            pg8::PlainSched S; S.o.init(M, NMIX, G, blk); S.A = (const bf16_t*)WSP(WS_H); S.lda = D; S.Bt = (const bf16_t*)WSP(WS_WIN); S.K = D;
            pg8::EpiStore E{(bf16_t*)WSP(WS_Z), ZLD};
            pg8::gemm_phase<pg8::EpiStore, pg8::PlainSched, true, true>(lds, wave_s, D, D, S, E);
            { const int task = (int)(((G % 8 == 0) ? (blk % 8) * (G / 8) + blk / 8 : blk) * NWAVES + wave_s);
              for (int t = task; t < M / 32; t += G * NWAVES) zs_mfma((const bf16_t*)WSP(WS_H), (const bf16_t*)WSP(WS_WSM), (float*)WSP(WS_ZS), t, hw_lane()); }
        }
        GRID_BAR();
        PH(11) GREP { GREP_BAR BLK_ENV
            pg8::S5aSched S; S.G = G; S.c = blk; S.Zb = (const bf16_t*)WSP(WS_Z); S.Bt1 = (const bf16_t*)WSP(WS_S5M1);
            pg8::EpiS5a E{(bf16_t*)WSP(WS_Z)};
            pg8::gemm_phase<pg8::EpiS5a, pg8::S5aSched, true, true, 1>(lds, wave_s, 0, 256, S, E);
        }
        GRID_BAR();
        PH(3) { PHASE_ENV
            if (wave == 0) for (int sid = blk; sid < 256; sid += G) s5_scan(l, sid, lane);
        }
        GRID_BAR();
        PH(12) { BLK_ENV
            pg8::S5bSched S; S.G = G; S.c = blk; S.X = (const bf16_t*)WSP(WS_Z); S.Bt3 = (const bf16_t*)WSP(WS_S5M3);
            pg8::EpiS5b E{(bf16_t*)WSP(WS_Z), inp(23) + l * 512};
            pg8::gemm_phase<pg8::EpiS5b, pg8::S5bSched, true, true>(lds, wave_s, ZLD, 256, S, E);
        }
        GRID_BAR();
        PH(3) { PHASE_ENV
#if PROBE_STREAM_REPS > 1
            for (int rep_ = 1; rep_ < PROBE_STREAM_REPS; ++rep_) { if (blk < 32) mx::stream<0, false>(l, lds, blk, wave_s); else if (blk < 64) mx::stream<1, false>(l, lds, blk - 32, wave_s); __syncthreads(); }
#endif
            if (blk < 32) mx::stream<0>(l, lds, blk, wave_s);
            else if (blk < 64) mx::stream<1>(l, lds, blk - 32, wave_s);
            else {
                {
                    int base = 0; const int gw2 = (blk - 64) * NWAVES + wave, NGW2 = (G - 64) * NWAVES;
                    LAS float* scr = (LAS float*)(lds + wave * 16384);
                    convert_matrix<0>(inp(24) + (size_t)l * 512 * 512, 512, 512, 512, (bf16_t*)WSP(WS_WGLU), scr, lane, gw2, NGW2, base);
                    convert_matrix<0>(inp(26) + (size_t)l * 512 * 1024, 1024, 512, 1024, (bf16_t*)WSP(WS_WPROJ), scr, lane, gw2, NGW2, base);
                    convert_matrix<0>(inp(27) + (size_t)l * 512 * 1024, 1024, 512, 1024, (bf16_t*)WSP(WS_WPROJ) + 1024 * 512, scr, lane, gw2, NGW2, base);
                    convert_matrix<0>(inp(28) + (size_t)l * 512 * 1024, 1024, 512, 1024, (bf16_t*)WSP(WS_WPROJ) + 2 * 1024 * 512, scr, lane, gw2, NGW2, base);
                    convert_matrix<0>(inp(30) + (size_t)l * D * D, 1024, 1024, 1024, (bf16_t*)WSP(WS_WOUT), scr, lane, gw2, NGW2, base);
                    convert_matrix<0>(inp(32) + (size_t)l * FF * D, 1024, FF, 1024, (bf16_t*)WSP(WS_WFO), scr, lane, gw2, NGW2, base);
                    __syncthreads();
                }
                pg8::PlainSched S; S.o.init(M, ZLD - NMIX, G - 64, blk - 64); S.A = (const bf16_t*)WSP(WS_H); S.lda = D; S.Bt = (const bf16_t*)WSP(WS_WIN) + (size_t)NMIX * D; S.K = D;
                pg8::EpiStore E{(bf16_t*)WSP(WS_Z) + NMIX, ZLD};
                pg8::gemm_phase<pg8::EpiStore, pg8::PlainSched, true, true>(lds, wave_s, D, D, S, E);
            }
        }
        GRID_BAR();
        PH(4) GREP { GREP_BAR BLK_ENV
            bf16_t* Z = (bf16_t*)WSP(WS_Z);
            pg8::PlainSched S; S.o.init(M, 512, G, blk); S.A = Z + SU; S.lda = ZLD; S.Bt = (const bf16_t*)WSP(WS_WGLU); S.K = 512;
            pg8::EpiGlu E{Z + YS2, ZLD, Z + SU, ZLD, inp(25) + l * 512};
            pg8::gemm_phase<pg8::EpiGlu, pg8::PlainSched, true, true>(lds, wave_s, ZLD, 512, S, E);
        }
        GRID_BAR();
        PH(5) GREP { GREP_BAR BLK_ENV
            bf16_t* Z = (bf16_t*)WSP(WS_Z);
            pg8::MergeSched S; S.o.init(M, 1024, G, blk); S.Zb = Z; S.Wp = (const bf16_t*)WSP(WS_WPROJ);
            pg8::EpiMerge E{Z + MRG, ZLD, Z + ZG, ZLD, inp(29) + l * 3072};
            pg8::gemm_phase<pg8::EpiMerge, pg8::MergeSched, true, true>(lds, wave_s, ZLD, 512, S, E);
        }
        GRID_BAR();
        PH(6) GREP { GREP_BAR BLK_ENV
            pg8::PlainSched S; S.o.init(M, 1024, G, blk); S.A = (const bf16_t*)WSP(WS_Z) + MRG; S.lda = ZLD; S.Bt = (const bf16_t*)WSP(WS_WOUT); S.K = 1024;
            pg8::EpiStore E{(bf16_t*)WSP(WS_H), D};
            pg8::gemm_phase<pg8::EpiStore, pg8::PlainSched, true, true>(lds, wave_s, ZLD, 1024, S, E);
        }
        GRID_BAR();
        PH(7) { PHASE_ENV
            const float* modl = (const float*)WSP(WS_MOD) + (size_t)l * 8 * 6144;
            { int base = 0; convert_matrix<2>(inp(31) + (size_t)l * D * 2 * FF, 2 * FF, 1024, 2 * FF, (bf16_t*)WSP(WS_WFI), (LAS float*)(lds + wave * 16384), lane, gw, NGW, base); }
            norm_rows<true, true>((const bf16_t*)WSP(WS_H), D, (l == 0) ? inp(0) : (const float*)inp_out(), inp(5) + l * D, modl, 2048, inp_out(), inp(6) + l * D, modl, 3072, 4096,
                                      (bf16_t*)WSP(WS_H), gw, NGW, lane);
        }
        GRID_BAR();
        PH(8) GREP { GREP_BAR BLK_ENV
            pg8::PlainSched S; S.o.init(M, 2 * FF, G, blk); S.A = (const bf16_t*)WSP(WS_H); S.lda = D; S.Bt = (const bf16_t*)WSP(WS_WFI); S.K = D;
            pg8::EpiSwiGlu E{(bf16_t*)WSP(WS_Z), FF};
            pg8::gemm_phase<pg8::EpiSwiGlu, pg8::PlainSched, true, true>(lds, wave_s, D, D, S, E);
        }
        GRID_BAR();
        PH(9) GREP { GREP_BAR BLK_ENV
            pg8::PlainSched S; S.o.init(M, 1024, G, blk); S.A = (const bf16_t*)WSP(WS_Z); S.lda = FF; S.Bt = (const bf16_t*)WSP(WS_WFO); S.K = FF;
            pg8::EpiStore E{(bf16_t*)WSP(WS_H), D};
            pg8::gemm_phase<pg8::EpiStore, pg8::PlainSched, true, true>(lds, wave_s, FF, FF, S, E);
        }
        GRID_BAR();
        PH(10) { PHASE_ENV
            const float* modl = (const float*)WSP(WS_MOD) + (size_t)l * 8 * 6144;
            if (l + 1 < DEPTH) {
                const int l1 = l + 1;
                LAS float* scr = (LAS float*)(lds + wave * 16384);
                int base = 0;
                if (blk < 32) s5_generate(l1, blk, lds, wave_s);
                convert_matrix<1>(inp(8) + (size_t)l1 * D * INDIM, INDIM, 1024, ZLD, (bf16_t*)WSP(WS_WIN), scr, lane, gw, NGW, base);
                if (blk >= 32 && blk < 40) convert_small(inp(8) + (size_t)l1 * D * INDIM, (bf16_t*)WSP(WS_WSM), blk - 32, tid);
                norm_rows<true, true>((const bf16_t*)WSP(WS_H), D, (const float*)inp_out(), inp(7) + l * D, modl, 5120, inp_out(), inp(4) + l1 * D, modl + 8 * 6144, 0, 1024,
                                      (bf16_t*)WSP(WS_H), gw, NGW, lane);
                GRID_BAR();
            } else {
                norm_rows<true, false>((const bf16_t*)WSP(WS_H), D, (const float*)inp_out(), inp(7) + l * D, modl, 5120, inp_out(), nullptr, nullptr, 0, 0, nullptr, gw, NGW, lane);
            }
        }
    }
}

extern "C" void kernel_launch(void* const* d_in, const int* in_sizes, int n_in, void* d_out, int out_size, void* d_ws, size_t ws_size, hipStream_t stream) {
    static int grid = 0;
    if (grid == 0) {
        if (n_in != 33 || ws_size < WS_END || out_size != M * D) { fprintf(stderr, "kernel_launch: unexpected n_in %d / ws %zu / out %d\n", n_in, ws_size, out_size); grid = -1; return; }
        int dev = 0, cus = 0, per_cu = 0;
        if (hipGetDevice(&dev) != hipSuccess || hipDeviceGetAttribute(&cus, hipDeviceAttributeMultiprocessorCount, dev) != hipSuccess) { grid = -1; return; }
        if (hipFuncSetAttribute((const void*)mega_fwd, hipFuncAttributeMaxDynamicSharedMemorySize, LDS_BYTES) != hipSuccess) { fprintf(stderr, "kernel_launch: hipFuncSetAttribute failed\n"); grid = -1; return; }
        if (hipOccupancyMaxActiveBlocksPerMultiprocessor(&per_cu, (const void*)mega_fwd, NWAVES * 64, LDS_BYTES) != hipSuccess || per_cu < 1) { fprintf(stderr, "kernel_launch: occupancy query says %d blocks/CU\n", per_cu); grid = -1; return; }
        (void)hipGetLastError();
        grid = cus;
    }
    if (grid < 0) return;
    (void)hipMemsetAsync((char*)d_ws + WS_CTL, 0, CTL_ZERO_BYTES, stream);
    Args a{};
    for (int i = 0; i < 33; ++i) a.in[i] = (const float*)d_in[i];
    a.out = (float*)d_out; a.ws = (unsigned char*)d_ws;
    hipLaunchKernelGGL(mega_fwd, dim3(grid), dim3(NWAVES * 64), LDS_BYTES, stream, a);
}
```

```cpp
#include <hip/hip_runtime.h>
#include <cstdint>
#include <cstdio>

#define LAS __attribute__((address_space(3)))
#define GAS __attribute__((address_space(1)))
typedef unsigned short bf16_t;
typedef short bf16x8 __attribute__((ext_vector_type(8)));
typedef float f32x4 __attribute__((ext_vector_type(4)));
typedef float f32x2 __attribute__((ext_vector_type(2)));
typedef unsigned u32x4 __attribute__((ext_vector_type(4)));
typedef unsigned u32x2 __attribute__((ext_vector_type(2)));

constexpr int NB = 8, T = 4096, D = 1024, M = NB * T, DEPTH = 2;
constexpr int INDIM = 6680, ZLD = 6656, FF = 2816;
constexpr int GQ = 0, GK = 256, GV = 512, GR = 1024, MQ = 1536, MK = 1792, MV = 2048, MO = 2560, SU = 3072, ZG = 3584;
constexpr int YGLA = GR;
constexpr int YML = MO;
constexpr int YS2 = 0;
constexpr int MRG = 1536;
constexpr int EXC = ZG;
constexpr int YPC = ZG + 512;
constexpr int NMIX = 3584;
constexpr size_t MiB = 1u << 20;
constexpr size_t WS_CTL = 0, CTL_ZERO_BYTES = 64 * 1024;
constexpr size_t WS_MOD = 512 * 1024;
constexpr size_t WS_ZS = 1 * MiB;
constexpr size_t WS_WIN = 5 * MiB;
constexpr size_t WS_WFI = 5 * MiB;
constexpr size_t WS_S5M1 = 18 * MiB;
constexpr size_t WS_S5M3 = 24 * MiB;
constexpr size_t WS_WGLU = 18 * MiB;
constexpr size_t WS_WPROJ = 18 * MiB + 512 * 1024;
constexpr size_t WS_WOUT = 21 * MiB + 512 * 1024;
constexpr size_t WS_WFO = 23 * MiB + 512 * 1024;
constexpr size_t WS_WSM = 29 * MiB;
constexpr size_t WS_H = 32 * MiB;
constexpr size_t WS_Z = 96 * MiB;
constexpr size_t WS_END = 512 * MiB;
constexpr int CW_BAR = 4096;

constexpr int RING_BYTES = 131072, LDSCTL_OFF = RING_BYTES, MISC_OFF = LDSCTL_OFF + 320, LDS_BYTES = 147456;
constexpr int NWAVES = 8;

__device__ __forceinline__ float bf2f(bf16_t v) { return __uint_as_float(((unsigned)v) << 16); }
__device__ __forceinline__ unsigned f2bf(float f) { unsigned u = __float_as_uint(f); return (u + 0x7fffu + ((u >> 16) & 1u)) >> 16; }
__device__ __forceinline__ unsigned pk2(float lo, float hi) { return f2bf(lo) | (f2bf(hi) << 16); }
__device__ __forceinline__ float bflo(unsigned u) { return __uint_as_float(u << 16); }
__device__ __forceinline__ float bfhi(unsigned u) { return __uint_as_float(u & 0xffff0000u); }
__device__ __forceinline__ int hw_lane() { int l; asm volatile("v_mbcnt_lo_u32_b32 %0, -1, 0\n\tv_mbcnt_hi_u32_b32 %0, -1, %0" : "=v"(l)); return l; }
__device__ __forceinline__ int hw_tid(int wv) { return wv * 64 + hw_lane(); }
__device__ __forceinline__ float shl(float v, int src) { return __int_as_float(__builtin_amdgcn_ds_bpermute(src << 2, __float_as_int(v))); }
__device__ __forceinline__ float wave_sum(float v, int lane) {
#pragma unroll
    for (int o = 1; o < 64; o <<= 1) v += shl(v, lane ^ o);
    return v;
}
__device__ __forceinline__ float sigmoidf_(float x) { return 1.f / (1.f + expf(-x)); }
__device__ __forceinline__ float siluf_(float x) { return x / (1.f + expf(-x)); }
__device__ __forceinline__ float logsigmoidf_(float x) { return fminf(x, 0.f) - log1pf(expf(-fabsf(x))); }
__device__ __forceinline__ float gelu_tanh(float y) { return 0.5f * y * (1.f + tanhf(0.7978845608028654f * (y + 0.044715f * y * y * y))); }
__device__ __forceinline__ float fexp_neg(float x) { return __builtin_amdgcn_exp2f(-1.4426950408889634f * x); }
__device__ __forceinline__ float fsigmoid(float x) { return __builtin_amdgcn_rcpf(1.f + fexp_neg(x)); }
#define LDS_WAIT() asm volatile("s_waitcnt lgkmcnt(0)" ::: "memory")
#define VM_WAIT() asm volatile("s_waitcnt vmcnt(0)" ::: "memory")

namespace pg8 {
constexpr int BM = 256, BK = 64, HALF = 128, HTB = HALF * BK * 2, STAGE_BYTES = 8 * HTB, NXCD = 8, WGM = 8;
__host__ __device__ __forceinline__ int lds_byte(int r, int c) { const int st = (r >> 4) * 2 + (c >> 5), rr = r & 15, cc = c & 31, ob = rr * 64 + cc * 2; return st * 1024 + (ob ^ (((ob >> 9) & 1) << 5)); }
__host__ __device__ __forceinline__ void stage_rc(int b, int& R, int& C) { const int st = b / 1024, sb = b % 1024, swz = sb ^ (((sb >> 9) & 1) << 5); R = (st >> 1) * 16 + swz / 64; C = (st & 1) * 32 + (swz % 64) / 2; }
__host__ __device__ __forceinline__ int perm32(int rho) { const int n = rho >> 4, i = rho & 15; return 8 * (i >> 2) + 4 * n + (i & 3); }

struct Unit { int pm, pn, br; };
struct TileOrder {
    int nM, nN, nwg, G, c;
    __device__ void init(int M_, int N_, int G_, int c_) { nM = M_ / BM; nN = N_ / BM; nwg = nM * nN; G = G_; c = c_; }
    __device__ bool tile(int i, int& pm, int& pn) const {
        const long L = (long)i * G + c; if (L >= nwg) return false;
        int wgid = (int)L; { const int q = nwg / NXCD, r = nwg % NXCD, xcd = wgid % NXCD, off = wgid / NXCD; wgid = (xcd < r ? xcd * (q + 1) : r * (q + 1) + (xcd - r) * q) + off; }
        const int nig = WGM * nN, gid = wgid / nig, fm = gid * WGM, gsz = (nM - fm) < WGM ? (nM - fm) : WGM;
        pm = fm + ((wgid % nig) % gsz); pn = (wgid % nig) / gsz; return true;
    }
};
struct PlainSched {
    TileOrder o; const bf16_t* A; int lda; const bf16_t* Bt; int K;
    __device__ bool next(int i, Unit& u) const { u.br = 0; return o.tile(i, u.pm, u.pn); }
    __device__ const char* Ap(const Unit& u) const { return (const char*)(A + (size_t)u.pm * BM * lda); }
    __device__ const char* Bp(const Unit& u) const { return (const char*)(Bt + (size_t)u.pn * BM * K); }
};
struct MergeSched {
    TileOrder o; const bf16_t* Zb; const bf16_t* Wp;
    __device__ bool next(int i, Unit& u) const { u.br = i % 3; return o.tile(i / 3, u.pm, u.pn); }
    __device__ const char* Ap(const Unit& u) const { const int col = u.br == 0 ? YGLA : (u.br == 1 ? YML : YS2); return (const char*)(Zb + (size_t)u.pm * BM * ZLD + col); }
    __device__ const char* Bp(const Unit& u) const { return (const char*)(Wp + (size_t)u.br * 1024 * 512 + (size_t)u.pn * BM * 512); }
};

__device__ __forceinline__ unsigned cvt_pk_bf16(float lo, float hi) { unsigned r; asm volatile("v_cvt_pk_bf16_f32 %0, %1, %2" : "=v"(r) : "v"(lo), "v"(hi)); return r; }

struct EpiStore {
    static constexpr bool PERM = true;
    bf16_t* O; int ldc;
    __device__ __forceinline__ bool keep(const Unit&) const { return false; }
    __device__ __forceinline__ void operator()(f32x4 (&acc)[2][2][4][2], const Unit& u, int wr, int wc, int fr, int fq) const {
        const int row0 = u.pm * BM + wr * 64 + fr, col0 = u.pn * BM + wc * 32 + 8 * fq;
#pragma unroll
        for (int ai = 0; ai < 2; ++ai)
#pragma unroll
            for (int m = 0; m < 4; ++m) { bf16_t* rowp = O + (size_t)(row0 + ai * HALF + m * 16) * ldc + col0;
#pragma unroll
                for (int bj = 0; bj < 2; ++bj) { const f32x4 v0 = acc[ai][bj][m][0], v1 = acc[ai][bj][m][1];
                    u32x4 w; w.x = cvt_pk_bf16(v0[0], v0[1]); w.y = cvt_pk_bf16(v0[2], v0[3]); w.z = cvt_pk_bf16(v1[0], v1[1]); w.w = cvt_pk_bf16(v1[2], v1[3]);
                    *(u32x4*)(rowp + bj * HALF) = w; } }
    }
};
struct EpiGlu {
    static constexpr bool PERM = true;
    bf16_t* O; int ldc; const bf16_t* Asrc; int lda; const float* bias;
    __device__ __forceinline__ bool keep(const Unit&) const { return false; }
    __device__ __forceinline__ void operator()(f32x4 (&acc)[2][2][4][2], const Unit& u, int wr, int wc, int fr, int fq) const {
        const int row0 = u.pm * BM + wr * 64 + fr, col0 = u.pn * BM + wc * 32 + 8 * fq;
        f32x4 bv[2][2];
#pragma unroll
        for (int bj = 0; bj < 2; ++bj)
#pragma unroll
            for (int n = 0; n < 2; ++n) bv[bj][n] = *(const f32x4*)(bias + col0 + bj * HALF + 4 * n);
#pragma unroll
        for (int ai = 0; ai < 2; ++ai)
#pragma unroll
            for (int m = 0; m < 4; ++m) { const size_t r = (size_t)(row0 + ai * HALF + m * 16);
#pragma unroll
                for (int bj = 0; bj < 2; ++bj) {
                    const u32x4 a = *(const u32x4*)(Asrc + r * lda + col0 + bj * HALF);
                    const f32x4 v0 = acc[ai][bj][m][0] + bv[bj][0], v1 = acc[ai][bj][m][1] + bv[bj][1];
                    u32x4 w;
                    w.x = cvt_pk_bf16(bflo(a.x) * fsigmoid(v0[0]), bfhi(a.x) * fsigmoid(v0[1])); w.y = cvt_pk_bf16(bflo(a.y) * fsigmoid(v0[2]), bfhi(a.y) * fsigmoid(v0[3]));
                    w.z = cvt_pk_bf16(bflo(a.z) * fsigmoid(v1[0]), bfhi(a.z) * fsigmoid(v1[1])); w.w = cvt_pk_bf16(bflo(a.w) * fsigmoid(v1[2]), bfhi(a.w) * fsigmoid(v1[3]));
                    *(u32x4*)(O + r * ldc + col0 + bj * HALF) = w; } }
    }
};
struct EpiSwiGlu {
    static constexpr bool PERM = true;
    bf16_t* O; int ldc;
    __device__ __forceinline__ bool keep(const Unit&) const { return false; }
    __device__ __forceinline__ void operator()(f32x4 (&acc)[2][2][4][2], const Unit& u, int wr, int wc, int fr, int fq) const {
        const int row0 = u.pm * BM + wr * 64 + fr, col0 = u.pn * HALF + wc * 32 + 8 * fq;
#pragma unroll
        for (int ai = 0; ai < 2; ++ai)
#pragma unroll
            for (int m = 0; m < 4; ++m) {
                float o[8];
#pragma unroll
                for (int n = 0; n < 2; ++n)
#pragma unroll
                    for (int e = 0; e < 4; ++e) { const float g = acc[ai][0][m][n][e], up = acc[ai][1][m][n][e]; o[n * 4 + e] = g * fsigmoid(g) * up; }
                u32x4 w; w.x = cvt_pk_bf16(o[0], o[1]); w.y = cvt_pk_bf16(o[2], o[3]); w.z = cvt_pk_bf16(o[4], o[5]); w.w = cvt_pk_bf16(o[6], o[7]);
                *(u32x4*)(O + (size_t)(row0 + ai * HALF + m * 16) * ldc + col0) = w; }
    }
};
struct EpiMerge {
    static constexpr bool PERM = true;
    bf16_t* O; int ldc; const bf16_t* Zg; int ldz; const float* bgb;
    __device__ __forceinline__ bool keep(const Unit& u) const { return u.br < 2; }
    __device__ __forceinline__ float e_of(float x) const { return fminf(fexp_neg(x), 1e30f); }
    __device__ __forceinline__ void operator()(f32x4 (&acc)[2][2][4][2], const Unit& u, int wr, int wc, int fr, int fq) const {
        const int row0 = u.pm * BM + wr * 64 + fr, col0 = u.pn * BM + wc * 32 + 8 * fq;
        const int br = u.br, brn = br < 2 ? br + 1 : 2;
#pragma unroll
        for (int bj = 0; bj < 2; ++bj) {
            float ba[8], bb[8];
#pragma unroll
            for (int e = 0; e < 8; ++e) { ba[e] = bgb[br * 1024 + col0 + bj * HALF + e]; bb[e] = bgb[brn * 1024 + col0 + bj * HALF + e]; }
#pragma unroll
            for (int ai = 0; ai < 2; ++ai)
#pragma unroll
                for (int m = 0; m < 4; ++m) { const size_t r = (size_t)(row0 + ai * HALF + m * 16);
                    const u32x4 za = *(const u32x4*)(Zg + r * ldz + br * 1024 + col0 + bj * HALF);
                    const u32x4 zb = *(const u32x4*)(Zg + r * ldz + brn * 1024 + col0 + bj * HALF);
                    const float xa[8] = {bflo(za.x), bfhi(za.x), bflo(za.y), bfhi(za.y), bflo(za.z), bfhi(za.z), bflo(za.w), bfhi(za.w)};
                    const float xb[8] = {bflo(zb.x), bfhi(zb.x), bflo(zb.y), bfhi(zb.y), bflo(zb.z), bfhi(zb.z), bflo(zb.w), bfhi(zb.w)};
                    float f[8];
#pragma unroll
                    for (int e = 0; e < 8; ++e) { const float ga = __builtin_amdgcn_rcpf(1.f + e_of(xa[e] + ba[e]));
                        f[e] = br < 2 ? ga * (1.f + e_of(xb[e] + bb[e])) : ga; }
                    f32x4 v0 = acc[ai][bj][m][0], v1 = acc[ai][bj][m][1];
                    v0[0] *= f[0]; v0[1] *= f[1]; v0[2] *= f[2]; v0[3] *= f[3]; v1[0] *= f[4]; v1[1] *= f[5]; v1[2] *= f[6]; v1[3] *= f[7];
                    if (br < 2) { acc[ai][bj][m][0] = v0; acc[ai][bj][m][1] = v1; }
                    else { u32x4 w; w.x = cvt_pk_bf16(v0[0], v0[1]); w.y = cvt_pk_bf16(v0[2], v0[3]); w.z = cvt_pk_bf16(v1[0], v1[1]); w.w = cvt_pk_bf16(v1[2], v1[3]);
                        *(u32x4*)(O + r * ldc + col0 + bj * HALF) = w; } }
        }
    }
};


struct S5aSched {
    int G, c; const bf16_t* Zb; const bf16_t* Bt1;
    __device__ bool next(int i, Unit& u) const { const int L = i * G + c; if (L >= 512) return false; u.br = L >> 4; u.pm = (L & 15) >> 1; u.pn = L & 1; return true; }
    __device__ const char* Ap(const Unit& u) const { return (const char*)(Zb + (size_t)u.pm * T * ZLD + SU + 16 * u.br); }
    __device__ const char* Bp(const Unit& u) const { return (const char*)(Bt1 + ((size_t)u.br * 384 + (size_t)u.pn * 256) * 256); }
};
struct EpiS5a {
    static constexpr bool PERM = true;
    bf16_t* Zb;
    __device__ __forceinline__ bool keep(const Unit&) const { return false; }
    __device__ __forceinline__ void operator()(f32x4 (&acc)[2][2][4][2], const Unit& u, int wr, int wc, int fr, int fq) const {
        const int rowbase = (u.br & 15) * 2048 + u.pm * 256 + wr * 64 + fr, colsub = wc * 32 + 8 * fq, hoff = (u.br >> 4) * 256;
#pragma unroll
        for (int ai = 0; ai < 2; ++ai)
#pragma unroll
            for (int m = 0; m < 4; ++m) { bf16_t* zrow = Zb + (size_t)(rowbase + ai * HALF + m * 16) * ZLD + hoff;
                if (u.pn == 0) {
                    float* ex = (float*)(zrow + EXC);
                    *(f32x4*)(ex + colsub) = acc[ai][0][m][0]; *(f32x4*)(ex + colsub + 4) = acc[ai][0][m][1];
                    const f32x4 v0 = acc[ai][1][m][0], v1 = acc[ai][1][m][1];
                    u32x4 w; w.x = cvt_pk_bf16(v0[0], v0[1]); w.y = cvt_pk_bf16(v0[2], v0[3]); w.z = cvt_pk_bf16(v1[0], v1[1]); w.w = cvt_pk_bf16(v1[2], v1[3]);
                    *(u32x4*)(zrow + YPC + colsub) = w;
                } else {
                    const f32x4 v0 = acc[ai][0][m][0], v1 = acc[ai][0][m][1];
                    u32x4 w; w.x = cvt_pk_bf16(v0[0], v0[1]); w.y = cvt_pk_bf16(v0[2], v0[3]); w.z = cvt_pk_bf16(v1[0], v1[1]); w.w = cvt_pk_bf16(v1[2], v1[3]);
                    *(u32x4*)(zrow + YPC + 128 + colsub) = w;
                } }
    }
};
struct S5bSched {
    int G, c; const bf16_t* X; const bf16_t* Bt3;
    __device__ bool next(int i, Unit& u) const { const int L = i * G + c; if (L >= 256) return false; u.br = L >> 3; u.pm = L & 7; u.pn = 0; return true; }
    __device__ const char* Ap(const Unit& u) const { return (const char*)(X + (size_t)((u.br & 15) * 2048 + u.pm * 256) * ZLD + EXC + (u.br >> 4) * 256); }
    __device__ const char* Bp(const Unit& u) const { return (const char*)(Bt3 + (size_t)u.br * 256 * 256); }
};
struct EpiS5b {
    static constexpr bool PERM = true;
    bf16_t* Zb; const float* dsk;
    __device__ __forceinline__ bool keep(const Unit&) const { return false; }
    __device__ __forceinline__ void operator()(f32x4 (&acc)[2][2][4][2], const Unit& u, int wr, int wc, int fr, int fq) const {
        const int g = u.br, b = u.pm;
#pragma unroll
        for (int bj = 0; bj < 2; ++bj) {
            const int j0 = bj * HALF + wc * 32 + 8 * fq, s = j0 >> 4, c0 = j0 & 15;
            const f32x4 d0 = *(const f32x4*)(dsk + 16 * g + c0), d1 = *(const f32x4*)(dsk + 16 * g + c0 + 4);
#pragma unroll
            for (int ai = 0; ai < 2; ++ai)
#pragma unroll
                for (int m = 0; m < 4; ++m) {
                    const int n = ai * HALF + wr * 64 + m * 16 + fr;
                    const u32x4 yp = *(const u32x4*)(Zb + (size_t)((g & 15) * 2048 + b * 256 + n) * ZLD + YPC + (g >> 4) * 256 + j0);
                    bf16_t* zp = Zb + ((size_t)b * T + 16 * n + s) * ZLD + SU + 16 * g + c0;
                    const u32x4 uu = *(const u32x4*)zp;
                    const f32x4 a0 = acc[ai][bj][m][0], a1 = acc[ai][bj][m][1];
                    float y[8];
                    y[0] = a0[0] + bflo(yp.x) + d0[0] * bflo(uu.x); y[1] = a0[1] + bfhi(yp.x) + d0[1] * bfhi(uu.x);
                    y[2] = a0[2] + bflo(yp.y) + d0[2] * bflo(uu.y); y[3] = a0[3] + bfhi(yp.y) + d0[3] * bfhi(uu.y);
                    y[4] = a1[0] + bflo(yp.z) + d1[0] * bflo(uu.z); y[5] = a1[1] + bfhi(yp.z) + d1[1] * bfhi(uu.z);
                    y[6] = a1[2] + bflo(yp.w) + d1[2] * bflo(uu.w); y[7] = a1[3] + bfhi(yp.w) + d1[3] * bfhi(uu.w);
#pragma unroll
                    for (int e = 0; e < 8; ++e) { const float v = y[e]; y[e] = v * fsigmoid(1.5957691216057308f * (v + 0.044715f * v * v * v)); }
                    u32x4 w; w.x = cvt_pk_bf16(y[0], y[1]); w.y = cvt_pk_bf16(y[2], y[3]); w.z = cvt_pk_bf16(y[4], y[5]); w.w = cvt_pk_bf16(y[6], y[7]);
                    *(u32x4*)zp = w;
                    if (m & 1) asm volatile("" ::: "memory");
                }
        }
    }
};

template <class Epi, class Sched, bool ALIGN_EPI, bool SP2, int AMODE = 0>
__device__ __forceinline__ void gemm_phase(LAS unsigned char* lds, const int wv, const int lda, const int K, const Sched& S, const Epi& E) {
    int tid_ = hw_tid(wv); asm volatile("" : "+v"(tid_));
    const int tid = tid_, wid = __builtin_amdgcn_readfirstlane(tid >> 6), lane = tid & 63, wr = wid >> 2, wc = wid & 3, fr = lane & 15, fq = lane >> 4;
    const int nt = K / BK;
    unsigned voffA[2], voffB[2];
#pragma unroll
    for (int i = 0; i < 2; ++i) { int R, C; stage_rc(tid * 16 + i * 8192, R, C); const int Rb = Epi::PERM ? ((R & ~31) + perm32(R & 31)) : R;
        voffA[i] = AMODE == 0 ? (unsigned)(R * lda + C) * 2u : (unsigned)((16 * R + (C >> 4)) * ZLD + (C & 15)) * 2u; voffB[i] = (unsigned)(Rb * K + C) * 2u; }
    const size_t kstep = (size_t)(BK * 2);
    const size_t kstepA = AMODE == 0 ? (size_t)(BK * 2) : (size_t)4 * ZLD * 2;
    const size_t hA = AMODE == 0 ? (size_t)HALF * lda * 2 : (size_t)HALF * 16 * ZLD * 2, hB = (size_t)HALF * K * 2;
    const unsigned ldsw = (unsigned)wid * 1024u;
    const int aoff = lds_byte(wr * 64 + fr, fq * 8), boff = lds_byte(wc * 32 + fr, fq * 8);
#define PG8_SA(b, h) (((b) * 2 + (h)) * HTB)
#define PG8_SB(b, h) ((4 + (b) * 2 + (h)) * HTB)
#define PG8_STAGE(bufoff, gbase, voff) do { _Pragma("unroll") for (int _i = 0; _i < 2; ++_i) \
        __builtin_amdgcn_global_load_lds((const unsigned*)((const char*)(gbase) + (voff)[_i]), (LAS unsigned*)(lds + (bufoff) + ldsw + _i * 8192), 16, 0, 0); } while (0)
#define PG8_LDA(dst, b, h) do { _Pragma("unroll") for (int m = 0; m < 4; ++m) _Pragma("unroll") for (int k = 0; k < 2; ++k) dst[m][k] = *(const LAS bf16x8*)(lds + PG8_SA(b, h) + aoff + m * 2048 + k * 1024); } while (0)
#define PG8_LDB(dst, b, h) do { _Pragma("unroll") for (int n = 0; n < 2; ++n) _Pragma("unroll") for (int k = 0; k < 2; ++k) dst[n][k] = *(const LAS bf16x8*)(lds + PG8_SB(b, h) + boff + n * 2048 + k * 1024); } while (0)
#define PG8_MMA(ai, bj, At, Bt) do { __builtin_amdgcn_s_setprio(1); _Pragma("unroll") for (int m = 0; m < 4; ++m) _Pragma("unroll") for (int n = 0; n < 2; ++n) _Pragma("unroll") for (int k = 0; k < 2; ++k) \
        acc[ai][bj][m][n] = __builtin_amdgcn_mfma_f32_16x16x32_bf16(Bt[n][k], At[m][k], acc[ai][bj][m][n], 0, 0, 0); __builtin_amdgcn_s_setprio(0); } while (0)
#define PG8_WAIT_V(n) asm volatile("s_waitcnt vmcnt(" #n ")" ::: "memory")
#define PG8_WAIT_L(n) asm volatile("s_waitcnt lgkmcnt(" #n ")" ::: "memory")
#define PG8_BAR __builtin_amdgcn_s_barrier()
#define PG8_SCHED __builtin_amdgcn_sched_barrier(0)
    Unit cur, nxt; int ui = 0;
    if (!S.next(0, cur)) return;
    f32x4 acc[2][2][4][2];
#pragma unroll
    for (int a = 0; a < 2; ++a)
#pragma unroll
        for (int b = 0; b < 2; ++b)
#pragma unroll
            for (int m = 0; m < 4; ++m)
#pragma unroll
                for (int n = 0; n < 2; ++n) acc[a][b][m][n] = (f32x4){0.f, 0.f, 0.f, 0.f};
    bf16x8 At[4][2], B0[2][2], B1[2][2];
    const char* cA = S.Ap(cur); const char* cB = S.Bp(cur);
    if constexpr (SP2) {
        PG8_STAGE(PG8_SB(0, 0), cB, voffB); PG8_STAGE(PG8_SB(0, 1), cB + hB, voffB); PG8_STAGE(PG8_SA(0, 0), cA, voffA); PG8_STAGE(PG8_SA(0, 1), cA + hA, voffA);
        if (wr == 1) PG8_BAR;
        PG8_WAIT_V(2); PG8_BAR;
        PG8_STAGE(PG8_SB(1, 0), cB + kstep, voffB); PG8_STAGE(PG8_SA(1, 0), cA + kstepA, voffA); PG8_STAGE(PG8_SB(1, 1), cB + hB + kstep, voffB);
        PG8_WAIT_V(6); PG8_BAR;
    } else {
        PG8_STAGE(PG8_SB(0, 0), cB, voffB); PG8_STAGE(PG8_SA(0, 0), cA, voffA); PG8_STAGE(PG8_SB(0, 1), cB + hB, voffB); PG8_STAGE(PG8_SA(0, 1), cA + hA, voffA);
        if (wr == 1) PG8_BAR;
        PG8_WAIT_V(4); PG8_BAR;
        PG8_STAGE(PG8_SB(1, 0), cB + kstep, voffB); PG8_STAGE(PG8_SA(1, 0), cA + kstepA, voffA); PG8_STAGE(PG8_SB(1, 1), cB + hB + kstep, voffB);
        PG8_WAIT_V(6); PG8_BAR;
    }
    for (;;) {
        const bool has_next = S.next(ui + 1, nxt);
        const char* nA = has_next ? S.Ap(nxt) : cA; const char* nB = has_next ? S.Bp(nxt) : cB;
        for (int t = 0; t < nt; t += 2) {
            const bool last = (t == nt - 2);
            const char* a1 = cA + (size_t)(t + 1) * kstepA;
            const char* a2 = last ? nA : cA + (size_t)(t + 2) * kstepA; const char* b2 = last ? nB : cB + (size_t)(t + 2) * kstep;
            const char* a3 = a2 + kstepA; const char* b3 = b2 + kstep;
            if constexpr (SP2) {
            PG8_LDB(B0, 0, 0); PG8_LDB(B1, 0, 1); PG8_SCHED; PG8_LDA(At, 0, 0); PG8_STAGE(PG8_SA(1, 1), a1 + hA, voffA);
            PG8_WAIT_V(8); PG8_WAIT_L(0); PG8_BAR; PG8_MMA(0, 0, At, B0); PG8_MMA(0, 1, At, B1); PG8_BAR; PG8_SCHED;
            PG8_LDA(At, 0, 1); PG8_STAGE(PG8_SB(0, 0), b2, voffB); PG8_STAGE(PG8_SB(0, 1), b2 + hB, voffB); PG8_STAGE(PG8_SA(0, 0), a2, voffA);
            PG8_WAIT_V(8); PG8_WAIT_L(0); PG8_BAR; PG8_MMA(1, 0, At, B0); PG8_MMA(1, 1, At, B1); PG8_BAR; PG8_SCHED;
            PG8_LDB(B0, 1, 0); PG8_LDB(B1, 1, 1); PG8_SCHED; PG8_LDA(At, 1, 0); PG8_STAGE(PG8_SA(0, 1), a2 + hA, voffA);
            PG8_WAIT_V(8); PG8_WAIT_L(0); PG8_BAR; PG8_MMA(0, 0, At, B0); PG8_MMA(0, 1, At, B1); PG8_BAR; PG8_SCHED;
            PG8_LDA(At, 1, 1); PG8_STAGE(PG8_SB(1, 0), b3, voffB); PG8_STAGE(PG8_SB(1, 1), b3 + hB, voffB); PG8_STAGE(PG8_SA(1, 0), a3, voffA);
            PG8_WAIT_V(8); PG8_WAIT_L(0); PG8_BAR; PG8_MMA(1, 0, At, B0); PG8_MMA(1, 1, At, B1); PG8_BAR; PG8_SCHED;
            } else {
            PG8_LDB(B0, 0, 0); PG8_SCHED; PG8_LDA(At, 0, 0); PG8_STAGE(PG8_SA(1, 1), a1 + hA, voffA);
            PG8_WAIT_L(8); PG8_BAR; PG8_WAIT_L(0); PG8_MMA(0, 0, At, B0); PG8_BAR; PG8_SCHED;
            PG8_LDB(B1, 0, 1); PG8_STAGE(PG8_SB(0, 0), b2, voffB);
            PG8_BAR; PG8_WAIT_L(0); PG8_MMA(0, 1, At, B1); PG8_BAR;
            PG8_LDA(At, 0, 1); PG8_STAGE(PG8_SA(0, 0), a2, voffA);
            PG8_BAR; PG8_WAIT_L(0); PG8_MMA(1, 0, At, B0); PG8_BAR; PG8_SCHED;
            PG8_STAGE(PG8_SB(0, 1), b2 + hB, voffB);
            PG8_WAIT_V(6); PG8_BAR; PG8_MMA(1, 1, At, B1); PG8_BAR;
            PG8_LDB(B0, 1, 0); PG8_SCHED; PG8_LDA(At, 1, 0); PG8_STAGE(PG8_SA(0, 1), a2 + hA, voffA);
            PG8_WAIT_L(8); PG8_BAR; PG8_WAIT_L(0); PG8_MMA(0, 0, At, B0); PG8_BAR; PG8_SCHED;
            PG8_LDB(B1, 1, 1); PG8_STAGE(PG8_SB(1, 0), b3, voffB);
            PG8_BAR; PG8_WAIT_L(0); PG8_MMA(0, 1, At, B1); PG8_BAR;
            PG8_LDA(At, 1, 1); PG8_STAGE(PG8_SA(1, 0), a3, voffA);
            PG8_BAR; PG8_WAIT_L(0); PG8_MMA(1, 0, At, B0); PG8_BAR; PG8_SCHED;
            PG8_STAGE(PG8_SB(1, 1), b3 + hB, voffB);
            PG8_WAIT_V(6); PG8_BAR; PG8_MMA(1, 1, At, B1); PG8_BAR;
            }
        }
        if constexpr (ALIGN_EPI) { if (wr == 0) PG8_BAR; }
        { const int lane_e = hw_lane();
          E(acc, cur, wr, wc, lane_e & 15, lane_e >> 4); }
        if (!has_next) break;
        if (!E.keep(cur)) {
#pragma unroll
        for (int a = 0; a < 2; ++a)
#pragma unroll
            for (int b = 0; b < 2; ++b)
#pragma unroll
                for (int m = 0; m < 4; ++m)
#pragma unroll
                    for (int n = 0; n < 2; ++n) acc[a][b][m][n] = (f32x4){0.f, 0.f, 0.f, 0.f};
        }
        cur = nxt; cA = nA; cB = nB; ++ui;
        if constexpr (ALIGN_EPI) { if (wr == 1) PG8_BAR; }
    }
    PG8_WAIT_V(0);
    if constexpr (!ALIGN_EPI) { if (wr == 0) PG8_BAR; }
    PG8_BAR;
#undef PG8_SA
#undef PG8_SB
#undef PG8_STAGE
#undef PG8_LDA
#undef PG8_LDB
#undef PG8_MMA
#undef PG8_WAIT_V
#undef PG8_WAIT_L
#undef PG8_BAR
#undef PG8_SCHED
}
}

#define XB_TMO      128
#define XB_XCNT(j)  (256  + 64 * (j))
#define XB_XSUB(j)  (1280 + 64 * (j))
#define XB_XGEN(j)  (2304 + 64 * (j))
#define XB_TOP      3328
#define XB_TOPGEN   3392
#define XCD_BAR_WORDS 3456
#define XB_SPIN_CAP (1u << 18)
__device__ __forceinline__ unsigned xb_ld(unsigned* p)              { return __hip_atomic_load(p, __ATOMIC_RELAXED, __HIP_MEMORY_SCOPE_AGENT); }
__device__ __forceinline__ unsigned xb_add(unsigned* p, unsigned v) { return __hip_atomic_fetch_add(p, v, __ATOMIC_RELAXED, __HIP_MEMORY_SCOPE_AGENT); }
__device__ __forceinline__ unsigned xb_xcc_id() { return (unsigned)__builtin_amdgcn_s_getreg((3 << 11) | 20) & 0xFu; }
#define XB_SPIN(cond, bar) do { unsigned _sp = 0; while (cond) { __builtin_amdgcn_s_sleep(1); \
    if ((++_sp & 255u) == 0u) { if (xb_ld(&(bar)[XB_TMO])) break; if (_sp > XB_SPIN_CAP) { atomicAdd(&(bar)[XB_TMO], 1u); break; } } } } while (0)
struct XcdBarrier { unsigned* bar; unsigned x; volatile LAS unsigned* st; };
__device__ __forceinline__ XcdBarrier xcd_barrier_post(unsigned* bar, volatile LAS unsigned* st) {
    XcdBarrier b; b.bar = bar; b.x = xb_xcc_id(); b.st = st;
    if (threadIdx.x == 0) (void)xb_add(&bar[XB_XCNT(b.x)], 1u);
    return b;
}
__device__ __forceinline__ void xcd_barrier_complete(unsigned* bar, unsigned x, unsigned& nloc, unsigned& nx) {
    const unsigned G = gridDim.x * gridDim.y * gridDim.z;
    unsigned sum, cnt, mine, sp = 0u;
    for (;;) {
        sum = 0u; cnt = 0u; mine = 0u;
#pragma unroll
        for (unsigned j = 0; j < 16; ++j) { const unsigned c = xb_ld(&bar[XB_XCNT(j)]); sum += c; cnt += (c > 0u) ? 1u : 0u; mine = (j == x) ? c : mine; }
        if (sum == G) break;
        __builtin_amdgcn_s_sleep(1);
        if ((++sp & 255u) == 0u) { if (xb_ld(&bar[XB_TMO])) break; if (sp > XB_SPIN_CAP) { atomicAdd(&bar[XB_TMO], 1u); break; } }
    }
    nloc = mine > 0u ? mine : 1u; nx = cnt > 0u ? cnt : 1u;
}
__device__ __forceinline__ void xcd_barrier(const XcdBarrier& b, const int wv) {
    asm volatile("s_waitcnt vmcnt(0)" ::: "memory");
    __syncthreads();
    if (wv == 0 && hw_lane() == 0) {
        unsigned* bar = b.bar;
        __builtin_amdgcn_s_waitcnt(0);
        unsigned nloc = b.st[0], nx = b.st[1];
        if (nloc == 0u) { xcd_barrier_complete(bar, b.x, nloc, nx); b.st[0] = nloc; b.st[1] = nx; }
        const unsigned old = xb_add(&bar[XB_XSUB(b.x)], 1u);
        const unsigned gen = old / nloc;
        if (old + 1u == (gen + 1u) * nloc) {
            __builtin_amdgcn_fence(__ATOMIC_RELEASE, "agent");
            asm volatile("s_waitcnt vmcnt(0)" ::: "memory");
            const unsigned og = xb_add(&bar[XB_TOP], 1u);
            const unsigned tg = og / nx;
            if (og + 1u == (tg + 1u) * nx) xb_add(&bar[XB_TOPGEN], 1u);
            else XB_SPIN(xb_ld(&bar[XB_TOPGEN]) == tg, bar);
            __builtin_amdgcn_fence(__ATOMIC_ACQUIRE, "agent");
            xb_add(&bar[XB_XGEN(b.x)], 1u);
            asm volatile("s_waitcnt vmcnt(0)" ::: "memory");
        } else {
            XB_SPIN(xb_ld(&bar[XB_XGEN(b.x)]) == gen, bar);
            __builtin_amdgcn_fence(__ATOMIC_ACQUIRE, "agent");
            asm volatile("s_waitcnt vmcnt(0)" ::: "memory");
        }
    }
    __syncthreads();
}

struct Args { const float* in[33]; float* out; unsigned char* ws; };
__device__ __forceinline__ const float* inp(int i) {
    unsigned off = (unsigned)i * 8u; asm volatile("" : "+s"(off));
    typedef const float* cfp;
    return *(const __attribute__((address_space(4))) cfp*)((const __attribute__((address_space(4))) char*)__builtin_amdgcn_kernarg_segment_ptr() + off);
}

#define WSP(off) (inp_ws() + (off))
__device__ __forceinline__ unsigned char* inp_ws() { return (unsigned char*)inp(34); }
__device__ __forceinline__ float* inp_out() { return (float*)inp(33); }

__device__ __forceinline__ void transpose_item(const float* W, int ldw, int K, bf16_t* WT, int src_n0, int dst_n0, int k0, LAS float* scr, int lane) {
#pragma unroll 8
    for (int i = 0; i < 32; ++i) { const int kk = 2 * i + (lane >> 5); scr[kk * 33 + (lane & 31)] = W[(size_t)(k0 + kk) * ldw + src_n0 + (lane & 31)]; }
    LDS_WAIT(); asm volatile("" ::: "memory");
    const int c = lane & 7;
#pragma unroll
    for (int j = 0; j < 4; ++j) { const int n = (lane >> 3) + 8 * j; const LAS float* s = scr + (8 * c) * 33 + n;
        u32x4 o; o.x = pk2(s[0 * 33], s[1 * 33]); o.y = pk2(s[2 * 33], s[3 * 33]); o.z = pk2(s[4 * 33], s[5 * 33]); o.w = pk2(s[6 * 33], s[7 * 33]);
        *(u32x4*)(WT + (size_t)(dst_n0 + n) * K + k0 + 8 * c) = o; }
    LDS_WAIT(); asm volatile("" ::: "memory");
}
template <int MAP>
__device__ __forceinline__ void convert_matrix(const float* W, int ldw, int K, int Ndst, bf16_t* WT, LAS float* scr, int lane, int gw, int NGW, int& base) {
    const int nblk = Ndst / 32, nitems = (K / 64) * nblk;
    int first = (gw - base % NGW + NGW) % NGW;
    for (int it = first; it < nitems; it += NGW) {
        const int kb = it / nblk, nb = it % nblk, d0 = nb * 32;
        int s0 = d0;
        if (MAP == 1) s0 = d0 + (d0 < 1024 ? 0 : (d0 < 2560 ? 16 : 24));
        if (MAP == 2) { const int pn = d0 >> 8, hh = (d0 & 255) >> 7, r = d0 & 127; s0 = hh * FF + pn * 128 + r; }
        transpose_item(W, ldw, K, WT, s0, d0, kb * 64, scr, lane);
    }
    base += nitems;
}

__device__ __forceinline__ void ada_phase(LAS unsigned char* lds, int blk, int wave, int lane) {
    if (blk >= 192) return;
    const int l = blk / 96, n0 = (blk % 96) * 64;
    const float* c = inp(1); const float* W = inp(2) + (size_t)l * 1024 * 6144; const float* bias = inp(3) + l * 6144;
    LAS float* cs = (LAS float*)lds;
    LAS float* part = (LAS float*)(lds + 32768);
    for (int i = wave * 64 + lane; i < 8192; i += NWAVES * 64) { const int b = i >> 10, k = i & 1023; cs[k * 8 + b] = siluf_(c[i]); }
    __syncthreads();
    float acc[8] = {0.f, 0.f, 0.f, 0.f, 0.f, 0.f, 0.f, 0.f};
#pragma unroll 4
    for (int k = wave * 128; k < wave * 128 + 128; ++k) {
        const float wv = W[(size_t)k * 6144 + n0 + lane];
        const f32x4 c0 = *(const LAS f32x4*)(cs + k * 8), c1 = *(const LAS f32x4*)(cs + k * 8 + 4);
        acc[0] += c0[0] * wv; acc[1] += c0[1] * wv; acc[2] += c0[2] * wv; acc[3] += c0[3] * wv;
        acc[4] += c1[0] * wv; acc[5] += c1[1] * wv; acc[6] += c1[2] * wv; acc[7] += c1[3] * wv;
    }
#pragma unroll
    for (int b = 0; b < 8; ++b) part[(wave * 8 + b) * 64 + lane] = acc[b];
    __syncthreads();
    {
        const int b = wave; float s = bias[n0 + lane];
#pragma unroll
        for (int w = 0; w < 8; ++w) s += part[(w * 8 + b) * 64 + lane];
        ((float*)WSP(WS_MOD))[(size_t)(l * 8 + b) * 6144 + n0 + lane] = s;
    }
    __syncthreads();
}

template <bool WITH_POST, bool WITH_PRE>
__device__ __forceinline__ void norm_rows(const bf16_t* Y, int ldy, const float* xin, const float* pw, const float* modl_post, int gt_off, float* xout,
                                          const float* w2, const float* modl_pre, int sh_off, int sc_off, bf16_t* H, int gw, int NGW, int lane) {
    f32x4 xc[2][4], xn[2][4]; u32x2 yc[2][4], yn[2][4];
#pragma unroll
    for (int q = 0; q < 2; ++q)
#pragma unroll
        for (int j = 0; j < 4; ++j) { xc[q][j] = *(const f32x4*)(xin + (size_t)(gw + q * NGW) * D + (lane + 64 * j) * 4);
            if (WITH_POST) yc[q][j] = *(const u32x2*)(Y + (size_t)(gw + q * NGW) * ldy + (lane + 64 * j) * 4); else yc[q][j] = (u32x2){0u, 0u}; xn[q][j] = xc[q][j]; yn[q][j] = yc[q][j]; }
    for (int row0 = gw; row0 < M; row0 += 2 * NGW) {
        const int rown = row0 + 2 * NGW;
        if (rown < M) {
#pragma unroll
            for (int q = 0; q < 2; ++q)
#pragma unroll
                for (int j = 0; j < 4; ++j) { xn[q][j] = *(const f32x4*)(xin + (size_t)(rown + q * NGW) * D + (lane + 64 * j) * 4);
                    if (WITH_POST) yn[q][j] = *(const u32x2*)(Y + (size_t)(rown + q * NGW) * ldy + (lane + 64 * j) * 4); }
        }
        f32x4 v[2][4];
        if (WITH_POST) {
            float ss[2] = {0.f, 0.f};
#pragma unroll
            for (int q = 0; q < 2; ++q)
#pragma unroll
                for (int j = 0; j < 4; ++j) { const u32x2 y = yc[q][j];
                    v[q][j] = (f32x4){bflo(y.x), bfhi(y.x), bflo(y.y), bfhi(y.y)}; ss[q] += v[q][j][0] * v[q][j][0] + v[q][j][1] * v[q][j][1] + v[q][j][2] * v[q][j][2] + v[q][j][3] * v[q][j][3]; }
#pragma unroll
            for (int o = 1; o < 64; o <<= 1) { const float t0 = shl(ss[0], lane ^ o), t1 = shl(ss[1], lane ^ o); ss[0] += t0; ss[1] += t1; }
#pragma unroll
            for (int q = 0; q < 2; ++q) {
                const int row = row0 + q * NGW, b = row / T;
                const float r = rsqrtf(ss[q] * (1.f / D) + 1e-6f);
                const float* gt = modl_post + (size_t)b * 6144 + gt_off;
#pragma unroll
                for (int j = 0; j < 4; ++j) {
                    const int col = (lane + 64 * j) * 4;
                    const f32x4 xo = xc[q][j], pwv = *(const f32x4*)(pw + col), gtv = *(const f32x4*)(gt + col);
#pragma unroll
                    for (int e = 0; e < 4; ++e) v[q][j][e] = xo[e] + (1.f + gtv[e]) * (v[q][j][e] * r * pwv[e]);
                    *(f32x4*)(xout + (size_t)row * D + col) = v[q][j];
                }
            }
        } else {
#pragma unroll
            for (int q = 0; q < 2; ++q)
#pragma unroll
                for (int j = 0; j < 4; ++j) v[q][j] = xc[q][j];
        }
        if (WITH_PRE) {
            float ss[2] = {0.f, 0.f};
#pragma unroll
            for (int q = 0; q < 2; ++q)
#pragma unroll
                for (int j = 0; j < 4; ++j) ss[q] += v[q][j][0] * v[q][j][0] + v[q][j][1] * v[q][j][1] + v[q][j][2] * v[q][j][2] + v[q][j][3] * v[q][j][3];
#pragma unroll
            for (int o = 1; o < 64; o <<= 1) { const float t0 = shl(ss[0], lane ^ o), t1 = shl(ss[1], lane ^ o); ss[0] += t0; ss[1] += t1; }
#pragma unroll
            for (int q = 0; q < 2; ++q) {
                const int row = row0 + q * NGW, b = row / T;
                const float r2 = rsqrtf(ss[q] * (1.f / D) + 1e-6f);
                const float* sh = modl_pre + (size_t)b * 6144 + sh_off; const float* sc = modl_pre + (size_t)b * 6144 + sc_off;
#pragma unroll
                for (int j = 0; j < 4; ++j) {
                    const int col = (lane + 64 * j) * 4;
                    const f32x4 wv = *(const f32x4*)(w2 + col), scv = *(const f32x4*)(sc + col), shv = *(const f32x4*)(sh + col);
#pragma unroll
                    for (int e = 0; e < 4; ++e) v[q][j][e] = v[q][j][e] * r2 * wv[e] * (1.f + scv[e]) + shv[e];
                    u32x2 o; o.x = pk2(v[q][j][0], v[q][j][1]); o.y = pk2(v[q][j][2], v[q][j][3]);
                    *(u32x2*)(H + (size_t)row * D + col) = o;
                }
            }
        }
#pragma unroll
        for (int q = 0; q < 2; ++q)
#pragma unroll
            for (int j = 0; j < 4; ++j) { xc[q][j] = xn[q][j]; yc[q][j] = yn[q][j]; }
    }
}
__device__ __forceinline__ void zs_mfma(const bf16_t* H, const bf16_t* Wsm, float* ZS, int task, int lane) {
    typedef float f32x16_ __attribute__((ext_vector_type(16)));
    const int r32 = lane & 31, hh = lane >> 5;
    const bf16_t* ap = H + (size_t)(32 * task + r32) * D + 8 * hh;
    const bf16_t* bp = Wsm + (size_t)r32 * D + 8 * hh;
    f32x16_ acc;
#pragma unroll
    for (int r = 0; r < 16; ++r) acc[r] = 0.f;
#pragma unroll 8
    for (int ks = 0; ks < D / 16; ++ks) acc = __builtin_amdgcn_mfma_f32_32x32x16_bf16(*(const bf16x8*)(ap + 16 * ks), *(const bf16x8*)(bp + 16 * ks), acc, 0, 0, 0);
    if (r32 < 24) {
#pragma unroll
        for (int r = 0; r < 16; ++r) ZS[(size_t)(32 * task + (r & 3) + 8 * (r >> 2) + 4 * hh) * 32 + r32] = acc[r];
    }
}
__device__ __forceinline__ void convert_small(const float* w_in, bf16_t* Wsm, int part, int tid) {
    for (int i = tid; i < 4 * 1024; i += NWAVES * 64) {
        const int c = 4 * part + (i >> 10), k = i & 1023;
        float v = 0.f;
        if (c < 16) v = w_in[(size_t)k * INDIM + 1024 + c]; else if (c < 24) v = w_in[(size_t)k * INDIM + 2576 + (c - 16)];
        Wsm[c * 1024 + k] = (bf16_t)f2bf(v);
    }
}

__device__ __forceinline__ void s5_generate(int l, int g, LAS unsigned char* lds, int wv) {
    int tid = hw_tid(wv); asm volatile("" : "+v"(tid));
    LAS float* ar = (LAS float*)lds;
    LAS float* ai = ar + 17 * 64;
    LAS float* bbr = ai + 17 * 64;
    LAS float* bbi = bbr + 1024;
    LAS float* cr = bbi + 1024;
    LAS float* ci = cr + 1024;
    LAS float* Kt = ci + 1024;
    bf16_t* Bt1 = (bf16_t*)WSP(WS_S5M1) + (size_t)g * 384 * 256;
    bf16_t* Bt3 = (bf16_t*)WSP(WS_S5M3) + (size_t)g * 256 * 256;
    __syncthreads();
    if (tid < 64) {
        const int p = tid;
        const float lre = fminf((inp(16) + l * 2048)[g * 64 + p], -1e-4f), lim = (inp(17) + l * 2048)[g * 64 + p], dt = expf((inp(18) + l * 32)[g]);
        for (int k = 0; k <= 16; ++k) { const float mg = expf((float)k * lre * dt), an = (float)k * lim * dt; ar[k * 64 + p] = mg * cosf(an); ai[k * 64 + p] = mg * sinf(an); }
        const float a1r = ar[64 + p], a1i = ai[64 + p];
        const float inv = 1.f / (lre * lre + lim * lim);
        const float zr_ = ((a1r - 1.f) * lre + a1i * lim) * inv, zi_ = (a1i * lre - (a1r - 1.f) * lim) * inv;
        const float* b_re = inp(19) + (size_t)l * 32768 + (size_t)(g * 64 + p) * 16; const float* b_im = inp(20) + (size_t)l * 32768 + (size_t)(g * 64 + p) * 16;
        for (int c = 0; c < 16; ++c) { const float br = b_re[c], bi = b_im[c]; bbr[p * 16 + c] = zr_ * br - zi_ * bi; bbi[p * 16 + c] = zr_ * bi + zi_ * br; }
    }
    for (int i = tid; i < 1024; i += 512) { cr[i] = (inp(21) + (size_t)l * 32768)[g * 1024 + i]; ci[i] = (inp(22) + (size_t)l * 32768)[g * 1024 + i]; }
    __syncthreads();
    {
        const int cp = tid >> 5, c = (tid >> 1) & 15, ph = tid & 1;
        float acc[16];
#pragma unroll
        for (int t = 0; t < 16; ++t) acc[t] = 0.f;
        for (int pp = 0; pp < 32; ++pp) {
            const int p = 32 * ph + pp;
            const float xr = cr[cp * 64 + p], xi = ci[cp * 64 + p], yr = bbr[p * 16 + c], yi = bbi[p * 16 + c];
            const float cbr = xr * yr - xi * yi, cbi = xr * yi + xi * yr;
#pragma unroll
            for (int t = 0; t < 16; ++t) acc[t] += cbr * ar[t * 64 + p] - cbi * ai[t * 64 + p];
        }
#pragma unroll
        for (int t = 0; t < 16; ++t) { const float o = acc[t] + shl(acc[t], (tid & 63) ^ 1); if (ph == 0) Kt[(t * 16 + cp) * 16 + c] = o; }
    }
    __syncthreads();
    for (int pc = tid; pc < 128 * 32; pc += 512) {
        const int row = pc >> 5, k0 = (pc & 31) * 8, sp = k0 >> 4, c0 = k0 & 15, p = row >> 1, e15 = 15 - sp;
        const float xr = ar[e15 * 64 + p], xi = ai[e15 * 64 + p];
        float v[8];
#pragma unroll
        for (int e = 0; e < 8; ++e) { const float yr = bbr[p * 16 + c0 + e], yi = bbi[p * 16 + c0 + e]; v[e] = (row & 1) == 0 ? (xr * yr - xi * yi) : (xr * yi + xi * yr); }
        u32x4 w; w.x = pk2(v[0], v[1]); w.y = pk2(v[2], v[3]); w.z = pk2(v[4], v[5]); w.w = pk2(v[6], v[7]);
        *(u32x4*)(Bt1 + (size_t)row * 256 + k0) = w;
    }
    for (int pc = tid; pc < 256 * 32; pc += 512) {
        const int j = pc >> 5, k0 = (pc & 31) * 8, s = j >> 4, cp = j & 15, sp = k0 >> 4, c0 = k0 & 15;
        float v[8];
#pragma unroll
        for (int e = 0; e < 8; ++e) v[e] = (sp <= s) ? Kt[((s - sp) * 16 + cp) * 16 + c0 + e] : 0.f;
        u32x4 w; w.x = pk2(v[0], v[1]); w.y = pk2(v[2], v[3]); w.z = pk2(v[4], v[5]); w.w = pk2(v[6], v[7]);
        *(u32x4*)(Bt1 + (size_t)(128 + j) * 256 + k0) = w;
    }
    for (int pc = tid; pc < 256 * 32; pc += 512) {
        const int j = pc >> 5, k0 = (pc & 31) * 8, s = j >> 4, cp = j & 15;
        float v[8];
#pragma unroll
        for (int e = 0; e < 8; ++e) {
            const int k = k0 + e, p = (k >> 1) & 63;
            const float xr = cr[cp * 64 + p], xi = ci[cp * 64 + p], yr = ar[(s + 1) * 64 + p], yi = ai[(s + 1) * 64 + p];
            v[e] = k >= 128 ? 0.f : ((k & 1) == 0 ? (xr * yr - xi * yi) : -(xr * yi + xi * yr));
        }
        u32x4 w; w.x = pk2(v[0], v[1]); w.y = pk2(v[2], v[3]); w.z = pk2(v[4], v[5]); w.w = pk2(v[6], v[7]);
        *(u32x4*)(Bt3 + (size_t)j * 256 + k0) = w;
    }
    __syncthreads();
}
__device__ __forceinline__ void s5_scan(int l, int sid, LAS unsigned char* lds, int wv) {
    int tid = hw_tid(wv); asm volatile("" : "+v"(tid));
    const int lane = tid & 63, w = wv;
    const int g = sid >> 3, b = sid & 7, p = lane;
    char* base = (char*)((bf16_t*)WSP(WS_Z) + (size_t)((g & 15) * 2048 + b * 256) * ZLD + EXC + (g >> 4) * 256);
    constexpr size_t RP = (size_t)ZLD * 2;
    __syncthreads();
#pragma unroll 8
    for (int r = 0; r < 32; ++r) { const int n = 32 * w + r; *(LAS f32x2*)(lds + n * 512 + 8 * p) = *(const f32x2*)(base + (size_t)n * RP + 8 * p); }
    __syncthreads();
    if (w == 0) {
        const float lre = fminf((inp(16) + l * 2048)[g * 64 + p], -1e-4f), lim = (inp(17) + l * 2048)[g * 64 + p], dt = expf((inp(18) + l * 32)[g]);
        const float mg = expf(16.f * lre * dt), an = 16.f * lim * dt, a16r = mg * cosf(an), a16i = mg * sinf(an);
        float xr = 0.f, xi = 0.f;
#pragma unroll 8
        for (int n = 0; n < 256; ++n) {
            const f32x2 e = *(const LAS f32x2*)(lds + n * 512 + 8 * p);
            const unsigned xp = pk2(xr, xi);
            const float tr = a16r * xr - a16i * xi + e[0], ti = a16r * xi + a16i * xr + e[1];
            xr = tr; xi = ti;
            asm volatile("" ::: "memory");
            *(LAS unsigned*)(lds + n * 512 + 4 * p) = xp;
        }
    }
    __syncthreads();
#pragma unroll 8
    for (int r = 0; r < 32; ++r) { const int n = 32 * w + r; unsigned* row = (unsigned*)(base + (size_t)n * RP); row[p] = *(const LAS unsigned*)(lds + n * 512 + 4 * p); row[64 + p] = 0u; }
}

namespace mx {
typedef float f32x16 __attribute__((ext_vector_type(16)));
__device__ __forceinline__ unsigned cpk(float lo, float hi) { return pg8::cvt_pk_bf16(lo, hi); }
__device__ __forceinline__ unsigned cpk1(float x) { return pg8::cvt_pk_bf16(x, x); }
constexpr int PB = 72;
constexpr int L_QS = 0, L_KS = 9216, L_KT = 18432, L_VT = 27648, L_PS = 46080, L_ST = 55296, L_OS = 73728, L_VEC = 107520;
constexpr int OSP = 132;
constexpr int V_SEG = 0, V_ELAST = 512, V_GA = 576, V_SETS = 1600, SETSZ = 384, V_RT = 0, V_CS = 64, V_WI = 128, V_WK = 192, V_ENM = 256, V_SC = 320, V_DEN = 2368, V_NORM = 2432, V_END = 2560;
static_assert(L_VEC + V_END * 4 <= RING_BYTES, "mixer LDS map");
__device__ __forceinline__ int crow(int reg, int hh) { return (reg & 3) + 8 * (reg >> 2) + 4 * hh; }
__device__ __forceinline__ float fexp(float x) { return __builtin_amdgcn_exp2f(1.4426950408889634f * x); }
__device__ __forceinline__ float flogsig(float x) { const float e = fexp(-fabsf(x)); return fminf(x, 0.f) - 0.6931471805599453f * __builtin_amdgcn_logf(1.f + e); }
#define MX_MFMA(a, b, c) __builtin_amdgcn_mfma_f32_32x32x16_bf16((a), (b), (c), 0, 0, 0)

template <int ROLE, bool STORE = true>
__device__ __forceinline__ void stream(int l, LAS unsigned char* lds, int bh, int wvs) {
    int tid = hw_tid(wvs); asm volatile("" : "+v"(tid));
    const int lane = tid & 63, w = __builtin_amdgcn_readfirstlane(tid >> 6), r32 = lane & 31, hh = lane >> 5;
    const int b = bh >> 2, h = bh & 3;
    bf16_t* Z = (bf16_t*)WSP(WS_Z); const float* ZS = (const float*)WSP(WS_ZS);
    LAS float* vec = (LAS float*)(lds + L_VEC);
    LAS bf16_t* Qs = (LAS bf16_t*)(lds + L_QS); LAS bf16_t* Ks = (LAS bf16_t*)(lds + L_KS); LAS bf16_t* KTs = (LAS bf16_t*)(lds + L_KT);
    LAS bf16_t* VTs = (LAS bf16_t*)(lds + L_VT); LAS bf16_t* Ps = (LAS bf16_t*)(lds + L_PS); LAS bf16_t* STs = (LAS bf16_t*)(lds + L_ST);
    LAS float* Os = (LAS float*)(lds + L_OS);
    const int qcol = (ROLE == 0 ? GQ : MQ) + h * 64, kcol = (ROLE == 0 ? GK : MK) + h * 64, vcol = (ROLE == 0 ? GV : MV) + h * 128, gcol = (ROLE == 0 ? GR : MO) + h * 128;
    const int vc_ = tid & 127, rq = tid >> 7, et = tid >> 3, cg = tid & 7;
    const int wa = w >> 2, wv = w & 3;
    float a2c[16], abd = 0.f, nwv[16];
    float cwq[4], cwk[4], cbq = 0.f, cbk = 0.f, ibh = 0.f, fbh = 0.f, mprev = 0.f;
#pragma unroll
    for (int r = 0; r < 16; ++r) { a2c[r] = 0.f; nwv[r] = 0.f; }
#pragma unroll
    for (int j = 0; j < 4; ++j) { cwq[j] = 0.f; cwk[j] = 0.f; }
    if (ROLE == 0) {
        const float* a2 = inp(9) + l * 16 * 256; const float* ab = inp(10) + l * 256; const float* nw = inp(11) + l * 512;
#pragma unroll
        for (int r = 0; r < 16; ++r) { a2c[r] = a2[r * 256 + h * 64 + lane]; nwv[r] = nw[h * 128 + 16 * cg + r]; }
        abd = ab[h * 64 + lane];
    } else {
        const float* cw = inp(12) + l * 4 * 512; const float* cb = inp(13) + l * 512;
#pragma unroll
        for (int j = 0; j < 4; ++j) { cwq[j] = cw[j * 512 + h * 64 + lane]; cwk[j] = cw[j * 512 + 256 + h * 64 + lane]; }
        cbq = cb[h * 64 + lane]; cbk = cb[256 + h * 64 + lane];
        ibh = (inp(14) + l * 4)[h]; fbh = (inp(15) + l * 4)[h];
    }
    for (int i = tid; i < 128 * PB / 2; i += 512) ((LAS unsigned*)STs)[i] = 0u;
    for (int i = tid; i < 64 * PB / 2; i += 512) ((LAS unsigned*)Ps)[i] = 0u;
    if (tid < 128) vec[V_NORM + tid] = 0.f;
    f32x16 accS;
#pragma unroll
    for (int r = 0; r < 16; ++r) accS[r] = 0.f;
    unsigned qi[11], ki[11], vi[16]; float zs0 = 0.f, zs1 = 0.f; u32x4 gt0 = {0u, 0u, 0u, 0u}, gt1 = {0u, 0u, 0u, 0u};
#define MX_LOAD(mrow, nn) do { \
        if (ROLE == 0) { \
            _Pragma("unroll") for (int i = 0; i < 8; ++i) { const bf16_t* zr = Z + ((mrow) + 8 * w + i) * ZLD; qi[i] = *(const unsigned*)(zr + qcol + (lane & ~1)); ki[i] = *(const unsigned*)(zr + kcol + (lane & ~1)); } \
            const float* zp = ZS + ((mrow) + et) * 32 + 2 * cg; zs0 = zp[0]; zs1 = zp[1]; \
        } else { \
            _Pragma("unroll") for (int i = 0; i < 11; ++i) { const int trel = 8 * w + i - 3; const int trc = ((nn) > 0 || trel >= 0) ? trel : 0;     \
                const bf16_t* zr = Z + ((mrow) + trc) * ZLD; qi[i] = *(const unsigned*)(zr + qcol + (lane & ~1)); ki[i] = *(const unsigned*)(zr + kcol + (lane & ~1)); } \
            if (w == 7) { const float* zp = ZS + ((mrow) + lane) * 32; zs0 = zp[16 + h]; zs1 = zp[20 + h]; } \
        } \
        _Pragma("unroll") for (int i = 0; i < 16; ++i) vi[i] = *(const unsigned*)(Z + ((mrow) + 16 * rq + i) * ZLD + vcol + (vc_ & ~1)); \
    } while (0)
#define MX_SCALARS(sv) do { \
        asm volatile("" : "+v"(zs0), "+v"(zs1)); \
        const float ip = zs0 + ibh, lf = flogsig(zs1 + fbh); \
        float bs = lf; \
        _Pragma("unroll") for (int o = 1; o < 64; o <<= 1) { const float t = shl(bs, lane >= o ? lane - o : lane); if (lane >= o) bs += t; } \
        const float cs = ip - bs; \
        float pm = cs; \
        _Pragma("unroll") for (int o = 1; o < 64; o <<= 1) { const float t = shl(pm, lane >= o ? lane - o : lane); if (lane >= o) pm = fmaxf(pm, t); } \
        const float mt = bs + fmaxf(mprev, pm); \
        (sv)[V_RT + lane] = bs - mt; (sv)[V_CS + lane] = cs; (sv)[V_WI + lane] = fexp(bs + mprev - mt); (sv)[V_ENM + lane] = fexp(-mt); \
        const float mnew = shl(mt, 63), b63 = shl(bs, 63); \
        (sv)[V_WK + lane] = fexp(b63 + cs - mnew); \
        if (lane == 0) (sv)[V_SC] = fexp(b63 + mprev - mnew); \
        mprev = mnew; \
    } while (0)
#define MX_PIN11(a) asm volatile("" : "+v"(a[0]), "+v"(a[1]), "+v"(a[2]), "+v"(a[3]), "+v"(a[4]), "+v"(a[5]), "+v"(a[6]), "+v"(a[7]), "+v"(a[8]), "+v"(a[9]), "+v"(a[10]))
#define MX_PIN8(a, o) asm volatile("" : "+v"(a[o]), "+v"(a[o + 1]), "+v"(a[o + 2]), "+v"(a[o + 3]), "+v"(a[o + 4]), "+v"(a[o + 5]), "+v"(a[o + 6]), "+v"(a[o + 7]))
    size_t m0 = (size_t)b * T;
    MX_LOAD(m0, 0);
    if (ROLE == 0) { vec[V_GA + et * 16 + 2 * cg] = zs0; vec[V_GA + et * 16 + 2 * cg + 1] = zs1; }
    else if (w == 7) MX_SCALARS(vec + V_SETS);
    __syncthreads();

#pragma unroll 1
    for (int n = 0; n <= 64; ++n) {
        if (n > 0) {
            const size_t mp = m0 - 64;
            const LAS float* orow = Os + et * OSP + 16 * cg;
            float o[16];
#pragma unroll
            for (int q4 = 0; q4 < 4; ++q4) { const f32x4 t4 = *(const LAS f32x4*)(orow + 4 * q4); o[4 * q4] = t4[0]; o[4 * q4 + 1] = t4[1]; o[4 * q4 + 2] = t4[2]; o[4 * q4 + 3] = t4[3]; }
            asm volatile("" : "+v"(gt0), "+v"(gt1));
            const unsigned gw_[8] = {gt0.x, gt0.y, gt0.z, gt0.w, gt1.x, gt1.y, gt1.z, gt1.w};
            float y[16];
            if (ROLE == 0) {
                float ss = 0.f;
#pragma unroll
                for (int e = 0; e < 16; ++e) ss += o[e] * o[e];
                ss += shl(ss, lane ^ 1); ss += shl(ss, lane ^ 2); ss += shl(ss, lane ^ 4);
                const float rn = rsqrtf(ss * (1.f / 128.f) + 1e-6f);
#pragma unroll
                for (int e = 0; e < 16; ++e) { const float g = (e & 1) ? bfhi(gw_[e >> 1]) : bflo(gw_[e >> 1]); y[e] = o[e] * rn * nwv[e] * g * fsigmoid(g); }
            } else {
                const float rdiv = vec[V_DEN + et];
#pragma unroll
                for (int e = 0; e < 16; ++e) { const float g = (e & 1) ? bfhi(gw_[e >> 1]) : bflo(gw_[e >> 1]); y[e] = o[e] * rdiv * fsigmoid(g); }
            }
            u32x4 s0, s1;
            s0.x = cpk(y[0], y[1]); s0.y = cpk(y[2], y[3]); s0.z = cpk(y[4], y[5]); s0.w = cpk(y[6], y[7]);
            s1.x = cpk(y[8], y[9]); s1.y = cpk(y[10], y[11]); s1.z = cpk(y[12], y[13]); s1.w = cpk(y[14], y[15]);
            bf16_t* dst = Z + (mp + et) * ZLD + gcol + 16 * cg;
            if (STORE) { *(u32x4*)dst = s0; *(u32x4*)(dst + 8) = s1; } else { asm volatile("" :: "v"(s0), "v"(s1), "v"(dst)); }
        }
        if (n == 64) break;
        if (ROLE == 0) { MX_PIN8(qi, 0); MX_PIN8(ki, 0); } else { MX_PIN11(qi); MX_PIN11(ki); if (n == 0 && w == 0) { qi[0] = qi[1] = qi[2] = 0u; ki[0] = ki[1] = ki[2] = 0u; } }
        float c8[8], qf[8], kf[8];
        const LAS float* sv = vec + V_SETS + (n & 1) * SETSZ;
        if (ROLE == 0) {
            float run = 0.f;
#pragma unroll
            for (int i = 0; i < 8; ++i) {
                const LAS f32x4* gp = (const LAS f32x4*)(vec + V_GA + (8 * w + i) * 16);
                float x = abd;
#pragma unroll
                for (int r4 = 0; r4 < 4; ++r4) { const f32x4 g4 = gp[r4]; x += g4[0] * a2c[4 * r4] + g4[1] * a2c[4 * r4 + 1] + g4[2] * a2c[4 * r4 + 2] + g4[3] * a2c[4 * r4 + 3]; }
                run += flogsig(x) * (1.f / 16.f); c8[i] = run;
                qf[i] = ((lane & 1) ? bfhi(qi[i]) : bflo(qi[i])) * 0.125f; kf[i] = (lane & 1) ? bfhi(ki[i]) : bflo(ki[i]);
            }
            vec[V_SEG + w * 64 + lane] = run;
        } else {
#pragma unroll
            for (int i = 0; i < 8; ++i) {
                float aq = cbq, ak = cbk;
#pragma unroll
                for (int j = 0; j < 4; ++j) { aq += cwq[j] * ((lane & 1) ? bfhi(qi[i + j]) : bflo(qi[i + j])); ak += cwk[j] * ((lane & 1) ? bfhi(ki[i + j]) : bflo(ki[i + j])); }
                qf[i] = aq * fsigmoid(aq); kf[i] = ak * fsigmoid(ak) * 0.125f; c8[i] = 0.f;
            }
        }
        if (ROLE == 0) __syncthreads();
        {
            u32x4 ktp; unsigned ktw[4];
            if (ROLE == 0) {
                float off = 0.f, tot = 0.f;
#pragma unroll
                for (int w2 = 0; w2 < 8; ++w2) { const float s = vec[V_SEG + w2 * 64 + lane]; tot += s; off += (w2 < w) ? s : 0.f; }
                if (w == 0) vec[V_ELAST + lane] = fexp(tot);
                float kt[8];
#pragma unroll
                for (int i = 0; i < 8; ++i) {
                    const float cum = off + c8[i];
                    Qs[(8 * w + i) * PB + lane] = (bf16_t)cpk1(qf[i] * fexp(cum));
                    Ks[(8 * w + i) * PB + lane] = (bf16_t)cpk1(kf[i] * fexp(-cum));
                    kt[i] = kf[i] * fexp(tot - cum);
                }
#pragma unroll
                for (int i = 0; i < 4; ++i) ktw[i] = cpk(kt[2 * i], kt[2 * i + 1]);
            } else {
                float kt[8];
#pragma unroll
                for (int i = 0; i < 8; ++i) {
                    Qs[(8 * w + i) * PB + lane] = (bf16_t)cpk1(qf[i]);
                    Ks[(8 * w + i) * PB + lane] = (bf16_t)cpk1(kf[i]);
                    kt[i] = kf[i] * sv[V_WK + 8 * w + i];
                }
#pragma unroll
                for (int i = 0; i < 4; ++i) ktw[i] = cpk(kt[2 * i], kt[2 * i + 1]);
            }
            ktp.x = ktw[0]; ktp.y = ktw[1]; ktp.z = ktw[2]; ktp.w = ktw[3];
            *(LAS u32x4*)(KTs + lane * PB + 8 * w) = ktp;
            MX_PIN8(vi, 0); MX_PIN8(vi, 8);
#pragma unroll
            for (int i = 0; i < 16; ++i) vi[i] = (vc_ & 1) ? (vi[i] >> 16) : (vi[i] & 0xffffu);
            u32x4 v0, v1;
            v0.x = vi[0] | ((unsigned)vi[1] << 16); v0.y = vi[2] | ((unsigned)vi[3] << 16); v0.z = vi[4] | ((unsigned)vi[5] << 16); v0.w = vi[6] | ((unsigned)vi[7] << 16);
            v1.x = vi[8] | ((unsigned)vi[9] << 16); v1.y = vi[10] | ((unsigned)vi[11] << 16); v1.z = vi[12] | ((unsigned)vi[13] << 16); v1.w = vi[14] | ((unsigned)vi[15] << 16);
            *(LAS u32x4*)(VTs + vc_ * PB + 16 * rq) = v0; *(LAS u32x4*)(VTs + vc_ * PB + 16 * rq + 8) = v1;
        }
        __syncthreads();
        { const bf16_t* gp = Z + (m0 + et) * ZLD + gcol + 16 * cg; gt0 = *(const u32x4*)gp; gt1 = *(const u32x4*)(gp + 8); }
        if (n < 63) MX_LOAD(m0 + 64, n + 1);
#define MX_FRAG(base, row, ks) (*(const LAS bf16x8*)(lds + (base) + ((row) * PB + 16 * (ks) + 8 * hh) * 2))
        if (w < 3) {
            const int ti = (w >= 1) ? 1 : 0, sj = (w == 2) ? 1 : 0;
            f32x16 sc;
#pragma unroll
            for (int r = 0; r < 16; ++r) sc[r] = 0.f;
#pragma unroll
            for (int ks = 0; ks < 4; ++ks) sc = MX_MFMA(MX_FRAG(L_QS, 32 * ti + r32, ks), MX_FRAG(L_KS, 32 * sj + r32, ks), sc);
            const float csv = (ROLE == 1) ? sv[V_CS + 32 * sj + r32] : 0.f;
#pragma unroll
            for (int r = 0; r < 16; ++r) {
                const int t = crow(r, hh);
                const bool keep = (ti != sj) || (r32 <= t);
                float val = sc[r];
                if (ROLE == 1) val *= fexp(sv[V_RT + 32 * ti + t] + csv);
                Ps[(32 * ti + t) * PB + 32 * sj + r32] = (bf16_t)cpk1(keep ? val : 0.f);
            }
        }
        f32x16 acco;
#pragma unroll
        for (int r = 0; r < 16; ++r) acco[r] = 0.f;
#pragma unroll
        for (int ks = 0; ks < 4; ++ks) acco = MX_MFMA(MX_FRAG(L_QS, 32 * wa + r32, ks), MX_FRAG(L_ST, 32 * wv + r32, ks), acco);
        if (ROLE == 1) {
#pragma unroll
            for (int r = 0; r < 16; ++r) acco[r] *= sv[V_WI + 32 * wa + crow(r, hh)];
        }
        if (ROLE == 0) {
#pragma unroll
            for (int r = 0; r < 16; ++r) accS[r] *= vec[V_ELAST + 32 * wa + crow(r, hh)];
        } else {
            const float carry = sv[V_SC];
#pragma unroll
            for (int r = 0; r < 16; ++r) accS[r] *= carry;
        }
#pragma unroll
        for (int ks = 0; ks < 4; ++ks) accS = MX_MFMA(MX_FRAG(L_KT, 32 * wa + r32, ks), MX_FRAG(L_VT, 32 * wv + r32, ks), accS);
        __syncthreads();
        if (wa == 0) {
#pragma unroll
            for (int ks = 0; ks < 2; ++ks) acco = MX_MFMA(MX_FRAG(L_PS, r32, ks), MX_FRAG(L_VT, 32 * wv + r32, ks), acco);
        } else {
#pragma unroll
            for (int ks = 0; ks < 4; ++ks) acco = MX_MFMA(MX_FRAG(L_PS, 32 + r32, ks), MX_FRAG(L_VT, 32 * wv + r32, ks), acco);
        }
#pragma unroll
        for (int r = 0; r < 16; ++r) Os[(32 * wa + crow(r, hh)) * OSP + 32 * wv + r32] = acco[r];
#pragma unroll
        for (int q4 = 0; q4 < 4; ++q4) { u32x2 p; p.x = cpk(accS[4 * q4], accS[4 * q4 + 1]); p.y = cpk(accS[4 * q4 + 2], accS[4 * q4 + 3]);
            *(LAS u32x2*)(STs + (32 * wv + r32) * PB + 32 * wa + 8 * q4 + 4 * hh) = p; }
        if (ROLE == 0) { if (n < 63) { vec[V_GA + et * 16 + 2 * cg] = zs0; vec[V_GA + et * 16 + 2 * cg + 1] = zs1; } }
        else {
            const LAS float* nprev = vec + V_NORM + (n & 1) * 64;
            if (w == 0) {
                float qn = 0.f, si = 0.f;
#pragma unroll
                for (int c8i = 0; c8i < 8; ++c8i) {
                    const u32x4 qv = *(const LAS u32x4*)(Qs + lane * PB + 8 * c8i), pv = *(const LAS u32x4*)(Ps + lane * PB + 8 * c8i);
                    const f32x4 n0 = *(const LAS f32x4*)(nprev + 8 * c8i), n1 = *(const LAS f32x4*)(nprev + 8 * c8i + 4);
                    qn += bflo(qv.x) * n0[0] + bfhi(qv.x) * n0[1] + bflo(qv.y) * n0[2] + bfhi(qv.y) * n0[3] + bflo(qv.z) * n1[0] + bfhi(qv.z) * n1[1] + bflo(qv.w) * n1[2] + bfhi(qv.w) * n1[3];
                    si += (bflo(pv.x) + bfhi(pv.x)) + (bflo(pv.y) + bfhi(pv.y)) + (bflo(pv.z) + bfhi(pv.z)) + (bflo(pv.w) + bfhi(pv.w));
                }
                const float den = sv[V_WI + lane] * qn + si;
                vec[V_DEN + lane] = 1.f / fmaxf(fabsf(den), sv[V_ENM + lane]);
            } else if (w == 7) {
                if (n < 63) MX_SCALARS(vec + V_SETS + ((n + 1) & 1) * SETSZ);
            } else if (w == 1) {
                float kn = 0.f;
#pragma unroll
                for (int c8i = 0; c8i < 8; ++c8i) { const u32x4 kv = *(const LAS u32x4*)(KTs + lane * PB + 8 * c8i);
                    kn += (bflo(kv.x) + bfhi(kv.x)) + (bflo(kv.y) + bfhi(kv.y)) + (bflo(kv.z) + bfhi(kv.z)) + (bflo(kv.w) + bfhi(kv.w)); }
                vec[V_NORM + ((n + 1) & 1) * 64 + lane] = sv[V_SC] * nprev[lane] + kn;
            }
        }
        __syncthreads();
        m0 += 64;
    }
#undef MX_LOAD
#undef MX_PIN8
#undef MX_SCALARS
#undef MX_PIN11
#undef MX_FRAG
}
}

#ifndef PHASE_MASK
#define PHASE_MASK 0xFFFF
#endif
#define PH(k) if constexpr ((PHASE_MASK >> (k)) & 1)
#ifndef PROBE_GEMM_REPS
#define PROBE_GEMM_REPS 1
#endif
#ifndef PROBE_STREAM_REPS
#define PROBE_STREAM_REPS 1
#endif
#define GREP _Pragma("unroll 1") for (int rep_ = 0; rep_ < PROBE_GEMM_REPS; ++rep_)
#define GREP_BAR if (rep_) GRID_BAR();
#define BLK_ENV int blk = blockIdx.x; asm volatile("" : "+s"(blk));
#define PHASE_ENV BLK_ENV int tid = hw_tid(wave_s); asm volatile("" : "+v"(tid)); const int lane = tid & 63, wave = wave_s; int vcu_ = vcu; asm volatile("" : "+s"(vcu_)); const int gw = vcu_ * NWAVES + wave; (void)lane; (void)gw;
__global__ void __launch_bounds__(NWAVES * 64, 2) mega_fwd(Args args) {
    extern __shared__ __attribute__((aligned(16))) unsigned char lds_raw[];
    LAS unsigned char* lds = (LAS unsigned char*)lds_raw;
    const int G = gridDim.x, blk0 = blockIdx.x;
    const int wave_s = __builtin_amdgcn_readfirstlane(threadIdx.x >> 6);
    const int vcu = (G % 8 == 0) ? (blk0 % 8) * (G / 8) + blk0 / 8 : blk0;
    const int NGW = G * NWAVES;
    for (int u = threadIdx.x; u < (LDS_BYTES - LDSCTL_OFF) / 4; u += NWAVES * 64) ((LAS unsigned*)(lds + LDSCTL_OFF))[u] = 0u;
    __syncthreads();
    (void)xcd_barrier_post((unsigned*)(args.ws + WS_CTL) + CW_BAR, (volatile LAS unsigned*)(lds + MISC_OFF) + 8);
#define GRID_BAR() do { XcdBarrier b_; b_.bar = (unsigned*)(inp_ws() + WS_CTL) + CW_BAR; b_.x = xb_xcc_id(); b_.st = (volatile LAS unsigned*)(lds + MISC_OFF) + 8; xcd_barrier(b_, wave_s); } while (0)

    PH(0) { PHASE_ENV
        ada_phase(lds, blk, wave, lane);
        if (blk < 32) s5_generate(0, blk, lds, wave_s);
        else if (blk < 40) convert_small(inp(8), (bf16_t*)WSP(WS_WSM), blk - 32, tid);
        LAS float* scr = (LAS float*)(lds + wave * 16384);
        int base = 0;
        convert_matrix<1>(inp(8), INDIM, 1024, ZLD, (bf16_t*)WSP(WS_WIN), scr, lane, gw, NGW, base);
    }
    GRID_BAR();

#pragma unroll 1
    for (int l = 0; l < DEPTH; ++l) {
        PH(1) if (l == 0) { PHASE_ENV
            norm_rows<false, true>(nullptr, 0, inp(0), nullptr, nullptr, 0, nullptr, inp(4), (const float*)WSP(WS_MOD), 0, 1024, (bf16_t*)WSP(WS_H), gw, NGW, lane);
            GRID_BAR();
        }
        PH(2) GREP { GREP_BAR BLK_ENV
            pg8::PlainSched S; S.o.init(M, NMIX, G, blk); S.A = (const bf16_t*)WSP(WS_H); S.lda = D; S.Bt = (const bf16_t*)WSP(WS_WIN); S.K = D;
            pg8::EpiStore E{(bf16_t*)WSP(WS_Z), ZLD};
            pg8::gemm_phase<pg8::EpiStore, pg8::PlainSched, true, true>(lds, wave_s, D, D, S, E);
            { const int task = (int)(((G % 8 == 0) ? (blk % 8) * (G / 8) + blk / 8 : blk) * NWAVES + wave_s);
              for (int t = task; t < M / 32; t += G * NWAVES) zs_mfma((const bf16_t*)WSP(WS_H), (const bf16_t*)WSP(WS_WSM), (float*)WSP(WS_ZS), t, hw_lane()); }
        }
        GRID_BAR();
        PH(11) GREP { GREP_BAR BLK_ENV
            pg8::S5aSched S; S.G = G; S.c = blk; S.Zb = (const bf16_t*)WSP(WS_Z); S.Bt1 = (const bf16_t*)WSP(WS_S5M1);
            pg8::EpiS5a E{(bf16_t*)WSP(WS_Z)};
            pg8::gemm_phase<pg8::EpiS5a, pg8::S5aSched, true, true, 1>(lds, wave_s, 0, 256, S, E);
        }
        GRID_BAR();
        PH(3) { PHASE_ENV
            for (int sid = blk; sid < 256; sid += G) s5_scan(l, sid, lds, wave_s);
        }
        GRID_BAR();
        PH(12) { BLK_ENV
            pg8::S5bSched S; S.G = G; S.c = blk; S.X = (const bf16_t*)WSP(WS_Z); S.Bt3 = (const bf16_t*)WSP(WS_S5M3);
            pg8::EpiS5b E{(bf16_t*)WSP(WS_Z), inp(23) + l * 512};
            pg8::gemm_phase<pg8::EpiS5b, pg8::S5bSched, true, true>(lds, wave_s, ZLD, 256, S, E);
        }
        GRID_BAR();
        PH(3) { PHASE_ENV
#if PROBE_STREAM_REPS > 1
            for (int rep_ = 1; rep_ < PROBE_STREAM_REPS; ++rep_) { if (blk < 32) mx::stream<0, false>(l, lds, blk, wave_s); else if (blk < 64) mx::stream<1, false>(l, lds, blk - 32, wave_s); __syncthreads(); }
#endif
            if (blk < 32) mx::stream<0>(l, lds, blk, wave_s);
            else if (blk < 64) mx::stream<1>(l, lds, blk - 32, wave_s);
            else {
                {
                    int base = 0; const int gw2 = (blk - 64) * NWAVES + wave, NGW2 = (G - 64) * NWAVES;
                    LAS float* scr = (LAS float*)(lds + wave * 16384);
                    convert_matrix<0>(inp(24) + (size_t)l * 512 * 512, 512, 512, 512, (bf16_t*)WSP(WS_WGLU), scr, lane, gw2, NGW2, base);
                    convert_matrix<0>(inp(26) + (size_t)l * 512 * 1024, 1024, 512, 1024, (bf16_t*)WSP(WS_WPROJ), scr, lane, gw2, NGW2, base);
                    convert_matrix<0>(inp(27) + (size_t)l * 512 * 1024, 1024, 512, 1024, (bf16_t*)WSP(WS_WPROJ) + 1024 * 512, scr, lane, gw2, NGW2, base);
                    convert_matrix<0>(inp(28) + (size_t)l * 512 * 1024, 1024, 512, 1024, (bf16_t*)WSP(WS_WPROJ) + 2 * 1024 * 512, scr, lane, gw2, NGW2, base);
                    convert_matrix<0>(inp(30) + (size_t)l * D * D, 1024, 1024, 1024, (bf16_t*)WSP(WS_WOUT), scr, lane, gw2, NGW2, base);
                    convert_matrix<0>(inp(32) + (size_t)l * FF * D, 1024, FF, 1024, (bf16_t*)WSP(WS_WFO), scr, lane, gw2, NGW2, base);
                    __syncthreads();
                }
                pg8::PlainSched S; S.o.init(M, ZLD - NMIX, G - 64, blk - 64); S.A = (const bf16_t*)WSP(WS_H); S.lda = D; S.Bt = (const bf16_t*)WSP(WS_WIN) + (size_t)NMIX * D; S.K = D;
                pg8::EpiStore E{(bf16_t*)WSP(WS_Z) + NMIX, ZLD};
                pg8::gemm_phase<pg8::EpiStore, pg8::PlainSched, true, true>(lds, wave_s, D, D, S, E);
            }
        }
        GRID_BAR();
        PH(4) GREP { GREP_BAR BLK_ENV
            bf16_t* Z = (bf16_t*)WSP(WS_Z);
            pg8::PlainSched S; S.o.init(M, 512, G, blk); S.A = Z + SU; S.lda = ZLD; S.Bt = (const bf16_t*)WSP(WS_WGLU); S.K = 512;
            pg8::EpiGlu E{Z + YS2, ZLD, Z + SU, ZLD, inp(25) + l * 512};
            pg8::gemm_phase<pg8::EpiGlu, pg8::PlainSched, true, true>(lds, wave_s, ZLD, 512, S, E);
        }
        GRID_BAR();
        PH(5) GREP { GREP_BAR BLK_ENV
            bf16_t* Z = (bf16_t*)WSP(WS_Z);
            pg8::MergeSched S; S.o.init(M, 1024, G, blk); S.Zb = Z; S.Wp = (const bf16_t*)WSP(WS_WPROJ);
            pg8::EpiMerge E{Z + MRG, ZLD, Z + ZG, ZLD, inp(29) + l * 3072};
            pg8::gemm_phase<pg8::EpiMerge, pg8::MergeSched, true, true>(lds, wave_s, ZLD, 512, S, E);
        }
        GRID_BAR();
        PH(6) GREP { GREP_BAR BLK_ENV
            pg8::PlainSched S; S.o.init(M, 1024, G, blk); S.A = (const bf16_t*)WSP(WS_Z) + MRG; S.lda = ZLD; S.Bt = (const bf16_t*)WSP(WS_WOUT); S.K = 1024;
            pg8::EpiStore E{(bf16_t*)WSP(WS_H), D};
            pg8::gemm_phase<pg8::EpiStore, pg8::PlainSched, true, true>(lds, wave_s, ZLD, 1024, S, E);
        }
        GRID_BAR();
        PH(7) { PHASE_ENV
            const float* modl = (const float*)WSP(WS_MOD) + (size_t)l * 8 * 6144;
            { int base = 0; convert_matrix<2>(inp(31) + (size_t)l * D * 2 * FF, 2 * FF, 1024, 2 * FF, (bf16_t*)WSP(WS_WFI), (LAS float*)(lds + wave * 16384), lane, gw, NGW, base); }
            norm_rows<true, true>((const bf16_t*)WSP(WS_H), D, (l == 0) ? inp(0) : (const float*)inp_out(), inp(5) + l * D, modl, 2048, inp_out(), inp(6) + l * D, modl, 3072, 4096,
                                      (bf16_t*)WSP(WS_H), gw, NGW, lane);
        }
        GRID_BAR();
        PH(8) GREP { GREP_BAR BLK_ENV
            pg8::PlainSched S; S.o.init(M, 2 * FF, G, blk); S.A = (const bf16_t*)WSP(WS_H); S.lda = D; S.Bt = (const bf16_t*)WSP(WS_WFI); S.K = D;
            pg8::EpiSwiGlu E{(bf16_t*)WSP(WS_Z), FF};
            pg8::gemm_phase<pg8::EpiSwiGlu, pg8::PlainSched, true, true>(lds, wave_s, D, D, S, E);
        }
        GRID_BAR();
        PH(9) GREP { GREP_BAR BLK_ENV
            pg8::PlainSched S; S.o.init(M, 1024, G, blk); S.A = (const bf16_t*)WSP(WS_Z); S.lda = FF; S.Bt = (const bf16_t*)WSP(WS_WFO); S.K = FF;
            pg8::EpiStore E{(bf16_t*)WSP(WS_H), D};
            pg8::gemm_phase<pg8::EpiStore, pg8::PlainSched, true, true>(lds, wave_s, FF, FF, S, E);
        }
        GRID_BAR();
        PH(10) { PHASE_ENV
            const float* modl = (const float*)WSP(WS_MOD) + (size_t)l * 8 * 6144;
            if (l + 1 < DEPTH) {
                const int l1 = l + 1;
                LAS float* scr = (LAS float*)(lds + wave * 16384);
                int base = 0;
                if (blk < 32) s5_generate(l1, blk, lds, wave_s);
                convert_matrix<1>(inp(8) + (size_t)l1 * D * INDIM, INDIM, 1024, ZLD, (bf16_t*)WSP(WS_WIN), scr, lane, gw, NGW, base);
                if (blk >= 32 && blk < 40) convert_small(inp(8) + (size_t)l1 * D * INDIM, (bf16_t*)WSP(WS_WSM), blk - 32, tid);
                norm_rows<true, true>((const bf16_t*)WSP(WS_H), D, (const float*)inp_out(), inp(7) + l * D, modl, 5120, inp_out(), inp(4) + l1 * D, modl + 8 * 6144, 0, 1024,
                                      (bf16_t*)WSP(WS_H), gw, NGW, lane);
                GRID_BAR();
            } else {
                norm_rows<true, false>((const bf16_t*)WSP(WS_H), D, (const float*)inp_out(), inp(7) + l * D, modl, 5120, inp_out(), nullptr, nullptr, 0, 0, nullptr, gw, NGW, lane);
            }
        }
    }
}

extern "C" void kernel_launch(void* const* d_in, const int* in_sizes, int n_in, void* d_out, int out_size, void* d_ws, size_t ws_size, hipStream_t stream) {
    static int grid = 0;
    if (grid == 0) {
        if (n_in != 33 || ws_size < WS_END || out_size != M * D) { fprintf(stderr, "kernel_launch: unexpected n_in %d / ws %zu / out %d\n", n_in, ws_size, out_size); grid = -1; return; }
        int dev = 0, cus = 0, per_cu = 0;
        if (hipGetDevice(&dev) != hipSuccess || hipDeviceGetAttribute(&cus, hipDeviceAttributeMultiprocessorCount, dev) != hipSuccess) { grid = -1; return; }
        if (hipFuncSetAttribute((const void*)mega_fwd, hipFuncAttributeMaxDynamicSharedMemorySize, LDS_BYTES) != hipSuccess) { fprintf(stderr, "kernel_launch: hipFuncSetAttribute failed\n"); grid = -1; return; }
        if (hipOccupancyMaxActiveBlocksPerMultiprocessor(&per_cu, (const void*)mega_fwd, NWAVES * 64, LDS_BYTES) != hipSuccess || per_cu < 1) { fprintf(stderr, "kernel_launch: occupancy query says %d blocks/CU\n", per_cu); grid = -1; return; }
        (void)hipGetLastError();
        grid = cus;
    }
    if (grid < 0) return;
    (void)hipMemsetAsync((char*)d_ws + WS_CTL, 0, CTL_ZERO_BYTES, stream);
    Args a{};
    for (int i = 0; i < 33; ++i) a.in[i] = (const float*)d_in[i];
    a.out = (float*)d_out; a.ws = (unsigned char*)d_ws;
    hipLaunchKernelGGL(mega_fwd, dim3(grid), dim3(NWAVES * 64), LDS_BYTES, stream, a);
}
```

```cpp
#include <hip/hip_runtime.h>
#include <cstdint>
#include <cstdio>

#define LAS __attribute__((address_space(3)))
#define GAS __attribute__((address_space(1)))
typedef unsigned short bf16_t;
typedef short bf16x8 __attribute__((ext_vector_type(8)));
typedef float f32x4 __attribute__((ext_vector_type(4)));
typedef float f32x2 __attribute__((ext_vector_type(2)));
typedef unsigned u32x4 __attribute__((ext_vector_type(4)));
typedef unsigned u32x2 __attribute__((ext_vector_type(2)));

constexpr int NB = 8, T = 4096, D = 1024, M = NB * T, DEPTH = 2;
constexpr int INDIM = 6680, ZLD = 6656, FF = 2816;
constexpr int GQ = 0, GK = 256, GV = 512, GR = 1024, MQ = 1536, MK = 1792, MV = 2048, MO = 2560, SU = 3072, ZG = 3584;
constexpr int YGLA = GR;
constexpr int YML = MO;
constexpr int YS2 = 0;
constexpr int MRG = 1536;
constexpr int EXC = ZG;
constexpr int YPC = ZG + 256;
constexpr int NMIX = 3584;
constexpr size_t MiB = 1u << 20;
constexpr size_t WS_CTL = 0, CTL_ZERO_BYTES = 64 * 1024;
constexpr size_t WS_MOD = 512 * 1024;
constexpr size_t WS_ZS = 1 * MiB;
constexpr size_t WS_WIN = 5 * MiB;
constexpr size_t WS_WFI = 5 * MiB;
constexpr size_t WS_S5M1 = 18 * MiB;
constexpr size_t WS_S5M3 = 24 * MiB;
constexpr size_t WS_WGLU = 18 * MiB;
constexpr size_t WS_WPROJ = 18 * MiB + 512 * 1024;
constexpr size_t WS_WOUT = 21 * MiB + 512 * 1024;
constexpr size_t WS_WFO = 23 * MiB + 512 * 1024;
constexpr size_t WS_A16 = 31 * MiB + 512 * 1024;
constexpr size_t WS_WSM = 29 * MiB;
constexpr size_t WS_H = 32 * MiB;
constexpr size_t WS_Z = 96 * MiB;
constexpr size_t WS_XB = WS_Z + 200 * MiB;
constexpr size_t WS_END = 512 * MiB;
constexpr int CW_BAR = 4096;
constexpr int CW_S5DONE = 6144;
constexpr int CW_PANEL = 8192;
constexpr size_t WS_SLOT = 29 * MiB + 64 * 1024;
constexpr int XZ = 0, HIDC = 1024;

constexpr int RING_BYTES = 131072, LDSCTL_OFF = RING_BYTES, MISC_OFF = LDSCTL_OFF + 320, LDS_BYTES = 163840;
constexpr int LT_OFF = RING_BYTES + 512;
constexpr int NWAVES = 8;

__device__ __forceinline__ float bf2f(bf16_t v) { return __uint_as_float(((unsigned)v) << 16); }
__device__ __forceinline__ unsigned f2bf(float f) { unsigned u = __float_as_uint(f); return (u + 0x7fffu + ((u >> 16) & 1u)) >> 16; }
__device__ __forceinline__ unsigned pk2(float lo, float hi) { return f2bf(lo) | (f2bf(hi) << 16); }
__device__ __forceinline__ float bflo(unsigned u) { return __uint_as_float(u << 16); }
__device__ __forceinline__ float bfhi(unsigned u) { return __uint_as_float(u & 0xffff0000u); }
__device__ __forceinline__ int hw_lane() { int l; asm volatile("v_mbcnt_lo_u32_b32 %0, -1, 0\n\tv_mbcnt_hi_u32_b32 %0, -1, %0" : "=v"(l)); return l; }
__device__ __forceinline__ int hw_tid(int wv) { return wv * 64 + hw_lane(); }
__device__ __forceinline__ float shl(float v, int src) { return __int_as_float(__builtin_amdgcn_ds_bpermute(src << 2, __float_as_int(v))); }
__device__ __forceinline__ float wave_sum(float v, int lane) {
#pragma unroll
    for (int o = 1; o < 64; o <<= 1) v += shl(v, lane ^ o);
    return v;
}
__device__ __forceinline__ float sigmoidf_(float x) { return 1.f / (1.f + expf(-x)); }
__device__ __forceinline__ float siluf_(float x) { return x / (1.f + expf(-x)); }
__device__ __forceinline__ float logsigmoidf_(float x) { return fminf(x, 0.f) - log1pf(expf(-fabsf(x))); }
__device__ __forceinline__ float gelu_tanh(float y) { return 0.5f * y * (1.f + tanhf(0.7978845608028654f * (y + 0.044715f * y * y * y))); }
__device__ __forceinline__ float fexp_neg(float x) { return __builtin_amdgcn_exp2f(-1.4426950408889634f * x); }
__device__ __forceinline__ float fsigmoid(float x) { return __builtin_amdgcn_rcpf(1.f + fexp_neg(x)); }
#define LDS_WAIT() asm volatile("s_waitcnt lgkmcnt(0)" ::: "memory")
#define VM_WAIT() asm volatile("s_waitcnt vmcnt(0)" ::: "memory")

struct Args { const float* in[33]; float* out; unsigned char* ws; };
__device__ __forceinline__ const float* inp(int i) {
    unsigned off = (unsigned)i * 8u; asm volatile("" : "+s"(off));
    typedef const float* cfp;
    return *(const __attribute__((address_space(4))) cfp*)((const __attribute__((address_space(4))) char*)__builtin_amdgcn_kernarg_segment_ptr() + off);
}

#define WSP(off) (inp_ws() + (off))
__device__ __forceinline__ unsigned char* inp_ws() { return (unsigned char*)inp(34); }
__device__ __forceinline__ float* inp_out() { return (float*)inp(33); }
constexpr size_t DU_WFI = 0, DU_WIN1 = 11u << 20, DU_S5M1 = 24u << 20, DU_S5M3 = 30u << 20, DU_WSM1 = 34u << 20;
__device__ __forceinline__ unsigned char* DUP(size_t off) { return (unsigned char*)inp_out() + (64u << 20) + off; }
__device__ __forceinline__ bf16_t* wp_win(int l) { return (bf16_t*)(l == 0 ? WSP(5u << 20) : DUP(DU_WIN1)); }
__device__ __forceinline__ bf16_t* wp_s5m1(int l) { return (bf16_t*)(l == 0 ? WSP(18u << 20) : DUP(DU_S5M1)); }
__device__ __forceinline__ bf16_t* wp_s5m3(int l) { return (bf16_t*)(l == 0 ? WSP(24u << 20) : DUP(DU_S5M3)); }
__device__ __forceinline__ bf16_t* wp_wsm(int l) { return (bf16_t*)(l == 0 ? WSP(29u << 20) : DUP(DU_WSM1)); }

namespace pg8 {
constexpr int BM = 256, BK = 64, HALF = 128, HTB = HALF * BK * 2, STAGE_BYTES = 8 * HTB, NXCD = 8, WGM = 8;
__host__ __device__ __forceinline__ int lds_byte(int r, int c) { const int st = (r >> 4) * 2 + (c >> 5), rr = r & 15, cc = c & 31, ob = rr * 64 + cc * 2; return st * 1024 + (ob ^ (((ob >> 9) & 1) << 5)); }
__host__ __device__ __forceinline__ void stage_rc(int b, int& R, int& C) { const int st = b / 1024, sb = b % 1024, swz = sb ^ (((sb >> 9) & 1) << 5); R = (st >> 1) * 16 + swz / 64; C = (st & 1) * 32 + (swz % 64) / 2; }
__host__ __device__ __forceinline__ int perm32(int rho) { const int n = rho >> 4, i = rho & 15; return 8 * (i >> 2) + 4 * n + (i & 3); }

struct Unit { int pm, pn, br; };
struct TileOrder {
    int nM, nN, nwg, G, c, nx;
    __device__ void init(int M_, int N_, int G_, int c_, int nx_ = NXCD) { nM = M_ / BM; nN = N_ / BM; nwg = nM * nN; G = G_; c = c_; nx = nx_; }
    __device__ bool tile(int i, int& pm, int& pn) const {
        const long L = (long)i * G + c; if (L >= nwg) return false;
        int wgid = (int)L; { const int q = nwg / nx, r = nwg % nx, xcd = wgid % nx, off = wgid / nx; wgid = (xcd < r ? xcd * (q + 1) : r * (q + 1) + (xcd - r) * q) + off; }
        const int nig = WGM * nN, gid = wgid / nig, fm = gid * WGM, gsz = (nM - fm) < WGM ? (nM - fm) : WGM;
        pm = fm + ((wgid % nig) % gsz); pn = (wgid % nig) / gsz; return true;
    }
};
struct PlainSched {
    TileOrder o; const bf16_t* A; int lda; const bf16_t* Bt; int K;
    __device__ bool next(int i, Unit& u) const { u.br = 0; return o.tile(i, u.pm, u.pn); }
    __device__ const char* Ap(const Unit& u) const { return (const char*)(A + (size_t)u.pm * BM * lda); }
    __device__ const char* Bp(const Unit& u) const { return (const char*)(Bt + (size_t)u.pn * BM * K); }
};
struct MergeSched {
    TileOrder o; const bf16_t* Zb; const bf16_t* Wp;
    __device__ bool next(int i, Unit& u) const { u.br = i % 3; return o.tile(i / 3, u.pm, u.pn); }
    __device__ const char* Ap(const Unit& u) const { const int col = u.br == 0 ? YGLA : (u.br == 1 ? YML : YS2); return (const char*)(Zb + (size_t)u.pm * BM * ZLD + col); }
    __device__ const char* Bp(const Unit& u) const { return (const char*)(Wp + (size_t)u.br * 1024 * 512 + (size_t)u.pn * BM * 512); }
};

__device__ __forceinline__ unsigned cvt_pk_bf16(float lo, float hi) { unsigned r; asm volatile("v_cvt_pk_bf16_f32 %0, %1, %2" : "=v"(r) : "v"(lo), "v"(hi)); return r; }

__device__ __forceinline__ void ring_stage_piece3(LAS unsigned char* ring, const bf16_t* xb, int ldx, int wid, int lane) {
#pragma unroll
    for (int i = 0; i < 2; ++i) {
        const int b = 3 * 16 + wid + 8 * i, r = 2 * b + (lane >> 5), cs = (lane & 31) ^ (r & 15);
        __builtin_amdgcn_global_load_lds((const unsigned*)(xb + (size_t)r * ldx + cs * 8), (LAS unsigned*)(ring + b * 1024), 16, 0, 0);
    }
}
__device__ __forceinline__ u32x4 ring_read(const LAS unsigned char* ring, int rt, int chunk) { return *(const LAS u32x4*)(ring + rt * 512 + ((chunk * 16) ^ ((rt & 15) * 16))); }
struct EpiStore {
    static constexpr bool PERM = true; static constexpr bool LDS_EPI = false;
    bf16_t* O; int ldc;
    int stagger = 0;
    int actmap = 0;
    int stagger_unused_ = 0;
    const float* gbias = nullptr;
    unsigned* waitp = nullptr; unsigned waitn = 0;
    __device__ __forceinline__ bool keep(const Unit&) const { return false; }
    __device__ __forceinline__ void operator()(f32x4 (&acc)[2][2][4][2], const Unit& u, int wr, int wc, int fr, int fq, LAS unsigned char* lds_) const {
        const int row0 = u.pm * BM + wr * 64 + fr, col0 = u.pn * BM + wc * 32 + 8 * fq;
        if (waitp) {
            unsigned spins = 0; while ((unsigned)__builtin_amdgcn_readfirstlane(__hip_atomic_load(waitp, __ATOMIC_RELAXED, __HIP_MEMORY_SCOPE_AGENT)) < waitn) { __builtin_amdgcn_s_sleep(8); if (++spins > (1u << 22)) break; }
        }
        const int am = actmap == 1 ? ((u.pn == GR / 256 || u.pn == GR / 256 + 1) ? 1 : ((u.pn == MO / 256 || u.pn == MO / 256 + 1) ? 2 : 0)) : 0;
#pragma unroll
        for (int ai = 0; ai < 2; ++ai)
#pragma unroll
            for (int m = 0; m < 4; ++m) { bf16_t* rowp = O + (size_t)(row0 + ai * HALF + m * 16) * ldc + col0;
#pragma unroll
                for (int bj = 0; bj < 2; ++bj) { f32x4 v0 = acc[ai][bj][m][0], v1 = acc[ai][bj][m][1];
                    if (actmap == 2) {
                        const f32x4 b0 = *(const f32x4*)(gbias + col0 + bj * HALF), b1 = *(const f32x4*)(gbias + col0 + bj * HALF + 4);
#pragma unroll
                        for (int e = 0; e < 4; ++e) { v0[e] = fmaxf(fsigmoid(v0[e] + b0[e]), 1e-30f); v1[e] = fmaxf(fsigmoid(v1[e] + b1[e]), 1e-30f); } }
                    if (am) {
#pragma unroll
                        for (int e = 0; e < 4; ++e) { const float s0 = fsigmoid(v0[e]), s1 = fsigmoid(v1[e]); v0[e] = am == 1 ? v0[e] * s0 : s0; v1[e] = am == 1 ? v1[e] * s1 : s1; } }
                    u32x4 w; w.x = cvt_pk_bf16(v0[0], v0[1]); w.y = cvt_pk_bf16(v0[2], v0[3]); w.z = cvt_pk_bf16(v1[0], v1[1]); w.w = cvt_pk_bf16(v1[2], v1[3]);
                    *(u32x4*)(rowp + bj * HALF) = w; } }
    }
};
struct EpiGlu {
    static constexpr bool PERM = true; static constexpr bool LDS_EPI = true;
    bf16_t* O; int ldc; const bf16_t* Asrc; int lda; const float* bias; LAS unsigned char* ring;
    int stagger = 0;
    __device__ __forceinline__ bool keep(const Unit&) const { return false; }
    __device__ __forceinline__ int ldx() const { return lda; }
    __device__ __forceinline__ const bf16_t* xbase(const Unit& u) const { return Asrc + (size_t)(u.pm * BM) * lda + u.pn * BM; }
    __device__ __forceinline__ void operator()(f32x4 (&acc)[2][2][4][2], const Unit& u, int wr, int wc, int fr, int fq, LAS unsigned char* lds_) const {
        const int row0 = u.pm * BM + wr * 64 + fr, col0 = u.pn * BM + wc * 32 + 8 * fq;
        ring_stage_piece3(ring, xbase(u), lda, wr * 4 + wc, fq * 16 + fr);
        f32x4 bv[2][2];
#pragma unroll
        for (int bj = 0; bj < 2; ++bj)
#pragma unroll
            for (int n = 0; n < 2; ++n) bv[bj][n] = *(const f32x4*)(bias + col0 + bj * HALF + 4 * n);
        asm volatile("s_waitcnt vmcnt(0)" ::: "memory"); __builtin_amdgcn_s_barrier(); asm volatile("" ::: "memory");
#pragma unroll
        for (int ai = 0; ai < 2; ++ai)
#pragma unroll
            for (int m = 0; m < 4; ++m) { const int rt = ai * HALF + wr * 64 + m * 16 + fr; const size_t r = (size_t)(row0 + ai * HALF + m * 16);
#pragma unroll
                for (int bj = 0; bj < 2; ++bj) {
                    const u32x4 a = ring_read(ring, rt, wc * 4 + fq + bj * 16);
                    const f32x4 v0 = acc[ai][bj][m][0] + bv[bj][0], v1 = acc[ai][bj][m][1] + bv[bj][1];
                    u32x4 w;
                    w.x = cvt_pk_bf16(bflo(a.x) * fsigmoid(v0[0]), bfhi(a.x) * fsigmoid(v0[1])); w.y = cvt_pk_bf16(bflo(a.y) * fsigmoid(v0[2]), bfhi(a.y) * fsigmoid(v0[3]));
                    w.z = cvt_pk_bf16(bflo(a.z) * fsigmoid(v1[0]), bfhi(a.z) * fsigmoid(v1[1])); w.w = cvt_pk_bf16(bflo(a.w) * fsigmoid(v1[2]), bfhi(a.w) * fsigmoid(v1[3]));
                    *(u32x4*)(O + r * ldc + col0 + bj * HALF) = w; } }
        asm volatile("s_waitcnt lgkmcnt(0)" ::: "memory"); __builtin_amdgcn_s_barrier(); asm volatile("" ::: "memory");
    }
};
struct EpiSwiGlu {
    static constexpr bool PERM = true; static constexpr bool LDS_EPI = false;
    bf16_t* O; int ldc;
    int stagger = 0;
    __device__ __forceinline__ bool keep(const Unit&) const { return false; }
    __device__ __forceinline__ void operator()(f32x4 (&acc)[2][2][4][2], const Unit& u, int wr, int wc, int fr, int fq, LAS unsigned char* lds_) const {
        const int row0 = u.pm * BM + wr * 64 + fr, col0 = u.pn * HALF + wc * 32 + 8 * fq;
#pragma unroll
        for (int ai = 0; ai < 2; ++ai)
#pragma unroll
            for (int m = 0; m < 4; ++m) {
                float o[8];
#pragma unroll
                for (int n = 0; n < 2; ++n)
#pragma unroll
                    for (int e = 0; e < 4; ++e) { const float g = acc[ai][0][m][n][e], up = acc[ai][1][m][n][e]; o[n * 4 + e] = g * fsigmoid(g) * up; }
                u32x4 w; w.x = cvt_pk_bf16(o[0], o[1]); w.y = cvt_pk_bf16(o[2], o[3]); w.z = cvt_pk_bf16(o[4], o[5]); w.w = cvt_pk_bf16(o[6], o[7]);
                *(u32x4*)(O + (size_t)(row0 + ai * HALF + m * 16) * ldc + col0) = w; }
    }
};
struct EpiMerge {
    static constexpr bool PERM = true; static constexpr bool LDS_EPI = false;
    bf16_t* O; int ldc; const bf16_t* Zg; int ldz; const float* bgb;
    int stagger = 0;
    __device__ __forceinline__ bool keep(const Unit& u) const { return u.br < 2; }
    __device__ __forceinline__ void operator()(f32x4 (&acc)[2][2][4][2], const Unit& u, int wr, int wc, int fr, int fq, LAS unsigned char* lds_) const {
        const int row0 = u.pm * BM + wr * 64 + fr, col0 = u.pn * BM + wc * 32 + 8 * fq;
        const int br = u.br, brn = br < 2 ? br + 1 : 2;
#pragma unroll
        for (int bj = 0; bj < 2; ++bj) {
#pragma unroll
            for (int ai = 0; ai < 2; ++ai)
#pragma unroll
                for (int m = 0; m < 4; ++m) { const size_t r = (size_t)(row0 + ai * HALF + m * 16);
                    const u32x4 za = *(const u32x4*)(Zg + r * ldz + br * 1024 + col0 + bj * HALF);
                    const u32x4 zb = *(const u32x4*)(Zg + r * ldz + brn * 1024 + col0 + bj * HALF);
                    const float xa[8] = {bflo(za.x), bfhi(za.x), bflo(za.y), bfhi(za.y), bflo(za.z), bfhi(za.z), bflo(za.w), bfhi(za.w)};
                    const float xb[8] = {bflo(zb.x), bfhi(zb.x), bflo(zb.y), bfhi(zb.y), bflo(zb.z), bfhi(zb.z), bflo(zb.w), bfhi(zb.w)};
                    float f[8];
#pragma unroll
                    for (int e = 0; e < 8; ++e) f[e] = br < 2 ? xa[e] * __builtin_amdgcn_rcpf(xb[e]) : xa[e];
                    f32x4 v0 = acc[ai][bj][m][0], v1 = acc[ai][bj][m][1];
                    v0[0] *= f[0]; v0[1] *= f[1]; v0[2] *= f[2]; v0[3] *= f[3]; v1[0] *= f[4]; v1[1] *= f[5]; v1[2] *= f[6]; v1[3] *= f[7];
                    if (br < 2) { acc[ai][bj][m][0] = v0; acc[ai][bj][m][1] = v1; }
                    else { u32x4 w; w.x = cvt_pk_bf16(v0[0], v0[1]); w.y = cvt_pk_bf16(v0[2], v0[3]); w.z = cvt_pk_bf16(v1[0], v1[1]); w.w = cvt_pk_bf16(v1[2], v1[3]);
                        *(u32x4*)(O + r * ldc + col0 + bj * HALF) = w; } }
        }
    }
};


typedef float f32x2v __attribute__((ext_vector_type(2)));
struct RowStats {
    unsigned long long* slots;
    unsigned* cnt;
    __device__ __forceinline__ void run(const Unit& u, int wid, int lane, LAS unsigned char* lt) const {
        const LAS f32x4* P = (const LAS f32x4*)lt; LAS f32x2v* S = (LAS f32x2v*)(lt + 16384);
        asm volatile("s_waitcnt lgkmcnt(0)" ::: "memory"); __builtin_amdgcn_s_barrier(); asm volatile("" ::: "memory");
        const int row = wid * 32 + (lane & 31);
        if (lane < 32) {
            const f32x4 p = (P[row * 4 + 0] + P[row * 4 + 1]) + (P[row * 4 + 2] + P[row * 4 + 3]);
            unsigned long long* sl = slots + ((size_t)(u.pm * BM + row) * 4 + u.pn) * 2;
            __hip_atomic_store(sl, ((unsigned long long)__float_as_uint(p[1]) << 32) | __float_as_uint(p[0]), __ATOMIC_RELAXED, __HIP_MEMORY_SCOPE_AGENT);
            __hip_atomic_store(sl + 1, ((unsigned long long)__float_as_uint(p[3]) << 32) | __float_as_uint(p[2]), __ATOMIC_RELAXED, __HIP_MEMORY_SCOPE_AGENT);
        }
        asm volatile("s_waitcnt vmcnt(0)" ::: "memory");
        if (lane == 0) __hip_atomic_fetch_add(cnt + 16 * u.pm, 1u, __ATOMIC_RELAXED, __HIP_MEMORY_SCOPE_AGENT);
        if (wid == 0) {
            unsigned spins = 0;
            while ((unsigned)__builtin_amdgcn_readfirstlane(__hip_atomic_load(cnt + 16 * u.pm, __ATOMIC_RELAXED, __HIP_MEMORY_SCOPE_AGENT)) < 32u) { __builtin_amdgcn_s_sleep(1); if (++spins > (1u << 22)) break; }
            __builtin_amdgcn_fence(__ATOMIC_ACQUIRE, "agent");
        }
        asm volatile("s_waitcnt vmcnt(0) lgkmcnt(0)" ::: "memory"); __builtin_amdgcn_s_barrier(); asm volatile("" ::: "memory");
        if (lane < 32) {
            const unsigned long long* sl = slots + (size_t)(u.pm * BM + row) * 8; float s0 = 0.f, s1 = 0.f, s2 = 0.f, s3 = 0.f;
#pragma unroll
            for (int k = 0; k < 4; ++k) { const unsigned long long a = __hip_atomic_load(sl + 2 * k, __ATOMIC_RELAXED, __HIP_MEMORY_SCOPE_AGENT), b = __hip_atomic_load(sl + 2 * k + 1, __ATOMIC_RELAXED, __HIP_MEMORY_SCOPE_AGENT);
                s0 += __uint_as_float((unsigned)a); s1 += __uint_as_float((unsigned)(a >> 32)); s2 += __uint_as_float((unsigned)b); s3 += __uint_as_float((unsigned)(b >> 32)); }
            const float r1 = rsqrtf(s0 * (1.f / 1024.f) + 1e-6f);
            const float r2 = rsqrtf(fmaxf(s1 + r1 * (s2 + s2 + r1 * s3), 0.f) * (1.f / 1024.f) + 1e-6f);
            S[row] = (f32x2v){r1, r2};
        }
        asm volatile("s_waitcnt lgkmcnt(0)" ::: "memory"); __builtin_amdgcn_s_barrier(); asm volatile("" ::: "memory");
    }
};
template <int PHASE, bool FINAL>
struct EpiNorm {
    static constexpr bool PERM = true; static constexpr bool LDS_EPI = true;
    int l; LAS unsigned char* lt;
    int stagger = 0;
    __device__ __forceinline__ bool keep(const Unit&) const { return false; }
    __device__ __forceinline__ const float* modl() const { return (const float*)WSP(WS_MOD) + (size_t)l * 8 * 6144; }
    __device__ __forceinline__ int ldx() const { return PHASE == 0 ? D : ZLD; }
    __device__ __forceinline__ const bf16_t* xbase(const Unit& u) const {
        return PHASE == 0 ? (const bf16_t*)inp_out() + (size_t)(u.pm * BM) * D + u.pn * BM : (const bf16_t*)WSP(WS_Z) + (size_t)(u.pm * BM) * ZLD + XZ + u.pn * BM; }
    __device__ __forceinline__ void operator()(f32x4 (&acc)[2][2][4][2], const Unit& u, int wr, int wc, int fr, int fq, LAS unsigned char* lds_) const {
        const int bofs = (u.pm >> 4) * 6144;
        const int colw = u.pn * BM + wc * 32 + 8 * fq;
        const int lane = fq * 16 + fr, wid = wr * 4 + wc;
        LAS unsigned char* ring = lt - LT_OFF;
        {
            const bf16_t* xb = xbase(u); const int ldx_ = ldx();
#pragma unroll
            for (int i = 0; i < 2; ++i) {
                const int b = 3 * 16 + wid + 8 * i, r = 2 * b + (lane >> 5), cs = (lane & 31) ^ (r & 15);
                __builtin_amdgcn_global_load_lds((const unsigned*)(xb + (size_t)r * ldx_ + cs * 8), (LAS unsigned*)(ring + b * 1024), 16, 0, 0);
            }
        }
        f32x4 c1[2][2];
        { const float* pw = inp(PHASE == 0 ? 5 : 7) + l * D + colw; const float* gt = modl() + (PHASE == 0 ? 2048 : 5120) + bofs + colw;
#pragma unroll
          for (int bj = 0; bj < 2; ++bj)
#pragma unroll
            for (int n = 0; n < 2; ++n) { const f32x4 p = *(const f32x4*)(pw + bj * HALF + 4 * n), g = *(const f32x4*)(gt + bj * HALF + 4 * n); c1[bj][n] = (1.f + g) * p; } }
        asm volatile("s_waitcnt vmcnt(0)" ::: "memory"); __builtin_amdgcn_s_barrier(); asm volatile("" ::: "memory");
        const int xc0 = (wc * 4 + fq) * 16;
        {
            LAS f32x4* P = (LAS f32x4*)lt;
#pragma unroll
            for (int ai = 0; ai < 2; ++ai)
#pragma unroll
                for (int m = 0; m < 4; ++m) {
                    const int rt = ai * HALF + wr * 64 + m * 16 + fr;
                    float s0 = 0.f, s1 = 0.f, s2 = 0.f, s3 = 0.f;
#pragma unroll
                    for (int bj = 0; bj < 2; ++bj) {
                        u32x4 xw = {0u, 0u, 0u, 0u};
                        if (!FINAL) xw = *(const LAS u32x4*)(ring + rt * 512 + ((xc0 + bj * 256) ^ (fr * 16)));
#pragma unroll
                        for (int n = 0; n < 2; ++n) { const f32x4 y = acc[ai][bj][m][n], t = c1[bj][n] * y; acc[ai][bj][m][n] = t;
                            if (!FINAL) { const unsigned q0 = n == 0 ? xw.x : xw.z, q1 = n == 0 ? xw.y : xw.w; const f32x4 x = (f32x4){bflo(q0), bfhi(q0), bflo(q1), bfhi(q1)};
#pragma unroll
                                for (int e = 0; e < 4; ++e) { s0 += y[e] * y[e]; s1 += x[e] * x[e]; s2 += x[e] * t[e]; s3 += t[e] * t[e]; } }
                            else {
#pragma unroll
                                for (int e = 0; e < 4; ++e) s0 += y[e] * y[e]; } }
                    }
                    s0 += shl(s0, lane ^ 16); s0 += shl(s0, lane ^ 32);
                    if (!FINAL) { s1 += shl(s1, lane ^ 16); s1 += shl(s1, lane ^ 32); s2 += shl(s2, lane ^ 16); s2 += shl(s2, lane ^ 32); s3 += shl(s3, lane ^ 16); s3 += shl(s3, lane ^ 32); }
                    if (fq == 0) P[rt * 4 + wc] = (f32x4){s0, s1, s2, s3};
                }
        }
        { RowStats st{(unsigned long long*)WSP(WS_SLOT), (unsigned*)WSP(WS_CTL) + CW_PANEL + (2 * l + PHASE) * 2048}; st.run(u, wid, lane, lt); }
        {
            const LAS f32x2v* S = (const LAS f32x2v*)(lt + 16384);
#pragma unroll
            for (int bj = 0; bj < 2; ++bj) {
                const int col = colw + bj * HALF;
                f32x4 c2[2], hv[2];
                if (!FINAL) {
                    const float* w2 = (PHASE == 0 ? inp(6) + l * D : inp(4) + (l + 1) * D) + col;
                    const float* sc = modl() + (PHASE == 0 ? 4096 : 8 * 6144 + 1024) + bofs + col; const float* sh = modl() + (PHASE == 0 ? 3072 : 8 * 6144) + bofs + col;
#pragma unroll
                    for (int n = 0; n < 2; ++n) { const f32x4 w = *(const f32x4*)(w2 + 4 * n), c = *(const f32x4*)(sc + 4 * n); c2[n] = w * (1.f + c); hv[n] = *(const f32x4*)(sh + 4 * n); }
                }
#pragma unroll
                for (int ai = 0; ai < 2; ++ai)
#pragma unroll
                    for (int m = 0; m < 4; ++m) {
                        const int rt = ai * HALF + wr * 64 + m * 16 + fr; const size_t R = (size_t)(u.pm * BM + rt); const f32x2v r = S[rt];
                        const u32x4 xw = *(const LAS u32x4*)(ring + rt * 512 + ((xc0 + bj * 256) ^ (fr * 16)));
                        const float x[8] = {bflo(xw.x), bfhi(xw.x), bflo(xw.y), bfhi(xw.y), bflo(xw.z), bfhi(xw.z), bflo(xw.w), bfhi(xw.w)};
                        f32x4 v0 = acc[ai][bj][m][0], v1 = acc[ai][bj][m][1];
#pragma unroll
                        for (int e = 0; e < 4; ++e) { v0[e] = x[e] + r.x * v0[e]; v1[e] = x[4 + e] + r.x * v1[e]; }
                        if (FINAL) { float* op = inp_out() + R * D + col; *(f32x4*)op = v0; *(f32x4*)(op + 4) = v1; }
                        else {
                            u32x4 w; w.x = cvt_pk_bf16(v0[0], v0[1]); w.y = cvt_pk_bf16(v0[2], v0[3]); w.z = cvt_pk_bf16(v1[0], v1[1]); w.w = cvt_pk_bf16(v1[2], v1[3]);
                            *(u32x4*)(PHASE == 0 ? (bf16_t*)WSP(WS_Z) + R * ZLD + XZ + col : (bf16_t*)inp_out() + R * D + col) = w;
                            const f32x4 a0 = (f32x4){bflo(w.x), bfhi(w.x), bflo(w.y), bfhi(w.y)}, a1 = (f32x4){bflo(w.z), bfhi(w.z), bflo(w.w), bfhi(w.w)};
                            const f32x4 o0 = a0 * r.y * c2[0] + hv[0], o1 = a1 * r.y * c2[1] + hv[1];
                            u32x4 h; h.x = cvt_pk_bf16(o0[0], o0[1]); h.y = cvt_pk_bf16(o0[2], o0[3]); h.z = cvt_pk_bf16(o1[0], o1[1]); h.w = cvt_pk_bf16(o1[2], o1[3]);
                            *(u32x4*)((bf16_t*)WSP(WS_H) + R * D + col) = h;
                        }
                    }
            }
        }
        asm volatile("s_waitcnt lgkmcnt(0)" ::: "memory"); __builtin_amdgcn_s_barrier(); asm volatile("" ::: "memory");
    }
};

struct S5aSched {
    int G, c; const bf16_t* Zb; const bf16_t* Bt1;
    __device__ bool next(int i, Unit& u) const { const int L = i * G + c; if (L >= 512) return false; u.pn = L < 256 ? 1 : 0; u.br = (L & 255) >> 3; u.pm = L & 7; return true; }
    __device__ const char* Ap(const Unit& u) const { return (const char*)(Zb + (size_t)u.pm * T * ZLD + SU + 16 * u.br); }
    __device__ const char* Bp(const Unit& u) const { return (const char*)(Bt1 + ((size_t)u.br * 384 + (size_t)u.pn * 256) * 256); }
};
struct EpiS5a {
    static constexpr bool PERM = true; static constexpr bool THROTTLE = false; static constexpr bool LDS_EPI = false;
    int l;
    int stagger = 0;
    __device__ __forceinline__ bool keep(const Unit&) const { return false; }
    __device__ __forceinline__ void operator()(f32x4 (&acc)[2][2][4][2], const Unit& u, int wr, int wc, int fr, int fq, LAS unsigned char* lds_) const {
        bf16_t* Zb = (bf16_t*)WSP(WS_Z); LAS unsigned char* ring = lds_;
        const int rowbase = (u.br & 15) * 2048 + u.pm * 256 + wr * 64 + fr, colsub = wc * 32 + 8 * fq, hoff = (u.br >> 4) * 256;
        if (u.pn == 0) {
            asm volatile("s_waitcnt vmcnt(0)" ::: "memory"); __builtin_amdgcn_s_barrier(); asm volatile("" ::: "memory");
#pragma unroll
            for (int ai = 0; ai < 2; ++ai)
#pragma unroll
                for (int m = 0; m < 4; ++m) {
                    const int n = ai * HALF + wr * 64 + m * 16 + fr;
                    LAS unsigned char* rowp = ring + n * 512;
                    *(LAS f32x4*)(rowp + (((colsub >> 2) ^ (n & 15)) * 16)) = acc[ai][0][m][0];
                    *(LAS f32x4*)(rowp + ((((colsub >> 2) + 1) ^ (n & 15)) * 16)) = acc[ai][0][m][1];
                    const f32x4 v0 = acc[ai][1][m][0], v1 = acc[ai][1][m][1];
                    u32x4 w; w.x = cvt_pk_bf16(v0[0], v0[1]); w.y = cvt_pk_bf16(v0[2], v0[3]); w.z = cvt_pk_bf16(v1[0], v1[1]); w.w = cvt_pk_bf16(v1[2], v1[3]);
                    *(u32x4*)(Zb + (size_t)(rowbase + ai * HALF + m * 16) * ZLD + hoff + YPC + colsub) = w;
                    asm volatile("" ::: "memory");
                }
        } else {
#pragma unroll
            for (int ai = 0; ai < 2; ++ai)
#pragma unroll
                for (int m = 0; m < 4; ++m) { bf16_t* zrow = Zb + (size_t)(rowbase + ai * HALF + m * 16) * ZLD + hoff;
                    const f32x4 v0 = acc[ai][0][m][0], v1 = acc[ai][0][m][1];
                    u32x4 w; w.x = cvt_pk_bf16(v0[0], v0[1]); w.y = cvt_pk_bf16(v0[2], v0[3]); w.z = cvt_pk_bf16(v1[0], v1[1]); w.w = cvt_pk_bf16(v1[2], v1[3]);
                    *(u32x4*)(zrow + YPC + 128 + colsub) = w; }
        }
    }
};
struct S5bSched {
    int G, c; const bf16_t* X; const bf16_t* Bt3;
    __device__ bool next(int i, Unit& u) const { const int L = i * G + c; if (L >= 256) return false; u.br = L >> 3; u.pm = L & 7; u.pn = 0; return true; }
    __device__ const char* Ap(const Unit& u) const { return (const char*)(X + (size_t)((u.br & 15) * 2048 + u.pm * 256) * ZLD + EXC + (u.br >> 4) * 128); }
    __device__ const char* Bp(const Unit& u) const { return (const char*)(Bt3 + (size_t)u.br * 256 * 128); }
};
struct EpiS5b {
    static constexpr bool PERM = true; static constexpr bool LDS_EPI = true;
    bf16_t* Zb; const float* dsk; LAS unsigned char* ring;
    int stagger = 0;
    __device__ __forceinline__ bool keep(const Unit&) const { return false; }
    __device__ __forceinline__ int ldx() const { return ZLD; }
    __device__ __forceinline__ const bf16_t* xbase(const Unit& u) const { return Zb + (size_t)((u.br & 15) * 2048 + u.pm * 256) * ZLD + YPC + (u.br >> 4) * 256; }
    __device__ __forceinline__ void operator()(f32x4 (&acc)[2][2][4][2], const Unit& u, int wr, int wc, int fr, int fq, LAS unsigned char* lds_) const {
        const int g = u.br, b = u.pm;
        ring_stage_piece3(ring, xbase(u), ZLD, wr * 4 + wc, fq * 16 + fr);
        asm volatile("s_waitcnt vmcnt(0)" ::: "memory"); __builtin_amdgcn_s_barrier(); asm volatile("" ::: "memory");
#pragma unroll
        for (int bj = 0; bj < 2; ++bj) {
            const int j0 = bj * HALF + wc * 32 + 8 * fq, s = j0 >> 4, c0 = j0 & 15;
            const f32x4 d0 = *(const f32x4*)(dsk + 16 * g + c0), d1 = *(const f32x4*)(dsk + 16 * g + c0 + 4);
#pragma unroll
            for (int ai = 0; ai < 2; ++ai)
#pragma unroll
                for (int m = 0; m < 4; ++m) {
                    const int n = ai * HALF + wr * 64 + m * 16 + fr;
                    const u32x4 yp = ring_read(ring, n, wc * 4 + fq + bj * 16);
                    bf16_t* zp = Zb + ((size_t)b * T + 16 * n + s) * ZLD + SU + 16 * g + c0;
                    const u32x4 uu = *(const u32x4*)zp;
                    const f32x4 a0 = acc[ai][bj][m][0], a1 = acc[ai][bj][m][1];
                    float y[8];
                    y[0] = a0[0] + bflo(yp.x) + d0[0] * bflo(uu.x); y[1] = a0[1] + bfhi(yp.x) + d0[1] * bfhi(uu.x);
                    y[2] = a0[2] + bflo(yp.y) + d0[2] * bflo(uu.y); y[3] = a0[3] + bfhi(yp.y) + d0[3] * bfhi(uu.y);
                    y[4] = a1[0] + bflo(yp.z) + d1[0] * bflo(uu.z); y[5] = a1[1] + bfhi(yp.z) + d1[1] * bfhi(uu.z);
                    y[6] = a1[2] + bflo(yp.w) + d1[2] * bflo(uu.w); y[7] = a1[3] + bfhi(yp.w) + d1[3] * bfhi(uu.w);
#pragma unroll
                    for (int e = 0; e < 8; ++e) { const float v = y[e]; y[e] = v * fsigmoid(1.5957691216057308f * (v + 0.044715f * v * v * v)); }
                    u32x4 w; w.x = cvt_pk_bf16(y[0], y[1]); w.y = cvt_pk_bf16(y[2], y[3]); w.z = cvt_pk_bf16(y[4], y[5]); w.w = cvt_pk_bf16(y[6], y[7]);
                    *(u32x4*)zp = w;
                    if ((m & 3) == 3) asm volatile("" ::: "memory");
                }
        }
        asm volatile("s_waitcnt lgkmcnt(0)" ::: "memory"); __builtin_amdgcn_s_barrier(); asm volatile("" ::: "memory");
    }
};
template <class Epi> __device__ __forceinline__ int epi_ldx(const Epi& E) { if constexpr (Epi::LDS_EPI) return E.ldx(); else return 0; }
template <class Epi> __device__ __forceinline__ const void* epi_xbase(const Epi& E, const Unit& u) { if constexpr (Epi::LDS_EPI) return E.xbase(u); else return nullptr; }
template <class Epi, class Sched, bool ALIGN_EPI, bool SP2, int AMODE = 0>
__device__ __forceinline__ void gemm_phase(LAS unsigned char* lds, const int wv, const int lda, const int K, const Sched& S, const Epi& E) {
    int tid_ = hw_tid(wv); asm volatile("" : "+v"(tid_));
    const int tid = tid_, wid = __builtin_amdgcn_readfirstlane(tid >> 6), lane = tid & 63, wr = wid >> 2, wc = wid & 3, fr = lane & 15, fq = lane >> 4;
    const int nt = K / BK;
    unsigned voffA[2], voffB[2];
#pragma unroll
    for (int i = 0; i < 2; ++i) { int R, C; stage_rc(tid * 16 + i * 8192, R, C); const int Rb = Epi::PERM ? ((R & ~31) + perm32(R & 31)) : R;
        voffA[i] = AMODE == 0 ? (unsigned)(R * lda + C) * 2u : (unsigned)((16 * R + (C >> 4)) * ZLD + (C & 15)) * 2u; voffB[i] = (unsigned)(Rb * K + C) * 2u; }
    const size_t kstep = (size_t)(BK * 2);
    const size_t kstepA = AMODE == 0 ? (size_t)(BK * 2) : (size_t)4 * ZLD * 2;
    const size_t hA = AMODE == 0 ? (size_t)HALF * lda * 2 : (size_t)HALF * 16 * ZLD * 2, hB = (size_t)HALF * K * 2;
    const unsigned ldsw = (unsigned)wid * 1024u;
    const int aoff = lds_byte(wr * 64 + fr, fq * 8), boff = lds_byte(wc * 32 + fr, fq * 8);
#define PG8_SA(b, h) (((b) * 2 + (h)) * HTB)
#define PG8_SB(b, h) ((4 + (b) * 2 + (h)) * HTB)
#define PG8_STAGE(bufoff, gbase, voff) do { _Pragma("unroll") for (int _i = 0; _i < 2; ++_i) \
        __builtin_amdgcn_global_load_lds((const unsigned*)((const char*)(gbase) + (voff)[_i]), (LAS unsigned*)(lds + (bufoff) + ldsw + _i * 8192), 16, 0, 0); } while (0)
#define PG8_STAGE_N(bufoff, gbase, voff) do { if (Epi::LDS_EPI && last) { \
        const int s_ = (bufoff) / HTB; const int ln_ = hw_lane(); const int ldx_ = epi_ldx(E); const char* xb_ = (const char*)epi_xbase(E, cur) + (size_t)(32 * s_) * ldx_ * 2; \
        _Pragma("unroll") for (int _i = 0; _i < 2; ++_i) { const int rl_ = 2 * (wid + 8 * _i) + (ln_ >> 5); const unsigned vo_ = (unsigned)(rl_ * ldx_ + (((ln_ & 31) ^ (rl_ & 15)) * 8)) * 2u; \
            __builtin_amdgcn_global_load_lds((const unsigned*)(xb_ + vo_), (LAS unsigned*)(lds + (bufoff) + ldsw + _i * 8192), 16, 0, 0); } \
    } else PG8_STAGE(bufoff, gbase, voff); } while (0)
#define PG8_LDA(dst, b, h) do { _Pragma("unroll") for (int m = 0; m < 4; ++m) _Pragma("unroll") for (int k = 0; k < 2; ++k) dst[m][k] = *(const LAS bf16x8*)(lds + PG8_SA(b, h) + aoff + m * 2048 + k * 1024); } while (0)
#define PG8_LDB(dst, b, h) do { _Pragma("unroll") for (int n = 0; n < 2; ++n) _Pragma("unroll") for (int k = 0; k < 2; ++k) dst[n][k] = *(const LAS bf16x8*)(lds + PG8_SB(b, h) + boff + n * 2048 + k * 1024); } while (0)
#define PG8_MMA(ai, bj, At, Bt) do { __builtin_amdgcn_s_setprio(1); _Pragma("unroll") for (int m = 0; m < 4; ++m) _Pragma("unroll") for (int n = 0; n < 2; ++n) _Pragma("unroll") for (int k = 0; k < 2; ++k) \
        acc[ai][bj][m][n] = __builtin_amdgcn_mfma_f32_16x16x32_bf16(Bt[n][k], At[m][k], acc[ai][bj][m][n], 0, 0, 0); __builtin_amdgcn_s_setprio(0); } while (0)
#define PG8_WAIT_V(n) asm volatile("s_waitcnt vmcnt(" #n ")" ::: "memory")
#define PG8_WAIT_L(n) asm volatile("s_waitcnt lgkmcnt(" #n ")" ::: "memory")
#define PG8_BAR __builtin_amdgcn_s_barrier()
#define PG8_SCHED __builtin_amdgcn_sched_barrier(0)
    Unit cur, nxt; int ui = 0;
    if (!S.next(0, cur)) return;
    if (E.stagger > 0) {
        const unsigned long long t0 = __builtin_amdgcn_s_memrealtime(), tgt = t0 + (unsigned long long)(((blockIdx.x >> 3) & 3) * E.stagger);
        while (__builtin_amdgcn_s_memrealtime() < tgt) __builtin_amdgcn_s_sleep(8);
    }
    f32x4 acc[2][2][4][2];
#pragma unroll
    for (int a = 0; a < 2; ++a)
#pragma unroll
        for (int b = 0; b < 2; ++b)
#pragma unroll
            for (int m = 0; m < 4; ++m)
#pragma unroll
                for (int n = 0; n < 2; ++n) acc[a][b][m][n] = (f32x4){0.f, 0.f, 0.f, 0.f};
    bf16x8 At[4][2], B0[2][2], B1[2][2];
    const char* cA = S.Ap(cur); const char* cB = S.Bp(cur);
#define PG8_PROLOGUE() do { \
    if constexpr (SP2) { \
        PG8_STAGE(PG8_SB(0, 0), cB, voffB); PG8_STAGE(PG8_SB(0, 1), cB + hB, voffB); PG8_STAGE(PG8_SA(0, 0), cA, voffA); PG8_STAGE(PG8_SA(0, 1), cA + hA, voffA); \
        if (wr == 1) PG8_BAR; \
        PG8_WAIT_V(2); PG8_BAR; \
        PG8_STAGE(PG8_SB(1, 0), cB + kstep, voffB); PG8_STAGE(PG8_SA(1, 0), cA + kstepA, voffA); PG8_STAGE(PG8_SB(1, 1), cB + hB + kstep, voffB); \
        PG8_WAIT_V(6); PG8_BAR; \
    } else { \
        PG8_STAGE(PG8_SB(0, 0), cB, voffB); PG8_STAGE(PG8_SA(0, 0), cA, voffA); PG8_STAGE(PG8_SB(0, 1), cB + hB, voffB); PG8_STAGE(PG8_SA(0, 1), cA + hA, voffA); \
        if (wr == 1) PG8_BAR; \
        PG8_WAIT_V(4); PG8_BAR; \
        PG8_STAGE(PG8_SB(1, 0), cB + kstep, voffB); PG8_STAGE(PG8_SA(1, 0), cA + kstepA, voffA); PG8_STAGE(PG8_SB(1, 1), cB + hB + kstep, voffB); \
        PG8_WAIT_V(6); PG8_BAR; \
    } } while (0)
    PG8_PROLOGUE();
    for (;;) {
        const bool has_next = S.next(ui + 1, nxt);
        const char* nA = has_next ? S.Ap(nxt) : cA; const char* nB = has_next ? S.Bp(nxt) : cB;
        for (int t = 0; t < nt; t += 2) {
            const bool last = (t == nt - 2);
            const char* a1 = cA + (size_t)(t + 1) * kstepA;
            const char* a2 = last ? nA : cA + (size_t)(t + 2) * kstepA; const char* b2 = last ? nB : cB + (size_t)(t + 2) * kstep;
            const char* a3 = a2 + kstepA; const char* b3 = b2 + kstep;
            if constexpr (SP2) {
            PG8_LDB(B0, 0, 0); PG8_LDB(B1, 0, 1); PG8_SCHED; PG8_LDA(At, 0, 0); PG8_STAGE(PG8_SA(1, 1), a1 + hA, voffA);
            PG8_WAIT_V(8); PG8_WAIT_L(0); PG8_BAR; PG8_MMA(0, 0, At, B0); PG8_MMA(0, 1, At, B1); PG8_BAR; PG8_SCHED;
            PG8_LDA(At, 0, 1); PG8_STAGE_N(PG8_SB(0, 0), b2, voffB); PG8_STAGE_N(PG8_SB(0, 1), b2 + hB, voffB); PG8_STAGE_N(PG8_SA(0, 0), a2, voffA);
            PG8_WAIT_V(8); PG8_WAIT_L(0); PG8_BAR; PG8_MMA(1, 0, At, B0); PG8_MMA(1, 1, At, B1); PG8_BAR; PG8_SCHED;
            PG8_LDB(B0, 1, 0); PG8_LDB(B1, 1, 1); PG8_SCHED; PG8_LDA(At, 1, 0); PG8_STAGE_N(PG8_SA(0, 1), a2 + hA, voffA);
            PG8_WAIT_V(8); PG8_WAIT_L(0); PG8_BAR; PG8_MMA(0, 0, At, B0); PG8_MMA(0, 1, At, B1); PG8_BAR; PG8_SCHED;
            PG8_LDA(At, 1, 1); PG8_STAGE_N(PG8_SB(1, 0), b3, voffB); PG8_STAGE_N(PG8_SB(1, 1), b3 + hB, voffB); PG8_STAGE_N(PG8_SA(1, 0), a3, voffA);
            PG8_WAIT_V(8); PG8_WAIT_L(0); PG8_BAR; PG8_MMA(1, 0, At, B0); PG8_MMA(1, 1, At, B1); PG8_BAR; PG8_SCHED;
            } else {
            PG8_LDB(B0, 0, 0); PG8_SCHED; PG8_LDA(At, 0, 0); PG8_STAGE(PG8_SA(1, 1), a1 + hA, voffA);
            PG8_WAIT_L(8); PG8_BAR; PG8_WAIT_L(0); PG8_MMA(0, 0, At, B0); PG8_BAR; PG8_SCHED;
            PG8_LDB(B1, 0, 1); PG8_STAGE(PG8_SB(0, 0), b2, voffB);
            PG8_BAR; PG8_WAIT_L(0); PG8_MMA(0, 1, At, B1); PG8_BAR;
            PG8_LDA(At, 0, 1); PG8_STAGE(PG8_SA(0, 0), a2, voffA);
            PG8_BAR; PG8_WAIT_L(0); PG8_MMA(1, 0, At, B0); PG8_BAR; PG8_SCHED;
            PG8_STAGE(PG8_SB(0, 1), b2 + hB, voffB);
            PG8_WAIT_V(6); PG8_BAR; PG8_MMA(1, 1, At, B1); PG8_BAR;
            PG8_LDB(B0, 1, 0); PG8_SCHED; PG8_LDA(At, 1, 0); PG8_STAGE(PG8_SA(0, 1), a2 + hA, voffA);
            PG8_WAIT_L(8); PG8_BAR; PG8_WAIT_L(0); PG8_MMA(0, 0, At, B0); PG8_BAR; PG8_SCHED;
            PG8_LDB(B1, 1, 1); PG8_STAGE(PG8_SB(1, 0), b3, voffB);
            PG8_BAR; PG8_WAIT_L(0); PG8_MMA(0, 1, At, B1); PG8_BAR;
            PG8_LDA(At, 1, 1); PG8_STAGE(PG8_SA(1, 0), a3, voffA);
            PG8_BAR; PG8_WAIT_L(0); PG8_MMA(1, 0, At, B0); PG8_BAR; PG8_SCHED;
            PG8_STAGE(PG8_SB(1, 1), b3 + hB, voffB);
            PG8_WAIT_V(6); PG8_BAR; PG8_MMA(1, 1, At, B1); PG8_BAR;
            }
        }
        if constexpr (ALIGN_EPI) { if (wr == 0) PG8_BAR; }
        { const int lane_e = hw_lane();
          E(acc, cur, wr, wc, lane_e & 15, lane_e >> 4, lds); }
        if (!has_next) break;
        if (!E.keep(cur)) {
#pragma unroll
        for (int a = 0; a < 2; ++a)
#pragma unroll
            for (int b = 0; b < 2; ++b)
#pragma unroll
                for (int m = 0; m < 4; ++m)
#pragma unroll
                    for (int n = 0; n < 2; ++n) acc[a][b][m][n] = (f32x4){0.f, 0.f, 0.f, 0.f};
        }
        cur = nxt; cA = nA; cB = nB; ++ui;
        if constexpr (Epi::LDS_EPI) { PG8_PROLOGUE(); }
        else if constexpr (ALIGN_EPI) { if (wr == 1) PG8_BAR; }
    }
    PG8_WAIT_V(0);
    if constexpr (!ALIGN_EPI) { if (wr == 0) PG8_BAR; }
    PG8_BAR;
#undef PG8_PROLOGUE
#undef PG8_STAGE_N
#undef PG8_SA
#undef PG8_SB
#undef PG8_STAGE
#undef PG8_LDA
#undef PG8_LDB
#undef PG8_MMA
#undef PG8_WAIT_V
#undef PG8_WAIT_L
#undef PG8_BAR
#undef PG8_SCHED
}
}

#define XB_TMO      128
#define XB_XCNT(j)  (256  + 64 * (j))
#define XB_XSUB(j)  (1280 + 64 * (j))
#define XB_XGEN(j)  (2304 + 64 * (j))
#define XB_TOP      3328
#define XB_TOPGEN   3392
#define XCD_BAR_WORDS 3456
#define XB_SPIN_CAP (1u << 18)
__device__ __forceinline__ unsigned xb_ld(unsigned* p)              { return __hip_atomic_load(p, __ATOMIC_RELAXED, __HIP_MEMORY_SCOPE_AGENT); }
__device__ __forceinline__ unsigned xb_add(unsigned* p, unsigned v) { return __hip_atomic_fetch_add(p, v, __ATOMIC_RELAXED, __HIP_MEMORY_SCOPE_AGENT); }
__device__ __forceinline__ unsigned xb_xcc_id() { return (unsigned)__builtin_amdgcn_s_getreg((3 << 11) | 20) & 0xFu; }
#define XB_SPIN(cond, bar) do { unsigned _sp = 0; while (cond) { __builtin_amdgcn_s_sleep(1); \
    if ((++_sp & 255u) == 0u) { if (xb_ld(&(bar)[XB_TMO])) break; if (_sp > XB_SPIN_CAP) { atomicAdd(&(bar)[XB_TMO], 1u); break; } } } } while (0)
struct XcdBarrier { unsigned* bar; unsigned x; volatile LAS unsigned* st; };
__device__ __forceinline__ XcdBarrier xcd_barrier_post(unsigned* bar, volatile LAS unsigned* st) {
    XcdBarrier b; b.bar = bar; b.x = xb_xcc_id(); b.st = st;
    if (threadIdx.x == 0) (void)xb_add(&bar[XB_XCNT(b.x)], 1u);
    return b;
}
__device__ __forceinline__ void xcd_barrier_complete(unsigned* bar, unsigned x, unsigned& nloc, unsigned& nx) {
    const unsigned G = gridDim.x * gridDim.y * gridDim.z;
    unsigned sum, cnt, mine, sp = 0u;
    for (;;) {
        sum = 0u; cnt = 0u; mine = 0u;
#pragma unroll
        for (unsigned j = 0; j < 16; ++j) { const unsigned c = xb_ld(&bar[XB_XCNT(j)]); sum += c; cnt += (c > 0u) ? 1u : 0u; mine = (j == x) ? c : mine; }
        if (sum == G) break;
        __builtin_amdgcn_s_sleep(1);
        if ((++sp & 255u) == 0u) { if (xb_ld(&bar[XB_TMO])) break; if (sp > XB_SPIN_CAP) { atomicAdd(&bar[XB_TMO], 1u); break; } }
    }
    nloc = mine > 0u ? mine : 1u; nx = cnt > 0u ? cnt : 1u;
}
__device__ __forceinline__ void xcd_barrier(const XcdBarrier& b, const int wv) {
    asm volatile("s_waitcnt vmcnt(0)" ::: "memory");
    __syncthreads();
    if (wv == 0 && hw_lane() == 0) {
        unsigned* bar = b.bar;
        __builtin_amdgcn_s_waitcnt(0);
        unsigned nloc = b.st[0], nx = b.st[1];
        if (nloc == 0u) { xcd_barrier_complete(bar, b.x, nloc, nx); b.st[0] = nloc; b.st[1] = nx; }
        const unsigned old = xb_add(&bar[XB_XSUB(b.x)], 1u);
        const unsigned gen = old / nloc;
        if (old + 1u == (gen + 1u) * nloc) {
            __builtin_amdgcn_fence(__ATOMIC_RELEASE, "agent");
            asm volatile("s_waitcnt vmcnt(0)" ::: "memory");
            const unsigned og = xb_add(&bar[XB_TOP], 1u);
            const unsigned tg = og / nx;
            if (og + 1u == (tg + 1u) * nx) xb_add(&bar[XB_TOPGEN], 1u);
            else XB_SPIN(xb_ld(&bar[XB_TOPGEN]) == tg, bar);
            __builtin_amdgcn_fence(__ATOMIC_ACQUIRE, "agent");
            xb_add(&bar[XB_XGEN(b.x)], 1u);
            asm volatile("s_waitcnt vmcnt(0)" ::: "memory");
        } else {
            XB_SPIN(xb_ld(&bar[XB_XGEN(b.x)]) == gen, bar);
            __builtin_amdgcn_fence(__ATOMIC_ACQUIRE, "agent");
            asm volatile("s_waitcnt vmcnt(0)" ::: "memory");
        }
    }
    __syncthreads();
}


__device__ __forceinline__ void transpose_item(const float* W, int ldw, int K, bf16_t* WT, int src_n0, int dst_n0, int k0, LAS float* scr, int lane) {
    {
        f32x4 v[8]; const float* wp = W + (size_t)(k0 + (lane >> 3)) * ldw + src_n0 + 4 * (lane & 7);
#pragma unroll
        for (int i = 0; i < 8; ++i) v[i] = *(const f32x4*)(wp + (size_t)(8 * i) * ldw);
        LAS float* sp = scr + (lane >> 3) * 33 + 4 * (lane & 7);
#pragma unroll
        for (int i = 0; i < 8; ++i) { sp[(8 * i) * 33 + 0] = v[i][0]; sp[(8 * i) * 33 + 1] = v[i][1]; sp[(8 * i) * 33 + 2] = v[i][2]; sp[(8 * i) * 33 + 3] = v[i][3]; }
    }
    LDS_WAIT(); asm volatile("" ::: "memory");
    const int c = lane & 7;
#pragma unroll
    for (int j = 0; j < 4; ++j) { const int n = (lane >> 3) + 8 * j; const LAS float* s = scr + (8 * c) * 33 + n;
        u32x4 o; o.x = pk2(s[0 * 33], s[1 * 33]); o.y = pk2(s[2 * 33], s[3 * 33]); o.z = pk2(s[4 * 33], s[5 * 33]); o.w = pk2(s[6 * 33], s[7 * 33]);
        *(u32x4*)(WT + (size_t)(dst_n0 + n) * K + k0 + 8 * c) = o; }
    LDS_WAIT(); asm volatile("" ::: "memory");
}
template <int MAP>
__device__ __forceinline__ void convert_matrix(const float* W, int ldw, int K, int Ndst, bf16_t* WT, LAS float* scr, int lane, int gw, int NGW, int& base) {
    const int nblk = Ndst / 32, nitems = (K / 64) * nblk;
    int first = (gw - base % NGW + NGW) % NGW;
    for (int it = first; it < nitems; it += NGW) {
        const int kb = it / nblk, nb = it % nblk, d0 = nb * 32;
        int s0 = d0;
        if (MAP == 1) s0 = d0 + (d0 < 1024 ? 0 : (d0 < 2560 ? 16 : 24));
        if (MAP == 2) { const int pn = d0 >> 8, hh = (d0 & 255) >> 7, r = d0 & 127; s0 = hh * FF + pn * 128 + r; }
        transpose_item(W, ldw, K, WT, s0, d0, kb * 64, scr, lane);
    }
    base += nitems;
}

__device__ __forceinline__ void ada_phase(LAS unsigned char* lds, int blk, int wave, int lane) {
    if (blk >= 192) return;
    const int l = blk / 96, n0 = (blk % 96) * 64;
    const float* c = inp(1); const float* W = inp(2) + (size_t)l * 1024 * 6144; const float* bias = inp(3) + l * 6144;
    LAS float* cs = (LAS float*)lds;
    LAS float* part = (LAS float*)(lds + 32768);
    for (int i = wave * 64 + lane; i < 8192; i += NWAVES * 64) { const int b = i >> 10, k = i & 1023; cs[k * 8 + b] = siluf_(c[i]); }
    __syncthreads();
    float acc[8] = {0.f, 0.f, 0.f, 0.f, 0.f, 0.f, 0.f, 0.f};
#pragma unroll 1
    for (int k0 = wave * 128; k0 < wave * 128 + 128; k0 += 16) {
        float wv[16];
#pragma unroll
        for (int j = 0; j < 16; ++j) wv[j] = W[(size_t)(k0 + j) * 6144 + n0 + lane];
#pragma unroll
        for (int j = 0; j < 16; ++j) {
            const f32x4 c0 = *(const LAS f32x4*)(cs + (k0 + j) * 8), c1 = *(const LAS f32x4*)(cs + (k0 + j) * 8 + 4);
            acc[0] += c0[0] * wv[j]; acc[1] += c0[1] * wv[j]; acc[2] += c0[2] * wv[j]; acc[3] += c0[3] * wv[j];
            acc[4] += c1[0] * wv[j]; acc[5] += c1[1] * wv[j]; acc[6] += c1[2] * wv[j]; acc[7] += c1[3] * wv[j];
        }
    }
#pragma unroll
    for (int b = 0; b < 8; ++b) part[(wave * 8 + b) * 64 + lane] = acc[b];
    __syncthreads();
    {
        const int b = wave; float s = bias[n0 + lane];
#pragma unroll
        for (int w = 0; w < 8; ++w) s += part[(w * 8 + b) * 64 + lane];
        ((float*)WSP(WS_MOD))[(size_t)(l * 8 + b) * 6144 + n0 + lane] = s;
    }
    __syncthreads();
}

template <bool WITH_POST, bool WITH_PRE, bool XIN_BF16, bool XOUT_BF16>
__device__ __forceinline__ void norm_rows(const bf16_t* Y, int ldy, const void* xin_, const float* pw, const float* modl_post, int gt_off, void* xout_,
                                          const float* w2, const float* modl_pre, int sh_off, int sc_off, bf16_t* H, int gw, int NGW, int lane) {
    const float* xin = (const float*)xin_; const bf16_t* xinb = (const bf16_t*)xin_; float* xout = (float*)xout_; bf16_t* xoutb = (bf16_t*)xout_;
    f32x4 xc[2][4], xn[2][4]; u32x2 yc[2][4], yn[2][4], bc[2][4], bn[2][4];
#define NR_LOAD(X, B, Yv, r0) do { _Pragma("unroll") for (int q = 0; q < 2; ++q) _Pragma("unroll") for (int j = 0; j < 4; ++j) { \
        if (XIN_BF16) B[q][j] = *(const u32x2*)(xinb + (size_t)((r0) + q * NGW) * D + (lane + 64 * j) * 4); else X[q][j] = *(const f32x4*)(xin + (size_t)((r0) + q * NGW) * D + (lane + 64 * j) * 4); \
        if (WITH_POST) Yv[q][j] = *(const u32x2*)(Y + (size_t)((r0) + q * NGW) * ldy + (lane + 64 * j) * 4); } } while (0)
#pragma unroll
    for (int q = 0; q < 2; ++q)
#pragma unroll
        for (int j = 0; j < 4; ++j) { xc[q][j] = (f32x4){0.f, 0.f, 0.f, 0.f}; xn[q][j] = xc[q][j]; yc[q][j] = (u32x2){0u, 0u}; yn[q][j] = yc[q][j]; bc[q][j] = yc[q][j]; bn[q][j] = yc[q][j]; }
    NR_LOAD(xc, bc, yc, gw);
    for (int row0 = gw; row0 < M; row0 += 2 * NGW) {
        const int rown = row0 + 2 * NGW;
        if (rown < M) NR_LOAD(xn, bn, yn, rown);
        f32x4 v[2][4];
        if (XIN_BF16) {
#pragma unroll
            for (int q = 0; q < 2; ++q)
#pragma unroll
                for (int j = 0; j < 4; ++j) xc[q][j] = (f32x4){bflo(bc[q][j].x), bfhi(bc[q][j].x), bflo(bc[q][j].y), bfhi(bc[q][j].y)};
        }
        if (WITH_POST) {
            float ss[2] = {0.f, 0.f};
#pragma unroll
            for (int q = 0; q < 2; ++q)
#pragma unroll
                for (int j = 0; j < 4; ++j) { const u32x2 y = yc[q][j];
                    v[q][j] = (f32x4){bflo(y.x), bfhi(y.x), bflo(y.y), bfhi(y.y)}; ss[q] += v[q][j][0] * v[q][j][0] + v[q][j][1] * v[q][j][1] + v[q][j][2] * v[q][j][2] + v[q][j][3] * v[q][j][3]; }
#pragma unroll
            for (int o = 1; o < 64; o <<= 1) { const float t0 = shl(ss[0], lane ^ o), t1 = shl(ss[1], lane ^ o); ss[0] += t0; ss[1] += t1; }
#pragma unroll
            for (int q = 0; q < 2; ++q) {
                const int row = row0 + q * NGW, b = row / T;
                const float r = rsqrtf(ss[q] * (1.f / D) + 1e-6f);
                const float* gt = modl_post + (size_t)b * 6144 + gt_off;
#pragma unroll
                for (int j = 0; j < 4; ++j) {
                    const int col = (lane + 64 * j) * 4;
                    const f32x4 xo = xc[q][j], pwv = *(const f32x4*)(pw + col), gtv = *(const f32x4*)(gt + col);
#pragma unroll
                    for (int e = 0; e < 4; ++e) v[q][j][e] = xo[e] + (1.f + gtv[e]) * (v[q][j][e] * r * pwv[e]);
                    if (XOUT_BF16) { u32x2 o; o.x = pk2(v[q][j][0], v[q][j][1]); o.y = pk2(v[q][j][2], v[q][j][3]); *(u32x2*)(xoutb + (size_t)row * D + col) = o;
                        v[q][j] = (f32x4){bflo(o.x), bfhi(o.x), bflo(o.y), bfhi(o.y)}; }
                    else *(f32x4*)(xout + (size_t)row * D + col) = v[q][j];
                }
            }
        } else {
#pragma unroll
            for (int q = 0; q < 2; ++q)
#pragma unroll
                for (int j = 0; j < 4; ++j) { v[q][j] = xc[q][j];
                    if (XOUT_BF16) { u32x2 o; o.x = pk2(v[q][j][0], v[q][j][1]); o.y = pk2(v[q][j][2], v[q][j][3]); *(u32x2*)(xoutb + (size_t)(row0 + q * NGW) * D + (lane + 64 * j) * 4) = o; } }
        }
        if (WITH_PRE) {
            float ss[2] = {0.f, 0.f};
#pragma unroll
            for (int q = 0; q < 2; ++q)
#pragma unroll
                for (int j = 0; j < 4; ++j) ss[q] += v[q][j][0] * v[q][j][0] + v[q][j][1] * v[q][j][1] + v[q][j][2] * v[q][j][2] + v[q][j][3] * v[q][j][3];
#pragma unroll
            for (int o = 1; o < 64; o <<= 1) { const float t0 = shl(ss[0], lane ^ o), t1 = shl(ss[1], lane ^ o); ss[0] += t0; ss[1] += t1; }
#pragma unroll
            for (int q = 0; q < 2; ++q) {
                const int row = row0 + q * NGW, b = row / T;
                const float r2 = rsqrtf(ss[q] * (1.f / D) + 1e-6f);
                const float* sh = modl_pre + (size_t)b * 6144 + sh_off; const float* sc = modl_pre + (size_t)b * 6144 + sc_off;
#pragma unroll
                for (int j = 0; j < 4; ++j) {
                    const int col = (lane + 64 * j) * 4;
                    const f32x4 wv = *(const f32x4*)(w2 + col), scv = *(const f32x4*)(sc + col), shv = *(const f32x4*)(sh + col);
#pragma unroll
                    for (int e = 0; e < 4; ++e) v[q][j][e] = v[q][j][e] * r2 * wv[e] * (1.f + scv[e]) + shv[e];
                    u32x2 o; o.x = pk2(v[q][j][0], v[q][j][1]); o.y = pk2(v[q][j][2], v[q][j][3]);
                    *(u32x2*)(H + (size_t)row * D + col) = o;
                }
            }
        }
#pragma unroll
        for (int q = 0; q < 2; ++q)
#pragma unroll
            for (int j = 0; j < 4; ++j) { xc[q][j] = xn[q][j]; yc[q][j] = yn[q][j]; bc[q][j] = bn[q][j]; }
    }
#undef NR_LOAD
}
__device__ __forceinline__ void zs_mfma(const bf16_t* H, const bf16_t* Wsm, float* ZS, int task, int lane) {
    typedef float f32x16_ __attribute__((ext_vector_type(16)));
    const int r32 = lane & 31, hh = lane >> 5;
    const bf16_t* ap = H + (size_t)(32 * task + r32) * D + 8 * hh;
    const bf16_t* bp = Wsm + (size_t)r32 * D + 8 * hh;
    f32x16_ acc;
#pragma unroll
    for (int r = 0; r < 16; ++r) acc[r] = 0.f;
#pragma unroll 8
    for (int ks = 0; ks < D / 16; ++ks) acc = __builtin_amdgcn_mfma_f32_32x32x16_bf16(*(const bf16x8*)(ap + 16 * ks), *(const bf16x8*)(bp + 16 * ks), acc, 0, 0, 0);
    if (r32 < 24) {
#pragma unroll
        for (int r = 0; r < 16; ++r) ZS[(size_t)(32 * task + (r & 3) + 8 * (r >> 2) + 4 * hh) * 32 + r32] = acc[r];
    }
}
__device__ __forceinline__ void convert_small(const float* w_in, bf16_t* Wsm, int part, int tid) {
    for (int i = tid; i < 4 * 1024; i += NWAVES * 64) {
        const int c = 4 * part + (i >> 10), k = i & 1023;
        float v = 0.f;
        if (c < 16) v = w_in[(size_t)k * INDIM + 1024 + c]; else if (c < 24) v = w_in[(size_t)k * INDIM + 2576 + (c - 16)];
        Wsm[c * 1024 + k] = (bf16_t)f2bf(v);
    }
}

__device__ __forceinline__ void s5_generate(int l, int g, LAS unsigned char* lds, int wv) {
    int tid = hw_tid(wv); asm volatile("" : "+v"(tid));
    LAS float* ar = (LAS float*)lds;
    LAS float* ai = ar + 17 * 64;
    LAS float* bbr = ai + 17 * 64;
    LAS float* bbi = bbr + 1024;
    LAS float* cr = bbi + 1024;
    LAS float* ci = cr + 1024;
    LAS float* Kt = ci + 1024;
    bf16_t* Bt1 = wp_s5m1(l) + (size_t)g * 384 * 256;
    bf16_t* Bt3 = wp_s5m3(l) + (size_t)g * 256 * 128;
    __syncthreads();
    {
        const float dt = expf((inp(18) + l * 32)[g]);
        for (int i = tid; i < 17 * 64; i += 512) {
            const int k = i >> 6, p = i & 63;
            const float lre = fminf((inp(16) + l * 2048)[g * 64 + p], -1e-4f), lim = (inp(17) + l * 2048)[g * 64 + p];
            const float mg = expf((float)k * lre * dt), an = (float)k * lim * dt; ar[i] = mg * cosf(an); ai[i] = mg * sinf(an);
        }
    }
    __syncthreads();
    if (tid < 64) { typedef float f32x2g __attribute__((ext_vector_type(2))); ((f32x2g*)WSP(WS_A16))[(l * 32 + g) * 64 + tid] = (f32x2g){ar[16 * 64 + tid], ai[16 * 64 + tid]}; }
    for (int i = tid; i < 1024; i += 512) {
        const int p = i >> 4;
        const float lre = fminf((inp(16) + l * 2048)[g * 64 + p], -1e-4f), lim = (inp(17) + l * 2048)[g * 64 + p];
        const float a1r = ar[64 + p], a1i = ai[64 + p];
        const float inv = 1.f / (lre * lre + lim * lim);
        const float zr_ = ((a1r - 1.f) * lre + a1i * lim) * inv, zi_ = (a1i * lre - (a1r - 1.f) * lim) * inv;
        const float br = (inp(19) + (size_t)l * 32768)[(size_t)(g * 64) * 16 + i], bi = (inp(20) + (size_t)l * 32768)[(size_t)(g * 64) * 16 + i];
        bbr[i] = zr_ * br - zi_ * bi; bbi[i] = zr_ * bi + zi_ * br;
    }
    for (int i = tid; i < 1024; i += 512) { cr[i] = (inp(21) + (size_t)l * 32768)[g * 1024 + i]; ci[i] = (inp(22) + (size_t)l * 32768)[g * 1024 + i]; }
    __syncthreads();
    {
        const int cp = tid >> 5, c = (tid >> 1) & 15, ph = tid & 1;
        float acc[16];
#pragma unroll
        for (int t = 0; t < 16; ++t) acc[t] = 0.f;
        for (int pp = 0; pp < 32; ++pp) {
            const int p = 32 * ph + pp;
            const float xr = cr[cp * 64 + p], xi = ci[cp * 64 + p], yr = bbr[p * 16 + c], yi = bbi[p * 16 + c];
            const float cbr = xr * yr - xi * yi, cbi = xr * yi + xi * yr;
#pragma unroll
            for (int t = 0; t < 16; ++t) acc[t] += cbr * ar[t * 64 + p] - cbi * ai[t * 64 + p];
        }
#pragma unroll
        for (int t = 0; t < 16; ++t) { const float o = acc[t] + shl(acc[t], (tid & 63) ^ 1); if (ph == 0) Kt[(t * 16 + cp) * 16 + c] = o; }
    }
    __syncthreads();
    for (int pc = tid; pc < 128 * 32; pc += 512) {
        const int row = pc >> 5, k0 = (pc & 31) * 8, sp = k0 >> 4, c0 = k0 & 15, p = row >> 1, e15 = 15 - sp;
        const float xr = ar[e15 * 64 + p], xi = ai[e15 * 64 + p];
        float v[8];
#pragma unroll
        for (int e = 0; e < 8; ++e) { const float yr = bbr[p * 16 + c0 + e], yi = bbi[p * 16 + c0 + e]; v[e] = (row & 1) == 0 ? (xr * yr - xi * yi) : (xr * yi + xi * yr); }
        u32x4 w; w.x = pk2(v[0], v[1]); w.y = pk2(v[2], v[3]); w.z = pk2(v[4], v[5]); w.w = pk2(v[6], v[7]);
        *(u32x4*)(Bt1 + (size_t)row * 256 + k0) = w;
    }
    for (int pc = tid; pc < 256 * 32; pc += 512) {
        const int j = pc >> 5, k0 = (pc & 31) * 8, s = j >> 4, cp = j & 15, sp = k0 >> 4, c0 = k0 & 15;
        float v[8];
#pragma unroll
        for (int e = 0; e < 8; ++e) v[e] = (sp <= s) ? Kt[((s - sp) * 16 + cp) * 16 + c0 + e] : 0.f;
        u32x4 w; w.x = pk2(v[0], v[1]); w.y = pk2(v[2], v[3]); w.z = pk2(v[4], v[5]); w.w = pk2(v[6], v[7]);
        *(u32x4*)(Bt1 + (size_t)(128 + j) * 256 + k0) = w;
    }
    for (int pc = tid; pc < 256 * 16; pc += 512) {
        const int j = pc >> 4, k0 = (pc & 15) * 8, s = j >> 4, cp = j & 15;
        float v[8];
#pragma unroll
        for (int e = 0; e < 8; ++e) {
            const int k = k0 + e, p = k >> 1;
            const float xr = cr[cp * 64 + p], xi = ci[cp * 64 + p], yr = ar[(s + 1) * 64 + p], yi = ai[(s + 1) * 64 + p];
            v[e] = (k & 1) == 0 ? (xr * yr - xi * yi) : -(xr * yi + xi * yr);
        }
        u32x4 w; w.x = pk2(v[0], v[1]); w.y = pk2(v[2], v[3]); w.z = pk2(v[4], v[5]); w.w = pk2(v[6], v[7]);
        *(u32x4*)(Bt3 + (size_t)j * 128 + k0) = w;
    }
    __syncthreads();
}
__device__ __forceinline__ void s5_scan_lds(int l, int g, int b, LAS unsigned char* lds, int wv) {
    int tid = hw_tid(wv); asm volatile("" : "+v"(tid));
    const int p = tid & 63, w = wv;
    typedef float f32x2s __attribute__((ext_vector_type(2)));
    __syncthreads();
    if (w == 0) {
        const f32x2s a16 = ((const f32x2s*)WSP(WS_A16))[(l * 32 + g) * 64 + p];
        const float a16r = a16.x, a16i = a16.y;
        float xr = 0.f, xi = 0.f;
#pragma unroll 8
        for (int n = 0; n < 256; ++n) {
            const f32x2s e = *(const LAS f32x2s*)(lds + n * 512 + (((p >> 1) ^ (n & 15)) * 16) + (p & 1) * 8);
            const unsigned xp = pk2(xr, xi);
            const float tr = a16r * xr - a16i * xi + e[0], ti = a16r * xi + a16i * xr + e[1];
            xr = tr; xi = ti;
            asm volatile("" ::: "memory");
            *(LAS unsigned*)(lds + n * 512 + 4 * p) = xp;
        }
    }
    __syncthreads();
    char* base = (char*)((bf16_t*)WSP(WS_Z) + (size_t)((g & 15) * 2048 + b * 256) * ZLD + EXC + (g >> 4) * 128);
    constexpr size_t RP = (size_t)ZLD * 2;
#pragma unroll 8
    for (int r = 0; r < 32; ++r) { const int n = 32 * w + r; unsigned* row = (unsigned*)(base + (size_t)n * RP); row[p] = *(const LAS unsigned*)(lds + n * 512 + 4 * p); }
}

namespace mx {
typedef float f32x16 __attribute__((ext_vector_type(16)));
__device__ __forceinline__ unsigned cpk(float lo, float hi) { return pg8::cvt_pk_bf16(lo, hi); }
constexpr int PB = 72;
constexpr int L_QS = 0, L_KS = 9216, L_KT = 18432, L_VT = 27648, L_PS = 46080, L_ST = 55296, L_OS = 73728, L_VEC = 107520;
constexpr int OSP = 132;
constexpr int V_SEG = 0  , V_ELAST = 1024, V_XS = 1088  , V_END = 5184;
static_assert(L_VEC + V_END * 4 <= RING_BYTES, "mixer LDS map");
constexpr int L_VEC2 = RING_BYTES + 512, SETSZ = 384, V_RT = 0, V_CS = 64, V_WI = 128, V_WK = 192, V_ENM = 256, V_SC = 320, V_DEN = 768, V_NORM = 832, V2_END = 960;
static_assert(L_VEC2 >= MISC_OFF + 128 && L_VEC2 + V2_END * 4 <= LDS_BYTES, "mixer LDS map (upper area)");
__device__ __forceinline__ int crow(int reg, int hh) { return (reg & 3) + 8 * (reg >> 2) + 4 * hh; }
__device__ __forceinline__ float fexp(float x) { return __builtin_amdgcn_exp2f(1.4426950408889634f * x); }
__device__ __forceinline__ float flogsig(float x) { const float e = fexp(-fabsf(x)); return fminf(x, 0.f) - 0.6931471805599453f * __builtin_amdgcn_logf(1.f + e); }
#define MX_MFMA(a, b, c) __builtin_amdgcn_mfma_f32_32x32x16_bf16((a), (b), (c), 0, 0, 0)
__device__ __forceinline__ void split8(const float (&x)[8], bf16x8& hi, bf16x8& lo) {
    u32x4 h, l;
    unsigned hw[4], lw[4];
#pragma unroll
    for (int i = 0; i < 4; ++i) { const unsigned p = cpk(x[2 * i], x[2 * i + 1]); hw[i] = p; lw[i] = cpk(x[2 * i] - bflo(p), x[2 * i + 1] - bfhi(p)); }
    h.x = hw[0]; h.y = hw[1]; h.z = hw[2]; h.w = hw[3]; l.x = lw[0]; l.y = lw[1]; l.z = lw[2]; l.w = lw[3];
    hi = __builtin_bit_cast(bf16x8, h); lo = __builtin_bit_cast(bf16x8, l);
}

template <int ROLE, bool STORE = true>
__device__ __forceinline__ void stream(int l, LAS unsigned char* lds, int bh, int wvs) {
    int tid = hw_tid(wvs); asm volatile("" : "+v"(tid));
    const int lane = tid & 63, w = __builtin_amdgcn_readfirstlane(tid >> 6), r32 = lane & 31, hh = lane >> 5;
    const int b = bh >> 2, h = bh & 3;
    LAS float* vec = (LAS float*)(lds + L_VEC); LAS float* vec2 = (LAS float*)(lds + L_VEC2);
    LAS bf16_t* Qs = (LAS bf16_t*)(lds + L_QS); LAS bf16_t* Ks = (LAS bf16_t*)(lds + L_KS); LAS bf16_t* KTs = (LAS bf16_t*)(lds + L_KT);
    LAS bf16_t* VTs = (LAS bf16_t*)(lds + L_VT); LAS bf16_t* Ps = (LAS bf16_t*)(lds + L_PS); LAS bf16_t* STs = (LAS bf16_t*)(lds + L_ST);
    LAS float* Os = (LAS float*)(lds + L_OS);
    const int qcol = (ROLE == 0 ? GQ : MQ) + h * 64, kcol = (ROLE == 0 ? GK : MK) + h * 64, vcol = (ROLE == 0 ? GV : MV) + h * 128, gcol = (ROLE == 0 ? GR : MO) + h * 128;
    const __amdgpu_buffer_rsrc_t zrs = __builtin_amdgcn_make_buffer_rsrc((void*)WSP(WS_Z), 0, 0x7fffffff, 0x00020000);
    const __amdgpu_buffer_rsrc_t srs = __builtin_amdgcn_make_buffer_rsrc((void*)WSP(WS_ZS), 0, 0x7fffffff, 0x00020000);
    const __amdgpu_buffer_rsrc_t zrs3 = __builtin_amdgcn_make_buffer_rsrc((void*)(WSP(WS_Z) - 3 * ZLD * 2), 0, 0x7fffffff, 0x00020000);
    const int dp = r32, rg = 2 * w + hh, et = tid >> 3, cg = tid & 7;
    const int wa = w >> 2, wv = w & 3;
    const unsigned vo_qk = (unsigned)((hh * 4 * ZLD + 2 * dp) * 2), vo_v = (unsigned)(lane * 4), vo_g = (unsigned)(((lane >> 3) * ZLD + 16 * (lane & 7)) * 2);
    float abd0 = 0.f, abd1 = 0.f, nwv[16];
    float cwq[4][2], cwk[4][2], cbq[2] = {0.f, 0.f}, cbk[2] = {0.f, 0.f}, ibh = 0.f, fbh = 0.f, mprev = 0.f;
    bf16x8 a2hi = {0, 0, 0, 0, 0, 0, 0, 0}, a2lo = {0, 0, 0, 0, 0, 0, 0, 0};
#pragma unroll
    for (int r = 0; r < 16; ++r) nwv[r] = 0.f;
#pragma unroll
    for (int j = 0; j < 4; ++j) { cwq[j][0] = cwq[j][1] = 0.f; cwk[j][0] = cwk[j][1] = 0.f; }
    if (ROLE == 0) {
        const float* a2 = inp(9) + l * 16 * 256; const float* ab = inp(10) + l * 256; const float* nw = inp(11) + l * 512;
#pragma unroll
        for (int r = 0; r < 16; ++r) nwv[r] = nw[h * 128 + 16 * cg + r];
        abd0 = ab[h * 64 + 2 * dp]; abd1 = ab[h * 64 + 2 * dp + 1];
        float bq[8];
#pragma unroll
        for (int j = 0; j < 8; ++j) bq[j] = a2[(8 * hh + j) * 256 + h * 64 + 32 * (w & 1) + r32];
        split8(bq, a2hi, a2lo);
    } else {
        const float* cw = inp(12) + l * 4 * 512; const float* cb = inp(13) + l * 512;
#pragma unroll
        for (int j = 0; j < 4; ++j)
#pragma unroll
            for (int c = 0; c < 2; ++c) { cwq[j][c] = cw[j * 512 + h * 64 + 2 * dp + c]; cwk[j][c] = cw[j * 512 + 256 + h * 64 + 2 * dp + c]; }
#pragma unroll
        for (int c = 0; c < 2; ++c) { cbq[c] = cb[h * 64 + 2 * dp + c]; cbk[c] = cb[256 + h * 64 + 2 * dp + c]; }
        ibh = (inp(14) + l * 4)[h]; fbh = (inp(15) + l * 4)[h];
    }
    for (int i = tid; i < 128 * PB / 2; i += 512) ((LAS unsigned*)STs)[i] = 0u;
    for (int i = tid; i < 64 * PB / 2; i += 512) ((LAS unsigned*)Ps)[i] = 0u;
    if (tid < 128) vec2[V_NORM + tid] = 0.f;
    f32x16 accS;
#pragma unroll
    for (int r = 0; r < 16; ++r) accS[r] = 0.f;
    unsigned qi[7], ki[7], vi[8]; float zs0 = 0.f, zs1 = 0.f; u32x4 gt0 = {0u, 0u, 0u, 0u}, gt1 = {0u, 0u, 0u, 0u}, ga0 = {0u, 0u, 0u, 0u}, ga1 = {0u, 0u, 0u, 0u};
#define MX_LOAD(mrow) do { \
        const unsigned rb_ = (unsigned)((mrow) + 8 * w) * (unsigned)(ZLD * 2); \
        if (ROLE == 0) { \
            _Pragma("unroll") for (int i = 0; i < 4; ++i) { qi[i] = __builtin_amdgcn_raw_buffer_load_b32(zrs, vo_qk, rb_ + (unsigned)((i * ZLD + qcol) * 2), 0); ki[i] = __builtin_amdgcn_raw_buffer_load_b32(zrs, vo_qk, rb_ + (unsigned)((i * ZLD + kcol) * 2), 0); } \
            if (w < 4) { const unsigned so_ = (unsigned)((mrow) + 32 * (w >> 1)) * 128u; ga0 = __builtin_amdgcn_raw_buffer_load_b128(srs, (unsigned)((r32 * 32 + 8 * hh) * 4), so_, 0); ga1 = __builtin_amdgcn_raw_buffer_load_b128(srs, (unsigned)((r32 * 32 + 8 * hh) * 4 + 16), so_, 0); } \
        } else { \
            _Pragma("unroll") for (int i = 0; i < 7; ++i) { qi[i] = __builtin_amdgcn_raw_buffer_load_b32(zrs3, vo_qk, rb_ + (unsigned)((i * ZLD + qcol) * 2), 0); ki[i] = __builtin_amdgcn_raw_buffer_load_b32(zrs3, vo_qk, rb_ + (unsigned)((i * ZLD + kcol) * 2), 0); } \
            if (w == 7) { const unsigned so_ = (unsigned)(mrow) * 128u; zs0 = __builtin_bit_cast(float, __builtin_amdgcn_raw_buffer_load_b32(srs, (unsigned)(lane * 128), so_ + (unsigned)((16 + h) * 4), 0)); \
                                                                         zs1 = __builtin_bit_cast(float, __builtin_amdgcn_raw_buffer_load_b32(srs, (unsigned)(lane * 128), so_ + (unsigned)((20 + h) * 4), 0)); } \
        } \
        _Pragma("unroll") for (int i = 0; i < 8; ++i) vi[i] = __builtin_amdgcn_raw_buffer_load_b32(zrs, vo_v, rb_ + (unsigned)((i * ZLD + vcol) * 2), 0); \
    } while (0)
#define MX_XS() do { if (w < 4) { \
        asm volatile("" : "+v"(ga0), "+v"(ga1)); \
        const float gf[8] = {__uint_as_float(ga0.x), __uint_as_float(ga0.y), __uint_as_float(ga0.z), __uint_as_float(ga0.w), __uint_as_float(ga1.x), __uint_as_float(ga1.y), __uint_as_float(ga1.z), __uint_as_float(ga1.w)}; \
        bf16x8 ahi, alo; split8(gf, ahi, alo); \
        f32x16 xa; _Pragma("unroll") for (int r = 0; r < 16; ++r) xa[r] = 0.f; \
        xa = MX_MFMA(alo, a2hi, xa); xa = MX_MFMA(ahi, a2lo, xa); xa = MX_MFMA(ahi, a2hi, xa); \
        _Pragma("unroll") for (int r = 0; r < 16; ++r) vec[V_XS + (32 * (w >> 1) + crow(r, hh)) * 64 + 32 * (w & 1) + r32] = xa[r]; } } while (0)
#define MX_SCALARS(sv) do { \
        asm volatile("" : "+v"(zs0), "+v"(zs1)); \
        const float ip = zs0 + ibh, lf = flogsig(zs1 + fbh); \
        float bs = lf; \
        _Pragma("unroll") for (int o = 1; o < 64; o <<= 1) { const float t = shl(bs, lane >= o ? lane - o : lane); if (lane >= o) bs += t; } \
        const float cs = ip - bs; \
        float pm = cs; \
        _Pragma("unroll") for (int o = 1; o < 64; o <<= 1) { const float t = shl(pm, lane >= o ? lane - o : lane); if (lane >= o) pm = fmaxf(pm, t); } \
        const float mt = bs + fmaxf(mprev, pm); \
        (sv)[V_RT + lane] = bs - mt; (sv)[V_CS + lane] = cs; (sv)[V_WI + lane] = fexp(bs + mprev - mt); (sv)[V_ENM + lane] = fexp(-mt); \
        const float mnew = shl(mt, 63), b63 = shl(bs, 63); \
        (sv)[V_WK + lane] = fexp(b63 + cs - mnew); \
        if (lane == 0) (sv)[V_SC] = fexp(b63 + mprev - mnew); \
        mprev = mnew; \
    } while (0)
#define MX_PIN7(a) asm volatile("" : "+v"(a[0]), "+v"(a[1]), "+v"(a[2]), "+v"(a[3]), "+v"(a[4]), "+v"(a[5]), "+v"(a[6]))
#define MX_PIN4(a) asm volatile("" : "+v"(a[0]), "+v"(a[1]), "+v"(a[2]), "+v"(a[3]))
#define MX_PIN8(a) asm volatile("" : "+v"(a[0]), "+v"(a[1]), "+v"(a[2]), "+v"(a[3]), "+v"(a[4]), "+v"(a[5]), "+v"(a[6]), "+v"(a[7]))
    unsigned m0 = (unsigned)(b * T);
    MX_LOAD(m0);
    if (ROLE == 0) MX_XS(); else if (w == 7) MX_SCALARS(vec2);
    __syncthreads();

#pragma unroll 1
    for (int n = 0; n <= 64; ++n) {
        if (n > 0) {
            const LAS float* orow = Os + et * OSP + 16 * cg;
            float o[16];
#pragma unroll
            for (int q4 = 0; q4 < 4; ++q4) { const f32x4 t4 = *(const LAS f32x4*)(orow + 4 * q4); o[4 * q4] = t4[0]; o[4 * q4 + 1] = t4[1]; o[4 * q4 + 2] = t4[2]; o[4 * q4 + 3] = t4[3]; }
            asm volatile("" : "+v"(gt0), "+v"(gt1));
            const unsigned gw_[8] = {gt0.x, gt0.y, gt0.z, gt0.w, gt1.x, gt1.y, gt1.z, gt1.w};
            float y[16];
            if (ROLE == 0) {
                float ss = 0.f;
#pragma unroll
                for (int e = 0; e < 16; ++e) ss += o[e] * o[e];
                ss += shl(ss, lane ^ 1); ss += shl(ss, lane ^ 2); ss += shl(ss, lane ^ 4);
                const float rn = rsqrtf(ss * (1.f / 128.f) + 1e-6f);
#pragma unroll
                for (int e = 0; e < 16; ++e) { const float g = (e & 1) ? bfhi(gw_[e >> 1]) : bflo(gw_[e >> 1]); y[e] = o[e] * rn * nwv[e] * g; }
            } else {
                const float rdiv = vec2[V_DEN + et];
#pragma unroll
                for (int e = 0; e < 16; ++e) { const float g = (e & 1) ? bfhi(gw_[e >> 1]) : bflo(gw_[e >> 1]); y[e] = o[e] * rdiv * g; }
            }
            u32x4 s0, s1;
            s0.x = cpk(y[0], y[1]); s0.y = cpk(y[2], y[3]); s0.z = cpk(y[4], y[5]); s0.w = cpk(y[6], y[7]);
            s1.x = cpk(y[8], y[9]); s1.y = cpk(y[10], y[11]); s1.z = cpk(y[12], y[13]); s1.w = cpk(y[14], y[15]);
            const unsigned so_ = (m0 - 64u + 8u * (unsigned)w) * (unsigned)(ZLD * 2) + (unsigned)(gcol * 2);
            if (STORE) { __builtin_amdgcn_raw_buffer_store_b128(s0, zrs, vo_g, so_, 0); __builtin_amdgcn_raw_buffer_store_b128(s1, zrs, vo_g + 16u, so_, 0); } else { asm volatile("" :: "v"(s0), "v"(s1)); }
        }
        if (n == 64) break;
        const LAS float* sv = vec2 + (n & 1) * SETSZ;
        float c4[4][2], qf[4][2], kf[4][2];
        if (ROLE == 0) {
            MX_PIN4(qi); MX_PIN4(ki);
            float run0 = 0.f, run1 = 0.f;
#pragma unroll
            for (int i = 0; i < 4; ++i) {
                const f32x2 x2 = *(const LAS f32x2*)(vec + V_XS + (4 * rg + i) * 64 + 2 * dp);
                run0 += flogsig(x2[0] + abd0) * (1.f / 16.f); run1 += flogsig(x2[1] + abd1) * (1.f / 16.f); c4[i][0] = run0; c4[i][1] = run1;
                qf[i][0] = bflo(qi[i]) * 0.125f; qf[i][1] = bfhi(qi[i]) * 0.125f; kf[i][0] = bflo(ki[i]); kf[i][1] = bfhi(ki[i]);
            }
            *(LAS f32x2*)(vec + V_SEG + rg * 64 + 2 * dp) = (f32x2){run0, run1};
            __syncthreads();
        } else {
            MX_PIN7(qi); MX_PIN7(ki);
            if (n == 0 && rg == 0) { qi[0] = qi[1] = qi[2] = 0u; ki[0] = ki[1] = ki[2] = 0u; }
#pragma unroll
            for (int i = 0; i < 4; ++i) {
                float aq0 = cbq[0], aq1 = cbq[1], ak0 = cbk[0], ak1 = cbk[1];
#pragma unroll
                for (int j = 0; j < 4; ++j) { aq0 += cwq[j][0] * bflo(qi[i + j]); aq1 += cwq[j][1] * bfhi(qi[i + j]); ak0 += cwk[j][0] * bflo(ki[i + j]); ak1 += cwk[j][1] * bfhi(ki[i + j]); }
                qf[i][0] = aq0 * fsigmoid(aq0); qf[i][1] = aq1 * fsigmoid(aq1); kf[i][0] = ak0 * fsigmoid(ak0) * 0.125f; kf[i][1] = ak1 * fsigmoid(ak1) * 0.125f;
                c4[i][0] = 0.f; c4[i][1] = 0.f;
            }
        }
        {
            float kt0[4], kt1[4];
            if (ROLE == 0) {
                float off0 = 0.f, off1 = 0.f, tot0 = 0.f, tot1 = 0.f;
#pragma unroll
                for (int r2 = 0; r2 < 16; ++r2) { const f32x2 s = *(const LAS f32x2*)(vec + V_SEG + r2 * 64 + 2 * dp); tot0 += s[0]; tot1 += s[1]; off0 += (r2 < rg) ? s[0] : 0.f; off1 += (r2 < rg) ? s[1] : 0.f; }
                if (rg == 0) *(LAS f32x2*)(vec + V_ELAST + 2 * dp) = (f32x2){fexp(tot0), fexp(tot1)};
#pragma unroll
                for (int i = 0; i < 4; ++i) {
                    const float cum0 = off0 + c4[i][0], cum1 = off1 + c4[i][1];
                    const float kk0 = kf[i][0] * fexp(-cum0), kk1 = kf[i][1] * fexp(-cum1);
                    *(LAS unsigned*)(Qs + (4 * rg + i) * PB + 2 * dp) = cpk(qf[i][0] * fexp(cum0), qf[i][1] * fexp(cum1));
                    *(LAS unsigned*)(Ks + (4 * rg + i) * PB + 2 * dp) = cpk(kk0, kk1);
                    kt0[i] = kk0; kt1[i] = kk1;
                }
            } else {
#pragma unroll
                for (int i = 0; i < 4; ++i) {
                    *(LAS unsigned*)(Qs + (4 * rg + i) * PB + 2 * dp) = cpk(qf[i][0], qf[i][1]);
                    *(LAS unsigned*)(Ks + (4 * rg + i) * PB + 2 * dp) = cpk(kf[i][0], kf[i][1]);
                    const float wk = sv[V_WK + 4 * rg + i];
                    kt0[i] = kf[i][0] * wk; kt1[i] = kf[i][1] * wk;
                }
            }
            *(LAS u32x2*)(KTs + (2 * dp) * PB + 4 * rg) = (u32x2){cpk(kt0[0], kt0[1]), cpk(kt0[2], kt0[3])};
            *(LAS u32x2*)(KTs + (2 * dp + 1) * PB + 4 * rg) = (u32x2){cpk(kt1[0], kt1[1]), cpk(kt1[2], kt1[3])};
            MX_PIN8(vi);
            u32x4 v0, v1;
            v0.x = (vi[0] & 0xffffu) | (vi[1] << 16); v0.y = (vi[2] & 0xffffu) | (vi[3] << 16); v0.z = (vi[4] & 0xffffu) | (vi[5] << 16); v0.w = (vi[6] & 0xffffu) | (vi[7] << 16);
            v1.x = (vi[0] >> 16) | (vi[1] & 0xffff0000u); v1.y = (vi[2] >> 16) | (vi[3] & 0xffff0000u); v1.z = (vi[4] >> 16) | (vi[5] & 0xffff0000u); v1.w = (vi[6] >> 16) | (vi[7] & 0xffff0000u);
            *(LAS u32x4*)(VTs + (2 * lane) * PB + 8 * w) = v0; *(LAS u32x4*)(VTs + (2 * lane + 1) * PB + 8 * w) = v1;
        }
        __syncthreads();
        { const unsigned so_ = (m0 + 8u * (unsigned)w) * (unsigned)(ZLD * 2) + (unsigned)(gcol * 2); gt0 = __builtin_amdgcn_raw_buffer_load_b128(zrs, vo_g, so_, 0); gt1 = __builtin_amdgcn_raw_buffer_load_b128(zrs, vo_g + 16u, so_, 0); }
        if (n < 63) MX_LOAD(m0 + 64u);
#define MX_FRAG(base, row, ks) (*(const LAS bf16x8*)(lds + (base) + ((row) * PB + 16 * (ks) + 8 * hh) * 2))
        if (w < 3) {
            const int ti = (w >= 1) ? 1 : 0, sj = (w == 2) ? 1 : 0;
            f32x16 sc;
#pragma unroll
            for (int r = 0; r < 16; ++r) sc[r] = 0.f;
#pragma unroll
            for (int ks = 0; ks < 4; ++ks) sc = MX_MFMA(MX_FRAG(L_KS, 32 * sj + r32, ks), MX_FRAG(L_QS, 32 * ti + r32, ks), sc);
            const float rtv = (ROLE == 1) ? sv[V_RT + 32 * ti + r32] : 0.f;
            float pv[16];
#pragma unroll
            for (int r = 0; r < 16; ++r) {
                const int s = crow(r, hh);
                const bool keep = (ti != sj) || (s <= r32);
                float val = sc[r];
                if (ROLE == 1) val *= fexp(rtv + sv[V_CS + 32 * sj + s]);
                pv[r] = keep ? val : 0.f;
            }
#pragma unroll
            for (int q4 = 0; q4 < 4; ++q4) *(LAS u32x2*)(Ps + (32 * ti + r32) * PB + 32 * sj + 8 * q4 + 4 * hh) = (u32x2){cpk(pv[4 * q4], pv[4 * q4 + 1]), cpk(pv[4 * q4 + 2], pv[4 * q4 + 3])};
        }
        f32x16 acco;
#pragma unroll
        for (int r = 0; r < 16; ++r) acco[r] = 0.f;
#pragma unroll
        for (int ks = 0; ks < 4; ++ks) acco = MX_MFMA(MX_FRAG(L_QS, 32 * wa + r32, ks), MX_FRAG(L_ST, 32 * wv + r32, ks), acco);
        if (ROLE == 1) {
#pragma unroll
            for (int r = 0; r < 16; ++r) acco[r] *= sv[V_WI + 32 * wa + crow(r, hh)];
            const float carry = sv[V_SC];
#pragma unroll
            for (int r = 0; r < 16; ++r) accS[r] *= carry;
        }
#pragma unroll
        for (int ks = 0; ks < 4; ++ks) accS = MX_MFMA(MX_FRAG(L_KT, 32 * wa + r32, ks), MX_FRAG(L_VT, 32 * wv + r32, ks), accS);
        if (ROLE == 0) {
#pragma unroll
            for (int r = 0; r < 16; ++r) accS[r] *= vec[V_ELAST + 32 * wa + crow(r, hh)];
        }
        __syncthreads();
        if (wa == 0) {
#pragma unroll
            for (int ks = 0; ks < 2; ++ks) acco = MX_MFMA(MX_FRAG(L_PS, r32, ks), MX_FRAG(L_VT, 32 * wv + r32, ks), acco);
        } else {
#pragma unroll
            for (int ks = 0; ks < 4; ++ks) acco = MX_MFMA(MX_FRAG(L_PS, 32 + r32, ks), MX_FRAG(L_VT, 32 * wv + r32, ks), acco);
        }
#pragma unroll
        for (int r = 0; r < 16; ++r) Os[(32 * wa + crow(r, hh)) * OSP + 32 * wv + r32] = acco[r];
#pragma unroll
        for (int q4 = 0; q4 < 4; ++q4) { u32x2 p; p.x = cpk(accS[4 * q4], accS[4 * q4 + 1]); p.y = cpk(accS[4 * q4 + 2], accS[4 * q4 + 3]);
            *(LAS u32x2*)(STs + (32 * wv + r32) * PB + 32 * wa + 8 * q4 + 4 * hh) = p; }
        if (ROLE == 0) { if (n < 63) MX_XS(); }
        else {
            const LAS float* nprev = vec2 + V_NORM + (n & 1) * 64;
            if (w == 0) {
                float qn = 0.f, si = 0.f;
#pragma unroll
                for (int c8i = 0; c8i < 8; ++c8i) {
                    const u32x4 qv = *(const LAS u32x4*)(Qs + lane * PB + 8 * c8i), pv = *(const LAS u32x4*)(Ps + lane * PB + 8 * c8i);
                    const f32x4 n0 = *(const LAS f32x4*)(nprev + 8 * c8i), n1 = *(const LAS f32x4*)(nprev + 8 * c8i + 4);
                    qn += bflo(qv.x) * n0[0] + bfhi(qv.x) * n0[1] + bflo(qv.y) * n0[2] + bfhi(qv.y) * n0[3] + bflo(qv.z) * n1[0] + bfhi(qv.z) * n1[1] + bflo(qv.w) * n1[2] + bfhi(qv.w) * n1[3];
                    si += (bflo(pv.x) + bfhi(pv.x)) + (bflo(pv.y) + bfhi(pv.y)) + (bflo(pv.z) + bfhi(pv.z)) + (bflo(pv.w) + bfhi(pv.w));
                }
                const float den = sv[V_WI + lane] * qn + si;
                vec2[V_DEN + lane] = 1.f / fmaxf(fabsf(den), sv[V_ENM + lane]);
            } else if (w == 7) {
                if (n < 63) MX_SCALARS(vec2 + ((n + 1) & 1) * SETSZ);
            } else if (w == 1) {
                float kn = 0.f;
#pragma unroll
                for (int c8i = 0; c8i < 8; ++c8i) { const u32x4 kv = *(const LAS u32x4*)(KTs + lane * PB + 8 * c8i);
                    kn += (bflo(kv.x) + bfhi(kv.x)) + (bflo(kv.y) + bfhi(kv.y)) + (bflo(kv.z) + bfhi(kv.z)) + (bflo(kv.w) + bfhi(kv.w)); }
                vec2[V_NORM + ((n + 1) & 1) * 64 + lane] = sv[V_SC] * nprev[lane] + kn;
            }
        }
        __syncthreads();
        m0 += 64u;
    }
#undef MX_LOAD
#undef MX_XS
#undef MX_PIN4
#undef MX_PIN7
#undef MX_PIN8
#undef MX_SCALARS
#undef MX_FRAG
}
}

#ifndef PHASE_MASK
#define PHASE_MASK 0xFFFF
#endif
#define PH(k) if constexpr ((PHASE_MASK >> (k)) & 1)
#ifndef STAGGER_TICKS
#define STAGGER_TICKS 0
#endif
#ifndef PROBE_GEMM_REPS
#define PROBE_GEMM_REPS 1
#endif
#ifndef PROBE_STREAM_REPS
#define PROBE_STREAM_REPS 1
#endif
#ifndef PROBE_GEMM_MASK
#define PROBE_GEMM_MASK 0xFFFF
#endif
#define GREP(k) _Pragma("unroll 1") for (int rep_ = 0; rep_ < (((PROBE_GEMM_MASK >> (k)) & 1) ? PROBE_GEMM_REPS : 1); ++rep_)
#define GREP_BAR if (rep_) GRID_BAR();
#define BLK_ENV int blk = blockIdx.x; asm volatile("" : "+s"(blk));
#define PHASE_ENV BLK_ENV int tid = hw_tid(wave_s); asm volatile("" : "+v"(tid)); const int lane = tid & 63, wave = wave_s; int vcu_ = vcu; asm volatile("" : "+s"(vcu_)); const int gw = vcu_ * NWAVES + wave; (void)lane; (void)gw;
__global__ void __launch_bounds__(NWAVES * 64, 2) mega_fwd(Args args) {
    extern __shared__ __attribute__((aligned(16))) unsigned char lds_raw[];
    LAS unsigned char* lds = (LAS unsigned char*)lds_raw;
    const int G = gridDim.x, blk0 = blockIdx.x;
    const int wave_s = __builtin_amdgcn_readfirstlane(threadIdx.x >> 6);
    const int vcu = (G % 8 == 0) ? (blk0 % 8) * (G / 8) + blk0 / 8 : blk0;
    const int NGW = G * NWAVES;
    for (int u = threadIdx.x; u < (LDS_BYTES - LDSCTL_OFF) / 4; u += NWAVES * 64) ((LAS unsigned*)(lds + LDSCTL_OFF))[u] = 0u;
    __syncthreads();
    (void)xcd_barrier_post((unsigned*)(args.ws + WS_CTL) + CW_BAR, (volatile LAS unsigned*)(lds + MISC_OFF) + 8);
#define GRID_BAR() do { XcdBarrier b_; b_.bar = (unsigned*)(inp_ws() + WS_CTL) + CW_BAR; b_.x = xb_xcc_id(); b_.st = (volatile LAS unsigned*)(lds + MISC_OFF) + 8; xcd_barrier(b_, wave_s); } while (0)

    PH(0) { PHASE_ENV
        ada_phase(lds, blk, wave, lane);
        if (blk >= 192 && blk < 224) s5_generate(0, blk - 192, lds, wave_s);
        else {
            if (blk >= 224 && blk < 232) { convert_small(inp(8), (bf16_t*)WSP(WS_WSM), blk - 224, tid); __syncthreads(); }
            LAS float* scr = (LAS float*)(lds + wave * 16384);
            int base = 0;
            convert_matrix<1>(inp(8), INDIM, 1024, ZLD, (bf16_t*)WSP(WS_WIN), scr, lane, (blk < 192 ? blk : blk - 32) * NWAVES + wave, (G - 32) * NWAVES, base);
        }
    }
    GRID_BAR();

#pragma unroll 1
    for (int l = 0; l < DEPTH; ++l) {
        PH(1) if (l == 0) { PHASE_ENV
            norm_rows<false, true, false, true>(nullptr, 0, inp(0), nullptr, nullptr, 0, inp_out(), inp(4), (const float*)WSP(WS_MOD), 0, 1024, (bf16_t*)WSP(WS_H), gw, NGW, lane);
            GRID_BAR();
        }
        PH(2) GREP(2) { GREP_BAR BLK_ENV
            pg8::PlainSched S; S.o.init(M, NMIX, G, blk); S.A = (const bf16_t*)WSP(WS_H); S.lda = D; S.Bt = wp_win(l); S.K = D;
            pg8::EpiStore E{(bf16_t*)WSP(WS_Z), ZLD, STAGGER_TICKS, 1};
            pg8::gemm_phase<pg8::EpiStore, pg8::PlainSched, true, true>(lds, wave_s, D, D, S, E);
            { const int task = (int)(((G % 8 == 0) ? (blk % 8) * (G / 8) + blk / 8 : blk) * NWAVES + wave_s);
              for (int t = task; t < M / 32; t += G * NWAVES) zs_mfma((const bf16_t*)WSP(WS_H), wp_wsm(l), (float*)WSP(WS_ZS), t, hw_lane()); }
        }
        GRID_BAR();
        PH(3) { PHASE_ENV
            if ((blk & 7) < 2) {
                const int sidx = (blk >> 3) * 2 + (blk & 7);
                if (sidx < 32) mx::stream<0>(l, lds, sidx, wave_s); else mx::stream<1>(l, lds, sidx - 32, wave_s);
            } else {
#define GX_ENV int blk_ = blockIdx.x; asm volatile("" : "+s"(blk_)); const int xq = blk_ & 7, gidx = (blk_ >> 3) * 6 + (xq - 2); const bool grpD = xq < 4; (void)gidx; (void)grpD;
#define S5_TASK(kk) do { \
                    { GX_ENV const int task = (grpD ? (blk_ >> 3) * 2 + (xq - 2) : 128 + (blk_ >> 3) * 4 + (xq - 4)) + 64 * (kk); \
                      int g256 = 256; asm volatile("" : "+s"(g256)); pg8::S5aSched S; S.G = g256; S.c = task; S.Zb = (const bf16_t*)WSP(WS_Z); S.Bt1 = wp_s5m1(l); pg8::EpiS5a E{l}; \
                      pg8::gemm_phase<pg8::EpiS5a, pg8::S5aSched, true, true, 1>(lds, wave_s, 0, 256, S, E); } \
                    { GX_ENV const int task = (grpD ? (blk_ >> 3) * 2 + (xq - 2) : 128 + (blk_ >> 3) * 4 + (xq - 4)) + 64 * (kk); s5_scan_lds(l, task >> 3, task & 7, lds, wave_s); } \
                    { asm volatile("s_waitcnt vmcnt(0)" ::: "memory"); __builtin_amdgcn_fence(__ATOMIC_RELEASE, "workgroup"); __syncthreads(); __builtin_amdgcn_fence(__ATOMIC_ACQUIRE, "workgroup"); } \
                    { GX_ENV const int task = (grpD ? (blk_ >> 3) * 2 + (xq - 2) : 128 + (blk_ >> 3) * 4 + (xq - 4)) + 64 * (kk); \
                      int g256 = 256; asm volatile("" : "+s"(g256)); pg8::S5bSched S; S.G = g256; S.c = task; S.X = (const bf16_t*)WSP(WS_Z); S.Bt3 = wp_s5m3(l); pg8::EpiS5b E{(bf16_t*)WSP(WS_Z), inp(23) + l * 512, lds}; \
                      pg8::gemm_phase<pg8::EpiS5b, pg8::S5bSched, true, true>(lds, wave_s, ZLD, 128, S, E); } \
                    __syncthreads(); } while (0)
                {   GX_ENV int base = 0; const int gw2 = gidx * NWAVES + wave, NGW2 = 192 * NWAVES;
                    LAS float* scr = (LAS float*)(lds + wave * 16384);
                    convert_matrix<2>(inp(31) + (size_t)l * D * 2 * FF, 2 * FF, 1024, 2 * FF, (bf16_t*)DUP(DU_WFI), scr, lane, gw2, NGW2, base);
                    if (l + 1 < DEPTH) {
                        convert_matrix<1>(inp(8) + (size_t)(l + 1) * D * INDIM, INDIM, 1024, ZLD, wp_win(l + 1), scr, lane, gw2, NGW2, base);
                        if (gidx >= 32 && gidx < 40) { __syncthreads(); convert_small(inp(8) + (size_t)(l + 1) * D * INDIM, wp_wsm(l + 1), gidx - 32, tid); }
                    }
                    __syncthreads();
                }
#pragma unroll 1
                for (int kt = 0; kt < 2; ++kt) {
                    { GX_ENV if (kt == 1 && !grpD) break; }
                    S5_TASK(kt);
                }
                {
                    asm volatile("s_waitcnt vmcnt(0) lgkmcnt(0)" ::: "memory"); __syncthreads();
                    if (wave_s == 0 && hw_lane() == 0) __hip_atomic_fetch_add((unsigned*)WSP(WS_CTL) + CW_S5DONE, 1u, __ATOMIC_RELAXED, __HIP_MEMORY_SCOPE_AGENT);
                }
                {
                    GX_ENV
                    pg8::PlainSched S;
                    if (grpD) S.o.init(M, 768, 64, (blk_ >> 3) * 2 + (xq - 2), 2); else S.o.init(M, 2304, 128, (blk_ >> 3) * 4 + (xq - 4), 4);
                    const int coff = grpD ? 0 : 768;
                    S.A = (const bf16_t*)WSP(WS_H); S.lda = D; S.Bt = wp_win(l) + (size_t)(NMIX + coff) * D; S.K = D;
                    pg8::EpiStore E{(bf16_t*)WSP(WS_Z) + NMIX + coff, ZLD, 0, 2, 0, inp(29) + l * 3072 + coff};
                    E.waitp = grpD ? (unsigned*)WSP(WS_CTL) + CW_S5DONE : nullptr; E.waitn = 192u * (unsigned)(l + 1);
                    pg8::gemm_phase<pg8::EpiStore, pg8::PlainSched, true, true>(lds, wave_s, D, D, S, E);
                }
                {
                    GX_ENV
                    if (wave_s == 0) { unsigned spins = 0; while ((unsigned)__builtin_amdgcn_readfirstlane(__hip_atomic_load((unsigned*)WSP(WS_CTL) + CW_S5DONE, __ATOMIC_RELAXED, __HIP_MEMORY_SCOPE_AGENT)) < 192u * (unsigned)(l + 1)) { __builtin_amdgcn_s_sleep(8); if (++spins > (1u << 22)) break; } }
                    __syncthreads();
                    int tid2 = hw_tid(wave_s); asm volatile("" : "+v"(tid2)); const int lane = tid2 & 63, wave = wave_s;
                    int base = 0; const int gw2 = gidx * NWAVES + wave, NGW2 = 192 * NWAVES;
                    LAS float* scr = (LAS float*)(lds + wave * 16384);
                    convert_matrix<0>(inp(24) + (size_t)l * 512 * 512, 512, 512, 512, (bf16_t*)WSP(WS_WGLU), scr, lane, gw2, NGW2, base);
                    convert_matrix<0>(inp(26) + (size_t)l * 512 * 1024, 1024, 512, 1024, (bf16_t*)WSP(WS_WPROJ), scr, lane, gw2, NGW2, base);
                    convert_matrix<0>(inp(27) + (size_t)l * 512 * 1024, 1024, 512, 1024, (bf16_t*)WSP(WS_WPROJ) + 1024 * 512, scr, lane, gw2, NGW2, base);
                    convert_matrix<0>(inp(28) + (size_t)l * 512 * 1024, 1024, 512, 1024, (bf16_t*)WSP(WS_WPROJ) + 2 * 1024 * 512, scr, lane, gw2, NGW2, base);
                    convert_matrix<0>(inp(30) + (size_t)l * D * D, 1024, 1024, 1024, (bf16_t*)WSP(WS_WOUT), scr, lane, gw2, NGW2, base);
                    convert_matrix<0>(inp(32) + (size_t)l * FF * D, 1024, FF, 1024, (bf16_t*)WSP(WS_WFO), scr, lane, gw2, NGW2, base);
                }
                { GX_ENV if (l + 1 < DEPTH && gidx < 32) { __syncthreads(); s5_generate(l + 1, gidx, lds, wave_s); } }
#undef S5_TASK
#undef GX_ENV
            }
        }
        GRID_BAR();
        PH(4) GREP(4) { GREP_BAR BLK_ENV
            bf16_t* Z = (bf16_t*)WSP(WS_Z);
            pg8::PlainSched S; S.o.init(M, 512, G, blk); S.A = Z + SU; S.lda = ZLD; S.Bt = (const bf16_t*)WSP(WS_WGLU); S.K = 512;
            pg8::EpiGlu E{Z + YS2, ZLD, Z + SU, ZLD, inp(25) + l * 512, lds};
            pg8::gemm_phase<pg8::EpiGlu, pg8::PlainSched, true, true>(lds, wave_s, ZLD, 512, S, E);
        }
        GRID_BAR();
        PH(5) GREP(5) { GREP_BAR BLK_ENV
            bf16_t* Z = (bf16_t*)WSP(WS_Z);
            pg8::MergeSched S; S.o.init(M, 1024, G, blk); S.Zb = Z; S.Wp = (const bf16_t*)WSP(WS_WPROJ);
            pg8::EpiMerge E{Z + MRG, ZLD, Z + ZG, ZLD, inp(29) + l * 3072};
            pg8::gemm_phase<pg8::EpiMerge, pg8::MergeSched, true, true>(lds, wave_s, ZLD, 512, S, E);
        }
        GRID_BAR();
        PH(6) GREP(6) { GREP_BAR BLK_ENV
            pg8::PlainSched S; S.o.init(M, 1024, G, blk); S.A = (const bf16_t*)WSP(WS_Z) + MRG; S.lda = ZLD; S.Bt = (const bf16_t*)WSP(WS_WOUT); S.K = 1024;
            pg8::EpiNorm<0, false> E{l, lds + LT_OFF}; pg8::gemm_phase<pg8::EpiNorm<0, false>, pg8::PlainSched, true, true>(lds, wave_s, ZLD, 1024, S, E);
        }
        GRID_BAR();
        PH(8) GREP(8) { GREP_BAR BLK_ENV
            pg8::PlainSched S; S.o.init(M, 2 * FF, G, blk); S.A = (const bf16_t*)WSP(WS_H); S.lda = D; S.Bt = (const bf16_t*)DUP(DU_WFI); S.K = D;
            pg8::EpiSwiGlu E{(bf16_t*)WSP(WS_Z) + HIDC, ZLD, STAGGER_TICKS};
            pg8::gemm_phase<pg8::EpiSwiGlu, pg8::PlainSched, true, true>(lds, wave_s, D, D, S, E);
        }
        GRID_BAR();
        PH(9) GREP(9) { GREP_BAR BLK_ENV
            pg8::PlainSched S; S.o.init(M, 1024, G, blk); S.A = (const bf16_t*)WSP(WS_Z) + HIDC; S.lda = ZLD; S.Bt = (const bf16_t*)WSP(WS_WFO); S.K = FF;
            if (l + 1 < DEPTH) { pg8::EpiNorm<1, false> E{l, lds + LT_OFF}; pg8::gemm_phase<pg8::EpiNorm<1, false>, pg8::PlainSched, true, true>(lds, wave_s, ZLD, FF, S, E); }
            else { pg8::EpiNorm<1, true> E{l, lds + LT_OFF}; pg8::gemm_phase<pg8::EpiNorm<1, true>, pg8::PlainSched, true, true>(lds, wave_s, ZLD, FF, S, E); }
        }
        if (l + 1 < DEPTH) GRID_BAR();
    }
}

extern "C" void kernel_launch(void* const* d_in, const int* in_sizes, int n_in, void* d_out, int out_size, void* d_ws, size_t ws_size, hipStream_t stream) {
    static int grid = 0;
    if (grid == 0) {
        if (n_in != 33 || ws_size < WS_END || out_size != M * D) { fprintf(stderr, "kernel_launch: unexpected n_in %d / ws %zu / out %d\n", n_in, ws_size, out_size); grid = -1; return; }
        int dev = 0, cus = 0, per_cu = 0;
        if (hipGetDevice(&dev) != hipSuccess || hipDeviceGetAttribute(&cus, hipDeviceAttributeMultiprocessorCount, dev) != hipSuccess) { grid = -1; return; }
        if (hipFuncSetAttribute((const void*)mega_fwd, hipFuncAttributeMaxDynamicSharedMemorySize, LDS_BYTES) != hipSuccess) { fprintf(stderr, "kernel_launch: hipFuncSetAttribute failed\n"); grid = -1; return; }
        if (hipOccupancyMaxActiveBlocksPerMultiprocessor(&per_cu, (const void*)mega_fwd, NWAVES * 64, LDS_BYTES) != hipSuccess || per_cu < 1) { fprintf(stderr, "kernel_launch: occupancy query says %d blocks/CU\n", per_cu); grid = -1; return; }
        (void)hipGetLastError();
        grid = cus;
    }
    if (grid < 0) return;
    (void)hipMemsetAsync((char*)d_ws + WS_CTL, 0, CTL_ZERO_BYTES, stream);
    Args a{};
    for (int i = 0; i < 33; ++i) a.in[i] = (const float*)d_in[i];
    a.out = (float*)d_out; a.ws = (unsigned char*)d_ws;
    hipLaunchKernelGGL(mega_fwd, dim3(grid), dim3(NWAVES * 64), LDS_BYTES, stream, a);
}
```

```cpp
#include <hip/hip_runtime.h>
#include <cstdint>
#include <cstdio>

#define LAS __attribute__((address_space(3)))
#define GAS __attribute__((address_space(1)))
typedef unsigned short bf16_t;
typedef short bf16x8 __attribute__((ext_vector_type(8)));
typedef float f32x4 __attribute__((ext_vector_type(4)));
typedef float f32x2 __attribute__((ext_vector_type(2)));
typedef unsigned u32x4 __attribute__((ext_vector_type(4)));
typedef unsigned u32x2 __attribute__((ext_vector_type(2)));

constexpr int NB = 8, T = 4096, D = 1024, M = NB * T, DEPTH = 2;
constexpr int INDIM = 6680, ZLD = 6656, FF = 2816;
constexpr int GQ = 0, GK = 256, GV = 512, GR = 1024, MQ = 1536, MK = 1792, MV = 2048, MO = 2560, SU = 3072, ZG = 3584;
constexpr int YGLA = GR;
constexpr int YML = MO;
constexpr int YS2 = 0;
constexpr int MRG = 1536;
constexpr int EXC = ZG;
constexpr int YPC = ZG + 256;
constexpr int NMIX = 3584;
constexpr size_t MiB = 1u << 20;
constexpr size_t WS_CTL = 0, CTL_ZERO_BYTES = 64 * 1024;
constexpr size_t WS_MOD = 512 * 1024;
constexpr size_t WS_ZS = 1 * MiB;
constexpr size_t WS_WIN = 5 * MiB;
constexpr size_t WS_WFI = 5 * MiB;
constexpr size_t WS_S5M1 = 18 * MiB;
constexpr size_t WS_S5M3 = 24 * MiB;
constexpr size_t WS_WGLU = 18 * MiB;
constexpr size_t WS_WPROJ = 18 * MiB + 512 * 1024;
constexpr size_t WS_WOUT = 21 * MiB + 512 * 1024;
constexpr size_t WS_WFO = 23 * MiB + 512 * 1024;
constexpr size_t WS_A16 = 31 * MiB + 512 * 1024;
constexpr size_t WS_WSM = 29 * MiB;
constexpr size_t WS_H = 32 * MiB;
constexpr size_t WS_Z = 96 * MiB;
constexpr size_t WS_XB = WS_Z + 200 * MiB;
constexpr size_t WS_END = 512 * MiB;
constexpr int CW_BAR = 4096;
constexpr int CW_S5DONE = 6144;
constexpr int CW_PANEL = 8192;
constexpr size_t WS_SLOT = 29 * MiB + 64 * 1024;
constexpr int XZ = 0, HIDC = 1024;

constexpr int RING_BYTES = 131072, LDSCTL_OFF = RING_BYTES, MISC_OFF = LDSCTL_OFF + 320, LDS_BYTES = 163840;
constexpr int LT_OFF = RING_BYTES + 512;
constexpr int NWAVES = 8;

__device__ __forceinline__ float bf2f(bf16_t v) { return __uint_as_float(((unsigned)v) << 16); }
__device__ __forceinline__ unsigned f2bf(float f) { unsigned u = __float_as_uint(f); return (u + 0x7fffu + ((u >> 16) & 1u)) >> 16; }
__device__ __forceinline__ unsigned pk2(float lo, float hi) { return f2bf(lo) | (f2bf(hi) << 16); }
__device__ __forceinline__ float bflo(unsigned u) { return __uint_as_float(u << 16); }
__device__ __forceinline__ float bfhi(unsigned u) { return __uint_as_float(u & 0xffff0000u); }
__device__ __forceinline__ int hw_lane() { int l; asm volatile("v_mbcnt_lo_u32_b32 %0, -1, 0\n\tv_mbcnt_hi_u32_b32 %0, -1, %0" : "=v"(l)); return l; }
__device__ __forceinline__ int hw_tid(int wv) { return wv * 64 + hw_lane(); }
__device__ __forceinline__ float shl(float v, int src) { return __int_as_float(__builtin_amdgcn_ds_bpermute(src << 2, __float_as_int(v))); }
__device__ __forceinline__ float wave_sum(float v, int lane) {
#pragma unroll
    for (int o = 1; o < 64; o <<= 1) v += shl(v, lane ^ o);
    return v;
}
__device__ __forceinline__ float sigmoidf_(float x) { return 1.f / (1.f + expf(-x)); }
__device__ __forceinline__ float siluf_(float x) { return x / (1.f + expf(-x)); }
__device__ __forceinline__ float logsigmoidf_(float x) { return fminf(x, 0.f) - log1pf(expf(-fabsf(x))); }
__device__ __forceinline__ float gelu_tanh(float y) { return 0.5f * y * (1.f + tanhf(0.7978845608028654f * (y + 0.044715f * y * y * y))); }
__device__ __forceinline__ float fexp_neg(float x) { return __builtin_amdgcn_exp2f(-1.4426950408889634f * x); }
__device__ __forceinline__ float fsigmoid(float x) { return __builtin_amdgcn_rcpf(1.f + fexp_neg(x)); }
#define LDS_WAIT() asm volatile("s_waitcnt lgkmcnt(0)" ::: "memory")
#define VM_WAIT() asm volatile("s_waitcnt vmcnt(0)" ::: "memory")

struct Args { const float* in[33]; float* out; unsigned char* ws; };
__device__ __forceinline__ const float* inp(int i) {
    unsigned off = (unsigned)i * 8u; asm volatile("" : "+s"(off));
    typedef const float* cfp;
    return *(const __attribute__((address_space(4))) cfp*)((const __attribute__((address_space(4))) char*)__builtin_amdgcn_kernarg_segment_ptr() + off);
}

#define WSP(off) (inp_ws() + (off))
__device__ __forceinline__ unsigned char* inp_ws() { return (unsigned char*)inp(34); }
__device__ __forceinline__ float* inp_out() { return (float*)inp(33); }
constexpr size_t DU_WFI = 0, DU_WIN1 = 11u << 20, DU_S5M1 = 24u << 20, DU_S5M3 = 30u << 20, DU_WSM1 = 34u << 20;
__device__ __forceinline__ unsigned char* DUP(size_t off) { return (unsigned char*)inp_out() + (64u << 20) + off; }
__device__ __forceinline__ bf16_t* wp_win(int l) { return (bf16_t*)(l == 0 ? WSP(5u << 20) : DUP(DU_WIN1)); }
__device__ __forceinline__ bf16_t* wp_s5m1(int l) { return (bf16_t*)(l == 0 ? WSP(18u << 20) : DUP(DU_S5M1)); }
__device__ __forceinline__ bf16_t* wp_s5m3(int l) { return (bf16_t*)(l == 0 ? WSP(24u << 20) : DUP(DU_S5M3)); }
__device__ __forceinline__ bf16_t* wp_wsm(int l) { return (bf16_t*)(l == 0 ? WSP(29u << 20) : DUP(DU_WSM1)); }

namespace pg8 {
constexpr int BM = 256, BK = 64, HALF = 128, HTB = HALF * BK * 2, STAGE_BYTES = 8 * HTB, NXCD = 8, WGM = 8;
__host__ __device__ __forceinline__ int lds_byte(int r, int c) { const int st = (r >> 4) * 2 + (c >> 5), rr = r & 15, cc = c & 31, ob = rr * 64 + cc * 2; return st * 1024 + (ob ^ (((ob >> 9) & 1) << 5)); }
__host__ __device__ __forceinline__ void stage_rc(int b, int& R, int& C) { const int st = b / 1024, sb = b % 1024, swz = sb ^ (((sb >> 9) & 1) << 5); R = (st >> 1) * 16 + swz / 64; C = (st & 1) * 32 + (swz % 64) / 2; }
__host__ __device__ __forceinline__ int perm32(int rho) { const int n = rho >> 4, i = rho & 15; return 8 * (i >> 2) + 4 * n + (i & 3); }

struct Unit { int pm, pn, br; };
struct TileOrder {
    int nM, nN, nwg, G, c, nx;
    __device__ void init(int M_, int N_, int G_, int c_, int nx_ = NXCD) { nM = M_ / BM; nN = N_ / BM; nwg = nM * nN; G = G_; c = c_; nx = nx_; }
    __device__ bool tile(int i, int& pm, int& pn) const {
        const long L = (long)i * G + c; if (L >= nwg) return false;
        int wgid = (int)L; { const int q = nwg / nx, r = nwg % nx, xcd = wgid % nx, off = wgid / nx; wgid = (xcd < r ? xcd * (q + 1) : r * (q + 1) + (xcd - r) * q) + off; }
        const int nig = WGM * nN, gid = wgid / nig, fm = gid * WGM, gsz = (nM - fm) < WGM ? (nM - fm) : WGM;
        pm = fm + ((wgid % nig) % gsz); pn = (wgid % nig) / gsz; return true;
    }
};
struct PlainSched {
    TileOrder o; const bf16_t* A; int lda; const bf16_t* Bt; int K;
    __device__ bool next(int i, Unit& u) const { u.br = 0; return o.tile(i, u.pm, u.pn); }
    __device__ const char* Ap(const Unit& u) const { return (const char*)(A + (size_t)u.pm * BM * lda); }
    __device__ const char* Bp(const Unit& u) const { return (const char*)(Bt + (size_t)u.pn * BM * K); }
};
struct MergeSched {
    TileOrder o; const bf16_t* Zb; const bf16_t* Wp;
    __device__ bool next(int i, Unit& u) const { u.br = i % 3; return o.tile(i / 3, u.pm, u.pn); }
    __device__ const char* Ap(const Unit& u) const { const int col = u.br == 0 ? YGLA : (u.br == 1 ? YML : YS2); return (const char*)(Zb + (size_t)u.pm * BM * ZLD + col); }
    __device__ const char* Bp(const Unit& u) const { return (const char*)(Wp + (size_t)u.br * 1024 * 512 + (size_t)u.pn * BM * 512); }
};

__device__ __forceinline__ unsigned cvt_pk_bf16(float lo, float hi) { unsigned r; asm volatile("v_cvt_pk_bf16_f32 %0, %1, %2" : "=v"(r) : "v"(lo), "v"(hi)); return r; }

__device__ __forceinline__ void ring_stage_piece3(LAS unsigned char* ring, const bf16_t* xb, int ldx, int wid, int lane) {
#pragma unroll
    for (int i = 0; i < 2; ++i) {
        const int b = 3 * 16 + wid + 8 * i, r = 2 * b + (lane >> 5), cs = (lane & 31) ^ (r & 15);
        __builtin_amdgcn_global_load_lds((const unsigned*)(xb + (size_t)r * ldx + cs * 8), (LAS unsigned*)(ring + b * 1024), 16, 0, 0);
    }
}
__device__ __forceinline__ u32x4 ring_read(const LAS unsigned char* ring, int rt, int chunk) { return *(const LAS u32x4*)(ring + rt * 512 + ((chunk * 16) ^ ((rt & 15) * 16))); }
struct EpiStore {
    static constexpr bool PERM = true; static constexpr bool LDS_EPI = false;
    bf16_t* O; int ldc;
    int stagger = 0;
    int actmap = 0;
    int stagger_unused_ = 0;
    const float* gbias = nullptr;
    unsigned* waitp = nullptr; unsigned waitn = 0;
    __device__ __forceinline__ bool keep(const Unit&) const { return false; }
    __device__ __forceinline__ void operator()(f32x4 (&acc)[2][2][4][2], const Unit& u, int wr, int wc, int fr, int fq, LAS unsigned char* lds_) const {
        const int row0 = u.pm * BM + wr * 64 + fr, col0 = u.pn * BM + wc * 32 + 8 * fq;
        if (waitp) {
            unsigned spins = 0; while ((unsigned)__builtin_amdgcn_readfirstlane(__hip_atomic_load(waitp, __ATOMIC_RELAXED, __HIP_MEMORY_SCOPE_AGENT)) < waitn) { __builtin_amdgcn_s_sleep(8); if (++spins > (1u << 22)) break; }
        }
        const int am = actmap == 1 ? ((u.pn == GR / 256 || u.pn == GR / 256 + 1) ? 1 : ((u.pn == MO / 256 || u.pn == MO / 256 + 1) ? 2 : 0)) : 0;
#pragma unroll
        for (int ai = 0; ai < 2; ++ai)
#pragma unroll
            for (int m = 0; m < 4; ++m) { bf16_t* rowp = O + (size_t)(row0 + ai * HALF + m * 16) * ldc + col0;
#pragma unroll
                for (int bj = 0; bj < 2; ++bj) { f32x4 v0 = acc[ai][bj][m][0], v1 = acc[ai][bj][m][1];
                    if (actmap == 2) {
                        const f32x4 b0 = *(const f32x4*)(gbias + col0 + bj * HALF), b1 = *(const f32x4*)(gbias + col0 + bj * HALF + 4);
#pragma unroll
                        for (int e = 0; e < 4; ++e) { v0[e] = fmaxf(fsigmoid(v0[e] + b0[e]), 1e-30f); v1[e] = fmaxf(fsigmoid(v1[e] + b1[e]), 1e-30f); } }
                    if (am) {
#pragma unroll
                        for (int e = 0; e < 4; ++e) { const float s0 = fsigmoid(v0[e]), s1 = fsigmoid(v1[e]); v0[e] = am == 1 ? v0[e] * s0 : s0; v1[e] = am == 1 ? v1[e] * s1 : s1; } }
                    u32x4 w; w.x = cvt_pk_bf16(v0[0], v0[1]); w.y = cvt_pk_bf16(v0[2], v0[3]); w.z = cvt_pk_bf16(v1[0], v1[1]); w.w = cvt_pk_bf16(v1[2], v1[3]);
                    *(u32x4*)(rowp + bj * HALF) = w; } }
    }
};
struct EpiGlu {
    static constexpr bool PERM = true; static constexpr bool LDS_EPI = true;
    bf16_t* O; int ldc; const bf16_t* Asrc; int lda; const float* bias; LAS unsigned char* ring;
    int stagger = 0;
    __device__ __forceinline__ bool keep(const Unit&) const { return false; }
    __device__ __forceinline__ int ldx() const { return lda; }
    __device__ __forceinline__ const bf16_t* xbase(const Unit& u) const { return Asrc + (size_t)(u.pm * BM) * lda + u.pn * BM; }
    __device__ __forceinline__ void operator()(f32x4 (&acc)[2][2][4][2], const Unit& u, int wr, int wc, int fr, int fq, LAS unsigned char* lds_) const {
        const int row0 = u.pm * BM + wr * 64 + fr, col0 = u.pn * BM + wc * 32 + 8 * fq;
        ring_stage_piece3(ring, xbase(u), lda, wr * 4 + wc, fq * 16 + fr);
        f32x4 bv[2][2];
#pragma unroll
        for (int bj = 0; bj < 2; ++bj)
#pragma unroll
            for (int n = 0; n < 2; ++n) bv[bj][n] = *(const f32x4*)(bias + col0 + bj * HALF + 4 * n);
        asm volatile("s_waitcnt vmcnt(0)" ::: "memory"); __builtin_amdgcn_s_barrier(); asm volatile("" ::: "memory");
#pragma unroll
        for (int ai = 0; ai < 2; ++ai)
#pragma unroll
            for (int m = 0; m < 4; ++m) { const int rt = ai * HALF + wr * 64 + m * 16 + fr; const size_t r = (size_t)(row0 + ai * HALF + m * 16);
#pragma unroll
                for (int bj = 0; bj < 2; ++bj) {
                    const u32x4 a = ring_read(ring, rt, wc * 4 + fq + bj * 16);
                    const f32x4 v0 = acc[ai][bj][m][0] + bv[bj][0], v1 = acc[ai][bj][m][1] + bv[bj][1];
                    u32x4 w;
                    w.x = cvt_pk_bf16(bflo(a.x) * fsigmoid(v0[0]), bfhi(a.x) * fsigmoid(v0[1])); w.y = cvt_pk_bf16(bflo(a.y) * fsigmoid(v0[2]), bfhi(a.y) * fsigmoid(v0[3]));
                    w.z = cvt_pk_bf16(bflo(a.z) * fsigmoid(v1[0]), bfhi(a.z) * fsigmoid(v1[1])); w.w = cvt_pk_bf16(bflo(a.w) * fsigmoid(v1[2]), bfhi(a.w) * fsigmoid(v1[3]));
                    *(u32x4*)(O + r * ldc + col0 + bj * HALF) = w; } }
        asm volatile("s_waitcnt lgkmcnt(0)" ::: "memory"); __builtin_amdgcn_s_barrier(); asm volatile("" ::: "memory");
    }
};
struct EpiSwiGlu {
    static constexpr bool PERM = true; static constexpr bool LDS_EPI = false;
    bf16_t* O; int ldc;
    int stagger = 0;
    __device__ __forceinline__ bool keep(const Unit&) const { return false; }
    __device__ __forceinline__ void operator()(f32x4 (&acc)[2][2][4][2], const Unit& u, int wr, int wc, int fr, int fq, LAS unsigned char* lds_) const {
        const int row0 = u.pm * BM + wr * 64 + fr, col0 = u.pn * HALF + wc * 32 + 8 * fq;
#pragma unroll
        for (int ai = 0; ai < 2; ++ai)
#pragma unroll
            for (int m = 0; m < 4; ++m) {
                float o[8];
#pragma unroll
                for (int n = 0; n < 2; ++n)
#pragma unroll
                    for (int e = 0; e < 4; ++e) { const float g = acc[ai][0][m][n][e], up = acc[ai][1][m][n][e]; o[n * 4 + e] = g * fsigmoid(g) * up; }
                u32x4 w; w.x = cvt_pk_bf16(o[0], o[1]); w.y = cvt_pk_bf16(o[2], o[3]); w.z = cvt_pk_bf16(o[4], o[5]); w.w = cvt_pk_bf16(o[6], o[7]);
                *(u32x4*)(O + (size_t)(row0 + ai * HALF + m * 16) * ldc + col0) = w; }
    }
};
struct EpiMerge {
    static constexpr bool PERM = true; static constexpr bool LDS_EPI = false;
    bf16_t* O; int ldc; const bf16_t* Zg; int ldz; const float* bgb;
    int stagger = 0;
    __device__ __forceinline__ bool keep(const Unit& u) const { return u.br < 2; }
    __device__ __forceinline__ void operator()(f32x4 (&acc)[2][2][4][2], const Unit& u, int wr, int wc, int fr, int fq, LAS unsigned char* lds_) const {
        const int row0 = u.pm * BM + wr * 64 + fr, col0 = u.pn * BM + wc * 32 + 8 * fq;
        const int br = u.br, brn = br < 2 ? br + 1 : 2;
#pragma unroll
        for (int bj = 0; bj < 2; ++bj) {
#pragma unroll
            for (int ai = 0; ai < 2; ++ai)
#pragma unroll
                for (int m = 0; m < 4; ++m) { const size_t r = (size_t)(row0 + ai * HALF + m * 16);
                    const u32x4 za = *(const u32x4*)(Zg + r * ldz + br * 1024 + col0 + bj * HALF);
                    const u32x4 zb = *(const u32x4*)(Zg + r * ldz + brn * 1024 + col0 + bj * HALF);
                    const float xa[8] = {bflo(za.x), bfhi(za.x), bflo(za.y), bfhi(za.y), bflo(za.z), bfhi(za.z), bflo(za.w), bfhi(za.w)};
                    const float xb[8] = {bflo(zb.x), bfhi(zb.x), bflo(zb.y), bfhi(zb.y), bflo(zb.z), bfhi(zb.z), bflo(zb.w), bfhi(zb.w)};
                    float f[8];
#pragma unroll
                    for (int e = 0; e < 8; ++e) f[e] = br < 2 ? xa[e] * __builtin_amdgcn_rcpf(xb[e]) : xa[e];
                    f32x4 v0 = acc[ai][bj][m][0], v1 = acc[ai][bj][m][1];
                    v0[0] *= f[0]; v0[1] *= f[1]; v0[2] *= f[2]; v0[3] *= f[3]; v1[0] *= f[4]; v1[1] *= f[5]; v1[2] *= f[6]; v1[3] *= f[7];
                    if (br < 2) { acc[ai][bj][m][0] = v0; acc[ai][bj][m][1] = v1; }
                    else { u32x4 w; w.x = cvt_pk_bf16(v0[0], v0[1]); w.y = cvt_pk_bf16(v0[2], v0[3]); w.z = cvt_pk_bf16(v1[0], v1[1]); w.w = cvt_pk_bf16(v1[2], v1[3]);
                        *(u32x4*)(O + r * ldc + col0 + bj * HALF) = w; } }
        }
    }
};


typedef float f32x2v __attribute__((ext_vector_type(2)));
struct RowStats {
    unsigned long long* slots;
    unsigned* cnt;
    __device__ __forceinline__ void run(const Unit& u, int wid, int lane, LAS unsigned char* lt) const {
        const LAS f32x4* P = (const LAS f32x4*)lt; LAS f32x2v* S = (LAS f32x2v*)(lt + 16384);
        asm volatile("s_waitcnt lgkmcnt(0)" ::: "memory"); __builtin_amdgcn_s_barrier(); asm volatile("" ::: "memory");
        const int row = wid * 32 + (lane & 31);
        if (lane < 32) {
            const f32x4 p = (P[row * 4 + 0] + P[row * 4 + 1]) + (P[row * 4 + 2] + P[row * 4 + 3]);
            unsigned long long* sl = slots + ((size_t)(u.pm * BM + row) * 4 + u.pn) * 2;
            __hip_atomic_store(sl, ((unsigned long long)__float_as_uint(p[1]) << 32) | __float_as_uint(p[0]), __ATOMIC_RELAXED, __HIP_MEMORY_SCOPE_AGENT);
            __hip_atomic_store(sl + 1, ((unsigned long long)__float_as_uint(p[3]) << 32) | __float_as_uint(p[2]), __ATOMIC_RELAXED, __HIP_MEMORY_SCOPE_AGENT);
        }
        asm volatile("s_waitcnt vmcnt(0)" ::: "memory");
        if (lane == 0) __hip_atomic_fetch_add(cnt + 16 * u.pm, 1u, __ATOMIC_RELAXED, __HIP_MEMORY_SCOPE_AGENT);
        if (wid == 0) {
            unsigned spins = 0;
            while ((unsigned)__builtin_amdgcn_readfirstlane(__hip_atomic_load(cnt + 16 * u.pm, __ATOMIC_RELAXED, __HIP_MEMORY_SCOPE_AGENT)) < 32u) { __builtin_amdgcn_s_sleep(1); if (++spins > (1u << 22)) break; }
            __builtin_amdgcn_fence(__ATOMIC_ACQUIRE, "agent");
        }
        asm volatile("s_waitcnt vmcnt(0) lgkmcnt(0)" ::: "memory"); __builtin_amdgcn_s_barrier(); asm volatile("" ::: "memory");
        if (lane < 32) {
            const unsigned long long* sl = slots + (size_t)(u.pm * BM + row) * 8; float s0 = 0.f, s1 = 0.f, s2 = 0.f, s3 = 0.f;
#pragma unroll
            for (int k = 0; k < 4; ++k) { const unsigned long long a = __hip_atomic_load(sl + 2 * k, __ATOMIC_RELAXED, __HIP_MEMORY_SCOPE_AGENT), b = __hip_atomic_load(sl + 2 * k + 1, __ATOMIC_RELAXED, __HIP_MEMORY_SCOPE_AGENT);
                s0 += __uint_as_float((unsigned)a); s1 += __uint_as_float((unsigned)(a >> 32)); s2 += __uint_as_float((unsigned)b); s3 += __uint_as_float((unsigned)(b >> 32)); }
            const float r1 = rsqrtf(s0 * (1.f / 1024.f) + 1e-6f);
            const float r2 = rsqrtf(fmaxf(s1 + r1 * (s2 + s2 + r1 * s3), 0.f) * (1.f / 1024.f) + 1e-6f);
            S[row] = (f32x2v){r1, r2};
        }
        asm volatile("s_waitcnt lgkmcnt(0)" ::: "memory"); __builtin_amdgcn_s_barrier(); asm volatile("" ::: "memory");
    }
};
template <int PHASE, bool FINAL>
struct EpiNorm {
    static constexpr bool PERM = true; static constexpr bool LDS_EPI = true;
    int l; LAS unsigned char* lt;
    int stagger = 0;
    __device__ __forceinline__ bool keep(const Unit&) const { return false; }
    __device__ __forceinline__ const float* modl() const { return (const float*)WSP(WS_MOD) + (size_t)l * 8 * 6144; }
    __device__ __forceinline__ int ldx() const { return PHASE == 0 ? D : ZLD; }
    __device__ __forceinline__ const bf16_t* xbase(const Unit& u) const {
        return PHASE == 0 ? (const bf16_t*)inp_out() + (size_t)(u.pm * BM) * D + u.pn * BM : (const bf16_t*)WSP(WS_Z) + (size_t)(u.pm * BM) * ZLD + XZ + u.pn * BM; }
    __device__ __forceinline__ void operator()(f32x4 (&acc)[2][2][4][2], const Unit& u, int wr, int wc, int fr, int fq, LAS unsigned char* lds_) const {
        const int bofs = (u.pm >> 4) * 6144;
        const int colw = u.pn * BM + wc * 32 + 8 * fq;
        const int lane = fq * 16 + fr, wid = wr * 4 + wc;
        LAS unsigned char* ring = lt - LT_OFF;
        {
            const bf16_t* xb = xbase(u); const int ldx_ = ldx();
#pragma unroll
            for (int i = 0; i < 2; ++i) {
                const int b = 3 * 16 + wid + 8 * i, r = 2 * b + (lane >> 5), cs = (lane & 31) ^ (r & 15);
                __builtin_amdgcn_global_load_lds((const unsigned*)(xb + (size_t)r * ldx_ + cs * 8), (LAS unsigned*)(ring + b * 1024), 16, 0, 0);
            }
        }
        f32x4 c1[2][2];
        { const float* pw = inp(PHASE == 0 ? 5 : 7) + l * D + colw; const float* gt = modl() + (PHASE == 0 ? 2048 : 5120) + bofs + colw;
#pragma unroll
          for (int bj = 0; bj < 2; ++bj)
#pragma unroll
            for (int n = 0; n < 2; ++n) { const f32x4 p = *(const f32x4*)(pw + bj * HALF + 4 * n), g = *(const f32x4*)(gt + bj * HALF + 4 * n); c1[bj][n] = (1.f + g) * p; } }
        asm volatile("s_waitcnt vmcnt(0)" ::: "memory"); __builtin_amdgcn_s_barrier(); asm volatile("" ::: "memory");
        const int xc0 = (wc * 4 + fq) * 16;
        {
            LAS f32x4* P = (LAS f32x4*)lt;
#pragma unroll
            for (int ai = 0; ai < 2; ++ai)
#pragma unroll
                for (int m = 0; m < 4; ++m) {
                    const int rt = ai * HALF + wr * 64 + m * 16 + fr;
                    float s0 = 0.f, s1 = 0.f, s2 = 0.f, s3 = 0.f;
#pragma unroll
                    for (int bj = 0; bj < 2; ++bj) {
                        u32x4 xw = {0u, 0u, 0u, 0u};
                        if (!FINAL) xw = *(const LAS u32x4*)(ring + rt * 512 + ((xc0 + bj * 256) ^ (fr * 16)));
#pragma unroll
                        for (int n = 0; n < 2; ++n) { const f32x4 y = acc[ai][bj][m][n], t = c1[bj][n] * y; acc[ai][bj][m][n] = t;
                            if (!FINAL) { const unsigned q0 = n == 0 ? xw.x : xw.z, q1 = n == 0 ? xw.y : xw.w; const f32x4 x = (f32x4){bflo(q0), bfhi(q0), bflo(q1), bfhi(q1)};
#pragma unroll
                                for (int e = 0; e < 4; ++e) { s0 += y[e] * y[e]; s1 += x[e] * x[e]; s2 += x[e] * t[e]; s3 += t[e] * t[e]; } }
                            else {
#pragma unroll
                                for (int e = 0; e < 4; ++e) s0 += y[e] * y[e]; } }
                    }
                    s0 += shl(s0, lane ^ 16); s0 += shl(s0, lane ^ 32);
                    if (!FINAL) { s1 += shl(s1, lane ^ 16); s1 += shl(s1, lane ^ 32); s2 += shl(s2, lane ^ 16); s2 += shl(s2, lane ^ 32); s3 += shl(s3, lane ^ 16); s3 += shl(s3, lane ^ 32); }
                    if (fq == 0) P[rt * 4 + wc] = (f32x4){s0, s1, s2, s3};
                }
        }
        { RowStats st{(unsigned long long*)WSP(WS_SLOT), (unsigned*)WSP(WS_CTL) + CW_PANEL + (2 * l + PHASE) * 2048}; st.run(u, wid, lane, lt); }
        {
            const LAS f32x2v* S = (const LAS f32x2v*)(lt + 16384);
#pragma unroll
            for (int bj = 0; bj < 2; ++bj) {
                const int col = colw + bj * HALF;
                f32x4 c2[2], hv[2];
                if (!FINAL) {
                    const float* w2 = (PHASE == 0 ? inp(6) + l * D : inp(4) + (l + 1) * D) + col;
                    const float* sc = modl() + (PHASE == 0 ? 4096 : 8 * 6144 + 1024) + bofs + col; const float* sh = modl() + (PHASE == 0 ? 3072 : 8 * 6144) + bofs + col;
#pragma unroll
                    for (int n = 0; n < 2; ++n) { const f32x4 w = *(const f32x4*)(w2 + 4 * n), c = *(const f32x4*)(sc + 4 * n); c2[n] = w * (1.f + c); hv[n] = *(const f32x4*)(sh + 4 * n); }
                }
#pragma unroll
                for (int ai = 0; ai < 2; ++ai)
#pragma unroll
                    for (int m = 0; m < 4; ++m) {
                        const int rt = ai * HALF + wr * 64 + m * 16 + fr; const size_t R = (size_t)(u.pm * BM + rt); const f32x2v r = S[rt];
                        const u32x4 xw = *(const LAS u32x4*)(ring + rt * 512 + ((xc0 + bj * 256) ^ (fr * 16)));
                        const float x[8] = {bflo(xw.x), bfhi(xw.x), bflo(xw.y), bfhi(xw.y), bflo(xw.z), bfhi(xw.z), bflo(xw.w), bfhi(xw.w)};
                        f32x4 v0 = acc[ai][bj][m][0], v1 = acc[ai][bj][m][1];
#pragma unroll
                        for (int e = 0; e < 4; ++e) { v0[e] = x[e] + r.x * v0[e]; v1[e] = x[4 + e] + r.x * v1[e]; }
                        if (FINAL) { float* op = inp_out() + R * D + col; *(f32x4*)op = v0; *(f32x4*)(op + 4) = v1; }
                        else {
                            u32x4 w; w.x = cvt_pk_bf16(v0[0], v0[1]); w.y = cvt_pk_bf16(v0[2], v0[3]); w.z = cvt_pk_bf16(v1[0], v1[1]); w.w = cvt_pk_bf16(v1[2], v1[3]);
                            *(u32x4*)(PHASE == 0 ? (bf16_t*)WSP(WS_Z) + R * ZLD + XZ + col : (bf16_t*)inp_out() + R * D + col) = w;
                            const f32x4 a0 = (f32x4){bflo(w.x), bfhi(w.x), bflo(w.y), bfhi(w.y)}, a1 = (f32x4){bflo(w.z), bfhi(w.z), bflo(w.w), bfhi(w.w)};
                            const f32x4 o0 = a0 * r.y * c2[0] + hv[0], o1 = a1 * r.y * c2[1] + hv[1];
                            u32x4 h; h.x = cvt_pk_bf16(o0[0], o0[1]); h.y = cvt_pk_bf16(o0[2], o0[3]); h.z = cvt_pk_bf16(o1[0], o1[1]); h.w = cvt_pk_bf16(o1[2], o1[3]);
                            *(u32x4*)((bf16_t*)WSP(WS_H) + R * D + col) = h;
                        }
                    }
            }
        }
        asm volatile("s_waitcnt lgkmcnt(0)" ::: "memory"); __builtin_amdgcn_s_barrier(); asm volatile("" ::: "memory");
    }
};

struct S5aSched {
    int G, c; const bf16_t* Zb; const bf16_t* Bt1;
    __device__ bool next(int i, Unit& u) const { const int L = i * G + c; if (L >= 512) return false; u.pn = L < 256 ? 1 : 0; u.br = (L & 255) >> 3; u.pm = L & 7; return true; }
    __device__ const char* Ap(const Unit& u) const { return (const char*)(Zb + (size_t)u.pm * T * ZLD + SU + 16 * u.br); }
    __device__ const char* Bp(const Unit& u) const { return (const char*)(Bt1 + ((size_t)u.br * 384 + (size_t)u.pn * 256) * 256); }
};
struct EpiS5a {
    static constexpr bool PERM = true; static constexpr bool THROTTLE = false; static constexpr bool LDS_EPI = false;
    int l;
    int stagger = 0;
    __device__ __forceinline__ bool keep(const Unit&) const { return false; }
    __device__ __forceinline__ void operator()(f32x4 (&acc)[2][2][4][2], const Unit& u, int wr, int wc, int fr, int fq, LAS unsigned char* lds_) const {
        bf16_t* Zb = (bf16_t*)WSP(WS_Z); LAS unsigned char* ring = lds_;
        const int rowbase = (u.br & 15) * 2048 + u.pm * 256 + wr * 64 + fr, colsub = wc * 32 + 8 * fq, hoff = (u.br >> 4) * 256;
        if (u.pn == 0) {
            asm volatile("s_waitcnt vmcnt(0)" ::: "memory"); __builtin_amdgcn_s_barrier(); asm volatile("" ::: "memory");
#pragma unroll
            for (int ai = 0; ai < 2; ++ai)
#pragma unroll
                for (int m = 0; m < 4; ++m) {
                    const int n = ai * HALF + wr * 64 + m * 16 + fr;
                    LAS unsigned char* rowp = ring + n * 512;
                    *(LAS f32x4*)(rowp + (((colsub >> 2) ^ (n & 15)) * 16)) = acc[ai][0][m][0];
                    *(LAS f32x4*)(rowp + ((((colsub >> 2) + 1) ^ (n & 15)) * 16)) = acc[ai][0][m][1];
                    const f32x4 v0 = acc[ai][1][m][0], v1 = acc[ai][1][m][1];
                    u32x4 w; w.x = cvt_pk_bf16(v0[0], v0[1]); w.y = cvt_pk_bf16(v0[2], v0[3]); w.z = cvt_pk_bf16(v1[0], v1[1]); w.w = cvt_pk_bf16(v1[2], v1[3]);
                    *(u32x4*)(Zb + (size_t)(rowbase + ai * HALF + m * 16) * ZLD + hoff + YPC + colsub) = w;
                    asm volatile("" ::: "memory");
                }
        } else {
#pragma unroll
            for (int ai = 0; ai < 2; ++ai)
#pragma unroll
                for (int m = 0; m < 4; ++m) { bf16_t* zrow = Zb + (size_t)(rowbase + ai * HALF + m * 16) * ZLD + hoff;
                    const f32x4 v0 = acc[ai][0][m][0], v1 = acc[ai][0][m][1];
                    u32x4 w; w.x = cvt_pk_bf16(v0[0], v0[1]); w.y = cvt_pk_bf16(v0[2], v0[3]); w.z = cvt_pk_bf16(v1[0], v1[1]); w.w = cvt_pk_bf16(v1[2], v1[3]);
                    *(u32x4*)(zrow + YPC + 128 + colsub) = w; }
        }
    }
};
struct S5bSched {
    int G, c; const bf16_t* X; const bf16_t* Bt3;
    __device__ bool next(int i, Unit& u) const { const int L = i * G + c; if (L >= 256) return false; u.br = L >> 3; u.pm = L & 7; u.pn = 0; return true; }
    __device__ const char* Ap(const Unit& u) const { return (const char*)(X + (size_t)((u.br & 15) * 2048 + u.pm * 256) * ZLD + EXC + (u.br >> 4) * 128); }
    __device__ const char* Bp(const Unit& u) const { return (const char*)(Bt3 + (size_t)u.br * 256 * 128); }
};
struct EpiS5b {
    static constexpr bool PERM = true; static constexpr bool LDS_EPI = true;
    bf16_t* Zb; const float* dsk; LAS unsigned char* ring;
    int stagger = 0;
    __device__ __forceinline__ bool keep(const Unit&) const { return false; }
    __device__ __forceinline__ int ldx() const { return ZLD; }
    __device__ __forceinline__ const bf16_t* xbase(const Unit& u) const { return Zb + (size_t)((u.br & 15) * 2048 + u.pm * 256) * ZLD + YPC + (u.br >> 4) * 256; }
    __device__ __forceinline__ void operator()(f32x4 (&acc)[2][2][4][2], const Unit& u, int wr, int wc, int fr, int fq, LAS unsigned char* lds_) const {
        const int g = u.br, b = u.pm;
        ring_stage_piece3(ring, xbase(u), ZLD, wr * 4 + wc, fq * 16 + fr);
        asm volatile("s_waitcnt vmcnt(0)" ::: "memory"); __builtin_amdgcn_s_barrier(); asm volatile("" ::: "memory");
#pragma unroll
        for (int bj = 0; bj < 2; ++bj) {
            const int j0 = bj * HALF + wc * 32 + 8 * fq, s = j0 >> 4, c0 = j0 & 15;
            const f32x4 d0 = *(const f32x4*)(dsk + 16 * g + c0), d1 = *(const f32x4*)(dsk + 16 * g + c0 + 4);
#pragma unroll
            for (int ai = 0; ai < 2; ++ai)
#pragma unroll
                for (int m = 0; m < 4; ++m) {
                    const int n = ai * HALF + wr * 64 + m * 16 + fr;
                    const u32x4 yp = ring_read(ring, n, wc * 4 + fq + bj * 16);
                    bf16_t* zp = Zb + ((size_t)b * T + 16 * n + s) * ZLD + SU + 16 * g + c0;
                    const u32x4 uu = *(const u32x4*)zp;
                    const f32x4 a0 = acc[ai][bj][m][0], a1 = acc[ai][bj][m][1];
                    float y[8];
                    y[0] = a0[0] + bflo(yp.x) + d0[0] * bflo(uu.x); y[1] = a0[1] + bfhi(yp.x) + d0[1] * bfhi(uu.x);
                    y[2] = a0[2] + bflo(yp.y) + d0[2] * bflo(uu.y); y[3] = a0[3] + bfhi(yp.y) + d0[3] * bfhi(uu.y);
                    y[4] = a1[0] + bflo(yp.z) + d1[0] * bflo(uu.z); y[5] = a1[1] + bfhi(yp.z) + d1[1] * bfhi(uu.z);
                    y[6] = a1[2] + bflo(yp.w) + d1[2] * bflo(uu.w); y[7] = a1[3] + bfhi(yp.w) + d1[3] * bfhi(uu.w);
#pragma unroll
                    for (int e = 0; e < 8; ++e) { const float v = y[e]; y[e] = v * fsigmoid(1.5957691216057308f * (v + 0.044715f * v * v * v)); }
                    u32x4 w; w.x = cvt_pk_bf16(y[0], y[1]); w.y = cvt_pk_bf16(y[2], y[3]); w.z = cvt_pk_bf16(y[4], y[5]); w.w = cvt_pk_bf16(y[6], y[7]);
                    *(u32x4*)zp = w;
                    if ((m & 3) == 3) asm volatile("" ::: "memory");
                }
        }
        asm volatile("s_waitcnt lgkmcnt(0)" ::: "memory"); __builtin_amdgcn_s_barrier(); asm volatile("" ::: "memory");
    }
};
template <class Epi> __device__ __forceinline__ int epi_ldx(const Epi& E) { if constexpr (Epi::LDS_EPI) return E.ldx(); else return 0; }
template <class Epi> __device__ __forceinline__ const void* epi_xbase(const Epi& E, const Unit& u) { if constexpr (Epi::LDS_EPI) return E.xbase(u); else return nullptr; }
template <class Epi, class Sched, bool ALIGN_EPI, bool SP2, int AMODE = 0>
__device__ __forceinline__ void gemm_phase(LAS unsigned char* lds, const int wv, const int lda, const int K, const Sched& S, const Epi& E) {
    int tid_ = hw_tid(wv); asm volatile("" : "+v"(tid_));
    const int tid = tid_, wid = __builtin_amdgcn_readfirstlane(tid >> 6), lane = tid & 63, wr = wid >> 2, wc = wid & 3, fr = lane & 15, fq = lane >> 4;
    const int nt = K / BK;
    unsigned voffA[2], voffB[2];
#pragma unroll
    for (int i = 0; i < 2; ++i) { int R, C; stage_rc(tid * 16 + i * 8192, R, C); const int Rb = Epi::PERM ? ((R & ~31) + perm32(R & 31)) : R;
        voffA[i] = AMODE == 0 ? (unsigned)(R * lda + C) * 2u : (unsigned)((16 * R + (C >> 4)) * ZLD + (C & 15)) * 2u; voffB[i] = (unsigned)(Rb * K + C) * 2u; }
    const size_t kstep = (size_t)(BK * 2);
    const size_t kstepA = AMODE == 0 ? (size_t)(BK * 2) : (size_t)4 * ZLD * 2;
    const size_t hA = AMODE == 0 ? (size_t)HALF * lda * 2 : (size_t)HALF * 16 * ZLD * 2, hB = (size_t)HALF * K * 2;
    const unsigned ldsw = (unsigned)wid * 1024u;
    const int aoff = lds_byte(wr * 64 + fr, fq * 8), boff = lds_byte(wc * 32 + fr, fq * 8);
#define PG8_SA(b, h) (((b) * 2 + (h)) * HTB)
#define PG8_SB(b, h) ((4 + (b) * 2 + (h)) * HTB)
#define PG8_STAGE(bufoff, gbase, voff) do { _Pragma("unroll") for (int _i = 0; _i < 2; ++_i) \
        __builtin_amdgcn_global_load_lds((const unsigned*)((const char*)(gbase) + (voff)[_i]), (LAS unsigned*)(lds + (bufoff) + ldsw + _i * 8192), 16, 0, 0); } while (0)
#define PG8_STAGE_N(bufoff, gbase, voff) do { if (Epi::LDS_EPI && last) { \
        const int s_ = (bufoff) / HTB; const int ln_ = hw_lane(); const int ldx_ = epi_ldx(E); const char* xb_ = (const char*)epi_xbase(E, cur) + (size_t)(32 * s_) * ldx_ * 2; \
        _Pragma("unroll") for (int _i = 0; _i < 2; ++_i) { const int rl_ = 2 * (wid + 8 * _i) + (ln_ >> 5); const unsigned vo_ = (unsigned)(rl_ * ldx_ + (((ln_ & 31) ^ (rl_ & 15)) * 8)) * 2u; \
            __builtin_amdgcn_global_load_lds((const unsigned*)(xb_ + vo_), (LAS unsigned*)(lds + (bufoff) + ldsw + _i * 8192), 16, 0, 0); } \
    } else PG8_STAGE(bufoff, gbase, voff); } while (0)
#define PG8_LDA(dst, b, h) do { _Pragma("unroll") for (int m = 0; m < 4; ++m) _Pragma("unroll") for (int k = 0; k < 2; ++k) dst[m][k] = *(const LAS bf16x8*)(lds + PG8_SA(b, h) + aoff + m * 2048 + k * 1024); } while (0)
#define PG8_LDB(dst, b, h) do { _Pragma("unroll") for (int n = 0; n < 2; ++n) _Pragma("unroll") for (int k = 0; k < 2; ++k) dst[n][k] = *(const LAS bf16x8*)(lds + PG8_SB(b, h) + boff + n * 2048 + k * 1024); } while (0)
#define PG8_MMA(ai, bj, At, Bt) do { __builtin_amdgcn_s_setprio(1); _Pragma("unroll") for (int m = 0; m < 4; ++m) _Pragma("unroll") for (int n = 0; n < 2; ++n) _Pragma("unroll") for (int k = 0; k < 2; ++k) \
        acc[ai][bj][m][n] = __builtin_amdgcn_mfma_f32_16x16x32_bf16(Bt[n][k], At[m][k], acc[ai][bj][m][n], 0, 0, 0); __builtin_amdgcn_s_setprio(0); } while (0)
#define PG8_WAIT_V(n) asm volatile("s_waitcnt vmcnt(" #n ")" ::: "memory")
#define PG8_WAIT_L(n) asm volatile("s_waitcnt lgkmcnt(" #n ")" ::: "memory")
#define PG8_BAR __builtin_amdgcn_s_barrier()
#define PG8_SCHED __builtin_amdgcn_sched_barrier(0)
    Unit cur, nxt; int ui = 0;
    if (!S.next(0, cur)) return;
    if (E.stagger > 0) {
        const unsigned long long t0 = __builtin_amdgcn_s_memrealtime(), tgt = t0 + (unsigned long long)(((blockIdx.x >> 3) & 3) * E.stagger);
        while (__builtin_amdgcn_s_memrealtime() < tgt) __builtin_amdgcn_s_sleep(8);
    }
    f32x4 acc[2][2][4][2];
#pragma unroll
    for (int a = 0; a < 2; ++a)
#pragma unroll
        for (int b = 0; b < 2; ++b)
#pragma unroll
            for (int m = 0; m < 4; ++m)
#pragma unroll
                for (int n = 0; n < 2; ++n) acc[a][b][m][n] = (f32x4){0.f, 0.f, 0.f, 0.f};
    bf16x8 At[4][2], B0[2][2], B1[2][2];
    const char* cA = S.Ap(cur); const char* cB = S.Bp(cur);
#define PG8_PROLOGUE() do { \
    if constexpr (SP2) { \
        PG8_STAGE(PG8_SB(0, 0), cB, voffB); PG8_STAGE(PG8_SB(0, 1), cB + hB, voffB); PG8_STAGE(PG8_SA(0, 0), cA, voffA); PG8_STAGE(PG8_SA(0, 1), cA + hA, voffA); \
        if (wr == 1) PG8_BAR; \
        PG8_WAIT_V(2); PG8_BAR; \
        PG8_STAGE(PG8_SB(1, 0), cB + kstep, voffB); PG8_STAGE(PG8_SA(1, 0), cA + kstepA, voffA); PG8_STAGE(PG8_SB(1, 1), cB + hB + kstep, voffB); \
        PG8_WAIT_V(6); PG8_BAR; \
    } else { \
        PG8_STAGE(PG8_SB(0, 0), cB, voffB); PG8_STAGE(PG8_SA(0, 0), cA, voffA); PG8_STAGE(PG8_SB(0, 1), cB + hB, voffB); PG8_STAGE(PG8_SA(0, 1), cA + hA, voffA); \
        if (wr == 1) PG8_BAR; \
        PG8_WAIT_V(4); PG8_BAR; \
        PG8_STAGE(PG8_SB(1, 0), cB + kstep, voffB); PG8_STAGE(PG8_SA(1, 0), cA + kstepA, voffA); PG8_STAGE(PG8_SB(1, 1), cB + hB + kstep, voffB); \
        PG8_WAIT_V(6); PG8_BAR; \
    } } while (0)
    PG8_PROLOGUE();
    for (;;) {
        const bool has_next = S.next(ui + 1, nxt);
        const char* nA = has_next ? S.Ap(nxt) : cA; const char* nB = has_next ? S.Bp(nxt) : cB;
        for (int t = 0; t < nt; t += 2) {
            const bool last = (t == nt - 2);
            const char* a1 = cA + (size_t)(t + 1) * kstepA;
            const char* a2 = last ? nA : cA + (size_t)(t + 2) * kstepA; const char* b2 = last ? nB : cB + (size_t)(t + 2) * kstep;
            const char* a3 = a2 + kstepA; const char* b3 = b2 + kstep;
            if constexpr (SP2) {
            PG8_LDB(B0, 0, 0); PG8_LDB(B1, 0, 1); PG8_SCHED; PG8_LDA(At, 0, 0); PG8_STAGE(PG8_SA(1, 1), a1 + hA, voffA);
            PG8_WAIT_V(8); PG8_WAIT_L(0); PG8_BAR; PG8_MMA(0, 0, At, B0); PG8_MMA(0, 1, At, B1); PG8_BAR; PG8_SCHED;
            PG8_LDA(At, 0, 1); PG8_STAGE_N(PG8_SB(0, 0), b2, voffB); PG8_STAGE_N(PG8_SB(0, 1), b2 + hB, voffB); PG8_STAGE_N(PG8_SA(0, 0), a2, voffA);
            PG8_WAIT_V(8); PG8_WAIT_L(0); PG8_BAR; PG8_MMA(1, 0, At, B0); PG8_MMA(1, 1, At, B1); PG8_BAR; PG8_SCHED;
            PG8_LDB(B0, 1, 0); PG8_LDB(B1, 1, 1); PG8_SCHED; PG8_LDA(At, 1, 0); PG8_STAGE_N(PG8_SA(0, 1), a2 + hA, voffA);
            PG8_WAIT_V(8); PG8_WAIT_L(0); PG8_BAR; PG8_MMA(0, 0, At, B0); PG8_MMA(0, 1, At, B1); PG8_BAR; PG8_SCHED;
            PG8_LDA(At, 1, 1); PG8_STAGE_N(PG8_SB(1, 0), b3, voffB); PG8_STAGE_N(PG8_SB(1, 1), b3 + hB, voffB); PG8_STAGE_N(PG8_SA(1, 0), a3, voffA);
            PG8_WAIT_V(8); PG8_WAIT_L(0); PG8_BAR; PG8_MMA(1, 0, At, B0); PG8_MMA(1, 1, At, B1); PG8_BAR; PG8_SCHED;
            } else {
            PG8_LDB(B0, 0, 0); PG8_SCHED; PG8_LDA(At, 0, 0); PG8_STAGE(PG8_SA(1, 1), a1 + hA, voffA);
            PG8_WAIT_L(8); PG8_BAR; PG8_WAIT_L(0); PG8_MMA(0, 0, At, B0); PG8_BAR; PG8_SCHED;
            PG8_LDB(B1, 0, 1); PG8_STAGE(PG8_SB(0, 0), b2, voffB);
            PG8_BAR; PG8_WAIT_L(0); PG8_MMA(0, 1, At, B1); PG8_BAR;
            PG8_LDA(At, 0, 1); PG8_STAGE(PG8_SA(0, 0), a2, voffA);
            PG8_BAR; PG8_WAIT_L(0); PG8_MMA(1, 0, At, B0); PG8_BAR; PG8_SCHED;
            PG8_STAGE(PG8_SB(0, 1), b2 + hB, voffB);
            PG8_WAIT_V(6); PG8_BAR; PG8_MMA(1, 1, At, B1); PG8_BAR;
            PG8_LDB(B0, 1, 0); PG8_SCHED; PG8_LDA(At, 1, 0); PG8_STAGE(PG8_SA(0, 1), a2 + hA, voffA);
            PG8_WAIT_L(8); PG8_BAR; PG8_WAIT_L(0); PG8_MMA(0, 0, At, B0); PG8_BAR; PG8_SCHED;
            PG8_LDB(B1, 1, 1); PG8_STAGE(PG8_SB(1, 0), b3, voffB);
            PG8_BAR; PG8_WAIT_L(0); PG8_MMA(0, 1, At, B1); PG8_BAR;
            PG8_LDA(At, 1, 1); PG8_STAGE(PG8_SA(1, 0), a3, voffA);
            PG8_BAR; PG8_WAIT_L(0); PG8_MMA(1, 0, At, B0); PG8_BAR; PG8_SCHED;
            PG8_STAGE(PG8_SB(1, 1), b3 + hB, voffB);
            PG8_WAIT_V(6); PG8_BAR; PG8_MMA(1, 1, At, B1); PG8_BAR;
            }
        }
        if constexpr (ALIGN_EPI) { if (wr == 0) PG8_BAR; }
        { const int lane_e = hw_lane();
          E(acc, cur, wr, wc, lane_e & 15, lane_e >> 4, lds); }
        if (!has_next) break;
        if (!E.keep(cur)) {
#pragma unroll
        for (int a = 0; a < 2; ++a)
#pragma unroll
            for (int b = 0; b < 2; ++b)
#pragma unroll
                for (int m = 0; m < 4; ++m)
#pragma unroll
                    for (int n = 0; n < 2; ++n) acc[a][b][m][n] = (f32x4){0.f, 0.f, 0.f, 0.f};
        }
        cur = nxt; cA = nA; cB = nB; ++ui;
        if constexpr (Epi::LDS_EPI) { PG8_PROLOGUE(); }
        else if constexpr (ALIGN_EPI) { if (wr == 1) PG8_BAR; }
    }
    PG8_WAIT_V(0);
    if constexpr (!ALIGN_EPI) { if (wr == 0) PG8_BAR; }
    PG8_BAR;
#undef PG8_PROLOGUE
#undef PG8_STAGE_N
#undef PG8_SA
#undef PG8_SB
#undef PG8_STAGE
#undef PG8_LDA
#undef PG8_LDB
#undef PG8_MMA
#undef PG8_WAIT_V
#undef PG8_WAIT_L
#undef PG8_BAR
#undef PG8_SCHED
}
}

#define XB_TMO      128
#define XB_XCNT(j)  (256  + 64 * (j))
#define XB_XSUB(j)  (1280 + 64 * (j))
#define XB_XGEN(j)  (2304 + 64 * (j))
#define XB_TOP      3328
#define XB_TOPGEN   3392
#define XCD_BAR_WORDS 3456
#define XB_SPIN_CAP (1u << 18)
__device__ __forceinline__ unsigned xb_ld(unsigned* p)              { return __hip_atomic_load(p, __ATOMIC_RELAXED, __HIP_MEMORY_SCOPE_AGENT); }
__device__ __forceinline__ unsigned xb_add(unsigned* p, unsigned v) { return __hip_atomic_fetch_add(p, v, __ATOMIC_RELAXED, __HIP_MEMORY_SCOPE_AGENT); }
__device__ __forceinline__ unsigned xb_xcc_id() { return (unsigned)__builtin_amdgcn_s_getreg((3 << 11) | 20) & 0xFu; }
#define XB_SPIN(cond, bar) do { unsigned _sp = 0; while (cond) { __builtin_amdgcn_s_sleep(1); \
    if ((++_sp & 255u) == 0u) { if (xb_ld(&(bar)[XB_TMO])) break; if (_sp > XB_SPIN_CAP) { atomicAdd(&(bar)[XB_TMO], 1u); break; } } } } while (0)
struct XcdBarrier { unsigned* bar; unsigned x; volatile LAS unsigned* st; };
__device__ __forceinline__ XcdBarrier xcd_barrier_post(unsigned* bar, volatile LAS unsigned* st) {
    XcdBarrier b; b.bar = bar; b.x = xb_xcc_id(); b.st = st;
    if (threadIdx.x == 0) (void)xb_add(&bar[XB_XCNT(b.x)], 1u);
    return b;
}
__device__ __forceinline__ void xcd_barrier_complete(unsigned* bar, unsigned x, unsigned& nloc, unsigned& nx) {
    const unsigned G = gridDim.x * gridDim.y * gridDim.z;
    unsigned sum, cnt, mine, sp = 0u;
    for (;;) {
        sum = 0u; cnt = 0u; mine = 0u;
#pragma unroll
        for (unsigned j = 0; j < 16; ++j) { const unsigned c = xb_ld(&bar[XB_XCNT(j)]); sum += c; cnt += (c > 0u) ? 1u : 0u; mine = (j == x) ? c : mine; }
        if (sum == G) break;
        __builtin_amdgcn_s_sleep(1);
        if ((++sp & 255u) == 0u) { if (xb_ld(&bar[XB_TMO])) break; if (sp > XB_SPIN_CAP) { atomicAdd(&bar[XB_TMO], 1u); break; } }
    }
    nloc = mine > 0u ? mine : 1u; nx = cnt > 0u ? cnt : 1u;
}
__device__ __forceinline__ void xcd_barrier(const XcdBarrier& b, const int wv) {
    asm volatile("s_waitcnt vmcnt(0)" ::: "memory");
    __syncthreads();
    if (wv == 0 && hw_lane() == 0) {
        unsigned* bar = b.bar;
        __builtin_amdgcn_s_waitcnt(0);
        unsigned nloc = b.st[0], nx = b.st[1];
        if (nloc == 0u) { xcd_barrier_complete(bar, b.x, nloc, nx); b.st[0] = nloc; b.st[1] = nx; }
        const unsigned old = xb_add(&bar[XB_XSUB(b.x)], 1u);
        const unsigned gen = old / nloc;
        if (old + 1u == (gen + 1u) * nloc) {
            __builtin_amdgcn_fence(__ATOMIC_RELEASE, "agent");
            asm volatile("s_waitcnt vmcnt(0)" ::: "memory");
            const unsigned og = xb_add(&bar[XB_TOP], 1u);
            const unsigned tg = og / nx;
            if (og + 1u == (tg + 1u) * nx) xb_add(&bar[XB_TOPGEN], 1u);
            else XB_SPIN(xb_ld(&bar[XB_TOPGEN]) == tg, bar);
            __builtin_amdgcn_fence(__ATOMIC_ACQUIRE, "agent");
            xb_add(&bar[XB_XGEN(b.x)], 1u);
            asm volatile("s_waitcnt vmcnt(0)" ::: "memory");
        } else {
            XB_SPIN(xb_ld(&bar[XB_XGEN(b.x)]) == gen, bar);
            __builtin_amdgcn_fence(__ATOMIC_ACQUIRE, "agent");
            asm volatile("s_waitcnt vmcnt(0)" ::: "memory");
        }
    }
    __syncthreads();
}


__device__ __forceinline__ void transpose_item(const float* W, int ldw, int K, bf16_t* WT, int src_n0, int dst_n0, int k0, LAS float* scr, int lane) {
    {
        f32x4 v[8]; const float* wp = W + (size_t)(k0 + (lane >> 3)) * ldw + src_n0 + 4 * (lane & 7);
#pragma unroll
        for (int i = 0; i < 8; ++i) v[i] = *(const f32x4*)(wp + (size_t)(8 * i) * ldw);
        LAS float* sp = scr + (lane >> 3) * 33 + 4 * (lane & 7);
#pragma unroll
        for (int i = 0; i < 8; ++i) { sp[(8 * i) * 33 + 0] = v[i][0]; sp[(8 * i) * 33 + 1] = v[i][1]; sp[(8 * i) * 33 + 2] = v[i][2]; sp[(8 * i) * 33 + 3] = v[i][3]; }
    }
    LDS_WAIT(); asm volatile("" ::: "memory");
    const int c = lane & 7;
#pragma unroll
    for (int j = 0; j < 4; ++j) { const int n = (lane >> 3) + 8 * j; const LAS float* s = scr + (8 * c) * 33 + n;
        u32x4 o; o.x = pk2(s[0 * 33], s[1 * 33]); o.y = pk2(s[2 * 33], s[3 * 33]); o.z = pk2(s[4 * 33], s[5 * 33]); o.w = pk2(s[6 * 33], s[7 * 33]);
        *(u32x4*)(WT + (size_t)(dst_n0 + n) * K + k0 + 8 * c) = o; }
    LDS_WAIT(); asm volatile("" ::: "memory");
}
template <int MAP>
__device__ __forceinline__ void convert_matrix(const float* W, int ldw, int K, int Ndst, bf16_t* WT, LAS float* scr, int lane, int gw, int NGW, int& base) {
    const int nblk = Ndst / 32, nitems = (K / 64) * nblk;
    int first = (gw - base % NGW + NGW) % NGW;
    for (int it = first; it < nitems; it += NGW) {
        const int kb = it / nblk, nb = it % nblk, d0 = nb * 32;
        int s0 = d0;
        if (MAP == 1) s0 = d0 + (d0 < 1024 ? 0 : (d0 < 2560 ? 16 : 24));
        if (MAP == 2) { const int pn = d0 >> 8, hh = (d0 & 255) >> 7, r = d0 & 127; s0 = hh * FF + pn * 128 + r; }
        transpose_item(W, ldw, K, WT, s0, d0, kb * 64, scr, lane);
    }
    base += nitems;
}

__device__ __forceinline__ void ada_phase(LAS unsigned char* lds, int blk, int wave, int lane) {
    if (blk >= 192) return;
    const int l = blk / 96, n0 = (blk % 96) * 64;
    const float* c = inp(1); const float* W = inp(2) + (size_t)l * 1024 * 6144; const float* bias = inp(3) + l * 6144;
    LAS float* cs = (LAS float*)lds;
    LAS float* part = (LAS float*)(lds + 32768);
    for (int i = wave * 64 + lane; i < 8192; i += NWAVES * 64) { const int b = i >> 10, k = i & 1023; cs[k * 8 + b] = siluf_(c[i]); }
    __syncthreads();
    float acc[8] = {0.f, 0.f, 0.f, 0.f, 0.f, 0.f, 0.f, 0.f};
#pragma unroll 1
    for (int k0 = wave * 128; k0 < wave * 128 + 128; k0 += 16) {
        float wv[16];
#pragma unroll
        for (int j = 0; j < 16; ++j) wv[j] = W[(size_t)(k0 + j) * 6144 + n0 + lane];
#pragma unroll
        for (int j = 0; j < 16; ++j) {
            const f32x4 c0 = *(const LAS f32x4*)(cs + (k0 + j) * 8), c1 = *(const LAS f32x4*)(cs + (k0 + j) * 8 + 4);
            acc[0] += c0[0] * wv[j]; acc[1] += c0[1] * wv[j]; acc[2] += c0[2] * wv[j]; acc[3] += c0[3] * wv[j];
            acc[4] += c1[0] * wv[j]; acc[5] += c1[1] * wv[j]; acc[6] += c1[2] * wv[j]; acc[7] += c1[3] * wv[j];
        }
    }
#pragma unroll
    for (int b = 0; b < 8; ++b) part[(wave * 8 + b) * 64 + lane] = acc[b];
    __syncthreads();
    {
        const int b = wave; float s = bias[n0 + lane];
#pragma unroll
        for (int w = 0; w < 8; ++w) s += part[(w * 8 + b) * 64 + lane];
        ((float*)WSP(WS_MOD))[(size_t)(l * 8 + b) * 6144 + n0 + lane] = s;
    }
    __syncthreads();
}

template <bool WITH_POST, bool WITH_PRE, bool XIN_BF16, bool XOUT_BF16>
__device__ __forceinline__ void norm_rows(const bf16_t* Y, int ldy, const void* xin_, const float* pw, const float* modl_post, int gt_off, void* xout_,
                                          const float* w2, const float* modl_pre, int sh_off, int sc_off, bf16_t* H, int gw, int NGW, int lane) {
    const float* xin = (const float*)xin_; const bf16_t* xinb = (const bf16_t*)xin_; float* xout = (float*)xout_; bf16_t* xoutb = (bf16_t*)xout_;
    f32x4 xc[2][4], xn[2][4]; u32x2 yc[2][4], yn[2][4], bc[2][4], bn[2][4];
#define NR_LOAD(X, B, Yv, r0) do { _Pragma("unroll") for (int q = 0; q < 2; ++q) _Pragma("unroll") for (int j = 0; j < 4; ++j) { \
        if (XIN_BF16) B[q][j] = *(const u32x2*)(xinb + (size_t)((r0) + q * NGW) * D + (lane + 64 * j) * 4); else X[q][j] = *(const f32x4*)(xin + (size_t)((r0) + q * NGW) * D + (lane + 64 * j) * 4); \
        if (WITH_POST) Yv[q][j] = *(const u32x2*)(Y + (size_t)((r0) + q * NGW) * ldy + (lane + 64 * j) * 4); } } while (0)
#pragma unroll
    for (int q = 0; q < 2; ++q)
#pragma unroll
        for (int j = 0; j < 4; ++j) { xc[q][j] = (f32x4){0.f, 0.f, 0.f, 0.f}; xn[q][j] = xc[q][j]; yc[q][j] = (u32x2){0u, 0u}; yn[q][j] = yc[q][j]; bc[q][j] = yc[q][j]; bn[q][j] = yc[q][j]; }
    NR_LOAD(xc, bc, yc, gw);
    for (int row0 = gw; row0 < M; row0 += 2 * NGW) {
        const int rown = row0 + 2 * NGW;
        if (rown < M) NR_LOAD(xn, bn, yn, rown);
        f32x4 v[2][4];
        if (XIN_BF16) {
#pragma unroll
            for (int q = 0; q < 2; ++q)
#pragma unroll
                for (int j = 0; j < 4; ++j) xc[q][j] = (f32x4){bflo(bc[q][j].x), bfhi(bc[q][j].x), bflo(bc[q][j].y), bfhi(bc[q][j].y)};
        }
        if (WITH_POST) {
            float ss[2] = {0.f, 0.f};
#pragma unroll
            for (int q = 0; q < 2; ++q)
#pragma unroll
                for (int j = 0; j < 4; ++j) { const u32x2 y = yc[q][j];
                    v[q][j] = (f32x4){bflo(y.x), bfhi(y.x), bflo(y.y), bfhi(y.y)}; ss[q] += v[q][j][0] * v[q][j][0] + v[q][j][1] * v[q][j][1] + v[q][j][2] * v[q][j][2] + v[q][j][3] * v[q][j][3]; }
#pragma unroll
            for (int o = 1; o < 64; o <<= 1) { const float t0 = shl(ss[0], lane ^ o), t1 = shl(ss[1], lane ^ o); ss[0] += t0; ss[1] += t1; }
#pragma unroll
            for (int q = 0; q < 2; ++q) {
                const int row = row0 + q * NGW, b = row / T;
                const float r = rsqrtf(ss[q] * (1.f / D) + 1e-6f);
                const float* gt = modl_post + (size_t)b * 6144 + gt_off;
#pragma unroll
                for (int j = 0; j < 4; ++j) {
                    const int col = (lane + 64 * j) * 4;
                    const f32x4 xo = xc[q][j], pwv = *(const f32x4*)(pw + col), gtv = *(const f32x4*)(gt + col);
#pragma unroll
                    for (int e = 0; e < 4; ++e) v[q][j][e] = xo[e] + (1.f + gtv[e]) * (v[q][j][e] * r * pwv[e]);
                    if (XOUT_BF16) { u32x2 o; o.x = pk2(v[q][j][0], v[q][j][1]); o.y = pk2(v[q][j][2], v[q][j][3]); *(u32x2*)(xoutb + (size_t)row * D + col) = o;
                        v[q][j] = (f32x4){bflo(o.x), bfhi(o.x), bflo(o.y), bfhi(o.y)}; }
                    else *(f32x4*)(xout + (size_t)row * D + col) = v[q][j];
                }
            }
        } else {
#pragma unroll
            for (int q = 0; q < 2; ++q)
#pragma unroll
                for (int j = 0; j < 4; ++j) { v[q][j] = xc[q][j];
                    if (XOUT_BF16) { u32x2 o; o.x = pk2(v[q][j][0], v[q][j][1]); o.y = pk2(v[q][j][2], v[q][j][3]); *(u32x2*)(xoutb + (size_t)(row0 + q * NGW) * D + (lane + 64 * j) * 4) = o; } }
        }
        if (WITH_PRE) {
            float ss[2] = {0.f, 0.f};
#pragma unroll
            for (int q = 0; q < 2; ++q)
#pragma unroll
                for (int j = 0; j < 4; ++j) ss[q] += v[q][j][0] * v[q][j][0] + v[q][j][1] * v[q][j][1] + v[q][j][2] * v[q][j][2] + v[q][j][3] * v[q][j][3];
#pragma unroll
            for (int o = 1; o < 64; o <<= 1) { const float t0 = shl(ss[0], lane ^ o), t1 = shl(ss[1], lane ^ o); ss[0] += t0; ss[1] += t1; }
#pragma unroll
            for (int q = 0; q < 2; ++q) {
                const int row = row0 + q * NGW, b = row / T;
                const float r2 = rsqrtf(ss[q] * (1.f / D) + 1e-6f);
                const float* sh = modl_pre + (size_t)b * 6144 + sh_off; const float* sc = modl_pre + (size_t)b * 6144 + sc_off;
#pragma unroll
                for (int j = 0; j < 4; ++j) {
                    const int col = (lane + 64 * j) * 4;
                    const f32x4 wv = *(const f32x4*)(w2 + col), scv = *(const f32x4*)(sc + col), shv = *(const f32x4*)(sh + col);
#pragma unroll
                    for (int e = 0; e < 4; ++e) v[q][j][e] = v[q][j][e] * r2 * wv[e] * (1.f + scv[e]) + shv[e];
                    u32x2 o; o.x = pk2(v[q][j][0], v[q][j][1]); o.y = pk2(v[q][j][2], v[q][j][3]);
                    *(u32x2*)(H + (size_t)row * D + col) = o;
                }
            }
        }
#pragma unroll
        for (int q = 0; q < 2; ++q)
#pragma unroll
            for (int j = 0; j < 4; ++j) { xc[q][j] = xn[q][j]; yc[q][j] = yn[q][j]; bc[q][j] = bn[q][j]; }
    }
#undef NR_LOAD
}
__device__ __forceinline__ void zs_mfma(const bf16_t* H, const bf16_t* Wsm, float* ZS, int task, int lane) {
    typedef float f32x16_ __attribute__((ext_vector_type(16)));
    const int r32 = lane & 31, hh = lane >> 5;
    const bf16_t* ap = H + (size_t)(32 * task + r32) * D + 8 * hh;
    const bf16_t* bp = Wsm + (size_t)r32 * D + 8 * hh;
    f32x16_ acc;
#pragma unroll
    for (int r = 0; r < 16; ++r) acc[r] = 0.f;
#pragma unroll 8
    for (int ks = 0; ks < D / 16; ++ks) acc = __builtin_amdgcn_mfma_f32_32x32x16_bf16(*(const bf16x8*)(ap + 16 * ks), *(const bf16x8*)(bp + 16 * ks), acc, 0, 0, 0);
    if (r32 < 24) {
#pragma unroll
        for (int r = 0; r < 16; ++r) ZS[(size_t)(32 * task + (r & 3) + 8 * (r >> 2) + 4 * hh) * 32 + r32] = acc[r];
    }
}
__device__ __forceinline__ void convert_small(const float* w_in, bf16_t* Wsm, int part, int tid) {
    for (int i = tid; i < 4 * 1024; i += NWAVES * 64) {
        const int c = 4 * part + (i >> 10), k = i & 1023;
        float v = 0.f;
        if (c < 16) v = w_in[(size_t)k * INDIM + 1024 + c]; else if (c < 24) v = w_in[(size_t)k * INDIM + 2576 + (c - 16)];
        Wsm[c * 1024 + k] = (bf16_t)f2bf(v);
    }
}

__device__ __forceinline__ void s5_generate(int l, int g, LAS unsigned char* lds, int wv) {
    int tid = hw_tid(wv); asm volatile("" : "+v"(tid));
    LAS float* ar = (LAS float*)lds;
    LAS float* ai = ar + 17 * 64;
    LAS float* bbr = ai + 17 * 64;
    LAS float* bbi = bbr + 1024;
    LAS float* cr = bbi + 1024;
    LAS float* ci = cr + 1024;
    LAS float* Kt = ci + 1024;
    bf16_t* Bt1 = wp_s5m1(l) + (size_t)g * 384 * 256;
    bf16_t* Bt3 = wp_s5m3(l) + (size_t)g * 256 * 128;
    __syncthreads();
    {
        const float dt = expf((inp(18) + l * 32)[g]);
        for (int i = tid; i < 17 * 64; i += 512) {
            const int k = i >> 6, p = i & 63;
            const float lre = fminf((inp(16) + l * 2048)[g * 64 + p], -1e-4f), lim = (inp(17) + l * 2048)[g * 64 + p];
            const float mg = expf((float)k * lre * dt), an = (float)k * lim * dt; ar[i] = mg * cosf(an); ai[i] = mg * sinf(an);
        }
    }
    __syncthreads();
    if (tid < 64) { typedef float f32x2g __attribute__((ext_vector_type(2))); ((f32x2g*)WSP(WS_A16))[(l * 32 + g) * 64 + tid] = (f32x2g){ar[16 * 64 + tid], ai[16 * 64 + tid]}; }
    for (int i = tid; i < 1024; i += 512) {
        const int p = i >> 4;
        const float lre = fminf((inp(16) + l * 2048)[g * 64 + p], -1e-4f), lim = (inp(17) + l * 2048)[g * 64 + p];
        const float a1r = ar[64 + p], a1i = ai[64 + p];
        const float inv = 1.f / (lre * lre + lim * lim);
        const float zr_ = ((a1r - 1.f) * lre + a1i * lim) * inv, zi_ = (a1i * lre - (a1r - 1.f) * lim) * inv;
        const float br = (inp(19) + (size_t)l * 32768)[(size_t)(g * 64) * 16 + i], bi = (inp(20) + (size_t)l * 32768)[(size_t)(g * 64) * 16 + i];
        bbr[i] = zr_ * br - zi_ * bi; bbi[i] = zr_ * bi + zi_ * br;
    }
    for (int i = tid; i < 1024; i += 512) { cr[i] = (inp(21) + (size_t)l * 32768)[g * 1024 + i]; ci[i] = (inp(22) + (size_t)l * 32768)[g * 1024 + i]; }
    __syncthreads();
    {
        const int cp = tid >> 5, c = (tid >> 1) & 15, ph = tid & 1;
        float acc[16];
#pragma unroll
        for (int t = 0; t < 16; ++t) acc[t] = 0.f;
        for (int pp = 0; pp < 32; ++pp) {
            const int p = 32 * ph + pp;
            const float xr = cr[cp * 64 + p], xi = ci[cp * 64 + p], yr = bbr[p * 16 + c], yi = bbi[p * 16 + c];
            const float cbr = xr * yr - xi * yi, cbi = xr * yi + xi * yr;
#pragma unroll
            for (int t = 0; t < 16; ++t) acc[t] += cbr * ar[t * 64 + p] - cbi * ai[t * 64 + p];
        }
#pragma unroll
        for (int t = 0; t < 16; ++t) { const float o = acc[t] + shl(acc[t], (tid & 63) ^ 1); if (ph == 0) Kt[(t * 16 + cp) * 16 + c] = o; }
    }
    __syncthreads();
    for (int pc = tid; pc < 128 * 32; pc += 512) {
        const int row = pc >> 5, k0 = (pc & 31) * 8, sp = k0 >> 4, c0 = k0 & 15, p = row >> 1, e15 = 15 - sp;
        const float xr = ar[e15 * 64 + p], xi = ai[e15 * 64 + p];
        float v[8];
#pragma unroll
        for (int e = 0; e < 8; ++e) { const float yr = bbr[p * 16 + c0 + e], yi = bbi[p * 16 + c0 + e]; v[e] = (row & 1) == 0 ? (xr * yr - xi * yi) : (xr * yi + xi * yr); }
        u32x4 w; w.x = pk2(v[0], v[1]); w.y = pk2(v[2], v[3]); w.z = pk2(v[4], v[5]); w.w = pk2(v[6], v[7]);
        *(u32x4*)(Bt1 + (size_t)row * 256 + k0) = w;
    }
    for (int pc = tid; pc < 256 * 32; pc += 512) {
        const int j = pc >> 5, k0 = (pc & 31) * 8, s = j >> 4, cp = j & 15, sp = k0 >> 4, c0 = k0 & 15;
        float v[8];
#pragma unroll
        for (int e = 0; e < 8; ++e) v[e] = (sp <= s) ? Kt[((s - sp) * 16 + cp) * 16 + c0 + e] : 0.f;
        u32x4 w; w.x = pk2(v[0], v[1]); w.y = pk2(v[2], v[3]); w.z = pk2(v[4], v[5]); w.w = pk2(v[6], v[7]);
        *(u32x4*)(Bt1 + (size_t)(128 + j) * 256 + k0) = w;
    }
    for (int pc = tid; pc < 256 * 16; pc += 512) {
        const int j = pc >> 4, k0 = (pc & 15) * 8, s = j >> 4, cp = j & 15;
        float v[8];
#pragma unroll
        for (int e = 0; e < 8; ++e) {
            const int k = k0 + e, p = k >> 1;
            const float xr = cr[cp * 64 + p], xi = ci[cp * 64 + p], yr = ar[(s + 1) * 64 + p], yi = ai[(s + 1) * 64 + p];
            v[e] = (k & 1) == 0 ? (xr * yr - xi * yi) : -(xr * yi + xi * yr);
        }
        u32x4 w; w.x = pk2(v[0], v[1]); w.y = pk2(v[2], v[3]); w.z = pk2(v[4], v[5]); w.w = pk2(v[6], v[7]);
        *(u32x4*)(Bt3 + (size_t)j * 128 + k0) = w;
    }
    __syncthreads();
}
__device__ __forceinline__ void s5_scan_lds(int l, int g, int b, LAS unsigned char* lds, int wv) {
    int tid = hw_tid(wv); asm volatile("" : "+v"(tid));
    const int p = tid & 63, w = wv;
    typedef float f32x2s __attribute__((ext_vector_type(2)));
    __syncthreads();
    if (w == 0) {
        const f32x2s a16 = ((const f32x2s*)WSP(WS_A16))[(l * 32 + g) * 64 + p];
        const float a16r = a16.x, a16i = a16.y;
        float xr = 0.f, xi = 0.f;
#pragma unroll 8
        for (int n = 0; n < 256; ++n) {
            const f32x2s e = *(const LAS f32x2s*)(lds + n * 512 + (((p >> 1) ^ (n & 15)) * 16) + (p & 1) * 8);
            const unsigned xp = pk2(xr, xi);
            const float tr = a16r * xr - a16i * xi + e[0], ti = a16r * xi + a16i * xr + e[1];
            xr = tr; xi = ti;
            asm volatile("" ::: "memory");
            *(LAS unsigned*)(lds + n * 512 + 4 * p) = xp;
        }
    }
    __syncthreads();
    char* base = (char*)((bf16_t*)WSP(WS_Z) + (size_t)((g & 15) * 2048 + b * 256) * ZLD + EXC + (g >> 4) * 128);
    constexpr size_t RP = (size_t)ZLD * 2;
#pragma unroll 8
    for (int r = 0; r < 32; ++r) { const int n = 32 * w + r; unsigned* row = (unsigned*)(base + (size_t)n * RP); row[p] = *(const LAS unsigned*)(lds + n * 512 + 4 * p); }
}

namespace mx {
typedef float f32x16 __attribute__((ext_vector_type(16)));
__device__ __forceinline__ unsigned cpk(float lo, float hi) { return pg8::cvt_pk_bf16(lo, hi); }
constexpr int PB = 72;
constexpr int L_QS = 0, L_KS = 9216, L_KT = 18432, L_VT = 27648, L_PS = 46080, L_ST = 55296, L_OS = 73728, L_VEC = 107520;
constexpr int OSP = 132;
constexpr int V_SEG = 0  , V_ELAST = 1024, V_XS = 1088  , V_END = 5184;
static_assert(L_VEC + V_END * 4 <= RING_BYTES, "mixer LDS map");
constexpr int L_VEC2 = RING_BYTES + 512, SETSZ = 384, V_RT = 0, V_CS = 64, V_WI = 128, V_WK = 192, V_ENM = 256, V_SC = 320, V_DEN = 768, V_NORM = 832, V2_END = 960;
static_assert(L_VEC2 >= MISC_OFF + 128 && L_VEC2 + V2_END * 4 <= LDS_BYTES, "mixer LDS map (upper area)");
__device__ __forceinline__ int crow(int reg, int hh) { return (reg & 3) + 8 * (reg >> 2) + 4 * hh; }
__device__ __forceinline__ float fexp(float x) { return __builtin_amdgcn_exp2f(1.4426950408889634f * x); }
__device__ __forceinline__ float flogsig(float x) { const float e = fexp(-fabsf(x)); return fminf(x, 0.f) - 0.6931471805599453f * __builtin_amdgcn_logf(1.f + e); }
#define MX_MFMA(a, b, c) __builtin_amdgcn_mfma_f32_32x32x16_bf16((a), (b), (c), 0, 0, 0)
__device__ __forceinline__ void split8(const float (&x)[8], bf16x8& hi, bf16x8& lo) {
    u32x4 h, l;
    unsigned hw[4], lw[4];
#pragma unroll
    for (int i = 0; i < 4; ++i) { const unsigned p = cpk(x[2 * i], x[2 * i + 1]); hw[i] = p; lw[i] = cpk(x[2 * i] - bflo(p), x[2 * i + 1] - bfhi(p)); }
    h.x = hw[0]; h.y = hw[1]; h.z = hw[2]; h.w = hw[3]; l.x = lw[0]; l.y = lw[1]; l.z = lw[2]; l.w = lw[3];
    hi = __builtin_bit_cast(bf16x8, h); lo = __builtin_bit_cast(bf16x8, l);
}

template <int ROLE, bool STORE = true>
__device__ __forceinline__ void stream(int l, LAS unsigned char* lds, int bh, int wvs) {
    int tid = hw_tid(wvs); asm volatile("" : "+v"(tid));
    const int lane = tid & 63, w = __builtin_amdgcn_readfirstlane(tid >> 6), r32 = lane & 31, hh = lane >> 5;
    const int b = bh >> 2, h = bh & 3;
    LAS float* vec = (LAS float*)(lds + L_VEC); LAS float* vec2 = (LAS float*)(lds + L_VEC2);
    LAS bf16_t* Qs = (LAS bf16_t*)(lds + L_QS); LAS bf16_t* Ks = (LAS bf16_t*)(lds + L_KS); LAS bf16_t* KTs = (LAS bf16_t*)(lds + L_KT);
    LAS bf16_t* VTs = (LAS bf16_t*)(lds + L_VT); LAS bf16_t* Ps = (LAS bf16_t*)(lds + L_PS); LAS bf16_t* STs = (LAS bf16_t*)(lds + L_ST);
    LAS float* Os = (LAS float*)(lds + L_OS);
    const int qcol = (ROLE == 0 ? GQ : MQ) + h * 64, kcol = (ROLE == 0 ? GK : MK) + h * 64, vcol = (ROLE == 0 ? GV : MV) + h * 128, gcol = (ROLE == 0 ? GR : MO) + h * 128;
    const __amdgpu_buffer_rsrc_t zrs = __builtin_amdgcn_make_buffer_rsrc((void*)WSP(WS_Z), 0, 0x7fffffff, 0x00020000);
    const __amdgpu_buffer_rsrc_t srs = __builtin_amdgcn_make_buffer_rsrc((void*)WSP(WS_ZS), 0, 0x7fffffff, 0x00020000);
    const __amdgpu_buffer_rsrc_t zrs3 = __builtin_amdgcn_make_buffer_rsrc((void*)(WSP(WS_Z) - 3 * ZLD * 2), 0, 0x7fffffff, 0x00020000);
    const int dp = r32, rg = 2 * w + hh, et = tid >> 3, cg = tid & 7;
    const int wa = w >> 2, wv = w & 3;
    const unsigned vo_qk = (unsigned)((hh * 4 * ZLD + 2 * dp) * 2), vo_v = (unsigned)(lane * 4), vo_g = (unsigned)(((lane >> 3) * ZLD + 16 * (lane & 7)) * 2);
    float abd0 = 0.f, abd1 = 0.f, nwv[16];
    float cwq[4][2], cwk[4][2], cbq[2] = {0.f, 0.f}, cbk[2] = {0.f, 0.f}, ibh = 0.f, fbh = 0.f, mprev = 0.f;
    bf16x8 a2hi = {0, 0, 0, 0, 0, 0, 0, 0}, a2lo = {0, 0, 0, 0, 0, 0, 0, 0};
#pragma unroll
    for (int r = 0; r < 16; ++r) nwv[r] = 0.f;
#pragma unroll
    for (int j = 0; j < 4; ++j) { cwq[j][0] = cwq[j][1] = 0.f; cwk[j][0] = cwk[j][1] = 0.f; }
    if (ROLE == 0) {
        const float* a2 = inp(9) + l * 16 * 256; const float* ab = inp(10) + l * 256; const float* nw = inp(11) + l * 512;
#pragma unroll
        for (int r = 0; r < 16; ++r) nwv[r] = nw[h * 128 + 16 * cg + r];
        abd0 = ab[h * 64 + 2 * dp]; abd1 = ab[h * 64 + 2 * dp + 1];
        float bq[8];
#pragma unroll
        for (int j = 0; j < 8; ++j) bq[j] = a2[(8 * hh + j) * 256 + h * 64 + 32 * (w & 1) + r32];
        split8(bq, a2hi, a2lo);
    } else {
        const float* cw = inp(12) + l * 4 * 512; const float* cb = inp(13) + l * 512;
#pragma unroll
        for (int j = 0; j < 4; ++j)
#pragma unroll
            for (int c = 0; c < 2; ++c) { cwq[j][c] = cw[j * 512 + h * 64 + 2 * dp + c]; cwk[j][c] = cw[j * 512 + 256 + h * 64 + 2 * dp + c]; }
#pragma unroll
        for (int c = 0; c < 2; ++c) { cbq[c] = cb[h * 64 + 2 * dp + c]; cbk[c] = cb[256 + h * 64 + 2 * dp + c]; }
        ibh = (inp(14) + l * 4)[h]; fbh = (inp(15) + l * 4)[h];
    }
    for (int i = tid; i < 128 * PB / 2; i += 512) ((LAS unsigned*)STs)[i] = 0u;
    for (int i = tid; i < 64 * PB / 2; i += 512) ((LAS unsigned*)Ps)[i] = 0u;
    if (tid < 128) vec2[V_NORM + tid] = 0.f;
    f32x16 accS;
#pragma unroll
    for (int r = 0; r < 16; ++r) accS[r] = 0.f;
    unsigned qi[7], ki[7], vi[8]; float zs0 = 0.f, zs1 = 0.f; u32x4 gt0 = {0u, 0u, 0u, 0u}, gt1 = {0u, 0u, 0u, 0u}, ga0 = {0u, 0u, 0u, 0u}, ga1 = {0u, 0u, 0u, 0u};
#define MX_LOAD(mrow) do { \
        const unsigned rb_ = (unsigned)((mrow) + 8 * w) * (unsigned)(ZLD * 2); \
        if (ROLE == 0) { \
            _Pragma("unroll") for (int i = 0; i < 4; ++i) { qi[i] = __builtin_amdgcn_raw_buffer_load_b32(zrs, vo_qk, rb_ + (unsigned)((i * ZLD + qcol) * 2), 0); ki[i] = __builtin_amdgcn_raw_buffer_load_b32(zrs, vo_qk, rb_ + (unsigned)((i * ZLD + kcol) * 2), 0); } \
            if (w < 4) { const unsigned so_ = (unsigned)((mrow) + 32 * (w >> 1)) * 128u; ga0 = __builtin_amdgcn_raw_buffer_load_b128(srs, (unsigned)((r32 * 32 + 8 * hh) * 4), so_, 0); ga1 = __builtin_amdgcn_raw_buffer_load_b128(srs, (unsigned)((r32 * 32 + 8 * hh) * 4 + 16), so_, 0); } \
        } else { \
            _Pragma("unroll") for (int i = 0; i < 7; ++i) { qi[i] = __builtin_amdgcn_raw_buffer_load_b32(zrs3, vo_qk, rb_ + (unsigned)((i * ZLD + qcol) * 2), 0); ki[i] = __builtin_amdgcn_raw_buffer_load_b32(zrs3, vo_qk, rb_ + (unsigned)((i * ZLD + kcol) * 2), 0); } \
            if (w == 7) { const unsigned so_ = (unsigned)(mrow) * 128u; zs0 = __builtin_bit_cast(float, __builtin_amdgcn_raw_buffer_load_b32(srs, (unsigned)(lane * 128), so_ + (unsigned)((16 + h) * 4), 0)); \
                                                                         zs1 = __builtin_bit_cast(float, __builtin_amdgcn_raw_buffer_load_b32(srs, (unsigned)(lane * 128), so_ + (unsigned)((20 + h) * 4), 0)); } \
        } \
        _Pragma("unroll") for (int i = 0; i < 8; ++i) vi[i] = __builtin_amdgcn_raw_buffer_load_b32(zrs, vo_v, rb_ + (unsigned)((i * ZLD + vcol) * 2), 0); \
    } while (0)
#define MX_XS() do { if (w < 4) { \
        asm volatile("" : "+v"(ga0), "+v"(ga1)); \
        const float gf[8] = {__uint_as_float(ga0.x), __uint_as_float(ga0.y), __uint_as_float(ga0.z), __uint_as_float(ga0.w), __uint_as_float(ga1.x), __uint_as_float(ga1.y), __uint_as_float(ga1.z), __uint_as_float(ga1.w)}; \
        bf16x8 ahi, alo; split8(gf, ahi, alo); \
        f32x16 xa; _Pragma("unroll") for (int r = 0; r < 16; ++r) xa[r] = 0.f; \
        xa = MX_MFMA(alo, a2hi, xa); xa = MX_MFMA(ahi, a2lo, xa); xa = MX_MFMA(ahi, a2hi, xa); \
        _Pragma("unroll") for (int r = 0; r < 16; ++r) vec[V_XS + (32 * (w >> 1) + crow(r, hh)) * 64 + 32 * (w & 1) + r32] = xa[r]; } } while (0)
#define MX_SCALARS(sv) do { \
        asm volatile("" : "+v"(zs0), "+v"(zs1)); \
        const float ip = zs0 + ibh, lf = flogsig(zs1 + fbh); \
        float bs = lf; \
        _Pragma("unroll") for (int o = 1; o < 64; o <<= 1) { const float t = shl(bs, lane >= o ? lane - o : lane); if (lane >= o) bs += t; } \
        const float cs = ip - bs; \
        float pm = cs; \
        _Pragma("unroll") for (int o = 1; o < 64; o <<= 1) { const float t = shl(pm, lane >= o ? lane - o : lane); if (lane >= o) pm = fmaxf(pm, t); } \
        const float mt = bs + fmaxf(mprev, pm); \
        (sv)[V_RT + lane] = bs - mt; (sv)[V_CS + lane] = cs; (sv)[V_WI + lane] = fexp(bs + mprev - mt); (sv)[V_ENM + lane] = fexp(-mt); \
        const float mnew = shl(mt, 63), b63 = shl(bs, 63); \
        (sv)[V_WK + lane] = fexp(b63 + cs - mnew); \
        if (lane == 0) (sv)[V_SC] = fexp(b63 + mprev - mnew); \
        mprev = mnew; \
    } while (0)
#define MX_PIN7(a) asm volatile("" : "+v"(a[0]), "+v"(a[1]), "+v"(a[2]), "+v"(a[3]), "+v"(a[4]), "+v"(a[5]), "+v"(a[6]))
#define MX_PIN4(a) asm volatile("" : "+v"(a[0]), "+v"(a[1]), "+v"(a[2]), "+v"(a[3]))
#define MX_PIN8(a) asm volatile("" : "+v"(a[0]), "+v"(a[1]), "+v"(a[2]), "+v"(a[3]), "+v"(a[4]), "+v"(a[5]), "+v"(a[6]), "+v"(a[7]))
    unsigned m0 = (unsigned)(b * T);
    MX_LOAD(m0);
    if (ROLE == 0) MX_XS(); else if (w == 7) MX_SCALARS(vec2);
    __syncthreads();

#pragma unroll 1
    for (int n = 0; n <= 64; ++n) {
        if (n > 0) {
            const LAS float* orow = Os + et * OSP + 16 * cg;
            float o[16];
#pragma unroll
            for (int q4 = 0; q4 < 4; ++q4) { const f32x4 t4 = *(const LAS f32x4*)(orow + 4 * q4); o[4 * q4] = t4[0]; o[4 * q4 + 1] = t4[1]; o[4 * q4 + 2] = t4[2]; o[4 * q4 + 3] = t4[3]; }
            asm volatile("" : "+v"(gt0), "+v"(gt1));
            const unsigned gw_[8] = {gt0.x, gt0.y, gt0.z, gt0.w, gt1.x, gt1.y, gt1.z, gt1.w};
            float y[16];
            if (ROLE == 0) {
                float ss = 0.f;
#pragma unroll
                for (int e = 0; e < 16; ++e) ss += o[e] * o[e];
                ss += shl(ss, lane ^ 1); ss += shl(ss, lane ^ 2); ss += shl(ss, lane ^ 4);
                const float rn = rsqrtf(ss * (1.f / 128.f) + 1e-6f);
#pragma unroll
                for (int e = 0; e < 16; ++e) { const float g = (e & 1) ? bfhi(gw_[e >> 1]) : bflo(gw_[e >> 1]); y[e] = o[e] * rn * nwv[e] * g; }
            } else {
                const float rdiv = vec2[V_DEN + et];
#pragma unroll
                for (int e = 0; e < 16; ++e) { const float g = (e & 1) ? bfhi(gw_[e >> 1]) : bflo(gw_[e >> 1]); y[e] = o[e] * rdiv * g; }
            }
            u32x4 s0, s1;
            s0.x = cpk(y[0], y[1]); s0.y = cpk(y[2], y[3]); s0.z = cpk(y[4], y[5]); s0.w = cpk(y[6], y[7]);
            s1.x = cpk(y[8], y[9]); s1.y = cpk(y[10], y[11]); s1.z = cpk(y[12], y[13]); s1.w = cpk(y[14], y[15]);
            const unsigned so_ = (m0 - 64u + 8u * (unsigned)w) * (unsigned)(ZLD * 2) + (unsigned)(gcol * 2);
            if (STORE) { __builtin_amdgcn_raw_buffer_store_b128(s0, zrs, vo_g, so_, 0); __builtin_amdgcn_raw_buffer_store_b128(s1, zrs, vo_g + 16u, so_, 0); } else { asm volatile("" :: "v"(s0), "v"(s1)); }
        }
        if (n == 64) break;
        const LAS float* sv = vec2 + (n & 1) * SETSZ;
        float c4[4][2], qf[4][2], kf[4][2];
        if (ROLE == 0) {
            MX_PIN4(qi); MX_PIN4(ki);
            float run0 = 0.f, run1 = 0.f;
#pragma unroll
            for (int i = 0; i < 4; ++i) {
                const f32x2 x2 = *(const LAS f32x2*)(vec + V_XS + (4 * rg + i) * 64 + 2 * dp);
                run0 += flogsig(x2[0] + abd0) * (1.f / 16.f); run1 += flogsig(x2[1] + abd1) * (1.f / 16.f); c4[i][0] = run0; c4[i][1] = run1;
                qf[i][0] = bflo(qi[i]) * 0.125f; qf[i][1] = bfhi(qi[i]) * 0.125f; kf[i][0] = bflo(ki[i]); kf[i][1] = bfhi(ki[i]);
            }
            *(LAS f32x2*)(vec + V_SEG + rg * 64 + 2 * dp) = (f32x2){run0, run1};
            __syncthreads();
        } else {
            MX_PIN7(qi); MX_PIN7(ki);
            if (n == 0 && rg == 0) { qi[0] = qi[1] = qi[2] = 0u; ki[0] = ki[1] = ki[2] = 0u; }
#pragma unroll
            for (int i = 0; i < 4; ++i) {
                float aq0 = cbq[0], aq1 = cbq[1], ak0 = cbk[0], ak1 = cbk[1];
#pragma unroll
                for (int j = 0; j < 4; ++j) { aq0 += cwq[j][0] * bflo(qi[i + j]); aq1 += cwq[j][1] * bfhi(qi[i + j]); ak0 += cwk[j][0] * bflo(ki[i + j]); ak1 += cwk[j][1] * bfhi(ki[i + j]); }
                qf[i][0] = aq0 * fsigmoid(aq0); qf[i][1] = aq1 * fsigmoid(aq1); kf[i][0] = ak0 * fsigmoid(ak0) * 0.125f; kf[i][1] = ak1 * fsigmoid(ak1) * 0.125f;
                c4[i][0] = 0.f; c4[i][1] = 0.f;
            }
        }
        {
            float kt0[4], kt1[4];
            if (ROLE == 0) {
                float off0 = 0.f, off1 = 0.f, tot0 = 0.f, tot1 = 0.f;
#pragma unroll
                for (int r2 = 0; r2 < 16; ++r2) { const f32x2 s = *(const LAS f32x2*)(vec + V_SEG + r2 * 64 + 2 * dp); tot0 += s[0]; tot1 += s[1]; off0 += (r2 < rg) ? s[0] : 0.f; off1 += (r2 < rg) ? s[1] : 0.f; }
                if (rg == 0) *(LAS f32x2*)(vec + V_ELAST + 2 * dp) = (f32x2){fexp(tot0), fexp(tot1)};
#pragma unroll
                for (int i = 0; i < 4; ++i) {
                    const float cum0 = off0 + c4[i][0], cum1 = off1 + c4[i][1];
                    const float kk0 = kf[i][0] * fexp(-cum0), kk1 = kf[i][1] * fexp(-cum1);
                    *(LAS unsigned*)(Qs + (4 * rg + i) * PB + 2 * dp) = cpk(qf[i][0] * fexp(cum0), qf[i][1] * fexp(cum1));
                    *(LAS unsigned*)(Ks + (4 * rg + i) * PB + 2 * dp) = cpk(kk0, kk1);
                    kt0[i] = kk0; kt1[i] = kk1;
                }
            } else {
#pragma unroll
                for (int i = 0; i < 4; ++i) {
                    *(LAS unsigned*)(Qs + (4 * rg + i) * PB + 2 * dp) = cpk(qf[i][0], qf[i][1]);
                    *(LAS unsigned*)(Ks + (4 * rg + i) * PB + 2 * dp) = cpk(kf[i][0], kf[i][1]);
                    const float wk = sv[V_WK + 4 * rg + i];
                    kt0[i] = kf[i][0] * wk; kt1[i] = kf[i][1] * wk;
                }
            }
            *(LAS u32x2*)(KTs + (2 * dp) * PB + 4 * rg) = (u32x2){cpk(kt0[0], kt0[1]), cpk(kt0[2], kt0[3])};
            *(LAS u32x2*)(KTs + (2 * dp + 1) * PB + 4 * rg) = (u32x2){cpk(kt1[0], kt1[1]), cpk(kt1[2], kt1[3])};
            MX_PIN8(vi);
            u32x4 v0, v1;
            v0.x = (vi[0] & 0xffffu) | (vi[1] << 16); v0.y = (vi[2] & 0xffffu) | (vi[3] << 16); v0.z = (vi[4] & 0xffffu) | (vi[5] << 16); v0.w = (vi[6] & 0xffffu) | (vi[7] << 16);
            v1.x = (vi[0] >> 16) | (vi[1] & 0xffff0000u); v1.y = (vi[2] >> 16) | (vi[3] & 0xffff0000u); v1.z = (vi[4] >> 16) | (vi[5] & 0xffff0000u); v1.w = (vi[6] >> 16) | (vi[7] & 0xffff0000u);
            *(LAS u32x4*)(VTs + (2 * lane) * PB + 8 * w) = v0; *(LAS u32x4*)(VTs + (2 * lane + 1) * PB + 8 * w) = v1;
        }
        __syncthreads();
        { const unsigned so_ = (m0 + 8u * (unsigned)w) * (unsigned)(ZLD * 2) + (unsigned)(gcol * 2); gt0 = __builtin_amdgcn_raw_buffer_load_b128(zrs, vo_g, so_, 0); gt1 = __builtin_amdgcn_raw_buffer_load_b128(zrs, vo_g + 16u, so_, 0); }
        if (n < 63) MX_LOAD(m0 + 64u);
#define MX_FRAG(base, row, ks) (*(const LAS bf16x8*)(lds + (base) + ((row) * PB + 16 * (ks) + 8 * hh) * 2))
        if (w < 3) {
            const int ti = (w >= 1) ? 1 : 0, sj = (w == 2) ? 1 : 0;
            f32x16 sc;
#pragma unroll
            for (int r = 0; r < 16; ++r) sc[r] = 0.f;
#pragma unroll
            for (int ks = 0; ks < 4; ++ks) sc = MX_MFMA(MX_FRAG(L_KS, 32 * sj + r32, ks), MX_FRAG(L_QS, 32 * ti + r32, ks), sc);
            const float rtv = (ROLE == 1) ? sv[V_RT + 32 * ti + r32] : 0.f;
            float pv[16];
#pragma unroll
            for (int r = 0; r < 16; ++r) {
                const int s = crow(r, hh);
                const bool keep = (ti != sj) || (s <= r32);
                float val = sc[r];
                if (ROLE == 1) val *= fexp(rtv + sv[V_CS + 32 * sj + s]);
                pv[r] = keep ? val : 0.f;
            }
#pragma unroll
            for (int q4 = 0; q4 < 4; ++q4) *(LAS u32x2*)(Ps + (32 * ti + r32) * PB + 32 * sj + 8 * q4 + 4 * hh) = (u32x2){cpk(pv[4 * q4], pv[4 * q4 + 1]), cpk(pv[4 * q4 + 2], pv[4 * q4 + 3])};
        }
        f32x16 acco;
#pragma unroll
        for (int r = 0; r < 16; ++r) acco[r] = 0.f;
#pragma unroll
        for (int ks = 0; ks < 4; ++ks) acco = MX_MFMA(MX_FRAG(L_QS, 32 * wa + r32, ks), MX_FRAG(L_ST, 32 * wv + r32, ks), acco);
        if (ROLE == 1) {
#pragma unroll
            for (int r = 0; r < 16; ++r) acco[r] *= sv[V_WI + 32 * wa + crow(r, hh)];
            const float carry = sv[V_SC];
#pragma unroll
            for (int r = 0; r < 16; ++r) accS[r] *= carry;
        }
#pragma unroll
        for (int ks = 0; ks < 4; ++ks) accS = MX_MFMA(MX_FRAG(L_KT, 32 * wa + r32, ks), MX_FRAG(L_VT, 32 * wv + r32, ks), accS);
        if (ROLE == 0) {
#pragma unroll
            for (int r = 0; r < 16; ++r) accS[r] *= vec[V_ELAST + 32 * wa + crow(r, hh)];
        }
        __syncthreads();
        if (wa == 0) {
#pragma unroll
            for (int ks = 0; ks < 2; ++ks) acco = MX_MFMA(MX_FRAG(L_PS, r32, ks), MX_FRAG(L_VT, 32 * wv + r32, ks), acco);
        } else {
#pragma unroll
            for (int ks = 0; ks < 4; ++ks) acco = MX_MFMA(MX_FRAG(L_PS, 32 + r32, ks), MX_FRAG(L_VT, 32 * wv + r32, ks), acco);
        }
#pragma unroll
        for (int r = 0; r < 16; ++r) Os[(32 * wa + crow(r, hh)) * OSP + 32 * wv + r32] = acco[r];
#pragma unroll
        for (int q4 = 0; q4 < 4; ++q4) { u32x2 p; p.x = cpk(accS[4 * q4], accS[4 * q4 + 1]); p.y = cpk(accS[4 * q4 + 2], accS[4 * q4 + 3]);
            *(LAS u32x2*)(STs + (32 * wv + r32) * PB + 32 * wa + 8 * q4 + 4 * hh) = p; }
        if (ROLE == 0) { if (n < 63) MX_XS(); }
        else {
            const LAS float* nprev = vec2 + V_NORM + (n & 1) * 64;
            if (w == 0) {
                float qn = 0.f, si = 0.f;
#pragma unroll
                for (int c8i = 0; c8i < 8; ++c8i) {
                    const u32x4 qv = *(const LAS u32x4*)(Qs + lane * PB + 8 * c8i), pv = *(const LAS u32x4*)(Ps + lane * PB + 8 * c8i);
                    const f32x4 n0 = *(const LAS f32x4*)(nprev + 8 * c8i), n1 = *(const LAS f32x4*)(nprev + 8 * c8i + 4);
                    qn += bflo(qv.x) * n0[0] + bfhi(qv.x) * n0[1] + bflo(qv.y) * n0[2] + bfhi(qv.y) * n0[3] + bflo(qv.z) * n1[0] + bfhi(qv.z) * n1[1] + bflo(qv.w) * n1[2] + bfhi(qv.w) * n1[3];
                    si += (bflo(pv.x) + bfhi(pv.x)) + (bflo(pv.y) + bfhi(pv.y)) + (bflo(pv.z) + bfhi(pv.z)) + (bflo(pv.w) + bfhi(pv.w));
                }
                const float den = sv[V_WI + lane] * qn + si;
                vec2[V_DEN + lane] = 1.f / fmaxf(fabsf(den), sv[V_ENM + lane]);
            } else if (w == 7) {
                if (n < 63) MX_SCALARS(vec2 + ((n + 1) & 1) * SETSZ);
            } else if (w == 1) {
                float kn = 0.f;
#pragma unroll
                for (int c8i = 0; c8i < 8; ++c8i) { const u32x4 kv = *(const LAS u32x4*)(KTs + lane * PB + 8 * c8i);
                    kn += (bflo(kv.x) + bfhi(kv.x)) + (bflo(kv.y) + bfhi(kv.y)) + (bflo(kv.z) + bfhi(kv.z)) + (bflo(kv.w) + bfhi(kv.w)); }
                vec2[V_NORM + ((n + 1) & 1) * 64 + lane] = sv[V_SC] * nprev[lane] + kn;
            }
        }
        __syncthreads();
        m0 += 64u;
    }
#undef MX_LOAD
#undef MX_XS
#undef MX_PIN4
#undef MX_PIN7
#undef MX_PIN8
#undef MX_SCALARS
#undef MX_FRAG
}
}

#ifndef PHASE_MASK
#define PHASE_MASK 0xFFFF
#endif
#define PH(k) if constexpr ((PHASE_MASK >> (k)) & 1)
#ifndef STAGGER_TICKS
#define STAGGER_TICKS 0
#endif
#ifndef PROBE_GEMM_REPS
#define PROBE_GEMM_REPS 1
#endif
#ifndef PROBE_STREAM_REPS
#define PROBE_STREAM_REPS 1
#endif
#ifndef PROBE_GEMM_MASK
#define PROBE_GEMM_MASK 0xFFFF
#endif
#define GREP(k) _Pragma("unroll 1") for (int rep_ = 0; rep_ < (((PROBE_GEMM_MASK >> (k)) & 1) ? PROBE_GEMM_REPS : 1); ++rep_)
#define GREP_BAR if (rep_) GRID_BAR();
#define BLK_ENV int blk = blockIdx.x; asm volatile("" : "+s"(blk));
#define PHASE_ENV BLK_ENV int tid = hw_tid(wave_s); asm volatile("" : "+v"(tid)); const int lane = tid & 63, wave = wave_s; int vcu_ = vcu; asm volatile("" : "+s"(vcu_)); const int gw = vcu_ * NWAVES + wave; (void)lane; (void)gw;
__global__ void __launch_bounds__(NWAVES * 64, 2) mega_fwd(Args args) {
    extern __shared__ __attribute__((aligned(16))) unsigned char lds_raw[];
    LAS unsigned char* lds = (LAS unsigned char*)lds_raw;
    const int G = gridDim.x, blk0 = blockIdx.x;
    const int wave_s = __builtin_amdgcn_readfirstlane(threadIdx.x >> 6);
    const int vcu = (G % 8 == 0) ? (blk0 % 8) * (G / 8) + blk0 / 8 : blk0;
    const int NGW = G * NWAVES;
    for (int u = threadIdx.x; u < (LDS_BYTES - LDSCTL_OFF) / 4; u += NWAVES * 64) ((LAS unsigned*)(lds + LDSCTL_OFF))[u] = 0u;
    __syncthreads();
    (void)xcd_barrier_post((unsigned*)(args.ws + WS_CTL) + CW_BAR, (volatile LAS unsigned*)(lds + MISC_OFF) + 8);
#define GRID_BAR() do { XcdBarrier b_; b_.bar = (unsigned*)(inp_ws() + WS_CTL) + CW_BAR; b_.x = xb_xcc_id(); b_.st = (volatile LAS unsigned*)(lds + MISC_OFF) + 8; xcd_barrier(b_, wave_s); } while (0)

    PH(0) { PHASE_ENV
        ada_phase(lds, blk, wave, lane);
        if (blk >= 192 && blk < 224) s5_generate(0, blk - 192, lds, wave_s);
        else {
            if (blk >= 224 && blk < 232) { convert_small(inp(8), (bf16_t*)WSP(WS_WSM), blk - 224, tid); __syncthreads(); }
            LAS float* scr = (LAS float*)(lds + wave * 16384);
            int base = 0;
            convert_matrix<1>(inp(8), INDIM, 1024, ZLD, (bf16_t*)WSP(WS_WIN), scr, lane, (blk < 192 ? blk : blk - 32) * NWAVES + wave, (G - 32) * NWAVES, base);
        }
    }
    GRID_BAR();

#pragma unroll 1
    for (int l = 0; l < DEPTH; ++l) {
        PH(1) if (l == 0) { PHASE_ENV
            norm_rows<false, true, false, true>(nullptr, 0, inp(0), nullptr, nullptr, 0, inp_out(), inp(4), (const float*)WSP(WS_MOD), 0, 1024, (bf16_t*)WSP(WS_H), gw, NGW, lane);
            GRID_BAR();
        }
        PH(2) GREP(2) { GREP_BAR BLK_ENV
            pg8::PlainSched S; S.o.init(M, NMIX, G, blk); S.A = (const bf16_t*)WSP(WS_H); S.lda = D; S.Bt = wp_win(l); S.K = D;
            pg8::EpiStore E{(bf16_t*)WSP(WS_Z), ZLD, STAGGER_TICKS, 1};
            pg8::gemm_phase<pg8::EpiStore, pg8::PlainSched, true, true>(lds, wave_s, D, D, S, E);
            { const int task = (int)(((G % 8 == 0) ? (blk % 8) * (G / 8) + blk / 8 : blk) * NWAVES + wave_s);
              for (int t = task; t < M / 32; t += G * NWAVES) zs_mfma((const bf16_t*)WSP(WS_H), wp_wsm(l), (float*)WSP(WS_ZS), t, hw_lane()); }
        }
        GRID_BAR();
        PH(3) { PHASE_ENV
            if ((blk & 7) < 2) {
                const int sidx = (blk >> 3) * 2 + (blk & 7);
                if (sidx < 32) mx::stream<0>(l, lds, sidx, wave_s); else mx::stream<1>(l, lds, sidx - 32, wave_s);
                if (l + 1 < DEPTH) {
                    __syncthreads();
                    int blk2 = blockIdx.x; asm volatile("" : "+s"(blk2)); const int sidx2 = (blk2 >> 3) * 2 + (blk2 & 7);
                    int tid2 = hw_tid(wave_s); asm volatile("" : "+v"(tid2)); const int lane2 = tid2 & 63;
                    if (sidx2 < 32) { s5_generate(l + 1, sidx2, lds, wave_s); __syncthreads(); }
                    int base = 0; LAS float* scr = (LAS float*)(lds + wave_s * 16384);
                    convert_matrix<1>(inp(8) + (size_t)(l + 1) * D * INDIM, INDIM, 1024, ZLD, wp_win(l + 1), scr, lane2, sidx2 * NWAVES + wave_s, 64 * NWAVES, base);
                    if (sidx2 >= 32 && sidx2 < 40) { __syncthreads(); convert_small(inp(8) + (size_t)(l + 1) * D * INDIM, wp_wsm(l + 1), sidx2 - 32, tid2); }
                }
            } else {
#define GX_ENV int blk_ = blockIdx.x; asm volatile("" : "+s"(blk_)); const int xq = blk_ & 7, gidx = (blk_ >> 3) * 6 + (xq - 2); const bool grpD = xq < 4; (void)gidx; (void)grpD;
#define S5_TASK(kk) do { \
                    { GX_ENV const int task = (grpD ? (blk_ >> 3) * 2 + (xq - 2) : 128 + (blk_ >> 3) * 4 + (xq - 4)) + 64 * (kk); \
                      int g256 = 256; asm volatile("" : "+s"(g256)); pg8::S5aSched S; S.G = g256; S.c = task; S.Zb = (const bf16_t*)WSP(WS_Z); S.Bt1 = wp_s5m1(l); pg8::EpiS5a E{l}; \
                      pg8::gemm_phase<pg8::EpiS5a, pg8::S5aSched, true, true, 1>(lds, wave_s, 0, 256, S, E); } \
                    { GX_ENV const int task = (grpD ? (blk_ >> 3) * 2 + (xq - 2) : 128 + (blk_ >> 3) * 4 + (xq - 4)) + 64 * (kk); s5_scan_lds(l, task >> 3, task & 7, lds, wave_s); } \
                    { asm volatile("s_waitcnt vmcnt(0)" ::: "memory"); __builtin_amdgcn_fence(__ATOMIC_RELEASE, "workgroup"); __syncthreads(); __builtin_amdgcn_fence(__ATOMIC_ACQUIRE, "workgroup"); } \
                    { GX_ENV const int task = (grpD ? (blk_ >> 3) * 2 + (xq - 2) : 128 + (blk_ >> 3) * 4 + (xq - 4)) + 64 * (kk); \
                      int g256 = 256; asm volatile("" : "+s"(g256)); pg8::S5bSched S; S.G = g256; S.c = task; S.X = (const bf16_t*)WSP(WS_Z); S.Bt3 = wp_s5m3(l); pg8::EpiS5b E{(bf16_t*)WSP(WS_Z), inp(23) + l * 512, lds}; \
                      pg8::gemm_phase<pg8::EpiS5b, pg8::S5bSched, true, true>(lds, wave_s, ZLD, 128, S, E); } \
                    __syncthreads(); } while (0)
                {   GX_ENV int base = 0; const int gw2 = gidx * NWAVES + wave, NGW2 = 192 * NWAVES;
                    LAS float* scr = (LAS float*)(lds + wave * 16384);
                    convert_matrix<2>(inp(31) + (size_t)l * D * 2 * FF, 2 * FF, 1024, 2 * FF, (bf16_t*)DUP(DU_WFI), scr, lane, gw2, NGW2, base);
                    __syncthreads();
                }
#pragma unroll 1
                for (int kt = 0; kt < 2; ++kt) {
                    { GX_ENV if (kt == 1 && !grpD) break; }
                    S5_TASK(kt);
                }
                {
                    asm volatile("s_waitcnt vmcnt(0) lgkmcnt(0)" ::: "memory"); __syncthreads();
                    if (wave_s == 0 && hw_lane() == 0) __hip_atomic_fetch_add((unsigned*)WSP(WS_CTL) + CW_S5DONE, 1u, __ATOMIC_RELAXED, __HIP_MEMORY_SCOPE_AGENT);
                }
                {
                    GX_ENV
                    pg8::PlainSched S;
                    if (grpD) S.o.init(M, 768, 64, (blk_ >> 3) * 2 + (xq - 2), 2); else S.o.init(M, 2304, 128, (blk_ >> 3) * 4 + (xq - 4), 4);
                    const int coff = grpD ? 0 : 768;
                    S.A = (const bf16_t*)WSP(WS_H); S.lda = D; S.Bt = wp_win(l) + (size_t)(NMIX + coff) * D; S.K = D;
                    pg8::EpiStore E{(bf16_t*)WSP(WS_Z) + NMIX + coff, ZLD, 0, 2, 0, inp(29) + l * 3072 + coff};
                    E.waitp = grpD ? (unsigned*)WSP(WS_CTL) + CW_S5DONE : nullptr; E.waitn = 192u * (unsigned)(l + 1);
                    pg8::gemm_phase<pg8::EpiStore, pg8::PlainSched, true, true>(lds, wave_s, D, D, S, E);
                }
                {
                    GX_ENV
                    if (wave_s == 0) { unsigned spins = 0; while ((unsigned)__builtin_amdgcn_readfirstlane(__hip_atomic_load((unsigned*)WSP(WS_CTL) + CW_S5DONE, __ATOMIC_RELAXED, __HIP_MEMORY_SCOPE_AGENT)) < 192u * (unsigned)(l + 1)) { __builtin_amdgcn_s_sleep(8); if (++spins > (1u << 22)) break; } }
                    __syncthreads();
                    int tid2 = hw_tid(wave_s); asm volatile("" : "+v"(tid2)); const int lane = tid2 & 63, wave = wave_s;
                    int base = 0; const int gw2 = gidx * NWAVES + wave, NGW2 = 192 * NWAVES;
                    LAS float* scr = (LAS float*)(lds + wave * 16384);
                    convert_matrix<0>(inp(24) + (size_t)l * 512 * 512, 512, 512, 512, (bf16_t*)WSP(WS_WGLU), scr, lane, gw2, NGW2, base);
                    convert_matrix<0>(inp(26) + (size_t)l * 512 * 1024, 1024, 512, 1024, (bf16_t*)WSP(WS_WPROJ), scr, lane, gw2, NGW2, base);
                    convert_matrix<0>(inp(27) + (size_t)l * 512 * 1024, 1024, 512, 1024, (bf16_t*)WSP(WS_WPROJ) + 1024 * 512, scr, lane, gw2, NGW2, base);
                    convert_matrix<0>(inp(28) + (size_t)l * 512 * 1024, 1024, 512, 1024, (bf16_t*)WSP(WS_WPROJ) + 2 * 1024 * 512, scr, lane, gw2, NGW2, base);
                    convert_matrix<0>(inp(30) + (size_t)l * D * D, 1024, 1024, 1024, (bf16_t*)WSP(WS_WOUT), scr, lane, gw2, NGW2, base);
                    convert_matrix<0>(inp(32) + (size_t)l * FF * D, 1024, FF, 1024, (bf16_t*)WSP(WS_WFO), scr, lane, gw2, NGW2, base);
                }
#undef S5_TASK
#undef GX_ENV
            }
        }
        GRID_BAR();
        PH(4) GREP(4) { GREP_BAR BLK_ENV
            bf16_t* Z = (bf16_t*)WSP(WS_Z);
            pg8::PlainSched S; S.o.init(M, 512, G, blk); S.A = Z + SU; S.lda = ZLD; S.Bt = (const bf16_t*)WSP(WS_WGLU); S.K = 512;
            pg8::EpiGlu E{Z + YS2, ZLD, Z + SU, ZLD, inp(25) + l * 512, lds};
            pg8::gemm_phase<pg8::EpiGlu, pg8::PlainSched, true, true>(lds, wave_s, ZLD, 512, S, E);
        }
        GRID_BAR();
        PH(5) GREP(5) { GREP_BAR BLK_ENV
            bf16_t* Z = (bf16_t*)WSP(WS_Z);
            pg8::MergeSched S; S.o.init(M, 1024, G, blk); S.Zb = Z; S.Wp = (const bf16_t*)WSP(WS_WPROJ);
            pg8::EpiMerge E{Z + MRG, ZLD, Z + ZG, ZLD, inp(29) + l * 3072};
            pg8::gemm_phase<pg8::EpiMerge, pg8::MergeSched, true, true>(lds, wave_s, ZLD, 512, S, E);
        }
        GRID_BAR();
        PH(6) GREP(6) { GREP_BAR BLK_ENV
            pg8::PlainSched S; S.o.init(M, 1024, G, blk); S.A = (const bf16_t*)WSP(WS_Z) + MRG; S.lda = ZLD; S.Bt = (const bf16_t*)WSP(WS_WOUT); S.K = 1024;
            pg8::EpiNorm<0, false> E{l, lds + LT_OFF}; pg8::gemm_phase<pg8::EpiNorm<0, false>, pg8::PlainSched, true, true>(lds, wave_s, ZLD, 1024, S, E);
        }
        GRID_BAR();
        PH(8) GREP(8) { GREP_BAR BLK_ENV
            pg8::PlainSched S; S.o.init(M, 2 * FF, G, blk); S.A = (const bf16_t*)WSP(WS_H); S.lda = D; S.Bt = (const bf16_t*)DUP(DU_WFI); S.K = D;
            pg8::EpiSwiGlu E{(bf16_t*)WSP(WS_Z) + HIDC, ZLD, STAGGER_TICKS};
            pg8::gemm_phase<pg8::EpiSwiGlu, pg8::PlainSched, true, true>(lds, wave_s, D, D, S, E);
        }
        GRID_BAR();
        PH(9) GREP(9) { GREP_BAR BLK_ENV
            pg8::PlainSched S; S.o.init(M, 1024, G, blk); S.A = (const bf16_t*)WSP(WS_Z) + HIDC; S.lda = ZLD; S.Bt = (const bf16_t*)WSP(WS_WFO); S.K = FF;
            if (l + 1 < DEPTH) { pg8::EpiNorm<1, false> E{l, lds + LT_OFF}; pg8::gemm_phase<pg8::EpiNorm<1, false>, pg8::PlainSched, true, true>(lds, wave_s, ZLD, FF, S, E); }
            else { pg8::EpiNorm<1, true> E{l, lds + LT_OFF}; pg8::gemm_phase<pg8::EpiNorm<1, true>, pg8::PlainSched, true, true>(lds, wave_s, ZLD, FF, S, E); }
        }
        if (l + 1 < DEPTH) GRID_BAR();
    }
}

extern "C" void kernel_launch(void* const* d_in, const int* in_sizes, int n_in, void* d_out, int out_size, void* d_ws, size_t ws_size, hipStream_t stream) {
    static int grid = 0;
    if (grid == 0) {
        if (n_in != 33 || ws_size < WS_END || out_size != M * D) { fprintf(stderr, "kernel_launch: unexpected n_in %d / ws %zu / out %d\n", n_in, ws_size, out_size); grid = -1; return; }
        int dev = 0, cus = 0, per_cu = 0;
        if (hipGetDevice(&dev) != hipSuccess || hipDeviceGetAttribute(&cus, hipDeviceAttributeMultiprocessorCount, dev) != hipSuccess) { grid = -1; return; }
        if (hipFuncSetAttribute((const void*)mega_fwd, hipFuncAttributeMaxDynamicSharedMemorySize, LDS_BYTES) != hipSuccess) { fprintf(stderr, "kernel_launch: hipFuncSetAttribute failed\n"); grid = -1; return; }
        if (hipOccupancyMaxActiveBlocksPerMultiprocessor(&per_cu, (const void*)mega_fwd, NWAVES * 64, LDS_BYTES) != hipSuccess || per_cu < 1) { fprintf(stderr, "kernel_launch: occupancy query says %d blocks/CU\n", per_cu); grid = -1; return; }
        (void)hipGetLastError();
        grid = cus;
    }
    if (grid < 0) return;
    (void)hipMemsetAsync((char*)d_ws + WS_CTL, 0, CTL_ZERO_BYTES, stream);
    Args a{};
    for (int i = 0; i < 33; ++i) a.in[i] = (const float*)d_in[i];
    a.out = (float*)d_out; a.ws = (unsigned char*)d_ws;
    hipLaunchKernelGGL(mega_fwd, dim3(grid), dim3(NWAVES * 64), LDS_BYTES, stream, a);
}
```

```cpp
#include <hip/hip_runtime.h>
#include <cstdint>
#include <cstdio>

#define LAS __attribute__((address_space(3)))
#define GAS __attribute__((address_space(1)))
typedef unsigned short bf16_t;
typedef short bf16x8 __attribute__((ext_vector_type(8)));
typedef float f32x4 __attribute__((ext_vector_type(4)));
typedef float f32x2 __attribute__((ext_vector_type(2)));
typedef unsigned u32x4 __attribute__((ext_vector_type(4)));
typedef unsigned u32x2 __attribute__((ext_vector_type(2)));

constexpr int NB = 8, T = 4096, D = 1024, M = NB * T, DEPTH = 2;
constexpr int INDIM = 6680, ZLD = 6656, FF = 2816;
constexpr int GQ = 0, GK = 256, GV = 512, GR = 1024, MQ = 1536, MK = 1792, MV = 2048, MO = 2560, SU = 3072, ZG = 3584;
constexpr int YGLA = GR;
constexpr int YML = MO;
constexpr int YS2 = 0;
constexpr int MRG = 1536;
constexpr int EXC = ZG;
constexpr int YPC = ZG + 256;
constexpr int NMIX = 3584;
constexpr size_t MiB = 1u << 20;
constexpr size_t WS_CTL = 0, CTL_ZERO_BYTES = 64 * 1024;
constexpr size_t WS_MOD = 512 * 1024;
constexpr size_t WS_ZS = 1 * MiB;
constexpr size_t WS_WIN = 5 * MiB;
constexpr size_t WS_S5M1 = 18 * MiB;
constexpr size_t WS_S5M3 = 24 * MiB;
constexpr size_t WS_WGLU = 18 * MiB;
constexpr size_t WS_WPROJ = 18 * MiB + 512 * 1024;
constexpr size_t WS_WOUT = 21 * MiB + 512 * 1024;
constexpr size_t WS_WFO = 23 * MiB + 512 * 1024;
constexpr size_t WS_A16 = 31 * MiB + 512 * 1024;
constexpr size_t WS_WSM = 29 * MiB;
constexpr size_t WS_H = 32 * MiB;
constexpr size_t WS_Z = 96 * MiB;
constexpr size_t WS_END = 512 * MiB;
constexpr int CW_BAR = 4096;
constexpr int CW_S5DONE = 6144;
constexpr int CW_PANEL = 8192;
constexpr size_t WS_SLOT = 29 * MiB + 64 * 1024;
constexpr int XZ = 0, HIDC = 1024;

constexpr int RING_BYTES = 131072, LDSCTL_OFF = RING_BYTES, MISC_OFF = LDSCTL_OFF + 320, LDS_BYTES = 163840;
constexpr int LT_OFF = RING_BYTES + 512;
constexpr int NWAVES = 8;

__device__ __forceinline__ float bf2f(bf16_t v) { return __uint_as_float(((unsigned)v) << 16); }
__device__ __forceinline__ unsigned f2bf(float f) { unsigned u = __float_as_uint(f); return (u + 0x7fffu + ((u >> 16) & 1u)) >> 16; }
__device__ __forceinline__ unsigned pk2(float lo, float hi) { return f2bf(lo) | (f2bf(hi) << 16); }
__device__ __forceinline__ float bflo(unsigned u) { return __uint_as_float(u << 16); }
__device__ __forceinline__ float bfhi(unsigned u) { return __uint_as_float(u & 0xffff0000u); }
__device__ __forceinline__ int hw_lane() { int l; asm volatile("v_mbcnt_lo_u32_b32 %0, -1, 0\n\tv_mbcnt_hi_u32_b32 %0, -1, %0" : "=v"(l)); return l; }
__device__ __forceinline__ int hw_tid(int wv) { return wv * 64 + hw_lane(); }
__device__ __forceinline__ float shl(float v, int src) { return __int_as_float(__builtin_amdgcn_ds_bpermute(src << 2, __float_as_int(v))); }
__device__ __forceinline__ float wave_sum(float v, int lane) {
#pragma unroll
    for (int o = 1; o < 64; o <<= 1) v += shl(v, lane ^ o);
    return v;
}
__device__ __forceinline__ float sigmoidf_(float x) { return 1.f / (1.f + expf(-x)); }
__device__ __forceinline__ float siluf_(float x) { return x / (1.f + expf(-x)); }
__device__ __forceinline__ float logsigmoidf_(float x) { return fminf(x, 0.f) - log1pf(expf(-fabsf(x))); }
__device__ __forceinline__ float gelu_tanh(float y) { return 0.5f * y * (1.f + tanhf(0.7978845608028654f * (y + 0.044715f * y * y * y))); }
__device__ __forceinline__ float fexp_neg(float x) { return __builtin_amdgcn_exp2f(-1.4426950408889634f * x); }
__device__ __forceinline__ float fsigmoid(float x) { return __builtin_amdgcn_rcpf(1.f + fexp_neg(x)); }
#define LDS_WAIT() asm volatile("s_waitcnt lgkmcnt(0)" ::: "memory")
#define VM_WAIT() asm volatile("s_waitcnt vmcnt(0)" ::: "memory")

struct Args { const float* in[33]; float* out; unsigned char* ws; };
__device__ __forceinline__ const float* inp(int i) {
    unsigned off = (unsigned)i * 8u; asm volatile("" : "+s"(off));
    typedef const float* cfp;
    return *(const __attribute__((address_space(4))) cfp*)((const __attribute__((address_space(4))) char*)__builtin_amdgcn_kernarg_segment_ptr() + off);
}

#define WSP(off) (inp_ws() + (off))
__device__ __forceinline__ unsigned char* inp_ws() { return (unsigned char*)inp(34); }
__device__ __forceinline__ float* inp_out() { return (float*)inp(33); }
constexpr size_t DU_WFI = 0, DU_WIN1 = 11u << 20, DU_S5M1 = 24u << 20, DU_S5M3 = 30u << 20, DU_WSM1 = 34u << 20;
__device__ __forceinline__ unsigned char* DUP(size_t off) { return (unsigned char*)inp_out() + (64u << 20) + off; }
__device__ __forceinline__ bf16_t* wp_win(int l) { return (bf16_t*)(l == 0 ? WSP(5u << 20) : DUP(DU_WIN1)); }
__device__ __forceinline__ bf16_t* wp_s5m1(int l) { return (bf16_t*)(l == 0 ? WSP(18u << 20) : DUP(DU_S5M1)); }
__device__ __forceinline__ bf16_t* wp_s5m3(int l) { return (bf16_t*)(l == 0 ? WSP(24u << 20) : DUP(DU_S5M3)); }
__device__ __forceinline__ bf16_t* wp_wsm(int l) { return (bf16_t*)(l == 0 ? WSP(29u << 20) : DUP(DU_WSM1)); }

namespace pg8 {
constexpr int BM = 256, BK = 64, HALF = 128, HTB = HALF * BK * 2, STAGE_BYTES = 8 * HTB, NXCD = 8, WGM = 8;
__host__ __device__ __forceinline__ int lds_byte(int r, int c) { const int st = (r >> 4) * 2 + (c >> 5), rr = r & 15, cc = c & 31, ob = rr * 64 + cc * 2; return st * 1024 + (ob ^ (((ob >> 9) & 1) << 5)); }
__host__ __device__ __forceinline__ void stage_rc(int b, int& R, int& C) { const int st = b / 1024, sb = b % 1024, swz = sb ^ (((sb >> 9) & 1) << 5); R = (st >> 1) * 16 + swz / 64; C = (st & 1) * 32 + (swz % 64) / 2; }
__host__ __device__ __forceinline__ int perm32(int rho) { const int n = rho >> 4, i = rho & 15; return 8 * (i >> 2) + 4 * n + (i & 3); }

struct Unit { int pm, pn, br; };
struct TileOrder {
    int nM, nN, nwg, G, c, nx;
    __device__ void init(int M_, int N_, int G_, int c_, int nx_ = NXCD) { nM = M_ / BM; nN = N_ / BM; nwg = nM * nN; G = G_; c = c_; nx = nx_; }
    __device__ bool tile(int i, int& pm, int& pn) const {
        const long L = (long)i * G + c; if (L >= nwg) return false;
        int wgid = (int)L; { const int q = nwg / nx, r = nwg % nx, xcd = wgid % nx, off = wgid / nx; wgid = (xcd < r ? xcd * (q + 1) : r * (q + 1) + (xcd - r) * q) + off; }
        const int nig = WGM * nN, gid = wgid / nig, fm = gid * WGM, gsz = (nM - fm) < WGM ? (nM - fm) : WGM;
        pm = fm + ((wgid % nig) % gsz); pn = (wgid % nig) / gsz; return true;
    }
};
struct PlainSched {
    TileOrder o; const bf16_t* A; int lda; const bf16_t* Bt; int K;
    __device__ bool next(int i, Unit& u) const { u.br = 0; return o.tile(i, u.pm, u.pn); }
    __device__ const char* Ap(const Unit& u) const { return (const char*)(A + (size_t)u.pm * BM * lda); }
    __device__ const char* Bp(const Unit& u) const { return (const char*)(Bt + (size_t)u.pn * BM * K); }
};
struct MergeSched {
    TileOrder o; const bf16_t* Zb; const bf16_t* Wp;
    __device__ bool next(int i, Unit& u) const { u.br = i % 3; return o.tile(i / 3, u.pm, u.pn); }
    __device__ const char* Ap(const Unit& u) const { const int col = u.br == 0 ? YGLA : (u.br == 1 ? YML : YS2); return (const char*)(Zb + (size_t)u.pm * BM * ZLD + col); }
    __device__ const char* Bp(const Unit& u) const { return (const char*)(Wp + (size_t)u.br * 1024 * 512 + (size_t)u.pn * BM * 512); }
};

__device__ __forceinline__ unsigned cvt_pk_bf16(float lo, float hi) { unsigned r; asm volatile("v_cvt_pk_bf16_f32 %0, %1, %2" : "=v"(r) : "v"(lo), "v"(hi)); return r; }

__device__ __forceinline__ void ring_stage_piece3(LAS unsigned char* ring, const bf16_t* xb, int ldx, int wid, int lane) {
#pragma unroll
    for (int i = 0; i < 2; ++i) {
        const int b = 3 * 16 + wid + 8 * i, r = 2 * b + (lane >> 5), cs = (lane & 31) ^ (r & 15);
        __builtin_amdgcn_global_load_lds((const unsigned*)(xb + (size_t)r * ldx + cs * 8), (LAS unsigned*)(ring + b * 1024), 16, 0, 0);
    }
}
__device__ __forceinline__ u32x4 ring_read(const LAS unsigned char* ring, int rt, int chunk) { return *(const LAS u32x4*)(ring + rt * 512 + ((chunk * 16) ^ ((rt & 15) * 16))); }
struct EpiStore {
    static constexpr bool PERM = true; static constexpr bool LDS_EPI = false;
    bf16_t* O; int ldc;
    int stagger = 0;
    int actmap = 0;
    int stagger_unused_ = 0;
    const float* gbias = nullptr;
    unsigned* waitp = nullptr; unsigned waitn = 0;
    __device__ __forceinline__ bool keep(const Unit&) const { return false; }
    __device__ __forceinline__ void operator()(f32x4 (&acc)[2][2][4][2], const Unit& u, int wr, int wc, int fr, int fq, LAS unsigned char* lds_) const {
        const int row0 = u.pm * BM + wr * 64 + fr, col0 = u.pn * BM + wc * 32 + 8 * fq;
        if (waitp) {
            unsigned spins = 0; while ((unsigned)__builtin_amdgcn_readfirstlane(__hip_atomic_load(waitp, __ATOMIC_RELAXED, __HIP_MEMORY_SCOPE_AGENT)) < waitn) { __builtin_amdgcn_s_sleep(8); if (++spins > (1u << 22)) break; }
        }
        const int am = actmap == 1 ? ((u.pn == GR / 256 || u.pn == GR / 256 + 1) ? 1 : ((u.pn == MO / 256 || u.pn == MO / 256 + 1) ? 2 : 0)) : 0;
#pragma unroll
        for (int ai = 0; ai < 2; ++ai)
#pragma unroll
            for (int m = 0; m < 4; ++m) { bf16_t* rowp = O + (size_t)(row0 + ai * HALF + m * 16) * ldc + col0;
#pragma unroll
                for (int bj = 0; bj < 2; ++bj) { f32x4 v0 = acc[ai][bj][m][0], v1 = acc[ai][bj][m][1];
                    if (actmap == 2) {
                        const f32x4 b0 = *(const f32x4*)(gbias + col0 + bj * HALF), b1 = *(const f32x4*)(gbias + col0 + bj * HALF + 4);
#pragma unroll
                        for (int e = 0; e < 4; ++e) { v0[e] = 1.f + fminf(fexp_neg(v0[e] + b0[e]), 1e30f); v1[e] = 1.f + fminf(fexp_neg(v1[e] + b1[e]), 1e30f); } }
                    if (am) {
#pragma unroll
                        for (int e = 0; e < 4; ++e) { const float s0 = fsigmoid(v0[e]), s1 = fsigmoid(v1[e]); v0[e] = am == 1 ? v0[e] * s0 : s0; v1[e] = am == 1 ? v1[e] * s1 : s1; } }
                    u32x4 w; w.x = cvt_pk_bf16(v0[0], v0[1]); w.y = cvt_pk_bf16(v0[2], v0[3]); w.z = cvt_pk_bf16(v1[0], v1[1]); w.w = cvt_pk_bf16(v1[2], v1[3]);
                    *(u32x4*)(rowp + bj * HALF) = w; } }
    }
};
struct EpiGlu {
    static constexpr bool PERM = true; static constexpr bool LDS_EPI = true;
    bf16_t* O; int ldc; const bf16_t* Asrc; int lda; const float* bias; LAS unsigned char* ring;
    int stagger = 0;
    __device__ __forceinline__ bool keep(const Unit&) const { return false; }
    __device__ __forceinline__ int ldx() const { return lda; }
    __device__ __forceinline__ const bf16_t* xbase(const Unit& u) const { return Asrc + (size_t)(u.pm * BM) * lda + u.pn * BM; }
    __device__ __forceinline__ void operator()(f32x4 (&acc)[2][2][4][2], const Unit& u, int wr, int wc, int fr, int fq, LAS unsigned char* lds_) const {
        const int row0 = u.pm * BM + wr * 64 + fr, col0 = u.pn * BM + wc * 32 + 8 * fq;
        ring_stage_piece3(ring, xbase(u), lda, wr * 4 + wc, fq * 16 + fr);
        f32x4 bv[2][2];
#pragma unroll
        for (int bj = 0; bj < 2; ++bj)
#pragma unroll
            for (int n = 0; n < 2; ++n) bv[bj][n] = *(const f32x4*)(bias + col0 + bj * HALF + 4 * n);
        asm volatile("s_waitcnt vmcnt(0)" ::: "memory"); __builtin_amdgcn_s_barrier(); asm volatile("" ::: "memory");
#pragma unroll
        for (int ai = 0; ai < 2; ++ai)
#pragma unroll
            for (int m = 0; m < 4; ++m) { const int rt = ai * HALF + wr * 64 + m * 16 + fr; const size_t r = (size_t)(row0 + ai * HALF + m * 16);
#pragma unroll
                for (int bj = 0; bj < 2; ++bj) {
                    const u32x4 a = ring_read(ring, rt, wc * 4 + fq + bj * 16);
                    const f32x4 v0 = acc[ai][bj][m][0] + bv[bj][0], v1 = acc[ai][bj][m][1] + bv[bj][1];
                    u32x4 w;
                    w.x = cvt_pk_bf16(bflo(a.x) * fsigmoid(v0[0]), bfhi(a.x) * fsigmoid(v0[1])); w.y = cvt_pk_bf16(bflo(a.y) * fsigmoid(v0[2]), bfhi(a.y) * fsigmoid(v0[3]));
                    w.z = cvt_pk_bf16(bflo(a.z) * fsigmoid(v1[0]), bfhi(a.z) * fsigmoid(v1[1])); w.w = cvt_pk_bf16(bflo(a.w) * fsigmoid(v1[2]), bfhi(a.w) * fsigmoid(v1[3]));
                    *(u32x4*)(O + r * ldc + col0 + bj * HALF) = w; } }
        asm volatile("s_waitcnt lgkmcnt(0)" ::: "memory"); __builtin_amdgcn_s_barrier(); asm volatile("" ::: "memory");
    }
};
struct EpiSwiGlu {
    static constexpr bool PERM = true; static constexpr bool LDS_EPI = false;
    bf16_t* O; int ldc;
    int stagger = 0;
    __device__ __forceinline__ bool keep(const Unit&) const { return false; }
    __device__ __forceinline__ void operator()(f32x4 (&acc)[2][2][4][2], const Unit& u, int wr, int wc, int fr, int fq, LAS unsigned char* lds_) const {
        const int row0 = u.pm * BM + wr * 64 + fr, col0 = u.pn * HALF + wc * 32 + 8 * fq;
#pragma unroll
        for (int ai = 0; ai < 2; ++ai)
#pragma unroll
            for (int m = 0; m < 4; ++m) {
                float o[8];
#pragma unroll
                for (int n = 0; n < 2; ++n)
#pragma unroll
                    for (int e = 0; e < 4; ++e) { const float g = acc[ai][0][m][n][e], up = acc[ai][1][m][n][e]; o[n * 4 + e] = g * fsigmoid(g) * up; }
                u32x4 w; w.x = cvt_pk_bf16(o[0], o[1]); w.y = cvt_pk_bf16(o[2], o[3]); w.z = cvt_pk_bf16(o[4], o[5]); w.w = cvt_pk_bf16(o[6], o[7]);
                *(u32x4*)(O + (size_t)(row0 + ai * HALF + m * 16) * ldc + col0) = w; }
    }
};
struct EpiMerge {
    static constexpr bool PERM = true; static constexpr bool LDS_EPI = false;
    bf16_t* O; int ldc; const bf16_t* Zg; int ldz; const float* bgb;
    int stagger = 0;
    __device__ __forceinline__ bool keep(const Unit& u) const { return u.br < 2; }
    __device__ __forceinline__ void operator()(f32x4 (&acc)[2][2][4][2], const Unit& u, int wr, int wc, int fr, int fq, LAS unsigned char* lds_) const {
        const int row0 = u.pm * BM + wr * 64 + fr, col0 = u.pn * BM + wc * 32 + 8 * fq;
        const int br = u.br, brn = br < 2 ? br + 1 : 2;
#pragma unroll
        for (int bj = 0; bj < 2; ++bj) {
#pragma unroll
            for (int ai = 0; ai < 2; ++ai)
#pragma unroll
                for (int m = 0; m < 4; ++m) { const size_t r = (size_t)(row0 + ai * HALF + m * 16);
                    const u32x4 za = *(const u32x4*)(Zg + r * ldz + br * 1024 + col0 + bj * HALF);
                    const u32x4 zb = *(const u32x4*)(Zg + r * ldz + brn * 1024 + col0 + bj * HALF);
                    const float xa[8] = {bflo(za.x), bfhi(za.x), bflo(za.y), bfhi(za.y), bflo(za.z), bfhi(za.z), bflo(za.w), bfhi(za.w)};
                    const float xb[8] = {bflo(zb.x), bfhi(zb.x), bflo(zb.y), bfhi(zb.y), bflo(zb.z), bfhi(zb.z), bflo(zb.w), bfhi(zb.w)};
                    float f[8];
#pragma unroll
                    for (int e = 0; e < 8; ++e) { const float ra = __builtin_amdgcn_rcpf(xa[e]); f[e] = br < 2 ? xb[e] * ra : ra; }
                    f32x4 v0 = acc[ai][bj][m][0], v1 = acc[ai][bj][m][1];
                    v0[0] *= f[0]; v0[1] *= f[1]; v0[2] *= f[2]; v0[3] *= f[3]; v1[0] *= f[4]; v1[1] *= f[5]; v1[2] *= f[6]; v1[3] *= f[7];
                    if (br < 2) { acc[ai][bj][m][0] = v0; acc[ai][bj][m][1] = v1; }
                    else { u32x4 w; w.x = cvt_pk_bf16(v0[0], v0[1]); w.y = cvt_pk_bf16(v0[2], v0[3]); w.z = cvt_pk_bf16(v1[0], v1[1]); w.w = cvt_pk_bf16(v1[2], v1[3]);
                        *(u32x4*)(O + r * ldc + col0 + bj * HALF) = w; } }
        }
    }
};


typedef float f32x2v __attribute__((ext_vector_type(2)));
struct RowStats {
    unsigned long long* slots;
    unsigned* cnt;
    __device__ __forceinline__ void run(const Unit& u, int wid, int lane, LAS unsigned char* lt) const {
        const LAS f32x4* P = (const LAS f32x4*)lt; LAS f32x2v* S = (LAS f32x2v*)(lt + 16384);
        asm volatile("s_waitcnt lgkmcnt(0)" ::: "memory"); __builtin_amdgcn_s_barrier(); asm volatile("" ::: "memory");
        const int row = wid * 32 + (lane & 31);
        if (lane < 32) {
            const f32x4 p = (P[row * 4 + 0] + P[row * 4 + 1]) + (P[row * 4 + 2] + P[row * 4 + 3]);
            unsigned long long* sl = slots + ((size_t)(u.pm * BM + row) * 4 + u.pn) * 2;
            __hip_atomic_store(sl, ((unsigned long long)__float_as_uint(p[1]) << 32) | __float_as_uint(p[0]), __ATOMIC_RELAXED, __HIP_MEMORY_SCOPE_AGENT);
            __hip_atomic_store(sl + 1, ((unsigned long long)__float_as_uint(p[3]) << 32) | __float_as_uint(p[2]), __ATOMIC_RELAXED, __HIP_MEMORY_SCOPE_AGENT);
        }
        asm volatile("s_waitcnt vmcnt(0)" ::: "memory");
        if (lane == 0) __hip_atomic_fetch_add(cnt + 16 * u.pm, 1u, __ATOMIC_RELAXED, __HIP_MEMORY_SCOPE_AGENT);
        if (wid == 0) {
            unsigned spins = 0;
            while ((unsigned)__builtin_amdgcn_readfirstlane(__hip_atomic_load(cnt + 16 * u.pm, __ATOMIC_RELAXED, __HIP_MEMORY_SCOPE_AGENT)) < 32u) { __builtin_amdgcn_s_sleep(1); if (++spins > (1u << 22)) break; }
            __builtin_amdgcn_fence(__ATOMIC_ACQUIRE, "agent");
        }
        asm volatile("s_waitcnt vmcnt(0) lgkmcnt(0)" ::: "memory"); __builtin_amdgcn_s_barrier(); asm volatile("" ::: "memory");
        if (lane < 32) {
            const unsigned long long* sl = slots + (size_t)(u.pm * BM + row) * 8; float s0 = 0.f, s1 = 0.f, s2 = 0.f, s3 = 0.f;
#pragma unroll
            for (int k = 0; k < 4; ++k) { const unsigned long long a = __hip_atomic_load(sl + 2 * k, __ATOMIC_RELAXED, __HIP_MEMORY_SCOPE_AGENT), b = __hip_atomic_load(sl + 2 * k + 1, __ATOMIC_RELAXED, __HIP_MEMORY_SCOPE_AGENT);
                s0 += __uint_as_float((unsigned)a); s1 += __uint_as_float((unsigned)(a >> 32)); s2 += __uint_as_float((unsigned)b); s3 += __uint_as_float((unsigned)(b >> 32)); }
            const float r1 = rsqrtf(s0 * (1.f / 1024.f) + 1e-6f);
            const float r2 = rsqrtf(fmaxf(s1 + r1 * (s2 + s2 + r1 * s3), 0.f) * (1.f / 1024.f) + 1e-6f);
            S[row] = (f32x2v){r1, r2};
        }
        asm volatile("s_waitcnt lgkmcnt(0)" ::: "memory"); __builtin_amdgcn_s_barrier(); asm volatile("" ::: "memory");
    }
};
template <int PHASE, bool FINAL>
struct EpiNorm {
    static constexpr bool PERM = true; static constexpr bool LDS_EPI = true;
    int l; LAS unsigned char* lt;
    int stagger = 0;
    __device__ __forceinline__ bool keep(const Unit&) const { return false; }
    __device__ __forceinline__ const float* modl() const { return (const float*)WSP(WS_MOD) + (size_t)l * 8 * 6144; }
    __device__ __forceinline__ int ldx() const { return PHASE == 0 ? D : ZLD; }
    __device__ __forceinline__ const bf16_t* xbase(const Unit& u) const {
        return PHASE == 0 ? (const bf16_t*)inp_out() + (size_t)(u.pm * BM) * D + u.pn * BM : (const bf16_t*)WSP(WS_Z) + (size_t)(u.pm * BM) * ZLD + XZ + u.pn * BM; }
    __device__ __forceinline__ void operator()(f32x4 (&acc)[2][2][4][2], const Unit& u, int wr, int wc, int fr, int fq, LAS unsigned char* lds_) const {
        const int bofs = (u.pm >> 4) * 6144;
        const int colw = u.pn * BM + wc * 32 + 8 * fq;
        const int lane = fq * 16 + fr, wid = wr * 4 + wc;
        LAS unsigned char* ring = lt - LT_OFF;
        {
            const bf16_t* xb = xbase(u); const int ldx_ = ldx();
#pragma unroll
            for (int i = 0; i < 2; ++i) {
                const int b = 3 * 16 + wid + 8 * i, r = 2 * b + (lane >> 5), cs = (lane & 31) ^ (r & 15);
                __builtin_amdgcn_global_load_lds((const unsigned*)(xb + (size_t)r * ldx_ + cs * 8), (LAS unsigned*)(ring + b * 1024), 16, 0, 0);
            }
        }
        f32x4 c1[2][2];
        { const float* pw = inp(PHASE == 0 ? 5 : 7) + l * D + colw; const float* gt = modl() + (PHASE == 0 ? 2048 : 5120) + bofs + colw;
#pragma unroll
          for (int bj = 0; bj < 2; ++bj)
#pragma unroll
            for (int n = 0; n < 2; ++n) { const f32x4 p = *(const f32x4*)(pw + bj * HALF + 4 * n), g = *(const f32x4*)(gt + bj * HALF + 4 * n); c1[bj][n] = (1.f + g) * p; } }
        asm volatile("s_waitcnt vmcnt(0)" ::: "memory"); __builtin_amdgcn_s_barrier(); asm volatile("" ::: "memory");
        const int xc0 = (wc * 4 + fq) * 16;
        {
            LAS f32x4* P = (LAS f32x4*)lt;
#pragma unroll
            for (int ai = 0; ai < 2; ++ai)
#pragma unroll
                for (int m = 0; m < 4; ++m) {
                    const int rt = ai * HALF + wr * 64 + m * 16 + fr;
                    float s0 = 0.f, s1 = 0.f, s2 = 0.f, s3 = 0.f;
#pragma unroll
                    for (int bj = 0; bj < 2; ++bj) {
                        u32x4 xw = {0u, 0u, 0u, 0u};
                        if (!FINAL) xw = *(const LAS u32x4*)(ring + rt * 512 + ((xc0 + bj * 256) ^ (fr * 16)));
#pragma unroll
                        for (int n = 0; n < 2; ++n) { const f32x4 y = acc[ai][bj][m][n], t = c1[bj][n] * y; acc[ai][bj][m][n] = t;
                            if (!FINAL) { const unsigned q0 = n == 0 ? xw.x : xw.z, q1 = n == 0 ? xw.y : xw.w; const f32x4 x = (f32x4){bflo(q0), bfhi(q0), bflo(q1), bfhi(q1)};
#pragma unroll
                                for (int e = 0; e < 4; ++e) { s0 += y[e] * y[e]; s1 += x[e] * x[e]; s2 += x[e] * t[e]; s3 += t[e] * t[e]; } }
                            else {
#pragma unroll
                                for (int e = 0; e < 4; ++e) s0 += y[e] * y[e]; } }
                    }
                    s0 += shl(s0, lane ^ 16); s0 += shl(s0, lane ^ 32);
                    if (!FINAL) { s1 += shl(s1, lane ^ 16); s1 += shl(s1, lane ^ 32); s2 += shl(s2, lane ^ 16); s2 += shl(s2, lane ^ 32); s3 += shl(s3, lane ^ 16); s3 += shl(s3, lane ^ 32); }
                    if (fq == 0) P[rt * 4 + wc] = (f32x4){s0, s1, s2, s3};
                }
        }
        { RowStats st{(unsigned long long*)WSP(WS_SLOT), (unsigned*)WSP(WS_CTL) + CW_PANEL + (2 * l + PHASE) * 2048}; st.run(u, wid, lane, lt); }
        {
            const LAS f32x2v* S = (const LAS f32x2v*)(lt + 16384);
#pragma unroll
            for (int bj = 0; bj < 2; ++bj) {
                const int col = colw + bj * HALF;
                f32x4 c2[2], hv[2];
                if (!FINAL) {
                    const float* w2 = (PHASE == 0 ? inp(6) + l * D : inp(4) + (l + 1) * D) + col;
                    const float* sc = modl() + (PHASE == 0 ? 4096 : 8 * 6144 + 1024) + bofs + col; const float* sh = modl() + (PHASE == 0 ? 3072 : 8 * 6144) + bofs + col;
#pragma unroll
                    for (int n = 0; n < 2; ++n) { const f32x4 w = *(const f32x4*)(w2 + 4 * n), c = *(const f32x4*)(sc + 4 * n); c2[n] = w * (1.f + c); hv[n] = *(const f32x4*)(sh + 4 * n); }
                }
#pragma unroll
                for (int ai = 0; ai < 2; ++ai)
#pragma unroll
                    for (int m = 0; m < 4; ++m) {
                        const int rt = ai * HALF + wr * 64 + m * 16 + fr; const size_t R = (size_t)(u.pm * BM + rt); const f32x2v r = S[rt];
                        const u32x4 xw = *(const LAS u32x4*)(ring + rt * 512 + ((xc0 + bj * 256) ^ (fr * 16)));
                        const float x[8] = {bflo(xw.x), bfhi(xw.x), bflo(xw.y), bfhi(xw.y), bflo(xw.z), bfhi(xw.z), bflo(xw.w), bfhi(xw.w)};
                        f32x4 v0 = acc[ai][bj][m][0], v1 = acc[ai][bj][m][1];
#pragma unroll
                        for (int e = 0; e < 4; ++e) { v0[e] = x[e] + r.x * v0[e]; v1[e] = x[4 + e] + r.x * v1[e]; }
                        if (FINAL) { float* op = inp_out() + R * D + col; *(f32x4*)op = v0; *(f32x4*)(op + 4) = v1; }
                        else {
                            u32x4 w; w.x = cvt_pk_bf16(v0[0], v0[1]); w.y = cvt_pk_bf16(v0[2], v0[3]); w.z = cvt_pk_bf16(v1[0], v1[1]); w.w = cvt_pk_bf16(v1[2], v1[3]);
                            *(u32x4*)(PHASE == 0 ? (bf16_t*)WSP(WS_Z) + R * ZLD + XZ + col : (bf16_t*)inp_out() + R * D + col) = w;
                            const f32x4 a0 = (f32x4){bflo(w.x), bfhi(w.x), bflo(w.y), bfhi(w.y)}, a1 = (f32x4){bflo(w.z), bfhi(w.z), bflo(w.w), bfhi(w.w)};
                            const f32x4 o0 = a0 * r.y * c2[0] + hv[0], o1 = a1 * r.y * c2[1] + hv[1];
                            u32x4 h; h.x = cvt_pk_bf16(o0[0], o0[1]); h.y = cvt_pk_bf16(o0[2], o0[3]); h.z = cvt_pk_bf16(o1[0], o1[1]); h.w = cvt_pk_bf16(o1[2], o1[3]);
                            *(u32x4*)((bf16_t*)WSP(WS_H) + R * D + col) = h;
                        }
                    }
            }
        }
        asm volatile("s_waitcnt lgkmcnt(0)" ::: "memory"); __builtin_amdgcn_s_barrier(); asm volatile("" ::: "memory");
    }
};

struct S5aSched {
    int G, c; const bf16_t* Zb; const bf16_t* Bt1;
    __device__ bool next(int i, Unit& u) const { const int L = i * G + c; if (L >= 512) return false; u.pn = L < 256 ? 1 : 0; u.br = (L & 255) >> 3; u.pm = L & 7; return true; }
    __device__ const char* Ap(const Unit& u) const { return (const char*)(Zb + (size_t)u.pm * T * ZLD + SU + 16 * u.br); }
    __device__ const char* Bp(const Unit& u) const { return (const char*)(Bt1 + ((size_t)u.br * 384 + (size_t)u.pn * 256) * 256); }
};
struct EpiS5a {
    static constexpr bool PERM = true; static constexpr bool THROTTLE = false; static constexpr bool LDS_EPI = false;
    int l;
    int stagger = 0;
    __device__ __forceinline__ bool keep(const Unit&) const { return false; }
    __device__ __forceinline__ void operator()(f32x4 (&acc)[2][2][4][2], const Unit& u, int wr, int wc, int fr, int fq, LAS unsigned char* lds_) const {
        bf16_t* Zb = (bf16_t*)WSP(WS_Z); LAS unsigned char* ring = lds_;
        const int rowbase = (u.br & 15) * 2048 + u.pm * 256 + wr * 64 + fr, colsub = wc * 32 + 8 * fq, hoff = (u.br >> 4) * 256;
        if (u.pn == 0) {
            asm volatile("s_waitcnt vmcnt(0)" ::: "memory"); __builtin_amdgcn_s_barrier(); asm volatile("" ::: "memory");
#pragma unroll
            for (int ai = 0; ai < 2; ++ai)
#pragma unroll
                for (int m = 0; m < 4; ++m) {
                    const int n = ai * HALF + wr * 64 + m * 16 + fr;
                    LAS unsigned char* rowp = ring + n * 512;
                    *(LAS f32x4*)(rowp + (((colsub >> 2) ^ (n & 15)) * 16)) = acc[ai][0][m][0];
                    *(LAS f32x4*)(rowp + ((((colsub >> 2) + 1) ^ (n & 15)) * 16)) = acc[ai][0][m][1];
                    const f32x4 v0 = acc[ai][1][m][0], v1 = acc[ai][1][m][1];
                    u32x4 w; w.x = cvt_pk_bf16(v0[0], v0[1]); w.y = cvt_pk_bf16(v0[2], v0[3]); w.z = cvt_pk_bf16(v1[0], v1[1]); w.w = cvt_pk_bf16(v1[2], v1[3]);
                    *(u32x4*)(Zb + (size_t)(rowbase + ai * HALF + m * 16) * ZLD + hoff + YPC + colsub) = w;
                    asm volatile("" ::: "memory");
                }
        } else {
#pragma unroll
            for (int ai = 0; ai < 2; ++ai)
#pragma unroll
                for (int m = 0; m < 4; ++m) { bf16_t* zrow = Zb + (size_t)(rowbase + ai * HALF + m * 16) * ZLD + hoff;
                    const f32x4 v0 = acc[ai][0][m][0], v1 = acc[ai][0][m][1];
                    u32x4 w; w.x = cvt_pk_bf16(v0[0], v0[1]); w.y = cvt_pk_bf16(v0[2], v0[3]); w.z = cvt_pk_bf16(v1[0], v1[1]); w.w = cvt_pk_bf16(v1[2], v1[3]);
                    *(u32x4*)(zrow + YPC + 128 + colsub) = w; }
        }
    }
};
struct S5bSched {
    int G, c; const bf16_t* X; const bf16_t* Bt3;
    __device__ bool next(int i, Unit& u) const { const int L = i * G + c; if (L >= 256) return false; u.br = L >> 3; u.pm = L & 7; u.pn = 0; return true; }
    __device__ const char* Ap(const Unit& u) const { return (const char*)(X + (size_t)((u.br & 15) * 2048 + u.pm * 256) * ZLD + EXC + (u.br >> 4) * 128); }
    __device__ const char* Bp(const Unit& u) const { return (const char*)(Bt3 + (size_t)u.br * 256 * 128); }
};
struct EpiS5b {
    static constexpr bool PERM = true; static constexpr bool LDS_EPI = true;
    bf16_t* Zb; const float* dsk; LAS unsigned char* ring;
    int stagger = 0;
    __device__ __forceinline__ bool keep(const Unit&) const { return false; }
    __device__ __forceinline__ int ldx() const { return ZLD; }
    __device__ __forceinline__ const bf16_t* xbase(const Unit& u) const { return Zb + (size_t)((u.br & 15) * 2048 + u.pm * 256) * ZLD + YPC + (u.br >> 4) * 256; }
    __device__ __forceinline__ void operator()(f32x4 (&acc)[2][2][4][2], const Unit& u, int wr, int wc, int fr, int fq, LAS unsigned char* lds_) const {
        const int g = u.br, b = u.pm;
        ring_stage_piece3(ring, xbase(u), ZLD, wr * 4 + wc, fq * 16 + fr);
        asm volatile("s_waitcnt vmcnt(0)" ::: "memory"); __builtin_amdgcn_s_barrier(); asm volatile("" ::: "memory");
#pragma unroll
        for (int bj = 0; bj < 2; ++bj) {
            const int j0 = bj * HALF + wc * 32 + 8 * fq, s = j0 >> 4, c0 = j0 & 15;
            const f32x4 d0 = *(const f32x4*)(dsk + 16 * g + c0), d1 = *(const f32x4*)(dsk + 16 * g + c0 + 4);
#pragma unroll
            for (int ai = 0; ai < 2; ++ai)
#pragma unroll
                for (int m = 0; m < 4; ++m) {
                    const int n = ai * HALF + wr * 64 + m * 16 + fr;
                    const u32x4 yp = ring_read(ring, n, wc * 4 + fq + bj * 16);
                    bf16_t* zp = Zb + ((size_t)b * T + 16 * n + s) * ZLD + SU + 16 * g + c0;
                    const u32x4 uu = *(const u32x4*)zp;
                    const f32x4 a0 = acc[ai][bj][m][0], a1 = acc[ai][bj][m][1];
                    float y[8];
                    y[0] = a0[0] + bflo(yp.x) + d0[0] * bflo(uu.x); y[1] = a0[1] + bfhi(yp.x) + d0[1] * bfhi(uu.x);
                    y[2] = a0[2] + bflo(yp.y) + d0[2] * bflo(uu.y); y[3] = a0[3] + bfhi(yp.y) + d0[3] * bfhi(uu.y);
                    y[4] = a1[0] + bflo(yp.z) + d1[0] * bflo(uu.z); y[5] = a1[1] + bfhi(yp.z) + d1[1] * bfhi(uu.z);
                    y[6] = a1[2] + bflo(yp.w) + d1[2] * bflo(uu.w); y[7] = a1[3] + bfhi(yp.w) + d1[3] * bfhi(uu.w);
#pragma unroll
                    for (int e = 0; e < 8; ++e) { const float v = y[e]; y[e] = v * fsigmoid(1.5957691216057308f * (v + 0.044715f * v * v * v)); }
                    u32x4 w; w.x = cvt_pk_bf16(y[0], y[1]); w.y = cvt_pk_bf16(y[2], y[3]); w.z = cvt_pk_bf16(y[4], y[5]); w.w = cvt_pk_bf16(y[6], y[7]);
                    *(u32x4*)zp = w;
                    if ((m & 3) == 3) asm volatile("" ::: "memory");
                }
        }
        asm volatile("s_waitcnt lgkmcnt(0)" ::: "memory"); __builtin_amdgcn_s_barrier(); asm volatile("" ::: "memory");
    }
};
template <class Epi> __device__ __forceinline__ int epi_ldx(const Epi& E) { if constexpr (Epi::LDS_EPI) return E.ldx(); else return 0; }
template <class Epi> __device__ __forceinline__ const void* epi_xbase(const Epi& E, const Unit& u) { if constexpr (Epi::LDS_EPI) return E.xbase(u); else return nullptr; }
template <class Epi, class Sched, bool ALIGN_EPI, bool SP2, int AMODE = 0>
__device__ __forceinline__ void gemm_phase(LAS unsigned char* lds, const int wv, const int lda, const int K, const Sched& S, const Epi& E) {
    int tid_ = hw_tid(wv); asm volatile("" : "+v"(tid_));
    const int tid = tid_, wid = __builtin_amdgcn_readfirstlane(tid >> 6), lane = tid & 63, wr = wid >> 2, wc = wid & 3, fr = lane & 15, fq = lane >> 4;
    const int nt = K / BK;
    unsigned voffA[2], voffB[2];
#pragma unroll
    for (int i = 0; i < 2; ++i) { int R, C; stage_rc(tid * 16 + i * 8192, R, C); const int Rb = Epi::PERM ? ((R & ~31) + perm32(R & 31)) : R;
        voffA[i] = AMODE == 0 ? (unsigned)(R * lda + C) * 2u : (unsigned)((16 * R + (C >> 4)) * ZLD + (C & 15)) * 2u; voffB[i] = (unsigned)(Rb * K + C) * 2u; }
    const size_t kstep = (size_t)(BK * 2);
    const size_t kstepA = AMODE == 0 ? (size_t)(BK * 2) : (size_t)4 * ZLD * 2;
    const size_t hA = AMODE == 0 ? (size_t)HALF * lda * 2 : (size_t)HALF * 16 * ZLD * 2, hB = (size_t)HALF * K * 2;
    const unsigned ldsw = (unsigned)wid * 1024u;
    const int aoff = lds_byte(wr * 64 + fr, fq * 8), boff = lds_byte(wc * 32 + fr, fq * 8);
#define PG8_SA(b, h) (((b) * 2 + (h)) * HTB)
#define PG8_SB(b, h) ((4 + (b) * 2 + (h)) * HTB)
#define PG8_STAGE(bufoff, gbase, voff) do { _Pragma("unroll") for (int _i = 0; _i < 2; ++_i) \
        __builtin_amdgcn_global_load_lds((const unsigned*)((const char*)(gbase) + (voff)[_i]), (LAS unsigned*)(lds + (bufoff) + ldsw + _i * 8192), 16, 0, 0); } while (0)
#define PG8_STAGE_N(bufoff, gbase, voff) do { if (Epi::LDS_EPI && last) { \
        const int s_ = (bufoff) / HTB; const int ln_ = hw_lane(); const int ldx_ = epi_ldx(E); const char* xb_ = (const char*)epi_xbase(E, cur) + (size_t)(32 * s_) * ldx_ * 2; \
        _Pragma("unroll") for (int _i = 0; _i < 2; ++_i) { const int rl_ = 2 * (wid + 8 * _i) + (ln_ >> 5); const unsigned vo_ = (unsigned)(rl_ * ldx_ + (((ln_ & 31) ^ (rl_ & 15)) * 8)) * 2u; \
            __builtin_amdgcn_global_load_lds((const unsigned*)(xb_ + vo_), (LAS unsigned*)(lds + (bufoff) + ldsw + _i * 8192), 16, 0, 0); } \
    } else PG8_STAGE(bufoff, gbase, voff); } while (0)
#define PG8_LDA(dst, b, h) do { _Pragma("unroll") for (int m = 0; m < 4; ++m) _Pragma("unroll") for (int k = 0; k < 2; ++k) dst[m][k] = *(const LAS bf16x8*)(lds + PG8_SA(b, h) + aoff + m * 2048 + k * 1024); } while (0)
#define PG8_LDB(dst, b, h) do { _Pragma("unroll") for (int n = 0; n < 2; ++n) _Pragma("unroll") for (int k = 0; k < 2; ++k) dst[n][k] = *(const LAS bf16x8*)(lds + PG8_SB(b, h) + boff + n * 2048 + k * 1024); } while (0)
#define PG8_MMA(ai, bj, At, Bt) do { __builtin_amdgcn_s_setprio(1); _Pragma("unroll") for (int m = 0; m < 4; ++m) _Pragma("unroll") for (int n = 0; n < 2; ++n) _Pragma("unroll") for (int k = 0; k < 2; ++k) \
        acc[ai][bj][m][n] = __builtin_amdgcn_mfma_f32_16x16x32_bf16(Bt[n][k], At[m][k], acc[ai][bj][m][n], 0, 0, 0); __builtin_amdgcn_s_setprio(0); } while (0)
#define PG8_WAIT_V(n) asm volatile("s_waitcnt vmcnt(" #n ")" ::: "memory")
#define PG8_WAIT_L(n) asm volatile("s_waitcnt lgkmcnt(" #n ")" ::: "memory")
#define PG8_BAR __builtin_amdgcn_s_barrier()
#define PG8_SCHED __builtin_amdgcn_sched_barrier(0)
    Unit cur, nxt; int ui = 0;
    if (!S.next(0, cur)) return;
    if (E.stagger > 0) {
        const unsigned long long t0 = __builtin_amdgcn_s_memrealtime(), tgt = t0 + (unsigned long long)(((blockIdx.x >> 3) & 3) * E.stagger);
        while (__builtin_amdgcn_s_memrealtime() < tgt) __builtin_amdgcn_s_sleep(8);
    }
    f32x4 acc[2][2][4][2];
#pragma unroll
    for (int a = 0; a < 2; ++a)
#pragma unroll
        for (int b = 0; b < 2; ++b)
#pragma unroll
            for (int m = 0; m < 4; ++m)
#pragma unroll
                for (int n = 0; n < 2; ++n) acc[a][b][m][n] = (f32x4){0.f, 0.f, 0.f, 0.f};
    bf16x8 At[4][2], B0[2][2], B1[2][2];
    const char* cA = S.Ap(cur); const char* cB = S.Bp(cur);
#define PG8_PROLOGUE() do { \
    if constexpr (SP2) { \
        PG8_STAGE(PG8_SB(0, 0), cB, voffB); PG8_STAGE(PG8_SB(0, 1), cB + hB, voffB); PG8_STAGE(PG8_SA(0, 0), cA, voffA); PG8_STAGE(PG8_SA(0, 1), cA + hA, voffA); \
        if (wr == 1) PG8_BAR; \
        PG8_WAIT_V(2); PG8_BAR; \
        PG8_STAGE(PG8_SB(1, 0), cB + kstep, voffB); PG8_STAGE(PG8_SA(1, 0), cA + kstepA, voffA); PG8_STAGE(PG8_SB(1, 1), cB + hB + kstep, voffB); \
        PG8_WAIT_V(6); PG8_BAR; \
    } else { \
        PG8_STAGE(PG8_SB(0, 0), cB, voffB); PG8_STAGE(PG8_SA(0, 0), cA, voffA); PG8_STAGE(PG8_SB(0, 1), cB + hB, voffB); PG8_STAGE(PG8_SA(0, 1), cA + hA, voffA); \
        if (wr == 1) PG8_BAR; \
        PG8_WAIT_V(4); PG8_BAR; \
        PG8_STAGE(PG8_SB(1, 0), cB + kstep, voffB); PG8_STAGE(PG8_SA(1, 0), cA + kstepA, voffA); PG8_STAGE(PG8_SB(1, 1), cB + hB + kstep, voffB); \
        PG8_WAIT_V(6); PG8_BAR; \
    } } while (0)
    PG8_PROLOGUE();
    for (;;) {
        const bool has_next = S.next(ui + 1, nxt);
        const char* nA = has_next ? S.Ap(nxt) : cA; const char* nB = has_next ? S.Bp(nxt) : cB;
        for (int t = 0; t < nt; t += 2) {
            const bool last = (t == nt - 2);
            const char* a1 = cA + (size_t)(t + 1) * kstepA;
            const char* a2 = last ? nA : cA + (size_t)(t + 2) * kstepA; const char* b2 = last ? nB : cB + (size_t)(t + 2) * kstep;
            const char* a3 = a2 + kstepA; const char* b3 = b2 + kstep;
            if constexpr (SP2) {
            PG8_LDB(B0, 0, 0); PG8_LDB(B1, 0, 1); PG8_SCHED; PG8_LDA(At, 0, 0); PG8_STAGE(PG8_SA(1, 1), a1 + hA, voffA);
            PG8_WAIT_V(8); PG8_WAIT_L(0); PG8_BAR; PG8_MMA(0, 0, At, B0); PG8_MMA(0, 1, At, B1); PG8_BAR; PG8_SCHED;
            PG8_LDA(At, 0, 1); PG8_STAGE_N(PG8_SB(0, 0), b2, voffB); PG8_STAGE_N(PG8_SB(0, 1), b2 + hB, voffB); PG8_STAGE_N(PG8_SA(0, 0), a2, voffA);
            PG8_WAIT_V(8); PG8_WAIT_L(0); PG8_BAR; PG8_MMA(1, 0, At, B0); PG8_MMA(1, 1, At, B1); PG8_BAR; PG8_SCHED;
            PG8_LDB(B0, 1, 0); PG8_LDB(B1, 1, 1); PG8_SCHED; PG8_LDA(At, 1, 0); PG8_STAGE_N(PG8_SA(0, 1), a2 + hA, voffA);
            PG8_WAIT_V(8); PG8_WAIT_L(0); PG8_BAR; PG8_MMA(0, 0, At, B0); PG8_MMA(0, 1, At, B1); PG8_BAR; PG8_SCHED;
            PG8_LDA(At, 1, 1); PG8_STAGE_N(PG8_SB(1, 0), b3, voffB); PG8_STAGE_N(PG8_SB(1, 1), b3 + hB, voffB); PG8_STAGE_N(PG8_SA(1, 0), a3, voffA);
            PG8_WAIT_V(8); PG8_WAIT_L(0); PG8_BAR; PG8_MMA(1, 0, At, B0); PG8_MMA(1, 1, At, B1); PG8_BAR; PG8_SCHED;
            } else {
            PG8_LDB(B0, 0, 0); PG8_SCHED; PG8_LDA(At, 0, 0); PG8_STAGE(PG8_SA(1, 1), a1 + hA, voffA);
            PG8_WAIT_L(8); PG8_BAR; PG8_WAIT_L(0); PG8_MMA(0, 0, At, B0); PG8_BAR; PG8_SCHED;
            PG8_LDB(B1, 0, 1); PG8_STAGE(PG8_SB(0, 0), b2, voffB);
            PG8_BAR; PG8_WAIT_L(0); PG8_MMA(0, 1, At, B1); PG8_BAR;
            PG8_LDA(At, 0, 1); PG8_STAGE(PG8_SA(0, 0), a2, voffA);
            PG8_BAR; PG8_WAIT_L(0); PG8_MMA(1, 0, At, B0); PG8_BAR; PG8_SCHED;
            PG8_STAGE(PG8_SB(0, 1), b2 + hB, voffB);
            PG8_WAIT_V(6); PG8_BAR; PG8_MMA(1, 1, At, B1); PG8_BAR;
            PG8_LDB(B0, 1, 0); PG8_SCHED; PG8_LDA(At, 1, 0); PG8_STAGE(PG8_SA(0, 1), a2 + hA, voffA);
            PG8_WAIT_L(8); PG8_BAR; PG8_WAIT_L(0); PG8_MMA(0, 0, At, B0); PG8_BAR; PG8_SCHED;
            PG8_LDB(B1, 1, 1); PG8_STAGE(PG8_SB(1, 0), b3, voffB);
            PG8_BAR; PG8_WAIT_L(0); PG8_MMA(0, 1, At, B1); PG8_BAR;
            PG8_LDA(At, 1, 1); PG8_STAGE(PG8_SA(1, 0), a3, voffA);
            PG8_BAR; PG8_WAIT_L(0); PG8_MMA(1, 0, At, B0); PG8_BAR; PG8_SCHED;
            PG8_STAGE(PG8_SB(1, 1), b3 + hB, voffB);
            PG8_WAIT_V(6); PG8_BAR; PG8_MMA(1, 1, At, B1); PG8_BAR;
            }
        }
        if constexpr (ALIGN_EPI) { if (wr == 0) PG8_BAR; }
        { const int lane_e = hw_lane();
          E(acc, cur, wr, wc, lane_e & 15, lane_e >> 4, lds); }
        if (!has_next) break;
        if (!E.keep(cur)) {
#pragma unroll
        for (int a = 0; a < 2; ++a)
#pragma unroll
            for (int b = 0; b < 2; ++b)
#pragma unroll
                for (int m = 0; m < 4; ++m)
#pragma unroll
                    for (int n = 0; n < 2; ++n) acc[a][b][m][n] = (f32x4){0.f, 0.f, 0.f, 0.f};
        }
        cur = nxt; cA = nA; cB = nB; ++ui;
        if constexpr (Epi::LDS_EPI) { PG8_PROLOGUE(); }
        else if constexpr (ALIGN_EPI) { if (wr == 1) PG8_BAR; }
    }
    PG8_WAIT_V(0);
    if constexpr (!ALIGN_EPI) { if (wr == 0) PG8_BAR; }
    PG8_BAR;
#undef PG8_PROLOGUE
#undef PG8_STAGE_N
#undef PG8_SA
#undef PG8_SB
#undef PG8_STAGE
#undef PG8_LDA
#undef PG8_LDB
#undef PG8_MMA
#undef PG8_WAIT_V
#undef PG8_WAIT_L
#undef PG8_BAR
#undef PG8_SCHED
}
}

#define XB_TMO      128
#define XB_XCNT(j)  (256  + 64 * (j))
#define XB_XSUB(j)  (1280 + 64 * (j))
#define XB_XGEN(j)  (2304 + 64 * (j))
#define XB_TOP      3328
#define XB_TOPGEN   3392
#define XCD_BAR_WORDS 3456
#define XB_SPIN_CAP (1u << 18)
__device__ __forceinline__ unsigned xb_ld(unsigned* p)              { return __hip_atomic_load(p, __ATOMIC_RELAXED, __HIP_MEMORY_SCOPE_AGENT); }
__device__ __forceinline__ unsigned xb_add(unsigned* p, unsigned v) { return __hip_atomic_fetch_add(p, v, __ATOMIC_RELAXED, __HIP_MEMORY_SCOPE_AGENT); }
__device__ __forceinline__ unsigned xb_xcc_id() { return (unsigned)__builtin_amdgcn_s_getreg((3 << 11) | 20) & 0xFu; }
#define XB_SPIN(cond, bar) do { unsigned _sp = 0; while (cond) { __builtin_amdgcn_s_sleep(1); \
    if ((++_sp & 255u) == 0u) { if (xb_ld(&(bar)[XB_TMO])) break; if (_sp > XB_SPIN_CAP) { atomicAdd(&(bar)[XB_TMO], 1u); break; } } } } while (0)
struct XcdBarrier { unsigned* bar; unsigned x; volatile LAS unsigned* st; };
__device__ __forceinline__ XcdBarrier xcd_barrier_post(unsigned* bar, volatile LAS unsigned* st) {
    XcdBarrier b; b.bar = bar; b.x = xb_xcc_id(); b.st = st;
    if (threadIdx.x == 0) (void)xb_add(&bar[XB_XCNT(b.x)], 1u);
    return b;
}
__device__ __forceinline__ void xcd_barrier_complete(unsigned* bar, unsigned x, unsigned& nloc, unsigned& nx) {
    const unsigned G = gridDim.x * gridDim.y * gridDim.z;
    unsigned sum, cnt, mine, sp = 0u;
    for (;;) {
        sum = 0u; cnt = 0u; mine = 0u;
#pragma unroll
        for (unsigned j = 0; j < 16; ++j) { const unsigned c = xb_ld(&bar[XB_XCNT(j)]); sum += c; cnt += (c > 0u) ? 1u : 0u; mine = (j == x) ? c : mine; }
        if (sum == G) break;
        __builtin_amdgcn_s_sleep(1);
        if ((++sp & 255u) == 0u) { if (xb_ld(&bar[XB_TMO])) break; if (sp > XB_SPIN_CAP) { atomicAdd(&bar[XB_TMO], 1u); break; } }
    }
    nloc = mine > 0u ? mine : 1u; nx = cnt > 0u ? cnt : 1u;
}
__device__ __forceinline__ void xcd_barrier(const XcdBarrier& b, const int wv) {
    asm volatile("s_waitcnt vmcnt(0)" ::: "memory");
    __syncthreads();
    if (wv == 0 && hw_lane() == 0) {
        unsigned* bar = b.bar;
        __builtin_amdgcn_s_waitcnt(0);
        unsigned nloc = b.st[0], nx = b.st[1];
        if (nloc == 0u) { xcd_barrier_complete(bar, b.x, nloc, nx); b.st[0] = nloc; b.st[1] = nx; }
        const unsigned old = xb_add(&bar[XB_XSUB(b.x)], 1u);
        const unsigned gen = old / nloc;
        if (old + 1u == (gen + 1u) * nloc) {
            __builtin_amdgcn_fence(__ATOMIC_RELEASE, "agent");
            asm volatile("s_waitcnt vmcnt(0)" ::: "memory");
            const unsigned og = xb_add(&bar[XB_TOP], 1u);
            const unsigned tg = og / nx;
            if (og + 1u == (tg + 1u) * nx) xb_add(&bar[XB_TOPGEN], 1u);
            else XB_SPIN(xb_ld(&bar[XB_TOPGEN]) == tg, bar);
            __builtin_amdgcn_fence(__ATOMIC_ACQUIRE, "agent");
            xb_add(&bar[XB_XGEN(b.x)], 1u);
            asm volatile("s_waitcnt vmcnt(0)" ::: "memory");
        } else {
            XB_SPIN(xb_ld(&bar[XB_XGEN(b.x)]) == gen, bar);
            __builtin_amdgcn_fence(__ATOMIC_ACQUIRE, "agent");
            asm volatile("s_waitcnt vmcnt(0)" ::: "memory");
        }
    }
    __syncthreads();
}


__device__ __forceinline__ void transpose_item(const float* W, int ldw, int K, bf16_t* WT, int src_n0, int dst_n0, int k0, LAS float* scr, int lane) {
    {
        f32x4 v[8]; const float* wp = W + (size_t)(k0 + (lane >> 3)) * ldw + src_n0 + 4 * (lane & 7);
#pragma unroll
        for (int i = 0; i < 8; ++i) v[i] = *(const f32x4*)(wp + (size_t)(8 * i) * ldw);
        LAS float* sp = scr + (lane >> 3) * 33 + 4 * (lane & 7);
#pragma unroll
        for (int i = 0; i < 8; ++i) { sp[(8 * i) * 33 + 0] = v[i][0]; sp[(8 * i) * 33 + 1] = v[i][1]; sp[(8 * i) * 33 + 2] = v[i][2]; sp[(8 * i) * 33 + 3] = v[i][3]; }
    }
    LDS_WAIT(); asm volatile("" ::: "memory");
    const int c = lane & 7;
#pragma unroll
    for (int j = 0; j < 4; ++j) { const int n = (lane >> 3) + 8 * j; const LAS float* s = scr + (8 * c) * 33 + n;
        u32x4 o; o.x = pk2(s[0 * 33], s[1 * 33]); o.y = pk2(s[2 * 33], s[3 * 33]); o.z = pk2(s[4 * 33], s[5 * 33]); o.w = pk2(s[6 * 33], s[7 * 33]);
        *(u32x4*)(WT + (size_t)(dst_n0 + n) * K + k0 + 8 * c) = o; }
    LDS_WAIT(); asm volatile("" ::: "memory");
}
template <int MAP>
__device__ __forceinline__ void convert_matrix(const float* W, int ldw, int K, int Ndst, bf16_t* WT, LAS float* scr, int lane, int gw, int NGW, int& base) {
    const int nblk = Ndst / 32, nitems = (K / 64) * nblk;
    int first = (gw - base % NGW + NGW) % NGW;
    for (int it = first; it < nitems; it += NGW) {
        const int kb = it / nblk, nb = it % nblk, d0 = nb * 32;
        int s0 = d0;
        if (MAP == 1) s0 = d0 + (d0 < 1024 ? 0 : (d0 < 2560 ? 16 : 24));
        if (MAP == 2) { const int pn = d0 >> 8, hh = (d0 & 255) >> 7, r = d0 & 127; s0 = hh * FF + pn * 128 + r; }
        transpose_item(W, ldw, K, WT, s0, d0, kb * 64, scr, lane);
    }
    base += nitems;
}

__device__ __forceinline__ void ada_phase(LAS unsigned char* lds, int blk, int wave, int lane) {
    if (blk >= 192) return;
    const int l = blk / 96, n0 = (blk % 96) * 64;
    const float* c = inp(1); const float* W = inp(2) + (size_t)l * 1024 * 6144; const float* bias = inp(3) + l * 6144;
    LAS float* cs = (LAS float*)lds;
    LAS float* part = (LAS float*)(lds + 32768);
    for (int i = wave * 64 + lane; i < 8192; i += NWAVES * 64) { const int b = i >> 10, k = i & 1023; cs[k * 8 + b] = siluf_(c[i]); }
    __syncthreads();
    float acc[8] = {0.f, 0.f, 0.f, 0.f, 0.f, 0.f, 0.f, 0.f};
#pragma unroll 1
    for (int k0 = wave * 128; k0 < wave * 128 + 128; k0 += 16) {
        float wv[16];
#pragma unroll
        for (int j = 0; j < 16; ++j) wv[j] = W[(size_t)(k0 + j) * 6144 + n0 + lane];
#pragma unroll
        for (int j = 0; j < 16; ++j) {
            const f32x4 c0 = *(const LAS f32x4*)(cs + (k0 + j) * 8), c1 = *(const LAS f32x4*)(cs + (k0 + j) * 8 + 4);
            acc[0] += c0[0] * wv[j]; acc[1] += c0[1] * wv[j]; acc[2] += c0[2] * wv[j]; acc[3] += c0[3] * wv[j];
            acc[4] += c1[0] * wv[j]; acc[5] += c1[1] * wv[j]; acc[6] += c1[2] * wv[j]; acc[7] += c1[3] * wv[j];
        }
    }
#pragma unroll
    for (int b = 0; b < 8; ++b) part[(wave * 8 + b) * 64 + lane] = acc[b];
    __syncthreads();
    {
        const int b = wave; float s = bias[n0 + lane];
#pragma unroll
        for (int w = 0; w < 8; ++w) s += part[(w * 8 + b) * 64 + lane];
        ((float*)WSP(WS_MOD))[(size_t)(l * 8 + b) * 6144 + n0 + lane] = s;
    }
    __syncthreads();
}

template <bool WITH_POST, bool WITH_PRE, bool XIN_BF16, bool XOUT_BF16>
__device__ __forceinline__ void norm_rows(const bf16_t* Y, int ldy, const void* xin_, const float* pw, const float* modl_post, int gt_off, void* xout_,
                                          const float* w2, const float* modl_pre, int sh_off, int sc_off, bf16_t* H, int gw, int NGW, int lane) {
    const float* xin = (const float*)xin_; const bf16_t* xinb = (const bf16_t*)xin_; float* xout = (float*)xout_; bf16_t* xoutb = (bf16_t*)xout_;
    f32x4 xc[2][4], xn[2][4]; u32x2 yc[2][4], yn[2][4], bc[2][4], bn[2][4];
#define NR_LOAD(X, B, Yv, r0) do { _Pragma("unroll") for (int q = 0; q < 2; ++q) _Pragma("unroll") for (int j = 0; j < 4; ++j) { \
        if (XIN_BF16) B[q][j] = *(const u32x2*)(xinb + (size_t)((r0) + q * NGW) * D + (lane + 64 * j) * 4); else X[q][j] = *(const f32x4*)(xin + (size_t)((r0) + q * NGW) * D + (lane + 64 * j) * 4); \
        if (WITH_POST) Yv[q][j] = *(const u32x2*)(Y + (size_t)((r0) + q * NGW) * ldy + (lane + 64 * j) * 4); } } while (0)
#pragma unroll
    for (int q = 0; q < 2; ++q)
#pragma unroll
        for (int j = 0; j < 4; ++j) { xc[q][j] = (f32x4){0.f, 0.f, 0.f, 0.f}; xn[q][j] = xc[q][j]; yc[q][j] = (u32x2){0u, 0u}; yn[q][j] = yc[q][j]; bc[q][j] = yc[q][j]; bn[q][j] = yc[q][j]; }
    NR_LOAD(xc, bc, yc, gw);
    for (int row0 = gw; row0 < M; row0 += 2 * NGW) {
        const int rown = row0 + 2 * NGW;
        if (rown < M) NR_LOAD(xn, bn, yn, rown);
        f32x4 v[2][4];
        if (XIN_BF16) {
#pragma unroll
            for (int q = 0; q < 2; ++q)
#pragma unroll
                for (int j = 0; j < 4; ++j) xc[q][j] = (f32x4){bflo(bc[q][j].x), bfhi(bc[q][j].x), bflo(bc[q][j].y), bfhi(bc[q][j].y)};
        }
        if (WITH_POST) {
            float ss[2] = {0.f, 0.f};
#pragma unroll
            for (int q = 0; q < 2; ++q)
#pragma unroll
                for (int j = 0; j < 4; ++j) { const u32x2 y = yc[q][j];
                    v[q][j] = (f32x4){bflo(y.x), bfhi(y.x), bflo(y.y), bfhi(y.y)}; ss[q] += v[q][j][0] * v[q][j][0] + v[q][j][1] * v[q][j][1] + v[q][j][2] * v[q][j][2] + v[q][j][3] * v[q][j][3]; }
#pragma unroll
            for (int o = 1; o < 64; o <<= 1) { const float t0 = shl(ss[0], lane ^ o), t1 = shl(ss[1], lane ^ o); ss[0] += t0; ss[1] += t1; }
#pragma unroll
            for (int q = 0; q < 2; ++q) {
                const int row = row0 + q * NGW, b = row / T;
                const float r = rsqrtf(ss[q] * (1.f / D) + 1e-6f);
                const float* gt = modl_post + (size_t)b * 6144 + gt_off;
#pragma unroll
                for (int j = 0; j < 4; ++j) {
                    const int col = (lane + 64 * j) * 4;
                    const f32x4 xo = xc[q][j], pwv = *(const f32x4*)(pw + col), gtv = *(const f32x4*)(gt + col);
#pragma unroll
                    for (int e = 0; e < 4; ++e) v[q][j][e] = xo[e] + (1.f + gtv[e]) * (v[q][j][e] * r * pwv[e]);
                    if (XOUT_BF16) { u32x2 o; o.x = pk2(v[q][j][0], v[q][j][1]); o.y = pk2(v[q][j][2], v[q][j][3]); *(u32x2*)(xoutb + (size_t)row * D + col) = o;
                        v[q][j] = (f32x4){bflo(o.x), bfhi(o.x), bflo(o.y), bfhi(o.y)}; }
                    else *(f32x4*)(xout + (size_t)row * D + col) = v[q][j];
                }
            }
        } else {
#pragma unroll
            for (int q = 0; q < 2; ++q)
#pragma unroll
                for (int j = 0; j < 4; ++j) { v[q][j] = xc[q][j];
                    if (XOUT_BF16) { u32x2 o; o.x = pk2(v[q][j][0], v[q][j][1]); o.y = pk2(v[q][j][2], v[q][j][3]); *(u32x2*)(xoutb + (size_t)(row0 + q * NGW) * D + (lane + 64 * j) * 4) = o; } }
        }
        if (WITH_PRE) {
            float ss[2] = {0.f, 0.f};
#pragma unroll
            for (int q = 0; q < 2; ++q)
#pragma unroll
                for (int j = 0; j < 4; ++j) ss[q] += v[q][j][0] * v[q][j][0] + v[q][j][1] * v[q][j][1] + v[q][j][2] * v[q][j][2] + v[q][j][3] * v[q][j][3];
#pragma unroll
            for (int o = 1; o < 64; o <<= 1) { const float t0 = shl(ss[0], lane ^ o), t1 = shl(ss[1], lane ^ o); ss[0] += t0; ss[1] += t1; }
#pragma unroll
            for (int q = 0; q < 2; ++q) {
                const int row = row0 + q * NGW, b = row / T;
                const float r2 = rsqrtf(ss[q] * (1.f / D) + 1e-6f);
                const float* sh = modl_pre + (size_t)b * 6144 + sh_off; const float* sc = modl_pre + (size_t)b * 6144 + sc_off;
#pragma unroll
                for (int j = 0; j < 4; ++j) {
                    const int col = (lane + 64 * j) * 4;
                    const f32x4 wv = *(const f32x4*)(w2 + col), scv = *(const f32x4*)(sc + col), shv = *(const f32x4*)(sh + col);
#pragma unroll
                    for (int e = 0; e < 4; ++e) v[q][j][e] = v[q][j][e] * r2 * wv[e] * (1.f + scv[e]) + shv[e];
                    u32x2 o; o.x = pk2(v[q][j][0], v[q][j][1]); o.y = pk2(v[q][j][2], v[q][j][3]);
                    *(u32x2*)(H + (size_t)row * D + col) = o;
                }
            }
        }
#pragma unroll
        for (int q = 0; q < 2; ++q)
#pragma unroll
            for (int j = 0; j < 4; ++j) { xc[q][j] = xn[q][j]; yc[q][j] = yn[q][j]; bc[q][j] = bn[q][j]; }
    }
#undef NR_LOAD
}
__device__ __forceinline__ void zs_mfma(const bf16_t* H, const bf16_t* Wsm, float* ZS, int task, int lane) {
    typedef float f32x16_ __attribute__((ext_vector_type(16)));
    const int r32 = lane & 31, hh = lane >> 5;
    const bf16_t* ap = H + (size_t)(32 * task + r32) * D + 8 * hh;
    const bf16_t* bp = Wsm + (size_t)r32 * D + 8 * hh;
    f32x16_ acc;
#pragma unroll
    for (int r = 0; r < 16; ++r) acc[r] = 0.f;
#pragma unroll 8
    for (int ks = 0; ks < D / 16; ++ks) acc = __builtin_amdgcn_mfma_f32_32x32x16_bf16(*(const bf16x8*)(ap + 16 * ks), *(const bf16x8*)(bp + 16 * ks), acc, 0, 0, 0);
    if (r32 < 24) {
#pragma unroll
        for (int r = 0; r < 16; ++r) ZS[(size_t)(32 * task + (r & 3) + 8 * (r >> 2) + 4 * hh) * 32 + r32] = acc[r];
    }
}
__device__ __forceinline__ void convert_small(const float* w_in, bf16_t* Wsm, int part, int tid) {
    for (int i = tid; i < 4 * 1024; i += NWAVES * 64) {
        const int c = 4 * part + (i >> 10), k = i & 1023;
        float v = 0.f;
        if (c < 16) v = w_in[(size_t)k * INDIM + 1024 + c]; else if (c < 24) v = w_in[(size_t)k * INDIM + 2576 + (c - 16)];
        Wsm[c * 1024 + k] = (bf16_t)f2bf(v);
    }
}

__device__ __forceinline__ void s5_generate(int l, int g, LAS unsigned char* lds, int wv) {
    int tid = hw_tid(wv); asm volatile("" : "+v"(tid));
    LAS float* ar = (LAS float*)lds;
    LAS float* ai = ar + 17 * 64;
    LAS float* bbr = ai + 17 * 64;
    LAS float* bbi = bbr + 1024;
    LAS float* cr = bbi + 1024;
    LAS float* ci = cr + 1024;
    LAS float* Kt = ci + 1024;
    bf16_t* Bt1 = wp_s5m1(l) + (size_t)g * 384 * 256;
    bf16_t* Bt3 = wp_s5m3(l) + (size_t)g * 256 * 128;
    __syncthreads();
    {
        const float dt = expf((inp(18) + l * 32)[g]);
        for (int i = tid; i < 17 * 64; i += 512) {
            const int k = i >> 6, p = i & 63;
            const float lre = fminf((inp(16) + l * 2048)[g * 64 + p], -1e-4f), lim = (inp(17) + l * 2048)[g * 64 + p];
            const float mg = expf((float)k * lre * dt), an = (float)k * lim * dt; ar[i] = mg * cosf(an); ai[i] = mg * sinf(an);
        }
    }
    __syncthreads();
    if (tid < 64) { typedef float f32x2g __attribute__((ext_vector_type(2))); ((f32x2g*)WSP(WS_A16))[(l * 32 + g) * 64 + tid] = (f32x2g){ar[16 * 64 + tid], ai[16 * 64 + tid]}; }
    for (int i = tid; i < 1024; i += 512) {
        const int p = i >> 4;
        const float lre = fminf((inp(16) + l * 2048)[g * 64 + p], -1e-4f), lim = (inp(17) + l * 2048)[g * 64 + p];
        const float a1r = ar[64 + p], a1i = ai[64 + p];
        const float inv = 1.f / (lre * lre + lim * lim);
        const float zr_ = ((a1r - 1.f) * lre + a1i * lim) * inv, zi_ = (a1i * lre - (a1r - 1.f) * lim) * inv;
        const float br = (inp(19) + (size_t)l * 32768)[(size_t)(g * 64) * 16 + i], bi = (inp(20) + (size_t)l * 32768)[(size_t)(g * 64) * 16 + i];
        bbr[i] = zr_ * br - zi_ * bi; bbi[i] = zr_ * bi + zi_ * br;
    }
    for (int i = tid; i < 1024; i += 512) { cr[i] = (inp(21) + (size_t)l * 32768)[g * 1024 + i]; ci[i] = (inp(22) + (size_t)l * 32768)[g * 1024 + i]; }
    __syncthreads();
    {
        const int cp = tid >> 5, c = (tid >> 1) & 15, ph = tid & 1;
        float acc[16];
#pragma unroll
        for (int t = 0; t < 16; ++t) acc[t] = 0.f;
        for (int pp = 0; pp < 32; ++pp) {
            const int p = 32 * ph + pp;
            const float xr = cr[cp * 64 + p], xi = ci[cp * 64 + p], yr = bbr[p * 16 + c], yi = bbi[p * 16 + c];
            const float cbr = xr * yr - xi * yi, cbi = xr * yi + xi * yr;
#pragma unroll
            for (int t = 0; t < 16; ++t) acc[t] += cbr * ar[t * 64 + p] - cbi * ai[t * 64 + p];
        }
#pragma unroll
        for (int t = 0; t < 16; ++t) { const float o = acc[t] + shl(acc[t], (tid & 63) ^ 1); if (ph == 0) Kt[(t * 16 + cp) * 16 + c] = o; }
    }
    __syncthreads();
    for (int pc = tid; pc < 128 * 32; pc += 512) {
        const int row = pc >> 5, k0 = (pc & 31) * 8, sp = k0 >> 4, c0 = k0 & 15, p = row >> 1, e15 = 15 - sp;
        const float xr = ar[e15 * 64 + p], xi = ai[e15 * 64 + p];
        float v[8];
#pragma unroll
        for (int e = 0; e < 8; ++e) { const float yr = bbr[p * 16 + c0 + e], yi = bbi[p * 16 + c0 + e]; v[e] = (row & 1) == 0 ? (xr * yr - xi * yi) : (xr * yi + xi * yr); }
        u32x4 w; w.x = pk2(v[0], v[1]); w.y = pk2(v[2], v[3]); w.z = pk2(v[4], v[5]); w.w = pk2(v[6], v[7]);
        *(u32x4*)(Bt1 + (size_t)row * 256 + k0) = w;
    }
    for (int pc = tid; pc < 256 * 32; pc += 512) {
        const int j = pc >> 5, k0 = (pc & 31) * 8, s = j >> 4, cp = j & 15, sp = k0 >> 4, c0 = k0 & 15;
        float v[8];
#pragma unroll
        for (int e = 0; e < 8; ++e) v[e] = (sp <= s) ? Kt[((s - sp) * 16 + cp) * 16 + c0 + e] : 0.f;
        u32x4 w; w.x = pk2(v[0], v[1]); w.y = pk2(v[2], v[3]); w.z = pk2(v[4], v[5]); w.w = pk2(v[6], v[7]);
        *(u32x4*)(Bt1 + (size_t)(128 + j) * 256 + k0) = w;
    }
    for (int pc = tid; pc < 256 * 16; pc += 512) {
        const int j = pc >> 4, k0 = (pc & 15) * 8, s = j >> 4, cp = j & 15;
        float v[8];
#pragma unroll
        for (int e = 0; e < 8; ++e) {
            const int k = k0 + e, p = k >> 1;
            const float xr = cr[cp * 64 + p], xi = ci[cp * 64 + p], yr = ar[(s + 1) * 64 + p], yi = ai[(s + 1) * 64 + p];
            v[e] = (k & 1) == 0 ? (xr * yr - xi * yi) : -(xr * yi + xi * yr);
        }
        u32x4 w; w.x = pk2(v[0], v[1]); w.y = pk2(v[2], v[3]); w.z = pk2(v[4], v[5]); w.w = pk2(v[6], v[7]);
        *(u32x4*)(Bt3 + (size_t)j * 128 + k0) = w;
    }
    __syncthreads();
}
__device__ __forceinline__ void s5_scan_lds(int l, int g, int b, LAS unsigned char* lds, int wv) {
    int tid = hw_tid(wv); asm volatile("" : "+v"(tid));
    const int p = tid & 63, w = wv;
    typedef float f32x2s __attribute__((ext_vector_type(2)));
    __syncthreads();
    if (w == 0) {
        const f32x2s a16 = ((const f32x2s*)WSP(WS_A16))[(l * 32 + g) * 64 + p];
        const float a16r = a16.x, a16i = a16.y;
        float xr = 0.f, xi = 0.f;
#pragma unroll 1
        for (int n0 = 0; n0 < 256; n0 += 16) {
            f32x2s e[16]; unsigned xp[16];
#pragma unroll
            for (int j = 0; j < 16; ++j) e[j] = *(const LAS f32x2s*)(lds + (n0 + j) * 512 + (((p >> 1) ^ ((n0 + j) & 15)) * 16) + (p & 1) * 8);
            asm volatile("s_waitcnt lgkmcnt(0)" ::: "memory");
#pragma unroll
            for (int j = 0; j < 16; ++j) {
                xp[j] = pk2(xr, xi);
                const float tr = a16r * xr - a16i * xi + e[j][0], ti = a16r * xi + a16i * xr + e[j][1];
                xr = tr; xi = ti;
            }
#pragma unroll
            for (int j = 0; j < 16; ++j) *(LAS unsigned*)(lds + (n0 + j) * 512 + 4 * p) = xp[j];
            asm volatile("" ::: "memory");
        }
    }
    __syncthreads();
    char* base = (char*)((bf16_t*)WSP(WS_Z) + (size_t)((g & 15) * 2048 + b * 256) * ZLD + EXC + (g >> 4) * 128);
    constexpr size_t RP = (size_t)ZLD * 2;
#pragma unroll 8
    for (int r = 0; r < 32; ++r) { const int n = 32 * w + r; unsigned* row = (unsigned*)(base + (size_t)n * RP); row[p] = *(const LAS unsigned*)(lds + n * 512 + 4 * p); }
}

namespace mx {
typedef float f32x16 __attribute__((ext_vector_type(16)));
__device__ __forceinline__ unsigned cpk(float lo, float hi) { return pg8::cvt_pk_bf16(lo, hi); }
constexpr int PB = 72;
constexpr int L_QS = 0, L_KS = 9216, L_KT = 18432, L_VT = 27648, L_PS = 46080, L_ST = 55296, L_OS = 73728, L_VEC = 107520;
constexpr int OSP = 132;
constexpr int V_SEG = 0  , V_ELAST = 1024, V_XS = 1088  , V_END = 5184;
static_assert(L_VEC + V_END * 4 <= RING_BYTES, "mixer LDS map");
constexpr int L_VEC2 = RING_BYTES + 512, SETSZ = 384, V_RT = 0, V_CS = 64, V_WI = 128, V_WK = 192, V_ENM = 256, V_SC = 320, V_DEN = 768, V_NORM = 832, V2_END = 960;
static_assert(L_VEC2 >= MISC_OFF + 128 && L_VEC2 + V2_END * 4 <= LDS_BYTES, "mixer LDS map (upper area)");
__device__ __forceinline__ int crow(int reg, int hh) { return (reg & 3) + 8 * (reg >> 2) + 4 * hh; }
__device__ __forceinline__ float fexp(float x) { return __builtin_amdgcn_exp2f(1.4426950408889634f * x); }
__device__ __forceinline__ float flogsig(float x) { const float e = fexp(-fabsf(x)); return fminf(x, 0.f) - 0.6931471805599453f * __builtin_amdgcn_logf(1.f + e); }
#define MX_MFMA(a, b, c) __builtin_amdgcn_mfma_f32_32x32x16_bf16((a), (b), (c), 0, 0, 0)
__device__ __forceinline__ void split8(const float (&x)[8], bf16x8& hi, bf16x8& lo) {
    u32x4 h, l;
    unsigned hw[4], lw[4];
#pragma unroll
    for (int i = 0; i < 4; ++i) { const unsigned p = cpk(x[2 * i], x[2 * i + 1]); hw[i] = p; lw[i] = cpk(x[2 * i] - bflo(p), x[2 * i + 1] - bfhi(p)); }
    h.x = hw[0]; h.y = hw[1]; h.z = hw[2]; h.w = hw[3]; l.x = lw[0]; l.y = lw[1]; l.z = lw[2]; l.w = lw[3];
    hi = __builtin_bit_cast(bf16x8, h); lo = __builtin_bit_cast(bf16x8, l);
}

template <int ROLE, bool STORE = true>
__device__ __forceinline__ void stream(int l, LAS unsigned char* lds, int bh, int wvs) {
    int tid = hw_tid(wvs); asm volatile("" : "+v"(tid));
    const int lane = tid & 63, w = __builtin_amdgcn_readfirstlane(tid >> 6), r32 = lane & 31, hh = lane >> 5;
    const int b = bh >> 2, h = bh & 3;
    LAS float* vec = (LAS float*)(lds + L_VEC); LAS float* vec2 = (LAS float*)(lds + L_VEC2);
    LAS bf16_t* Qs = (LAS bf16_t*)(lds + L_QS); LAS bf16_t* Ks = (LAS bf16_t*)(lds + L_KS); LAS bf16_t* KTs = (LAS bf16_t*)(lds + L_KT);
    LAS bf16_t* VTs = (LAS bf16_t*)(lds + L_VT); LAS bf16_t* Ps = (LAS bf16_t*)(lds + L_PS); LAS bf16_t* STs = (LAS bf16_t*)(lds + L_ST);
    LAS float* Os = (LAS float*)(lds + L_OS);
    const int qcol = (ROLE == 0 ? GQ : MQ) + h * 64, kcol = (ROLE == 0 ? GK : MK) + h * 64, vcol = (ROLE == 0 ? GV : MV) + h * 128, gcol = (ROLE == 0 ? GR : MO) + h * 128;
    const __amdgpu_buffer_rsrc_t zrs = __builtin_amdgcn_make_buffer_rsrc((void*)WSP(WS_Z), 0, 0x7fffffff, 0x00020000);
    const __amdgpu_buffer_rsrc_t srs = __builtin_amdgcn_make_buffer_rsrc((void*)WSP(WS_ZS), 0, 0x7fffffff, 0x00020000);
    const __amdgpu_buffer_rsrc_t zrs3 = __builtin_amdgcn_make_buffer_rsrc((void*)(WSP(WS_Z) - 3 * ZLD * 2), 0, 0x7fffffff, 0x00020000);
    const int dp = r32, rg = 2 * w + hh, et = tid >> 3, cg = tid & 7;
    const int wa = w >> 2, wv = w & 3;
    const unsigned vo_qk = (unsigned)((hh * 4 * ZLD + 2 * dp) * 2), vo_v = (unsigned)(lane * 4), vo_g = (unsigned)(((lane >> 3) * ZLD + 16 * (lane & 7)) * 2);
    float abd0 = 0.f, abd1 = 0.f, nwv[16];
    float cwq[4][2], cwk[4][2], cbq[2] = {0.f, 0.f}, cbk[2] = {0.f, 0.f}, ibh = 0.f, fbh = 0.f, mprev = 0.f;
    bf16x8 a2hi = {0, 0, 0, 0, 0, 0, 0, 0}, a2lo = {0, 0, 0, 0, 0, 0, 0, 0};
#pragma unroll
    for (int r = 0; r < 16; ++r) nwv[r] = 0.f;
#pragma unroll
    for (int j = 0; j < 4; ++j) { cwq[j][0] = cwq[j][1] = 0.f; cwk[j][0] = cwk[j][1] = 0.f; }
    if (ROLE == 0) {
        const float* a2 = inp(9) + l * 16 * 256; const float* ab = inp(10) + l * 256; const float* nw = inp(11) + l * 512;
#pragma unroll
        for (int r = 0; r < 16; ++r) nwv[r] = nw[h * 128 + 16 * cg + r];
        abd0 = ab[h * 64 + 2 * dp]; abd1 = ab[h * 64 + 2 * dp + 1];
        float bq[8];
#pragma unroll
        for (int j = 0; j < 8; ++j) bq[j] = a2[(8 * hh + j) * 256 + h * 64 + 32 * (w & 1) + r32];
        split8(bq, a2hi, a2lo);
    } else {
        const float* cw = inp(12) + l * 4 * 512; const float* cb = inp(13) + l * 512;
#pragma unroll
        for (int j = 0; j < 4; ++j)
#pragma unroll
            for (int c = 0; c < 2; ++c) { cwq[j][c] = cw[j * 512 + h * 64 + 2 * dp + c]; cwk[j][c] = cw[j * 512 + 256 + h * 64 + 2 * dp + c]; }
#pragma unroll
        for (int c = 0; c < 2; ++c) { cbq[c] = cb[h * 64 + 2 * dp + c]; cbk[c] = cb[256 + h * 64 + 2 * dp + c]; }
        ibh = (inp(14) + l * 4)[h]; fbh = (inp(15) + l * 4)[h];
    }
    for (int i = tid; i < 128 * PB / 2; i += 512) ((LAS unsigned*)STs)[i] = 0u;
    for (int i = tid; i < 64 * PB / 2; i += 512) ((LAS unsigned*)Ps)[i] = 0u;
    if (tid < 128) vec2[V_NORM + tid] = 0.f;
    f32x16 accS;
#pragma unroll
    for (int r = 0; r < 16; ++r) accS[r] = 0.f;
    unsigned qi[7], ki[7], vi[8]; float zs0 = 0.f, zs1 = 0.f; u32x4 gt0 = {0u, 0u, 0u, 0u}, gt1 = {0u, 0u, 0u, 0u}, ga0 = {0u, 0u, 0u, 0u}, ga1 = {0u, 0u, 0u, 0u};
#define MX_LOAD(mrow) do { \
        const unsigned rb_ = (unsigned)((mrow) + 8 * w) * (unsigned)(ZLD * 2); \
        if (ROLE == 0) { \
            _Pragma("unroll") for (int i = 0; i < 4; ++i) { qi[i] = __builtin_amdgcn_raw_buffer_load_b32(zrs, vo_qk, rb_ + (unsigned)((i * ZLD + qcol) * 2), 0); ki[i] = __builtin_amdgcn_raw_buffer_load_b32(zrs, vo_qk, rb_ + (unsigned)((i * ZLD + kcol) * 2), 0); } \
            if (w < 4) { const unsigned so_ = (unsigned)((mrow) + 32 * (w >> 1)) * 128u; ga0 = __builtin_amdgcn_raw_buffer_load_b128(srs, (unsigned)((r32 * 32 + 8 * hh) * 4), so_, 0); ga1 = __builtin_amdgcn_raw_buffer_load_b128(srs, (unsigned)((r32 * 32 + 8 * hh) * 4 + 16), so_, 0); } \
        } else { \
            _Pragma("unroll") for (int i = 0; i < 7; ++i) { qi[i] = __builtin_amdgcn_raw_buffer_load_b32(zrs3, vo_qk, rb_ + (unsigned)((i * ZLD + qcol) * 2), 0); ki[i] = __builtin_amdgcn_raw_buffer_load_b32(zrs3, vo_qk, rb_ + (unsigned)((i * ZLD + kcol) * 2), 0); } \
            if (w == 7) { const unsigned so_ = (unsigned)(mrow) * 128u; zs0 = __builtin_bit_cast(float, __builtin_amdgcn_raw_buffer_load_b32(srs, (unsigned)(lane * 128), so_ + (unsigned)((16 + h) * 4), 0)); \
                                                                         zs1 = __builtin_bit_cast(float, __builtin_amdgcn_raw_buffer_load_b32(srs, (unsigned)(lane * 128), so_ + (unsigned)((20 + h) * 4), 0)); } \
        } \
        _Pragma("unroll") for (int i = 0; i < 8; ++i) vi[i] = __builtin_amdgcn_raw_buffer_load_b32(zrs, vo_v, rb_ + (unsigned)((i * ZLD + vcol) * 2), 0); \
    } while (0)
#define MX_XS() do { if (w < 4) { \
        asm volatile("" : "+v"(ga0), "+v"(ga1)); \
        const float gf[8] = {__uint_as_float(ga0.x), __uint_as_float(ga0.y), __uint_as_float(ga0.z), __uint_as_float(ga0.w), __uint_as_float(ga1.x), __uint_as_float(ga1.y), __uint_as_float(ga1.z), __uint_as_float(ga1.w)}; \
        bf16x8 ahi, alo; split8(gf, ahi, alo); \
        f32x16 xa; _Pragma("unroll") for (int r = 0; r < 16; ++r) xa[r] = 0.f; \
        xa = MX_MFMA(alo, a2hi, xa); xa = MX_MFMA(ahi, a2lo, xa); xa = MX_MFMA(ahi, a2hi, xa); \
        _Pragma("unroll") for (int r = 0; r < 16; ++r) vec[V_XS + (32 * (w >> 1) + crow(r, hh)) * 64 + 32 * (w & 1) + r32] = xa[r]; } } while (0)
#define MX_SCALARS(sv) do { \
        asm volatile("" : "+v"(zs0), "+v"(zs1)); \
        const float ip = zs0 + ibh, lf = flogsig(zs1 + fbh); \
        float bs = lf; \
        _Pragma("unroll") for (int o = 1; o < 64; o <<= 1) { const float t = shl(bs, lane >= o ? lane - o : lane); if (lane >= o) bs += t; } \
        const float cs = ip - bs; \
        float pm = cs; \
        _Pragma("unroll") for (int o = 1; o < 64; o <<= 1) { const float t = shl(pm, lane >= o ? lane - o : lane); if (lane >= o) pm = fmaxf(pm, t); } \
        const float mt = bs + fmaxf(mprev, pm); \
        (sv)[V_RT + lane] = bs - mt; (sv)[V_CS + lane] = cs; (sv)[V_WI + lane] = fexp(bs + mprev - mt); (sv)[V_ENM + lane] = fexp(-mt); \
        const float mnew = shl(mt, 63), b63 = shl(bs, 63); \
        (sv)[V_WK + lane] = fexp(b63 + cs - mnew); \
        if (lane == 0) (sv)[V_SC] = fexp(b63 + mprev - mnew); \
        mprev = mnew; \
    } while (0)
#define MX_PIN7(a) asm volatile("" : "+v"(a[0]), "+v"(a[1]), "+v"(a[2]), "+v"(a[3]), "+v"(a[4]), "+v"(a[5]), "+v"(a[6]))
#define MX_PIN4(a) asm volatile("" : "+v"(a[0]), "+v"(a[1]), "+v"(a[2]), "+v"(a[3]))
#define MX_PIN8(a) asm volatile("" : "+v"(a[0]), "+v"(a[1]), "+v"(a[2]), "+v"(a[3]), "+v"(a[4]), "+v"(a[5]), "+v"(a[6]), "+v"(a[7]))
    unsigned m0 = (unsigned)(b * T);
    MX_LOAD(m0);
    if (ROLE == 0) MX_XS(); else if (w == 7) MX_SCALARS(vec2);
    __syncthreads();

#pragma unroll 1
    for (int n = 0; n <= 64; ++n) {
        if (n > 0) {
            const LAS float* orow = Os + et * OSP + 16 * cg;
            float o[16];
#pragma unroll
            for (int q4 = 0; q4 < 4; ++q4) { const f32x4 t4 = *(const LAS f32x4*)(orow + 4 * q4); o[4 * q4] = t4[0]; o[4 * q4 + 1] = t4[1]; o[4 * q4 + 2] = t4[2]; o[4 * q4 + 3] = t4[3]; }
            asm volatile("" : "+v"(gt0), "+v"(gt1));
            const unsigned gw_[8] = {gt0.x, gt0.y, gt0.z, gt0.w, gt1.x, gt1.y, gt1.z, gt1.w};
            float y[16];
            if (ROLE == 0) {
                float ss = 0.f;
#pragma unroll
                for (int e = 0; e < 16; ++e) ss += o[e] * o[e];
                ss += shl(ss, lane ^ 1); ss += shl(ss, lane ^ 2); ss += shl(ss, lane ^ 4);
                const float rn = rsqrtf(ss * (1.f / 128.f) + 1e-6f);
#pragma unroll
                for (int e = 0; e < 16; ++e) { const float g = (e & 1) ? bfhi(gw_[e >> 1]) : bflo(gw_[e >> 1]); y[e] = o[e] * rn * nwv[e] * g; }
            } else {
                const float rdiv = vec2[V_DEN + et];
#pragma unroll
                for (int e = 0; e < 16; ++e) { const float g = (e & 1) ? bfhi(gw_[e >> 1]) : bflo(gw_[e >> 1]); y[e] = o[e] * rdiv * g; }
            }
            u32x4 s0, s1;
            s0.x = cpk(y[0], y[1]); s0.y = cpk(y[2], y[3]); s0.z = cpk(y[4], y[5]); s0.w = cpk(y[6], y[7]);
            s1.x = cpk(y[8], y[9]); s1.y = cpk(y[10], y[11]); s1.z = cpk(y[12], y[13]); s1.w = cpk(y[14], y[15]);
            const unsigned so_ = (m0 - 64u + 8u * (unsigned)w) * (unsigned)(ZLD * 2) + (unsigned)(gcol * 2);
            if (STORE) { __builtin_amdgcn_raw_buffer_store_b128(s0, zrs, vo_g, so_, 0); __builtin_amdgcn_raw_buffer_store_b128(s1, zrs, vo_g + 16u, so_, 0); } else { asm volatile("" :: "v"(s0), "v"(s1)); }
        }
        if (n == 64) break;
        const LAS float* sv = vec2 + (n & 1) * SETSZ;
        float c4[4][2], qf[4][2], kf[4][2];
        if (ROLE == 0) {
            MX_PIN4(qi); MX_PIN4(ki);
            float run0 = 0.f, run1 = 0.f;
#pragma unroll
            for (int i = 0; i < 4; ++i) {
                const f32x2 x2 = *(const LAS f32x2*)(vec + V_XS + (4 * rg + i) * 64 + 2 * dp);
                run0 += flogsig(x2[0] + abd0) * (1.f / 16.f); run1 += flogsig(x2[1] + abd1) * (1.f / 16.f); c4[i][0] = run0; c4[i][1] = run1;
                qf[i][0] = bflo(qi[i]) * 0.125f; qf[i][1] = bfhi(qi[i]) * 0.125f; kf[i][0] = bflo(ki[i]); kf[i][1] = bfhi(ki[i]);
            }
            *(LAS f32x2*)(vec + V_SEG + rg * 64 + 2 * dp) = (f32x2){run0, run1};
            __syncthreads();
        } else {
            MX_PIN7(qi); MX_PIN7(ki);
            if (n == 0 && rg == 0) { qi[0] = qi[1] = qi[2] = 0u; ki[0] = ki[1] = ki[2] = 0u; }
#pragma unroll
            for (int i = 0; i < 4; ++i) {
                float aq0 = cbq[0], aq1 = cbq[1], ak0 = cbk[0], ak1 = cbk[1];
#pragma unroll
                for (int j = 0; j < 4; ++j) { aq0 += cwq[j][0] * bflo(qi[i + j]); aq1 += cwq[j][1] * bfhi(qi[i + j]); ak0 += cwk[j][0] * bflo(ki[i + j]); ak1 += cwk[j][1] * bfhi(ki[i + j]); }
                qf[i][0] = aq0 * fsigmoid(aq0); qf[i][1] = aq1 * fsigmoid(aq1); kf[i][0] = ak0 * fsigmoid(ak0) * 0.125f; kf[i][1] = ak1 * fsigmoid(ak1) * 0.125f;
                c4[i][0] = 0.f; c4[i][1] = 0.f;
            }
        }
        {
            float kt0[4], kt1[4];
            if (ROLE == 0) {
                float off0 = 0.f, off1 = 0.f, tot0 = 0.f, tot1 = 0.f;
#pragma unroll
                for (int r2 = 0; r2 < 16; ++r2) { const f32x2 s = *(const LAS f32x2*)(vec + V_SEG + r2 * 64 + 2 * dp); tot0 += s[0]; tot1 += s[1]; off0 += (r2 < rg) ? s[0] : 0.f; off1 += (r2 < rg) ? s[1] : 0.f; }
                if (rg == 0) *(LAS f32x2*)(vec + V_ELAST + 2 * dp) = (f32x2){fexp(tot0), fexp(tot1)};
#pragma unroll
                for (int i = 0; i < 4; ++i) {
                    const float cum0 = off0 + c4[i][0], cum1 = off1 + c4[i][1];
                    const float kk0 = kf[i][0] * fexp(-cum0), kk1 = kf[i][1] * fexp(-cum1);
                    *(LAS unsigned*)(Qs + (4 * rg + i) * PB + 2 * dp) = cpk(qf[i][0] * fexp(cum0), qf[i][1] * fexp(cum1));
                    *(LAS unsigned*)(Ks + (4 * rg + i) * PB + 2 * dp) = cpk(kk0, kk1);
                    kt0[i] = kk0; kt1[i] = kk1;
                }
            } else {
#pragma unroll
                for (int i = 0; i < 4; ++i) {
                    *(LAS unsigned*)(Qs + (4 * rg + i) * PB + 2 * dp) = cpk(qf[i][0], qf[i][1]);
                    *(LAS unsigned*)(Ks + (4 * rg + i) * PB + 2 * dp) = cpk(kf[i][0], kf[i][1]);
                    const float wk = sv[V_WK + 4 * rg + i];
                    kt0[i] = kf[i][0] * wk; kt1[i] = kf[i][1] * wk;
                }
            }
            *(LAS u32x2*)(KTs + (2 * dp) * PB + 4 * rg) = (u32x2){cpk(kt0[0], kt0[1]), cpk(kt0[2], kt0[3])};
            *(LAS u32x2*)(KTs + (2 * dp + 1) * PB + 4 * rg) = (u32x2){cpk(kt1[0], kt1[1]), cpk(kt1[2], kt1[3])};
            MX_PIN8(vi);
            u32x4 v0, v1;
            v0.x = (vi[0] & 0xffffu) | (vi[1] << 16); v0.y = (vi[2] & 0xffffu) | (vi[3] << 16); v0.z = (vi[4] & 0xffffu) | (vi[5] << 16); v0.w = (vi[6] & 0xffffu) | (vi[7] << 16);
            v1.x = (vi[0] >> 16) | (vi[1] & 0xffff0000u); v1.y = (vi[2] >> 16) | (vi[3] & 0xffff0000u); v1.z = (vi[4] >> 16) | (vi[5] & 0xffff0000u); v1.w = (vi[6] >> 16) | (vi[7] & 0xffff0000u);
            *(LAS u32x4*)(VTs + (2 * lane) * PB + 8 * w) = v0; *(LAS u32x4*)(VTs + (2 * lane + 1) * PB + 8 * w) = v1;
        }
        __syncthreads();
        { const unsigned so_ = (m0 + 8u * (unsigned)w) * (unsigned)(ZLD * 2) + (unsigned)(gcol * 2); gt0 = __builtin_amdgcn_raw_buffer_load_b128(zrs, vo_g, so_, 0); gt1 = __builtin_amdgcn_raw_buffer_load_b128(zrs, vo_g + 16u, so_, 0); }
        if (n < 63) MX_LOAD(m0 + 64u);
#define MX_FRAG(base, row, ks) (*(const LAS bf16x8*)(lds + (base) + ((row) * PB + 16 * (ks) + 8 * hh) * 2))
        if (w < 3) {
            const int ti = (w >= 1) ? 1 : 0, sj = (w == 2) ? 1 : 0;
            f32x16 sc;
#pragma unroll
            for (int r = 0; r < 16; ++r) sc[r] = 0.f;
#pragma unroll
            for (int ks = 0; ks < 4; ++ks) sc = MX_MFMA(MX_FRAG(L_KS, 32 * sj + r32, ks), MX_FRAG(L_QS, 32 * ti + r32, ks), sc);
            const float rtv = (ROLE == 1) ? sv[V_RT + 32 * ti + r32] : 0.f;
            float pv[16];
#pragma unroll
            for (int r = 0; r < 16; ++r) {
                const int s = crow(r, hh);
                const bool keep = (ti != sj) || (s <= r32);
                float val = sc[r];
                if (ROLE == 1) val *= fexp(rtv + sv[V_CS + 32 * sj + s]);
                pv[r] = keep ? val : 0.f;
            }
#pragma unroll
            for (int q4 = 0; q4 < 4; ++q4) *(LAS u32x2*)(Ps + (32 * ti + r32) * PB + 32 * sj + 8 * q4 + 4 * hh) = (u32x2){cpk(pv[4 * q4], pv[4 * q4 + 1]), cpk(pv[4 * q4 + 2], pv[4 * q4 + 3])};
        }
        f32x16 acco;
#pragma unroll
        for (int r = 0; r < 16; ++r) acco[r] = 0.f;
#pragma unroll
        for (int ks = 0; ks < 4; ++ks) acco = MX_MFMA(MX_FRAG(L_QS, 32 * wa + r32, ks), MX_FRAG(L_ST, 32 * wv + r32, ks), acco);
        if (ROLE == 1) {
#pragma unroll
            for (int r = 0; r < 16; ++r) acco[r] *= sv[V_WI + 32 * wa + crow(r, hh)];
            const float carry = sv[V_SC];
#pragma unroll
            for (int r = 0; r < 16; ++r) accS[r] *= carry;
        }
#pragma unroll
        for (int ks = 0; ks < 4; ++ks) accS = MX_MFMA(MX_FRAG(L_KT, 32 * wa + r32, ks), MX_FRAG(L_VT, 32 * wv + r32, ks), accS);
        if (ROLE == 0) {
#pragma unroll
            for (int r = 0; r < 16; ++r) accS[r] *= vec[V_ELAST + 32 * wa + crow(r, hh)];
        }
        __syncthreads();
        if (wa == 0) {
#pragma unroll
            for (int ks = 0; ks < 2; ++ks) acco = MX_MFMA(MX_FRAG(L_PS, r32, ks), MX_FRAG(L_VT, 32 * wv + r32, ks), acco);
        } else {
#pragma unroll
            for (int ks = 0; ks < 4; ++ks) acco = MX_MFMA(MX_FRAG(L_PS, 32 + r32, ks), MX_FRAG(L_VT, 32 * wv + r32, ks), acco);
        }
#pragma unroll
        for (int r = 0; r < 16; ++r) Os[(32 * wa + crow(r, hh)) * OSP + 32 * wv + r32] = acco[r];
#pragma unroll
        for (int q4 = 0; q4 < 4; ++q4) { u32x2 p; p.x = cpk(accS[4 * q4], accS[4 * q4 + 1]); p.y = cpk(accS[4 * q4 + 2], accS[4 * q4 + 3]);
            *(LAS u32x2*)(STs + (32 * wv + r32) * PB + 32 * wa + 8 * q4 + 4 * hh) = p; }
        if (ROLE == 0) { if (n < 63) MX_XS(); }
        else {
            const LAS float* nprev = vec2 + V_NORM + (n & 1) * 64;
            if (w == 0) {
                float qn = 0.f, si = 0.f;
#pragma unroll
                for (int c8i = 0; c8i < 8; ++c8i) {
                    const u32x4 qv = *(const LAS u32x4*)(Qs + lane * PB + 8 * c8i), pv = *(const LAS u32x4*)(Ps + lane * PB + 8 * c8i);
                    const f32x4 n0 = *(const LAS f32x4*)(nprev + 8 * c8i), n1 = *(const LAS f32x4*)(nprev + 8 * c8i + 4);
                    qn += bflo(qv.x) * n0[0] + bfhi(qv.x) * n0[1] + bflo(qv.y) * n0[2] + bfhi(qv.y) * n0[3] + bflo(qv.z) * n1[0] + bfhi(qv.z) * n1[1] + bflo(qv.w) * n1[2] + bfhi(qv.w) * n1[3];
                    si += (bflo(pv.x) + bfhi(pv.x)) + (bflo(pv.y) + bfhi(pv.y)) + (bflo(pv.z) + bfhi(pv.z)) + (bflo(pv.w) + bfhi(pv.w));
                }
                const float den = sv[V_WI + lane] * qn + si;
                vec2[V_DEN + lane] = 1.f / fmaxf(fabsf(den), sv[V_ENM + lane]);
            } else if (w == 7) {
                if (n < 63) MX_SCALARS(vec2 + ((n + 1) & 1) * SETSZ);
            } else if (w == 1) {
                float kn = 0.f;
#pragma unroll
                for (int c8i = 0; c8i < 8; ++c8i) { const u32x4 kv = *(const LAS u32x4*)(KTs + lane * PB + 8 * c8i);
                    kn += (bflo(kv.x) + bfhi(kv.x)) + (bflo(kv.y) + bfhi(kv.y)) + (bflo(kv.z) + bfhi(kv.z)) + (bflo(kv.w) + bfhi(kv.w)); }
                vec2[V_NORM + ((n + 1) & 1) * 64 + lane] = sv[V_SC] * nprev[lane] + kn;
            }
        }
        __syncthreads();
        m0 += 64u;
    }
#undef MX_LOAD
#undef MX_XS
#undef MX_PIN4
#undef MX_PIN7
#undef MX_PIN8
#undef MX_SCALARS
#undef MX_FRAG
}
}

#ifndef PHASE_MASK
#define PHASE_MASK 0xFFFF
#endif
#define PH(k) if constexpr ((PHASE_MASK >> (k)) & 1)
#ifndef STAGGER_TICKS
#define STAGGER_TICKS 0
#endif
#ifndef PROBE_GEMM_REPS
#define PROBE_GEMM_REPS 1
#endif
#ifndef PROBE_STREAM_REPS
#define PROBE_STREAM_REPS 1
#endif
#ifndef PROBE_GEMM_MASK
#define PROBE_GEMM_MASK 0xFFFF
#endif
#define GREP(k) _Pragma("unroll 1") for (int rep_ = 0; rep_ < (((PROBE_GEMM_MASK >> (k)) & 1) ? PROBE_GEMM_REPS : 1); ++rep_)
#define GREP_BAR if (rep_) GRID_BAR();
#define BLK_ENV int blk = blockIdx.x; asm volatile("" : "+s"(blk));
#define PHASE_ENV BLK_ENV int tid = hw_tid(wave_s); asm volatile("" : "+v"(tid)); const int lane = tid & 63, wave = wave_s; int vcu_ = vcu; asm volatile("" : "+s"(vcu_)); const int gw = vcu_ * NWAVES + wave; (void)lane; (void)gw;
__global__ void __launch_bounds__(NWAVES * 64, 2) mega_fwd(Args args) {
    extern __shared__ __attribute__((aligned(16))) unsigned char lds_raw[];
    LAS unsigned char* lds = (LAS unsigned char*)lds_raw;
    const int G = gridDim.x, blk0 = blockIdx.x;
    const int wave_s = __builtin_amdgcn_readfirstlane(threadIdx.x >> 6);
    const int vcu = (G % 8 == 0) ? (blk0 % 8) * (G / 8) + blk0 / 8 : blk0;
    const int NGW = G * NWAVES;
    for (int u = threadIdx.x; u < (LDS_BYTES - LDSCTL_OFF) / 4; u += NWAVES * 64) ((LAS unsigned*)(lds + LDSCTL_OFF))[u] = 0u;
    __syncthreads();
    (void)xcd_barrier_post((unsigned*)(args.ws + WS_CTL) + CW_BAR, (volatile LAS unsigned*)(lds + MISC_OFF) + 8);
#define GRID_BAR() do { XcdBarrier b_; b_.bar = (unsigned*)(inp_ws() + WS_CTL) + CW_BAR; b_.x = xb_xcc_id(); b_.st = (volatile LAS unsigned*)(lds + MISC_OFF) + 8; xcd_barrier(b_, wave_s); } while (0)

    PH(0) { PHASE_ENV
        ada_phase(lds, blk, wave, lane);
        if (blk >= 192 && blk < 224) s5_generate(0, blk - 192, lds, wave_s);
        else {
            if (blk >= 224 && blk < 232) { convert_small(inp(8), (bf16_t*)WSP(WS_WSM), blk - 224, tid); __syncthreads(); }
            LAS float* scr = (LAS float*)(lds + wave * 16384);
            int base = 0;
            convert_matrix<1>(inp(8), INDIM, 1024, ZLD, (bf16_t*)WSP(WS_WIN), scr, lane, (blk < 192 ? blk : blk - 32) * NWAVES + wave, (G - 32) * NWAVES, base);
        }
    }
    GRID_BAR();

#pragma unroll 1
    for (int l = 0; l < DEPTH; ++l) {
        PH(1) if (l == 0) { PHASE_ENV
            norm_rows<false, true, false, true>(nullptr, 0, inp(0), nullptr, nullptr, 0, inp_out(), inp(4), (const float*)WSP(WS_MOD), 0, 1024, (bf16_t*)WSP(WS_H), gw, NGW, lane);
            GRID_BAR();
        }
        PH(2) GREP(2) { GREP_BAR BLK_ENV
            pg8::PlainSched S; S.o.init(M, NMIX, G, blk); S.A = (const bf16_t*)WSP(WS_H); S.lda = D; S.Bt = wp_win(l); S.K = D;
            pg8::EpiStore E{(bf16_t*)WSP(WS_Z), ZLD, STAGGER_TICKS, 1};
            pg8::gemm_phase<pg8::EpiStore, pg8::PlainSched, true, true>(lds, wave_s, D, D, S, E);
            { const int task = (int)(((G % 8 == 0) ? (blk % 8) * (G / 8) + blk / 8 : blk) * NWAVES + wave_s);
              for (int t = task; t < M / 32; t += G * NWAVES) zs_mfma((const bf16_t*)WSP(WS_H), wp_wsm(l), (float*)WSP(WS_ZS), t, hw_lane()); }
        }
        GRID_BAR();
        PH(3) { PHASE_ENV
            if ((blk & 7) < 2) {
                const int sidx = (blk >> 3) * 2 + (blk & 7);
                if (sidx < 32) mx::stream<0>(l, lds, sidx, wave_s); else mx::stream<1>(l, lds, sidx - 32, wave_s);
                if (l + 1 < DEPTH) {
                    __syncthreads();
                    int blk2 = blockIdx.x; asm volatile("" : "+s"(blk2)); const int sidx2 = (blk2 >> 3) * 2 + (blk2 & 7);
                    int tid2 = hw_tid(wave_s); asm volatile("" : "+v"(tid2)); const int lane2 = tid2 & 63;
                    if (sidx2 < 32) { s5_generate(l + 1, sidx2, lds, wave_s); __syncthreads(); }
                    int base = 0; LAS float* scr = (LAS float*)(lds + wave_s * 16384);
                    convert_matrix<1>(inp(8) + (size_t)(l + 1) * D * INDIM, INDIM, 1024, ZLD, wp_win(l + 1), scr, lane2, sidx2 * NWAVES + wave_s, 64 * NWAVES, base);
                    convert_matrix<2>(inp(31) + (size_t)l * D * 2 * FF, 2 * FF, 1024, 2 * FF, (bf16_t*)DUP(DU_WFI), scr, lane2, sidx2 * NWAVES + wave_s, 64 * NWAVES, base);
                    if (sidx2 >= 32 && sidx2 < 40) { __syncthreads(); convert_small(inp(8) + (size_t)(l + 1) * D * INDIM, wp_wsm(l + 1), sidx2 - 32, tid2); }
                }
            } else {
#define GX_ENV int blk_ = blockIdx.x; asm volatile("" : "+s"(blk_)); const int xq = blk_ & 7, gidx = (blk_ >> 3) * 6 + (xq - 2); const bool grpD = xq < 4; (void)gidx; (void)grpD;
#define S5_TASK(kk) do { \
                    { GX_ENV const int task = (grpD ? (blk_ >> 3) * 2 + (xq - 2) : 128 + (blk_ >> 3) * 4 + (xq - 4)) + 64 * (kk); \
                      int g256 = 256; asm volatile("" : "+s"(g256)); pg8::S5aSched S; S.G = g256; S.c = task; S.Zb = (const bf16_t*)WSP(WS_Z); S.Bt1 = wp_s5m1(l); pg8::EpiS5a E{l}; \
                      pg8::gemm_phase<pg8::EpiS5a, pg8::S5aSched, true, true, 1>(lds, wave_s, 0, 256, S, E); } \
                    { GX_ENV const int task = (grpD ? (blk_ >> 3) * 2 + (xq - 2) : 128 + (blk_ >> 3) * 4 + (xq - 4)) + 64 * (kk); s5_scan_lds(l, task >> 3, task & 7, lds, wave_s); } \
                    { asm volatile("s_waitcnt vmcnt(0)" ::: "memory"); __builtin_amdgcn_fence(__ATOMIC_RELEASE, "workgroup"); __syncthreads(); __builtin_amdgcn_fence(__ATOMIC_ACQUIRE, "workgroup"); } \
                    { GX_ENV const int task = (grpD ? (blk_ >> 3) * 2 + (xq - 2) : 128 + (blk_ >> 3) * 4 + (xq - 4)) + 64 * (kk); \
                      int g256 = 256; asm volatile("" : "+s"(g256)); pg8::S5bSched S; S.G = g256; S.c = task; S.X = (const bf16_t*)WSP(WS_Z); S.Bt3 = wp_s5m3(l); pg8::EpiS5b E{(bf16_t*)WSP(WS_Z), inp(23) + l * 512, lds}; \
                      pg8::gemm_phase<pg8::EpiS5b, pg8::S5bSched, true, true>(lds, wave_s, ZLD, 128, S, E); } \
                    __syncthreads(); } while (0)
                {   GX_ENV int base = 0; const int gw2 = gidx * NWAVES + wave, NGW2 = 192 * NWAVES;
                    LAS float* scr = (LAS float*)(lds + wave * 16384);
                    if (l + 1 == DEPTH) convert_matrix<2>(inp(31) + (size_t)l * D * 2 * FF, 2 * FF, 1024, 2 * FF, (bf16_t*)DUP(DU_WFI), scr, lane, gw2, NGW2, base);
                    __syncthreads();
                }
#pragma unroll 1
                for (int kt = 0; kt < 2; ++kt) {
                    { GX_ENV if (kt == 1 && !grpD) break; }
                    S5_TASK(kt);
                }
                {
                    asm volatile("s_waitcnt vmcnt(0) lgkmcnt(0)" ::: "memory"); __syncthreads();
                    if (wave_s == 0 && hw_lane() == 0) __hip_atomic_fetch_add((unsigned*)WSP(WS_CTL) + CW_S5DONE, 1u, __ATOMIC_RELAXED, __HIP_MEMORY_SCOPE_AGENT);
                }
                {
                    GX_ENV
                    pg8::PlainSched S;
                    if (grpD) S.o.init(M, 768, 64, (blk_ >> 3) * 2 + (xq - 2), 2); else S.o.init(M, 2304, 128, (blk_ >> 3) * 4 + (xq - 4), 4);
                    const int coff = grpD ? 0 : 768;
                    S.A = (const bf16_t*)WSP(WS_H); S.lda = D; S.Bt = wp_win(l) + (size_t)(NMIX + coff) * D; S.K = D;
                    pg8::EpiStore E{(bf16_t*)WSP(WS_Z) + NMIX + coff, ZLD, 0, 2, 0, inp(29) + l * 3072 + coff};
                    E.waitp = grpD ? (unsigned*)WSP(WS_CTL) + CW_S5DONE : nullptr; E.waitn = 192u * (unsigned)(l + 1);
                    pg8::gemm_phase<pg8::EpiStore, pg8::PlainSched, true, true>(lds, wave_s, D, D, S, E);
                }
                {
                    GX_ENV
                    if (wave_s == 0) { unsigned spins = 0; while ((unsigned)__builtin_amdgcn_readfirstlane(__hip_atomic_load((unsigned*)WSP(WS_CTL) + CW_S5DONE, __ATOMIC_RELAXED, __HIP_MEMORY_SCOPE_AGENT)) < 192u * (unsigned)(l + 1)) { __builtin_amdgcn_s_sleep(8); if (++spins > (1u << 22)) break; } }
                    __syncthreads();
                    int tid2 = hw_tid(wave_s); asm volatile("" : "+v"(tid2)); const int lane = tid2 & 63, wave = wave_s;
                    int base = 0; const int gw2 = gidx * NWAVES + wave, NGW2 = 192 * NWAVES;
                    LAS float* scr = (LAS float*)(lds + wave * 16384);
                    convert_matrix<0>(inp(24) + (size_t)l * 512 * 512, 512, 512, 512, (bf16_t*)WSP(WS_WGLU), scr, lane, gw2, NGW2, base);
                    convert_matrix<0>(inp(26) + (size_t)l * 512 * 1024, 1024, 512, 1024, (bf16_t*)WSP(WS_WPROJ), scr, lane, gw2, NGW2, base);
                    convert_matrix<0>(inp(27) + (size_t)l * 512 * 1024, 1024, 512, 1024, (bf16_t*)WSP(WS_WPROJ) + 1024 * 512, scr, lane, gw2, NGW2, base);
                    convert_matrix<0>(inp(28) + (size_t)l * 512 * 1024, 1024, 512, 1024, (bf16_t*)WSP(WS_WPROJ) + 2 * 1024 * 512, scr, lane, gw2, NGW2, base);
                    convert_matrix<0>(inp(30) + (size_t)l * D * D, 1024, 1024, 1024, (bf16_t*)WSP(WS_WOUT), scr, lane, gw2, NGW2, base);
                    convert_matrix<0>(inp(32) + (size_t)l * FF * D, 1024, FF, 1024, (bf16_t*)WSP(WS_WFO), scr, lane, gw2, NGW2, base);
                }
#undef S5_TASK
#undef GX_ENV
            }
        }
        GRID_BAR();
        PH(4) GREP(4) { GREP_BAR BLK_ENV
            bf16_t* Z = (bf16_t*)WSP(WS_Z);
            pg8::PlainSched S; S.o.init(M, 512, G, blk); S.A = Z + SU; S.lda = ZLD; S.Bt = (const bf16_t*)WSP(WS_WGLU); S.K = 512;
            pg8::EpiGlu E{Z + YS2, ZLD, Z + SU, ZLD, inp(25) + l * 512, lds};
            pg8::gemm_phase<pg8::EpiGlu, pg8::PlainSched, true, true>(lds, wave_s, ZLD, 512, S, E);
        }
        GRID_BAR();
        PH(5) GREP(5) { GREP_BAR BLK_ENV
            bf16_t* Z = (bf16_t*)WSP(WS_Z);
            pg8::MergeSched S; S.o.init(M, 1024, G, blk); S.Zb = Z; S.Wp = (const bf16_t*)WSP(WS_WPROJ);
            pg8::EpiMerge E{Z + MRG, ZLD, Z + ZG, ZLD, inp(29) + l * 3072};
            pg8::gemm_phase<pg8::EpiMerge, pg8::MergeSched, true, true>(lds, wave_s, ZLD, 512, S, E);
        }
        GRID_BAR();
        PH(6) GREP(6) { GREP_BAR BLK_ENV
            pg8::PlainSched S; S.o.init(M, 1024, G, blk); S.A = (const bf16_t*)WSP(WS_Z) + MRG; S.lda = ZLD; S.Bt = (const bf16_t*)WSP(WS_WOUT); S.K = 1024;
            pg8::EpiNorm<0, false> E{l, lds + LT_OFF}; pg8::gemm_phase<pg8::EpiNorm<0, false>, pg8::PlainSched, true, true>(lds, wave_s, ZLD, 1024, S, E);
        }
        GRID_BAR();
        PH(8) GREP(8) { GREP_BAR BLK_ENV
            pg8::PlainSched S; S.o.init(M, 2 * FF, G, blk); S.A = (const bf16_t*)WSP(WS_H); S.lda = D; S.Bt = (const bf16_t*)DUP(DU_WFI); S.K = D;
            pg8::EpiSwiGlu E{(bf16_t*)WSP(WS_Z) + HIDC, ZLD, STAGGER_TICKS};
            pg8::gemm_phase<pg8::EpiSwiGlu, pg8::PlainSched, true, true>(lds, wave_s, D, D, S, E);
        }
        GRID_BAR();
        PH(9) GREP(9) { GREP_BAR BLK_ENV
            pg8::PlainSched S; S.o.init(M, 1024, G, blk); S.A = (const bf16_t*)WSP(WS_Z) + HIDC; S.lda = ZLD; S.Bt = (const bf16_t*)WSP(WS_WFO); S.K = FF;
            if (l + 1 < DEPTH) { pg8::EpiNorm<1, false> E{l, lds + LT_OFF}; pg8::gemm_phase<pg8::EpiNorm<1, false>, pg8::PlainSched, true, true>(lds, wave_s, ZLD, FF, S, E); }
            else { pg8::EpiNorm<1, true> E{l, lds + LT_OFF}; pg8::gemm_phase<pg8::EpiNorm<1, true>, pg8::PlainSched, true, true>(lds, wave_s, ZLD, FF, S, E); }
        }
        if (l + 1 < DEPTH) GRID_BAR();
    }
}

extern "C" void kernel_launch(void* const* d_in, const int* in_sizes, int n_in, void* d_out, int out_size, void* d_ws, size_t ws_size, hipStream_t stream) {
    static int grid = 0;
    if (grid == 0) {
        if (n_in != 33 || ws_size < WS_END || out_size != M * D) { fprintf(stderr, "kernel_launch: unexpected n_in %d / ws %zu / out %d\n", n_in, ws_size, out_size); grid = -1; return; }
        int dev = 0, cus = 0, per_cu = 0;
        if (hipGetDevice(&dev) != hipSuccess || hipDeviceGetAttribute(&cus, hipDeviceAttributeMultiprocessorCount, dev) != hipSuccess) { grid = -1; return; }
        if (hipFuncSetAttribute((const void*)mega_fwd, hipFuncAttributeMaxDynamicSharedMemorySize, LDS_BYTES) != hipSuccess) { fprintf(stderr, "kernel_launch: hipFuncSetAttribute failed\n"); grid = -1; return; }
        if (hipOccupancyMaxActiveBlocksPerMultiprocessor(&per_cu, (const void*)mega_fwd, NWAVES * 64, LDS_BYTES) != hipSuccess || per_cu < 1) { fprintf(stderr, "kernel_launch: occupancy query says %d blocks/CU\n", per_cu); grid = -1; return; }
        (void)hipGetLastError();
        grid = cus;
    }
    if (grid < 0) return;
    (void)hipMemsetAsync((char*)d_ws + WS_CTL, 0, CTL_ZERO_BYTES, stream);
    Args a{};
    for (int i = 0; i < 33; ++i) a.in[i] = (const float*)d_in[i];
    a.out = (float*)d_out; a.ws = (unsigned char*)d_ws;
    hipLaunchKernelGGL(mega_fwd, dim3(grid), dim3(NWAVES * 64), LDS_BYTES, stream, a);
}
```

```cpp
#include <hip/hip_runtime.h>
#include <cstdint>
#include <cstdio>

#define LAS __attribute__((address_space(3)))
#define GAS __attribute__((address_space(1)))
typedef unsigned short bf16_t;
typedef short bf16x8 __attribute__((ext_vector_type(8)));
typedef float f32x4 __attribute__((ext_vector_type(4)));
typedef float f32x2 __attribute__((ext_vector_type(2)));
typedef unsigned u32x4 __attribute__((ext_vector_type(4)));
typedef unsigned u32x2 __attribute__((ext_vector_type(2)));

constexpr int NB = 8, T = 4096, D = 1024, M = NB * T, DEPTH = 2;
constexpr int INDIM = 6680, ZLD = 6656, FF = 2816;
constexpr int GQ = 0, GK = 256, GV = 512, GR = 1024, MQ = 1536, MK = 1792, MV = 2048, MO = 2560, SU = 3072, ZG = 3584;
constexpr int YGLA = GR;
constexpr int YML = MO;
constexpr int YS2 = 0;
constexpr int MRG = 1536;
constexpr int EXC = ZG;
constexpr int YPC = ZG + 256;
constexpr int NMIX = 3584;
constexpr size_t MiB = 1u << 20;
constexpr size_t WS_CTL = 0, CTL_ZERO_BYTES = 64 * 1024;
constexpr size_t WS_MOD = 512 * 1024;
constexpr size_t WS_ZS = 1 * MiB;
constexpr size_t WS_WIN = 5 * MiB;
constexpr size_t WS_S5M1 = 18 * MiB;
constexpr size_t WS_S5M3 = 24 * MiB;
constexpr size_t WS_WGLU = 18 * MiB;
constexpr size_t WS_WPROJ = 18 * MiB + 512 * 1024;
constexpr size_t WS_WOUT = 21 * MiB + 512 * 1024;
constexpr size_t WS_WFO = 23 * MiB + 512 * 1024;
constexpr size_t WS_A16 = 31 * MiB + 512 * 1024;
constexpr size_t WS_WSM = 29 * MiB;
constexpr size_t WS_H = 32 * MiB;
constexpr size_t WS_Z = 96 * MiB;
constexpr size_t WS_END = 512 * MiB;
constexpr int CW_BAR = 4096;
constexpr int CW_S5DONE = 6144;
constexpr int CW_PANEL = 8192;
constexpr size_t WS_SLOT = 29 * MiB + 64 * 1024;
constexpr int XZ = 0, HIDC = 1024;

constexpr int RING_BYTES = 131072, LDSCTL_OFF = RING_BYTES, MISC_OFF = LDSCTL_OFF + 320, LDS_BYTES = 163840;
constexpr int LT_OFF = RING_BYTES + 512;
constexpr int NWAVES = 8;

__device__ __forceinline__ float bf2f(bf16_t v) { return __uint_as_float(((unsigned)v) << 16); }
__device__ __forceinline__ unsigned f2bf(float f) { unsigned u = __float_as_uint(f); return (u + 0x7fffu + ((u >> 16) & 1u)) >> 16; }
__device__ __forceinline__ unsigned pk2(float lo, float hi) { return f2bf(lo) | (f2bf(hi) << 16); }
__device__ __forceinline__ float bflo(unsigned u) { return __uint_as_float(u << 16); }
__device__ __forceinline__ float bfhi(unsigned u) { return __uint_as_float(u & 0xffff0000u); }
__device__ __forceinline__ int hw_lane() { int l; asm volatile("v_mbcnt_lo_u32_b32 %0, -1, 0\n\tv_mbcnt_hi_u32_b32 %0, -1, %0" : "=v"(l)); return l; }
__device__ __forceinline__ int hw_tid(int wv) { return wv * 64 + hw_lane(); }
__device__ __forceinline__ float shl(float v, int src) { return __int_as_float(__builtin_amdgcn_ds_bpermute(src << 2, __float_as_int(v))); }
template <int CTRL, int ROWMASK = 0xf, int BANKMASK = 0xf>
__device__ __forceinline__ float dpp_f(float old, float v) { return __int_as_float(__builtin_amdgcn_update_dpp(__float_as_int(old), __float_as_int(v), CTRL, ROWMASK, BANKMASK, false)); }
__device__ __forceinline__ float wave_scan_add(float v) {
    v += dpp_f<0x111>(0.f, v); v += dpp_f<0x112>(0.f, v); v += dpp_f<0x114>(0.f, v); v += dpp_f<0x118>(0.f, v);
    v += dpp_f<0x142, 0xa>(0.f, v); v += dpp_f<0x143, 0xc>(0.f, v); return v;
}
__device__ __forceinline__ float wave_scan_max(float v) {
    const float ninf = __int_as_float(0xff800000);
    v = fmaxf(v, dpp_f<0x111>(ninf, v)); v = fmaxf(v, dpp_f<0x112>(ninf, v)); v = fmaxf(v, dpp_f<0x114>(ninf, v)); v = fmaxf(v, dpp_f<0x118>(ninf, v));
    v = fmaxf(v, dpp_f<0x142, 0xa>(ninf, v)); v = fmaxf(v, dpp_f<0x143, 0xc>(ninf, v)); return v;
}
__device__ __forceinline__ float sum_rows4(float s) {
    const auto r = __builtin_amdgcn_permlane16_swap(__float_as_uint(s), __float_as_uint(s), false, false); s = __uint_as_float(r[0]) + __uint_as_float(r[1]);
    const auto q = __builtin_amdgcn_permlane32_swap(__float_as_uint(s), __float_as_uint(s), false, false); return __uint_as_float(q[0]) + __uint_as_float(q[1]);
}
__device__ __forceinline__ float lane63(float v) { return __int_as_float(__builtin_amdgcn_readlane(__float_as_int(v), 63)); }
__device__ __forceinline__ float wave_sum(float v, int lane) {
#pragma unroll
    for (int o = 1; o < 64; o <<= 1) v += shl(v, lane ^ o);
    return v;
}
__device__ __forceinline__ float sigmoidf_(float x) { return 1.f / (1.f + expf(-x)); }
__device__ __forceinline__ float siluf_(float x) { return x / (1.f + expf(-x)); }
__device__ __forceinline__ float logsigmoidf_(float x) { return fminf(x, 0.f) - log1pf(expf(-fabsf(x))); }
__device__ __forceinline__ float gelu_tanh(float y) { return 0.5f * y * (1.f + tanhf(0.7978845608028654f * (y + 0.044715f * y * y * y))); }
__device__ __forceinline__ float fexp_neg(float x) { return __builtin_amdgcn_exp2f(-1.4426950408889634f * x); }
__device__ __forceinline__ float fsigmoid(float x) { return __builtin_amdgcn_rcpf(1.f + fexp_neg(x)); }
#define LDS_WAIT() asm volatile("s_waitcnt lgkmcnt(0)" ::: "memory")
#define VM_WAIT() asm volatile("s_waitcnt vmcnt(0)" ::: "memory")

struct Args { const float* in[33]; float* out; unsigned char* ws; };
__device__ __forceinline__ const float* inp(int i) {
    unsigned off = (unsigned)i * 8u; asm volatile("" : "+s"(off));
    typedef const float* cfp;
    return *(const __attribute__((address_space(4))) cfp*)((const __attribute__((address_space(4))) char*)__builtin_amdgcn_kernarg_segment_ptr() + off);
}

#define WSP(off) (inp_ws() + (off))
__device__ __forceinline__ unsigned char* inp_ws() { return (unsigned char*)inp(34); }
__device__ __forceinline__ float* inp_out() { return (float*)inp(33); }
constexpr size_t DU_WFI = 0, DU_WIN1 = 11u << 20, DU_S5M1 = 24u << 20, DU_S5M3 = 30u << 20, DU_WSM1 = 34u << 20;
__device__ __forceinline__ unsigned char* DUP(size_t off) { return (unsigned char*)inp_out() + (64u << 20) + off; }
__device__ __forceinline__ bf16_t* wp_win(int l) { return (bf16_t*)(l == 0 ? WSP(5u << 20) : DUP(DU_WIN1)); }
__device__ __forceinline__ bf16_t* wp_s5m1(int l) { return (bf16_t*)(l == 0 ? WSP(18u << 20) : DUP(DU_S5M1)); }
__device__ __forceinline__ bf16_t* wp_s5m3(int l) { return (bf16_t*)(l == 0 ? WSP(24u << 20) : DUP(DU_S5M3)); }
__device__ __forceinline__ bf16_t* wp_wsm(int l) { return (bf16_t*)(l == 0 ? WSP(29u << 20) : DUP(DU_WSM1)); }

namespace pg8 {
constexpr int BM = 256, BK = 64, HALF = 128, HTB = HALF * BK * 2, STAGE_BYTES = 8 * HTB, NXCD = 8, WGM = 8;
__host__ __device__ __forceinline__ int lds_byte(int r, int c) { const int st = (r >> 4) * 2 + (c >> 5), rr = r & 15, cc = c & 31, ob = rr * 64 + cc * 2; return st * 1024 + (ob ^ (((ob >> 9) & 1) << 5)); }
__host__ __device__ __forceinline__ void stage_rc(int b, int& R, int& C) { const int st = b / 1024, sb = b % 1024, swz = sb ^ (((sb >> 9) & 1) << 5); R = (st >> 1) * 16 + swz / 64; C = (st & 1) * 32 + (swz % 64) / 2; }
__host__ __device__ __forceinline__ int perm32(int rho) { const int n = rho >> 4, i = rho & 15; return 8 * (i >> 2) + 4 * n + (i & 3); }

struct Unit { int pm, pn, br; };
struct TileOrder {
    int nM, nN, nwg, G, c, nx;
    __device__ void init(int M_, int N_, int G_, int c_, int nx_ = NXCD) { nM = M_ / BM; nN = N_ / BM; nwg = nM * nN; G = G_; c = c_; nx = nx_; }
    __device__ bool tile(int i, int& pm, int& pn) const {
        const long L = (long)i * G + c; if (L >= nwg) return false;
        int wgid = (int)L; { const int q = nwg / nx, r = nwg % nx, xcd = wgid % nx, off = wgid / nx; wgid = (xcd < r ? xcd * (q + 1) : r * (q + 1) + (xcd - r) * q) + off; }
        const int nig = WGM * nN, gid = wgid / nig, fm = gid * WGM, gsz = (nM - fm) < WGM ? (nM - fm) : WGM;
        pm = fm + ((wgid % nig) % gsz); pn = (wgid % nig) / gsz; return true;
    }
};
struct PlainSched {
    TileOrder o; const bf16_t* A; int lda; const bf16_t* Bt; int K;
    __device__ bool next(int i, Unit& u) const { u.br = 0; return o.tile(i, u.pm, u.pn); }
    __device__ const char* Ap(const Unit& u) const { return (const char*)(A + (size_t)u.pm * BM * lda); }
    __device__ const char* Bp(const Unit& u) const { return (const char*)(Bt + (size_t)u.pn * BM * K); }
};
struct MergeSched {
    TileOrder o; const bf16_t* Zb; const bf16_t* Wp;
    __device__ bool next(int i, Unit& u) const { u.br = i % 3; return o.tile(i / 3, u.pm, u.pn); }
    __device__ const char* Ap(const Unit& u) const { const int col = u.br == 0 ? YGLA : (u.br == 1 ? YML : YS2); return (const char*)(Zb + (size_t)u.pm * BM * ZLD + col); }
    __device__ const char* Bp(const Unit& u) const { return (const char*)(Wp + (size_t)u.br * 1024 * 512 + (size_t)u.pn * BM * 512); }
};

__device__ __forceinline__ unsigned cvt_pk_bf16(float lo, float hi) { unsigned r; asm volatile("v_cvt_pk_bf16_f32 %0, %1, %2" : "=v"(r) : "v"(lo), "v"(hi)); return r; }

__device__ __forceinline__ void ring_stage_piece3(LAS unsigned char* ring, const bf16_t* xb, int ldx, int wid, int lane) {
#pragma unroll
    for (int i = 0; i < 2; ++i) {
        const int b = 3 * 16 + wid + 8 * i, r = 2 * b + (lane >> 5), cs = (lane & 31) ^ (r & 15);
        __builtin_amdgcn_global_load_lds((const unsigned*)(xb + (size_t)r * ldx + cs * 8), (LAS unsigned*)(ring + b * 1024), 16, 0, 0);
    }
}
__device__ __forceinline__ u32x4 ring_read(const LAS unsigned char* ring, int rt, int chunk) { return *(const LAS u32x4*)(ring + rt * 512 + ((chunk * 16) ^ ((rt & 15) * 16))); }
struct EpiStore {
    static constexpr bool PERM = true; static constexpr bool LDS_EPI = false;
    bf16_t* O; int ldc;
    int stagger = 0;
    int actmap = 0;
    int stagger_unused_ = 0;
    const float* gbias = nullptr;
    unsigned* waitp = nullptr; unsigned waitn = 0;
    __device__ __forceinline__ bool keep(const Unit&) const { return false; }
    __device__ __forceinline__ void operator()(f32x4 (&acc)[2][2][4][2], const Unit& u, int wr, int wc, int fr, int fq, LAS unsigned char* lds_) const {
        const int row0 = u.pm * BM + wr * 64 + fr, col0 = u.pn * BM + wc * 32 + 8 * fq;
        if (waitp) {
            unsigned spins = 0; while ((unsigned)__builtin_amdgcn_readfirstlane(__hip_atomic_load(waitp, __ATOMIC_RELAXED, __HIP_MEMORY_SCOPE_AGENT)) < waitn) { __builtin_amdgcn_s_sleep(8); if (++spins > (1u << 22)) break; }
        }
        const int am = actmap == 1 ? ((u.pn == GR / 256 || u.pn == GR / 256 + 1) ? 1 : ((u.pn == MO / 256 || u.pn == MO / 256 + 1) ? 2 : 0)) : 0;
        f32x4 gb[2][2] = {{{0.f, 0.f, 0.f, 0.f}, {0.f, 0.f, 0.f, 0.f}}, {{0.f, 0.f, 0.f, 0.f}, {0.f, 0.f, 0.f, 0.f}}};
        if (actmap == 2) {
#pragma unroll
            for (int bj = 0; bj < 2; ++bj) { gb[bj][0] = *(const f32x4*)(gbias + col0 + bj * HALF); gb[bj][1] = *(const f32x4*)(gbias + col0 + bj * HALF + 4); }
        }
#pragma unroll
        for (int ai = 0; ai < 2; ++ai)
#pragma unroll
            for (int m = 0; m < 4; ++m) { bf16_t* rowp = O + (size_t)(row0 + ai * HALF + m * 16) * ldc + col0;
#pragma unroll
                for (int bj = 0; bj < 2; ++bj) { f32x4 v0 = acc[ai][bj][m][0], v1 = acc[ai][bj][m][1];
                    if (actmap == 2) {
                        const f32x4 b0 = gb[bj][0], b1 = gb[bj][1];
#pragma unroll
                        for (int e = 0; e < 4; ++e) { v0[e] = 1.f + fminf(fexp_neg(v0[e] + b0[e]), 1e30f); v1[e] = 1.f + fminf(fexp_neg(v1[e] + b1[e]), 1e30f); } }
                    if (am) {
#pragma unroll
                        for (int e = 0; e < 4; ++e) { const float s0 = fsigmoid(v0[e]), s1 = fsigmoid(v1[e]); v0[e] = am == 1 ? v0[e] * s0 : s0; v1[e] = am == 1 ? v1[e] * s1 : s1; } }
                    u32x4 w; w.x = cvt_pk_bf16(v0[0], v0[1]); w.y = cvt_pk_bf16(v0[2], v0[3]); w.z = cvt_pk_bf16(v1[0], v1[1]); w.w = cvt_pk_bf16(v1[2], v1[3]);
                    *(u32x4*)(rowp + bj * HALF) = w; } }
    }
};
struct EpiGlu {
    static constexpr bool PERM = true; static constexpr bool LDS_EPI = true;
    bf16_t* O; int ldc; const bf16_t* Asrc; int lda; const float* bias; LAS unsigned char* ring;
    int stagger = 0;
    __device__ __forceinline__ bool keep(const Unit&) const { return false; }
    __device__ __forceinline__ int ldx() const { return lda; }
    __device__ __forceinline__ const bf16_t* xbase(const Unit& u) const { return Asrc + (size_t)(u.pm * BM) * lda + u.pn * BM; }
    __device__ __forceinline__ void operator()(f32x4 (&acc)[2][2][4][2], const Unit& u, int wr, int wc, int fr, int fq, LAS unsigned char* lds_) const {
        const int row0 = u.pm * BM + wr * 64 + fr, col0 = u.pn * BM + wc * 32 + 8 * fq;
        ring_stage_piece3(ring, xbase(u), lda, wr * 4 + wc, fq * 16 + fr);
        f32x4 bv[2][2];
#pragma unroll
        for (int bj = 0; bj < 2; ++bj)
#pragma unroll
            for (int n = 0; n < 2; ++n) bv[bj][n] = *(const f32x4*)(bias + col0 + bj * HALF + 4 * n);
        asm volatile("s_waitcnt vmcnt(0)" ::: "memory"); __builtin_amdgcn_s_barrier(); asm volatile("" ::: "memory");
#pragma unroll
        for (int ai = 0; ai < 2; ++ai)
#pragma unroll
            for (int m = 0; m < 4; ++m) { const int rt = ai * HALF + wr * 64 + m * 16 + fr; const size_t r = (size_t)(row0 + ai * HALF + m * 16);
#pragma unroll
                for (int bj = 0; bj < 2; ++bj) {
                    const u32x4 a = ring_read(ring, rt, wc * 4 + fq + bj * 16);
                    const f32x4 v0 = acc[ai][bj][m][0] + bv[bj][0], v1 = acc[ai][bj][m][1] + bv[bj][1];
                    u32x4 w;
                    w.x = cvt_pk_bf16(bflo(a.x) * fsigmoid(v0[0]), bfhi(a.x) * fsigmoid(v0[1])); w.y = cvt_pk_bf16(bflo(a.y) * fsigmoid(v0[2]), bfhi(a.y) * fsigmoid(v0[3]));
                    w.z = cvt_pk_bf16(bflo(a.z) * fsigmoid(v1[0]), bfhi(a.z) * fsigmoid(v1[1])); w.w = cvt_pk_bf16(bflo(a.w) * fsigmoid(v1[2]), bfhi(a.w) * fsigmoid(v1[3]));
                    *(u32x4*)(O + r * ldc + col0 + bj * HALF) = w; } }
        asm volatile("s_waitcnt lgkmcnt(0)" ::: "memory"); __builtin_amdgcn_s_barrier(); asm volatile("" ::: "memory");
    }
};
struct EpiSwiGlu {
    static constexpr bool PERM = true; static constexpr bool LDS_EPI = false;
    bf16_t* O; int ldc;
    int stagger = 0;
    __device__ __forceinline__ bool keep(const Unit&) const { return false; }
    __device__ __forceinline__ void operator()(f32x4 (&acc)[2][2][4][2], const Unit& u, int wr, int wc, int fr, int fq, LAS unsigned char* lds_) const {
        const int row0 = u.pm * BM + wr * 64 + fr, col0 = u.pn * HALF + wc * 32 + 8 * fq;
#pragma unroll
        for (int ai = 0; ai < 2; ++ai)
#pragma unroll
            for (int m = 0; m < 4; ++m) {
                float o[8];
#pragma unroll
                for (int n = 0; n < 2; ++n)
#pragma unroll
                    for (int e = 0; e < 4; ++e) { const float g = acc[ai][0][m][n][e], up = acc[ai][1][m][n][e]; o[n * 4 + e] = g * fsigmoid(g) * up; }
                u32x4 w; w.x = cvt_pk_bf16(o[0], o[1]); w.y = cvt_pk_bf16(o[2], o[3]); w.z = cvt_pk_bf16(o[4], o[5]); w.w = cvt_pk_bf16(o[6], o[7]);
                *(u32x4*)(O + (size_t)(row0 + ai * HALF + m * 16) * ldc + col0) = w; }
    }
};
struct EpiMerge {
    static constexpr bool PERM = true; static constexpr bool LDS_EPI = false;
    bf16_t* O; int ldc; const bf16_t* Zg; int ldz; const float* bgb;
    int stagger = 0;
    __device__ __forceinline__ bool keep(const Unit& u) const { return u.br < 2; }
    __device__ __forceinline__ void operator()(f32x4 (&acc)[2][2][4][2], const Unit& u, int wr, int wc, int fr, int fq, LAS unsigned char* lds_) const {
        const int row0 = u.pm * BM + wr * 64 + fr, col0 = u.pn * BM + wc * 32 + 8 * fq;
        const int br = u.br, brn = br < 2 ? br + 1 : 2;
#pragma unroll
        for (int bj = 0; bj < 2; ++bj) {
#pragma unroll
            for (int ai = 0; ai < 2; ++ai) {
                u32x4 za4[4], zb4[4];
#pragma unroll
                for (int m = 0; m < 4; ++m) { const size_t r = (size_t)(row0 + ai * HALF + m * 16);
                    za4[m] = *(const u32x4*)(Zg + r * ldz + br * 1024 + col0 + bj * HALF);
                    zb4[m] = *(const u32x4*)(Zg + r * ldz + brn * 1024 + col0 + bj * HALF); }
                asm volatile("" ::: "memory");
#pragma unroll
                for (int m = 0; m < 4; ++m) { const size_t r = (size_t)(row0 + ai * HALF + m * 16);
                    const u32x4 za = za4[m], zb = zb4[m];
                    const float xa[8] = {bflo(za.x), bfhi(za.x), bflo(za.y), bfhi(za.y), bflo(za.z), bfhi(za.z), bflo(za.w), bfhi(za.w)};
                    const float xb[8] = {bflo(zb.x), bfhi(zb.x), bflo(zb.y), bfhi(zb.y), bflo(zb.z), bfhi(zb.z), bflo(zb.w), bfhi(zb.w)};
                    float f[8];
#pragma unroll
                    for (int e = 0; e < 8; ++e) { const float ra = __builtin_amdgcn_rcpf(xa[e]); f[e] = br < 2 ? xb[e] * ra : ra; }
                    f32x4 v0 = acc[ai][bj][m][0], v1 = acc[ai][bj][m][1];
                    v0[0] *= f[0]; v0[1] *= f[1]; v0[2] *= f[2]; v0[3] *= f[3]; v1[0] *= f[4]; v1[1] *= f[5]; v1[2] *= f[6]; v1[3] *= f[7];
                    if (br < 2) { acc[ai][bj][m][0] = v0; acc[ai][bj][m][1] = v1; }
                    else { u32x4 w; w.x = cvt_pk_bf16(v0[0], v0[1]); w.y = cvt_pk_bf16(v0[2], v0[3]); w.z = cvt_pk_bf16(v1[0], v1[1]); w.w = cvt_pk_bf16(v1[2], v1[3]);
                        *(u32x4*)(O + r * ldc + col0 + bj * HALF) = w; } }
                asm volatile("" ::: "memory");
            }
        }
    }
};


typedef float f32x2v __attribute__((ext_vector_type(2)));
struct RowStats {
    unsigned long long* slots;
    unsigned* cnt;
    __device__ __forceinline__ void run(const Unit& u, int wid, int lane, LAS unsigned char* lt) const {
        const LAS f32x4* P = (const LAS f32x4*)lt; LAS f32x2v* S = (LAS f32x2v*)(lt + 16384);
        asm volatile("s_waitcnt lgkmcnt(0)" ::: "memory"); __builtin_amdgcn_s_barrier(); asm volatile("" ::: "memory");
        const int row = wid * 32 + (lane & 31);
        if (lane < 32) {
            const f32x4 p = (P[row * 4 + 0] + P[row * 4 + 1]) + (P[row * 4 + 2] + P[row * 4 + 3]);
            unsigned long long* sl = slots + ((size_t)(u.pm * BM + row) * 4 + u.pn) * 2;
            __hip_atomic_store(sl, ((unsigned long long)__float_as_uint(p[1]) << 32) | __float_as_uint(p[0]), __ATOMIC_RELAXED, __HIP_MEMORY_SCOPE_AGENT);
            __hip_atomic_store(sl + 1, ((unsigned long long)__float_as_uint(p[3]) << 32) | __float_as_uint(p[2]), __ATOMIC_RELAXED, __HIP_MEMORY_SCOPE_AGENT);
        }
        asm volatile("s_waitcnt vmcnt(0)" ::: "memory");
        if (lane == 0) __hip_atomic_fetch_add(cnt + 16 * u.pm, 1u, __ATOMIC_RELAXED, __HIP_MEMORY_SCOPE_AGENT);
        if (wid == 0) {
            unsigned spins = 0;
            while ((unsigned)__builtin_amdgcn_readfirstlane(__hip_atomic_load(cnt + 16 * u.pm, __ATOMIC_RELAXED, __HIP_MEMORY_SCOPE_AGENT)) < 32u) { if (++spins > (1u << 24)) break; }
            __builtin_amdgcn_fence(__ATOMIC_ACQUIRE, "agent");
        }
        asm volatile("s_waitcnt vmcnt(0) lgkmcnt(0)" ::: "memory"); __builtin_amdgcn_s_barrier(); asm volatile("" ::: "memory");
        if (lane < 32) {
            const unsigned long long* sl = slots + (size_t)(u.pm * BM + row) * 8; float s0 = 0.f, s1 = 0.f, s2 = 0.f, s3 = 0.f;
#pragma unroll
            for (int k = 0; k < 4; ++k) { const unsigned long long a = __hip_atomic_load(sl + 2 * k, __ATOMIC_RELAXED, __HIP_MEMORY_SCOPE_AGENT), b = __hip_atomic_load(sl + 2 * k + 1, __ATOMIC_RELAXED, __HIP_MEMORY_SCOPE_AGENT);
                s0 += __uint_as_float((unsigned)a); s1 += __uint_as_float((unsigned)(a >> 32)); s2 += __uint_as_float((unsigned)b); s3 += __uint_as_float((unsigned)(b >> 32)); }
            const float r1 = rsqrtf(s0 * (1.f / 1024.f) + 1e-6f);
            const float r2 = rsqrtf(fmaxf(s1 + r1 * (s2 + s2 + r1 * s3), 0.f) * (1.f / 1024.f) + 1e-6f);
            S[row] = (f32x2v){r1, r2};
        }
        asm volatile("s_waitcnt lgkmcnt(0)" ::: "memory"); __builtin_amdgcn_s_barrier(); asm volatile("" ::: "memory");
    }
};
template <int PHASE, bool FINAL>
struct EpiNorm {
    static constexpr bool PERM = true; static constexpr bool LDS_EPI = true;
    int l; LAS unsigned char* lt;
    int stagger = 0;
    __device__ __forceinline__ bool keep(const Unit&) const { return false; }
    __device__ __forceinline__ const float* modl() const { return (const float*)WSP(WS_MOD) + (size_t)l * 8 * 6144; }
    __device__ __forceinline__ int ldx() const { return PHASE == 0 ? D : ZLD; }
    __device__ __forceinline__ const bf16_t* xbase(const Unit& u) const {
        return PHASE == 0 ? (const bf16_t*)inp_out() + (size_t)(u.pm * BM) * D + u.pn * BM : (const bf16_t*)WSP(WS_Z) + (size_t)(u.pm * BM) * ZLD + XZ + u.pn * BM; }
    __device__ __forceinline__ void operator()(f32x4 (&acc)[2][2][4][2], const Unit& u, int wr, int wc, int fr, int fq, LAS unsigned char* lds_) const {
        const int bofs = (u.pm >> 4) * 6144;
        const int colw = u.pn * BM + wc * 32 + 8 * fq;
        const int lane = fq * 16 + fr, wid = wr * 4 + wc;
        LAS unsigned char* ring = lt - LT_OFF;
        {
            const bf16_t* xb = xbase(u); const int ldx_ = ldx();
#pragma unroll
            for (int i = 0; i < 2; ++i) {
                const int b = 3 * 16 + wid + 8 * i, r = 2 * b + (lane >> 5), cs = (lane & 31) ^ (r & 15);
                __builtin_amdgcn_global_load_lds((const unsigned*)(xb + (size_t)r * ldx_ + cs * 8), (LAS unsigned*)(ring + b * 1024), 16, 0, 0);
            }
        }
        f32x4 c1[2][2];
        { const float* pw = inp(PHASE == 0 ? 5 : 7) + l * D + colw; const float* gt = modl() + (PHASE == 0 ? 2048 : 5120) + bofs + colw;
#pragma unroll
          for (int bj = 0; bj < 2; ++bj)
#pragma unroll
            for (int n = 0; n < 2; ++n) { const f32x4 p = *(const f32x4*)(pw + bj * HALF + 4 * n), g = *(const f32x4*)(gt + bj * HALF + 4 * n); c1[bj][n] = (1.f + g) * p; } }
        asm volatile("s_waitcnt vmcnt(0)" ::: "memory"); __builtin_amdgcn_s_barrier(); asm volatile("" ::: "memory");
        const int xc0 = (wc * 4 + fq) * 16;
        {
            LAS f32x4* P = (LAS f32x4*)lt;
#pragma unroll
            for (int ai = 0; ai < 2; ++ai)
#pragma unroll
                for (int m = 0; m < 4; ++m) {
                    const int rt = ai * HALF + wr * 64 + m * 16 + fr;
                    float s0 = 0.f, s1 = 0.f, s2 = 0.f, s3 = 0.f;
#pragma unroll
                    for (int bj = 0; bj < 2; ++bj) {
                        u32x4 xw = {0u, 0u, 0u, 0u};
                        if (!FINAL) xw = *(const LAS u32x4*)(ring + rt * 512 + ((xc0 + bj * 256) ^ (fr * 16)));
#pragma unroll
                        for (int n = 0; n < 2; ++n) { const f32x4 y = acc[ai][bj][m][n], t = c1[bj][n] * y; acc[ai][bj][m][n] = t;
                            if (!FINAL) { const unsigned q0 = n == 0 ? xw.x : xw.z, q1 = n == 0 ? xw.y : xw.w; const f32x4 x = (f32x4){bflo(q0), bfhi(q0), bflo(q1), bfhi(q1)};
#pragma unroll
                                for (int e = 0; e < 4; ++e) { s0 += y[e] * y[e]; s1 += x[e] * x[e]; s2 += x[e] * t[e]; s3 += t[e] * t[e]; } }
                            else {
#pragma unroll
                                for (int e = 0; e < 4; ++e) s0 += y[e] * y[e]; } }
                    }
                    s0 = sum_rows4(s0);
                    if (!FINAL) { s1 = sum_rows4(s1); s2 = sum_rows4(s2); s3 = sum_rows4(s3); }
                    if (fq == 0) P[rt * 4 + wc] = (f32x4){s0, s1, s2, s3};
                }
        }
        { RowStats st{(unsigned long long*)WSP(WS_SLOT), (unsigned*)WSP(WS_CTL) + CW_PANEL + (2 * l + PHASE) * 2048}; st.run(u, wid, lane, lt); }
        {
            const LAS f32x2v* S = (const LAS f32x2v*)(lt + 16384);
#pragma unroll
            for (int bj = 0; bj < 2; ++bj) {
                const int col = colw + bj * HALF;
                f32x4 c2[2], hv[2];
                if (!FINAL) {
                    const float* w2 = (PHASE == 0 ? inp(6) + l * D : inp(4) + (l + 1) * D) + col;
                    const float* sc = modl() + (PHASE == 0 ? 4096 : 8 * 6144 + 1024) + bofs + col; const float* sh = modl() + (PHASE == 0 ? 3072 : 8 * 6144) + bofs + col;
#pragma unroll
                    for (int n = 0; n < 2; ++n) { const f32x4 w = *(const f32x4*)(w2 + 4 * n), c = *(const f32x4*)(sc + 4 * n); c2[n] = w * (1.f + c); hv[n] = *(const f32x4*)(sh + 4 * n); }
                }
#pragma unroll
                for (int ai = 0; ai < 2; ++ai)
#pragma unroll
                    for (int m = 0; m < 4; ++m) {
                        const int rt = ai * HALF + wr * 64 + m * 16 + fr; const size_t R = (size_t)(u.pm * BM + rt); const f32x2v r = S[rt];
                        const u32x4 xw = *(const LAS u32x4*)(ring + rt * 512 + ((xc0 + bj * 256) ^ (fr * 16)));
                        const float x[8] = {bflo(xw.x), bfhi(xw.x), bflo(xw.y), bfhi(xw.y), bflo(xw.z), bfhi(xw.z), bflo(xw.w), bfhi(xw.w)};
                        f32x4 v0 = acc[ai][bj][m][0], v1 = acc[ai][bj][m][1];
#pragma unroll
                        for (int e = 0; e < 4; ++e) { v0[e] = x[e] + r.x * v0[e]; v1[e] = x[4 + e] + r.x * v1[e]; }
                        if (FINAL) { float* op = inp_out() + R * D + col; __builtin_nontemporal_store(v0, (f32x4*)op); __builtin_nontemporal_store(v1, (f32x4*)(op + 4)); }
                        else {
                            u32x4 w; w.x = cvt_pk_bf16(v0[0], v0[1]); w.y = cvt_pk_bf16(v0[2], v0[3]); w.z = cvt_pk_bf16(v1[0], v1[1]); w.w = cvt_pk_bf16(v1[2], v1[3]);
                            *(u32x4*)(PHASE == 0 ? (bf16_t*)WSP(WS_Z) + R * ZLD + XZ + col : (bf16_t*)inp_out() + R * D + col) = w;
                            const f32x4 a0 = (f32x4){bflo(w.x), bfhi(w.x), bflo(w.y), bfhi(w.y)}, a1 = (f32x4){bflo(w.z), bfhi(w.z), bflo(w.w), bfhi(w.w)};
                            const f32x4 o0 = a0 * r.y * c2[0] + hv[0], o1 = a1 * r.y * c2[1] + hv[1];
                            u32x4 h; h.x = cvt_pk_bf16(o0[0], o0[1]); h.y = cvt_pk_bf16(o0[2], o0[3]); h.z = cvt_pk_bf16(o1[0], o1[1]); h.w = cvt_pk_bf16(o1[2], o1[3]);
                            *(u32x4*)((bf16_t*)WSP(WS_H) + R * D + col) = h;
                        }
                    }
            }
        }
        asm volatile("s_waitcnt lgkmcnt(0)" ::: "memory"); __builtin_amdgcn_s_barrier(); asm volatile("" ::: "memory");
    }
};

struct S5aSched {
    int G, c; const bf16_t* Zb; const bf16_t* Bt1;
    __device__ bool next(int i, Unit& u) const { const int L = i * G + c; if (L >= 512) return false; u.pn = L < 256 ? 1 : 0; u.br = (L & 255) >> 3; u.pm = L & 7; return true; }
    __device__ const char* Ap(const Unit& u) const { return (const char*)(Zb + (size_t)u.pm * T * ZLD + SU + 16 * u.br); }
    __device__ const char* Bp(const Unit& u) const { return (const char*)(Bt1 + ((size_t)u.br * 384 + (size_t)u.pn * 256) * 256); }
};
struct EpiS5a {
    static constexpr bool PERM = true; static constexpr bool THROTTLE = false; static constexpr bool LDS_EPI = false;
    int l;
    int stagger = 0;
    __device__ __forceinline__ bool keep(const Unit&) const { return false; }
    __device__ __forceinline__ void operator()(f32x4 (&acc)[2][2][4][2], const Unit& u, int wr, int wc, int fr, int fq, LAS unsigned char* lds_) const {
        bf16_t* Zb = (bf16_t*)WSP(WS_Z); LAS unsigned char* ring = lds_;
        const int rowbase = (u.br & 15) * 2048 + u.pm * 256 + wr * 64 + fr, colsub = wc * 32 + 8 * fq, hoff = (u.br >> 4) * 256;
        if (u.pn == 0) {
            asm volatile("s_waitcnt vmcnt(0)" ::: "memory"); __builtin_amdgcn_s_barrier(); asm volatile("" ::: "memory");
#pragma unroll
            for (int ai = 0; ai < 2; ++ai)
#pragma unroll
                for (int m = 0; m < 4; ++m) {
                    const int n = ai * HALF + wr * 64 + m * 16 + fr;
                    LAS unsigned char* rowp = ring + n * 512;
                    *(LAS f32x4*)(rowp + (((colsub >> 2) ^ (n & 15)) * 16)) = acc[ai][0][m][0];
                    *(LAS f32x4*)(rowp + ((((colsub >> 2) + 1) ^ (n & 15)) * 16)) = acc[ai][0][m][1];
                    const f32x4 v0 = acc[ai][1][m][0], v1 = acc[ai][1][m][1];
                    u32x4 w; w.x = cvt_pk_bf16(v0[0], v0[1]); w.y = cvt_pk_bf16(v0[2], v0[3]); w.z = cvt_pk_bf16(v1[0], v1[1]); w.w = cvt_pk_bf16(v1[2], v1[3]);
                    *(u32x4*)(Zb + (size_t)(rowbase + ai * HALF + m * 16) * ZLD + hoff + YPC + colsub) = w;
                    asm volatile("" ::: "memory");
                }
        } else {
#pragma unroll
            for (int ai = 0; ai < 2; ++ai)
#pragma unroll
                for (int m = 0; m < 4; ++m) { bf16_t* zrow = Zb + (size_t)(rowbase + ai * HALF + m * 16) * ZLD + hoff;
                    const f32x4 v0 = acc[ai][0][m][0], v1 = acc[ai][0][m][1];
                    u32x4 w; w.x = cvt_pk_bf16(v0[0], v0[1]); w.y = cvt_pk_bf16(v0[2], v0[3]); w.z = cvt_pk_bf16(v1[0], v1[1]); w.w = cvt_pk_bf16(v1[2], v1[3]);
                    *(u32x4*)(zrow + YPC + 128 + colsub) = w; }
        }
    }
};
struct S5bSched {
    int G, c; const bf16_t* X; const bf16_t* Bt3;
    __device__ bool next(int i, Unit& u) const { const int L = i * G + c; if (L >= 256) return false; u.br = L >> 3; u.pm = L & 7; u.pn = 0; return true; }
    __device__ const char* Ap(const Unit& u) const { return (const char*)(X + (size_t)((u.br & 15) * 2048 + u.pm * 256) * ZLD + EXC + (u.br >> 4) * 128); }
    __device__ const char* Bp(const Unit& u) const { return (const char*)(Bt3 + (size_t)u.br * 256 * 128); }
};
struct EpiS5b {
    static constexpr bool PERM = true; static constexpr bool LDS_EPI = true;
    bf16_t* Zb; const float* dsk; LAS unsigned char* ring;
    int stagger = 0;
    __device__ __forceinline__ bool keep(const Unit&) const { return false; }
    __device__ __forceinline__ int ldx() const { return ZLD; }
    __device__ __forceinline__ const bf16_t* xbase(const Unit& u) const { return Zb + (size_t)((u.br & 15) * 2048 + u.pm * 256) * ZLD + YPC + (u.br >> 4) * 256; }
    __device__ __forceinline__ void operator()(f32x4 (&acc)[2][2][4][2], const Unit& u, int wr, int wc, int fr, int fq, LAS unsigned char* lds_) const {
        const int g = u.br, b = u.pm;
        ring_stage_piece3(ring, xbase(u), ZLD, wr * 4 + wc, fq * 16 + fr);
        asm volatile("s_waitcnt vmcnt(0)" ::: "memory"); __builtin_amdgcn_s_barrier(); asm volatile("" ::: "memory");
#pragma unroll
        for (int bj = 0; bj < 2; ++bj) {
            const int j0 = bj * HALF + wc * 32 + 8 * fq, s = j0 >> 4, c0 = j0 & 15;
            const f32x4 d0 = *(const f32x4*)(dsk + 16 * g + c0), d1 = *(const f32x4*)(dsk + 16 * g + c0 + 4);
#pragma unroll
            for (int ai = 0; ai < 2; ++ai) {
                u32x4 uu4[4];
#pragma unroll
                for (int m = 0; m < 4; ++m) { const int n = ai * HALF + wr * 64 + m * 16 + fr; uu4[m] = *(const u32x4*)(Zb + ((size_t)b * T + 16 * n + s) * ZLD + SU + 16 * g + c0); }
                asm volatile("" ::: "memory");
#pragma unroll
                for (int m = 0; m < 4; ++m) {
                    const int n = ai * HALF + wr * 64 + m * 16 + fr;
                    const u32x4 yp = ring_read(ring, n, wc * 4 + fq + bj * 16);
                    bf16_t* zp = Zb + ((size_t)b * T + 16 * n + s) * ZLD + SU + 16 * g + c0;
                    const u32x4 uu = uu4[m];
                    const f32x4 a0 = acc[ai][bj][m][0], a1 = acc[ai][bj][m][1];
                    float y[8];
                    y[0] = a0[0] + bflo(yp.x) + d0[0] * bflo(uu.x); y[1] = a0[1] + bfhi(yp.x) + d0[1] * bfhi(uu.x);
                    y[2] = a0[2] + bflo(yp.y) + d0[2] * bflo(uu.y); y[3] = a0[3] + bfhi(yp.y) + d0[3] * bfhi(uu.y);
                    y[4] = a1[0] + bflo(yp.z) + d1[0] * bflo(uu.z); y[5] = a1[1] + bfhi(yp.z) + d1[1] * bfhi(uu.z);
                    y[6] = a1[2] + bflo(yp.w) + d1[2] * bflo(uu.w); y[7] = a1[3] + bfhi(yp.w) + d1[3] * bfhi(uu.w);
#pragma unroll
                    for (int e = 0; e < 8; ++e) { const float v = y[e]; y[e] = v * fsigmoid(1.5957691216057308f * (v + 0.044715f * v * v * v)); }
                    u32x4 w; w.x = cvt_pk_bf16(y[0], y[1]); w.y = cvt_pk_bf16(y[2], y[3]); w.z = cvt_pk_bf16(y[4], y[5]); w.w = cvt_pk_bf16(y[6], y[7]);
                    *(u32x4*)zp = w;
                }
                asm volatile("" ::: "memory");
            }
        }
        asm volatile("s_waitcnt lgkmcnt(0)" ::: "memory"); __builtin_amdgcn_s_barrier(); asm volatile("" ::: "memory");
    }
};
template <class Epi> __device__ __forceinline__ int epi_ldx(const Epi& E) { if constexpr (Epi::LDS_EPI) return E.ldx(); else return 0; }
template <class Epi> __device__ __forceinline__ const void* epi_xbase(const Epi& E, const Unit& u) { if constexpr (Epi::LDS_EPI) return E.xbase(u); else return nullptr; }
template <class Epi, class Sched, bool ALIGN_EPI, bool SP2, int AMODE = 0>
__device__ __forceinline__ void gemm_phase(LAS unsigned char* lds, const int wv, const int lda, const int K, const Sched& S, const Epi& E) {
    int tid_ = hw_tid(wv); asm volatile("" : "+v"(tid_));
    const int tid = tid_, wid = __builtin_amdgcn_readfirstlane(tid >> 6), lane = tid & 63, wr = wid >> 2, wc = wid & 3, fr = lane & 15, fq = lane >> 4;
    const int nt = K / BK;
    unsigned voffA[2], voffB[2];
#pragma unroll
    for (int i = 0; i < 2; ++i) { int R, C; stage_rc(tid * 16 + i * 8192, R, C); const int Rb = Epi::PERM ? ((R & ~31) + perm32(R & 31)) : R;
        voffA[i] = AMODE == 0 ? (unsigned)(R * lda + C) * 2u : (unsigned)((16 * R + (C >> 4)) * ZLD + (C & 15)) * 2u; voffB[i] = (unsigned)(Rb * K + C) * 2u; }
    const size_t kstep = (size_t)(BK * 2);
    const size_t kstepA = AMODE == 0 ? (size_t)(BK * 2) : (size_t)4 * ZLD * 2;
    const size_t hA = AMODE == 0 ? (size_t)HALF * lda * 2 : (size_t)HALF * 16 * ZLD * 2, hB = (size_t)HALF * K * 2;
    const unsigned ldsw = (unsigned)wid * 1024u;
    const int aoff = lds_byte(wr * 64 + fr, fq * 8), boff = lds_byte(wc * 32 + fr, fq * 8);
#define PG8_SA(b, h) (((b) * 2 + (h)) * HTB)
#define PG8_SB(b, h) ((4 + (b) * 2 + (h)) * HTB)
#define PG8_STAGE(bufoff, gbase, voff) do { _Pragma("unroll") for (int _i = 0; _i < 2; ++_i) \
        __builtin_amdgcn_global_load_lds((const unsigned*)((const char*)(gbase) + (voff)[_i]), (LAS unsigned*)(lds + (bufoff) + ldsw + _i * 8192), 16, 0, 0); } while (0)
#define PG8_STAGE_N(bufoff, gbase, voff) do { if (Epi::LDS_EPI && last) { \
        const int s_ = (bufoff) / HTB; const int ln_ = hw_lane(); const int ldx_ = epi_ldx(E); const char* xb_ = (const char*)epi_xbase(E, cur) + (size_t)(32 * s_) * ldx_ * 2; \
        _Pragma("unroll") for (int _i = 0; _i < 2; ++_i) { const int rl_ = 2 * (wid + 8 * _i) + (ln_ >> 5); const unsigned vo_ = (unsigned)(rl_ * ldx_ + (((ln_ & 31) ^ (rl_ & 15)) * 8)) * 2u; \
            __builtin_amdgcn_global_load_lds((const unsigned*)(xb_ + vo_), (LAS unsigned*)(lds + (bufoff) + ldsw + _i * 8192), 16, 0, 0); } \
    } else PG8_STAGE(bufoff, gbase, voff); } while (0)
#define PG8_LDA(dst, b, h) do { _Pragma("unroll") for (int m = 0; m < 4; ++m) _Pragma("unroll") for (int k = 0; k < 2; ++k) dst[m][k] = *(const LAS bf16x8*)(lds + PG8_SA(b, h) + aoff + m * 2048 + k * 1024); } while (0)
#define PG8_LDB(dst, b, h) do { _Pragma("unroll") for (int n = 0; n < 2; ++n) _Pragma("unroll") for (int k = 0; k < 2; ++k) dst[n][k] = *(const LAS bf16x8*)(lds + PG8_SB(b, h) + boff + n * 2048 + k * 1024); } while (0)
#define PG8_MMA(ai, bj, At, Bt) do { __builtin_amdgcn_s_setprio(1); _Pragma("unroll") for (int m = 0; m < 4; ++m) _Pragma("unroll") for (int n = 0; n < 2; ++n) _Pragma("unroll") for (int k = 0; k < 2; ++k) \
        acc[ai][bj][m][n] = __builtin_amdgcn_mfma_f32_16x16x32_bf16(Bt[n][k], At[m][k], acc[ai][bj][m][n], 0, 0, 0); __builtin_amdgcn_s_setprio(0); } while (0)
#define PG8_WAIT_V(n) asm volatile("s_waitcnt vmcnt(" #n ")" ::: "memory")
#define PG8_WAIT_L(n) asm volatile("s_waitcnt lgkmcnt(" #n ")" ::: "memory")
#define PG8_BAR __builtin_amdgcn_s_barrier()
#define PG8_SCHED __builtin_amdgcn_sched_barrier(0)
    Unit cur, nxt; int ui = 0;
    if (!S.next(0, cur)) return;
    if (E.stagger > 0) {
        const unsigned long long t0 = __builtin_amdgcn_s_memrealtime(), tgt = t0 + (unsigned long long)(((blockIdx.x >> 3) & 3) * E.stagger);
        while (__builtin_amdgcn_s_memrealtime() < tgt) __builtin_amdgcn_s_sleep(8);
    }
    f32x4 acc[2][2][4][2];
#pragma unroll
    for (int a = 0; a < 2; ++a)
#pragma unroll
        for (int b = 0; b < 2; ++b)
#pragma unroll
            for (int m = 0; m < 4; ++m)
#pragma unroll
                for (int n = 0; n < 2; ++n) acc[a][b][m][n] = (f32x4){0.f, 0.f, 0.f, 0.f};
    bf16x8 At[4][2], B0[2][2], B1[2][2];
    const char* cA = S.Ap(cur); const char* cB = S.Bp(cur);
#define PG8_PROLOGUE() do { \
    if constexpr (SP2) { \
        PG8_STAGE(PG8_SB(0, 0), cB, voffB); PG8_STAGE(PG8_SB(0, 1), cB + hB, voffB); PG8_STAGE(PG8_SA(0, 0), cA, voffA); PG8_STAGE(PG8_SA(0, 1), cA + hA, voffA); \
        if (wr == 1) PG8_BAR; \
        PG8_WAIT_V(2); PG8_BAR; \
        PG8_STAGE(PG8_SB(1, 0), cB + kstep, voffB); PG8_STAGE(PG8_SA(1, 0), cA + kstepA, voffA); PG8_STAGE(PG8_SB(1, 1), cB + hB + kstep, voffB); \
        PG8_WAIT_V(6); PG8_BAR; \
    } else { \
        PG8_STAGE(PG8_SB(0, 0), cB, voffB); PG8_STAGE(PG8_SA(0, 0), cA, voffA); PG8_STAGE(PG8_SB(0, 1), cB + hB, voffB); PG8_STAGE(PG8_SA(0, 1), cA + hA, voffA); \
        if (wr == 1) PG8_BAR; \
        PG8_WAIT_V(4); PG8_BAR; \
        PG8_STAGE(PG8_SB(1, 0), cB + kstep, voffB); PG8_STAGE(PG8_SA(1, 0), cA + kstepA, voffA); PG8_STAGE(PG8_SB(1, 1), cB + hB + kstep, voffB); \
        PG8_WAIT_V(6); PG8_BAR; \
    } } while (0)
    PG8_PROLOGUE();
    for (;;) {
        const bool has_next = S.next(ui + 1, nxt);
        const char* nA = has_next ? S.Ap(nxt) : cA; const char* nB = has_next ? S.Bp(nxt) : cB;
        for (int t = 0; t < nt; t += 2) {
            const bool last = (t == nt - 2);
            const char* a1 = cA + (size_t)(t + 1) * kstepA;
            const char* a2 = last ? nA : cA + (size_t)(t + 2) * kstepA; const char* b2 = last ? nB : cB + (size_t)(t + 2) * kstep;
            const char* a3 = a2 + kstepA; const char* b3 = b2 + kstep;
            if constexpr (SP2) {
            PG8_LDB(B0, 0, 0); PG8_LDB(B1, 0, 1); PG8_SCHED; PG8_LDA(At, 0, 0); PG8_STAGE(PG8_SA(1, 1), a1 + hA, voffA);
            PG8_WAIT_V(8); PG8_WAIT_L(0); PG8_BAR; PG8_MMA(0, 0, At, B0); PG8_MMA(0, 1, At, B1); PG8_BAR; PG8_SCHED;
            PG8_LDA(At, 0, 1); PG8_STAGE_N(PG8_SB(0, 0), b2, voffB); PG8_STAGE_N(PG8_SB(0, 1), b2 + hB, voffB); PG8_STAGE_N(PG8_SA(0, 0), a2, voffA);
            PG8_WAIT_V(8); PG8_WAIT_L(0); PG8_BAR; PG8_MMA(1, 0, At, B0); PG8_MMA(1, 1, At, B1); PG8_BAR; PG8_SCHED;
            PG8_LDB(B0, 1, 0); PG8_LDB(B1, 1, 1); PG8_SCHED; PG8_LDA(At, 1, 0); PG8_STAGE_N(PG8_SA(0, 1), a2 + hA, voffA);
            PG8_WAIT_V(8); PG8_WAIT_L(0); PG8_BAR; PG8_MMA(0, 0, At, B0); PG8_MMA(0, 1, At, B1); PG8_BAR; PG8_SCHED;
            PG8_LDA(At, 1, 1); PG8_STAGE_N(PG8_SB(1, 0), b3, voffB); PG8_STAGE_N(PG8_SB(1, 1), b3 + hB, voffB); PG8_STAGE_N(PG8_SA(1, 0), a3, voffA);
            PG8_WAIT_V(8); PG8_WAIT_L(0); PG8_BAR; PG8_MMA(1, 0, At, B0); PG8_MMA(1, 1, At, B1); PG8_BAR; PG8_SCHED;
            } else {
            PG8_LDB(B0, 0, 0); PG8_SCHED; PG8_LDA(At, 0, 0); PG8_STAGE(PG8_SA(1, 1), a1 + hA, voffA);
            PG8_WAIT_L(8); PG8_BAR; PG8_WAIT_L(0); PG8_MMA(0, 0, At, B0); PG8_BAR; PG8_SCHED;
            PG8_LDB(B1, 0, 1); PG8_STAGE(PG8_SB(0, 0), b2, voffB);
            PG8_BAR; PG8_WAIT_L(0); PG8_MMA(0, 1, At, B1); PG8_BAR;
            PG8_LDA(At, 0, 1); PG8_STAGE(PG8_SA(0, 0), a2, voffA);
            PG8_BAR; PG8_WAIT_L(0); PG8_MMA(1, 0, At, B0); PG8_BAR; PG8_SCHED;
            PG8_STAGE(PG8_SB(0, 1), b2 + hB, voffB);
            PG8_WAIT_V(6); PG8_BAR; PG8_MMA(1, 1, At, B1); PG8_BAR;
            PG8_LDB(B0, 1, 0); PG8_SCHED; PG8_LDA(At, 1, 0); PG8_STAGE(PG8_SA(0, 1), a2 + hA, voffA);
            PG8_WAIT_L(8); PG8_BAR; PG8_WAIT_L(0); PG8_MMA(0, 0, At, B0); PG8_BAR; PG8_SCHED;
            PG8_LDB(B1, 1, 1); PG8_STAGE(PG8_SB(1, 0), b3, voffB);
            PG8_BAR; PG8_WAIT_L(0); PG8_MMA(0, 1, At, B1); PG8_BAR;
            PG8_LDA(At, 1, 1); PG8_STAGE(PG8_SA(1, 0), a3, voffA);
            PG8_BAR; PG8_WAIT_L(0); PG8_MMA(1, 0, At, B0); PG8_BAR; PG8_SCHED;
            PG8_STAGE(PG8_SB(1, 1), b3 + hB, voffB);
            PG8_WAIT_V(6); PG8_BAR; PG8_MMA(1, 1, At, B1); PG8_BAR;
            }
        }
        if constexpr (ALIGN_EPI) { if (wr == 0) PG8_BAR; }
        { const int lane_e = hw_lane();
          E(acc, cur, wr, wc, lane_e & 15, lane_e >> 4, lds); }
        if (!has_next) break;
        if (!E.keep(cur)) {
#pragma unroll
        for (int a = 0; a < 2; ++a)
#pragma unroll
            for (int b = 0; b < 2; ++b)
#pragma unroll
                for (int m = 0; m < 4; ++m)
#pragma unroll
                    for (int n = 0; n < 2; ++n) acc[a][b][m][n] = (f32x4){0.f, 0.f, 0.f, 0.f};
        }
        cur = nxt; cA = nA; cB = nB; ++ui;
        if constexpr (Epi::LDS_EPI) { PG8_PROLOGUE(); }
        else if constexpr (ALIGN_EPI) { if (wr == 1) PG8_BAR; }
    }
    PG8_WAIT_V(0);
    if constexpr (!ALIGN_EPI) { if (wr == 0) PG8_BAR; }
    PG8_BAR;
#undef PG8_PROLOGUE
#undef PG8_STAGE_N
#undef PG8_SA
#undef PG8_SB
#undef PG8_STAGE
#undef PG8_LDA
#undef PG8_LDB
#undef PG8_MMA
#undef PG8_WAIT_V
#undef PG8_WAIT_L
#undef PG8_BAR
#undef PG8_SCHED
}
}

#define XB_TMO      128
#define XB_XCNT(j)  (256  + 64 * (j))
#define XB_XSUB(j)  (1280 + 64 * (j))
#define XB_XGEN(j)  (2304 + 64 * (j))
#define XB_TOP      3328
#define XB_TOPGEN   3392
#define XCD_BAR_WORDS 3456
#define XB_SPIN_CAP (1u << 18)
__device__ __forceinline__ unsigned xb_ld(unsigned* p)              { return __hip_atomic_load(p, __ATOMIC_RELAXED, __HIP_MEMORY_SCOPE_AGENT); }
__device__ __forceinline__ unsigned xb_add(unsigned* p, unsigned v) { return __hip_atomic_fetch_add(p, v, __ATOMIC_RELAXED, __HIP_MEMORY_SCOPE_AGENT); }
__device__ __forceinline__ unsigned xb_xcc_id() { return (unsigned)__builtin_amdgcn_s_getreg((3 << 11) | 20) & 0xFu; }
#define XB_SPIN(cond, bar) do { unsigned _sp = 0; while (cond) { __builtin_amdgcn_s_sleep(1); \
    if ((++_sp & 255u) == 0u) { if (xb_ld(&(bar)[XB_TMO])) break; if (_sp > XB_SPIN_CAP) { atomicAdd(&(bar)[XB_TMO], 1u); break; } } } } while (0)
struct XcdBarrier { unsigned* bar; unsigned x; volatile LAS unsigned* st; };
__device__ __forceinline__ XcdBarrier xcd_barrier_post(unsigned* bar, volatile LAS unsigned* st) {
    XcdBarrier b; b.bar = bar; b.x = xb_xcc_id(); b.st = st;
    if (threadIdx.x == 0) (void)xb_add(&bar[XB_XCNT(b.x)], 1u);
    return b;
}
__device__ __forceinline__ void xcd_barrier_complete(unsigned* bar, unsigned x, unsigned& nloc, unsigned& nx) {
    const unsigned G = gridDim.x * gridDim.y * gridDim.z;
    unsigned sum, cnt, mine, sp = 0u;
    for (;;) {
        sum = 0u; cnt = 0u; mine = 0u;
#pragma unroll
        for (unsigned j = 0; j < 16; ++j) { const unsigned c = xb_ld(&bar[XB_XCNT(j)]); sum += c; cnt += (c > 0u) ? 1u : 0u; mine = (j == x) ? c : mine; }
        if (sum == G) break;
        __builtin_amdgcn_s_sleep(1);
        if ((++sp & 255u) == 0u) { if (xb_ld(&bar[XB_TMO])) break; if (sp > XB_SPIN_CAP) { atomicAdd(&bar[XB_TMO], 1u); break; } }
    }
    nloc = mine > 0u ? mine : 1u; nx = cnt > 0u ? cnt : 1u;
}
__device__ __forceinline__ void xcd_barrier(const XcdBarrier& b, const int wv) {
    asm volatile("s_waitcnt vmcnt(0)" ::: "memory");
    __syncthreads();
    if (wv == 0 && hw_lane() == 0) {
        unsigned* bar = b.bar;
        __builtin_amdgcn_s_waitcnt(0);
        unsigned nloc = b.st[0], nx = b.st[1];
        if (nloc == 0u) { xcd_barrier_complete(bar, b.x, nloc, nx); b.st[0] = nloc; b.st[1] = nx; }
        const unsigned old = xb_add(&bar[XB_XSUB(b.x)], 1u);
        const unsigned gen = old / nloc;
        if (old + 1u == (gen + 1u) * nloc) {
            __builtin_amdgcn_fence(__ATOMIC_RELEASE, "agent");
            asm volatile("s_waitcnt vmcnt(0)" ::: "memory");
            const unsigned og = xb_add(&bar[XB_TOP], 1u);
            const unsigned tg = og / nx;
            if (og + 1u == (tg + 1u) * nx) xb_add(&bar[XB_TOPGEN], 1u);
            else XB_SPIN(xb_ld(&bar[XB_TOPGEN]) == tg, bar);
            __builtin_amdgcn_fence(__ATOMIC_ACQUIRE, "agent");
            xb_add(&bar[XB_XGEN(b.x)], 1u);
            asm volatile("s_waitcnt vmcnt(0)" ::: "memory");
        } else {
            XB_SPIN(xb_ld(&bar[XB_XGEN(b.x)]) == gen, bar);
            __builtin_amdgcn_fence(__ATOMIC_ACQUIRE, "agent");
            asm volatile("s_waitcnt vmcnt(0)" ::: "memory");
        }
    }
    __syncthreads();
}


__device__ __forceinline__ void ti_load(f32x4 (&v)[8], const float* W, int ldw, int src_n0, int k0, int lane) {
    const float* wp = W + (size_t)(k0 + (lane >> 3)) * ldw + src_n0 + 4 * (lane & 7);
#pragma unroll
    for (int i = 0; i < 8; ++i) v[i] = __builtin_nontemporal_load((const f32x4*)(wp + (size_t)(8 * i) * ldw));
}
__device__ __forceinline__ void ti_store(const f32x4 (&v)[8], int K, bf16_t* WT, int dst_n0, int k0, LAS float* scr, int lane) {
    LAS float* sp = scr + (lane >> 3) * 33 + 4 * (lane & 7);
#pragma unroll
    for (int i = 0; i < 8; ++i) { sp[(8 * i) * 33 + 0] = v[i][0]; sp[(8 * i) * 33 + 1] = v[i][1]; sp[(8 * i) * 33 + 2] = v[i][2]; sp[(8 * i) * 33 + 3] = v[i][3]; }
    LDS_WAIT(); asm volatile("" ::: "memory");
    const int c = lane & 7;
#pragma unroll
    for (int j = 0; j < 4; ++j) { const int n = (lane >> 3) + 8 * j; const LAS float* s = scr + (8 * c) * 33 + n;
        u32x4 o; o.x = pk2(s[0 * 33], s[1 * 33]); o.y = pk2(s[2 * 33], s[3 * 33]); o.z = pk2(s[4 * 33], s[5 * 33]); o.w = pk2(s[6 * 33], s[7 * 33]);
        *(u32x4*)(WT + (size_t)(dst_n0 + n) * K + k0 + 8 * c) = o; }
    LDS_WAIT(); asm volatile("" ::: "memory");
}
template <int MAP>
__device__ __forceinline__ void cm_coords(int it, int nblk, int& d0, int& s0, int& k0) {
    const int kb = it / nblk, nb = it % nblk; d0 = nb * 32; k0 = kb * 64; s0 = d0;
    if (MAP == 1) s0 = d0 + (d0 < 1024 ? 0 : (d0 < 2560 ? 16 : 24));
    if (MAP == 2) { const int pn = d0 >> 8, hh = (d0 & 255) >> 7, r = d0 & 127; s0 = hh * FF + pn * 128 + r; }
}
template <int MAP>
__device__ __forceinline__ void convert_matrix(const float* W, int ldw, int K, int Ndst, bf16_t* WT, LAS float* scr, int lane, int gw, int NGW, int& base) {
    const int nblk = Ndst / 32, nitems = (K / 64) * nblk;
    int it = (gw - base % NGW + NGW) % NGW;
    f32x4 cur[8], nxt[8];
    int d0 = 0, s0 = 0, k0 = 0;
    if (it < nitems) { cm_coords<MAP>(it, nblk, d0, s0, k0); ti_load(cur, W, ldw, s0, k0, lane); }
#pragma unroll 1
    for (; it < nitems; it += NGW) {
        int d1 = 0, s1 = 0, k1 = 0; const bool more = it + NGW < nitems;
        if (more) { cm_coords<MAP>(it + NGW, nblk, d1, s1, k1); ti_load(nxt, W, ldw, s1, k1, lane); }
        ti_store(cur, K, WT, d0, k0, scr, lane);
        if (more) {
#pragma unroll
            for (int i = 0; i < 8; ++i) cur[i] = nxt[i];
            d0 = d1; k0 = k1; }
    }
    base += nitems;
}

__device__ __forceinline__ void ada_phase(LAS unsigned char* lds, int blk, int wave, int lane) {
    if (blk >= 192) return;
    const int l = blk / 96, n0 = (blk % 96) * 64;
    const float* c = inp(1); const float* W = inp(2) + (size_t)l * 1024 * 6144; const float* bias = inp(3) + l * 6144;
    LAS float* cs = (LAS float*)lds;
    LAS float* part = (LAS float*)(lds + 32768);
    float wv[16];
#define ADA_LD(k0_) do { _Pragma("unroll") for (int j = 0; j < 16; ++j) wv[j] = __builtin_nontemporal_load(W + (size_t)((k0_) + j) * 6144 + n0 + lane); } while (0)
    ADA_LD(wave * 128);
    for (int i = wave * 64 + lane; i < 8192; i += NWAVES * 64) { const int b = i >> 10, k = i & 1023; cs[k * 8 + b] = siluf_(c[i]); }
    __syncthreads();
    float acc[8] = {0.f, 0.f, 0.f, 0.f, 0.f, 0.f, 0.f, 0.f};
#pragma unroll 1
    for (int k0 = wave * 128; k0 < wave * 128 + 128; k0 += 16) {
#pragma unroll
        for (int j = 0; j < 16; ++j) {
            const f32x4 c0 = *(const LAS f32x4*)(cs + (k0 + j) * 8), c1 = *(const LAS f32x4*)(cs + (k0 + j) * 8 + 4);
            acc[0] += c0[0] * wv[j]; acc[1] += c0[1] * wv[j]; acc[2] += c0[2] * wv[j]; acc[3] += c0[3] * wv[j];
            acc[4] += c1[0] * wv[j]; acc[5] += c1[1] * wv[j]; acc[6] += c1[2] * wv[j]; acc[7] += c1[3] * wv[j];
        }
        if (k0 + 16 < wave * 128 + 128) ADA_LD(k0 + 16);
    }
#undef ADA_LD
#pragma unroll
    for (int b = 0; b < 8; ++b) part[(wave * 8 + b) * 64 + lane] = acc[b];
    __syncthreads();
    {
        const int b = wave; float s = bias[n0 + lane];
#pragma unroll
        for (int w = 0; w < 8; ++w) s += part[(w * 8 + b) * 64 + lane];
        ((float*)WSP(WS_MOD))[(size_t)(l * 8 + b) * 6144 + n0 + lane] = s;
    }
    __syncthreads();
}

template <bool WITH_POST, bool WITH_PRE, bool XIN_BF16, bool XOUT_BF16>
__device__ __forceinline__ void norm_rows(const bf16_t* Y, int ldy, const void* xin_, const float* pw, const float* modl_post, int gt_off, void* xout_,
                                          const float* w2, const float* modl_pre, int sh_off, int sc_off, bf16_t* H, int gw, int NGW, int lane) {
    const float* xin = (const float*)xin_; const bf16_t* xinb = (const bf16_t*)xin_; float* xout = (float*)xout_; bf16_t* xoutb = (bf16_t*)xout_;
    f32x4 xc[2][4], xn[2][4]; u32x2 yc[2][4], yn[2][4], bc[2][4], bn[2][4];
#define NR_LOAD(X, B, Yv, r0) do { _Pragma("unroll") for (int q = 0; q < 2; ++q) _Pragma("unroll") for (int j = 0; j < 4; ++j) { \
        if (XIN_BF16) B[q][j] = *(const u32x2*)(xinb + (size_t)((r0) + q * NGW) * D + (lane + 64 * j) * 4); else X[q][j] = *(const f32x4*)(xin + (size_t)((r0) + q * NGW) * D + (lane + 64 * j) * 4); \
        if (WITH_POST) Yv[q][j] = *(const u32x2*)(Y + (size_t)((r0) + q * NGW) * ldy + (lane + 64 * j) * 4); } } while (0)
#pragma unroll
    for (int q = 0; q < 2; ++q)
#pragma unroll
        for (int j = 0; j < 4; ++j) { xc[q][j] = (f32x4){0.f, 0.f, 0.f, 0.f}; xn[q][j] = xc[q][j]; yc[q][j] = (u32x2){0u, 0u}; yn[q][j] = yc[q][j]; bc[q][j] = yc[q][j]; bn[q][j] = yc[q][j]; }
    NR_LOAD(xc, bc, yc, gw);
    for (int row0 = gw; row0 < M; row0 += 2 * NGW) {
        const int rown = row0 + 2 * NGW;
        if (rown < M) NR_LOAD(xn, bn, yn, rown);
        f32x4 v[2][4];
        if (XIN_BF16) {
#pragma unroll
            for (int q = 0; q < 2; ++q)
#pragma unroll
                for (int j = 0; j < 4; ++j) xc[q][j] = (f32x4){bflo(bc[q][j].x), bfhi(bc[q][j].x), bflo(bc[q][j].y), bfhi(bc[q][j].y)};
        }
        if (WITH_POST) {
            float ss[2] = {0.f, 0.f};
#pragma unroll
            for (int q = 0; q < 2; ++q)
#pragma unroll
                for (int j = 0; j < 4; ++j) { const u32x2 y = yc[q][j];
                    v[q][j] = (f32x4){bflo(y.x), bfhi(y.x), bflo(y.y), bfhi(y.y)}; ss[q] += v[q][j][0] * v[q][j][0] + v[q][j][1] * v[q][j][1] + v[q][j][2] * v[q][j][2] + v[q][j][3] * v[q][j][3]; }
#pragma unroll
            for (int o = 1; o < 64; o <<= 1) { const float t0 = shl(ss[0], lane ^ o), t1 = shl(ss[1], lane ^ o); ss[0] += t0; ss[1] += t1; }
#pragma unroll
            for (int q = 0; q < 2; ++q) {
                const int row = row0 + q * NGW, b = row / T;
                const float r = rsqrtf(ss[q] * (1.f / D) + 1e-6f);
                const float* gt = modl_post + (size_t)b * 6144 + gt_off;
#pragma unroll
                for (int j = 0; j < 4; ++j) {
                    const int col = (lane + 64 * j) * 4;
                    const f32x4 xo = xc[q][j], pwv = *(const f32x4*)(pw + col), gtv = *(const f32x4*)(gt + col);
#pragma unroll
                    for (int e = 0; e < 4; ++e) v[q][j][e] = xo[e] + (1.f + gtv[e]) * (v[q][j][e] * r * pwv[e]);
                    if (XOUT_BF16) { u32x2 o; o.x = pk2(v[q][j][0], v[q][j][1]); o.y = pk2(v[q][j][2], v[q][j][3]); *(u32x2*)(xoutb + (size_t)row * D + col) = o;
                        v[q][j] = (f32x4){bflo(o.x), bfhi(o.x), bflo(o.y), bfhi(o.y)}; }
                    else *(f32x4*)(xout + (size_t)row * D + col) = v[q][j];
                }
            }
        } else {
#pragma unroll
            for (int q = 0; q < 2; ++q)
#pragma unroll
                for (int j = 0; j < 4; ++j) { v[q][j] = xc[q][j];
                    if (XOUT_BF16) { u32x2 o; o.x = pk2(v[q][j][0], v[q][j][1]); o.y = pk2(v[q][j][2], v[q][j][3]); *(u32x2*)(xoutb + (size_t)(row0 + q * NGW) * D + (lane + 64 * j) * 4) = o; } }
        }
        if (WITH_PRE) {
            float ss[2] = {0.f, 0.f};
#pragma unroll
            for (int q = 0; q < 2; ++q)
#pragma unroll
                for (int j = 0; j < 4; ++j) ss[q] += v[q][j][0] * v[q][j][0] + v[q][j][1] * v[q][j][1] + v[q][j][2] * v[q][j][2] + v[q][j][3] * v[q][j][3];
#pragma unroll
            for (int o = 1; o < 64; o <<= 1) { const float t0 = shl(ss[0], lane ^ o), t1 = shl(ss[1], lane ^ o); ss[0] += t0; ss[1] += t1; }
#pragma unroll
            for (int q = 0; q < 2; ++q) {
                const int row = row0 + q * NGW, b = row / T;
                const float r2 = rsqrtf(ss[q] * (1.f / D) + 1e-6f);
                const float* sh = modl_pre + (size_t)b * 6144 + sh_off; const float* sc = modl_pre + (size_t)b * 6144 + sc_off;
#pragma unroll
                for (int j = 0; j < 4; ++j) {
                    const int col = (lane + 64 * j) * 4;
                    const f32x4 wv = *(const f32x4*)(w2 + col), scv = *(const f32x4*)(sc + col), shv = *(const f32x4*)(sh + col);
#pragma unroll
                    for (int e = 0; e < 4; ++e) v[q][j][e] = v[q][j][e] * r2 * wv[e] * (1.f + scv[e]) + shv[e];
                    u32x2 o; o.x = pk2(v[q][j][0], v[q][j][1]); o.y = pk2(v[q][j][2], v[q][j][3]);
                    *(u32x2*)(H + (size_t)row * D + col) = o;
                }
            }
        }
#pragma unroll
        for (int q = 0; q < 2; ++q)
#pragma unroll
            for (int j = 0; j < 4; ++j) { xc[q][j] = xn[q][j]; yc[q][j] = yn[q][j]; bc[q][j] = bn[q][j]; }
    }
#undef NR_LOAD
}
__device__ __forceinline__ void prenorm0_rows(const float* xin, bf16_t* xb, const float* w2, const float* modl, bf16_t* H, int gw, int NGW, int lane) {
    constexpr int NR = 4;
    f32x4 xc[NR][4], xn[NR][4];
#define P1_LOAD(X, r0) do { _Pragma("unroll") for (int q = 0; q < NR; ++q) _Pragma("unroll") for (int j = 0; j < 4; ++j) X[q][j] = __builtin_nontemporal_load((const f32x4*)(xin + (size_t)((r0) + q * NGW) * D + (lane + 64 * j) * 4)); } while (0)
    P1_LOAD(xc, gw);
#pragma unroll 1
    for (int row0 = gw; row0 < M; row0 += NR * NGW) {
        const int rown = row0 + NR * NGW;
        if (rown < M) P1_LOAD(xn, rown);
        float ss[NR];
#pragma unroll
        for (int q = 0; q < NR; ++q) { ss[q] = 0.f;
#pragma unroll
            for (int j = 0; j < 4; ++j) ss[q] += xc[q][j][0] * xc[q][j][0] + xc[q][j][1] * xc[q][j][1] + xc[q][j][2] * xc[q][j][2] + xc[q][j][3] * xc[q][j][3]; }
#pragma unroll
        for (int o = 1; o < 64; o <<= 1) {
            float t[NR];
#pragma unroll
            for (int q = 0; q < NR; ++q) t[q] = shl(ss[q], lane ^ o);
#pragma unroll
            for (int q = 0; q < NR; ++q) ss[q] += t[q];
        }
#pragma unroll
        for (int q = 0; q < NR; ++q) {
            const int row = row0 + q * NGW, b = row / T;
            const float r2 = rsqrtf(ss[q] * (1.f / D) + 1e-6f);
            const float* sh = modl + (size_t)b * 6144; const float* sc = sh + 1024;
#pragma unroll
            for (int j = 0; j < 4; ++j) {
                const int col = (lane + 64 * j) * 4;
                const f32x4 v = xc[q][j], wv = *(const f32x4*)(w2 + col), scv = *(const f32x4*)(sc + col), shv = *(const f32x4*)(sh + col);
                u32x2 o; o.x = pk2(v[0], v[1]); o.y = pk2(v[2], v[3]); __builtin_nontemporal_store(o, (u32x2*)(xb + (size_t)row * D + col));
                f32x4 h;
#pragma unroll
                for (int e = 0; e < 4; ++e) h[e] = v[e] * r2 * wv[e] * (1.f + scv[e]) + shv[e];
                u32x2 ho; ho.x = pk2(h[0], h[1]); ho.y = pk2(h[2], h[3]); *(u32x2*)(H + (size_t)row * D + col) = ho;
            }
        }
#pragma unroll
        for (int q = 0; q < NR; ++q)
#pragma unroll
            for (int j = 0; j < 4; ++j) xc[q][j] = xn[q][j];
    }
#undef P1_LOAD
}
__device__ __forceinline__ void zs_mfma(const bf16_t* H, const bf16_t* Wsm, float* ZS, int task, int lane) {
    typedef float f32x16_ __attribute__((ext_vector_type(16)));
    const int r32 = lane & 31, hh = lane >> 5;
    const bf16_t* ap = H + (size_t)(32 * task + r32) * D + 8 * hh;
    const bf16_t* bp = Wsm + (size_t)r32 * D + 8 * hh;
    f32x16_ acc;
#pragma unroll
    for (int r = 0; r < 16; ++r) acc[r] = 0.f;
#pragma unroll 1
    for (int k0 = 0; k0 < D / 16; k0 += 16) {
        bf16x8 af[16], bf[16];
#pragma unroll
        for (int j = 0; j < 16; ++j) { af[j] = *(const bf16x8*)(ap + 16 * (k0 + j)); bf[j] = *(const bf16x8*)(bp + 16 * (k0 + j)); }
#pragma unroll
        for (int j = 0; j < 16; ++j) acc = __builtin_amdgcn_mfma_f32_32x32x16_bf16(af[j], bf[j], acc, 0, 0, 0);
    }
    if (r32 < 24) {
#pragma unroll
        for (int r = 0; r < 16; ++r) ZS[(size_t)(32 * task + (r & 3) + 8 * (r >> 2) + 4 * hh) * 32 + r32] = acc[r];
    }
}
__device__ __forceinline__ void zs_mfma_pair(const bf16_t* H, const bf16_t* Wsm, float* ZS, int task, int khalf, int slot, LAS unsigned char* lds, int lane) {
    typedef float f32x16_ __attribute__((ext_vector_type(16)));
    const int r32 = lane & 31, hh = lane >> 5;
    const bf16_t* ap = H + (size_t)(32 * task + r32) * D + 8 * hh + 512 * khalf;
    const bf16_t* bp = Wsm + (size_t)r32 * D + 8 * hh + 512 * khalf;
    f32x16_ acc;
#pragma unroll
    for (int r = 0; r < 16; ++r) acc[r] = 0.f;
#pragma unroll 1
    for (int k0 = 0; k0 < 32; k0 += 16) {
        bf16x8 af[16], bf[16];
#pragma unroll
        for (int j = 0; j < 16; ++j) { af[j] = *(const bf16x8*)(ap + 16 * (k0 + j)); bf[j] = *(const bf16x8*)(bp + 16 * (k0 + j)); }
#pragma unroll
        for (int j = 0; j < 16; ++j) acc = __builtin_amdgcn_mfma_f32_32x32x16_bf16(af[j], bf[j], acc, 0, 0, 0);
    }
    LAS float* ex = (LAS float*)lds + slot * 1024;
    if (khalf == 1) {
#pragma unroll
        for (int r = 0; r < 16; ++r) ex[r * 64 + lane] = acc[r];
    }
    __syncthreads();
    if (khalf == 0 && r32 < 24) {
#pragma unroll
        for (int r = 0; r < 16; ++r) ZS[(size_t)(32 * task + (r & 3) + 8 * (r >> 2) + 4 * hh) * 32 + r32] = acc[r] + ex[r * 64 + lane];
    }
}
__device__ __forceinline__ void convert_small(const float* w_in, bf16_t* Wsm, int part, int tid) {
    for (int i = tid; i < 4 * 1024; i += NWAVES * 64) {
        const int c = 4 * part + (i >> 10), k = i & 1023;
        float v = 0.f;
        if (c < 16) v = w_in[(size_t)k * INDIM + 1024 + c]; else if (c < 24) v = w_in[(size_t)k * INDIM + 2576 + (c - 16)];
        Wsm[c * 1024 + k] = (bf16_t)f2bf(v);
    }
}

__device__ __forceinline__ void s5_generate(int l, int g, LAS unsigned char* lds, int wv) {
    int tid = hw_tid(wv); asm volatile("" : "+v"(tid));
    LAS float* ar = (LAS float*)lds;
    LAS float* ai = ar + 17 * 64;
    LAS float* bbr = ai + 17 * 64;
    LAS float* bbi = bbr + 1024;
    LAS float* cr = bbi + 1024;
    LAS float* ci = cr + 1024;
    LAS float* Kt = ci + 1024;
    bf16_t* Bt1 = wp_s5m1(l) + (size_t)g * 384 * 256;
    bf16_t* Bt3 = wp_s5m3(l) + (size_t)g * 256 * 128;
    __syncthreads();
    {
        const float dt = expf((inp(18) + l * 32)[g]);
        for (int i = tid; i < 17 * 64; i += 512) {
            const int k = i >> 6, p = i & 63;
            const float lre = fminf((inp(16) + l * 2048)[g * 64 + p], -1e-4f), lim = (inp(17) + l * 2048)[g * 64 + p];
            const float mg = expf((float)k * lre * dt), an = (float)k * lim * dt; ar[i] = mg * cosf(an); ai[i] = mg * sinf(an);
        }
    }
    __syncthreads();
    if (tid < 64) { typedef float f32x2g __attribute__((ext_vector_type(2))); ((f32x2g*)WSP(WS_A16))[(l * 32 + g) * 64 + tid] = (f32x2g){ar[16 * 64 + tid], ai[16 * 64 + tid]}; }
    for (int i = tid; i < 1024; i += 512) {
        const int p = i >> 4;
        const float lre = fminf((inp(16) + l * 2048)[g * 64 + p], -1e-4f), lim = (inp(17) + l * 2048)[g * 64 + p];
        const float a1r = ar[64 + p], a1i = ai[64 + p];
        const float inv = 1.f / (lre * lre + lim * lim);
        const float zr_ = ((a1r - 1.f) * lre + a1i * lim) * inv, zi_ = (a1i * lre - (a1r - 1.f) * lim) * inv;
        const float br = (inp(19) + (size_t)l * 32768)[(size_t)(g * 64) * 16 + i], bi = (inp(20) + (size_t)l * 32768)[(size_t)(g * 64) * 16 + i];
        bbr[i] = zr_ * br - zi_ * bi; bbi[i] = zr_ * bi + zi_ * br;
    }
    for (int i = tid; i < 1024; i += 512) { cr[i] = (inp(21) + (size_t)l * 32768)[g * 1024 + i]; ci[i] = (inp(22) + (size_t)l * 32768)[g * 1024 + i]; }
    __syncthreads();
    {
        const int cp = tid >> 5, c = (tid >> 1) & 15, ph = tid & 1;
        float acc[16];
#pragma unroll
        for (int t = 0; t < 16; ++t) acc[t] = 0.f;
        for (int pp = 0; pp < 32; ++pp) {
            const int p = 32 * ph + pp;
            const float xr = cr[cp * 64 + p], xi = ci[cp * 64 + p], yr = bbr[p * 16 + c], yi = bbi[p * 16 + c];
            const float cbr = xr * yr - xi * yi, cbi = xr * yi + xi * yr;
#pragma unroll
            for (int t = 0; t < 16; ++t) acc[t] += cbr * ar[t * 64 + p] - cbi * ai[t * 64 + p];
        }
#pragma unroll
        for (int t = 0; t < 16; ++t) { const float o = acc[t] + shl(acc[t], (tid & 63) ^ 1); if (ph == 0) Kt[(t * 16 + cp) * 16 + c] = o; }
    }
    __syncthreads();
    for (int pc = tid; pc < 128 * 32; pc += 512) {
        const int row = pc >> 5, k0 = (pc & 31) * 8, sp = k0 >> 4, c0 = k0 & 15, p = row >> 1, e15 = 15 - sp;
        const float xr = ar[e15 * 64 + p], xi = ai[e15 * 64 + p];
        float v[8];
#pragma unroll
        for (int e = 0; e < 8; ++e) { const float yr = bbr[p * 16 + c0 + e], yi = bbi[p * 16 + c0 + e]; v[e] = (row & 1) == 0 ? (xr * yr - xi * yi) : (xr * yi + xi * yr); }
        u32x4 w; w.x = pk2(v[0], v[1]); w.y = pk2(v[2], v[3]); w.z = pk2(v[4], v[5]); w.w = pk2(v[6], v[7]);
        *(u32x4*)(Bt1 + (size_t)row * 256 + k0) = w;
    }
    for (int pc = tid; pc < 256 * 32; pc += 512) {
        const int j = pc >> 5, k0 = (pc & 31) * 8, s = j >> 4, cp = j & 15, sp = k0 >> 4, c0 = k0 & 15;
        float v[8];
#pragma unroll
        for (int e = 0; e < 8; ++e) v[e] = (sp <= s) ? Kt[((s - sp) * 16 + cp) * 16 + c0 + e] : 0.f;
        u32x4 w; w.x = pk2(v[0], v[1]); w.y = pk2(v[2], v[3]); w.z = pk2(v[4], v[5]); w.w = pk2(v[6], v[7]);
        *(u32x4*)(Bt1 + (size_t)(128 + j) * 256 + k0) = w;
    }
    for (int pc = tid; pc < 256 * 16; pc += 512) {
        const int j = pc >> 4, k0 = (pc & 15) * 8, s = j >> 4, cp = j & 15;
        float v[8];
#pragma unroll
        for (int e = 0; e < 8; ++e) {
            const int k = k0 + e, p = k >> 1;
            const float xr = cr[cp * 64 + p], xi = ci[cp * 64 + p], yr = ar[(s + 1) * 64 + p], yi = ai[(s + 1) * 64 + p];
            v[e] = (k & 1) == 0 ? (xr * yr - xi * yi) : -(xr * yi + xi * yr);
        }
        u32x4 w; w.x = pk2(v[0], v[1]); w.y = pk2(v[2], v[3]); w.z = pk2(v[4], v[5]); w.w = pk2(v[6], v[7]);
        *(u32x4*)(Bt3 + (size_t)j * 128 + k0) = w;
    }
    __syncthreads();
}
__device__ __forceinline__ void s5_scan_lds(int l, int g, int b, LAS unsigned char* lds, int wv) {
    int tid = hw_tid(wv); asm volatile("" : "+v"(tid));
    const int p = tid & 63, w = wv;
    typedef float f32x2s __attribute__((ext_vector_type(2)));
    __syncthreads();
    if (w == 0) {
        const f32x2s a16 = ((const f32x2s*)WSP(WS_A16))[(l * 32 + g) * 64 + p];
        const float a16r = a16.x, a16i = a16.y;
        float xr = 0.f, xi = 0.f;
#pragma unroll 1
        for (int n0 = 0; n0 < 256; n0 += 16) {
            f32x2s e[16]; unsigned xp[16];
#pragma unroll
            for (int j = 0; j < 16; ++j) e[j] = *(const LAS f32x2s*)(lds + (n0 + j) * 512 + (((p >> 1) ^ ((n0 + j) & 15)) * 16) + (p & 1) * 8);
            asm volatile("s_waitcnt lgkmcnt(0)" ::: "memory");
#pragma unroll
            for (int j = 0; j < 16; ++j) {
                xp[j] = pk2(xr, xi);
                const float tr = a16r * xr - a16i * xi + e[j][0], ti = a16r * xi + a16i * xr + e[j][1];
                xr = tr; xi = ti;
            }
#pragma unroll
            for (int j = 0; j < 16; ++j) *(LAS unsigned*)(lds + (n0 + j) * 512 + 4 * p) = xp[j];
            asm volatile("" ::: "memory");
        }
    }
    __syncthreads();
    char* base = (char*)((bf16_t*)WSP(WS_Z) + (size_t)((g & 15) * 2048 + b * 256) * ZLD + EXC + (g >> 4) * 128);
    constexpr size_t RP = (size_t)ZLD * 2;
#pragma unroll 8
    for (int r = 0; r < 32; ++r) { const int n = 32 * w + r; unsigned* row = (unsigned*)(base + (size_t)n * RP); row[p] = *(const LAS unsigned*)(lds + n * 512 + 4 * p); }
}

namespace mx {
typedef float f32x16 __attribute__((ext_vector_type(16)));
__device__ __forceinline__ unsigned cpk(float lo, float hi) { return pg8::cvt_pk_bf16(lo, hi); }
constexpr int PB = 72;
constexpr int L_QS = 0, L_KS = 9216, L_KT = 18432, L_VT = 27648, L_PS = 46080, L_ST = 55296, L_OS = 73728, L_VEC = 107520;
constexpr int OSP = 132;
constexpr int V_SEG = 0  , V_ELAST = 1024, V_XS = 1088  , V_END = 5184;
static_assert(L_VEC + V_END * 4 <= RING_BYTES, "mixer LDS map");
constexpr int L_VEC2 = RING_BYTES + 512, SETSZ = 384, V_RT = 0, V_CS = 64, V_WI = 128, V_WK = 192, V_ENM = 256, V_SC = 320, V_DEN = 768, V_NORM = 832, V2_END = 960;
static_assert(L_VEC2 >= MISC_OFF + 128 && L_VEC2 + V2_END * 4 <= LDS_BYTES, "mixer LDS map (upper area)");
__device__ __forceinline__ int crow(int reg, int hh) { return (reg & 3) + 8 * (reg >> 2) + 4 * hh; }
__device__ __forceinline__ float fexp(float x) { return __builtin_amdgcn_exp2f(1.4426950408889634f * x); }
__device__ __forceinline__ float flogsig(float x) { const float e = fexp(-fabsf(x)); return fminf(x, 0.f) - 0.6931471805599453f * __builtin_amdgcn_logf(1.f + e); }
#define MX_MFMA(a, b, c) __builtin_amdgcn_mfma_f32_32x32x16_bf16((a), (b), (c), 0, 0, 0)
__device__ __forceinline__ void split8(const float (&x)[8], bf16x8& hi, bf16x8& lo) {
    u32x4 h, l;
    unsigned hw[4], lw[4];
#pragma unroll
    for (int i = 0; i < 4; ++i) { const unsigned p = cpk(x[2 * i], x[2 * i + 1]); hw[i] = p; lw[i] = cpk(x[2 * i] - bflo(p), x[2 * i + 1] - bfhi(p)); }
    h.x = hw[0]; h.y = hw[1]; h.z = hw[2]; h.w = hw[3]; l.x = lw[0]; l.y = lw[1]; l.z = lw[2]; l.w = lw[3];
    hi = __builtin_bit_cast(bf16x8, h); lo = __builtin_bit_cast(bf16x8, l);
}

template <int ROLE, bool STORE = true>
__device__ __forceinline__ void stream(int l, LAS unsigned char* lds, int bh, int wvs) {
    int tid = hw_tid(wvs); asm volatile("" : "+v"(tid));
    const int lane = tid & 63, w = __builtin_amdgcn_readfirstlane(tid >> 6), r32 = lane & 31, hh = lane >> 5;
    const int b = bh >> 2, h = bh & 3;
    LAS float* vec = (LAS float*)(lds + L_VEC); LAS float* vec2 = (LAS float*)(lds + L_VEC2);
    LAS bf16_t* Qs = (LAS bf16_t*)(lds + L_QS); LAS bf16_t* Ks = (LAS bf16_t*)(lds + L_KS); LAS bf16_t* KTs = (LAS bf16_t*)(lds + L_KT);
    LAS bf16_t* VTs = (LAS bf16_t*)(lds + L_VT); LAS bf16_t* Ps = (LAS bf16_t*)(lds + L_PS); LAS bf16_t* STs = (LAS bf16_t*)(lds + L_ST);
    LAS float* Os = (LAS float*)(lds + L_OS);
    const int qcol = (ROLE == 0 ? GQ : MQ) + h * 64, kcol = (ROLE == 0 ? GK : MK) + h * 64, vcol = (ROLE == 0 ? GV : MV) + h * 128, gcol = (ROLE == 0 ? GR : MO) + h * 128;
    const __amdgpu_buffer_rsrc_t zrs = __builtin_amdgcn_make_buffer_rsrc((void*)WSP(WS_Z), 0, 0x7fffffff, 0x00020000);
    const __amdgpu_buffer_rsrc_t srs = __builtin_amdgcn_make_buffer_rsrc((void*)WSP(WS_ZS), 0, 0x7fffffff, 0x00020000);
    const __amdgpu_buffer_rsrc_t zrs3 = __builtin_amdgcn_make_buffer_rsrc((void*)(WSP(WS_Z) - 3 * ZLD * 2), 0, 0x7fffffff, 0x00020000);
    const int dp = r32, rg = 2 * w + hh, et = tid >> 3, cg = tid & 7;
    const int wa = w >> 2, wv = w & 3;
    const unsigned vo_qk = (unsigned)((hh * 4 * ZLD + 2 * dp) * 2), vo_v = (unsigned)(lane * 4), vo_g = (unsigned)(((lane >> 3) * ZLD + 16 * (lane & 7)) * 2);
    float abd0 = 0.f, abd1 = 0.f, nwv[16];
    float cwq[4][2], cwk[4][2], cbq[2] = {0.f, 0.f}, cbk[2] = {0.f, 0.f}, ibh = 0.f, fbh = 0.f, mprev = 0.f;
    bf16x8 a2hi = {0, 0, 0, 0, 0, 0, 0, 0}, a2lo = {0, 0, 0, 0, 0, 0, 0, 0};
#pragma unroll
    for (int r = 0; r < 16; ++r) nwv[r] = 0.f;
#pragma unroll
    for (int j = 0; j < 4; ++j) { cwq[j][0] = cwq[j][1] = 0.f; cwk[j][0] = cwk[j][1] = 0.f; }
    if (ROLE == 0) {
        const float* a2 = inp(9) + l * 16 * 256; const float* ab = inp(10) + l * 256; const float* nw = inp(11) + l * 512;
#pragma unroll
        for (int r = 0; r < 16; ++r) nwv[r] = nw[h * 128 + 16 * cg + r];
        abd0 = ab[h * 64 + 2 * dp]; abd1 = ab[h * 64 + 2 * dp + 1];
        float bq[8];
#pragma unroll
        for (int j = 0; j < 8; ++j) bq[j] = a2[(8 * hh + j) * 256 + h * 64 + 32 * (w & 1) + r32];
        split8(bq, a2hi, a2lo);
    } else {
        const float* cw = inp(12) + l * 4 * 512; const float* cb = inp(13) + l * 512;
#pragma unroll
        for (int j = 0; j < 4; ++j)
#pragma unroll
            for (int c = 0; c < 2; ++c) { cwq[j][c] = cw[j * 512 + h * 64 + 2 * dp + c]; cwk[j][c] = cw[j * 512 + 256 + h * 64 + 2 * dp + c]; }
#pragma unroll
        for (int c = 0; c < 2; ++c) { cbq[c] = cb[h * 64 + 2 * dp + c]; cbk[c] = cb[256 + h * 64 + 2 * dp + c]; }
        ibh = (inp(14) + l * 4)[h]; fbh = (inp(15) + l * 4)[h];
    }
    for (int i = tid; i < 128 * PB / 2; i += 512) ((LAS unsigned*)STs)[i] = 0u;
    for (int i = tid; i < 64 * PB / 2; i += 512) ((LAS unsigned*)Ps)[i] = 0u;
    if (tid < 128) vec2[V_NORM + tid] = 0.f;
    f32x16 accS;
#pragma unroll
    for (int r = 0; r < 16; ++r) accS[r] = 0.f;
    unsigned qi[7], ki[7], vi[8]; float zs0 = 0.f, zs1 = 0.f; u32x4 gt0 = {0u, 0u, 0u, 0u}, gt1 = {0u, 0u, 0u, 0u}, ga0 = {0u, 0u, 0u, 0u}, ga1 = {0u, 0u, 0u, 0u};
#define MX_LOAD(mrow) do { \
        const unsigned rb_ = (unsigned)((mrow) + 8 * w) * (unsigned)(ZLD * 2); \
        if (ROLE == 0) { \
            _Pragma("unroll") for (int i = 0; i < 4; ++i) { qi[i] = __builtin_amdgcn_raw_buffer_load_b32(zrs, vo_qk, rb_ + (unsigned)((i * ZLD + qcol) * 2), 0); ki[i] = __builtin_amdgcn_raw_buffer_load_b32(zrs, vo_qk, rb_ + (unsigned)((i * ZLD + kcol) * 2), 0); } \
            if (w < 4) { const unsigned so_ = (unsigned)((mrow) + 32 * (w >> 1)) * 128u; ga0 = __builtin_amdgcn_raw_buffer_load_b128(srs, (unsigned)((r32 * 32 + 8 * hh) * 4), so_, 0); ga1 = __builtin_amdgcn_raw_buffer_load_b128(srs, (unsigned)((r32 * 32 + 8 * hh) * 4 + 16), so_, 0); } \
        } else { \
            _Pragma("unroll") for (int i = 0; i < 7; ++i) { qi[i] = __builtin_amdgcn_raw_buffer_load_b32(zrs3, vo_qk, rb_ + (unsigned)((i * ZLD + qcol) * 2), 0); ki[i] = __builtin_amdgcn_raw_buffer_load_b32(zrs3, vo_qk, rb_ + (unsigned)((i * ZLD + kcol) * 2), 0); } \
            if (w == 7) { const unsigned so_ = (unsigned)(mrow) * 128u; zs0 = __builtin_bit_cast(float, __builtin_amdgcn_raw_buffer_load_b32(srs, (unsigned)(lane * 128), so_ + (unsigned)((16 + h) * 4), 0)); \
                                                                         zs1 = __builtin_bit_cast(float, __builtin_amdgcn_raw_buffer_load_b32(srs, (unsigned)(lane * 128), so_ + (unsigned)((20 + h) * 4), 0)); } \
        } \
        _Pragma("unroll") for (int i = 0; i < 8; ++i) vi[i] = __builtin_amdgcn_raw_buffer_load_b32(zrs, vo_v, rb_ + (unsigned)((i * ZLD + vcol) * 2), 0); \
    } while (0)
#define MX_XS() do { if (w < 4) { \
        asm volatile("" : "+v"(ga0), "+v"(ga1)); \
        const float gf[8] = {__uint_as_float(ga0.x), __uint_as_float(ga0.y), __uint_as_float(ga0.z), __uint_as_float(ga0.w), __uint_as_float(ga1.x), __uint_as_float(ga1.y), __uint_as_float(ga1.z), __uint_as_float(ga1.w)}; \
        bf16x8 ahi, alo; split8(gf, ahi, alo); \
        f32x16 xa; _Pragma("unroll") for (int r = 0; r < 16; ++r) xa[r] = 0.f; \
        xa = MX_MFMA(alo, a2hi, xa); xa = MX_MFMA(ahi, a2lo, xa); xa = MX_MFMA(ahi, a2hi, xa); \
        _Pragma("unroll") for (int r = 0; r < 16; ++r) vec[V_XS + (32 * (w >> 1) + crow(r, hh)) * 64 + 32 * (w & 1) + r32] = xa[r]; } } while (0)
#define MX_SCALARS(sv) do { \
        asm volatile("" : "+v"(zs0), "+v"(zs1)); \
        const float ip = zs0 + ibh, lf = flogsig(zs1 + fbh); \
        const float bs = wave_scan_add(lf); \
        const float cs = ip - bs; \
        const float pm = wave_scan_max(cs); \
        const float mt = bs + fmaxf(mprev, pm); \
        (sv)[V_RT + lane] = bs - mt; (sv)[V_CS + lane] = cs; (sv)[V_WI + lane] = fexp(bs + mprev - mt); (sv)[V_ENM + lane] = fexp(-mt); \
        const float mnew = lane63(mt), b63 = lane63(bs); \
        (sv)[V_WK + lane] = fexp(b63 + cs - mnew); \
        if (lane == 0) (sv)[V_SC] = fexp(b63 + mprev - mnew); \
        mprev = mnew; \
    } while (0)
#define MX_PIN7(a) asm volatile("" : "+v"(a[0]), "+v"(a[1]), "+v"(a[2]), "+v"(a[3]), "+v"(a[4]), "+v"(a[5]), "+v"(a[6]))
#define MX_PIN4(a) asm volatile("" : "+v"(a[0]), "+v"(a[1]), "+v"(a[2]), "+v"(a[3]))
#define MX_PIN8(a) asm volatile("" : "+v"(a[0]), "+v"(a[1]), "+v"(a[2]), "+v"(a[3]), "+v"(a[4]), "+v"(a[5]), "+v"(a[6]), "+v"(a[7]))
    unsigned m0 = (unsigned)(b * T);
    MX_LOAD(m0);
    if (ROLE == 0) MX_XS(); else if (w == 7) MX_SCALARS(vec2);
    __syncthreads();

#pragma unroll 1
    for (int n = 0; n <= 64; ++n) {
        if (n > 0) {
            const LAS float* orow = Os + et * OSP + 16 * cg;
            float o[16];
#pragma unroll
            for (int q4 = 0; q4 < 4; ++q4) { const f32x4 t4 = *(const LAS f32x4*)(orow + 4 * q4); o[4 * q4] = t4[0]; o[4 * q4 + 1] = t4[1]; o[4 * q4 + 2] = t4[2]; o[4 * q4 + 3] = t4[3]; }
            asm volatile("" : "+v"(gt0), "+v"(gt1));
            const unsigned gw_[8] = {gt0.x, gt0.y, gt0.z, gt0.w, gt1.x, gt1.y, gt1.z, gt1.w};
            float y[16];
            if (ROLE == 0) {
                float ss = 0.f;
#pragma unroll
                for (int e = 0; e < 16; ++e) ss += o[e] * o[e];
                ss += dpp_f<0xB1>(ss, ss); ss += dpp_f<0x4E>(ss, ss); ss += dpp_f<0x141>(ss, ss);
                const float rn = rsqrtf(ss * (1.f / 128.f) + 1e-6f);
#pragma unroll
                for (int e = 0; e < 16; ++e) { const float g = (e & 1) ? bfhi(gw_[e >> 1]) : bflo(gw_[e >> 1]); y[e] = o[e] * rn * nwv[e] * g; }
            } else {
                const float rdiv = vec2[V_DEN + et];
#pragma unroll
                for (int e = 0; e < 16; ++e) { const float g = (e & 1) ? bfhi(gw_[e >> 1]) : bflo(gw_[e >> 1]); y[e] = o[e] * rdiv * g; }
            }
            u32x4 s0, s1;
            s0.x = cpk(y[0], y[1]); s0.y = cpk(y[2], y[3]); s0.z = cpk(y[4], y[5]); s0.w = cpk(y[6], y[7]);
            s1.x = cpk(y[8], y[9]); s1.y = cpk(y[10], y[11]); s1.z = cpk(y[12], y[13]); s1.w = cpk(y[14], y[15]);
            const unsigned so_ = (m0 - 64u + 8u * (unsigned)w) * (unsigned)(ZLD * 2) + (unsigned)(gcol * 2);
            if (STORE) { __builtin_amdgcn_raw_buffer_store_b128(s0, zrs, vo_g, so_, 0); __builtin_amdgcn_raw_buffer_store_b128(s1, zrs, vo_g + 16u, so_, 0); } else { asm volatile("" :: "v"(s0), "v"(s1)); }
        }
        if (n == 64) break;
        const LAS float* sv = vec2 + (n & 1) * SETSZ;
        float c4[4][2], qf[4][2], kf[4][2];
        if (ROLE == 0) {
            MX_PIN4(qi); MX_PIN4(ki);
            float run0 = 0.f, run1 = 0.f;
#pragma unroll
            for (int i = 0; i < 4; ++i) {
                const f32x2 x2 = *(const LAS f32x2*)(vec + V_XS + (4 * rg + i) * 64 + 2 * dp);
                run0 += flogsig(x2[0] + abd0) * (1.f / 16.f); run1 += flogsig(x2[1] + abd1) * (1.f / 16.f); c4[i][0] = run0; c4[i][1] = run1;
                qf[i][0] = bflo(qi[i]) * 0.125f; qf[i][1] = bfhi(qi[i]) * 0.125f; kf[i][0] = bflo(ki[i]); kf[i][1] = bfhi(ki[i]);
            }
            *(LAS f32x2*)(vec + V_SEG + rg * 64 + 2 * dp) = (f32x2){run0, run1};
            __syncthreads();
        } else {
            MX_PIN7(qi); MX_PIN7(ki);
            if (n == 0 && rg == 0) { qi[0] = qi[1] = qi[2] = 0u; ki[0] = ki[1] = ki[2] = 0u; }
#pragma unroll
            for (int i = 0; i < 4; ++i) {
                float aq0 = cbq[0], aq1 = cbq[1], ak0 = cbk[0], ak1 = cbk[1];
#pragma unroll
                for (int j = 0; j < 4; ++j) { aq0 += cwq[j][0] * bflo(qi[i + j]); aq1 += cwq[j][1] * bfhi(qi[i + j]); ak0 += cwk[j][0] * bflo(ki[i + j]); ak1 += cwk[j][1] * bfhi(ki[i + j]); }
                qf[i][0] = aq0 * fsigmoid(aq0); qf[i][1] = aq1 * fsigmoid(aq1); kf[i][0] = ak0 * fsigmoid(ak0) * 0.125f; kf[i][1] = ak1 * fsigmoid(ak1) * 0.125f;
                c4[i][0] = 0.f; c4[i][1] = 0.f;
            }
        }
        {
            float kt0[4], kt1[4];
            if (ROLE == 0) {
                float off0 = 0.f, off1 = 0.f, tot0 = 0.f, tot1 = 0.f;
#pragma unroll
                for (int r2 = 0; r2 < 16; ++r2) { const f32x2 s = *(const LAS f32x2*)(vec + V_SEG + r2 * 64 + 2 * dp); tot0 += s[0]; tot1 += s[1]; off0 += (r2 < rg) ? s[0] : 0.f; off1 += (r2 < rg) ? s[1] : 0.f; }
                if (rg == 0) *(LAS f32x2*)(vec + V_ELAST + 2 * dp) = (f32x2){fexp(tot0), fexp(tot1)};
#pragma unroll
                for (int i = 0; i < 4; ++i) {
                    const float cum0 = off0 + c4[i][0], cum1 = off1 + c4[i][1];
                    const float kk0 = kf[i][0] * fexp(-cum0), kk1 = kf[i][1] * fexp(-cum1);
                    *(LAS unsigned*)(Qs + (4 * rg + i) * PB + 2 * dp) = cpk(qf[i][0] * fexp(cum0), qf[i][1] * fexp(cum1));
                    *(LAS unsigned*)(Ks + (4 * rg + i) * PB + 2 * dp) = cpk(kk0, kk1);
                    kt0[i] = kk0; kt1[i] = kk1;
                }
            } else {
#pragma unroll
                for (int i = 0; i < 4; ++i) {
                    *(LAS unsigned*)(Qs + (4 * rg + i) * PB + 2 * dp) = cpk(qf[i][0], qf[i][1]);
                    *(LAS unsigned*)(Ks + (4 * rg + i) * PB + 2 * dp) = cpk(kf[i][0], kf[i][1]);
                    const float wk = sv[V_WK + 4 * rg + i];
                    kt0[i] = kf[i][0] * wk; kt1[i] = kf[i][1] * wk;
                }
            }
            *(LAS u32x2*)(KTs + (2 * dp) * PB + 4 * rg) = (u32x2){cpk(kt0[0], kt0[1]), cpk(kt0[2], kt0[3])};
            *(LAS u32x2*)(KTs + (2 * dp + 1) * PB + 4 * rg) = (u32x2){cpk(kt1[0], kt1[1]), cpk(kt1[2], kt1[3])};
            MX_PIN8(vi);
            u32x4 v0, v1;
            v0.x = (vi[0] & 0xffffu) | (vi[1] << 16); v0.y = (vi[2] & 0xffffu) | (vi[3] << 16); v0.z = (vi[4] & 0xffffu) | (vi[5] << 16); v0.w = (vi[6] & 0xffffu) | (vi[7] << 16);
            v1.x = (vi[0] >> 16) | (vi[1] & 0xffff0000u); v1.y = (vi[2] >> 16) | (vi[3] & 0xffff0000u); v1.z = (vi[4] >> 16) | (vi[5] & 0xffff0000u); v1.w = (vi[6] >> 16) | (vi[7] & 0xffff0000u);
            *(LAS u32x4*)(VTs + (2 * lane) * PB + 8 * w) = v0; *(LAS u32x4*)(VTs + (2 * lane + 1) * PB + 8 * w) = v1;
        }
        __syncthreads();
        { const unsigned so_ = (m0 + 8u * (unsigned)w) * (unsigned)(ZLD * 2) + (unsigned)(gcol * 2); gt0 = __builtin_amdgcn_raw_buffer_load_b128(zrs, vo_g, so_, 0); gt1 = __builtin_amdgcn_raw_buffer_load_b128(zrs, vo_g + 16u, so_, 0); }
        if (n < 63) MX_LOAD(m0 + 64u);
#define MX_FRAG(base, row, ks) (*(const LAS bf16x8*)(lds + (base) + ((row) * PB + 16 * (ks) + 8 * hh) * 2))
        if (w < 3) {
            const int ti = (w >= 1) ? 1 : 0, sj = (w == 2) ? 1 : 0;
            f32x16 sc;
#pragma unroll
            for (int r = 0; r < 16; ++r) sc[r] = 0.f;
#pragma unroll
            for (int ks = 0; ks < 4; ++ks) sc = MX_MFMA(MX_FRAG(L_KS, 32 * sj + r32, ks), MX_FRAG(L_QS, 32 * ti + r32, ks), sc);
            const float rtv = (ROLE == 1) ? sv[V_RT + 32 * ti + r32] : 0.f;
            float pv[16];
#pragma unroll
            for (int q4 = 0; q4 < 4; ++q4) {
                f32x4 cs4 = {0.f, 0.f, 0.f, 0.f};
                if (ROLE == 1) cs4 = *(const LAS f32x4*)(sv + V_CS + 32 * sj + 8 * q4 + 4 * hh);
#pragma unroll
                for (int i = 0; i < 4; ++i) {
                    const int r = 4 * q4 + i, s = crow(r, hh);
                    const bool keep = (ti != sj) || (s <= r32);
                    float val = sc[r];
                    if (ROLE == 1) val *= fexp(rtv + cs4[i]);
                    pv[r] = keep ? val : 0.f;
                }
            }
#pragma unroll
            for (int q4 = 0; q4 < 4; ++q4) *(LAS u32x2*)(Ps + (32 * ti + r32) * PB + 32 * sj + 8 * q4 + 4 * hh) = (u32x2){cpk(pv[4 * q4], pv[4 * q4 + 1]), cpk(pv[4 * q4 + 2], pv[4 * q4 + 3])};
        }
        f32x16 acco;
#pragma unroll
        for (int r = 0; r < 16; ++r) acco[r] = 0.f;
#pragma unroll
        for (int ks = 0; ks < 4; ++ks) acco = MX_MFMA(MX_FRAG(L_QS, 32 * wa + r32, ks), MX_FRAG(L_ST, 32 * wv + r32, ks), acco);
        if (ROLE == 1) {
#pragma unroll
            for (int r = 0; r < 16; ++r) acco[r] *= sv[V_WI + 32 * wa + crow(r, hh)];
            const float carry = sv[V_SC];
#pragma unroll
            for (int r = 0; r < 16; ++r) accS[r] *= carry;
        }
#pragma unroll
        for (int ks = 0; ks < 4; ++ks) accS = MX_MFMA(MX_FRAG(L_KT, 32 * wa + r32, ks), MX_FRAG(L_VT, 32 * wv + r32, ks), accS);
        if (ROLE == 0) {
#pragma unroll
            for (int r = 0; r < 16; ++r) accS[r] *= vec[V_ELAST + 32 * wa + crow(r, hh)];
        }
        __syncthreads();
        if (wa == 0) {
#pragma unroll
            for (int ks = 0; ks < 2; ++ks) acco = MX_MFMA(MX_FRAG(L_PS, r32, ks), MX_FRAG(L_VT, 32 * wv + r32, ks), acco);
        } else {
#pragma unroll
            for (int ks = 0; ks < 4; ++ks) acco = MX_MFMA(MX_FRAG(L_PS, 32 + r32, ks), MX_FRAG(L_VT, 32 * wv + r32, ks), acco);
        }
#pragma unroll
        for (int r = 0; r < 16; ++r) Os[(32 * wa + crow(r, hh)) * OSP + 32 * wv + r32] = acco[r];
#pragma unroll
        for (int q4 = 0; q4 < 4; ++q4) { u32x2 p; p.x = cpk(accS[4 * q4], accS[4 * q4 + 1]); p.y = cpk(accS[4 * q4 + 2], accS[4 * q4 + 3]);
            *(LAS u32x2*)(STs + (32 * wv + r32) * PB + 32 * wa + 8 * q4 + 4 * hh) = p; }
        if (ROLE == 0) { if (n < 63) MX_XS(); }
        else {
            const LAS float* nprev = vec2 + V_NORM + (n & 1) * 64;
            if (w < 4) {
                const int row = 16 * w + (lane >> 2), part = lane & 3;
                float qn = 0.f, si = 0.f, kn = 0.f;
#pragma unroll
                for (int k = 0; k < 2; ++k) {
                    const int c8i = 2 * part + k;
                    const u32x4 qv = *(const LAS u32x4*)(Qs + row * PB + 8 * c8i), pv = *(const LAS u32x4*)(Ps + row * PB + 8 * c8i), kv = *(const LAS u32x4*)(KTs + row * PB + 8 * c8i);
                    const f32x4 n0 = *(const LAS f32x4*)(nprev + 8 * c8i), n1 = *(const LAS f32x4*)(nprev + 8 * c8i + 4);
                    qn += bflo(qv.x) * n0[0] + bfhi(qv.x) * n0[1] + bflo(qv.y) * n0[2] + bfhi(qv.y) * n0[3] + bflo(qv.z) * n1[0] + bfhi(qv.z) * n1[1] + bflo(qv.w) * n1[2] + bfhi(qv.w) * n1[3];
                    si += (bflo(pv.x) + bfhi(pv.x)) + (bflo(pv.y) + bfhi(pv.y)) + (bflo(pv.z) + bfhi(pv.z)) + (bflo(pv.w) + bfhi(pv.w));
                    kn += (bflo(kv.x) + bfhi(kv.x)) + (bflo(kv.y) + bfhi(kv.y)) + (bflo(kv.z) + bfhi(kv.z)) + (bflo(kv.w) + bfhi(kv.w));
                }
                qn += dpp_f<0xB1>(qn, qn); si += dpp_f<0xB1>(si, si); kn += dpp_f<0xB1>(kn, kn);
                qn += dpp_f<0x4E>(qn, qn); si += dpp_f<0x4E>(si, si); kn += dpp_f<0x4E>(kn, kn);
                if (part == 0) {
                    const float den = sv[V_WI + row] * qn + si;
                    vec2[V_DEN + row] = 1.f / fmaxf(fabsf(den), sv[V_ENM + row]);
                    vec2[V_NORM + ((n + 1) & 1) * 64 + row] = sv[V_SC] * nprev[row] + kn;
                }
            }
            if (w == 7) {
                if (n < 63) MX_SCALARS(vec2 + ((n + 1) & 1) * SETSZ);
            }
        }
        __syncthreads();
        m0 += 64u;
    }
#undef MX_LOAD
#undef MX_XS
#undef MX_PIN4
#undef MX_PIN7
#undef MX_PIN8
#undef MX_SCALARS
#undef MX_FRAG
}
}

#ifndef PHASE_MASK
#define PHASE_MASK 0xFFFF
#endif
#define PH(k) if constexpr ((PHASE_MASK >> (k)) & 1)
#ifndef STAGGER_TICKS
#define STAGGER_TICKS 0
#endif
#ifndef PROBE_GEMM_REPS
#define PROBE_GEMM_REPS 1
#endif
#ifndef PROBE_STREAM_REPS
#define PROBE_STREAM_REPS 1
#endif
#ifndef PROBE_GEMM_MASK
#define PROBE_GEMM_MASK 0xFFFF
#endif
#define GREP(k) _Pragma("unroll 1") for (int rep_ = 0; rep_ < (((PROBE_GEMM_MASK >> (k)) & 1) ? PROBE_GEMM_REPS : 1); ++rep_)
#define GREP_BAR if (rep_) GRID_BAR();
#define BLK_ENV int blk = blockIdx.x; asm volatile("" : "+s"(blk));
#define PHASE_ENV BLK_ENV int tid = hw_tid(wave_s); asm volatile("" : "+v"(tid)); const int lane = tid & 63, wave = wave_s; int vcu_ = vcu; asm volatile("" : "+s"(vcu_)); const int gw = vcu_ * NWAVES + wave; (void)lane; (void)gw;
__global__ void __launch_bounds__(NWAVES * 64, 2) mega_fwd(Args args) {
    extern __shared__ __attribute__((aligned(16))) unsigned char lds_raw[];
    LAS unsigned char* lds = (LAS unsigned char*)lds_raw;
    const int G = gridDim.x, blk0 = blockIdx.x;
    const int wave_s = __builtin_amdgcn_readfirstlane(threadIdx.x >> 6);
    const int vcu = (G % 8 == 0) ? (blk0 % 8) * (G / 8) + blk0 / 8 : blk0;
    const int NGW = G * NWAVES;
    for (int u = threadIdx.x; u < (LDS_BYTES - LDSCTL_OFF) / 4; u += NWAVES * 64) ((LAS unsigned*)(lds + LDSCTL_OFF))[u] = 0u;
    __syncthreads();
    (void)xcd_barrier_post((unsigned*)(args.ws + WS_CTL) + CW_BAR, (volatile LAS unsigned*)(lds + MISC_OFF) + 8);
#define GRID_BAR() do { XcdBarrier b_; b_.bar = (unsigned*)(inp_ws() + WS_CTL) + CW_BAR; b_.x = xb_xcc_id(); b_.st = (volatile LAS unsigned*)(lds + MISC_OFF) + 8; xcd_barrier(b_, wave_s); } while (0)

    PH(0) { PHASE_ENV
        ada_phase(lds, blk, wave, lane);
        if (blk >= 192 && blk < 224) s5_generate(0, blk - 192, lds, wave_s);
        else {
            if (blk >= 224 && blk < 232) { convert_small(inp(8), (bf16_t*)WSP(WS_WSM), blk - 224, tid); __syncthreads(); }
            LAS float* scr = (LAS float*)(lds + wave * 16384);
            int base = 0;
            convert_matrix<1>(inp(8), INDIM, 1024, ZLD, (bf16_t*)WSP(WS_WIN), scr, lane, (blk < 192 ? blk : blk - 32) * NWAVES + wave, (G - 32) * NWAVES, base);
        }
    }
    GRID_BAR();

#pragma unroll 1
    for (int l = 0; l < DEPTH; ++l) {
        PH(1) if (l == 0) { PHASE_ENV
            prenorm0_rows(inp(0), (bf16_t*)inp_out(), inp(4), (const float*)WSP(WS_MOD), (bf16_t*)WSP(WS_H), gw, NGW, lane);
            GRID_BAR();
        }
        PH(2) GREP(2) { GREP_BAR BLK_ENV
            pg8::PlainSched S; S.o.init(M, NMIX, G, blk); S.A = (const bf16_t*)WSP(WS_H); S.lda = D; S.Bt = wp_win(l); S.K = D;
            pg8::EpiStore E{(bf16_t*)WSP(WS_Z), ZLD, STAGGER_TICKS, 1};
            pg8::gemm_phase<pg8::EpiStore, pg8::PlainSched, true, true>(lds, wave_s, D, D, S, E);
            {
                const int vb = (G % 8 == 0) ? (blk % 8) * (G / 8) + blk / 8 : blk;
                __syncthreads();
                for (int t0 = vb * 4; t0 < M / 32; t0 += G * 4) zs_mfma_pair((const bf16_t*)WSP(WS_H), wp_wsm(l), (float*)WSP(WS_ZS), t0 + (wave_s & 3), wave_s >> 2, wave_s & 3, lds, hw_lane());
            }
        }
        GRID_BAR();
        PH(3) { PHASE_ENV
            if ((blk & 7) < 2) {
                const int sidx = (blk >> 3) * 2 + (blk & 7);
                if (sidx < 32) mx::stream<0>(l, lds, sidx, wave_s); else mx::stream<1>(l, lds, sidx - 32, wave_s);
                if (l + 1 < DEPTH) {
                    __syncthreads();
                    int blk2 = blockIdx.x; asm volatile("" : "+s"(blk2)); const int sidx2 = (blk2 >> 3) * 2 + (blk2 & 7);
                    int tid2 = hw_tid(wave_s); asm volatile("" : "+v"(tid2)); const int lane2 = tid2 & 63;
                    int base = 0; LAS float* scr = (LAS float*)(lds + wave_s * 16384);
                    convert_matrix<1>(inp(8) + (size_t)(l + 1) * D * INDIM, INDIM, 1024, ZLD, wp_win(l + 1), scr, lane2, sidx2 * NWAVES + wave_s, 64 * NWAVES, base);
                    convert_matrix<2>(inp(31) + (size_t)l * D * 2 * FF, 2 * FF, 1024, 2 * FF, (bf16_t*)DUP(DU_WFI), scr, lane2, sidx2 * NWAVES + wave_s, 64 * NWAVES, base);
                } else {
                    __syncthreads();
                    int blk2 = blockIdx.x; asm volatile("" : "+s"(blk2)); const int sidx2 = (blk2 >> 3) * 2 + (blk2 & 7);
                    int tid2 = hw_tid(wave_s); asm volatile("" : "+v"(tid2)); const int lane2 = tid2 & 63;
                    int base = 0; LAS float* scr = (LAS float*)(lds + wave_s * 16384); const int gw2 = sidx2 * NWAVES + wave_s, NGW2 = 64 * NWAVES;
                    convert_matrix<2>(inp(31) + (size_t)l * D * 2 * FF, 2 * FF, 1024, 2 * FF, (bf16_t*)DUP(DU_WFI), scr, lane2, gw2, NGW2, base);
                }
            } else {
#define GX_ENV int blk_ = blockIdx.x; asm volatile("" : "+s"(blk_)); const int xq = blk_ & 7, gidx = (blk_ >> 3) * 6 + (xq - 2); const bool grpD = xq < 4; (void)gidx; (void)grpD;
#define S5_TASK(kk) do { \
                    { GX_ENV const int task = (grpD ? (blk_ >> 3) * 2 + (xq - 2) : 128 + (blk_ >> 3) * 4 + (xq - 4)) + 64 * (kk); \
                      int g256 = 256; asm volatile("" : "+s"(g256)); pg8::S5aSched S; S.G = g256; S.c = task; S.Zb = (const bf16_t*)WSP(WS_Z); S.Bt1 = wp_s5m1(l); pg8::EpiS5a E{l}; \
                      pg8::gemm_phase<pg8::EpiS5a, pg8::S5aSched, true, true, 1>(lds, wave_s, 0, 256, S, E); } \
                    { GX_ENV const int task = (grpD ? (blk_ >> 3) * 2 + (xq - 2) : 128 + (blk_ >> 3) * 4 + (xq - 4)) + 64 * (kk); s5_scan_lds(l, task >> 3, task & 7, lds, wave_s); } \
                    { asm volatile("s_waitcnt vmcnt(0)" ::: "memory"); __builtin_amdgcn_fence(__ATOMIC_RELEASE, "workgroup"); __syncthreads(); __builtin_amdgcn_fence(__ATOMIC_ACQUIRE, "workgroup"); } \
                    { GX_ENV const int task = (grpD ? (blk_ >> 3) * 2 + (xq - 2) : 128 + (blk_ >> 3) * 4 + (xq - 4)) + 64 * (kk); \
                      int g256 = 256; asm volatile("" : "+s"(g256)); pg8::S5bSched S; S.G = g256; S.c = task; S.X = (const bf16_t*)WSP(WS_Z); S.Bt3 = wp_s5m3(l); pg8::EpiS5b E{(bf16_t*)WSP(WS_Z), inp(23) + l * 512, lds}; \
                      pg8::gemm_phase<pg8::EpiS5b, pg8::S5bSched, true, true>(lds, wave_s, ZLD, 128, S, E); } \
                    __syncthreads(); } while (0)
                {   GX_ENV int base = 0; const int gw2 = gidx * NWAVES + wave, NGW2 = 192 * NWAVES;
                    LAS float* scr = (LAS float*)(lds + wave * 16384);
                    __syncthreads();
                }
#pragma unroll 1
                for (int kt = 0; kt < 2; ++kt) {
                    { GX_ENV if (kt == 1 && !grpD) break; }
                    S5_TASK(kt);
                }
                {
                    asm volatile("s_waitcnt vmcnt(0) lgkmcnt(0)" ::: "memory"); __syncthreads();
                    if (wave_s == 0 && hw_lane() == 0) __hip_atomic_fetch_add((unsigned*)WSP(WS_CTL) + CW_S5DONE, 1u, __ATOMIC_RELAXED, __HIP_MEMORY_SCOPE_AGENT);
                }
                {
                    GX_ENV
                    pg8::PlainSched S;
                    if (grpD) S.o.init(M, 768, 64, (blk_ >> 3) * 2 + (xq - 2), 2); else S.o.init(M, 2304, 128, (blk_ >> 3) * 4 + (xq - 4), 4);
                    const int coff = grpD ? 0 : 768;
                    S.A = (const bf16_t*)WSP(WS_H); S.lda = D; S.Bt = wp_win(l) + (size_t)(NMIX + coff) * D; S.K = D;
                    pg8::EpiStore E{(bf16_t*)WSP(WS_Z) + NMIX + coff, ZLD, 0, 2, 0, inp(29) + l * 3072 + coff};
                    E.waitp = grpD ? (unsigned*)WSP(WS_CTL) + CW_S5DONE : nullptr; E.waitn = 192u * (unsigned)(l + 1);
                    pg8::gemm_phase<pg8::EpiStore, pg8::PlainSched, true, true>(lds, wave_s, D, D, S, E);
                }
                {
                    GX_ENV
                    const bool allg = (l + 1 < DEPTH);
                    if (allg || grpD) {
                    if (wave_s == 0) { unsigned spins = 0; while ((unsigned)__builtin_amdgcn_readfirstlane(__hip_atomic_load((unsigned*)WSP(WS_CTL) + CW_S5DONE, __ATOMIC_RELAXED, __HIP_MEMORY_SCOPE_AGENT)) < 192u * (unsigned)(l + 1)) { __builtin_amdgcn_s_sleep(8); if (++spins > (1u << 22)) break; } }
                    __syncthreads();
                    int tid2 = hw_tid(wave_s); asm volatile("" : "+v"(tid2)); const int lane = tid2 & 63, wave = wave_s;
                    int base = 0; const int gw2 = (allg ? gidx : (blk_ >> 3) * 2 + (xq - 2)) * NWAVES + wave, NGW2 = (allg ? 192 : 64) * NWAVES;
                    LAS float* scr = (LAS float*)(lds + wave * 16384);
                    convert_matrix<0>(inp(24) + (size_t)l * 512 * 512, 512, 512, 512, (bf16_t*)WSP(WS_WGLU), scr, lane, gw2, NGW2, base);
                    convert_matrix<0>(inp(26) + (size_t)l * 512 * 1024, 1024, 512, 1024, (bf16_t*)WSP(WS_WPROJ), scr, lane, gw2, NGW2, base);
                    convert_matrix<0>(inp(27) + (size_t)l * 512 * 1024, 1024, 512, 1024, (bf16_t*)WSP(WS_WPROJ) + 1024 * 512, scr, lane, gw2, NGW2, base);
                    convert_matrix<0>(inp(28) + (size_t)l * 512 * 1024, 1024, 512, 1024, (bf16_t*)WSP(WS_WPROJ) + 2 * 1024 * 512, scr, lane, gw2, NGW2, base);
                    convert_matrix<0>(inp(30) + (size_t)l * D * D, 1024, 1024, 1024, (bf16_t*)WSP(WS_WOUT), scr, lane, gw2, NGW2, base);
                    convert_matrix<0>(inp(32) + (size_t)l * FF * D, 1024, FF, 1024, (bf16_t*)WSP(WS_WFO), scr, lane, gw2, NGW2, base);
                    }
                }
                { GX_ENV if (l + 1 < DEPTH && grpD && (blk_ >> 3) < 16) { __syncthreads(); s5_generate(l + 1, (blk_ >> 3) * 2 + (xq - 2), lds, wave_s); } }
                { GX_ENV if (l + 1 < DEPTH && grpD && xq == 2 && (blk_ >> 3) >= 16 && (blk_ >> 3) < 24) { __syncthreads(); int tid3 = hw_tid(wave_s); asm volatile("" : "+v"(tid3)); convert_small(inp(8) + (size_t)(l + 1) * D * INDIM, wp_wsm(l + 1), (blk_ >> 3) - 16, tid3); } }
#undef S5_TASK
#undef GX_ENV
            }
        }
        GRID_BAR();
        PH(4) GREP(4) { GREP_BAR BLK_ENV
            bf16_t* Z = (bf16_t*)WSP(WS_Z);
            pg8::PlainSched S; S.o.init(M, 512, G, blk); S.A = Z + SU; S.lda = ZLD; S.Bt = (const bf16_t*)WSP(WS_WGLU); S.K = 512;
            pg8::EpiGlu E{Z + YS2, ZLD, Z + SU, ZLD, inp(25) + l * 512, lds};
            pg8::gemm_phase<pg8::EpiGlu, pg8::PlainSched, true, true>(lds, wave_s, ZLD, 512, S, E);
        }
        GRID_BAR();
        PH(5) GREP(5) { GREP_BAR BLK_ENV
            bf16_t* Z = (bf16_t*)WSP(WS_Z);
            pg8::MergeSched S; S.o.init(M, 1024, G, blk); S.Zb = Z; S.Wp = (const bf16_t*)WSP(WS_WPROJ);
            pg8::EpiMerge E{Z + MRG, ZLD, Z + ZG, ZLD, inp(29) + l * 3072};
            pg8::gemm_phase<pg8::EpiMerge, pg8::MergeSched, true, true>(lds, wave_s, ZLD, 512, S, E);
        }
        GRID_BAR();
        PH(6) GREP(6) { GREP_BAR BLK_ENV
            pg8::PlainSched S; S.o.init(M, 1024, G, blk); S.A = (const bf16_t*)WSP(WS_Z) + MRG; S.lda = ZLD; S.Bt = (const bf16_t*)WSP(WS_WOUT); S.K = 1024;
            pg8::EpiNorm<0, false> E{l, lds + LT_OFF}; pg8::gemm_phase<pg8::EpiNorm<0, false>, pg8::PlainSched, true, true>(lds, wave_s, ZLD, 1024, S, E);
        }
        GRID_BAR();
        PH(8) GREP(8) { GREP_BAR BLK_ENV
            pg8::PlainSched S; S.o.init(M, 2 * FF, G, blk); S.A = (const bf16_t*)WSP(WS_H); S.lda = D; S.Bt = (const bf16_t*)DUP(DU_WFI); S.K = D;
            pg8::EpiSwiGlu E{(bf16_t*)WSP(WS_Z) + HIDC, ZLD, STAGGER_TICKS};
            pg8::gemm_phase<pg8::EpiSwiGlu, pg8::PlainSched, true, true>(lds, wave_s, D, D, S, E);
        }
        GRID_BAR();
        PH(9) GREP(9) { GREP_BAR BLK_ENV
            pg8::PlainSched S; S.o.init(M, 1024, G, blk); S.A = (const bf16_t*)WSP(WS_Z) + HIDC; S.lda = ZLD; S.Bt = (const bf16_t*)WSP(WS_WFO); S.K = FF;
            if (l + 1 < DEPTH) { pg8::EpiNorm<1, false> E{l, lds + LT_OFF}; pg8::gemm_phase<pg8::EpiNorm<1, false>, pg8::PlainSched, true, true>(lds, wave_s, ZLD, FF, S, E); }
            else { pg8::EpiNorm<1, true> E{l, lds + LT_OFF}; pg8::gemm_phase<pg8::EpiNorm<1, true>, pg8::PlainSched, true, true>(lds, wave_s, ZLD, FF, S, E); }
        }
        if (l + 1 < DEPTH) GRID_BAR();
    }
}

extern "C" void kernel_launch(void* const* d_in, const int* in_sizes, int n_in, void* d_out, int out_size, void* d_ws, size_t ws_size, hipStream_t stream) {
    static int grid = 0;
    if (grid == 0) {
        if (n_in != 33 || ws_size < WS_END || out_size != M * D) { fprintf(stderr, "kernel_launch: unexpected n_in %d / ws %zu / out %d\n", n_in, ws_size, out_size); grid = -1; return; }
        int dev = 0, cus = 0, per_cu = 0;
        if (hipGetDevice(&dev) != hipSuccess || hipDeviceGetAttribute(&cus, hipDeviceAttributeMultiprocessorCount, dev) != hipSuccess) { grid = -1; return; }
        if (hipFuncSetAttribute((const void*)mega_fwd, hipFuncAttributeMaxDynamicSharedMemorySize, LDS_BYTES) != hipSuccess) { fprintf(stderr, "kernel_launch: hipFuncSetAttribute failed\n"); grid = -1; return; }
        if (hipOccupancyMaxActiveBlocksPerMultiprocessor(&per_cu, (const void*)mega_fwd, NWAVES * 64, LDS_BYTES) != hipSuccess || per_cu < 1) { fprintf(stderr, "kernel_launch: occupancy query says %d blocks/CU\n", per_cu); grid = -1; return; }
        (void)hipGetLastError();
        grid = cus;
    }
    if (grid < 0) return;
    (void)hipMemsetAsync((char*)d_ws + WS_CTL, 0, CTL_ZERO_BYTES, stream);
    Args a{};
    for (int i = 0; i < 33; ++i) a.in[i] = (const float*)d_in[i];
    a.out = (float*)d_out; a.ws = (unsigned char*)d_ws;
    hipLaunchKernelGGL(mega_fwd, dim3(grid), dim3(NWAVES * 64), LDS_BYTES, stream, a);
}
```
